# Optimizing an MI355X kernel written in HIP

```python
import math
import jax, jax.numpy as jnp
from jax import lax
import numpy as np

D_MODEL = 2048
BATCH = 2
SEQ = 16384
DEPTH = 2

GRID_W = 64
CTX_LEN = 256
BRANCH_W = D_MODEL // 2
N_BRANCH = 3
A_DK = 64
A_DV = 2 * A_DK
A_HEADS = BRANCH_W // A_DV
R_DK = 128
R_DV = 256
R_HEADS = BRANCH_W // R_DV
R_CHUNK = 128
G_DK = 128
G_DV = 128
G_HEADS = BRANCH_W // G_DV
G_CHUNK = 64
D_FF = ((8 * D_MODEL // 3) + 127) // 128 * 128
ATTN_BLOCK = 128
ROPE_BASE = 10000.0
EPS = 1e-6
F_FLOOR = 1e-20
SPLITS = (A_HEADS * 2 * A_DK, A_HEADS * 2 * A_DK, A_HEADS * A_DV,
          R_HEADS * R_DK, R_HEADS * R_DK, R_HEADS * R_DV, R_HEADS * R_DV,
          G_HEADS * G_DK, G_HEADS * G_DK, G_HEADS * G_DK,
          G_HEADS * G_DV, G_HEADS * G_DV,
          D_MODEL, D_MODEL, D_MODEL)
N_IN = sum(SPLITS)

kernel_name = 'hybrid_diffattn_retnet_hgrn2_convffn_dit'


def rms(t):
    tf = t.astype(jnp.float32)
    return (tf * lax.rsqrt(jnp.mean(tf * tf, axis=-1, keepdims=True) + EPS)).astype(t.dtype)


def modulate(t, shift, scale):
    return rms(t) * (1.0 + scale) + shift


def axial_rope(t, row, col):
    half = t.shape[-1] // 2
    nf = half // 2
    inv = ROPE_BASE ** (-jnp.arange(nf, dtype=jnp.float32) / nf)

    def rot(u, pos):
        ang = pos.astype(jnp.float32)[:, None] * inv[None, :]
        cos = jnp.cos(ang)[None, :, None, :].astype(u.dtype)
        sin = jnp.sin(ang)[None, :, None, :].astype(u.dtype)
        u1, u2 = u[..., :nf], u[..., nf:]
        return jnp.concatenate([u1 * cos - u2 * sin, u1 * sin + u2 * cos], axis=-1)

    return jnp.concatenate([rot(t[..., :half], row), rot(t[..., half:], col)], axis=-1)


def diff_attention(q, k, v, lam):
    s = jnp.einsum('bqhmd,bkhmd->bhmqk', q, k, preferred_element_type=jnp.float32) * (A_DK ** -0.5)
    p = jax.nn.softmax(s, axis=-1)
    a = p[:, :, 0] - lam.astype(jnp.float32) * p[:, :, 1]
    return jnp.einsum('bhqk,bkhd->bqhd', a.astype(v.dtype), v)


def diff_attention_blocked(q, k, v, lam):
    B, T = q.shape[:2]
    nb = T // ATTN_BLOCK
    qb = q.reshape((B, nb, ATTN_BLOCK) + q.shape[2:]).swapaxes(0, 1)
    o = lax.map(lambda qi: diff_attention(qi, k, v, lam), qb)
    return o.swapaxes(0, 1).reshape(B, T, A_HEADS, A_DV)


def _chunk(a, C):
    B, T, H, d = a.shape
    return a.reshape(B, T // C, C, H, d).transpose(1, 0, 3, 2, 4)


def _unchunk(o):
    n, B, H, C, d = o.shape
    return o.transpose(1, 0, 3, 2, 4).reshape(B, n * C, H, d)


def retention_scan(q, k, v, log_gamma, s0):
    C = min(R_CHUNK, q.shape[1])
    dt = q.dtype
    idx = jnp.arange(C, dtype=jnp.float32)
    rel = idx[:, None] - idx[None, :]
    lg = log_gamma[:, None, None]
    dmat = jnp.where(rel >= 0, jnp.exp(lg * jnp.maximum(rel, 0.0)), 0.0).astype(dt)
    q_dec = jnp.exp(log_gamma[:, None] * (idx + 1.0)).astype(dt)[None, :, :, None]
    k_dec = jnp.exp(log_gamma[:, None] * (C - 1.0 - idx)).astype(dt)[None, :, :, None]
    s_dec = jnp.exp(log_gamma * C).astype(dt)[None, :, None, None]

    def step(S, inp):
        qc, kc, vc = inp
        att = jnp.einsum('bhid,bhjd->bhij', qc, kc) * dmat
        o = jnp.einsum('bhij,bhjv->bhiv', att, vc) + jnp.einsum('bhid,bhdv->bhiv', qc * q_dec, S)
        S = S * s_dec + jnp.einsum('bhjd,bhjv->bhdv', kc * k_dec, vc)
        return S, o

    S, o = lax.scan(step, s0, (_chunk(q, C), _chunk(k, C), _chunk(v, C)))
    return _unchunk(o), S


def retention_final_state(k, v, log_gamma):
    L = k.shape[1]
    w = jnp.exp(log_gamma[None, :] * (L - 1.0 - jnp.arange(L, dtype=jnp.float32))[:, None]).astype(k.dtype)
    return jnp.einsum('blhd,lh,blhv->bhdv', k, w, v)


def gla_scan(q, k, v, log_a, s0):
    C = G_CHUNK
    dt = q.dtype
    mask = jnp.tril(jnp.ones((C, C), dtype=bool))[None, None, :, :, None]
    maskf = mask.astype(jnp.float32)

    def step(S, inp):
        qc, kc, vc, lc = inp
        b = jnp.cumsum(lc.astype(jnp.float32), axis=2)
        rel = jnp.where(mask, b[:, :, :, None, :] - b[:, :, None, :, :], 0.0)
        dec = (jnp.exp(rel) * maskf).astype(dt)
        att = jnp.einsum('bhid,bhjd,bhijd->bhij', qc, kc, dec)
        o = jnp.einsum('bhij,bhjv->bhiv', att, vc) + jnp.einsum('bhid,bhdv->bhiv', qc * jnp.exp(b).astype(dt), S)
        b_last = b[:, :, -1:, :]
        S = S * jnp.exp(b_last[:, :, 0, :, None]).astype(dt) + jnp.einsum(
            'bhjd,bhjv->bhdv', kc * jnp.exp(b_last - b).astype(dt), vc)
        return S, o

    S, o = lax.scan(step, s0, (_chunk(q, C), _chunk(k, C), _chunk(v, C), _chunk(log_a, C)))
    return _unchunk(o), S


def gla_final_state(k, v, log_a):
    b = jnp.cumsum(log_a.astype(jnp.float32), axis=1)
    w = jnp.exp(b[:, -1:] - b).astype(k.dtype)
    return jnp.einsum('blhd,blhv->bhdv', k * w, v)


def token_mixer(hx, hc, w_in, b_gate, a_qk_norm, a_lambda, a_subln, r_norm, lower_bound, g_norm,
                w_branch, w_out, layer, row, col, need_ctx):
    off = np.cumsum((0,) + SPLITS)

    def part(h, i):
        return h @ w_in[:, int(off[i]):int(off[i + 1])]

    def heads(h, i, n, d):
        return part(h, i).reshape(h.shape[0], h.shape[1], n, d)

    def flip(a):
        return a[:, ::-1]

    outs_x, outs_c = [], []

    lam_init = 0.8 - 0.6 * math.exp(-0.3 * layer)
    lam = (jnp.exp(jnp.sum(a_lambda[0] * a_lambda[1])) - jnp.exp(jnp.sum(a_lambda[2] * a_lambda[3]))
           + lam_init)

    def diff_qk(h, i, gain, rotate):
        t = rms(heads(h, i, 2 * A_HEADS, A_DK)) * gain
        if rotate:
            t = axial_rope(t, row, col)
        return t.reshape(h.shape[0], h.shape[1], A_HEADS, 2, A_DK)

    def diff_post(o):
        return (rms(o) * a_subln * (1.0 - lam_init)).reshape(o.shape[0], o.shape[1], BRANCH_W)

    aqx = diff_qk(hx, 0, a_qk_norm[0], True)
    akx = diff_qk(hx, 1, a_qk_norm[1], True)
    akc = diff_qk(hc, 1, a_qk_norm[1], False)
    avx = heads(hx, 2, A_HEADS, A_DV)
    avc = heads(hc, 2, A_HEADS, A_DV)
    outs_x.append(diff_post(diff_attention_blocked(
        aqx, jnp.concatenate([akx, akc], axis=1), jnp.concatenate([avx, avc], axis=1), lam)))
    if need_ctx:
        aqc = diff_qk(hc, 0, a_qk_norm[0], False)
        outs_c.append(diff_post(diff_attention(aqc, akc, avc, lam)))

    log_gf = jnp.log1p(-jnp.exp2(-5.0 - jnp.arange(R_HEADS, dtype=jnp.float32)))
    log_gb = log_gf[::-1]

    def ret_q(h, rotate):
        q = heads(h, 3, R_HEADS, R_DK)
        return axial_rope(q, row, col) if rotate else q

    def ret_k(h, rotate):
        k = heads(h, 4, R_HEADS, R_DK) * (R_DK ** -0.5)
        return axial_rope(k, row, col) if rotate else k

    def ret_post(h, o):
        return jax.nn.silu(part(h, 6)) * (rms(o) * r_norm).reshape(h.shape[0], h.shape[1], BRANCH_W)

    rkc, rvc = ret_k(hc, False), heads(hc, 5, R_HEADS, R_DV)
    if need_ctx:
        rqc = ret_q(hc, False)
        r0 = jnp.zeros((hc.shape[0], R_HEADS, R_DK, R_DV), hc.dtype)
        rc_f, rs_f = retention_scan(rqc, rkc, rvc, log_gf, r0)
        rc_b, rs_b = retention_scan(flip(rqc), flip(rkc), flip(rvc), log_gb, r0)
        outs_c.append(ret_post(hc, rc_f + flip(rc_b)))
    else:
        rs_f = retention_final_state(rkc, rvc, log_gf)
        rs_b = retention_final_state(flip(rkc), flip(rvc), log_gb)
    rqx, rkx, rvx = ret_q(hx, True), ret_k(hx, True), heads(hx, 5, R_HEADS, R_DV)
    rx_f, _ = retention_scan(rqx, rkx, rvx, log_gf, rs_f)
    rx_b, _ = retention_scan(flip(rqx), flip(rkx), flip(rvx), log_gb, rs_b)
    outs_x.append(ret_post(hx, rx_f + flip(rx_b)))

    def hg_gate(h, i, lb):
        z = heads(h, i, G_HEADS, G_DK).astype(jnp.float32)
        lbh = lb.astype(jnp.float32).reshape(G_HEADS, G_DK)
        f = lbh + (1.0 - lbh) * jax.nn.sigmoid(z)
        log_f = jnp.log(jnp.maximum(f, F_FLOOR))
        one_minus_f = (1.0 - lbh) * jax.nn.sigmoid(-z)
        return log_f.astype(h.dtype), one_minus_f.astype(h.dtype)

    def hg_q(h):
        return jax.nn.silu(heads(h, 7, G_HEADS, G_DK)) * (G_DK ** -0.5)

    def hg_post(h, o):
        return jax.nn.silu(part(h, 11)) * (rms(o) * g_norm).reshape(h.shape[0], h.shape[1], BRANCH_W)

    lfc, kfc = hg_gate(hc, 8, lower_bound[0])
    lbc, kbc = hg_gate(hc, 9, lower_bound[1])
    ivc = heads(hc, 10, G_HEADS, G_DV)
    if need_ctx:
        gqc = hg_q(hc)
        g0 = jnp.zeros((hc.shape[0], G_HEADS, G_DK, G_DV), hc.dtype)
        gc_f, gs_f = gla_scan(gqc, kfc, ivc, lfc, g0)
        gc_b, gs_b = gla_scan(flip(gqc), flip(kbc), flip(ivc), flip(lbc), g0)
        outs_c.append(hg_post(hc, gc_f + flip(gc_b)))
    else:
        gs_f = gla_final_state(kfc, ivc, lfc)
        gs_b = gla_final_state(flip(kbc), flip(ivc), flip(lbc))
    lfx, kfx = hg_gate(hx, 8, lower_bound[0])
    lbx, kbx = hg_gate(hx, 9, lower_bound[1])
    ivx, gqx = heads(hx, 10, G_HEADS, G_DV), hg_q(hx)
    gx_f, _ = gla_scan(gqx, kfx, ivx, lfx, gs_f)
    gx_b, _ = gla_scan(flip(gqx), flip(kbx), flip(ivx), flip(lbx), gs_b)
    outs_x.append(hg_post(hx, gx_f + flip(gx_b)))

    def merge(h, outs):
        y = None
        for n, o in enumerate(outs):
            t = jax.nn.sigmoid(part(h, 12 + n) + b_gate[n]) * (o @ w_branch[n])
            y = t if y is None else y + t
        return y @ w_out

    return merge(hx, outs_x), (merge(hc, outs_c) if need_ctx else None)


def dwconv3(u, w, b):
    up = jnp.pad(u, ((0, 0), (1, 1), (0, 0)))
    return up[:, :-2] * w[0] + up[:, 1:-1] * w[1] + up[:, 2:] * w[2] + b


def conv_ffn(h, w_up, conv_w, conv_b, w_down):
    gate = dwconv3(h @ w_up[:, :D_FF], conv_w[:, :D_FF], conv_b[:D_FF])
    up = dwconv3(h @ w_up[:, D_FF:], conv_w[:, D_FF:], conv_b[D_FF:])
    return (jax.nn.silu(gate) * up) @ w_down


def setup_inputs(seed: int = 0) -> dict:
    key = jax.random.key(seed)
    ks = jax.random.split(key, 20)
    L, D = DEPTH, D_MODEL

    def n(k, shape, s):
        return jax.random.normal(k, shape, jnp.float32) * s

    return {
        'x': n(ks[0], (BATCH, SEQ, D), 1.0),
        'c': n(ks[1], (BATCH, D), 1.0),
        'ctx': n(ks[2], (BATCH, CTX_LEN, D), 1.0),
        'c_ctx': n(ks[3], (D,), 1.0),
        'w_mod': n(ks[4], (L, D, 6 * D), 0.5 * D ** -0.5),
        'b_mod': n(ks[5], (L, 6 * D), 0.02),
        'w_in': n(ks[6], (L, D, N_IN), D ** -0.5),
        'b_gate': n(ks[7], (L, N_BRANCH, D), 0.02),
        'a_qk_norm': 1.0 + n(ks[8], (L, 2, A_DK), 0.02),
        'a_lambda': n(ks[9], (L, 4, A_DK), 0.1),
        'a_subln': 1.0 + n(ks[10], (L, A_DV), 0.02),
        'r_norm': 1.0 + n(ks[11], (L, R_DV), 0.02),
        'g_lower_bound': n(ks[12], (L, 2, G_HEADS * G_DK), 0.1),
        'g_norm': 1.0 + n(ks[13], (L, G_DV), 0.02),
        'w_branch': n(ks[14], (L, N_BRANCH, BRANCH_W, D), BRANCH_W ** -0.5),
        'w_out': n(ks[15], (L, D, D), D ** -0.5),
        'w_up': n(ks[16], (L, D, 2 * D_FF), D ** -0.5),
        'conv_w': n(ks[17], (L, 3, 2 * D_FF), 0.5),
        'conv_b': n(ks[18], (L, 2 * D_FF), 0.02),
        'w_down': n(ks[19], (L, D_FF, D), D_FF ** -0.5),
    }


def reference(x, c, ctx, c_ctx, w_mod, b_mod, w_in, b_gate, a_qk_norm, a_lambda, a_subln, r_norm,
              g_lower_bound, g_norm, w_branch, w_out, w_up, conv_w, conv_b, w_down):
    T = x.shape[1]
    rows = T // GRID_W
    row = jnp.repeat(jnp.arange(rows), GRID_W)
    col = jnp.tile(jnp.arange(GRID_W), rows)
    lb_soft = jax.nn.softmax(g_lower_bound.astype(jnp.float32), axis=0)
    lower_bounds = jnp.cumsum(lb_soft, axis=0) - lb_soft[0]
    xc = ctx
    for l in range(DEPTH):
        need_ctx = l < DEPTH - 1
        mx = jnp.split((jax.nn.silu(c) @ w_mod[l] + b_mod[l])[:, None, :], 6, axis=-1)
        mc = jnp.split(jax.nn.silu(c_ctx) @ w_mod[l] + b_mod[l], 6, axis=-1)
        hx = modulate(x, mx[0], mx[1])
        hc = modulate(xc, mc[0], mc[1])
        ox, oc = token_mixer(hx, hc, w_in[l], b_gate[l], a_qk_norm[l], a_lambda[l], a_subln[l], r_norm[l],
                             lower_bounds[l], g_norm[l], w_branch[l], w_out[l], l, row, col, need_ctx)
        x = x + mx[2] * ox
        x = x + mx[5] * conv_ffn(modulate(x, mx[3], mx[4]), w_up[l], conv_w[l], conv_b[l], w_down[l])
        if need_ctx:
            xc = xc + mc[2] * oc
            xc = xc + mc[5] * conv_ffn(modulate(xc, mc[3], mc[4]), w_up[l], conv_w[l], conv_b[l], w_down[l])
    return x
```

```cpp
#include <hip/hip_runtime.h>
#include <cstdio>
#include <cstdint>
namespace pg8 {
#define PG8_LAS __attribute__((address_space(3)))
typedef unsigned short bf16_t;
typedef short bf16x8 __attribute__((ext_vector_type(8)));
typedef float f32x4 __attribute__((ext_vector_type(4)));
typedef unsigned u32x4 __attribute__((ext_vector_type(4)));
constexpr int BM = 256, BK = 64, HALF = 128, HTB = HALF * BK * 2  , STAGE_BYTES = 8 * HTB, NXCD = 8, WGM = 8;

__host__ __device__ __forceinline__ int lds_byte(int r, int c) { const int st = (r >> 4) * 2 + (c >> 5), rr = r & 15, cc = c & 31, ob = rr * 64 + cc * 2; return st * 1024 + (ob ^ (((ob >> 9) & 1) << 5)); }
__host__ __device__ __forceinline__ void stage_rc(int b, int& R, int& C) { const int st = b / 1024, sb = b % 1024, swz = sb ^ (((sb >> 9) & 1) << 5); R = (st >> 1) * 16 + swz / 64; C = (st & 1) * 32 + (swz % 64) / 2; }
__host__ __device__ __forceinline__ int perm32(int rho) { const int n = rho >> 4, i = rho & 15; return 8 * (i >> 2) + 4 * n + (i & 3); }

struct Unit { int pm, pn; };
struct Gemm { const bf16_t* A; const bf16_t* Bt; int M, N, K; };

struct StaticOrder {
    int nM, nN, nwg, G, c;
    __host__ __device__ void init(int M, int N, int G_, int c_) { nM = M / BM; nN = N / BM; nwg = nM * nN; G = G_; c = c_; }
    __host__ __device__ bool next(int i, Unit& u) const {
        const long L = (long)i * G + c; if (L >= nwg) return false;
        int wgid = (int)L; { const int q = nwg / NXCD, r = nwg % NXCD, xcd = wgid % NXCD, off = wgid / NXCD; wgid = (xcd < r ? xcd * (q + 1) : r * (q + 1) + (xcd - r) * q) + off; }
        const int nig = WGM * nN, gid = wgid / nig, fm = gid * WGM, gsz = (nM - fm) < WGM ? (nM - fm) : WGM;
        u.pm = fm + ((wgid % nig) % gsz); u.pn = (wgid % nig) / gsz; return true;
    }
    __device__ __forceinline__ void a_ready(const Unit&) const {}
    __device__ __forceinline__ void done(const Unit&) const {}
};
struct CountedOrder : StaticOrder {
    const unsigned* ready; unsigned need; unsigned* tmo;
    __device__ __forceinline__ void a_ready(const Unit& u) const {
        if (threadIdx.x < 64) {
            const unsigned long long t0 = __builtin_amdgcn_s_memrealtime(); unsigned polls = 0;
            while ((unsigned)__builtin_amdgcn_readfirstlane(__hip_atomic_load(ready + 64 * u.pm, __ATOMIC_RELAXED, __HIP_MEMORY_SCOPE_AGENT)) < need) {
                if ((++polls & 255u) == 0u && __builtin_amdgcn_readfirstlane(__hip_atomic_load(tmo, __ATOMIC_RELAXED, __HIP_MEMORY_SCOPE_AGENT)) != 0u) break;
                if (__builtin_amdgcn_s_memrealtime() - t0 > 2000000ull) {
                    if (threadIdx.x == 0) { unsigned expect = 0u; __hip_atomic_compare_exchange_strong(tmo + 1, &expect, 0x600u | (unsigned)(u.pm & 0xff), __ATOMIC_RELAXED, __ATOMIC_RELAXED, __HIP_MEMORY_SCOPE_AGENT); __hip_atomic_store(tmo, 1u, __ATOMIC_RELAXED, __HIP_MEMORY_SCOPE_AGENT); }
                    break; }
                __builtin_amdgcn_s_sleep(2); }
            __builtin_amdgcn_fence(__ATOMIC_ACQUIRE, "agent");
            asm volatile("s_waitcnt vmcnt(0)" ::: "memory");
        }
#if !defined(BROKEN_HOOK_NO_BARRIER)
        asm volatile("" ::: "memory"); __builtin_amdgcn_s_barrier(); asm volatile("" ::: "memory");
#endif
    }
};

template <class Epi, class Sched, bool STAMP = false>
__device__ __forceinline__ void gemm_phase(PG8_LAS unsigned char* lds, const Gemm g, const Sched& S, const Epi& E, unsigned long long* stamps) {
    const int tid = threadIdx.x, wid = __builtin_amdgcn_readfirstlane(tid >> 6), lane = tid & 63, wr = wid >> 2, wc = wid & 3, fr = lane & 15, fq = lane >> 4;
    const int K = g.K, nt = K / BK;
    int ts_lo = 0, ts_hi = 0, nts = 0; const unsigned long long rt_entry = STAMP ? (unsigned long long)wall_clock64() : 0ull;
#define PG8_STAMP() do { if (STAMP && wid == 0 && nts < 64) { const unsigned long long _c = (unsigned long long)clock64(); \
        ts_lo = (lane == nts) ? (int)(unsigned)_c : ts_lo; ts_hi = (lane == nts) ? (int)(unsigned)(_c >> 32) : ts_hi; ++nts; } } while (0)
    PG8_STAMP();
    unsigned voffA[2], voffB[2];
#pragma unroll
    for (int i = 0; i < 2; ++i) { int R, C; stage_rc(tid * 16 + i * 8192, R, C); const int Rb = Epi::PERM ? ((R & ~31) + perm32(R & 31)) : R;
        voffA[i] = (unsigned)(R * K + C) * 2u; voffB[i] = (unsigned)(Rb * K + C) * 2u; }
    const size_t kstep = (size_t)(BK * 2);
    const size_t hstep = (size_t)HALF * K * 2;
    const size_t tstep = 2 * hstep;
    const unsigned ldsw = (unsigned)wid * 1024u;
    const int aoff = lds_byte(wr * 64 + fr, fq * 8), boff = lds_byte(wc * 32 + fr, fq * 8);
#define PG8_SA(b, h) (((b) * 2 + (h)) * HTB)
#define PG8_SB(b, h) ((4 + (b) * 2 + (h)) * HTB)
#define PG8_STAGE(bufoff, gbase, voff) do { _Pragma("unroll") for (int _i = 0; _i < 2; ++_i) \
        __builtin_amdgcn_global_load_lds((const unsigned*)((const char*)(gbase) + (voff)[_i]), (PG8_LAS unsigned*)(lds + (bufoff) + ldsw + _i * 8192), 16, 0, 0); } while (0)
#define PG8_LDA(dst, b, h) do { _Pragma("unroll") for (int m = 0; m < 4; ++m) _Pragma("unroll") for (int k = 0; k < 2; ++k) dst[m][k] = *(const PG8_LAS bf16x8*)(lds + PG8_SA(b, h) + aoff + m * 2048 + k * 1024); } while (0)
#define PG8_LDB(dst, b, h) do { _Pragma("unroll") for (int n = 0; n < 2; ++n) _Pragma("unroll") for (int k = 0; k < 2; ++k) dst[n][k] = *(const PG8_LAS bf16x8*)(lds + PG8_SB(b, h) + boff + n * 2048 + k * 1024); } while (0)
#define PG8_MMA(ai, bj, At, Bt) do { __builtin_amdgcn_s_setprio(1); _Pragma("unroll") for (int m = 0; m < 4; ++m) _Pragma("unroll") for (int n = 0; n < 2; ++n) _Pragma("unroll") for (int k = 0; k < 2; ++k) \
        acc[ai][bj][m][n] = __builtin_amdgcn_mfma_f32_16x16x32_bf16(Bt[n][k], At[m][k], acc[ai][bj][m][n], 0, 0, 0); __builtin_amdgcn_s_setprio(0); } while (0)
#define PG8_WAIT_V(n) asm volatile("s_waitcnt vmcnt(" #n ")" ::: "memory")
#define PG8_WAIT_L(n) asm volatile("s_waitcnt lgkmcnt(" #n ")" ::: "memory")
#define PG8_BAR __builtin_amdgcn_s_barrier()
#define PG8_SCHED __builtin_amdgcn_sched_barrier(0)
    Unit cur, nxt; int ui = 0;
    if (!S.next(0, cur)) return;
    f32x4 acc[2][2][4][2];
#pragma unroll
    for (int a = 0; a < 2; ++a)
#pragma unroll
        for (int b = 0; b < 2; ++b)
#pragma unroll
            for (int m = 0; m < 4; ++m)
#pragma unroll
                for (int n = 0; n < 2; ++n) acc[a][b][m][n] = (f32x4){0.f, 0.f, 0.f, 0.f};
    bf16x8 At[4][2], B0[2][2], B1[2][2];
    const char* cA = (const char*)g.A + (size_t)cur.pm * tstep; const char* cB = (const char*)g.Bt + (size_t)cur.pn * tstep;
    S.a_ready(cur);
    PG8_STAGE(PG8_SB(0, 0), cB, voffB); PG8_STAGE(PG8_SA(0, 0), cA, voffA); PG8_STAGE(PG8_SB(0, 1), cB + hstep, voffB); PG8_STAGE(PG8_SA(0, 1), cA + hstep, voffA);
    if (wr == 1) PG8_BAR;
    PG8_WAIT_V(4); PG8_BAR;
    PG8_STAGE(PG8_SB(1, 0), cB + kstep, voffB); PG8_STAGE(PG8_SA(1, 0), cA + kstep, voffA); PG8_STAGE(PG8_SB(1, 1), cB + hstep + kstep, voffB);
    PG8_WAIT_V(6); PG8_BAR;
    PG8_STAMP();
    for (;;) {
        const bool has_next = S.next(ui + 1, nxt);
        const char* nA = has_next ? (const char*)g.A + (size_t)nxt.pm * tstep : cA; const char* nB = has_next ? (const char*)g.Bt + (size_t)nxt.pn * tstep : cB;
        for (int t = 0; t < nt; t += 2) {
            const bool last = (t == nt - 2);
            const char* a1 = cA + (size_t)(t + 1) * kstep;
            const char* a2 = last ? nA : cA + (size_t)(t + 2) * kstep; const char* b2 = last ? nB : cB + (size_t)(t + 2) * kstep;
            const char* a3 = a2 + kstep; const char* b3 = b2 + kstep;
            if (last && has_next) S.a_ready(nxt);
            PG8_LDB(B0, 0, 0); PG8_SCHED; PG8_LDA(At, 0, 0); PG8_STAGE(PG8_SA(1, 1), a1 + hstep, voffA);
            PG8_WAIT_L(8); PG8_BAR; PG8_WAIT_L(0); PG8_MMA(0, 0, At, B0); PG8_BAR; PG8_SCHED;
            PG8_LDB(B1, 0, 1); PG8_STAGE(PG8_SB(0, 0), b2, voffB);
            PG8_BAR; PG8_WAIT_L(0); PG8_MMA(0, 1, At, B1); PG8_BAR;
            PG8_LDA(At, 0, 1); PG8_STAGE(PG8_SA(0, 0), a2, voffA);
            PG8_BAR; PG8_WAIT_L(0); PG8_MMA(1, 0, At, B0); PG8_BAR; PG8_SCHED;
            PG8_STAGE(PG8_SB(0, 1), b2 + hstep, voffB);
            PG8_WAIT_V(6); PG8_BAR; PG8_MMA(1, 1, At, B1); PG8_BAR;
            PG8_LDB(B0, 1, 0); PG8_SCHED; PG8_LDA(At, 1, 0); PG8_STAGE(PG8_SA(0, 1), a2 + hstep, voffA);
            PG8_WAIT_L(8); PG8_BAR; PG8_WAIT_L(0); PG8_MMA(0, 0, At, B0); PG8_BAR; PG8_SCHED;
            PG8_LDB(B1, 1, 1); PG8_STAGE(PG8_SB(1, 0), b3, voffB);
            PG8_BAR; PG8_WAIT_L(0); PG8_MMA(0, 1, At, B1); PG8_BAR;
            PG8_LDA(At, 1, 1); PG8_STAGE(PG8_SA(1, 0), a3, voffA);
            PG8_BAR; PG8_WAIT_L(0); PG8_MMA(1, 0, At, B0); PG8_BAR; PG8_SCHED;
            PG8_STAGE(PG8_SB(1, 1), b3 + hstep, voffB);
            PG8_WAIT_V(6); PG8_BAR; PG8_MMA(1, 1, At, B1); PG8_BAR;
        }
        PG8_STAMP();
        if constexpr (!Epi::AFTER_DRAIN) { E(acc, cur, wr, wc, fr, fq); S.done(cur); }
        PG8_STAMP();
        if (!has_next) break;
#pragma unroll
        for (int a = 0; a < 2; ++a)
#pragma unroll
            for (int b = 0; b < 2; ++b)
#pragma unroll
                for (int m = 0; m < 4; ++m)
#pragma unroll
                    for (int n = 0; n < 2; ++n) acc[a][b][m][n] = (f32x4){0.f, 0.f, 0.f, 0.f};
        cur = nxt; cA = nA; cB = nB; ++ui;
    }
    PG8_WAIT_V(0);
    if (wr == 0) PG8_BAR;
    PG8_BAR;
    if constexpr (Epi::AFTER_DRAIN) { E.fused(acc, cur, wr, wc, fr, fq, lds, wid, lane); S.done(cur); }
    PG8_STAMP();
    if (STAMP && wid == 0) { stamps[lane] = lane < nts ? (((unsigned long long)(unsigned)ts_hi << 32) | (unsigned)ts_lo) : 0ull;
        if (lane == 62) stamps[62] = rt_entry; if (lane == 63) stamps[63] = (unsigned long long)wall_clock64(); }
#undef PG8_STAMP
#undef PG8_SA
#undef PG8_SB
#undef PG8_STAGE
#undef PG8_LDA
#undef PG8_LDB
#undef PG8_MMA
#undef PG8_WAIT_V
#undef PG8_WAIT_L
#undef PG8_BAR
#undef PG8_SCHED
}
}

#define GAS __attribute__((address_space(1)))
#define LAS __attribute__((address_space(3)))
typedef unsigned short bf16_t;
typedef short bf16x8 __attribute__((ext_vector_type(8)));
typedef short s16x4 __attribute__((ext_vector_type(4)));
typedef float f32x4 __attribute__((ext_vector_type(4)));
typedef float f32x2 __attribute__((ext_vector_type(2)));
typedef float f32x16 __attribute__((ext_vector_type(16)));
typedef unsigned u32x4 __attribute__((ext_vector_type(4)));
typedef unsigned u32x2 __attribute__((ext_vector_type(2)));

__device__ __forceinline__ unsigned cvtpk(float lo, float hi) { unsigned r; asm volatile("v_cvt_pk_bf16_f32 %0, %1, %2" : "=v"(r) : "v"(lo), "v"(hi)); return r; }
__device__ __forceinline__ float bf2f(unsigned short b) { return __uint_as_float(((unsigned)b) << 16); }
__device__ __forceinline__ float bflo(unsigned w) { return __uint_as_float(w << 16); }
__device__ __forceinline__ float bfhi(unsigned w) { return __uint_as_float(w & 0xffff0000u); }
__device__ __forceinline__ float wave_sum(float v) {
#pragma unroll
    for (int o = 1; o < 64; o <<= 1) v += __shfl_xor(v, o);
    return v;
}
__device__ __forceinline__ float sigmoidf_(float x) { return 1.0f / (1.0f + __expf(-x)); }
__device__ __forceinline__ float siluf_(float x) { return x / (1.0f + __expf(-x)); }

#define XB_TMO      128
#define XB_XCNT(j)  (256  + 64 * (j))
#define XB_XSUB(j)  (1280 + 64 * (j))
#define XB_XGEN(j)  (2304 + 64 * (j))
#define XB_TOP      3328
#define XB_TOPGEN   3392
#define XCD_BAR_WORDS 3456
#define XB_SPIN_CAP (1u << 18)

__device__ __forceinline__ unsigned xb_ld(unsigned* p)              { return __hip_atomic_load(p, __ATOMIC_RELAXED, __HIP_MEMORY_SCOPE_AGENT); }
__device__ __forceinline__ unsigned xb_add(unsigned* p, unsigned v) { return __hip_atomic_fetch_add(p, v, __ATOMIC_RELAXED, __HIP_MEMORY_SCOPE_AGENT); }
__device__ __forceinline__ unsigned xb_xcc_id() { return (unsigned)__builtin_amdgcn_s_getreg((3 << 11) | 20) & 0xFu; }
#define XB_SPIN(cond, bar) do { unsigned _sp = 0; while (cond) { __builtin_amdgcn_s_sleep(1); \
    if ((++_sp & 255u) == 0u) { if (xb_ld(&(bar)[XB_TMO])) break; if (_sp > XB_SPIN_CAP) { atomicAdd(&(bar)[XB_TMO], 1u); break; } } } } while (0)

struct XcdBarrier {
    unsigned* bar; unsigned x;
    volatile LAS unsigned* st;
};
__device__ __forceinline__ XcdBarrier xcd_barrier_post(unsigned* bar, volatile LAS unsigned* st) {
    XcdBarrier b; b.bar = bar; b.x = xb_xcc_id(); b.st = st;
    if (threadIdx.x == 0) (void)xb_add(&bar[XB_XCNT(b.x)], 1u);
    return b;
}
__device__ __forceinline__ void xcd_barrier_complete(unsigned* bar, unsigned x, unsigned& nloc, unsigned& nx) {
    const unsigned G = gridDim.x * gridDim.y * gridDim.z;
    unsigned sum, cnt, mine, sp = 0u;
    for (;;) {
        sum = 0u; cnt = 0u; mine = 0u;
#pragma unroll
        for (unsigned j = 0; j < 16; ++j) { const unsigned c = xb_ld(&bar[XB_XCNT(j)]); sum += c; cnt += (c > 0u) ? 1u : 0u; mine = (j == x) ? c : mine; }
        if (sum == G) break;
        __builtin_amdgcn_s_sleep(1);
        if ((++sp & 255u) == 0u) { if (xb_ld(&bar[XB_TMO])) break; if (sp > XB_SPIN_CAP) { atomicAdd(&bar[XB_TMO], 1u); break; } }
    }
    nloc = mine > 0u ? mine : 1u; nx = cnt > 0u ? cnt : 1u;
}
__device__ __forceinline__ void xcd_barrier(const XcdBarrier& b) {
    asm volatile("s_waitcnt vmcnt(0)" ::: "memory");
    __syncthreads();
    if (threadIdx.x == 0) {
        unsigned* bar = b.bar;
        __builtin_amdgcn_s_waitcnt(0);
        unsigned nloc = b.st[0], nx = b.st[1];
        if (nloc == 0u) { xcd_barrier_complete(bar, b.x, nloc, nx); b.st[0] = nloc; b.st[1] = nx; }
        const unsigned old = xb_add(&bar[XB_XSUB(b.x)], 1u);
        const unsigned gen = old / nloc;
        if (old + 1u == (gen + 1u) * nloc) {
            __builtin_amdgcn_fence(__ATOMIC_RELEASE, "agent");
            asm volatile("s_waitcnt vmcnt(0)" ::: "memory");
            const unsigned og = xb_add(&bar[XB_TOP], 1u);
            const unsigned tg = og / nx;
            if (og + 1u == (tg + 1u) * nx) xb_add(&bar[XB_TOPGEN], 1u);
            else XB_SPIN(xb_ld(&bar[XB_TOPGEN]) == tg, bar);
            __builtin_amdgcn_fence(__ATOMIC_ACQUIRE, "agent");
            xb_add(&bar[XB_XGEN(b.x)], 1u);
            asm volatile("s_waitcnt vmcnt(0)" ::: "memory");
        } else {
            XB_SPIN(xb_ld(&bar[XB_XGEN(b.x)]) == gen, bar);
            __builtin_amdgcn_fence(__ATOMIC_ACQUIRE, "agent");
            asm volatile("s_waitcnt vmcnt(0)" ::: "memory");
        }
    }
    __syncthreads();
}

constexpr int D = 2048, NB = 2, T = 16384, LC = 256, TT = T + LC  , MR = NB * TT  ;
constexpr int NPAN = MR / 256  , PPB = TT / 256  ;
constexpr int NIN = 17408, DFF = 5504, NUP = 2 * DFF;
constexpr int NWAVES = 8, NTHR = 512;
constexpr float EPS = 1e-6f;
constexpr float LOG2E = 1.4426950408889634f;

enum { I_X = 0, I_C, I_CTX, I_CCTX, I_WMOD, I_BMOD, I_WIN, I_BGATE, I_QKN, I_LAMBDA, I_SUBLN, I_RNORM, I_GLB, I_GNORM, I_WBR, I_WOUT, I_WUP, I_CONVW, I_CONVB, I_WDOWN, N_INPUTS };

enum { TY_ROPE64 = 0, TY_ROPE128 = 1, TY_PLAIN = 2 };
enum { PT_DQ = 0, PT_DK = 4, PT_DV = 8, PT_RQ = 12, PT_RK = 14, PT_RV = 16, PT_GQ = 20, PT_GF = 24, PT_GB = 28, PT_GI = 32, PT_RG = 36, PT_GG = 40, PT_MA = 44, PT_MB = 52, PT_MC = 60, PT_END = 68 };
__host__ __device__ __forceinline__ int pt_logical_base(int pt) {
    if (pt < PT_RQ) return 256 * pt;
    if (pt < PT_RV) return 3072 + 256 * (pt - PT_RQ);
    if (pt < PT_GQ) return 4096 + 256 * (pt - PT_RV);
    if (pt < PT_RG) return 6144 + 256 * (pt - PT_GQ);
    if (pt < PT_GG) return 5120 + 256 * (pt - PT_RG);
    if (pt < PT_MA) return 10240 + 256 * (pt - PT_GG);
    return 11264 + 256 * (pt - PT_MA);
}
__host__ __device__ __forceinline__ int pt_type(int pt) { return pt < PT_DV ? TY_ROPE64 : (pt >= PT_RQ && pt < PT_RV) ? TY_ROPE128 : TY_PLAIN; }
__host__ __device__ __forceinline__ int perm_col(int type, int p) {
    const int bj = p >> 7, wc = (p >> 5) & 3, n = (p >> 4) & 1, fq = (p >> 2) & 3, e = p & 3;
    if (type == TY_ROPE64)  return 64 * wc + 32 * (fq >> 1) + 16 * bj + 8 * (fq & 1) + 4 * n + e;
    if (type == TY_ROPE128) return 128 * (wc >> 1) + 64 * (wc & 1) + 32 * bj + 8 * fq + 4 * n + e;
    return 64 * wc + 16 * fq + 8 * bj + 4 * n + e;
}
__host__ __device__ __forceinline__ int perm_col_up(int p) { const int bj = p >> 7, wc = (p >> 5) & 3, n = (p >> 4) & 1, fq = (p >> 2) & 3, e = p & 3; return 128 * bj + 32 * wc + 8 * fq + 4 * n + e; }

constexpr size_t MiB = 1u << 20;
constexpr size_t WS_CTL = 0, CTL_ZERO_BYTES = 1 * MiB;
constexpr size_t WS_MODP = 1 * MiB;
constexpr size_t WS_MODV = 6 * MiB;
constexpr size_t WS_ROPEA = 7 * MiB;
constexpr size_t WS_ROPEB = 7 * MiB + 64 * 1024;
constexpr size_t WS_LB = 7 * MiB + 256 * 1024;
constexpr size_t WS_SCAL = 7 * MiB + 512 * 1024;
constexpr size_t WS_XC = 9 * MiB;
constexpr size_t WS_WT = 13 * MiB;
constexpr size_t WT_IN = 0, WT_BR = 68 * MiB, WT_OUT = 80 * MiB, WT_UP = 88 * MiB, WT_DOWN = 131 * MiB;
constexpr size_t WS_H = 166 * MiB;
constexpr size_t WS_DYN = 296 * MiB;
constexpr size_t DY_OA = WS_DYN, DY_OB = WS_DYN + 65 * MiB, DY_OC = WS_DYN + 130 * MiB;
constexpr size_t DY_R1 = WS_DYN + 195 * MiB;
constexpr size_t DY_R2 = WS_DYN + 455 * MiB;
constexpr size_t DY_OACC = WS_DYN + 585 * MiB;
constexpr size_t DY_G = WS_DYN, DY_RAW = WS_DYN + 350 * MiB;
constexpr size_t WS_END = WS_DYN + 715 * MiB;
constexpr size_t SZ_ROWS1K = (size_t)MR * 1024 * 2;

constexpr int CW_BAR = 4096;

constexpr int RING_BYTES = 131072, LDSCTL_OFF = RING_BYTES, MISC_OFF = LDSCTL_OFF + 320, LDS_BYTES = 147456;

struct Args { const float* in[N_INPUTS]; float* out; unsigned char* ws; int layer, ph_lo, ph_hi, pad; };

struct Frame {
    LAS unsigned char* lds; unsigned char* ldsg;
    int tid, lane, wave, G, bid;
    const float* in[N_INPUTS]; float* out; unsigned char* ws;
};
#define WSP(T_, off) ((T_*)(F.ws + (off)))

__device__ __forceinline__ void p0_mod_partial(Frame& F) {
    LAS float* sv = (LAS float*)F.lds;
    for (int i = F.tid; i < 3 * D; i += NTHR) { const int v = i / D, k = i % D; const float c = v < 2 ? F.in[I_C][v * D + k] : F.in[I_CCTX][k]; sv[i] = siluf_(c); }
    __syncthreads();
    float* part = WSP(float, WS_MODP);
    const int total = 2 * 16 * 3072;
    for (int task = F.bid * NTHR + F.tid; task < total; task += F.G * NTHR) {
        const int q = task % 3072, ks = (task / 3072) % 16, l = task / (3072 * 16);
        const float* W = F.in[I_WMOD] + ((size_t)l * D + ks * 128) * (6 * D) + q * 4;
        f32x4 a0 = {0, 0, 0, 0}, a1 = a0, a2 = a0;
#pragma unroll 8
        for (int k = 0; k < 128; ++k) { const f32x4 w = *(const f32x4*)(W + (size_t)k * (6 * D)); const float s0 = sv[ks * 128 + k], s1 = sv[D + ks * 128 + k], s2 = sv[2 * D + ks * 128 + k];
            a0 += w * s0; a1 += w * s1; a2 += w * s2; }
        float* o = part + ((size_t)(ks * 2 + l) * 3) * (6 * D) + q * 4;
        *(f32x4*)(o) = a0; *(f32x4*)(o + 6 * D) = a1; *(f32x4*)(o + 12 * D) = a2;
    }
    __syncthreads();
}
__device__ __forceinline__ void p0_tables(Frame& F) {
    const int gt = F.bid * NTHR + F.tid, NGT = F.G * NTHR;
    f32x2* ra = WSP(f32x2, WS_ROPEA); f32x2* rb = WSP(f32x2, WS_ROPEB);
    for (int i = gt; i < 256 * 16; i += NGT) { const int pos = i >> 4, f = i & 15; const float inv = powf(10000.0f, -(float)f / 16.0f); const float ang = (float)pos * inv; ra[i] = (f32x2){cosf(ang), sinf(ang)}; }
    for (int i = gt; i < 256 * 32; i += NGT) { const int pos = i >> 5, f = i & 31; const float inv = powf(10000.0f, -(float)f / 32.0f); const float ang = (float)pos * inv; rb[i] = (f32x2){cosf(ang), sinf(ang)}; }
    float* lb = WSP(float, WS_LB);
    for (int i = gt; i < 2 * 1024; i += NGT) { const float g0 = F.in[I_GLB][i], g1 = F.in[I_GLB][2048 + i]; const float m = fmaxf(g0, g1); const float e0 = expf(g0 - m), e1 = expf(g1 - m);
        lb[i] = 0.0f; lb[2048 + i] = e1 / (e0 + e1); }
    if (gt == 0) {
        float* sc = WSP(float, WS_SCAL);
        for (int l = 0; l < 2; ++l) {
            const float* al = F.in[I_LAMBDA] + l * 256; float s1 = 0.f, s2 = 0.f;
            for (int i = 0; i < 64; ++i) { s1 += al[i] * al[64 + i]; s2 += al[128 + i] * al[192 + i]; }
            const float lam_init = 0.8f - 0.6f * expf(-0.3f * (float)l);
            sc[l] = expf(s1) - expf(s2) + lam_init;
            const float* g = F.in[I_QKN] + l * 128; float mq = 0.f, mk = 0.f;
            for (int i = 0; i < 64; ++i) { mq = fmaxf(mq, fabsf(g[i])); mk = fmaxf(mk, fabsf(g[64 + i])); }
            sc[2 + l] = -(8.0f * mq * mk * 1.02f) * LOG2E;
        }
    }
}
__device__ __forceinline__ void convert_tile(Frame& F, const float* W, int N, int K, bf16_t* WT, int prow0, int k0, int base0, int base1, int ptype  ) {
    LAS float* t = (LAS float*)F.lds;
#pragma unroll 4
    for (int i = 0; i < 32; ++i) { const int idx = i * NTHR + F.tid, kk = idx >> 8, c = idx & 255; const int col = c < 128 ? base0 + c : base1 + (c - 128);
        t[kk * 257 + c] = W[(size_t)(k0 + kk) * N + col]; }
    __syncthreads();
#pragma unroll
    for (int i = 0; i < 4; ++i) { const int item = i * NTHR + F.tid, ch = item & 7, p = item >> 3; const int lc = ptype < 0 ? perm_col_up(p) : perm_col(ptype, p);
        const LAS float* s = t + (8 * ch) * 257 + lc;
        u32x4 o; o.x = cvtpk(s[0], s[257]); o.y = cvtpk(s[2 * 257], s[3 * 257]); o.z = cvtpk(s[4 * 257], s[5 * 257]); o.w = cvtpk(s[6 * 257], s[7 * 257]);
        *(u32x4*)(WT + (size_t)(prow0 + p) * K + k0 + 8 * ch) = o; }
    __syncthreads();
}
__device__ __forceinline__ void convert_weights(Frame& F, int l) {
    bf16_t* wt = WSP(bf16_t, WS_WT);
    constexpr int T_IN = 68 * 32, T_BR = 3 * 8 * 16, T_OUT = 8 * 32, T_UP = 43 * 32, T_DN = 8 * 86, T_ALL = T_IN + T_BR + T_OUT + T_UP + T_DN;
    for (int it = F.bid; it < T_ALL; it += F.G) {
        int r = it;
        if (r < T_IN) { const int pt = r / 32, kb = r % 32; const int lb = pt_logical_base(pt);
            convert_tile(F, F.in[I_WIN] + (size_t)l * D * NIN, NIN, D, wt + WT_IN / 2, pt * 256, kb * 64, lb, lb + 128, pt_type(pt)); continue; } r -= T_IN;
        if (r < T_BR) { const int n = r / 128, pt = (r % 128) / 16, kb = r % 16;
            convert_tile(F, F.in[I_WBR] + ((size_t)l * 3 + n) * 1024 * D, D, 1024, wt + WT_BR / 2 + (size_t)n * D * 1024, pt * 256, kb * 64, pt * 256, pt * 256 + 128, TY_PLAIN); continue; } r -= T_BR;
        if (r < T_OUT) { const int pt = r / 32, kb = r % 32;
            convert_tile(F, F.in[I_WOUT] + (size_t)l * D * D, D, D, wt + WT_OUT / 2, pt * 256, kb * 64, pt * 256, pt * 256 + 128, TY_PLAIN); continue; } r -= T_OUT;
        if (r < T_UP) { const int pt = r / 32, kb = r % 32;
            convert_tile(F, F.in[I_WUP] + (size_t)l * D * NUP, NUP, D, wt + WT_UP / 2, pt * 256, kb * 64, pt * 128, DFF + pt * 128, -1); continue; } r -= T_UP;
        { const int pt = r / 86, kb = r % 86;
            convert_tile(F, F.in[I_WDOWN] + (size_t)l * DFF * D, D, DFF, wt + WT_DOWN / 2, pt * 256, kb * 64, pt * 256, pt * 256 + 128, TY_PLAIN); }
    }
}
__device__ __forceinline__ void p1_mod_final(Frame& F) {
    const float* part = WSP(float, WS_MODP); float* mv = WSP(float, WS_MODV);
    for (int i = F.bid * NTHR + F.tid; i < 2 * 3 * 6 * D; i += F.G * NTHR) { const int n = i % (6 * D), l = i / (3 * 6 * D);
        float s = F.in[I_BMOD][l * 6 * D + n];
#pragma unroll
        for (int ks = 0; ks < 16; ++ks) s += part[(size_t)ks * (2 * 3 * 6 * D) + i];
        mv[i] = s; }
}

__device__ __forceinline__ const float* xrow_src(Frame& F, int R, int use_inputs) {
    const int b = R / TT, t = R % TT;
    if (t < T) return (use_inputs ? F.in[I_X] : (const float*)F.out) + ((size_t)b * T + t) * D;
    return (use_inputs ? F.in[I_CTX] : (const float*)WSP(float, WS_XC)) + ((size_t)b * LC + (t - T)) * D;
}
__device__ __forceinline__ void norm_phase(Frame& F, int l, int which  ) {
    const int gw = F.bid * NWAVES + F.wave, NGW = F.G * NWAVES;
    bf16_t* h = WSP(bf16_t, WS_H); const float* mv = WSP(float, WS_MODV);
    const int use_inputs = (l == 0 && which == 0);
    for (int R = gw; R < MR; R += NGW) {
        const int b = R / TT, t = R % TT, v = t < T ? b : 2;
        const float* shift = mv + ((size_t)(l * 3 + v) * 6 + (which ? 3 : 0)) * D; const float* scale = shift + D;
        const f32x4* xr = (const f32x4*)xrow_src(F, R, use_inputs) + F.lane;
        f32x4 x[8]; float ss = 0.f;
#pragma unroll
        for (int j = 0; j < 8; ++j) { x[j] = xr[64 * j]; ss += (x[j].x * x[j].x + x[j].y * x[j].y) + (x[j].z * x[j].z + x[j].w * x[j].w); }
        const float rstd = rsqrtf(wave_sum(ss) * (1.0f / D) + EPS);
        u32x2* o = (u32x2*)(h + (size_t)R * D) + F.lane;
#pragma unroll
        for (int j = 0; j < 8; ++j) { const f32x4 sc = *((const f32x4*)scale + F.lane + 64 * j), sh = *((const f32x4*)shift + F.lane + 64 * j);
            const f32x4 y = x[j] * rstd * (sc + 1.0f) + sh; u32x2 w; w.x = cvtpk(y.x, y.y); w.y = cvtpk(y.z, y.w); o[64 * j] = w; }
    }
}

typedef f32x4 acc_t[2][2][4][2];
__device__ __forceinline__ u32x4 pack8(const f32x4 a, const f32x4 b) { u32x4 w; w.x = cvtpk(a[0], a[1]); w.y = cvtpk(a[2], a[3]); w.z = cvtpk(b[0], b[1]); w.w = cvtpk(b[2], b[3]); return w; }

struct EpiIn {
    static constexpr bool PERM = false, AFTER_DRAIN = false;
    int pt0;
    bf16_t *r2, *r1;
    const float* qkn;
    const f32x2 *ropeA, *ropeB;
    __device__ __forceinline__ void operator()(const acc_t& acc, const pg8::Unit& u, int wr, int wc, int fr, int fq) const {
        const int pt = pt0 + u.pn, b = u.pm / PPB, tb = (u.pm % PPB) * 256 + wr * 64 + fr;
        if (pt < PT_DV) {
            const int isk = pt >= PT_DK, sh = 4 * (pt - (isk ? PT_DK : PT_DQ)) + wc, d0 = 32 * (fq >> 1) + 8 * (fq & 1);
            bf16_t* base = r2 + (isk ? (size_t)MR * 1024 : (size_t)0) + ((size_t)(b * 16 + sh) * TT) * 64 + d0;
            const float* gp = qkn + isk * 64 + d0; const float osc = isk ? 1.0f : LOG2E * 0.125f;
            f32x4 g[2][2];
#pragma unroll
            for (int s = 0; s < 2; ++s)
#pragma unroll
                for (int n = 0; n < 2; ++n) g[s][n] = *(const f32x4*)(gp + 16 * s + 4 * n) * osc;
#pragma unroll
            for (int ai = 0; ai < 2; ++ai)
#pragma unroll
                for (int m = 0; m < 4; ++m) {
                    const int t = tb + ai * 128 + m * 16;
                    f32x4 x[2][2]; float ss = 0.f;
#pragma unroll
                    for (int s = 0; s < 2; ++s)
#pragma unroll
                        for (int n = 0; n < 2; ++n) { x[s][n] = acc[ai][s][m][n]; ss += (x[s][n][0] * x[s][n][0] + x[s][n][1] * x[s][n][1]) + (x[s][n][2] * x[s][n][2] + x[s][n][3] * x[s][n][3]); }
                    ss += __shfl_xor(ss, 16); ss += __shfl_xor(ss, 32);
                    const float rstd = rsqrtf(ss * (1.0f / 64.0f) + EPS);
#pragma unroll
                    for (int s = 0; s < 2; ++s)
#pragma unroll
                        for (int n = 0; n < 2; ++n) x[s][n] = x[s][n] * rstd * g[s][n];
                    if (t < T) {
                        const int pos = (fq < 2) ? (t >> 6) : (t & 63);
                        const f32x4* rp = (const f32x4*)(ropeA + pos * 16 + 8 * (fq & 1));
#pragma unroll
                        for (int n = 0; n < 2; ++n) { const f32x4 c01 = rp[2 * n], c23 = rp[2 * n + 1];
                            const f32x4 cs = {c01[0], c01[2], c23[0], c23[2]}, sn = {c01[1], c01[3], c23[1], c23[3]};
                            const f32x4 u1 = x[0][n], u2 = x[1][n]; x[0][n] = u1 * cs - u2 * sn; x[1][n] = u1 * sn + u2 * cs; }
                    }
                    bf16_t* rowp = base + (size_t)t * 64;
                    *(u32x4*)(rowp) = pack8(x[0][0], x[0][1]); *(u32x4*)(rowp + 16) = pack8(x[1][0], x[1][1]);
                }
        } else if (pt >= PT_RQ && pt < PT_RV) {
            const int isk = pt >= PT_RK, head = 2 * (pt - (isk ? PT_RK : PT_RQ)) + (wc >> 1), d0 = 64 * (wc & 1) + 8 * fq;
            bf16_t* base = r2 + (isk ? (size_t)MR * 512 : (size_t)0) + ((size_t)(b * 4 + head) * TT) * 128 + d0;
            const float osc = isk ? 0.08838834764831845f : 1.0f;
#pragma unroll
            for (int ai = 0; ai < 2; ++ai)
#pragma unroll
                for (int m = 0; m < 4; ++m) {
                    const int t = tb + ai * 128 + m * 16;
                    f32x4 x[2][2];
#pragma unroll
                    for (int s = 0; s < 2; ++s)
#pragma unroll
                        for (int n = 0; n < 2; ++n) x[s][n] = acc[ai][s][m][n] * osc;
                    if (t < T) {
                        const int pos = ((wc & 1) == 0) ? (t >> 6) : (t & 63);
                        const f32x4* rp = (const f32x4*)(ropeB + pos * 32 + 8 * fq);
#pragma unroll
                        for (int n = 0; n < 2; ++n) { const f32x4 c01 = rp[2 * n], c23 = rp[2 * n + 1];
                            const f32x4 cs = {c01[0], c01[2], c23[0], c23[2]}, sn = {c01[1], c01[3], c23[1], c23[3]};
                            const f32x4 u1 = x[0][n], u2 = x[1][n]; x[0][n] = u1 * cs - u2 * sn; x[1][n] = u1 * sn + u2 * cs; }
                    }
                    bf16_t* rowp = base + (size_t)t * 128;
                    *(u32x4*)(rowp) = pack8(x[0][0], x[0][1]); *(u32x4*)(rowp + 32) = pack8(x[1][0], x[1][1]);
                }
        } else {
            int pts, hd; bf16_t* sb;
            if (pt < PT_RQ) { sb = r2 + (size_t)MR * 2048; pts = PT_DV; hd = 128; } else if (pt < PT_GQ) { sb = r2 + (size_t)MR * 1024; pts = PT_RV; hd = 256; }
            else { const int s4 = (pt - PT_GQ) >> 2; sb = r1 + (size_t)s4 * MR * 1024; pts = PT_GQ + 4 * s4; hd = 128; }
            const int c = 256 * (pt - pts) + 64 * wc + 16 * fq, head = c / hd, dim = c % hd, H = 1024 / hd;
            bf16_t* base = sb + ((size_t)(b * H + head) * TT) * hd + dim;
            const bool isq = (pt >= PT_GQ && pt < PT_GF);
#pragma unroll
            for (int ai = 0; ai < 2; ++ai)
#pragma unroll
                for (int m = 0; m < 4; ++m) {
                    const int t = tb + ai * 128 + m * 16; bf16_t* rowp = base + (size_t)t * hd;
#pragma unroll
                    for (int bj = 0; bj < 2; ++bj) { f32x4 a = acc[ai][bj][m][0], c2 = acc[ai][bj][m][1];
                        if (isq) {
#pragma unroll
                            for (int e = 0; e < 4; ++e) { a[e] = siluf_(a[e]) * 0.08838834764831845f; c2[e] = siluf_(c2[e]) * 0.08838834764831845f; } }
                        *(u32x4*)(rowp + 8 * bj) = pack8(a, c2); }
                }
        }
    }
};

struct EpiOutGate {
    static constexpr bool PERM = false, AFTER_DRAIN = false;
    bf16_t *oB, *oC;
    __device__ __forceinline__ void operator()(const acc_t& acc, const pg8::Unit& u, int wr, int wc, int fr, int fq) const {
        bf16_t* o = (u.pn < 4 ? oB : oC) + 256 * (u.pn & 3) + 64 * wc + 16 * fq; const int R0 = u.pm * 256 + wr * 64 + fr;
#pragma unroll
        for (int ai = 0; ai < 2; ++ai)
#pragma unroll
            for (int m = 0; m < 4; ++m) { bf16_t* rowp = o + (size_t)(R0 + ai * 128 + m * 16) * 1024;
#pragma unroll
                for (int bj = 0; bj < 2; ++bj) { const u32x4 w = *(const u32x4*)(rowp + 8 * bj); const f32x4 a = acc[ai][bj][m][0], c = acc[ai][bj][m][1];
                    const f32x4 r0 = {bflo(w.x) * siluf_(a[0]), bfhi(w.x) * siluf_(a[1]), bflo(w.y) * siluf_(a[2]), bfhi(w.y) * siluf_(a[3])};
                    const f32x4 r1 = {bflo(w.z) * siluf_(c[0]), bfhi(w.z) * siluf_(c[1]), bflo(w.w) * siluf_(c[2]), bfhi(w.w) * siluf_(c[3])};
                    *(u32x4*)(rowp + 8 * bj) = pack8(r0, r1); } }
    }
};
struct EpiGate {
    static constexpr bool PERM = false, AFTER_DRAIN = false;
    bf16_t* G; const float* bias;
    __device__ __forceinline__ void operator()(const acc_t& acc, const pg8::Unit& u, int wr, int wc, int fr, int fq) const {
        const int c0 = 256 * u.pn + 64 * wc + 16 * fq, R0 = u.pm * 256 + wr * 64 + fr;
        f32x4 bv[2][2];
#pragma unroll
        for (int bj = 0; bj < 2; ++bj)
#pragma unroll
            for (int n = 0; n < 2; ++n) bv[bj][n] = *(const f32x4*)(bias + c0 + 8 * bj + 4 * n);
#pragma unroll
        for (int ai = 0; ai < 2; ++ai)
#pragma unroll
            for (int m = 0; m < 4; ++m) { bf16_t* rowp = G + (size_t)(R0 + ai * 128 + m * 16) * D + c0;
#pragma unroll
                for (int bj = 0; bj < 2; ++bj) { f32x4 a = acc[ai][bj][m][0] + bv[bj][0], c = acc[ai][bj][m][1] + bv[bj][1];
#pragma unroll
                    for (int e = 0; e < 4; ++e) { a[e] = sigmoidf_(a[e]); c[e] = sigmoidf_(c[e]); }
                    *(u32x4*)(rowp + 8 * bj) = pack8(a, c); } }
    }
};
template <int NB_> struct EpiProj {
    static constexpr bool PERM = false, AFTER_DRAIN = false;
    const bf16_t* G; float* Y; bf16_t* y;
    __device__ __forceinline__ void operator()(const acc_t& acc, const pg8::Unit& u, int wr, int wc, int fr, int fq) const {
        const int c0 = 256 * u.pn + 64 * wc + 16 * fq, R0 = u.pm * 256 + wr * 64 + fr;
#pragma unroll
        for (int ai = 0; ai < 2; ++ai)
#pragma unroll
            for (int m = 0; m < 4; ++m) { const size_t ro = (size_t)(R0 + ai * 128 + m * 16) * D + c0;
#pragma unroll
                for (int bj = 0; bj < 2; ++bj) { const u32x4 w = *(const u32x4*)(G + ro + 8 * bj); const f32x4 a = acc[ai][bj][m][0], c = acc[ai][bj][m][1];
                    f32x4 r0 = {bflo(w.x) * a[0], bfhi(w.x) * a[1], bflo(w.y) * a[2], bfhi(w.y) * a[3]};
                    f32x4 r1 = {bflo(w.z) * c[0], bfhi(w.z) * c[1], bflo(w.w) * c[2], bfhi(w.w) * c[3]};
                    float* yp = Y + ro + 8 * bj;
                    if (NB_ >= 1) { r0 += *(const f32x4*)(yp); r1 += *(const f32x4*)(yp + 4); }
                    if (NB_ <= 1) { *(f32x4*)(yp) = r0; *(f32x4*)(yp + 4) = r1; }
                    else *(u32x4*)(y + ro + 8 * bj) = pack8(r0, r1); } }
    }
};
struct EpiRes {
    static constexpr bool PERM = false, AFTER_DRAIN = false;
    const float *srcx, *srcc; float *dstx, *dstc; const float* gate0;
    __device__ __forceinline__ void operator()(const acc_t& acc, const pg8::Unit& u, int wr, int wc, int fr, int fq) const {
        const int b = u.pm / PPB, lp = u.pm % PPB, c0 = 256 * u.pn + 64 * wc + 16 * fq, r0 = wr * 64 + fr;
        const bool isc = (lp == PPB - 1);
        const size_t rb = isc ? (size_t)(b * LC) : (size_t)(b * T + lp * 256);
        const float* s = (isc ? srcc : srcx) + (rb + r0) * D + c0; float* d = (isc ? dstc : dstx) + (rb + r0) * D + c0;
        const float* gp = gate0 + (size_t)(isc ? 2 : b) * 6 * D + c0;
        f32x4 gv[2][2];
#pragma unroll
        for (int bj = 0; bj < 2; ++bj)
#pragma unroll
            for (int n = 0; n < 2; ++n) gv[bj][n] = *(const f32x4*)(gp + 8 * bj + 4 * n);
#pragma unroll
        for (int ai = 0; ai < 2; ++ai)
#pragma unroll
            for (int m = 0; m < 4; ++m) { const size_t ro = (size_t)(ai * 128 + m * 16) * D;
#pragma unroll
                for (int bj = 0; bj < 2; ++bj)
#pragma unroll
                    for (int n = 0; n < 2; ++n) *(f32x4*)(d + ro + 8 * bj + 4 * n) = *(const f32x4*)(s + ro + 8 * bj + 4 * n) + gv[bj][n] * acc[ai][bj][m][n]; }
    }
};
__device__ __forceinline__ float dpp_up1(float cur, float prev) {
    const int old = __builtin_amdgcn_mov_dpp(__float_as_int(prev), 0x121  , 0xf, 0xf, false);
    return __int_as_float(__builtin_amdgcn_update_dpp(old, __float_as_int(cur), 0x111  , 0xf, 0xf, false));
}
__device__ __forceinline__ float dpp_dn1(float cur, float next) {
    const int old = __builtin_amdgcn_mov_dpp(__float_as_int(next), 0x12F  , 0xf, 0xf, false);
    return __int_as_float(__builtin_amdgcn_update_dpp(old, __float_as_int(cur), 0x101  , 0xf, 0xf, false));
}
struct EpiConv {
    static constexpr bool PERM = false, AFTER_DRAIN = false;
    bf16_t* g; float* raw; const float* cw; const float* cb;
    __device__ __forceinline__ void operator()(const acc_t& acc, const pg8::Unit& u, int wr, int wc, int fr, int fq) const {
        const int jc = 128 * u.pn + 32 * wc + 8 * fq, R0 = u.pm * 256 + wr * 64 + fr;
        u32x2 keep[2][4];
#pragma unroll
        for (int n = 0; n < 2; ++n) {
            const int j = jc + 4 * n;
            const f32x4 wg0 = *(const f32x4*)(cw + j), wg1 = *(const f32x4*)(cw + NUP + j), wg2 = *(const f32x4*)(cw + 2 * NUP + j), bg = *(const f32x4*)(cb + j);
            const f32x4 wu0 = *(const f32x4*)(cw + DFF + j), wu1 = *(const f32x4*)(cw + NUP + DFF + j), wu2 = *(const f32x4*)(cw + 2 * NUP + DFF + j), bu = *(const f32x4*)(cb + DFF + j);
#pragma unroll
            for (int ai = 0; ai < 2; ++ai)
#pragma unroll
                for (int m = 0; m < 4; ++m) {
                    const f32x4 xg = acc[ai][0][m][n], xu = acc[ai][1][m][n];
                    const f32x4 pg = acc[ai][0][m > 0 ? m - 1 : 0][n], ng = acc[ai][0][m < 3 ? m + 1 : 3][n], pu = acc[ai][1][m > 0 ? m - 1 : 0][n], nu = acc[ai][1][m < 3 ? m + 1 : 3][n];
                    f32x4 yg, yu;
#pragma unroll
                    for (int e = 0; e < 4; ++e) {
                        yg[e] = wg0[e] * dpp_up1(xg[e], pg[e]) + wg1[e] * xg[e] + wg2[e] * dpp_dn1(xg[e], ng[e]) + bg[e];
                        yu[e] = wu0[e] * dpp_up1(xu[e], pu[e]) + wu1[e] * xu[e] + wu2[e] * dpp_dn1(xu[e], nu[e]) + bu[e];
                    }
                    f32x4 r;
#pragma unroll
                    for (int e = 0; e < 4; ++e) r[e] = siluf_(yg[e]) * yu[e];
                    u32x2 pk; pk.x = cvtpk(r[0], r[1]); pk.y = cvtpk(r[2], r[3]);
                    if (n == 0) keep[ai][m] = pk;
                    else { u32x4 w; w.x = keep[ai][m].x; w.y = keep[ai][m].y; w.z = pk.x; w.w = pk.y; *(u32x4*)(g + (size_t)(R0 + ai * 128 + m * 16) * DFF + jc) = w; }
                    if ((m == 0 && fr < 2) || (m == 3 && fr >= 14)) {
                        const int slot = (m == 0) ? fr : fr - 12; float* rp = raw + ((size_t)(u.pm * 4 + ai * 2 + wr) * 4 + slot) * NUP + j;
                        *(f32x4*)(rp) = xg; *(f32x4*)(rp + DFF) = xu;
                    }
                }
        }
    }
};

namespace att {
constexpr int KVBLK = 64;
constexpr int SHM_V = 64 * 128 * 2, SHM_K = 64 * 64 * 2;
#define KSWZ64(row, colB) ((row) * 128 + ((colB) ^ ((((row) >> 1) & 7) << 4)))
#define SBAR() __builtin_amdgcn_sched_barrier(0)
__device__ __forceinline__ int crow(int r, int hi) { return (r & 3) + 8 * (r >> 2) + 4 * hi; }
__device__ __forceinline__ void exp16(f32x16& p) {
#pragma unroll
    for (int r = 0; r < 16; ++r) p[r] = __builtin_amdgcn_exp2f(p[r]);
}
__device__ __forceinline__ void finishSM(f32x16& p0, f32x16& p1, float& lsum, bf16x8& pa0, bf16x8& pa1, bf16x8& pa2, bf16x8& pa3) {
    exp16(p1);
    float ps = 0;
#pragma unroll
    for (int r = 0; r < 16; ++r) ps += p0[r];
#pragma unroll
    for (int r = 0; r < 16; ++r) ps += p1[r];
    lsum += ps;
#define PK4(P, BASE, OUT) do { unsigned a0 = cvtpk(P[BASE + 0], P[BASE + 1]), a1 = cvtpk(P[BASE + 2], P[BASE + 3]);   \
    unsigned b0 = cvtpk(P[BASE + 4], P[BASE + 5]), b1 = cvtpk(P[BASE + 6], P[BASE + 7]);                              \
    auto r0 = __builtin_amdgcn_permlane32_swap(a0, b0, false, false); auto r1 = __builtin_amdgcn_permlane32_swap(a1, b1, false, false); \
    u32x4 w = {r0[0], r1[0], r0[1], r1[1]}; OUT = *reinterpret_cast<bf16x8*>(&w); } while (0)
    PK4(p0, 0, pa0); PK4(p0, 8, pa1); PK4(p1, 0, pa2); PK4(p1, 8, pa3);
#undef PK4
}
__device__ __forceinline__ void qkt(f32x16& p0, f32x16& p1, const LAS char* Ks, const bf16x8* qr, int r32, int hi, float negM) {
#pragma unroll
    for (int r = 0; r < 16; ++r) { p0[r] = negM; p1[r] = negM; }
#pragma unroll
    for (int d0 = 0; d0 < 4; ++d0) { const int cb = (d0 * 16 + hi * 8) * 2;
        const bf16x8 b0 = *(const LAS bf16x8*)(Ks + KSWZ64(r32, cb));
        const bf16x8 b1 = *(const LAS bf16x8*)(Ks + KSWZ64(32 + r32, cb));
        p0 = __builtin_amdgcn_mfma_f32_32x32x16_bf16(b0, qr[d0], p0, 0, 0, 0);
        p1 = __builtin_amdgcn_mfma_f32_32x32x16_bf16(b1, qr[d0], p1, 0, 0, 0); }
}
__device__ __forceinline__ int v_st(int k, int c) { const int kk = (k & ~0xC) | ((k & 4) << 1) | ((k & 8) >> 1); return ((kk >> 3) * 4 + (c >> 5)) * 512 + ((kk & 7) * 32 + (c & 31)) * 2; }
__device__ __forceinline__ int v_rd_base(int lane) { return ((lane & 3) << 3) | (((lane >> 2) & 3) << 6) | (((lane >> 4) & 1) << 5) | (((lane >> 5) & 1) << 8); }
constexpr int v_rd_off(int d0, int ks, int half) { return d0 * 512 + ks * 4096 + half * 2048; }
template <int OFF> __device__ __forceinline__ s16x4 tr_read(int vb) {
  s16x4 r; asm volatile("ds_read_b64_tr_b16 %0, %1 offset:%2" : "=&v"(r) : "v"(vb), "i"(OFF) : "memory"); return r;
}
template <int D0> __device__ __forceinline__ void pv_one(f32x16& od, int vb, bf16x8 pa0, bf16x8 pa1, bf16x8 pa2, bf16x8 pa3) {
  const s16x4 l0 = tr_read<v_rd_off(D0, 0, 0)>(vb), h0 = tr_read<v_rd_off(D0, 0, 1)>(vb), l1 = tr_read<v_rd_off(D0, 1, 0)>(vb), h1 = tr_read<v_rd_off(D0, 1, 1)>(vb);
  const s16x4 l2 = tr_read<v_rd_off(D0, 2, 0)>(vb), h2 = tr_read<v_rd_off(D0, 2, 1)>(vb), l3 = tr_read<v_rd_off(D0, 3, 0)>(vb), h3 = tr_read<v_rd_off(D0, 3, 1)>(vb);
  asm volatile("s_waitcnt lgkmcnt(0)" ::: "memory"); SBAR();
#define PK(L, H) (bf16x8){L[0], L[1], L[2], L[3], H[0], H[1], H[2], H[3]}
  od = __builtin_amdgcn_mfma_f32_32x32x16_bf16(pa0, PK(l0, h0), od, 0, 0, 0);
  od = __builtin_amdgcn_mfma_f32_32x32x16_bf16(pa1, PK(l1, h1), od, 0, 0, 0);
  od = __builtin_amdgcn_mfma_f32_32x32x16_bf16(pa2, PK(l2, h2), od, 0, 0, 0);
  od = __builtin_amdgcn_mfma_f32_32x32x16_bf16(pa3, PK(l3, h3), od, 0, 0, 0);
#undef PK
}
__device__ __forceinline__ void pv_d0(f32x16* o, int vb, bf16x8 pa0, bf16x8 pa1, bf16x8 pa2, bf16x8 pa3) {
  pv_one<0>(o[0], vb, pa0, pa1, pa2, pa3); pv_one<1>(o[1], vb, pa0, pa1, pa2, pa3); pv_one<2>(o[2], vb, pa0, pa1, pa2, pa3); pv_one<3>(o[3], vb, pa0, pa1, pa2, pa3);
}
__device__ __forceinline__ void attn_unit(const bf16_t* __restrict__ Qb, const bf16_t* __restrict__ Kh, const bf16_t* __restrict__ Vh, float* __restrict__ Ob, int nkeys, float negM, LAS char* lds) {
  const int tid = threadIdx.x, wid = tid >> 6, lane = tid & 63, r32 = lane & 31, hi = lane >> 5;
  LAS char* V_lds = lds; LAS char* K_lds = lds + 2 * SHM_V;
  LAS float* li_l = (LAS float*)(lds + 2 * SHM_V + 2 * SHM_K) + wid * 64;
  float lsum = 0; f32x16 o[4];
#pragma unroll
  for (int d = 0; d < 4; ++d)
#pragma unroll
    for (int r = 0; r < 16; ++r) o[d][r] = 0.f;
  bf16x8 qr[4];
  const bf16_t* Qw = Qb + (long)(wid * 32 + r32) * 64 + hi * 8;
#pragma unroll
  for (int d0 = 0; d0 < 4; ++d0) qr[d0] = *reinterpret_cast<const bf16x8*>(Qw + d0 * 16);
  const int kr = tid >> 3, kc = (tid & 7) * 8, kst = KSWZ64(kr, kc * 2);
  const int sr = tid >> 4, sc = (tid & 15) * 8, vst0 = v_st(sr, sc), vst1 = v_st(32 + sr, sc);
  const int vb0 = (int)(uintptr_t)V_lds + v_rd_base(lane);
  bf16x8 sk[1], sv0[1], sv1[1];
#define SLOAD(i, k0) do { sv0[i] = *reinterpret_cast<const bf16x8*>(&Vh[(long)((k0) + sr) * 128 + sc]); sv1[i] = *reinterpret_cast<const bf16x8*>(&Vh[(long)((k0) + 32 + sr) * 128 + sc]); \
    sk[i] = *reinterpret_cast<const bf16x8*>(&Kh[(long)((k0) + kr) * 64 + kc]); } while (0)
#define SWRITE(b, i) do { *(LAS bf16x8*)(V_lds + (b) * SHM_V + vst0) = sv0[i]; *(LAS bf16x8*)(V_lds + (b) * SHM_V + vst1) = sv1[i]; *(LAS bf16x8*)(K_lds + (b) * SHM_K + kst) = sk[i]; } while (0)
#define SWAIT() asm volatile("s_waitcnt vmcnt(0)" ::: "memory")
  f32x16 pA0, pA1, pB0, pB1; bf16x8 pa0, pa1, pa2, pa3; const int NT = nkeys / KVBLK;
  SLOAD(0, 0); asm volatile("s_waitcnt vmcnt(0)" ::: "memory"); SWRITE(0, 0); __syncthreads();
  qkt(pA0, pA1, K_lds, qr, r32, hi, negM); exp16(pA0);
  SLOAD(0, KVBLK);
  SWAIT(); SWRITE(1, 0); __syncthreads();
  for (int j = 1; j + 1 < NT; j += 2) {
    SBAR(); qkt(pB0, pB1, K_lds + SHM_K, qr, r32, hi, negM);
    finishSM(pA0, pA1, lsum, pa0, pa1, pa2, pa3); SBAR();
    SLOAD(0, (j + 1) * KVBLK); SBAR();
    pv_d0(o, vb0, pa0, pa1, pa2, pa3); exp16(pB0);
    __syncthreads(); SWAIT(); SWRITE(0, 0);
    __syncthreads();
    SBAR(); qkt(pA0, pA1, K_lds, qr, r32, hi, negM);
    finishSM(pB0, pB1, lsum, pa0, pa1, pa2, pa3); SBAR();
    SLOAD(0, (j + 2) * KVBLK); SBAR();
    pv_d0(o, vb0 + SHM_V, pa0, pa1, pa2, pa3); exp16(pA0);
    __syncthreads(); SWAIT(); SWRITE(1, 0);
    __syncthreads();
  }
  SBAR(); qkt(pB0, pB1, K_lds + SHM_K, qr, r32, hi, negM);
  finishSM(pA0, pA1, lsum, pa0, pa1, pa2, pa3); SBAR();
  pv_d0(o, vb0, pa0, pa1, pa2, pa3); exp16(pB0);
  finishSM(pB0, pB1, lsum, pa0, pa1, pa2, pa3); SBAR();
  pv_d0(o, vb0 + SHM_V, pa0, pa1, pa2, pa3);
  { auto rr = __builtin_amdgcn_permlane32_swap(__float_as_uint(lsum), __float_as_uint(lsum), false, false); lsum = __uint_as_float(rr[0]) + __uint_as_float(rr[1]); }
  if (hi == 0) li_l[r32] = lsum; asm volatile("s_waitcnt lgkmcnt(0)" ::: "memory");
  float rli[16];
#pragma unroll
  for (int r = 0; r < 16; ++r) rli[r] = __builtin_amdgcn_rcpf(li_l[crow(r, hi)]);
  float* Ow = Ob + (long)(wid * 32) * D;
#pragma unroll
  for (int r = 0; r < 16; ++r) { const int orow = crow(r, hi);
#pragma unroll
    for (int d0 = 0; d0 < 4; ++d0) Ow[(long)orow * D + d0 * 32 + r32] = o[d0][r] * rli[r]; }
  __syncthreads();
#undef SLOAD
#undef SWRITE
#undef SWAIT
}
}

__device__ __forceinline__ void attn_phase(Frame& F, int l) {
    const bf16_t* Q = WSP(bf16_t, DY_R2); const bf16_t* K = Q + (size_t)MR * 1024; const bf16_t* V = K + (size_t)MR * 1024;
    float* O = WSP(float, DY_R1); const float negM = WSP(float, WS_SCAL)[2 + l];
    const int NU = NB * 16 * 64 + NB * 16;
    for (int u = F.bid; u < NU; u += F.G) {
        int b, sh, q0, k0, nk;
        if (u < NB * 16 * 64) { b = u / (16 * 64); sh = (u / 64) % 16; q0 = (u % 64) * 256; k0 = 0; nk = TT; }
        else { const int v = u - NB * 16 * 64; b = v / 16; sh = v % 16; q0 = T; k0 = T; nk = LC; }
        const size_t hb = (size_t)(b * 16 + sh) * TT;
        att::attn_unit(Q + (hb + q0) * 64, K + (hb + k0) * 64, V + ((size_t)(b * 8 + (sh >> 1)) * TT + k0) * 128, O + ((size_t)b * TT + q0) * D + sh * 128, nk, negM, (LAS char*)F.lds);
    }
}
__device__ __forceinline__ void combine_phase(Frame& F, int l) {
    const int gw = F.bid * NWAVES + F.wave, NGW = F.G * NWAVES;
    const float* O = WSP(float, DY_R1); bf16_t* oA = WSP(bf16_t, DY_OA);
    const float lam = WSP(float, WS_SCAL)[l]; const float post = 1.0f - (0.8f - 0.6f * expf(-0.3f * (float)l));
    const f32x2 sl = *((const f32x2*)(F.in[I_SUBLN] + l * 128) + F.lane);
    for (int R = gw; R < MR; R += NGW) {
        const f32x2* orow = (const f32x2*)(O + (size_t)R * D) + F.lane; unsigned* dst = (unsigned*)(oA + (size_t)R * 1024) + F.lane;
#pragma unroll
        for (int h = 0; h < 8; ++h) { const f32x2 a = orow[(2 * h) * 64], c = orow[(2 * h + 1) * 64]; const f32x2 d = a - c * lam;
            const float ss = wave_sum(d.x * d.x + d.y * d.y); const float rs = rsqrtf(ss * (1.0f / 128.0f) + EPS) * post;
            dst[h * 64] = cvtpk(d.x * rs * sl.x, d.y * rs * sl.y); }
    }
}

__device__ __forceinline__ int tok_of(int p, int dir) { return dir == 0 ? (p < LC ? T + p : p - LC) : (p < LC ? T + (LC - 1 - p) : T - 1 - (p - LC)); }
constexpr int RET_NSEG = 16, RET_L = TT / RET_NSEG  , HG_NSEG = 8, HG_L = TT / HG_NSEG  , SC_TB = 16;
template <int PASS> __device__ __forceinline__ void ret_scan(Frame& F) {
    const bf16_t* RQ = WSP(bf16_t, DY_R2); const bf16_t* RK = RQ + (size_t)MR * 512; const bf16_t* RV = RK + (size_t)MR * 512;
    float* Send = WSP(float, DY_R1);
    float* oacc = WSP(float, DY_OACC);
    LAS float* qs = (LAS float*)F.lds; LAS float* ks = qs + SC_TB * 128; LAS float* vs = ks + SC_TB * 128;
    const int half = F.lane >> 5, dv = 32 * F.wave + (F.lane & 31);
    for (int u = F.bid; u < 16 * RET_NSEG; u += F.G) {
        const int seq = u / RET_NSEG, seg = u % RET_NSEG, dir = seq & 1, h = (seq >> 1) & 3, b = seq >> 3;
        const int hh = dir ? 3 - h : h; const float lg = log1pf(-exp2f(-5.0f - (float)hh)), gamma = expf(lg), gammaL = expf(lg * (float)RET_L);
        const size_t hb = (size_t)(b * 4 + h) * TT;
        float S[64];
#pragma unroll
        for (int i = 0; i < 64; ++i) S[i] = 0.f;
        if (PASS == 2) { for (int s2 = 0; s2 < seg; ++s2) { const float* sp = Send + ((size_t)(seq * RET_NSEG + s2) * 128 + 64 * half) * 256 + dv;
#pragma unroll
                for (int i = 0; i < 64; ++i) S[i] = gammaL * S[i] + sp[(size_t)i * 256]; } }
        for (int blk = 0; blk < RET_L / SC_TB; ++blk) {
            const int p0 = seg * RET_L + blk * SC_TB;
            {
                const int tk = (F.tid & 255) >> 4, ch = F.tid & 15; const int t = tok_of(p0 + tk, dir);
                if (F.tid < 256) { const u32x4 w = *(const u32x4*)(RK + (hb + t) * 128 + ch * 8); LAS float* d = ks + tk * 128 + ch * 8;
                    d[0] = bflo(w.x); d[1] = bfhi(w.x); d[2] = bflo(w.y); d[3] = bfhi(w.y); d[4] = bflo(w.z); d[5] = bfhi(w.z); d[6] = bflo(w.w); d[7] = bfhi(w.w); }
                else if (PASS == 2) { const u32x4 w = *(const u32x4*)(RQ + (hb + t) * 128 + ch * 8); LAS float* d = qs + tk * 128 + ch * 8;
                    d[0] = bflo(w.x); d[1] = bfhi(w.x); d[2] = bflo(w.y); d[3] = bfhi(w.y); d[4] = bflo(w.z); d[5] = bfhi(w.z); d[6] = bflo(w.w); d[7] = bfhi(w.w); }
                const int tk2 = F.tid >> 5, ch2 = F.tid & 31; const int t2 = tok_of(p0 + tk2, dir);
                const u32x4 w = *(const u32x4*)(RV + (hb + t2) * 256 + ch2 * 8); LAS float* d = vs + tk2 * 256 + ch2 * 8;
                d[0] = bflo(w.x); d[1] = bfhi(w.x); d[2] = bflo(w.y); d[3] = bfhi(w.y); d[4] = bflo(w.z); d[5] = bfhi(w.z); d[6] = bflo(w.w); d[7] = bfhi(w.w);
            }
            __syncthreads();
            for (int tk = 0; tk < SC_TB; ++tk) {
                const float vv = vs[tk * 256 + dv]; float acc = 0.f;
                const LAS f32x4* k4 = (const LAS f32x4*)(ks + tk * 128 + 64 * half); const LAS f32x4* q4 = (const LAS f32x4*)(qs + tk * 128 + 64 * half);
#pragma unroll
                for (int i4 = 0; i4 < 16; ++i4) { const f32x4 kk = k4[i4];
                    if (PASS == 2) { const f32x4 qq = q4[i4];
#pragma unroll
                        for (int j = 0; j < 4; ++j) { S[4 * i4 + j] = gamma * S[4 * i4 + j] + kk[j] * vv; acc += qq[j] * S[4 * i4 + j]; } }
                    else {
#pragma unroll
                        for (int j = 0; j < 4; ++j) S[4 * i4 + j] = gamma * S[4 * i4 + j] + kk[j] * vv; } }
                if (PASS == 2) { acc += __shfl_xor(acc, 32); const int t = tok_of(p0 + tk, dir);
                    if (half == 0) __hip_atomic_fetch_add(oacc + ((size_t)b * TT + t) * 1024 + h * 256 + dv, acc, __ATOMIC_RELAXED, __HIP_MEMORY_SCOPE_AGENT); }
            }
            __syncthreads();
        }
        if (PASS == 1) { float* sp = Send + ((size_t)(seq * RET_NSEG + seg) * 128 + 64 * half) * 256 + dv;
#pragma unroll
            for (int i = 0; i < 64; ++i) sp[(size_t)i * 256] = S[i]; }
    }
}
template <int PASS> __device__ __forceinline__ void hg_scan(Frame& F, int l) {
    const bf16_t* GQ = WSP(bf16_t, DY_R1); const bf16_t* GFp = GQ + (size_t)MR * 1024; const bf16_t* GBp = GFp + (size_t)MR * 1024; const bf16_t* GI = GBp + (size_t)MR * 1024;
    float* Send = WSP(float, DY_R2);
    float* Aend = Send + (size_t)32 * HG_NSEG * 128 * 128;
    float* oacc = WSP(float, DY_OACC);
    const float* lbv = WSP(float, WS_LB) + l * 2048;
    LAS float* qs = (LAS float*)F.lds; LAS float* as = qs + SC_TB * 128; LAS float* ks = as + SC_TB * 128; LAS float* vs = ks + SC_TB * 128;
    const int q2 = F.lane >> 4, dv = 16 * F.wave + (F.lane & 15);
    for (int u = F.bid; u < 32 * HG_NSEG; u += F.G) {
        const int seq = u / HG_NSEG, seg = u % HG_NSEG, dir = seq & 1, h = (seq >> 1) & 7, b = seq >> 4;
        const size_t hb = (size_t)(b * 8 + h) * TT; const bf16_t* Z = dir ? GBp : GFp; const float* lb = lbv + dir * 1024 + h * 128;
        float S[32], Ap[32];
#pragma unroll
        for (int i = 0; i < 32; ++i) { S[i] = 0.f; Ap[i] = 1.f; }
        if (PASS == 2) { for (int s2 = 0; s2 < seg; ++s2) { const float* sp = Send + ((size_t)(seq * HG_NSEG + s2) * 128 + 32 * q2) * 128 + dv; const float* ap = Aend + (size_t)(seq * HG_NSEG + s2) * 128 + 32 * q2;
#pragma unroll
                for (int i = 0; i < 32; ++i) S[i] = ap[i] * S[i] + sp[(size_t)i * 128]; } }
        for (int blk = 0; blk < HG_L / SC_TB; ++blk) {
            const int p0 = seg * HG_L + blk * SC_TB;
            {
                const int tk = F.tid >> 5, c4 = (F.tid & 31) * 4; const int t = tok_of(p0 + tk, dir); const size_t ro = (hb + t) * 128 + c4;
                const u32x2 wz = *(const u32x2*)(Z + ro), wv = *(const u32x2*)(GI + ro); const f32x4 lbb = *(const f32x4*)(lb + c4);
                const float z[4] = {bflo(wz.x), bfhi(wz.x), bflo(wz.y), bfhi(wz.y)};
                f32x4 a, kk;
#pragma unroll
                for (int j = 0; j < 4; ++j) { const float sg = sigmoidf_(z[j]); a[j] = fmaxf(lbb[j] + (1.0f - lbb[j]) * sg, 1e-20f); kk[j] = (1.0f - lbb[j]) * (1.0f - sg); }
                *(LAS f32x4*)(as + tk * 128 + c4) = a; *(LAS f32x4*)(ks + tk * 128 + c4) = kk;
                *(LAS f32x4*)(vs + tk * 128 + c4) = (f32x4){bflo(wv.x), bfhi(wv.x), bflo(wv.y), bfhi(wv.y)};
                if (PASS == 2) { const u32x2 wq = *(const u32x2*)(GQ + ro); *(LAS f32x4*)(qs + tk * 128 + c4) = (f32x4){bflo(wq.x), bfhi(wq.x), bflo(wq.y), bfhi(wq.y)}; }
            }
            __syncthreads();
            for (int tk = 0; tk < SC_TB; ++tk) {
                const float vv = vs[tk * 128 + dv]; float acc = 0.f;
                const LAS f32x4* a4 = (const LAS f32x4*)(as + tk * 128 + 32 * q2); const LAS f32x4* k4 = (const LAS f32x4*)(ks + tk * 128 + 32 * q2); const LAS f32x4* q4 = (const LAS f32x4*)(qs + tk * 128 + 32 * q2);
#pragma unroll
                for (int i4 = 0; i4 < 8; ++i4) { const f32x4 aa = a4[i4], kk = k4[i4];
                    if (PASS == 2) { const f32x4 qq = q4[i4];
#pragma unroll
                        for (int j = 0; j < 4; ++j) { S[4 * i4 + j] = aa[j] * S[4 * i4 + j] + kk[j] * vv; acc += qq[j] * S[4 * i4 + j]; } }
                    else {
#pragma unroll
                        for (int j = 0; j < 4; ++j) { S[4 * i4 + j] = aa[j] * S[4 * i4 + j] + kk[j] * vv; Ap[4 * i4 + j] *= aa[j]; } } }
                if (PASS == 2) { acc += __shfl_xor(acc, 16); acc += __shfl_xor(acc, 32); const int t = tok_of(p0 + tk, dir);
                    if (q2 == 0) __hip_atomic_fetch_add(oacc + ((size_t)b * TT + t) * 1024 + h * 128 + dv, acc, __ATOMIC_RELAXED, __HIP_MEMORY_SCOPE_AGENT); }
            }
            __syncthreads();
        }
        if (PASS == 1) { float* sp = Send + ((size_t)(seq * HG_NSEG + seg) * 128 + 32 * q2) * 128 + dv;
#pragma unroll
            for (int i = 0; i < 32; ++i) sp[(size_t)i * 128] = S[i];
            if (F.wave == 0 && (F.lane & 15) == 0) { float* ap = Aend + (size_t)(seq * HG_NSEG + seg) * 128 + 32 * q2;
#pragma unroll
                for (int i = 0; i < 32; ++i) ap[i] = Ap[i]; } }
    }
}
__device__ __forceinline__ void zero_oacc(Frame& F) {
    f32x4* p = WSP(f32x4, DY_OACC); const size_t n = (size_t)MR * 1024 / 4;
    for (size_t i = (size_t)F.bid * NTHR + F.tid; i < n; i += (size_t)F.G * NTHR) p[i] = (f32x4){0.f, 0.f, 0.f, 0.f};
}
template <int HD> __device__ __forceinline__ void postnorm_phase(Frame& F, const float* w, bf16_t* o) {
    const int gw = F.bid * NWAVES + F.wave, NGW = F.G * NWAVES; const float* oacc = WSP(float, DY_OACC);
    constexpr int PER = HD / 64;
    for (int R = gw; R < MR; R += NGW) {
#pragma unroll
        for (int h = 0; h < 1024 / HD; ++h) {
            float x[PER]; float ss = 0.f;
#pragma unroll
            for (int j = 0; j < PER; ++j) { x[j] = oacc[(size_t)R * 1024 + h * HD + F.lane * PER + j]; ss += x[j] * x[j]; }
            const float rs = rsqrtf(wave_sum(ss) * (1.0f / HD) + EPS);
#pragma unroll
            for (int j = 0; j < PER; j += 2) *(unsigned*)(o + (size_t)R * 1024 + h * HD + F.lane * PER + j) = cvtpk(x[j] * rs * w[F.lane * PER + j], x[j + 1] * rs * w[F.lane * PER + j + 1]);
        }
    }
}
__device__ __forceinline__ void ffn_fixup(Frame& F, int l) {
    const float* raw = WSP(float, DY_RAW); bf16_t* g = WSP(bf16_t, DY_G);
    const float* cw = F.in[I_CONVW] + (size_t)l * 3 * NUP; const float* cb = F.in[I_CONVB] + (size_t)l * NUP;
    const int NBLK = MR / 64, per = DFF / 4;
    const size_t total = (size_t)NBLK * 2 * per;
    for (size_t it = (size_t)F.bid * NTHR + F.tid; it < total; it += (size_t)F.G * NTHR) {
        const int cq = (int)(it % per), rb = (int)(it / per), blk = rb >> 1, last = rb & 1, j = cq * 4;
        const int bl = blk % (TT / 64);
        const bool seq_first = (bl == 0 || bl == T / 64), seq_last = (bl == T / 64 - 1 || bl == TT / 64 - 1);
        const float* rc = raw + ((size_t)blk * 4 + (last ? 3 : 0)) * NUP;
        const float* rp = last ? raw + ((size_t)blk * 4 + 2) * NUP : raw + ((size_t)(blk - 1) * 4 + 3) * NUP;
        const float* rn = last ? raw + ((size_t)(blk + 1) * 4 + 0) * NUP : raw + ((size_t)blk * 4 + 1) * NUP;
        const bool zp = (!last && seq_first), zn = (last && seq_last);
        const f32x4 z4 = {0.f, 0.f, 0.f, 0.f};
        const f32x4 pg = zp ? z4 : *(const f32x4*)(rp + j), pu = zp ? z4 : *(const f32x4*)(rp + DFF + j);
        const f32x4 ng = zn ? z4 : *(const f32x4*)(rn + j), nu = zn ? z4 : *(const f32x4*)(rn + DFF + j);
        const f32x4 xg = *(const f32x4*)(rc + j), xu = *(const f32x4*)(rc + DFF + j);
        const f32x4 yg = *(const f32x4*)(cw + j) * pg + *(const f32x4*)(cw + NUP + j) * xg + *(const f32x4*)(cw + 2 * NUP + j) * ng + *(const f32x4*)(cb + j);
        const f32x4 yu = *(const f32x4*)(cw + DFF + j) * pu + *(const f32x4*)(cw + NUP + DFF + j) * xu + *(const f32x4*)(cw + 2 * NUP + DFF + j) * nu + *(const f32x4*)(cb + DFF + j);
        u32x2 w; w.x = cvtpk(siluf_(yg[0]) * yu[0], siluf_(yg[1]) * yu[1]); w.y = cvtpk(siluf_(yg[2]) * yu[2], siluf_(yg[3]) * yu[3]);
        *(u32x2*)(g + (size_t)(blk * 64 + (last ? 63 : 0)) * DFF + j) = w;
    }
}

enum { PH_PRO = 0, PH_MODFIN, PH_N1, PH_GA, PH_ATT, PH_GB, PH_R1, PH_R2, PH_GC, PH_H1, PH_H2, PH_HN, PH_OG, PH_MG, PH_WO, PH_N2, PH_UP, PH_FIX, PH_DN, PH_COUNT };

template <class Epi> __device__ __forceinline__ void run_gemm(Frame& F, const bf16_t* A, const bf16_t* Bt, int N, int K, const Epi& E) {
    pg8::Gemm g{A, Bt, MR, N, K}; pg8::StaticOrder S; S.init(MR, N, F.G, F.bid);
    pg8::gemm_phase<Epi, pg8::StaticOrder, false>(F.lds, g, S, E, nullptr);
}
__device__ __forceinline__ EpiIn make_epi_in(Frame& F, int l, int pt0) {
    EpiIn E; E.pt0 = pt0;
    E.r2 = WSP(bf16_t, DY_R2); E.r1 = WSP(bf16_t, DY_R1);
    E.qkn = F.in[I_QKN] + l * 128; E.ropeA = WSP(f32x2, WS_ROPEA); E.ropeB = WSP(f32x2, WS_ROPEB);
    return E;
}
__device__ __forceinline__ EpiRes make_epi_res(Frame& F, int l, int use_inputs, int gidx) {
    EpiRes E; E.srcx = use_inputs ? F.in[I_X] : F.out; E.srcc = use_inputs ? F.in[I_CTX] : WSP(float, WS_XC); E.dstx = F.out; E.dstc = WSP(float, WS_XC);
    E.gate0 = WSP(float, WS_MODV) + ((size_t)(l * 3) * 6 + gidx) * D; return E;
}

template <int PH> __device__ __forceinline__ void run_phase(Frame& F, int l) {
    const bf16_t* h = WSP(bf16_t, WS_H); const bf16_t* wt = WSP(bf16_t, WS_WT);
    const bf16_t* wt_in = wt + WT_IN / 2;
    if constexpr (PH == PH_PRO) { p0_mod_partial(F); p0_tables(F); convert_weights(F, 0); }
    if constexpr (PH == PH_MODFIN) { p1_mod_final(F); }
    if constexpr (PH == PH_N1) { if (l == 1) convert_weights(F, 1); norm_phase(F, l, 0); }
    if constexpr (PH == PH_GA) { const EpiIn E = make_epi_in(F, l, PT_DQ); run_gemm(F, h, wt_in, 3072, D, E); }
    if constexpr (PH == PH_ATT) { attn_phase(F, l); }
    if constexpr (PH == PH_GB) { const EpiIn E = make_epi_in(F, l, PT_RQ); run_gemm(F, h, wt_in + (size_t)PT_RQ * 256 * D, 2048, D, E); combine_phase(F, l); zero_oacc(F); }
    if constexpr (PH == PH_R1) { ret_scan<1>(F); }
    if constexpr (PH == PH_R2) { ret_scan<2>(F); }
    if constexpr (PH == PH_GC) { postnorm_phase<256>(F, F.in[I_RNORM] + l * 256, WSP(bf16_t, DY_OB)); const EpiIn E = make_epi_in(F, l, PT_GQ); run_gemm(F, h, wt_in + (size_t)PT_GQ * 256 * D, 4096, D, E); }
    if constexpr (PH == PH_H1) { zero_oacc(F); hg_scan<1>(F, l); }
    if constexpr (PH == PH_H2) { hg_scan<2>(F, l); }
    if constexpr (PH == PH_HN) { postnorm_phase<128>(F, F.in[I_GNORM] + l * 128, WSP(bf16_t, DY_OC)); }
    if constexpr (PH == PH_OG) { EpiOutGate E; E.oB = WSP(bf16_t, DY_OB); E.oC = WSP(bf16_t, DY_OC); run_gemm(F, h, wt_in + (size_t)PT_RG * 256 * D, 2048, D, E); }
    if constexpr (PH == PH_MG) {
        bf16_t* G = WSP(bf16_t, DY_R2); float* Y = WSP(float, DY_R1); bf16_t* y = WSP(bf16_t, DY_OACC);
        const float* bg = F.in[I_BGATE] + (size_t)l * 3 * D; const bf16_t* wbr = wt + WT_BR / 2;
        { EpiGate E{G, bg}; run_gemm(F, h, wt_in + (size_t)PT_MA * 256 * D, 2048, D, E); }
        { EpiProj<0> E{G, Y, y}; run_gemm(F, WSP(bf16_t, DY_OA), wbr, 2048, 1024, E); }
        { EpiGate E{G, bg + D}; run_gemm(F, h, wt_in + (size_t)PT_MB * 256 * D, 2048, D, E); }
        { EpiProj<1> E{G, Y, y}; run_gemm(F, WSP(bf16_t, DY_OB), wbr + (size_t)D * 1024, 2048, 1024, E); }
        { EpiGate E{G, bg + 2 * D}; run_gemm(F, h, wt_in + (size_t)PT_MC * 256 * D, 2048, D, E); }
        { EpiProj<2> E{G, Y, y}; run_gemm(F, WSP(bf16_t, DY_OC), wbr + (size_t)2 * D * 1024, 2048, 1024, E); }
    }
    if constexpr (PH == PH_WO) { const EpiRes E = make_epi_res(F, l, l == 0, 2); run_gemm(F, WSP(bf16_t, DY_OACC), wt + WT_OUT / 2, 2048, D, E); }
    if constexpr (PH == PH_N2) { norm_phase(F, l, 1); }
    if constexpr (PH == PH_UP) { EpiConv E; E.g = WSP(bf16_t, DY_G); E.raw = WSP(float, DY_RAW); E.cw = F.in[I_CONVW] + (size_t)l * 3 * NUP; E.cb = F.in[I_CONVB] + (size_t)l * NUP;
        run_gemm(F, h, wt + WT_UP / 2, NUP, D, E); }
    if constexpr (PH == PH_FIX) { ffn_fixup(F, l); }
    if constexpr (PH == PH_DN) { const EpiRes E = make_epi_res(F, l, 0, 5); run_gemm(F, WSP(bf16_t, DY_G), wt + WT_DOWN / 2, 2048, DFF, E); }
}

__device__ __forceinline__ void frame_init(Frame& F, const Args& a, unsigned char* lds) {
    F.lds = (LAS unsigned char*)lds; F.ldsg = lds;
    F.tid = threadIdx.x; F.lane = F.tid & 63; F.wave = __builtin_amdgcn_readfirstlane(F.tid >> 6); F.G = gridDim.x; F.bid = blockIdx.x;
#pragma unroll
    for (int i = 0; i < N_INPUTS; ++i) F.in[i] = a.in[i];
    F.out = a.out; F.ws = a.ws;
}
template <int PH> __global__ void __launch_bounds__(NTHR, 2) k_phase(Args a) {
    extern __shared__ __attribute__((aligned(16))) unsigned char lds[];
    Frame F; frame_init(F, a, lds);
    run_phase<PH>(F, a.layer);
}
__global__ void k_fill(float* out, size_t n, float v) { for (size_t i = (size_t)blockIdx.x * blockDim.x + threadIdx.x; i < n; i += (size_t)gridDim.x * blockDim.x) out[i] = v; }

template <int PH> static void launch_phase(const Args& a0, int layer, int grid, hipStream_t stream) {
    static bool attr = false;
    if (!attr) { if (hipFuncSetAttribute((const void*)k_phase<PH>, hipFuncAttributeMaxDynamicSharedMemorySize, LDS_BYTES) != hipSuccess) fprintf(stderr, "kernel_launch: hipFuncSetAttribute failed for phase %d\n", PH); attr = true; }
    Args a = a0; a.layer = layer;
    hipLaunchKernelGGL(k_phase<PH>, dim3(grid), dim3(NTHR), LDS_BYTES, stream, a);
    const hipError_t e = hipPeekAtLastError(); if (e != hipSuccess) fprintf(stderr, "kernel_launch: phase %d launch failed: %s\n", PH, hipGetErrorName(e));
}
extern "C" void kernel_launch(void* const* d_in, const int* in_sizes, int n_in, void* d_out, int out_size, void* d_ws, size_t ws_size, hipStream_t stream) {
    static int grid = 0;
    if (grid == 0) { int dev = 0, cus = 0; if (hipGetDevice(&dev) != hipSuccess || hipDeviceGetAttribute(&cus, hipDeviceAttributeMultiprocessorCount, dev) != hipSuccess || cus < 1) cus = 256; grid = cus; }
    if (n_in != N_INPUTS || out_size != NB * T * D || ws_size < WS_END) {
        fprintf(stderr, "kernel_launch: unexpected shapes: n_in %d out %d ws %zu (need %zu)\n", n_in, out_size, ws_size, (size_t)WS_END);
        hipLaunchKernelGGL(k_fill, dim3(1024), dim3(256), 0, stream, (float*)d_out, (size_t)out_size, (float)(ws_size >> 20));
        return;
    }
    Args a{};
    for (int i = 0; i < N_INPUTS; ++i) a.in[i] = (const float*)d_in[i];
    a.out = (float*)d_out; a.ws = (unsigned char*)d_ws; a.layer = 0; a.ph_lo = 0; a.ph_hi = 0; a.pad = 0;
    launch_phase<PH_PRO>(a, 0, grid, stream);
    launch_phase<PH_MODFIN>(a, 0, grid, stream);
    for (int l = 0; l < 2; ++l) {
        launch_phase<PH_N1>(a, l, grid, stream); launch_phase<PH_GA>(a, l, grid, stream); launch_phase<PH_ATT>(a, l, grid, stream); launch_phase<PH_GB>(a, l, grid, stream);
        launch_phase<PH_R1>(a, l, grid, stream); launch_phase<PH_R2>(a, l, grid, stream); launch_phase<PH_GC>(a, l, grid, stream); launch_phase<PH_H1>(a, l, grid, stream);
        launch_phase<PH_H2>(a, l, grid, stream); launch_phase<PH_HN>(a, l, grid, stream); launch_phase<PH_OG>(a, l, grid, stream); launch_phase<PH_MG>(a, l, grid, stream);
        launch_phase<PH_WO>(a, l, grid, stream); launch_phase<PH_N2>(a, l, grid, stream); launch_phase<PH_UP>(a, l, grid, stream); launch_phase<PH_FIX>(a, l, grid, stream);
        launch_phase<PH_DN>(a, l, grid, stream);
    }
}
```

```cpp
#include <hip/hip_runtime.h>
#include <cstdio>
#include <cstdint>
namespace pg8 {
#define PG8_LAS __attribute__((address_space(3)))
typedef unsigned short bf16_t;
typedef short bf16x8 __attribute__((ext_vector_type(8)));
typedef float f32x4 __attribute__((ext_vector_type(4)));
typedef unsigned u32x4 __attribute__((ext_vector_type(4)));
constexpr int BM = 256, BK = 64, HALF = 128, HTB = HALF * BK * 2  , STAGE_BYTES = 8 * HTB, NXCD = 8, WGM = 8;

__host__ __device__ __forceinline__ int lds_byte(int r, int c) { const int st = (r >> 4) * 2 + (c >> 5), rr = r & 15, cc = c & 31, ob = rr * 64 + cc * 2; return st * 1024 + (ob ^ (((ob >> 9) & 1) << 5)); }
__host__ __device__ __forceinline__ void stage_rc(int b, int& R, int& C) { const int st = b / 1024, sb = b % 1024, swz = sb ^ (((sb >> 9) & 1) << 5); R = (st >> 1) * 16 + swz / 64; C = (st & 1) * 32 + (swz % 64) / 2; }
__host__ __device__ __forceinline__ int perm32(int rho) { const int n = rho >> 4, i = rho & 15; return 8 * (i >> 2) + 4 * n + (i & 3); }

struct Unit { int pm, pn; };
struct Gemm { const bf16_t* A; const bf16_t* Bt; int M, N, K; };

struct StaticOrder {
    int nM, nN, nwg, G, c;
    __host__ __device__ void init(int M, int N, int G_, int c_) { nM = M / BM; nN = N / BM; nwg = nM * nN; G = G_; c = c_; }
    __host__ __device__ bool next(int i, Unit& u) const {
        const long L = (long)i * G + c; if (L >= nwg) return false;
        int wgid = (int)L; { const int q = nwg / NXCD, r = nwg % NXCD, xcd = wgid % NXCD, off = wgid / NXCD; wgid = (xcd < r ? xcd * (q + 1) : r * (q + 1) + (xcd - r) * q) + off; }
        const int nig = WGM * nN, gid = wgid / nig, fm = gid * WGM, gsz = (nM - fm) < WGM ? (nM - fm) : WGM;
        u.pm = fm + ((wgid % nig) % gsz); u.pn = (wgid % nig) / gsz; return true;
    }
    __device__ __forceinline__ void a_ready(const Unit&) const {}
    __device__ __forceinline__ void done(const Unit&) const {}
};
struct CountedOrder : StaticOrder {
    const unsigned* ready; unsigned need; unsigned* tmo;
    __device__ __forceinline__ void a_ready(const Unit& u) const {
        if (threadIdx.x < 64) {
            const unsigned long long t0 = __builtin_amdgcn_s_memrealtime(); unsigned polls = 0;
            while ((unsigned)__builtin_amdgcn_readfirstlane(__hip_atomic_load(ready + 64 * u.pm, __ATOMIC_RELAXED, __HIP_MEMORY_SCOPE_AGENT)) < need) {
                if ((++polls & 255u) == 0u && __builtin_amdgcn_readfirstlane(__hip_atomic_load(tmo, __ATOMIC_RELAXED, __HIP_MEMORY_SCOPE_AGENT)) != 0u) break;
                if (__builtin_amdgcn_s_memrealtime() - t0 > 2000000ull) {
                    if (threadIdx.x == 0) { unsigned expect = 0u; __hip_atomic_compare_exchange_strong(tmo + 1, &expect, 0x600u | (unsigned)(u.pm & 0xff), __ATOMIC_RELAXED, __ATOMIC_RELAXED, __HIP_MEMORY_SCOPE_AGENT); __hip_atomic_store(tmo, 1u, __ATOMIC_RELAXED, __HIP_MEMORY_SCOPE_AGENT); }
                    break; }
                __builtin_amdgcn_s_sleep(2); }
            __builtin_amdgcn_fence(__ATOMIC_ACQUIRE, "agent");
            asm volatile("s_waitcnt vmcnt(0)" ::: "memory");
        }
#if !defined(BROKEN_HOOK_NO_BARRIER)
        asm volatile("" ::: "memory"); __builtin_amdgcn_s_barrier(); asm volatile("" ::: "memory");
#endif
    }
};

template <class T, class = void> struct keeps_acc { static constexpr bool value = false; };
template <class T> struct keeps_acc<T, decltype((void)T::KEEPS_ACC)> { static constexpr bool value = true; };
template <class Epi, class Sched, bool STAMP = false>
__device__ __forceinline__ void gemm_phase(PG8_LAS unsigned char* lds, const Gemm g, const Sched& S, const Epi& E, unsigned long long* stamps) {
    int tid_ = threadIdx.x; asm volatile("" : "+v"(tid_));
    const int tid = tid_, wid = __builtin_amdgcn_readfirstlane(tid >> 6), lane = tid & 63, wr = wid >> 2, wc = wid & 3, fr = lane & 15, fq = lane >> 4;
    const int K = g.K, nt = K / BK;
    int ts_lo = 0, ts_hi = 0, nts = 0; const unsigned long long rt_entry = STAMP ? (unsigned long long)wall_clock64() : 0ull;
#define PG8_STAMP() do { if (STAMP && wid == 0 && nts < 64) { const unsigned long long _c = (unsigned long long)clock64(); \
        ts_lo = (lane == nts) ? (int)(unsigned)_c : ts_lo; ts_hi = (lane == nts) ? (int)(unsigned)(_c >> 32) : ts_hi; ++nts; } } while (0)
    PG8_STAMP();
    unsigned voffA[2], voffB[2];
#pragma unroll
    for (int i = 0; i < 2; ++i) { int R, C; stage_rc(tid * 16 + i * 8192, R, C); const int Rb = Epi::PERM ? ((R & ~31) + perm32(R & 31)) : R;
        voffA[i] = (unsigned)(R * K + C) * 2u; voffB[i] = (unsigned)(Rb * K + C) * 2u; }
    const size_t kstep = (size_t)(BK * 2);
    const size_t hstep = (size_t)HALF * K * 2;
    const size_t tstep = 2 * hstep;
    const unsigned ldsw = (unsigned)wid * 1024u;
    const int aoff = lds_byte(wr * 64 + fr, fq * 8), boff = lds_byte(wc * 32 + fr, fq * 8);
#define PG8_SA(b, h) (((b) * 2 + (h)) * HTB)
#define PG8_SB(b, h) ((4 + (b) * 2 + (h)) * HTB)
#define PG8_STAGE(bufoff, gbase, voff) do { const char* g_ = (const char*)(gbase); asm volatile("" : "+s"(g_));     \
        _Pragma("unroll") for (int _i = 0; _i < 2; ++_i) { asm volatile("" : "+v"((voff)[_i]));                         \
        __builtin_amdgcn_global_load_lds((const unsigned*)(g_ + (voff)[_i]), (PG8_LAS unsigned*)(lds + (bufoff) + ldsw + _i * 8192), 16, 0, 0); } } while (0)
#define PG8_LDA(dst, b, h) do { _Pragma("unroll") for (int m = 0; m < 4; ++m) _Pragma("unroll") for (int k = 0; k < 2; ++k) dst[m][k] = *(const PG8_LAS bf16x8*)(lds + PG8_SA(b, h) + aoff + m * 2048 + k * 1024); } while (0)
#define PG8_LDB(dst, b, h) do { _Pragma("unroll") for (int n = 0; n < 2; ++n) _Pragma("unroll") for (int k = 0; k < 2; ++k) dst[n][k] = *(const PG8_LAS bf16x8*)(lds + PG8_SB(b, h) + boff + n * 2048 + k * 1024); } while (0)
#define PG8_MMA(ai, bj, At, Bt) do { __builtin_amdgcn_s_setprio(1); _Pragma("unroll") for (int m = 0; m < 4; ++m) _Pragma("unroll") for (int n = 0; n < 2; ++n) _Pragma("unroll") for (int k = 0; k < 2; ++k) \
        acc[ai][bj][m][n] = __builtin_amdgcn_mfma_f32_16x16x32_bf16(Bt[n][k], At[m][k], acc[ai][bj][m][n], 0, 0, 0); __builtin_amdgcn_s_setprio(0); } while (0)
#define PG8_WAIT_V(n) asm volatile("s_waitcnt vmcnt(" #n ")" ::: "memory")
#define PG8_WAIT_L(n) asm volatile("s_waitcnt lgkmcnt(" #n ")" ::: "memory")
#define PG8_BAR __builtin_amdgcn_s_barrier()
#define PG8_SCHED __builtin_amdgcn_sched_barrier(0)
    Unit cur, nxt; int ui = 0;
    if (!S.next(0, cur)) return;
    f32x4 acc[2][2][4][2];
#pragma unroll
    for (int a = 0; a < 2; ++a)
#pragma unroll
        for (int b = 0; b < 2; ++b)
#pragma unroll
            for (int m = 0; m < 4; ++m)
#pragma unroll
                for (int n = 0; n < 2; ++n) acc[a][b][m][n] = (f32x4){0.f, 0.f, 0.f, 0.f};
    bf16x8 At[4][2], B0[2][2], B1[2][2];
    const char* cA = (const char*)g.A + (size_t)cur.pm * tstep; const char* cB = (const char*)g.Bt + (size_t)cur.pn * tstep;
    S.a_ready(cur);
    PG8_STAGE(PG8_SB(0, 0), cB, voffB); PG8_STAGE(PG8_SA(0, 0), cA, voffA); PG8_STAGE(PG8_SB(0, 1), cB + hstep, voffB); PG8_STAGE(PG8_SA(0, 1), cA + hstep, voffA);
    if (wr == 1) PG8_BAR;
    PG8_WAIT_V(4); PG8_BAR;
    PG8_STAGE(PG8_SB(1, 0), cB + kstep, voffB); PG8_STAGE(PG8_SA(1, 0), cA + kstep, voffA); PG8_STAGE(PG8_SB(1, 1), cB + hstep + kstep, voffB);
    PG8_WAIT_V(6); PG8_BAR;
    PG8_STAMP();
    for (;;) {
        const bool has_next = S.next(ui + 1, nxt);
        const char* nA = has_next ? (const char*)g.A + (size_t)nxt.pm * tstep : cA; const char* nB = has_next ? (const char*)g.Bt + (size_t)nxt.pn * tstep : cB;
        for (int t = 0; t < nt; t += 2) {
            const bool last = (t == nt - 2);
            const char* a1 = cA + (size_t)(t + 1) * kstep;
            const char* a2 = last ? nA : cA + (size_t)(t + 2) * kstep; const char* b2 = last ? nB : cB + (size_t)(t + 2) * kstep;
            const char* a3 = a2 + kstep; const char* b3 = b2 + kstep;
            if (last && has_next) S.a_ready(nxt);
            PG8_LDB(B0, 0, 0); PG8_SCHED; PG8_LDA(At, 0, 0); PG8_STAGE(PG8_SA(1, 1), a1 + hstep, voffA);
            PG8_WAIT_L(8); PG8_BAR; PG8_WAIT_L(0); PG8_MMA(0, 0, At, B0); PG8_BAR; PG8_SCHED;
            PG8_LDB(B1, 0, 1); PG8_STAGE(PG8_SB(0, 0), b2, voffB);
            PG8_BAR; PG8_WAIT_L(0); PG8_MMA(0, 1, At, B1); PG8_BAR;
            PG8_LDA(At, 0, 1); PG8_STAGE(PG8_SA(0, 0), a2, voffA);
            PG8_BAR; PG8_WAIT_L(0); PG8_MMA(1, 0, At, B0); PG8_BAR; PG8_SCHED;
            PG8_STAGE(PG8_SB(0, 1), b2 + hstep, voffB);
            PG8_WAIT_V(6); PG8_BAR; PG8_MMA(1, 1, At, B1); PG8_BAR;
            PG8_LDB(B0, 1, 0); PG8_SCHED; PG8_LDA(At, 1, 0); PG8_STAGE(PG8_SA(0, 1), a2 + hstep, voffA);
            PG8_WAIT_L(8); PG8_BAR; PG8_WAIT_L(0); PG8_MMA(0, 0, At, B0); PG8_BAR; PG8_SCHED;
            PG8_LDB(B1, 1, 1); PG8_STAGE(PG8_SB(1, 0), b3, voffB);
            PG8_BAR; PG8_WAIT_L(0); PG8_MMA(0, 1, At, B1); PG8_BAR;
            PG8_LDA(At, 1, 1); PG8_STAGE(PG8_SA(1, 0), a3, voffA);
            PG8_BAR; PG8_WAIT_L(0); PG8_MMA(1, 0, At, B0); PG8_BAR; PG8_SCHED;
            PG8_STAGE(PG8_SB(1, 1), b3 + hstep, voffB);
            PG8_WAIT_V(6); PG8_BAR; PG8_MMA(1, 1, At, B1); PG8_BAR;
        }
        PG8_STAMP();
        if constexpr (!Epi::AFTER_DRAIN) { E(acc, cur, wr, wc, fr, fq); S.done(cur); }
        PG8_STAMP();
        if (!has_next) break;
        bool keep_acc = false;
        if constexpr (keeps_acc<Epi>::value) keep_acc = S.keep(ui);
        if (!keep_acc) {
#pragma unroll
        for (int a = 0; a < 2; ++a)
#pragma unroll
            for (int b = 0; b < 2; ++b)
#pragma unroll
                for (int m = 0; m < 4; ++m)
#pragma unroll
                    for (int n = 0; n < 2; ++n) acc[a][b][m][n] = (f32x4){0.f, 0.f, 0.f, 0.f};
        }
        cur = nxt; cA = nA; cB = nB; ++ui;
    }
    PG8_WAIT_V(0);
    if (wr == 0) PG8_BAR;
    PG8_BAR;
    if constexpr (Epi::AFTER_DRAIN) { E.fused(acc, cur, wr, wc, fr, fq, lds, wid, lane); S.done(cur); }
    PG8_STAMP();
    if (STAMP && wid == 0) { stamps[lane] = lane < nts ? (((unsigned long long)(unsigned)ts_hi << 32) | (unsigned)ts_lo) : 0ull;
        if (lane == 62) stamps[62] = rt_entry; if (lane == 63) stamps[63] = (unsigned long long)wall_clock64(); }
#undef PG8_STAMP
#undef PG8_SA
#undef PG8_SB
#undef PG8_STAGE
#undef PG8_LDA
#undef PG8_LDB
#undef PG8_MMA
#undef PG8_WAIT_V
#undef PG8_WAIT_L
#undef PG8_BAR
#undef PG8_SCHED
}
}

#define GAS __attribute__((address_space(1)))
#define LAS __attribute__((address_space(3)))
typedef unsigned short bf16_t;
typedef short bf16x8 __attribute__((ext_vector_type(8)));
typedef short s16x4 __attribute__((ext_vector_type(4)));
typedef float f32x4 __attribute__((ext_vector_type(4)));
typedef float f32x2 __attribute__((ext_vector_type(2)));
typedef float f32x16 __attribute__((ext_vector_type(16)));
typedef unsigned u32x4 __attribute__((ext_vector_type(4)));
typedef unsigned u32x2 __attribute__((ext_vector_type(2)));

typedef __bf16 bf16x2_t __attribute__((ext_vector_type(2)));
__device__ __forceinline__ unsigned cvtpk_c(float lo, float hi) { const f32x2 v = {lo, hi}; return __builtin_bit_cast(unsigned, __builtin_convertvector(v, bf16x2_t)); }
__device__ __forceinline__ unsigned cvtpk(float lo, float hi) { unsigned r; asm volatile("v_cvt_pk_bf16_f32 %0, %1, %2" : "=v"(r) : "v"(lo), "v"(hi)); return r; }
__device__ __forceinline__ float bf2f(unsigned short b) { return __uint_as_float(((unsigned)b) << 16); }
__device__ __forceinline__ float bflo(unsigned w) { return __uint_as_float(w << 16); }
__device__ __forceinline__ float bfhi(unsigned w) { return __uint_as_float(w & 0xffff0000u); }
__device__ __forceinline__ float wave_sum(float v) {
#pragma unroll
    for (int o = 1; o < 64; o <<= 1) v += __shfl_xor(v, o);
    return v;
}
__device__ __forceinline__ float sigmoidf_(float x) { return __builtin_amdgcn_rcpf(1.0f + __builtin_amdgcn_exp2f(-1.4426950408889634f * x)); }
__device__ __forceinline__ float siluf_(float x) { return x * __builtin_amdgcn_rcpf(1.0f + __builtin_amdgcn_exp2f(-1.4426950408889634f * x)); }

#define XB_TMO      128
#define XB_XCNT(j)  (256  + 64 * (j))
#define XB_XSUB(j)  (1280 + 64 * (j))
#define XB_XGEN(j)  (2304 + 64 * (j))
#define XB_TOP      3328
#define XB_TOPGEN   3392
#define XCD_BAR_WORDS 3456
#define XB_SPIN_CAP (1u << 18)

__device__ __forceinline__ unsigned xb_ld(unsigned* p)              { return __hip_atomic_load(p, __ATOMIC_RELAXED, __HIP_MEMORY_SCOPE_AGENT); }
__device__ __forceinline__ unsigned xb_add(unsigned* p, unsigned v) { return __hip_atomic_fetch_add(p, v, __ATOMIC_RELAXED, __HIP_MEMORY_SCOPE_AGENT); }
__device__ __forceinline__ unsigned xb_xcc_id() { return (unsigned)__builtin_amdgcn_s_getreg((3 << 11) | 20) & 0xFu; }
#define XB_SPIN(cond, bar) do { unsigned _sp = 0; while (cond) { __builtin_amdgcn_s_sleep(1); \
    if ((++_sp & 255u) == 0u) { if (xb_ld(&(bar)[XB_TMO])) break; if (_sp > XB_SPIN_CAP) { atomicAdd(&(bar)[XB_TMO], 1u); break; } } } } while (0)

struct XcdBarrier {
    unsigned* bar; unsigned x;
    volatile LAS unsigned* st;
};
__device__ __forceinline__ XcdBarrier xcd_barrier_post(unsigned* bar, volatile LAS unsigned* st) {
    XcdBarrier b; b.bar = bar; b.x = xb_xcc_id(); b.st = st;
    if (threadIdx.x == 0) (void)xb_add(&bar[XB_XCNT(b.x)], 1u);
    return b;
}
__device__ __forceinline__ void xcd_barrier_complete(unsigned* bar, unsigned x, unsigned& nloc, unsigned& nx) {
    const unsigned G = gridDim.x * gridDim.y * gridDim.z;
    unsigned sum, cnt, mine, sp = 0u;
    for (;;) {
        sum = 0u; cnt = 0u; mine = 0u;
#pragma unroll
        for (unsigned j = 0; j < 16; ++j) { const unsigned c = xb_ld(&bar[XB_XCNT(j)]); sum += c; cnt += (c > 0u) ? 1u : 0u; mine = (j == x) ? c : mine; }
        if (sum == G) break;
        __builtin_amdgcn_s_sleep(1);
        if ((++sp & 255u) == 0u) { if (xb_ld(&bar[XB_TMO])) break; if (sp > XB_SPIN_CAP) { atomicAdd(&bar[XB_TMO], 1u); break; } }
    }
    nloc = mine > 0u ? mine : 1u; nx = cnt > 0u ? cnt : 1u;
}
__device__ __forceinline__ void xcd_barrier(const XcdBarrier& b) {
    asm volatile("s_waitcnt vmcnt(0)" ::: "memory");
    __syncthreads();
    if (threadIdx.x == 0) {
        unsigned* bar = b.bar;
        __builtin_amdgcn_s_waitcnt(0);
        unsigned nloc = b.st[0], nx = b.st[1];
        if (nloc == 0u) { xcd_barrier_complete(bar, b.x, nloc, nx); b.st[0] = nloc; b.st[1] = nx; }
        const unsigned old = xb_add(&bar[XB_XSUB(b.x)], 1u);
        const unsigned gen = old / nloc;
        if (old + 1u == (gen + 1u) * nloc) {
            __builtin_amdgcn_fence(__ATOMIC_RELEASE, "agent");
            asm volatile("s_waitcnt vmcnt(0)" ::: "memory");
            const unsigned og = xb_add(&bar[XB_TOP], 1u);
            const unsigned tg = og / nx;
            if (og + 1u == (tg + 1u) * nx) xb_add(&bar[XB_TOPGEN], 1u);
            else XB_SPIN(xb_ld(&bar[XB_TOPGEN]) == tg, bar);
            __builtin_amdgcn_fence(__ATOMIC_ACQUIRE, "agent");
            xb_add(&bar[XB_XGEN(b.x)], 1u);
            asm volatile("s_waitcnt vmcnt(0)" ::: "memory");
        } else {
            XB_SPIN(xb_ld(&bar[XB_XGEN(b.x)]) == gen, bar);
            __builtin_amdgcn_fence(__ATOMIC_ACQUIRE, "agent");
            asm volatile("s_waitcnt vmcnt(0)" ::: "memory");
        }
    }
    __syncthreads();
}

constexpr int D = 2048, NB = 2, T = 16384, LC = 256, TT = T + LC  , MR = NB * TT  ;
constexpr int NPAN = MR / 256  , PPB = TT / 256  ;
constexpr int NIN = 17408, DFF = 5504, NUP = 2 * DFF;
constexpr int NWAVES = 8, NTHR = 512;
constexpr float EPS = 1e-6f;
constexpr float LOG2E = 1.4426950408889634f;

enum { I_X = 0, I_C, I_CTX, I_CCTX, I_WMOD, I_BMOD, I_WIN, I_BGATE, I_QKN, I_LAMBDA, I_SUBLN, I_RNORM, I_GLB, I_GNORM, I_WBR, I_WOUT, I_WUP, I_CONVW, I_CONVB, I_WDOWN, N_INPUTS };

enum { TY_ROPE64 = 0, TY_ROPE128 = 1, TY_PLAIN = 2 };
enum { PT_DQ = 0, PT_DK = 4, PT_DV = 8, PT_RQ = 12, PT_RK = 14, PT_RV = 16, PT_GQ = 20, PT_GF = 24, PT_GB = 28, PT_GI = 32, PT_RG = 36, PT_GG = 40, PT_MA = 44, PT_MB = 52, PT_MC = 60, PT_END = 68 };
__host__ __device__ __forceinline__ int pt_logical_base(int pt) {
    if (pt < PT_RQ) return 256 * pt;
    if (pt < PT_RV) return 3072 + 256 * (pt - PT_RQ);
    if (pt < PT_GQ) return 4096 + 256 * (pt - PT_RV);
    if (pt < PT_RG) return 6144 + 256 * (pt - PT_GQ);
    if (pt < PT_GG) return 5120 + 256 * (pt - PT_RG);
    if (pt < PT_MA) return 10240 + 256 * (pt - PT_GG);
    return 11264 + 256 * (pt - PT_MA);
}
__host__ __device__ __forceinline__ int pt_type(int pt) { return pt < PT_DV ? TY_ROPE64 : (pt >= PT_RQ && pt < PT_RV) ? TY_ROPE128 : TY_PLAIN; }
__host__ __device__ __forceinline__ int perm_col(int type, int p) {
    const int bj = p >> 7, wc = (p >> 5) & 3, n = (p >> 4) & 1, fq = (p >> 2) & 3, e = p & 3;
    if (type == TY_ROPE64)  return 64 * wc + 32 * (fq >> 1) + 16 * bj + 8 * (fq & 1) + 4 * n + e;
    if (type == TY_ROPE128) return 128 * (wc >> 1) + 64 * (wc & 1) + 32 * bj + 8 * fq + 4 * n + e;
    return 64 * wc + 32 * bj + 8 * fq + 4 * n + e;
}
__host__ __device__ __forceinline__ int perm_col_up(int p) { const int bj = p >> 7, wc = (p >> 5) & 3, n = (p >> 4) & 1, fq = (p >> 2) & 3, e = p & 3; return 128 * bj + 32 * wc + 8 * fq + 4 * n + e; }

constexpr size_t MiB = 1u << 20;
constexpr size_t WS_CTL = 0, CTL_ZERO_BYTES = 1 * MiB;
constexpr size_t WS_MODP = 1 * MiB;
constexpr size_t WS_MODV = 6 * MiB;
constexpr size_t WS_ROPEA = 7 * MiB;
constexpr size_t WS_ROPEB = 7 * MiB + 64 * 1024;
constexpr size_t WS_LB = 7 * MiB + 256 * 1024;
constexpr size_t WS_SCAL = 7 * MiB + 512 * 1024;
constexpr size_t WS_XC = 9 * MiB;
constexpr size_t WS_WT = 13 * MiB;
constexpr size_t WT_IN = 0, WT_BR = 68 * MiB, WT_OUT = 80 * MiB, WT_UP = 88 * MiB, WT_DOWN = 131 * MiB;
constexpr size_t WS_H = 166 * MiB;
constexpr size_t WS_DYN = 296 * MiB;
constexpr size_t DY_OA = WS_DYN, DY_OB = WS_DYN + 65 * MiB, DY_OC = WS_DYN + 130 * MiB;
constexpr size_t DY_OSUB = WS_DYN + 195 * MiB;
constexpr size_t DY_US = DY_OSUB;
constexpr size_t DY_QKV = WS_DYN + 65 * MiB;
constexpr size_t DY_O1 = WS_DYN + 260 * MiB;
constexpr size_t DY_PC = WS_DYN + 325 * MiB;
constexpr size_t DY_PB = WS_DYN + 585 * MiB;
constexpr size_t DY_MG = WS_DYN + 325 * MiB;
constexpr size_t DY_Y = DY_OSUB, DY_YO = DY_OSUB;
constexpr size_t DY_G = WS_DYN, DY_RAW = WS_DYN + 350 * MiB;
constexpr size_t WS_END = WS_DYN + 715 * MiB;
constexpr size_t SZ_ROWS1K = (size_t)MR * 1024 * 2;

constexpr int CW_BAR = 4096;

constexpr int RING_BYTES = 131072, LDSCTL_OFF = RING_BYTES, MISC_OFF = LDSCTL_OFF + 320, LDS_BYTES = 147456;

struct Args { const float* in[N_INPUTS]; float* out; unsigned char* ws; int layer, ph_lo, ph_hi, pad; };

struct Frame {
    LAS unsigned char* lds;
    int tid, lane, wave, G, bid;
    const Args* a; unsigned char* ws;
};
__device__ __forceinline__ float* outp(const Frame& F) { GAS float* p = (GAS float*)F.a->out; asm volatile("" : "+s"(p)); return (float*)p; }
__device__ __forceinline__ const float* inp(const Frame& F, int i) { const GAS float* p = (const GAS float*)F.a->in[i]; asm volatile("" : "+s"(p)); return (const float*)p; }
__device__ __forceinline__ int opaque_tid() { int t = threadIdx.x; asm volatile("" : "+v"(t)); return t; }
__device__ __forceinline__ void frame_refresh(Frame& F) { GAS unsigned char* w_ = (GAS unsigned char*)F.a->ws; asm volatile("" : "+s"(w_)); F.ws = (unsigned char*)w_; F.tid = opaque_tid(); F.lane = F.tid & 63; F.wave = __builtin_amdgcn_readfirstlane(F.tid >> 6); }
#define WSP(T_, off) ((T_*)(F.ws + (off)))

__device__ __forceinline__ void p0_mod_partial(Frame& F) {
    LAS float* sv = (LAS float*)F.lds;
    for (int i = F.tid; i < 3 * D; i += NTHR) { const int v = i / D, k = i % D; const float c = v < 2 ? inp(F, I_C)[v * D + k] : inp(F, I_CCTX)[k]; sv[i] = siluf_(c); }
    __syncthreads();
    float* part = WSP(float, WS_MODP);
    const int total = 2 * 16 * 3072;
    for (int task = F.bid * NTHR + F.tid; task < total; task += F.G * NTHR) {
        const int q = task % 3072, ks = (task / 3072) % 16, l = task / (3072 * 16);
        const float* W = inp(F, I_WMOD) + ((size_t)l * D + ks * 128) * (6 * D) + q * 4;
        f32x4 a0 = {0, 0, 0, 0}, a1 = a0, a2 = a0;
#pragma unroll 8
        for (int k = 0; k < 128; ++k) { const f32x4 w = *(const f32x4*)(W + (size_t)k * (6 * D)); const float s0 = sv[ks * 128 + k], s1 = sv[D + ks * 128 + k], s2 = sv[2 * D + ks * 128 + k];
            a0 += w * s0; a1 += w * s1; a2 += w * s2; }
        float* o = part + ((size_t)(ks * 2 + l) * 3) * (6 * D) + q * 4;
        *(f32x4*)(o) = a0; *(f32x4*)(o + 6 * D) = a1; *(f32x4*)(o + 12 * D) = a2;
    }
    __syncthreads();
}
__device__ __forceinline__ void p0_tables(Frame& F) {
    const int gt = F.bid * NTHR + F.tid, NGT = F.G * NTHR;
    f32x2* ra = WSP(f32x2, WS_ROPEA); f32x2* rb = WSP(f32x2, WS_ROPEB);
    for (int i = gt; i < 256 * 16; i += NGT) { const int pos = i >> 4, f = i & 15; const float inv = powf(10000.0f, -(float)f / 16.0f); const float ang = (float)pos * inv; ra[i] = (f32x2){cosf(ang), sinf(ang)}; }
    for (int i = gt; i < 256 * 32; i += NGT) { const int pos = i >> 5, f = i & 31; const float inv = powf(10000.0f, -(float)f / 32.0f); const float ang = (float)pos * inv; rb[i] = (f32x2){cosf(ang), sinf(ang)}; }
    float* lb = WSP(float, WS_LB);
    for (int i = gt; i < 2 * 1024; i += NGT) { const float g0 = inp(F, I_GLB)[i], g1 = inp(F, I_GLB)[2048 + i]; const float m = fmaxf(g0, g1); const float e0 = expf(g0 - m), e1 = expf(g1 - m);
        lb[i] = 0.0f; lb[2048 + i] = e1 / (e0 + e1); }
    if (gt == 0) {
        float* sc = WSP(float, WS_SCAL);
        for (int l = 0; l < 2; ++l) {
            const float* al = inp(F, I_LAMBDA) + l * 256; float s1 = 0.f, s2 = 0.f;
            for (int i = 0; i < 64; ++i) { s1 += al[i] * al[64 + i]; s2 += al[128 + i] * al[192 + i]; }
            const float lam_init = 0.8f - 0.6f * expf(-0.3f * (float)l);
            sc[l] = expf(s1) - expf(s2) + lam_init;
            const float* g = inp(F, I_QKN) + l * 128; float mq = 0.f, mk = 0.f;
            for (int i = 0; i < 64; ++i) { mq = fmaxf(mq, fabsf(g[i])); mk = fmaxf(mk, fabsf(g[64 + i])); }
            sc[2 + l] = -(8.0f * mq * mk * 1.02f) * LOG2E;
        }
    }
}
__device__ __forceinline__ void convert_tile(Frame& F, const float* W, int N, int K, bf16_t* WT, int prow0, int k0, int base0, int base1, int ptype  ) {
    LAS float* t = (LAS float*)F.lds;
    { float wv[32];
#pragma unroll
      for (int i = 0; i < 32; ++i) { const int idx = i * NTHR + F.tid, kk = idx >> 8, c = idx & 255; const int col = c < 128 ? base0 + c : base1 + (c - 128);
          wv[i] = W[(size_t)(k0 + kk) * N + col]; }
#pragma unroll
      for (int i = 0; i < 32; ++i) { const int idx = i * NTHR + F.tid, kk = idx >> 8, c = idx & 255; t[kk * 257 + c] = wv[i]; } }
    __syncthreads();
#pragma unroll
    for (int i = 0; i < 4; ++i) { const int item = i * NTHR + F.tid, ch = item & 7, p = item >> 3; const int lc = ptype < 0 ? perm_col_up(p) : perm_col(ptype, p);
        const LAS float* s = t + (8 * ch) * 257 + lc;
        u32x4 o; o.x = cvtpk(s[0], s[257]); o.y = cvtpk(s[2 * 257], s[3 * 257]); o.z = cvtpk(s[4 * 257], s[5 * 257]); o.w = cvtpk(s[6 * 257], s[7 * 257]);
        *(u32x4*)(WT + (size_t)(prow0 + p) * K + k0 + 8 * ch) = o; }
    __syncthreads();
}
__device__ __forceinline__ void convert_weights(Frame& F, int l) {
    bf16_t* wt = WSP(bf16_t, WS_WT);
    constexpr int T_IN = 68 * 32, T_BR = 3 * 8 * 16, T_OUT = 8 * 32, T_UP = 43 * 32, T_DN = 8 * 86, T_ALL = T_IN + T_BR + T_OUT + T_UP + T_DN;
    for (int it = F.bid; it < T_ALL; it += F.G) {
        int r = it;
        if (r < T_IN) { const int pt = r / 32, kb = r % 32; const int lb = pt_logical_base(pt);
            convert_tile(F, inp(F, I_WIN) + (size_t)l * D * NIN, NIN, D, wt + WT_IN / 2, pt * 256, kb * 64, lb, lb + 128, pt_type(pt)); continue; } r -= T_IN;
        if (r < T_BR) { const int n = r / 128, pt = (r % 128) / 16, kb = r % 16;
            convert_tile(F, inp(F, I_WBR) + ((size_t)l * 3 + n) * 1024 * D, D, 1024, wt + WT_BR / 2 + (size_t)n * D * 1024, pt * 256, kb * 64, pt * 256, pt * 256 + 128, TY_PLAIN); continue; } r -= T_BR;
        if (r < T_OUT) { const int pt = r / 32, kb = r % 32;
            convert_tile(F, inp(F, I_WOUT) + (size_t)l * D * D, D, D, wt + WT_OUT / 2, pt * 256, kb * 64, pt * 256, pt * 256 + 128, TY_PLAIN); continue; } r -= T_OUT;
        if (r < T_UP) { const int pt = r / 32, kb = r % 32;
            convert_tile(F, inp(F, I_WUP) + (size_t)l * D * NUP, NUP, D, wt + WT_UP / 2, pt * 256, kb * 64, pt * 128, DFF + pt * 128, -1); continue; } r -= T_UP;
        { const int pt = r / 86, kb = r % 86;
            convert_tile(F, inp(F, I_WDOWN) + (size_t)l * DFF * D, D, DFF, wt + WT_DOWN / 2, pt * 256, kb * 64, pt * 256, pt * 256 + 128, TY_PLAIN); }
    }
}
__device__ __forceinline__ void p1_mod_final(Frame& F) {
    const float* part = WSP(float, WS_MODP); float* mv = WSP(float, WS_MODV);
    for (int i = F.bid * NTHR + F.tid; i < 2 * 3 * 6 * D; i += F.G * NTHR) { const int n = i % (6 * D), l = i / (3 * 6 * D);
        float s = inp(F, I_BMOD)[l * 6 * D + n];
#pragma unroll
        for (int ks = 0; ks < 16; ++ks) s += part[(size_t)ks * (2 * 3 * 6 * D) + i];
        mv[i] = s; }
}

__device__ __forceinline__ const float* xrow_src(Frame& F, int R, int use_inputs) {
    const int b = R / TT, t = R % TT;
    if (t < T) return (use_inputs ? inp(F, I_X) : (const float*)outp(F)) + ((size_t)b * T + t) * D;
    return (use_inputs ? inp(F, I_CTX) : (const float*)WSP(float, WS_XC)) + ((size_t)b * LC + (t - T)) * D;
}
__device__ __forceinline__ void norm_phase(Frame& F, int l, int which  ) {
    const int gw = F.bid * NWAVES + F.wave, NGW = F.G * NWAVES;
    bf16_t* h = WSP(bf16_t, WS_H); const float* mv = WSP(float, WS_MODV);
    const int use_inputs = (l == 0 && which == 0);
    f32x4 x[8], xn[8], sc1[8], sh[8]; int vcur = -1;
    if (gw < MR) { const f32x4* xr = (const f32x4*)xrow_src(F, gw, use_inputs) + F.lane;
#pragma unroll
        for (int j = 0; j < 8; ++j) x[j] = xr[64 * j]; }
    for (int R = gw; R < MR; R += NGW) {
        const int Rn = R + NGW;
        if (Rn < MR) { const f32x4* xr = (const f32x4*)xrow_src(F, Rn, use_inputs) + F.lane;
#pragma unroll
            for (int j = 0; j < 8; ++j) xn[j] = xr[64 * j]; }
        const int b = R / TT, t = R % TT, v = t < T ? b : 2;
        if (v != vcur) {
            const float* shift = mv + ((size_t)(l * 3 + v) * 6 + (which ? 3 : 0)) * D; const float* scale = shift + D;
#pragma unroll
            for (int j = 0; j < 8; ++j) { sc1[j] = *((const f32x4*)scale + F.lane + 64 * j) + 1.0f; sh[j] = *((const f32x4*)shift + F.lane + 64 * j); }
            vcur = v;
        }
        float ss = 0.f;
#pragma unroll
        for (int j = 0; j < 8; ++j) ss += (x[j].x * x[j].x + x[j].y * x[j].y) + (x[j].z * x[j].z + x[j].w * x[j].w);
        const float rstd = rsqrtf(wave_sum(ss) * (1.0f / D) + EPS);
        u32x2* o = (u32x2*)(h + (size_t)R * D) + F.lane;
#pragma unroll
        for (int j = 0; j < 8; ++j) { const f32x4 y = x[j] * rstd * sc1[j] + sh[j]; u32x2 w; w.x = cvtpk(y.x, y.y); w.y = cvtpk(y.z, y.w); o[64 * j] = w; }
#pragma unroll
        for (int j = 0; j < 8; ++j) x[j] = xn[j];
    }
}

typedef f32x4 acc_t[2][2][4][2];
__device__ __forceinline__ u32x4 pack8(const f32x4 a, const f32x4 b) { u32x4 w; w.x = cvtpk(a[0], a[1]); w.y = cvtpk(a[2], a[3]); w.z = cvtpk(b[0], b[1]); w.w = cvtpk(b[2], b[3]); return w; }

struct EpiIn {
    static constexpr bool PERM = false, AFTER_DRAIN = false;
    int pt0;
    bf16_t *rq, *r2, *r1;
    const float* qkn;
    const f32x2 *ropeA, *ropeB;
    __device__ __forceinline__ void operator()(const acc_t& acc, const pg8::Unit& u, int wr, int wc, int fr, int fq) const {
        const int pt = pt0 + u.pn, b = u.pm / PPB, tb = (u.pm % PPB) * 256 + wr * 64 + fr;
        if (pt < PT_DV) {
            const int isk = pt >= PT_DK, sh = 4 * (pt - (isk ? PT_DK : PT_DQ)) + wc, d0 = 32 * (fq >> 1) + 8 * (fq & 1);
            bf16_t* base = rq + (isk ? (size_t)MR * 1024 : (size_t)0) + ((size_t)(b * 16 + sh) * TT) * 64 + d0;
            const float* gp = qkn + isk * 64 + d0; const float osc = isk ? 1.0f : LOG2E * 0.125f;
            f32x4 g[2][2];
#pragma unroll
            for (int s = 0; s < 2; ++s)
#pragma unroll
                for (int n = 0; n < 2; ++n) g[s][n] = *(const f32x4*)(gp + 16 * s + 4 * n) * osc;
            const bool lat = (u.pm % PPB) != PPB - 1;
            f32x4 c0_[4], c1_[4], c2_[4];
#define R64_LD(buf, it) do { const int t = lat ? tb + ((it) >> 2) * 128 + ((it) & 3) * 16 : 0; const int pos = (fq < 2) ? (t >> 6) : (t & 63);                                              \
                const f32x4* rp = (const f32x4*)(ropeA + pos * 16 + 8 * (fq & 1)); _Pragma("unroll") for (int k = 0; k < 4; ++k) buf[k] = rp[k]; } while (0)
#define R64_DO(buf, it) do { constexpr int ai = (it) >> 2, m = (it) & 3; const int t = tb + ai * 128 + m * 16;                                                                                  \
                f32x4 x[2][2]; float ss = 0.f;                                                                                                                                                    \
                _Pragma("unroll") for (int s = 0; s < 2; ++s) _Pragma("unroll") for (int n = 0; n < 2; ++n) { x[s][n] = acc[ai][s][m][n];                                                         \
                    ss += (x[s][n][0] * x[s][n][0] + x[s][n][1] * x[s][n][1]) + (x[s][n][2] * x[s][n][2] + x[s][n][3] * x[s][n][3]); }                                                            \
                ss += __shfl_xor(ss, 16); ss += __shfl_xor(ss, 32);                                                                                                                               \
                const float rstd = rsqrtf(ss * (1.0f / 64.0f) + EPS);                                                                                                                             \
                _Pragma("unroll") for (int s = 0; s < 2; ++s) _Pragma("unroll") for (int n = 0; n < 2; ++n) x[s][n] = x[s][n] * rstd * g[s][n];                                                   \
                if (lat) { _Pragma("unroll") for (int n = 0; n < 2; ++n) { const f32x4 c01 = buf[2 * n], c23 = buf[2 * n + 1];               \
                    const f32x4 cs = {c01[0], c01[2], c23[0], c23[2]}, sn = {c01[1], c01[3], c23[1], c23[3]};                                                                                     \
                    const f32x4 u1 = x[0][n], u2 = x[1][n]; x[0][n] = u1 * cs - u2 * sn; x[1][n] = u1 * sn + u2 * cs; } }                                                                         \
                bf16_t* rowp = base + (size_t)t * 64;                                                                                                                                             \
                *(u32x4*)(rowp) = pack8(x[0][0], x[0][1]); *(u32x4*)(rowp + 16) = pack8(x[1][0], x[1][1]); } while (0)
            R64_LD(c0_, 0); R64_LD(c1_, 1); R64_LD(c2_, 2); R64_DO(c0_, 0); R64_LD(c0_, 3); R64_DO(c1_, 1); R64_LD(c1_, 4); R64_DO(c2_, 2); R64_LD(c2_, 5);
            R64_DO(c0_, 3); R64_LD(c0_, 6); R64_DO(c1_, 4); R64_LD(c1_, 7); R64_DO(c2_, 5); R64_DO(c0_, 6); R64_DO(c1_, 7);
#undef R64_LD
#undef R64_DO
        } else if (pt >= PT_RQ && pt < PT_RV) {
            const int isk = pt >= PT_RK, head = 2 * (pt - (isk ? PT_RK : PT_RQ)) + (wc >> 1), d0 = 64 * (wc & 1) + 8 * fq;
            bf16_t* base = r2 + (isk ? (size_t)MR * 512 : (size_t)0) + ((size_t)(b * 4 + head) * TT) * 128 + d0;
            const float osc = isk ? 0.08838834764831845f : 1.0f;
            const bool lat = (u.pm % PPB) != PPB - 1;
            f32x4 c0_[4], c1_[4], c2_[4];
#define R128_LD(buf, it) do { const int t = lat ? tb + ((it) >> 2) * 128 + ((it) & 3) * 16 : 0; const int pos = ((wc & 1) == 0) ? (t >> 6) : (t & 63);                                          \
                const f32x4* rp = (const f32x4*)(ropeB + pos * 32 + 8 * fq); _Pragma("unroll") for (int k = 0; k < 4; ++k) buf[k] = rp[k]; } while (0)
#define R128_DO(buf, it) do { constexpr int ai = (it) >> 2, m = (it) & 3; const int t = tb + ai * 128 + m * 16;                                                                                  \
                f32x4 x[2][2];                                                                                                                                                                    \
                _Pragma("unroll") for (int s = 0; s < 2; ++s) _Pragma("unroll") for (int n = 0; n < 2; ++n) x[s][n] = acc[ai][s][m][n] * osc;                                                     \
                if (lat) { _Pragma("unroll") for (int n = 0; n < 2; ++n) { const f32x4 c01 = buf[2 * n], c23 = buf[2 * n + 1];                                                                     \
                    const f32x4 cs = {c01[0], c01[2], c23[0], c23[2]}, sn = {c01[1], c01[3], c23[1], c23[3]};                                                                                     \
                    const f32x4 u1 = x[0][n], u2 = x[1][n]; x[0][n] = u1 * cs - u2 * sn; x[1][n] = u1 * sn + u2 * cs; } }                                                                         \
                bf16_t* rowp = base + (size_t)t * 128;                                                                                                                                            \
                *(u32x4*)(rowp) = pack8(x[0][0], x[0][1]); *(u32x4*)(rowp + 32) = pack8(x[1][0], x[1][1]); } while (0)
            R128_LD(c0_, 0); R128_LD(c1_, 1); R128_LD(c2_, 2); R128_DO(c0_, 0); R128_LD(c0_, 3); R128_DO(c1_, 1); R128_LD(c1_, 4); R128_DO(c2_, 2); R128_LD(c2_, 5);
            R128_DO(c0_, 3); R128_LD(c0_, 6); R128_DO(c1_, 4); R128_LD(c1_, 7); R128_DO(c2_, 5); R128_DO(c0_, 6); R128_DO(c1_, 7);
#undef R128_LD
#undef R128_DO
        } else {
            int pts, hd; bf16_t* sb;
            if (pt < PT_RQ) { sb = rq + (size_t)MR * 2048; pts = PT_DV; hd = 128; } else if (pt < PT_GQ) { sb = r2 + (size_t)MR * 1024; pts = PT_RV; hd = 256; }
            else { const int s4 = (pt - PT_GQ) >> 2; sb = r1 + (size_t)s4 * MR * 1024; pts = PT_GQ + 4 * s4; hd = 128; }
            const int c = 256 * (pt - pts) + 64 * wc + 8 * fq, head = c / hd, dim = c % hd, H = 1024 / hd;
            bf16_t* base = sb + ((size_t)(b * H + head) * TT) * hd + dim;
            const bool isq = (pt >= PT_GQ && pt < PT_GF);
#pragma unroll
            for (int ai = 0; ai < 2; ++ai)
#pragma unroll
                for (int m = 0; m < 4; ++m) {
                    const int t = tb + ai * 128 + m * 16; bf16_t* rowp = base + (size_t)t * hd;
#pragma unroll
                    for (int bj = 0; bj < 2; ++bj) { f32x4 a = acc[ai][bj][m][0], c2 = acc[ai][bj][m][1];
                        if (isq) {
#pragma unroll
                            for (int e = 0; e < 4; ++e) { a[e] = siluf_(a[e]) * 0.08838834764831845f; c2[e] = siluf_(c2[e]) * 0.08838834764831845f; } }
                        *(u32x4*)(rowp + 32 * bj) = pack8(a, c2); }
                }
        }
    }
};

struct EpiGates {
    static constexpr bool PERM = false, AFTER_DRAIN = false;
    bf16_t *oB, *oC, *G; const float* bias;
    __device__ __forceinline__ void operator()(const acc_t& acc, const pg8::Unit& u, int wr, int wc, int fr, int fq) const {
        const int R0 = u.pm * 256 + wr * 64 + fr;
        if (u.pn < 8) {
            bf16_t* o = (u.pn < 4 ? oB : oC) + 256 * (u.pn & 3) + 64 * wc + 8 * fq + (size_t)R0 * 1024;
            u32x4 wv[2][4][2];
#pragma unroll
            for (int ai = 0; ai < 2; ++ai)
#pragma unroll
                for (int m = 0; m < 4; ++m)
#pragma unroll
                    for (int bj = 0; bj < 2; ++bj) wv[ai][m][bj] = *(const u32x4*)(o + (size_t)(ai * 128 + m * 16) * 1024 + 32 * bj);
#pragma unroll
            for (int ai = 0; ai < 2; ++ai)
#pragma unroll
                for (int m = 0; m < 4; ++m) { bf16_t* rowp = o + (size_t)(ai * 128 + m * 16) * 1024;
#pragma unroll
                    for (int bj = 0; bj < 2; ++bj) { const u32x4 w = wv[ai][m][bj]; const f32x4 a = acc[ai][bj][m][0], c = acc[ai][bj][m][1];
                        const f32x4 r0 = {bflo(w.x) * siluf_(a[0]), bfhi(w.x) * siluf_(a[1]), bflo(w.y) * siluf_(a[2]), bfhi(w.y) * siluf_(a[3])};
                        const f32x4 r1 = {bflo(w.z) * siluf_(c[0]), bfhi(w.z) * siluf_(c[1]), bflo(w.w) * siluf_(c[2]), bfhi(w.w) * siluf_(c[3])};
                        *(u32x4*)(rowp + 32 * bj) = pack8(r0, r1); } }
        } else {
            const int t = u.pn - 8, n = t >> 3, c0 = 256 * (t & 7) + 64 * wc + 8 * fq;
            const float* bp = bias + n * D + c0; bf16_t* Gn = G + (size_t)n * MR * D + c0;
            f32x4 bv[2][2];
#pragma unroll
            for (int bj = 0; bj < 2; ++bj)
#pragma unroll
                for (int k = 0; k < 2; ++k) bv[bj][k] = *(const f32x4*)(bp + 32 * bj + 4 * k);
#pragma unroll
            for (int ai = 0; ai < 2; ++ai)
#pragma unroll
                for (int m = 0; m < 4; ++m) { bf16_t* rowp = Gn + (size_t)(R0 + ai * 128 + m * 16) * D;
#pragma unroll
                    for (int bj = 0; bj < 2; ++bj) { f32x4 a = acc[ai][bj][m][0] + bv[bj][0], c = acc[ai][bj][m][1] + bv[bj][1];
#pragma unroll
                        for (int e = 0; e < 4; ++e) { a[e] = fmaxf(sigmoidf_(a[e]), 7.888609052210118e-31f); c[e] = fmaxf(sigmoidf_(c[e]), 7.888609052210118e-31f); }
                        u32x4 w; w.x = cvtpk_c(a[0], a[1]); w.y = cvtpk_c(a[2], a[3]); w.z = cvtpk_c(c[0], c[1]); w.w = cvtpk_c(c[2], c[3]);
                        *(u32x4*)(rowp + 32 * bj) = w; } }
        }
    }
};
struct EpiProjAll {
    static constexpr bool PERM = false, AFTER_DRAIN = false, KEEPS_ACC = true;
    const bf16_t* G; bf16_t* y;
    __device__ __forceinline__ void operator()(acc_t& acc, const pg8::Unit& u, int wr, int wc, int fr, int fq) const {
        const int n = u.pm / NPAN, pm = u.pm - n * NPAN, pn = u.pn & 7;
        const int c0 = 256 * pn + 64 * wc + 8 * fq, R0 = pm * 256 + wr * 64 + fr;
        const bf16_t* Gn = G + (size_t)n * MR * D + (size_t)R0 * D + c0; const bf16_t* Gx = Gn + (size_t)MR * D;
        bf16_t* yp = y + (size_t)R0 * D + c0;
        u32x4 wa[4], xa[4], wb[4], xb[4];
#define PJ_LD(GW_, GX_, ai, bj) do { _Pragma("unroll") for (int m = 0; m < 4; ++m) { const size_t ro = (size_t)((ai) * 128 + m * 16) * D + 32 * (bj); GW_[m] = *(const u32x4*)(Gn + ro); GX_[m] = *(const u32x4*)(Gx + ro); } } while (0)
#define PJ_LD1(GW_, ai, bj) do { _Pragma("unroll") for (int m = 0; m < 4; ++m) { const size_t ro = (size_t)((ai) * 128 + m * 16) * D + 32 * (bj); GW_[m] = *(const u32x4*)(Gn + ro); } } while (0)
#define PJ_RATIO(GW_, GX_, ai, bj) do { _Pragma("unroll") for (int m = 0; m < 4; ++m) {                                                     \
            const float g[8] = {bflo(GW_[m].x), bfhi(GW_[m].x), bflo(GW_[m].y), bfhi(GW_[m].y), bflo(GW_[m].z), bfhi(GW_[m].z), bflo(GW_[m].w), bfhi(GW_[m].w)};            \
            const float d[8] = {bflo(GX_[m].x), bfhi(GX_[m].x), bflo(GX_[m].y), bfhi(GX_[m].y), bflo(GX_[m].z), bfhi(GX_[m].z), bflo(GX_[m].w), bfhi(GX_[m].w)};            \
            f32x4 r0 = acc[ai][bj][m][0], r1 = acc[ai][bj][m][1];                                                                                                         \
            _Pragma("unroll") for (int e = 0; e < 4; ++e) { r0[e] *= g[e] * __builtin_amdgcn_rcpf(d[e]); r1[e] *= g[4 + e] * __builtin_amdgcn_rcpf(d[4 + e]); }           \
            acc[ai][bj][m][0] = r0; acc[ai][bj][m][1] = r1; } } while (0)
#define PJ_FINAL(GW_, ai, bj) do { _Pragma("unroll") for (int m = 0; m < 4; ++m) {                                                           \
            const float g[8] = {bflo(GW_[m].x), bfhi(GW_[m].x), bflo(GW_[m].y), bfhi(GW_[m].y), bflo(GW_[m].z), bfhi(GW_[m].z), bflo(GW_[m].w), bfhi(GW_[m].w)};            \
            f32x4 r0 = acc[ai][bj][m][0], r1 = acc[ai][bj][m][1];                                                                                                         \
            _Pragma("unroll") for (int e = 0; e < 4; ++e) { r0[e] *= g[e]; r1[e] *= g[4 + e]; }                                                                           \
            *(u32x4*)(yp + (size_t)((ai) * 128 + m * 16) * D + 32 * (bj)) = pack8(r0, r1); } } while (0)
        if (n < 2) { PJ_LD(wa, xa, 0, 0); PJ_LD(wb, xb, 0, 1); PJ_RATIO(wa, xa, 0, 0); PJ_LD(wa, xa, 1, 0); PJ_RATIO(wb, xb, 0, 1); PJ_LD(wb, xb, 1, 1); PJ_RATIO(wa, xa, 1, 0); PJ_RATIO(wb, xb, 1, 1); }
        else { PJ_LD1(wa, 0, 0); PJ_LD1(wb, 0, 1); PJ_LD1(xa, 1, 0); PJ_LD1(xb, 1, 1); PJ_FINAL(wa, 0, 0); PJ_FINAL(wb, 0, 1); PJ_FINAL(xa, 1, 0); PJ_FINAL(xb, 1, 1); }
#undef PJ_LD
#undef PJ_LD1
#undef PJ_RATIO
#undef PJ_FINAL
    }
};
struct EpiRes {
    static constexpr bool PERM = false, AFTER_DRAIN = false;
    const float *srcx, *srcc; float *dstx, *dstc; const float* gate0;
    __device__ __forceinline__ void operator()(const acc_t& acc, const pg8::Unit& u, int wr, int wc, int fr, int fq) const {
        const int b = u.pm / PPB, lp = u.pm % PPB, c0 = 256 * u.pn + 64 * wc + 8 * fq, r0 = wr * 64 + fr;
        const bool isc = (lp == PPB - 1);
        const size_t rb = isc ? (size_t)(b * LC) : (size_t)(b * T + lp * 256);
        const float* s = (isc ? srcc : srcx) + (rb + r0) * D + c0; float* d = (isc ? dstc : dstx) + (rb + r0) * D + c0;
        const float* gp = gate0 + (size_t)(isc ? 2 : b) * 6 * D + c0;
        f32x4 gv[2][2];
#pragma unroll
        for (int bj = 0; bj < 2; ++bj)
#pragma unroll
            for (int n = 0; n < 2; ++n) gv[bj][n] = *(const f32x4*)(gp + 32 * bj + 4 * n);
        f32x4 sa[4][2], sb[4][2];
#define RES_LD(buf, ai, bj) do { _Pragma("unroll") for (int m = 0; m < 4; ++m) _Pragma("unroll") for (int n = 0; n < 2; ++n) buf[m][n] = *(const f32x4*)(s + (size_t)((ai) * 128 + m * 16) * D + 32 * (bj) + 4 * n); } while (0)
#define RES_ST(buf, ai, bj) do { _Pragma("unroll") for (int m = 0; m < 4; ++m) _Pragma("unroll") for (int n = 0; n < 2; ++n) *(f32x4*)(d + (size_t)((ai) * 128 + m * 16) * D + 32 * (bj) + 4 * n) = buf[m][n] + gv[bj][n] * acc[ai][bj][m][n]; } while (0)
        RES_LD(sa, 0, 0); RES_LD(sb, 0, 1); RES_ST(sa, 0, 0); RES_LD(sa, 1, 0); RES_ST(sb, 0, 1); RES_LD(sb, 1, 1); RES_ST(sa, 1, 0); RES_ST(sb, 1, 1);
#undef RES_LD
#undef RES_ST
    }
};
__device__ __forceinline__ float dpp_up1(float cur, float prev) {
    const int old = __builtin_amdgcn_mov_dpp(__float_as_int(prev), 0x121  , 0xf, 0xf, false);
    return __int_as_float(__builtin_amdgcn_update_dpp(old, __float_as_int(cur), 0x111  , 0xf, 0xf, false));
}
__device__ __forceinline__ float dpp_dn1(float cur, float next) {
    const int old = __builtin_amdgcn_mov_dpp(__float_as_int(next), 0x12F  , 0xf, 0xf, false);
    return __int_as_float(__builtin_amdgcn_update_dpp(old, __float_as_int(cur), 0x101  , 0xf, 0xf, false));
}
struct EpiConv {
    static constexpr bool PERM = false, AFTER_DRAIN = false;
    bf16_t* g; float* raw; const float* cw; const float* cb;
    __device__ __forceinline__ void operator()(const acc_t& acc, const pg8::Unit& u, int wr, int wc, int fr, int fq) const {
        const int jc = 128 * u.pn + 32 * wc + 8 * fq, R0 = u.pm * 256 + wr * 64 + fr;
        u32x2 keep[2][4];
        f32x4 cwv[2][8];
#pragma unroll
        for (int n = 0; n < 2; ++n) { const int j = jc + 4 * n;
            cwv[n][0] = *(const f32x4*)(cw + j); cwv[n][1] = *(const f32x4*)(cw + NUP + j); cwv[n][2] = *(const f32x4*)(cw + 2 * NUP + j); cwv[n][3] = *(const f32x4*)(cb + j);
            cwv[n][4] = *(const f32x4*)(cw + DFF + j); cwv[n][5] = *(const f32x4*)(cw + NUP + DFF + j); cwv[n][6] = *(const f32x4*)(cw + 2 * NUP + DFF + j); cwv[n][7] = *(const f32x4*)(cb + DFF + j); }
        const float m0 = (fr == 0) ? 1.0f : 0.0f, m15 = (fr == 15) ? 1.0f : 0.0f;
#define FMAC_DPP(y, x, w, CTRL) asm("v_fmac_f32_dpp %0, %1, %2 " CTRL " row_mask:0xf bank_mask:0xf bound_ctrl:1" : "+v"(y) : "v"(x), "v"(w))
#pragma unroll
        for (int n = 0; n < 2; ++n) {
            const int j = jc + 4 * n;
            const f32x4 wg0 = cwv[n][0], wg1 = cwv[n][1], wg2 = cwv[n][2], bg = cwv[n][3];
            const f32x4 wu0 = cwv[n][4], wu1 = cwv[n][5], wu2 = cwv[n][6], bu = cwv[n][7];
            const f32x4 wg0e = wg0 * m0, wg2e = wg2 * m15, wu0e = wu0 * m0, wu2e = wu2 * m15;
#pragma unroll
            for (int ai = 0; ai < 2; ++ai)
#pragma unroll
                for (int m = 0; m < 4; ++m) {
                    const f32x4 xg = acc[ai][0][m][n], xu = acc[ai][1][m][n];
                    const f32x4 pg = acc[ai][0][m > 0 ? m - 1 : 0][n], ng = acc[ai][0][m < 3 ? m + 1 : 3][n], pu = acc[ai][1][m > 0 ? m - 1 : 0][n], nu = acc[ai][1][m < 3 ? m + 1 : 3][n];
                    f32x4 yg, yu;
#pragma unroll
                    for (int e = 0; e < 4; ++e) {
                        float g_ = wg1[e] * xg[e] + bg[e], u_ = wu1[e] * xu[e] + bu[e];
                        { const float a0 = xg[e], a1 = pg[e], a2 = ng[e], c0 = wg0[e], c1 = wg0e[e], c2 = wg2[e], c3 = wg2e[e];
                          FMAC_DPP(g_, a0, c0, "row_shr:1"); FMAC_DPP(g_, a1, c1, "row_mirror"); FMAC_DPP(g_, a0, c2, "row_shl:1"); FMAC_DPP(g_, a2, c3, "row_mirror"); }
                        { const float a0 = xu[e], a1 = pu[e], a2 = nu[e], c0 = wu0[e], c1 = wu0e[e], c2 = wu2[e], c3 = wu2e[e];
                          FMAC_DPP(u_, a0, c0, "row_shr:1"); FMAC_DPP(u_, a1, c1, "row_mirror"); FMAC_DPP(u_, a0, c2, "row_shl:1"); FMAC_DPP(u_, a2, c3, "row_mirror"); }
                        yg[e] = g_; yu[e] = u_;
                    }
                    f32x4 r;
#pragma unroll
                    for (int e = 0; e < 4; ++e) r[e] = siluf_(yg[e]) * yu[e];
                    u32x2 pk; pk.x = cvtpk(r[0], r[1]); pk.y = cvtpk(r[2], r[3]);
                    if (n == 0) keep[ai][m] = pk;
                    else { u32x4 w; w.x = keep[ai][m].x; w.y = keep[ai][m].y; w.z = pk.x; w.w = pk.y; *(u32x4*)(g + (size_t)(R0 + ai * 128 + m * 16) * DFF + jc) = w; }
                    if ((m == 0 && fr < 2) || (m == 3 && fr >= 14)) {
                        const int slot = (m == 0) ? fr : fr - 12; float* rp = raw + ((size_t)(u.pm * 4 + ai * 2 + wr) * 4 + slot) * NUP + j;
                        *(f32x4*)(rp) = xg; *(f32x4*)(rp + DFF) = xu;
                    }
                }
        }
#undef FMAC_DPP
    }
};

namespace att {
constexpr int KVBLK = 64;
constexpr int SHM_V = 64 * 128 * 2, SHM_K = 64 * 64 * 2;
#define KSWZ64(row, colB) ((row) * 128 + ((colB) ^ ((((row) >> 1) & 7) << 4)))
#define SBAR() __builtin_amdgcn_sched_barrier(0)
__device__ __forceinline__ int crow(int r, int hi) { return (r & 3) + 8 * (r >> 2) + 4 * hi; }
template <int SK = 0> __device__ __forceinline__ void exp16(f32x16& p) {
    if (SK & 1) return;
#pragma unroll
    for (int r = 0; r < 16; ++r) p[r] = __builtin_amdgcn_exp2f(p[r]);
}
template <int BASE> __device__ __forceinline__ void exp8(f32x16& p) {
    float e[8];
#pragma unroll
    for (int r = 0; r < 8; ++r) e[r] = __builtin_amdgcn_exp2f(p[BASE + r]);
    asm volatile("" : "+v"(e[0]), "+v"(e[1]), "+v"(e[2]), "+v"(e[3]), "+v"(e[4]), "+v"(e[5]), "+v"(e[6]), "+v"(e[7]));
#pragma unroll
    for (int r = 0; r < 8; ++r) p[BASE + r] = e[r];
}
template <int SK = 0> __device__ __forceinline__ void finishSM(f32x16& p0, f32x16& p1, float& lsum, bf16x8& pa0, bf16x8& pa1, bf16x8& pa2, bf16x8& pa3) {
    if (SK & 8) { lsum += p0[0] + p1[0]; const unsigned c_ = cvtpk(p0[1], p1[1]); u32x4 w_ = {c_, c_, c_, c_}; pa0 = pa1 = pa2 = pa3 = *reinterpret_cast<bf16x8*>(&w_); return; }
    float ps = 0;
#pragma unroll
    for (int r = 0; r < 16; ++r) ps += p0[r];
#pragma unroll
    for (int r = 0; r < 16; ++r) ps += p1[r];
    lsum += ps;
#define PK4(P, BASE, OUT) do { unsigned a0 = cvtpk(P[BASE + 0], P[BASE + 1]), a1 = cvtpk(P[BASE + 2], P[BASE + 3]);   \
    unsigned b0 = cvtpk(P[BASE + 4], P[BASE + 5]), b1 = cvtpk(P[BASE + 6], P[BASE + 7]);                              \
    auto r0 = __builtin_amdgcn_permlane32_swap(a0, b0, false, false); auto r1 = __builtin_amdgcn_permlane32_swap(a1, b1, false, false); \
    u32x4 w = {r0[0], r1[0], r0[1], r1[1]}; OUT = *reinterpret_cast<bf16x8*>(&w); } while (0)
    PK4(p0, 0, pa0); PK4(p0, 8, pa1); PK4(p1, 0, pa2); PK4(p1, 8, pa3);
#undef PK4
}
template <int SK = 0> __device__ __forceinline__ void qkt(f32x16& p0, f32x16& p1, const LAS char* Ks, const bf16x8* qr, int r32, int hi, float negM) {
#pragma unroll
    for (int r = 0; r < 16; ++r) { p0[r] = 0.f; p1[r] = 0.f; }
    if (SK & 4) return;
#pragma unroll
    for (int d0 = 0; d0 < 4; ++d0) { const int cb = (d0 * 16 + hi * 8) * 2;
        const bf16x8 b0 = *(const LAS bf16x8*)(Ks + KSWZ64(r32, cb));
        const bf16x8 b1 = *(const LAS bf16x8*)(Ks + KSWZ64(32 + r32, cb));
        p0 = __builtin_amdgcn_mfma_f32_32x32x16_bf16(b0, qr[d0], p0, 0, 0, 0);
        p1 = __builtin_amdgcn_mfma_f32_32x32x16_bf16(b1, qr[d0], p1, 0, 0, 0); }
}
__device__ __forceinline__ int v_st(int k, int c) { const int kk = (k & ~0xC) | ((k & 4) << 1) | ((k & 8) >> 1); return ((kk >> 3) * 4 + (c >> 5)) * 512 + ((kk & 7) * 32 + (c & 31)) * 2; }
__device__ __forceinline__ int v_rd_base(int lane) { return ((lane & 3) << 3) | (((lane >> 2) & 3) << 6) | (((lane >> 4) & 1) << 5) | (((lane >> 5) & 1) << 8); }
constexpr int v_rd_off(int d0, int ks, int half) { return d0 * 512 + ks * 4096 + half * 2048; }
template <int OFF> __device__ __forceinline__ s16x4 tr_read(int vb) {
  s16x4 r; asm volatile("ds_read_b64_tr_b16 %0, %1 offset:%2" : "=&v"(r) : "v"(vb), "i"(OFF) : "memory"); return r;
}
template <int D0> __device__ __forceinline__ void pv_one(f32x16& od, int vb, bf16x8 pa0, bf16x8 pa1, bf16x8 pa2, bf16x8 pa3) {
  const s16x4 l0 = tr_read<v_rd_off(D0, 0, 0)>(vb), h0 = tr_read<v_rd_off(D0, 0, 1)>(vb), l1 = tr_read<v_rd_off(D0, 1, 0)>(vb), h1 = tr_read<v_rd_off(D0, 1, 1)>(vb);
  const s16x4 l2 = tr_read<v_rd_off(D0, 2, 0)>(vb), h2 = tr_read<v_rd_off(D0, 2, 1)>(vb), l3 = tr_read<v_rd_off(D0, 3, 0)>(vb), h3 = tr_read<v_rd_off(D0, 3, 1)>(vb);
  asm volatile("s_waitcnt lgkmcnt(0)" ::: "memory"); SBAR();
#define PK(L, H) (bf16x8){L[0], L[1], L[2], L[3], H[0], H[1], H[2], H[3]}
  od = __builtin_amdgcn_mfma_f32_32x32x16_bf16(pa0, PK(l0, h0), od, 0, 0, 0);
  od = __builtin_amdgcn_mfma_f32_32x32x16_bf16(pa1, PK(l1, h1), od, 0, 0, 0);
  od = __builtin_amdgcn_mfma_f32_32x32x16_bf16(pa2, PK(l2, h2), od, 0, 0, 0);
  od = __builtin_amdgcn_mfma_f32_32x32x16_bf16(pa3, PK(l3, h3), od, 0, 0, 0);
#undef PK
}
template <int SK = 0> __device__ __forceinline__ void pv_d0(f32x16* o, int vb, bf16x8 pa0, bf16x8 pa1, bf16x8 pa2, bf16x8 pa3) {
  if (SK & 2) { o[0][0] += __builtin_bit_cast(float, (int)pa0[0] << 16); return; }
  pv_one<0>(o[0], vb, pa0, pa1, pa2, pa3); pv_one<1>(o[1], vb, pa0, pa1, pa2, pa3); pv_one<2>(o[2], vb, pa0, pa1, pa2, pa3); pv_one<3>(o[3], vb, pa0, pa1, pa2, pa3);
}
#define ATT_WAITL(n) asm volatile("s_waitcnt lgkmcnt(" #n ")" ::: "memory")
template <int D0> __device__ __forceinline__ void readv(s16x4 (&v)[8], int vb) {
  v[0] = tr_read<v_rd_off(D0, 0, 0)>(vb); v[1] = tr_read<v_rd_off(D0, 0, 1)>(vb); v[2] = tr_read<v_rd_off(D0, 1, 0)>(vb); v[3] = tr_read<v_rd_off(D0, 1, 1)>(vb);
  v[4] = tr_read<v_rd_off(D0, 2, 0)>(vb); v[5] = tr_read<v_rd_off(D0, 2, 1)>(vb); v[6] = tr_read<v_rd_off(D0, 3, 0)>(vb); v[7] = tr_read<v_rd_off(D0, 3, 1)>(vb);
}
__device__ __forceinline__ void pvm(f32x16& od, const s16x4 (&v)[8], bf16x8 pa0, bf16x8 pa1, bf16x8 pa2, bf16x8 pa3) {
#define PK(L, H) (bf16x8){L[0], L[1], L[2], L[3], H[0], H[1], H[2], H[3]}
  od = __builtin_amdgcn_mfma_f32_32x32x16_bf16(pa0, PK(v[0], v[1]), od, 0, 0, 0);
  od = __builtin_amdgcn_mfma_f32_32x32x16_bf16(pa1, PK(v[2], v[3]), od, 0, 0, 0);
  od = __builtin_amdgcn_mfma_f32_32x32x16_bf16(pa2, PK(v[4], v[5]), od, 0, 0, 0);
  od = __builtin_amdgcn_mfma_f32_32x32x16_bf16(pa3, PK(v[6], v[7]), od, 0, 0, 0);
#undef PK
}
template <int SK, bool HASNEXT> __device__ __forceinline__ void tile_step(f32x16& pN0, f32x16& pN1, f32x16 (&o)[4], const bf16x8 (&qr)[4], float& lsum,
                                                                         const LAS char* ksn, int vbc, float negM, int r32, int hi) {
  bf16x8 kf0[4], kf1[4], pa0, pa1, pa2, pa3; s16x4 va[8], vc[8], vd[8];
  if (HASNEXT && !(SK & 4)) {
#pragma unroll
    for (int d0 = 0; d0 < 4; ++d0) { const int cb = (d0 * 16 + hi * 8) * 2; kf0[d0] = *(const LAS bf16x8*)(ksn + KSWZ64(r32, cb)); kf1[d0] = *(const LAS bf16x8*)(ksn + KSWZ64(32 + r32, cb)); }
  }
  SBAR();
  finishSM<SK>(pN0, pN1, lsum, pa0, pa1, pa2, pa3);
  SBAR();
  if (SK & 2) { o[0][0] += __builtin_bit_cast(float, (int)pa0[0] << 16); }
  else { readv<0>(va, vbc); readv<1>(vc, vbc); }
  SBAR();
  if (HASNEXT) {
#pragma unroll
    for (int r = 0; r < 16; ++r) { pN0[r] = 0.f; pN1[r] = 0.f; }
    if (!(SK & 4)) {
      if (SK & 2) ATT_WAITL(0); else ATT_WAITL(15);
      SBAR();
#pragma unroll
      for (int d0 = 0; d0 < 4; ++d0) { pN0 = __builtin_amdgcn_mfma_f32_32x32x16_bf16(kf0[d0], qr[d0], pN0, 0, 0, 0); pN1 = __builtin_amdgcn_mfma_f32_32x32x16_bf16(kf1[d0], qr[d0], pN1, 0, 0, 0); }
    }
  }
  SBAR();
  if (!(SK & 2)) {
    readv<2>(vd, vbc); SBAR(); ATT_WAITL(15); SBAR(); pvm(o[0], va, pa0, pa1, pa2, pa3); if (HASNEXT && !(SK & 1)) exp8<0>(pN0); SBAR();
    readv<3>(va, vbc); SBAR(); ATT_WAITL(15); SBAR(); pvm(o[1], vc, pa0, pa1, pa2, pa3); if (HASNEXT && !(SK & 1)) exp8<8>(pN0); SBAR();
    ATT_WAITL(8); SBAR(); pvm(o[2], vd, pa0, pa1, pa2, pa3); if (HASNEXT && !(SK & 1)) exp8<0>(pN1); SBAR();
    ATT_WAITL(0); SBAR(); pvm(o[3], va, pa0, pa1, pa2, pa3); if (HASNEXT && !(SK & 1)) exp8<8>(pN1); SBAR();
  } else if (HASNEXT && !(SK & 1)) { exp8<0>(pN0); exp8<8>(pN0); exp8<0>(pN1); exp8<8>(pN1); }
}
constexpr int SLOT = SHM_K + SHM_V, NSLOT = 4;
#define ATT_WAITV(n) asm volatile("s_waitcnt vmcnt(" #n ")" ::: "memory")
template <int SK = 0> __device__ __forceinline__ void attn_unit(const bf16_t* __restrict__ Qb, const bf16_t* __restrict__ Kh, const bf16_t* __restrict__ Vh, bf16_t* Ob, bf16_t* oAb, int second, float lam, float post,
                                                                const float* __restrict__ subln, int nkeys, float negM, LAS char* lds) {
  int tid_ = threadIdx.x; asm volatile("" : "+v"(tid_));
  const int tid = tid_, wid = __builtin_amdgcn_readfirstlane(tid >> 6), lane = tid & 63, r32 = lane & 31, hi = lane >> 5;
  LAS float* li_l = (LAS float*)(lds + NSLOT * SLOT) + wid * 64;
  float lsum = 0; f32x16 o[4];
#pragma unroll
  for (int d = 0; d < 4; ++d)
#pragma unroll
    for (int r = 0; r < 16; ++r) o[d][r] = 0.f;
  bf16x8 qr[4];
  const bf16_t* Qw = Qb + (long)(wid * 32 + r32) * 64 + hi * 8;
#pragma unroll
  for (int d0 = 0; d0 < 4; ++d0) qr[d0] = *reinterpret_cast<const bf16x8*>(Qw + d0 * 16);
  unsigned offK, offV[2];
  { const int row = 8 * wid + (lane >> 3), ch = (lane & 7) ^ ((row >> 1) & 7); offK = (unsigned)(row * 64 + ch * 8); }
#pragma unroll
  for (int i = 0; i < 2; ++i) { const int piece = wid + 8 * i, sub = piece * 2 + (lane >> 5), kk = (sub >> 2) * 8 + ((lane & 31) >> 2), k = (kk & ~0xC) | ((kk & 4) << 1) | ((kk & 8) >> 1), c = (sub & 3) * 32 + 8 * (lane & 3);
      offV[i] = (unsigned)(k * 128 + c); }
  const int vbase = (int)(uintptr_t)lds + SHM_K + v_rd_base(lane);
#define ISSUE(t) do { const int s_ = (t) & (NSLOT - 1); const long k0_ = (long)(t) * KVBLK; \
    __builtin_amdgcn_global_load_lds((const unsigned*)(Kh + k0_ * 64 + offK), (LAS unsigned*)(lds + s_ * SLOT + wid * 1024), 16, 0, 0); \
    __builtin_amdgcn_global_load_lds((const unsigned*)(Vh + k0_ * 128 + offV[0]), (LAS unsigned*)(lds + s_ * SLOT + SHM_K + wid * 1024), 16, 0, 0); \
    __builtin_amdgcn_global_load_lds((const unsigned*)(Vh + k0_ * 128 + offV[1]), (LAS unsigned*)(lds + s_ * SLOT + SHM_K + 8192 + wid * 1024), 16, 0, 0); } while (0)
#define KS(t) (lds + ((t) & (NSLOT - 1)) * SLOT)
#define VB(t) (vbase + ((t) & (NSLOT - 1)) * SLOT)
  f32x16 pA0, pA1; const int NT = nkeys / KVBLK;
  if (wid >= 4) __builtin_amdgcn_s_setprio(1);
  ATT_WAITV(0);
  ISSUE(0); ISSUE(1); ISSUE(2);
  ATT_WAITV(6); __builtin_amdgcn_s_barrier(); asm volatile("" ::: "memory");
  qkt<SK>(pA0, pA1, KS(0), qr, r32, hi, negM); exp16<SK>(pA0); exp16<SK>(pA1);
  for (int j = 0; j + 2 < NT; ++j) {
    if (j + 2 < NT) ATT_WAITV(3); else ATT_WAITV(0);
    __builtin_amdgcn_s_barrier(); asm volatile("" ::: "memory");
    if (!(SK & 16) && j + 3 < NT) ISSUE(j + 3);
    tile_step<SK, true>(pA0, pA1, o, qr, lsum, KS(j + 1), VB(j), negM, r32, hi);
  }
  ATT_WAITV(0); __builtin_amdgcn_s_barrier(); asm volatile("" ::: "memory");
  tile_step<SK, true>(pA0, pA1, o, qr, lsum, KS(NT - 1), VB(NT - 2), negM, r32, hi);
  tile_step<SK, false>(pA0, pA1, o, qr, lsum, KS(NT - 1), VB(NT - 1), negM, r32, hi);
  { auto rr = __builtin_amdgcn_permlane32_swap(__float_as_uint(lsum), __float_as_uint(lsum), false, false); lsum = __uint_as_float(rr[0]) + __uint_as_float(rr[1]); }
  if (hi == 0) li_l[r32] = lsum; asm volatile("s_waitcnt lgkmcnt(0)" ::: "memory");
  float rli[16];
#pragma unroll
  for (int r = 0; r < 16; ++r) rli[r] = __builtin_amdgcn_rcpf(li_l[crow(r, hi)]);
  bf16_t* Ow = Ob + (long)(wid * 32) * 1024;
  if (!second) {
#pragma unroll
    for (int r = 0; r < 16; ++r) { const int orow = crow(r, hi);
#pragma unroll
      for (int d0 = 0; d0 < 4; ++d0) Ow[(long)orow * 1024 + d0 * 32 + r32] = (bf16_t)(cvtpk(o[d0][r] * rli[r], 0.f) & 0xffffu); }
  } else {
    float sl[4];
#pragma unroll
    for (int d0 = 0; d0 < 4; ++d0) sl[d0] = subln[d0 * 32 + r32];
    bf16_t* Aw = oAb + (long)(wid * 32) * 1024;
#pragma unroll
    for (int rg = 0; rg < 4; ++rg) {
      unsigned short o1[4][4];
#pragma unroll
      for (int j = 0; j < 4; ++j)
#pragma unroll
        for (int d0 = 0; d0 < 4; ++d0) o1[j][d0] = *(const unsigned short*)(Ow + (long)crow(4 * rg + j, hi) * 1024 + d0 * 32 + r32);
#pragma unroll
      for (int j = 0; j < 4; ++j) { const int r = 4 * rg + j; float dd[4], ss = 0.f;
#pragma unroll
        for (int d0 = 0; d0 < 4; ++d0) { dd[d0] = __uint_as_float((unsigned)o1[j][d0] << 16) - lam * (o[d0][r] * rli[r]); ss += dd[d0] * dd[d0]; }
        ss += __shfl_xor(ss, 1); ss += __shfl_xor(ss, 2); ss += __shfl_xor(ss, 4); ss += __shfl_xor(ss, 8); ss += __shfl_xor(ss, 16);
        const float rs = rsqrtf(ss * (1.0f / 128.0f) + EPS) * post; bf16_t* rowp = Aw + (long)crow(r, hi) * 1024;
#pragma unroll
        for (int d0 = 0; d0 < 4; ++d0) { const float y = dd[d0] * rs; rowp[d0 * 32 + r32] = (bf16_t)(cvtpk(y * sl[d0], 0.f) & 0xffffu); } }
    }
  }
  __builtin_amdgcn_s_setprio(0);
  __builtin_amdgcn_s_barrier(); asm volatile("" ::: "memory");
#undef ISSUE
#undef KS
#undef VB
#undef ITER
}
}

template <int SK = 0> __device__ __forceinline__ void attn_phase(Frame& F, int l) {
    const bf16_t* Q = WSP(bf16_t, DY_QKV); const bf16_t* K = Q + (size_t)MR * 1024; const bf16_t* V = K + (size_t)MR * 1024;
    bf16_t* O = WSP(bf16_t, DY_O1); bf16_t* oA = WSP(bf16_t, DY_OA); const float negM = 0.f;
    const float lam = WSP(float, WS_SCAL)[l]; const float post = 1.0f - (0.8f - 0.6f * expf(-0.3f * (float)l)); const float* subln = inp(F, I_SUBLN) + l * 128;
    const int NL = NB * 8 * 64, NU = NL + (l == 0 ? NB * 8 : 0);
    for (int i = 0; i * F.G < NU; ++i) {
        int u = i * F.G + F.bid;
        if (F.G == 256 && i < 4) { const int hh = i * 8 + (F.bid & 7); u = (hh >> 1) * 64 + (hh & 1) * 32 + (F.bid >> 3); }
        if (u >= NU) break;
        int p, q0, k0, nk;
        if (u < NL) { p = u / 64; q0 = (u % 64) * 256; k0 = 0; nk = TT; }
        else { p = u - NL; q0 = T; k0 = T; nk = LC; }
        const int b = p >> 3, h = p & 7;
        for (int sm = 0; sm < 2; ++sm) {
            const size_t hb = (size_t)(b * 16 + 2 * h + sm) * TT;
            att::attn_unit<SK>(Q + (hb + q0) * 64, K + (hb + k0) * 64, V + ((size_t)(b * 8 + h) * TT + k0) * 128, O + ((size_t)b * TT + q0) * 1024 + h * 128, oA + ((size_t)b * TT + q0) * 1024 + h * 128,
                               sm, lam, post, subln, nk, negM, (LAS char*)F.lds);
        }
    }
}
__device__ __forceinline__ void ffn_fixup(Frame& F, int l) {
    const float* raw = WSP(float, DY_RAW); bf16_t* g = WSP(bf16_t, DY_G);
    const float* cw = inp(F, I_CONVW) + (size_t)l * 3 * NUP; const float* cb = inp(F, I_CONVB) + (size_t)l * NUP;
    const int NBLK = MR / 64, per = DFF / 4;
    const size_t total = (size_t)NBLK * 2 * per;
    for (size_t it = (size_t)F.bid * NTHR + F.tid; it < total; it += (size_t)F.G * NTHR) {
        const int cq = (int)(it % per), rb = (int)(it / per), blk = rb >> 1, last = rb & 1, j = cq * 4;
        const int bl = blk % (TT / 64);
        const bool seq_first = (bl == 0 || bl == T / 64), seq_last = (bl == T / 64 - 1 || bl == TT / 64 - 1);
        const float* rc = raw + ((size_t)blk * 4 + (last ? 3 : 0)) * NUP;
        const float* rp = last ? raw + ((size_t)blk * 4 + 2) * NUP : raw + ((size_t)(blk - 1) * 4 + 3) * NUP;
        const float* rn = last ? raw + ((size_t)(blk + 1) * 4 + 0) * NUP : raw + ((size_t)blk * 4 + 1) * NUP;
        const bool zp = (!last && seq_first), zn = (last && seq_last);
        const f32x4 z4 = {0.f, 0.f, 0.f, 0.f};
        f32x4 v[14];
        { const float* rpp = zp ? rc : rp; const float* rnn = zn ? rc : rn;
          v[0] = *(const f32x4*)(rpp + j); v[1] = *(const f32x4*)(rpp + DFF + j); v[2] = *(const f32x4*)(rnn + j); v[3] = *(const f32x4*)(rnn + DFF + j);
          v[4] = *(const f32x4*)(rc + j); v[5] = *(const f32x4*)(rc + DFF + j);
          v[6] = *(const f32x4*)(cw + j); v[7] = *(const f32x4*)(cw + NUP + j); v[8] = *(const f32x4*)(cw + 2 * NUP + j); v[9] = *(const f32x4*)(cb + j);
          v[10] = *(const f32x4*)(cw + DFF + j); v[11] = *(const f32x4*)(cw + NUP + DFF + j); v[12] = *(const f32x4*)(cw + 2 * NUP + DFF + j); v[13] = *(const f32x4*)(cb + DFF + j); }
#pragma unroll
        for (int k = 0; k < 14; ++k) asm volatile("" : "+v"(v[k]));
        const f32x4 pg = zp ? z4 : v[0], pu = zp ? z4 : v[1], ng = zn ? z4 : v[2], nu = zn ? z4 : v[3], xg = v[4], xu = v[5];
        const f32x4 yg = v[6] * pg + v[7] * xg + v[8] * ng + v[9];
        const f32x4 yu = v[10] * pu + v[11] * xu + v[12] * nu + v[13];
        u32x2 w; w.x = cvtpk(siluf_(yg[0]) * yu[0], siluf_(yg[1]) * yu[1]); w.y = cvtpk(siluf_(yg[2]) * yu[2], siluf_(yg[3]) * yu[3]);
        *(u32x2*)(g + (size_t)(blk * 64 + (last ? 63 : 0)) * DFF + j) = w;
    }
}

namespace scn {
using att::crow; using att::v_st; using att::v_rd_base; using att::v_rd_off; using att::tr_read;
__device__ __forceinline__ int cp_of(int c, int dir) { return c == PPB - 1 ? 0 : (dir ? (PPB - 1) - c : c + 1); }
#define KSWZ256(row, colB) ((row) * 256 + ((colB) ^ (((row) & 7) << 4)))
#define PKF(L, H) (bf16x8){L[0], L[1], L[2], L[3], H[0], H[1], H[2], H[3]}
__device__ __forceinline__ u32x4 scale8(const u32x4 w, float s) { u32x4 o; o.x = cvtpk(bflo(w.x) * s, bfhi(w.x) * s); o.y = cvtpk(bflo(w.y) * s, bfhi(w.y) * s); o.z = cvtpk(bflo(w.z) * s, bfhi(w.z) * s); o.w = cvtpk(bflo(w.w) * s, bfhi(w.w) * s); return o; }
__device__ __forceinline__ float ret_lg2(int h, int dir) { const int hh = dir ? 3 - h : h; return log1pf(-exp2f(-5.0f - (float)hh)) * LOG2E; }
constexpr size_t RET_US_ELEMS = (size_t)128 * 256, HG_US_ELEMS = (size_t)128 * 128;
constexpr size_t US_RET_OFF = DY_US, US_HG_OFF = DY_US + 65 * MiB;
constexpr size_t HG_A_OFF = WS_MODP;

__device__ __forceinline__ void store_state_tile(bf16_t* us, const f32x16& a, int rb, int d0, int nd0, int c32, int hi) {
#pragma unroll
    for (int g = 0; g < 4; ++g) { const int ks = 2 * rb + (g >> 1), ln = c32 + 32 * (g & 1);
        u32x2 w; w.x = cvtpk_c(a[4 * g], a[4 * g + 1]); w.y = cvtpk_c(a[4 * g + 2], a[4 * g + 3]);
        *(u32x2*)(us + ((size_t)(ks * nd0 + d0) * 64 + ln) * 8 + 4 * hi) = w; }
}

template <int TILE, int KST> __device__ __forceinline__ void ra_step(f32x16 (&acc)[4][2], int vbK, const int (&vbV)[2]) {
    bf16x8 A[4], Bv[2];
    { const s16x4 lo = tr_read<TILE * 16384 + v_rd_off(0, KST, 0)>(vbK), h4 = tr_read<TILE * 16384 + v_rd_off(0, KST, 1)>(vbK); A[0] = PKF(lo, h4); }
    { const s16x4 lo = tr_read<TILE * 16384 + v_rd_off(1, KST, 0)>(vbK), h4 = tr_read<TILE * 16384 + v_rd_off(1, KST, 1)>(vbK); A[1] = PKF(lo, h4); }
    { const s16x4 lo = tr_read<TILE * 16384 + v_rd_off(2, KST, 0)>(vbK), h4 = tr_read<TILE * 16384 + v_rd_off(2, KST, 1)>(vbK); A[2] = PKF(lo, h4); }
    { const s16x4 lo = tr_read<TILE * 16384 + v_rd_off(3, KST, 0)>(vbK), h4 = tr_read<TILE * 16384 + v_rd_off(3, KST, 1)>(vbK); A[3] = PKF(lo, h4); }
    { const s16x4 lo = tr_read<TILE * 32768 + v_rd_off(0, KST, 0)>(vbV[0]), h4 = tr_read<TILE * 32768 + v_rd_off(0, KST, 1)>(vbV[0]); Bv[0] = PKF(lo, h4); }
    { const s16x4 lo = tr_read<TILE * 32768 + v_rd_off(0, KST, 0)>(vbV[1]), h4 = tr_read<TILE * 32768 + v_rd_off(0, KST, 1)>(vbV[1]); Bv[1] = PKF(lo, h4); }
    asm volatile("s_waitcnt lgkmcnt(0)" ::: "memory"); __builtin_amdgcn_sched_barrier(0);
#pragma unroll
    for (int rb = 0; rb < 4; ++rb)
#pragma unroll
        for (int cb = 0; cb < 2; ++cb) acc[rb][cb] = __builtin_amdgcn_mfma_f32_32x32x16_bf16(A[rb], Bv[cb], acc[rb][cb], 0, 0, 0);
}
__device__ __forceinline__ void ret_local_unit(Frame& F, int b, int h, int c) {
    const bf16_t* RK = WSP(bf16_t, DY_PB) + (size_t)MR * 512; const bf16_t* RV = RK + (size_t)MR * 512;
    const size_t hb = (size_t)(b * 4 + h) * TT + (size_t)c * 256;
    const float lgf = ret_lg2(h, 0), lgb = ret_lg2(h, 1);
    const int w = F.wave, lane = F.lane, c32 = lane & 31, hi = lane >> 5, dir = w >> 2, dvq = w & 3;
    LAS char* lds = (LAS char*)F.lds;
    f32x16 acc[4][2];
#pragma unroll
    for (int rb = 0; rb < 4; ++rb)
#pragma unroll
        for (int cb = 0; cb < 2; ++cb)
#pragma unroll
            for (int r = 0; r < 16; ++r) acc[rb][cb][r] = 0.f;
    const int vbK = (int)(uintptr_t)lds + dir * 32768 + v_rd_base(lane);
    int vbV[2];
#pragma unroll
    for (int cb = 0; cb < 2; ++cb) { const int colblk = 2 * dvq + cb; vbV[cb] = (int)(uintptr_t)lds + 65536 + (colblk >> 2) * 16384 + (colblk & 3) * 512 + v_rd_base(lane); }
    for (int hh = 0; hh < 2; ++hh) {
        __syncthreads();
        u32x4 kq[4];
#pragma unroll
        for (int i = 0; i < 4; ++i) { const int idx = i * NTHR + F.tid, row = idx >> 4, ch = idx & 15, p = 128 * hh + row; kq[i] = *(const u32x4*)(RK + (hb + p) * 128 + ch * 8); }
#pragma unroll
        for (int i = 0; i < 4; ++i) asm volatile("" : "+v"(kq[i]));
#pragma unroll
        for (int i = 0; i < 4; ++i) { const int idx = i * NTHR + F.tid, row = idx >> 4, ch = idx & 15, p = 128 * hh + row;
            const u32x4 kv = kq[i];
            const float ff = __builtin_amdgcn_exp2f(lgf * (float)(255 - p)), fb = __builtin_amdgcn_exp2f(lgb * (float)p);
            const int off = (row >> 6) * 16384 + v_st(row & 63, ch * 8);
            *(LAS u32x4*)(lds + off) = scale8(kv, ff); *(LAS u32x4*)(lds + 32768 + off) = scale8(kv, fb); }
        { u32x4 vq[8];
#pragma unroll
          for (int i = 0; i < 8; ++i) { const int idx = i * NTHR + F.tid, row = idx >> 5, col = (idx & 31) * 8, p = 128 * hh + row; vq[i] = *(const u32x4*)(RV + (hb + p) * 256 + col); }
#pragma unroll
          for (int i = 0; i < 8; ++i) asm volatile("" : "+v"(vq[i]));
#pragma unroll
          for (int i = 0; i < 8; ++i) { const int idx = i * NTHR + F.tid, row = idx >> 5, col = (idx & 31) * 8;
            *(LAS u32x4*)(lds + 65536 + ((row >> 6) * 2 + (col >> 7)) * 16384 + v_st(row & 63, col & 127)) = vq[i]; } }
        __syncthreads();
        ra_step<0, 0>(acc, vbK, vbV); ra_step<0, 1>(acc, vbK, vbV); ra_step<0, 2>(acc, vbK, vbV); ra_step<0, 3>(acc, vbK, vbV);
        ra_step<1, 0>(acc, vbK, vbV); ra_step<1, 1>(acc, vbK, vbV); ra_step<1, 2>(acc, vbK, vbV); ra_step<1, 3>(acc, vbK, vbV);
    }
    bf16_t* us = (bf16_t*)(F.ws + US_RET_OFF) + ((size_t)((b * 4 + h) * 2 + dir) * PPB + cp_of(c, dir)) * RET_US_ELEMS;
#pragma unroll
    for (int rb = 0; rb < 4; ++rb)
#pragma unroll
        for (int cb = 0; cb < 2; ++cb) store_state_tile(us, acc[rb][cb], rb, 2 * dvq + cb, 8, c32, hi);
}

__device__ __forceinline__ void scan_states(Frame& F, bool do_ret, bool do_hg) {
  for (int gt = F.bid * NTHR + F.tid; gt < 131072; gt += F.G * NTHR) {
    if (gt < 65536) {
        if (!do_ret) continue;
        const int seq = gt >> 12, vec = gt & 4095, dir = seq & 1, h = (seq >> 1) & 3;
        const float g = exp2f(ret_lg2(h, dir) * 256.0f);
        u32x4* p = (u32x4*)(F.ws + US_RET_OFF) + (size_t)seq * PPB * 4096 + vec;
        float S[8];
#pragma unroll
        for (int e = 0; e < 8; ++e) S[e] = 0.f;
        for (int cp0 = 0; cp0 < PPB; cp0 += 13) {
            u32x4 ub[13];
#pragma unroll
            for (int k = 0; k < 13; ++k) ub[k] = p[(size_t)(cp0 + k) * 4096];
#pragma unroll
            for (int k = 0; k < 13; ++k) { const u32x4 u = ub[k];
                u32x4 o; o.x = cvtpk(S[0], S[1]); o.y = cvtpk(S[2], S[3]); o.z = cvtpk(S[4], S[5]); o.w = cvtpk(S[6], S[7]); p[(size_t)(cp0 + k) * 4096] = o;
                S[0] = g * S[0] + bflo(u.x); S[1] = g * S[1] + bfhi(u.x); S[2] = g * S[2] + bflo(u.y); S[3] = g * S[3] + bfhi(u.y);
                S[4] = g * S[4] + bflo(u.z); S[5] = g * S[5] + bfhi(u.z); S[6] = g * S[6] + bflo(u.w); S[7] = g * S[7] + bfhi(u.w); } }
    } else {
        if (!do_hg) continue;
        const int gv = gt - 65536, seq = gv >> 11, vec = gv & 2047;
        const int ks = vec >> 8, hi = (vec >> 5) & 1, dk0 = 16 * ks + 8 * hi;
        u32x4* p = (u32x4*)(F.ws + US_HG_OFF) + (size_t)seq * PPB * 2048 + vec;
        const f32x4* ap = (const f32x4*)((const float*)(F.ws + HG_A_OFF) + (size_t)seq * PPB * 128 + dk0);
        float S[8];
#pragma unroll
        for (int e = 0; e < 8; ++e) S[e] = 0.f;
        for (int cp0 = 0; cp0 < PPB; cp0 += 5) {
            u32x4 ub[5]; f32x4 a0b[5], a1b[5];
#pragma unroll
            for (int k = 0; k < 5; ++k) { ub[k] = p[(size_t)(cp0 + k) * 2048]; a0b[k] = ap[(cp0 + k) * 32]; a1b[k] = ap[(cp0 + k) * 32 + 1]; }
#pragma unroll
            for (int k = 0; k < 5; ++k) { const u32x4 u = ub[k]; const f32x4 a0 = a0b[k], a1 = a1b[k];
                u32x4 o; o.x = cvtpk(S[0], S[1]); o.y = cvtpk(S[2], S[3]); o.z = cvtpk(S[4], S[5]); o.w = cvtpk(S[6], S[7]); p[(size_t)(cp0 + k) * 2048] = o;
                S[0] = a0[0] * S[0] + bflo(u.x); S[1] = a0[1] * S[1] + bfhi(u.x); S[2] = a0[2] * S[2] + bflo(u.y); S[3] = a0[3] * S[3] + bfhi(u.y);
                S[4] = a1[0] * S[4] + bflo(u.z); S[5] = a1[1] * S[5] + bfhi(u.z); S[6] = a1[2] * S[6] + bflo(u.w); S[7] = a1[3] * S[7] + bfhi(u.w); } }
    }
  }
}

__device__ __forceinline__ void ret_out_unit(Frame& F, int l, int b, int h, int c) {
    const bf16_t* RQ = WSP(bf16_t, DY_PB); const bf16_t* RK = RQ + (size_t)MR * 512; const bf16_t* RV = RK + (size_t)MR * 512;
    const size_t hb = (size_t)(b * 4 + h) * TT + (size_t)c * 256;
    const float lgf = ret_lg2(h, 0), lgb = ret_lg2(h, 1);
    const int w = F.wave, lane = F.lane, r32 = lane & 31, hi = lane >> 5, irow = 32 * w + r32;
    LAS char* lds = (LAS char*)F.lds;
    bf16x8 qr[8];
#pragma unroll
    for (int d0 = 0; d0 < 8; ++d0) qr[d0] = *(const bf16x8*)(RQ + (hb + irow) * 128 + d0 * 16 + hi * 8);
    const int vb = (int)(uintptr_t)lds + 16384 + v_rd_base(lane);
    unsigned okk[2], ovv[2];
#pragma unroll
    for (int i = 0; i < 2; ++i) { const int P = w + 8 * i, row = 4 * P + (lane >> 4), ch = (lane & 15) ^ (row & 7); okk[i] = (unsigned)(row * 128 + ch * 8);
        const int sub = P * 2 + (lane >> 5), kk = (sub >> 2) * 8 + ((lane & 31) >> 2), k = (kk & ~0xC) | ((kk & 4) << 1) | ((kk & 8) >> 1), c = (sub & 3) * 32 + 8 * (lane & 3); ovv[i] = (unsigned)(k * 256 + c); }
    float ssq[16]; LAS unsigned* keep = (LAS unsigned*)(lds + 65536 + w * 8192) + lane;
#pragma unroll
    for (int r = 0; r < 16; ++r) ssq[r] = 0.f;
    f32x16 o[4];
#pragma unroll 1
    for (int half = 0; half < 2; ++half) {
#pragma unroll
        for (int d = 0; d < 4; ++d)
#pragma unroll
            for (int r = 0; r < 16; ++r) o[d][r] = 0.f;
#define RSC_ISSUE(J_, buf_) do { const size_t kb_ = (hb + 64 * (J_)) * 128, vbs_ = (hb + 64 * (J_)) * 256 + half * 128; \
            __builtin_amdgcn_global_load_lds((const unsigned*)(RK + kb_ + okk[0]), (LAS unsigned*)(lds + (buf_) * 32768 + w * 1024), 16, 0, 0); \
            __builtin_amdgcn_global_load_lds((const unsigned*)(RK + kb_ + okk[1]), (LAS unsigned*)(lds + (buf_) * 32768 + (w + 8) * 1024), 16, 0, 0); \
            __builtin_amdgcn_global_load_lds((const unsigned*)(RV + vbs_ + ovv[0]), (LAS unsigned*)(lds + (buf_) * 32768 + 16384 + w * 1024), 16, 0, 0); \
            __builtin_amdgcn_global_load_lds((const unsigned*)(RV + vbs_ + ovv[1]), (LAS unsigned*)(lds + (buf_) * 32768 + 16384 + (w + 8) * 1024), 16, 0, 0); } while (0)
        asm volatile("s_waitcnt vmcnt(0)" ::: "memory");
        RSC_ISSUE(0, 0);
#pragma unroll 1
        for (int J = 0; J < 4; ++J) {
            const int buf = J & 1;
            asm volatile("s_waitcnt lgkmcnt(0)" ::: "memory"); __builtin_amdgcn_s_barrier(); asm volatile("" ::: "memory");
            if (J < 3) { RSC_ISSUE(J + 1, buf ^ 1); asm volatile("s_waitcnt vmcnt(4)" ::: "memory"); } else asm volatile("s_waitcnt vmcnt(0)" ::: "memory");
            __builtin_amdgcn_s_barrier(); asm volatile("" ::: "memory");
            LAS char* kb = lds + buf * 32768; const int vbj = vb + buf * 32768;
            f32x16 p0, p1;
#pragma unroll
            for (int r = 0; r < 16; ++r) { p0[r] = 0.f; p1[r] = 0.f; }
#pragma unroll
            for (int d0 = 0; d0 < 8; ++d0) { const int cb = (d0 * 16 + hi * 8) * 2;
                const bf16x8 b0 = *(const LAS bf16x8*)(kb + KSWZ256(r32, cb)), b1 = *(const LAS bf16x8*)(kb + KSWZ256(32 + r32, cb));
                p0 = __builtin_amdgcn_mfma_f32_32x32x16_bf16(b0, qr[d0], p0, 0, 0, 0); p1 = __builtin_amdgcn_mfma_f32_32x32x16_bf16(b1, qr[d0], p1, 0, 0, 0); }
#pragma unroll
            for (int r = 0; r < 16; ++r) { const int d0i = irow - (64 * J + crow(r, hi)), d1i = d0i - 32;
                const float e0 = d0i >= 0 ? lgf * (float)d0i : -lgb * (float)d0i, e1 = d1i >= 0 ? lgf * (float)d1i : -lgb * (float)d1i;
                float m0 = __builtin_amdgcn_exp2f(e0), m1 = __builtin_amdgcn_exp2f(e1); if (d0i == 0) m0 = 2.0f; if (d1i == 0) m1 = 2.0f;
                p0[r] *= m0; p1[r] *= m1; }
            bf16x8 pa0, pa1, pa2, pa3;
#define PK4(P, BASE, OUT) do { unsigned a0 = cvtpk(P[BASE + 0], P[BASE + 1]), a1 = cvtpk(P[BASE + 2], P[BASE + 3]);   \
    unsigned b0_ = cvtpk(P[BASE + 4], P[BASE + 5]), b1_ = cvtpk(P[BASE + 6], P[BASE + 7]);                              \
    auto r0 = __builtin_amdgcn_permlane32_swap(a0, b0_, false, false); auto r1 = __builtin_amdgcn_permlane32_swap(a1, b1_, false, false); \
    u32x4 w_ = {r0[0], r1[0], r0[1], r1[1]}; OUT = *reinterpret_cast<bf16x8*>(&w_); } while (0)
            PK4(p0, 0, pa0); PK4(p0, 8, pa1); PK4(p1, 0, pa2); PK4(p1, 8, pa3);
            att::pv_d0(o, vbj, pa0, pa1, pa2, pa3);
        }
#undef RSC_ISSUE
#pragma unroll 1
        for (int dir = 0; dir < 2; ++dir) {
            const float sc = dir ? __builtin_amdgcn_exp2f(lgb * (float)(256 - irow)) : __builtin_amdgcn_exp2f(lgf * (float)(irow + 1));
            const bf16_t* us = (const bf16_t*)(F.ws + US_RET_OFF) + ((size_t)((b * 4 + h) * 2 + dir) * PPB + cp_of(c, dir)) * RET_US_ELEMS;
            __syncthreads();
#pragma unroll
            for (int i = 0; i < 4; ++i) { const int idx = i * NTHR + F.tid, fr_ = idx >> 6, ln = idx & 63, ks = fr_ >> 2, d0 = fr_ & 3;
                *(LAS u32x4*)(lds + 32768 + idx * 16) = *(const u32x4*)(us + ((size_t)(ks * 8 + half * 4 + d0) * 64 + ln) * 8); }
            __syncthreads();
#pragma unroll
            for (int ks = 0; ks < 8; ++ks) { const u32x4 qs = scale8(*reinterpret_cast<const u32x4*>(&qr[ks]), sc); const bf16x8 qa = *reinterpret_cast<const bf16x8*>(&qs);
#pragma unroll
                for (int d0 = 0; d0 < 4; ++d0) { const bf16x8 sf = *(const LAS bf16x8*)(lds + 32768 + ((ks * 4 + d0) * 64 + lane) * 16);
                    o[d0] = __builtin_amdgcn_mfma_f32_32x32x16_bf16(qa, sf, o[d0], 0, 0, 0); } }
        }
#pragma unroll
        for (int d0 = 0; d0 < 4; ++d0)
#pragma unroll
            for (int r = 0; r < 16; ++r) ssq[r] += o[d0][r] * o[d0][r];
        if (half == 0) {
#pragma unroll
            for (int d0 = 0; d0 < 4; ++d0)
#pragma unroll
                for (int r = 0; r < 8; ++r) keep[(d0 * 8 + r) * 64] = cvtpk_c(o[d0][2 * r], o[d0][2 * r + 1]);
        }
    }
    const float* rn = inp(F, I_RNORM) + l * 256;
    bf16_t* ob = WSP(bf16_t, DY_OB) + ((size_t)b * TT + (size_t)c * 256 + 32 * w) * 1024 + h * 256 + r32;
    float wn[8];
#pragma unroll
    for (int j = 0; j < 8; ++j) wn[j] = rn[32 * j + r32];
#pragma unroll
    for (int r = 0; r < 16; ++r) { float s = ssq[r];
        s += __shfl_xor(s, 1); s += __shfl_xor(s, 2); s += __shfl_xor(s, 4); s += __shfl_xor(s, 8); s += __shfl_xor(s, 16);
        const float rs = rsqrtf(s * (1.0f / 256.0f) + EPS); bf16_t* rowp = ob + (size_t)crow(r, hi) * 1024;
#pragma unroll
        for (int d0 = 0; d0 < 4; ++d0) { const unsigned pw = keep[(d0 * 8 + (r >> 1)) * 64]; const float v0 = (r & 1) ? bfhi(pw) : bflo(pw);
            rowp[32 * d0] = (bf16_t)(cvtpk(v0 * rs * wn[d0], 0.f) & 0xffffu);
            rowp[128 + 32 * d0] = (bf16_t)(cvtpk(o[d0][r] * rs * wn[4 + d0], 0.f) & 0xffffu); } }
    __syncthreads();
#undef PK4
}
}


namespace hgm {
using att::crow; using att::v_st; using att::v_rd_base; using att::v_rd_off; using att::tr_read;
constexpr int TTAB_OFF = RING_BYTES + 1024;
__device__ __forceinline__ float dpp_shr0(float v, int) { return v; }
template <int CTRL> __device__ __forceinline__ float dppz(float v) { return __int_as_float(__builtin_amdgcn_update_dpp(0, __float_as_int(v), CTRL, 0xf, 0xf, true)); }
template <bool REV> __device__ __forceinline__ void scan32x8(float (&v)[8], int lane, float (&tot)[8]) {
#pragma unroll
    for (int e = 0; e < 8; ++e) v[e] += REV ? dppz<0x101>(v[e]) : dppz<0x111>(v[e]);
#pragma unroll
    for (int e = 0; e < 8; ++e) v[e] += REV ? dppz<0x102>(v[e]) : dppz<0x112>(v[e]);
#pragma unroll
    for (int e = 0; e < 8; ++e) v[e] += REV ? dppz<0x104>(v[e]) : dppz<0x114>(v[e]);
#pragma unroll
    for (int e = 0; e < 8; ++e) v[e] += REV ? dppz<0x108>(v[e]) : dppz<0x118>(v[e]);
    const bool up = (lane & 32) != 0, addrow = REV ? ((lane & 16) == 0) : ((lane & 16) != 0);
    float cr[8];
#pragma unroll
    for (int e = 0; e < 8; ++e) { const float t0 = __int_as_float(__builtin_amdgcn_readlane(__float_as_int(v[e]), REV ? 16 : 15)), t1 = __int_as_float(__builtin_amdgcn_readlane(__float_as_int(v[e]), REV ? 48 : 47)); cr[e] = up ? t1 : t0; }
#pragma unroll
    for (int e = 0; e < 8; ++e) v[e] += addrow ? cr[e] : 0.f;
#pragma unroll
    for (int e = 0; e < 8; ++e) { const float t0 = __int_as_float(__builtin_amdgcn_readlane(__float_as_int(v[e]), REV ? 0 : 31)), t1 = __int_as_float(__builtin_amdgcn_readlane(__float_as_int(v[e]), REV ? 32 : 63)); tot[e] = up ? t1 : t0; }
}
constexpr int LBT_OFF = TTAB_OFF + 4096 + 4608;
template <bool REV, int LAYOUT> __device__ __forceinline__ void prep(const bf16_t* zrow, const LAS float* lbl, int lane, LAS float* ttab_w, float (&E)[64], LAS char* lds, int row) {
    const int hi = lane >> 5;
    u32x4 zw[8];
#pragma unroll
    for (int d0 = 0; d0 < 8; ++d0) zw[d0] = *(const u32x4*)(zrow + 16 * d0);
#pragma unroll
    for (int d0 = 0; d0 < 8; ++d0) {
        const f32x4 l0 = *(const LAS f32x4*)(lbl + 16 * d0), l1 = *(const LAS f32x4*)(lbl + 16 * d0 + 4);
        const float z[8] = {bflo(zw[d0].x), bfhi(zw[d0].x), bflo(zw[d0].y), bfhi(zw[d0].y), bflo(zw[d0].z), bfhi(zw[d0].z), bflo(zw[d0].w), bfhi(zw[d0].w)};
        const float lb[8] = {l0[0], l0[1], l0[2], l0[3], l1[0], l1[1], l1[2], l1[3]};
        float kk[8], Bv[8], tot[8];
#pragma unroll
        for (int e = 0; e < 8; ++e) { const float sg = sigmoidf_(z[e]); const float f = fmaxf(lb[e] + (1.0f - lb[e]) * sg, 1e-20f); Bv[e] = __builtin_amdgcn_logf(f); kk[e] = (1.0f - lb[e]) * (1.0f - sg); }
        scan32x8<REV>(Bv, lane, tot);
        float kv[8];
#pragma unroll
        for (int e = 0; e < 8; ++e) { const float ee = Bv[e] - tot[e]; E[d0 * 8 + e] = ee; kv[e] = kk[e] * __builtin_amdgcn_exp2f(-ee); }
        if ((lane & 31) == 0) { *(LAS f32x4*)(ttab_w + 16 * d0 + 8 * hi) = (f32x4){tot[0], tot[1], tot[2], tot[3]}; *(LAS f32x4*)(ttab_w + 16 * d0 + 8 * hi + 4) = (f32x4){tot[4], tot[5], tot[6], tot[7]}; }
        u32x4 kh; kh.x = cvtpk(kv[0], kv[1]); kh.y = cvtpk(kv[2], kv[3]); kh.z = cvtpk(kv[4], kv[5]); kh.w = cvtpk(kv[6], kv[7]);
        if (LAYOUT == 0) *(LAS u32x4*)(lds + KSWZ256(row, (16 * d0 + 8 * hi) * 2)) = kh;
        else *(LAS u32x4*)(lds + (row >> 6) * 16384 + v_st(row & 63, 16 * d0 + 8 * hi)) = kh;
        __builtin_amdgcn_sched_barrier(0);
    }
}
template <bool REV> __device__ __forceinline__ void prep_roll(const bf16_t* zrow, const LAS float* lbl, int lane, LAS float* ttab_w, LAS char* lds, int row) {
    const int hi = lane >> 5;
    u32x4 zn = *(const u32x4*)(zrow);
#pragma unroll 1
    for (int d0 = 0; d0 < 8; ++d0) {
        const u32x4 zc = zn; if (d0 < 7) zn = *(const u32x4*)(zrow + 16 * (d0 + 1));
        const f32x4 l0 = *(const LAS f32x4*)(lbl + 16 * d0), l1 = *(const LAS f32x4*)(lbl + 16 * d0 + 4);
        const float z[8] = {bflo(zc.x), bfhi(zc.x), bflo(zc.y), bfhi(zc.y), bflo(zc.z), bfhi(zc.z), bflo(zc.w), bfhi(zc.w)};
        const float lb[8] = {l0[0], l0[1], l0[2], l0[3], l1[0], l1[1], l1[2], l1[3]};
        float kk[8], Bv[8], tot[8];
#pragma unroll
        for (int e = 0; e < 8; ++e) { const float sg = sigmoidf_(z[e]); const float f = fmaxf(lb[e] + (1.0f - lb[e]) * sg, 1e-20f); Bv[e] = __builtin_amdgcn_logf(f); kk[e] = (1.0f - lb[e]) * (1.0f - sg); }
        scan32x8<REV>(Bv, lane, tot);
        float kv[8];
#pragma unroll
        for (int e = 0; e < 8; ++e) { const float ee = Bv[e] - tot[e]; kv[e] = kk[e] * __builtin_amdgcn_exp2f(-ee); }
        if ((lane & 31) == 0) { *(LAS f32x4*)(ttab_w + 16 * d0 + 8 * hi) = (f32x4){tot[0], tot[1], tot[2], tot[3]}; *(LAS f32x4*)(ttab_w + 16 * d0 + 8 * hi + 4) = (f32x4){tot[4], tot[5], tot[6], tot[7]}; }
        u32x4 kh; kh.x = cvtpk(kv[0], kv[1]); kh.y = cvtpk(kv[2], kv[3]); kh.z = cvtpk(kv[4], kv[5]); kh.w = cvtpk(kv[6], kv[7]);
        *(LAS u32x4*)(lds + (row >> 6) * 16384 + v_st(row & 63, 16 * d0 + 8 * hi)) = kh;
        __builtin_amdgcn_sched_barrier(0);
    }
}
__device__ __forceinline__ u32x4 qscale(const u32x4 q, const float* Ek) {
    u32x4 o; o.x = cvtpk(bflo(q.x) * __builtin_amdgcn_exp2f(Ek[0]), bfhi(q.x) * __builtin_amdgcn_exp2f(Ek[1])); o.y = cvtpk(bflo(q.y) * __builtin_amdgcn_exp2f(Ek[2]), bfhi(q.y) * __builtin_amdgcn_exp2f(Ek[3]));
    o.z = cvtpk(bflo(q.z) * __builtin_amdgcn_exp2f(Ek[4]), bfhi(q.z) * __builtin_amdgcn_exp2f(Ek[5])); o.w = cvtpk(bflo(q.w) * __builtin_amdgcn_exp2f(Ek[6]), bfhi(q.w) * __builtin_amdgcn_exp2f(Ek[7])); return o;
}
#define HG_PK4(P, BASE, OUT) do { unsigned a0 = cvtpk_c(P[BASE + 0], P[BASE + 1]), a1 = cvtpk_c(P[BASE + 2], P[BASE + 3]);     \
    unsigned b0_ = cvtpk_c(P[BASE + 4], P[BASE + 5]), b1_ = cvtpk_c(P[BASE + 6], P[BASE + 7]);                              \
    auto r0 = __builtin_amdgcn_permlane32_swap(a0, b0_, false, false); auto r1 = __builtin_amdgcn_permlane32_swap(a1, b1_, false, false); \
    u32x4 w_ = {r0[0], r1[0], r0[1], r1[1]}; OUT = *reinterpret_cast<bf16x8*>(&w_); } while (0)
template <int D0> __device__ __forceinline__ void pv32(f32x16& od, int vb, bf16x8 pa0, bf16x8 pa1) {
    const s16x4 l0 = tr_read<v_rd_off(D0, 0, 0)>(vb), h0 = tr_read<v_rd_off(D0, 0, 1)>(vb), l1 = tr_read<v_rd_off(D0, 1, 0)>(vb), h1 = tr_read<v_rd_off(D0, 1, 1)>(vb);
    asm volatile("s_waitcnt lgkmcnt(0)" ::: "memory"); __builtin_amdgcn_sched_barrier(0);
    od = __builtin_amdgcn_mfma_f32_32x32x16_bf16(pa0, (bf16x8){l0[0], l0[1], l0[2], l0[3], h0[0], h0[1], h0[2], h0[3]}, od, 0, 0, 0);
    od = __builtin_amdgcn_mfma_f32_32x32x16_bf16(pa1, (bf16x8){l1[0], l1[1], l1[2], l1[3], h1[0], h1[1], h1[2], h1[3]}, od, 0, 0, 0);
}

constexpr int PTAB_OFF = TTAB_OFF + 4096;
__device__ __forceinline__ u32x4 qfac(u32x4 Q, const LAS float* ca, const LAS float* cb, bool sub) {
    asm volatile("" : "+v"(Q.x), "+v"(Q.y), "+v"(Q.z), "+v"(Q.w));
    f32x4 a0 = *(const LAS f32x4*)(ca), a1 = *(const LAS f32x4*)(ca + 4);
    if (sub) { a0 -= *(const LAS f32x4*)(cb); a1 -= *(const LAS f32x4*)(cb + 4); }
    u32x4 o; o.x = cvtpk(bflo(Q.x) * __builtin_amdgcn_exp2f(a0[0]), bfhi(Q.x) * __builtin_amdgcn_exp2f(a0[1])); o.y = cvtpk(bflo(Q.y) * __builtin_amdgcn_exp2f(a0[2]), bfhi(Q.y) * __builtin_amdgcn_exp2f(a0[3]));
    o.z = cvtpk(bflo(Q.z) * __builtin_amdgcn_exp2f(a1[0]), bfhi(Q.z) * __builtin_amdgcn_exp2f(a1[1])); o.w = cvtpk(bflo(Q.w) * __builtin_amdgcn_exp2f(a1[2]), bfhi(Q.w) * __builtin_amdgcn_exp2f(a1[3])); return o;
}
constexpr int FTAB_OFF = LBT_OFF + 1024;
__device__ __forceinline__ u32x4 qmul(u32x4 Q, const LAS float* f) {
    asm volatile("" : "+v"(Q.x), "+v"(Q.y), "+v"(Q.z), "+v"(Q.w));
    const f32x4 a0 = *(const LAS f32x4*)(f), a1 = *(const LAS f32x4*)(f + 4);
    u32x4 o; o.x = cvtpk(bflo(Q.x) * a0[0], bfhi(Q.x) * a0[1]); o.y = cvtpk(bflo(Q.y) * a0[2], bfhi(Q.y) * a0[3]);
    o.z = cvtpk(bflo(Q.z) * a1[0], bfhi(Q.z) * a1[1]); o.w = cvtpk(bflo(Q.w) * a1[2], bfhi(Q.w) * a1[3]); return o;
}
template <bool REV, int SK = 0> __device__ __forceinline__ void out_dir(Frame& F, int l, int b, int h, int c, f32x16 (&o)[4]) {
    const int w = F.wave, lane = F.lane, r32 = lane & 31, hi = lane >> 5, dir = REV ? 1 : 0;
    LAS char* lds = (LAS char*)F.lds; LAS float* ttab = (LAS float*)(lds + TTAB_OFF); LAS float* ptab = (LAS float*)(lds + PTAB_OFF);
    const size_t rowoff = ((size_t)(b * 8 + h) * TT + (size_t)c * 256 + 32 * w + r32) * 128 + 8 * hi;
    const bf16_t* Z = WSP(bf16_t, DY_PC) + (size_t)(1 + dir) * MR * 1024 + rowoff; const bf16_t* GQ = WSP(bf16_t, DY_PC) + rowoff;
    LAS float* lbt = (LAS float*)(lds + LBT_OFF) + dir * 128;
    __syncthreads();
    u32x4 Qp[8];
    { float E[64];
      prep<REV, 0>(Z, lbt + 8 * hi, lane, ttab + w * 128, E, lds, 32 * w + r32);
#pragma unroll
      for (int d0 = 0; d0 < 8; ++d0) Qp[d0] = *(const u32x4*)(GQ + 16 * d0);
#pragma unroll
      for (int d0 = 0; d0 < 8; ++d0) asm volatile("" : "+v"(Qp[d0]));
#pragma unroll
      for (int d0 = 0; d0 < 8; ++d0) Qp[d0] = qscale(Qp[d0], &E[d0 * 8]); }
    __syncthreads();
    if (F.tid < 128) { float s = 0.f;
#pragma unroll
        for (int pi = 0; pi < 8; ++pi) { ptab[pi * 128 + F.tid] = s; s += ttab[(REV ? 7 - pi : pi) * 128 + F.tid]; }
        ptab[8 * 128 + F.tid] = s; }
    __syncthreads();
    const int vbase = (int)(uintptr_t)lds + 65536 + v_rd_base(lane);
    const int piw = REV ? 7 - w : w; const LAS float* cw = ptab + (piw + 1) * 128 + 8 * hi; LAS float* ftab = (LAS float*)(lds + FTAB_OFF) + w * 128;
    for (int pi = (SK & 1) ? -1 : piw; pi >= 0; --pi) {
        const int J = REV ? 7 - pi : pi; const LAS float* cj = ptab + (pi + 1) * 128 + 8 * hi;
        { const LAS float* pw = ptab + (piw + 1) * 128, *pj = ptab + (pi + 1) * 128;
          ftab[lane] = __builtin_amdgcn_exp2f(pw[lane] - pj[lane]); ftab[lane + 64] = __builtin_amdgcn_exp2f(pw[lane + 64] - pj[lane + 64]); }
        asm volatile("s_waitcnt lgkmcnt(0)" ::: "memory");
        f32x16 p;
#pragma unroll
        for (int r = 0; r < 16; ++r) p[r] = 0.f;
#pragma unroll
        for (int d0 = 0; d0 < 8; ++d0) { const u32x4 qt = qmul(Qp[d0], ftab + 8 * hi + 16 * d0); const bf16x8 a = *(const LAS bf16x8*)(lds + KSWZ256(32 * J + r32, (16 * d0 + 8 * hi) * 2));
            p = __builtin_amdgcn_mfma_f32_32x32x16_bf16(a, *reinterpret_cast<const bf16x8*>(&qt), p, 0, 0, 0);
            if (d0 & 1) __builtin_amdgcn_sched_barrier(0); }
        if (pi == piw) {
#pragma unroll
            for (int r = 0; r < 16; ++r) { const int jj = crow(r, hi); const bool keep = REV ? (jj >= r32) : (jj <= r32); p[r] = keep ? p[r] : 0.f; } }
        bf16x8 pa0, pa1; HG_PK4(p, 0, pa0); HG_PK4(p, 8, pa1);
        const int vb = vbase + (J >> 1) * 16384 + (J & 1) * 8192;
        pv32<0>(o[0], vb, pa0, pa1); pv32<1>(o[1], vb, pa0, pa1); pv32<2>(o[2], vb, pa0, pa1); pv32<3>(o[3], vb, pa0, pa1);
    }
    const bf16_t* us = (const bf16_t*)(F.ws + scn::US_HG_OFF) + ((size_t)((b * 8 + h) * 2 + dir) * PPB + scn::cp_of(c, dir)) * scn::HG_US_ELEMS + (size_t)lane * 8;
    if (!(SK & 2)) {
        bf16x8 sfa[2][4], sfb[2][4];
#define HG_SLD(buf, kq) do { _Pragma("unroll") for (int k2 = 0; k2 < 2; ++k2) _Pragma("unroll") for (int d0 = 0; d0 < 4; ++d0) buf[k2][d0] = *(const bf16x8*)(us + (size_t)((2 * (kq) + k2) * 4 + d0) * 512); } while (0)
#define HG_SMM(buf, kq) do { _Pragma("unroll") for (int k2 = 0; k2 < 2; ++k2) { const u32x4 qe = qfac(Qp[2 * (kq) + k2], cw + 16 * (2 * (kq) + k2), cw, false);                                  \
            _Pragma("unroll") for (int d0 = 0; d0 < 4; ++d0) o[d0] = __builtin_amdgcn_mfma_f32_32x32x16_bf16(*reinterpret_cast<const bf16x8*>(&qe), buf[k2][d0], o[d0], 0, 0, 0); } } while (0)
        HG_SLD(sfa, 0); HG_SLD(sfb, 1); __builtin_amdgcn_sched_barrier(0);
        HG_SMM(sfa, 0); __builtin_amdgcn_sched_barrier(0); HG_SLD(sfa, 2); __builtin_amdgcn_sched_barrier(0);
        HG_SMM(sfb, 1); __builtin_amdgcn_sched_barrier(0); HG_SLD(sfb, 3); __builtin_amdgcn_sched_barrier(0);
        HG_SMM(sfa, 2); __builtin_amdgcn_sched_barrier(0); HG_SMM(sfb, 3); __builtin_amdgcn_sched_barrier(0);
#undef HG_SLD
#undef HG_SMM
    }
    __syncthreads();
}
template <int SK = 0> __device__ __forceinline__ void out_unit(Frame& F, int l, int b, int h, int c) {
    const int w = F.wave, lane = F.lane, r32 = lane & 31, hi = lane >> 5;
    LAS char* lds = (LAS char*)F.lds;
    const size_t rowoff = ((size_t)(b * 8 + h) * TT + (size_t)c * 256 + 32 * w + r32) * 128 + 8 * hi;
    const bf16_t* GI = WSP(bf16_t, DY_PC) + (size_t)3 * MR * 1024 + rowoff;
    { u32x4 gv[8];
#pragma unroll
      for (int d0 = 0; d0 < 8; ++d0) gv[d0] = *(const u32x4*)(GI + 16 * d0);
      float lbv = 0.f; if (F.tid < 256) lbv = WSP(float, WS_LB)[l * 2048 + (F.tid >> 7) * 1024 + h * 128 + (F.tid & 127)];
#pragma unroll
      for (int d0 = 0; d0 < 8; ++d0) asm volatile("" : "+v"(gv[d0]));
      if (F.tid < 256) ((LAS float*)(lds + LBT_OFF))[F.tid] = lbv;
#pragma unroll
      for (int d0 = 0; d0 < 8; ++d0) { const int row = 32 * w + r32; *(LAS u32x4*)(lds + 65536 + (row >> 6) * 16384 + v_st(row & 63, 16 * d0 + 8 * hi)) = gv[d0]; } }
    f32x16 o[4];
#pragma unroll
    for (int d = 0; d < 4; ++d)
#pragma unroll
        for (int r = 0; r < 16; ++r) o[d][r] = 0.f;
    out_dir<false, SK>(F, l, b, h, c, o);
    if (!(SK & 4)) out_dir<true, SK>(F, l, b, h, c, o);
    const float* gn = inp(F, I_GNORM) + l * 128;
    bf16_t* oc = WSP(bf16_t, DY_OC) + ((size_t)b * TT + (size_t)c * 256 + 32 * w) * 1024 + h * 128 + r32;
    float wn[4];
#pragma unroll
    for (int j = 0; j < 4; ++j) wn[j] = gn[32 * j + r32];
#pragma unroll
    for (int r = 0; r < 16; ++r) { float s = 0.f;
#pragma unroll
        for (int d0 = 0; d0 < 4; ++d0) s += o[d0][r] * o[d0][r];
        s += __shfl_xor(s, 1); s += __shfl_xor(s, 2); s += __shfl_xor(s, 4); s += __shfl_xor(s, 8); s += __shfl_xor(s, 16);
        const float rs = rsqrtf(s * (1.0f / 128.0f) + EPS); bf16_t* rowp = oc + (size_t)crow(r, hi) * 1024;
#pragma unroll
        for (int d0 = 0; d0 < 4; ++d0) rowp[32 * d0] = (bf16_t)(cvtpk(o[d0][r] * rs * wn[d0], 0.f) & 0xffffu); }
}

template <bool REV> __device__ __forceinline__ void local_dir(Frame& F, int l, int b, int h, int c) {
    const int w = F.wave, lane = F.lane, r32 = lane & 31, hi = lane >> 5, dir = REV ? 1 : 0, rb = w >> 1, cb0 = 2 * (w & 1);
    LAS char* lds = (LAS char*)F.lds; LAS float* ttab = (LAS float*)(lds + TTAB_OFF);
    const bf16_t* Z = WSP(bf16_t, DY_PC) + (size_t)(1 + dir) * MR * 1024 + ((size_t)(b * 8 + h) * TT + (size_t)c * 256 + 32 * w + r32) * 128 + 8 * hi;
    LAS float* lbt = (LAS float*)(lds + LBT_OFF) + dir * 128;
    __syncthreads();
    prep_roll<REV>(Z, lbt + 8 * hi, lane, ttab + w * 128, lds, 32 * w + r32);
    __syncthreads();
    f32x16 acc[2];
#pragma unroll
    for (int cb = 0; cb < 2; ++cb)
#pragma unroll
        for (int r = 0; r < 16; ++r) acc[cb][r] = 0.f;
    const int vbK0 = (int)(uintptr_t)lds + rb * 512 + v_rd_base(lane), vbV0 = (int)(uintptr_t)lds + 65536 + cb0 * 512 + v_rd_base(lane);
    for (int i = 0; i < 8; ++i) { const int blk = REV ? 7 - i : i;
        if (i > 0) { const LAS float* tb = ttab + blk * 128 + 32 * rb + 4 * hi;
#pragma unroll
            for (int g = 0; g < 4; ++g) { const f32x4 t = *(const LAS f32x4*)(tb + 8 * g);
#pragma unroll
                for (int j = 0; j < 4; ++j) { const float s = __builtin_amdgcn_exp2f(t[j]); acc[0][4 * g + j] *= s; acc[1][4 * g + j] *= s; } } }
        const int off = (blk >> 1) * 16384 + (blk & 1) * 8192; const int vk = vbK0 + off, vv = vbV0 + off;
#define HL_STEP(KS2) { const s16x4 al = tr_read<v_rd_off(0, KS2, 0)>(vk), ah = tr_read<v_rd_off(0, KS2, 1)>(vk), b0l = tr_read<v_rd_off(0, KS2, 0)>(vv), b0h = tr_read<v_rd_off(0, KS2, 1)>(vv), \
            b1l = tr_read<v_rd_off(1, KS2, 0)>(vv), b1h = tr_read<v_rd_off(1, KS2, 1)>(vv); \
            asm volatile("s_waitcnt lgkmcnt(0)" ::: "memory"); __builtin_amdgcn_sched_barrier(0); \
            const bf16x8 A_ = {al[0], al[1], al[2], al[3], ah[0], ah[1], ah[2], ah[3]}; \
            acc[0] = __builtin_amdgcn_mfma_f32_32x32x16_bf16(A_, (bf16x8){b0l[0], b0l[1], b0l[2], b0l[3], b0h[0], b0h[1], b0h[2], b0h[3]}, acc[0], 0, 0, 0); \
            acc[1] = __builtin_amdgcn_mfma_f32_32x32x16_bf16(A_, (bf16x8){b1l[0], b1l[1], b1l[2], b1l[3], b1h[0], b1h[1], b1h[2], b1h[3]}, acc[1], 0, 0, 0); }
        HL_STEP(0) HL_STEP(1)
#undef HL_STEP
    }
    const size_t slot = (size_t)((b * 8 + h) * 2 + dir) * PPB + scn::cp_of(c, dir);
    bf16_t* us = (bf16_t*)(F.ws + scn::US_HG_OFF) + slot * scn::HG_US_ELEMS;
    scn::store_state_tile(us, acc[0], rb, cb0, 4, r32, hi); scn::store_state_tile(us, acc[1], rb, cb0 + 1, 4, r32, hi);
    if (F.tid < 128) { float s = 0.f;
#pragma unroll
        for (int k = 0; k < 8; ++k) s += ttab[k * 128 + F.tid];
        ((float*)(F.ws + scn::HG_A_OFF))[slot * 128 + F.tid] = __builtin_amdgcn_exp2f(s); }
    __syncthreads();
}
__device__ __forceinline__ void local_unit(Frame& F, int l, int b, int h, int c) {
    const int w = F.wave, lane = F.lane, r32 = lane & 31, hi = lane >> 5;
    LAS char* lds = (LAS char*)F.lds;
    const bf16_t* GI = WSP(bf16_t, DY_PC) + (size_t)3 * MR * 1024 + ((size_t)(b * 8 + h) * TT + (size_t)c * 256 + 32 * w + r32) * 128 + 8 * hi;
    { u32x4 gv[8];
#pragma unroll
      for (int d0 = 0; d0 < 8; ++d0) gv[d0] = *(const u32x4*)(GI + 16 * d0);
      float lbv = 0.f; if (F.tid < 256) lbv = WSP(float, WS_LB)[l * 2048 + (F.tid >> 7) * 1024 + h * 128 + (F.tid & 127)];
#pragma unroll
      for (int d0 = 0; d0 < 8; ++d0) asm volatile("" : "+v"(gv[d0]));
      if (F.tid < 256) ((LAS float*)(lds + LBT_OFF))[F.tid] = lbv;
#pragma unroll
      for (int d0 = 0; d0 < 8; ++d0) { const int row = 32 * w + r32; *(LAS u32x4*)(lds + 65536 + (row >> 6) * 16384 + v_st(row & 63, 16 * d0 + 8 * hi)) = gv[d0]; } }
    local_dir<false>(F, l, b, h, c);
    local_dir<true>(F, l, b, h, c);
}
}

__device__ __forceinline__ void sa_phase(Frame& F, int l) {
    for (int u = F.bid; u < NB * 4 * PPB; u += F.G) { const int c = u % PPB, h = (u / PPB) & 3, b = u / (PPB * 4); scn::ret_local_unit(F, b, h, c); __syncthreads(); }
    frame_refresh(F);
    for (int u = F.G - 1 - F.bid; u < NB * 8 * PPB; u += F.G) { const int c = u % PPB, h = (u / PPB) & 7, b = u / (PPB * 8); hgm::local_unit(F, l, b, h, c); }
}
__device__ __forceinline__ void sc_phase(Frame& F, int l) {
    const int NC = (l == 1) ? PPB - 1 : PPB;
    for (int u = F.bid; u < NB * 4 * NC; u += F.G) { const int c = u % NC, h = (u / NC) & 3, b = u / (NC * 4); scn::ret_out_unit(F, l, b, h, c); }
    frame_refresh(F);
#ifndef HG_PROBE
#define HG_PROBE -1
#endif
    if (HG_PROBE >= 0) { for (int u = F.G - 1 - F.bid; u < NB * 8 * NC; u += F.G) { const int c = u % NC, h = (u / NC) & 7, b = u / (NC * 8); hgm::out_unit<(HG_PROBE < 0 ? 0 : HG_PROBE)>(F, l, b, h, c); } frame_refresh(F); }
    for (int u = F.G - 1 - F.bid; u < NB * 8 * NC; u += F.G) { const int c = u % NC, h = (u / NC) & 7, b = u / (NC * 8); hgm::out_unit<0>(F, l, b, h, c); }
}

#ifndef RET_MFMA
#define RET_MFMA 1
#endif
enum { PH_PRO = 0, PH_MODFIN, PH_N1, PH_GA, PH_ATT, PH_GB, PH_SA, PH_SB, PH_SC, PH_OG, PH_MG, PH_WO, PH_N2, PH_UP, PH_FIX, PH_DN, PH_COUNT };

struct PanelOrder : pg8::StaticOrder {
    int skip;
    __device__ __forceinline__ bool next(int i, pg8::Unit& u) const { const bool ok = pg8::StaticOrder::next(i, u); if (ok && skip) u.pm += (u.pm >= PPB - 1) ? 1 : 0; return ok; }
};
struct ProjOrder : PanelOrder {
    __device__ __forceinline__ bool next(int i, pg8::Unit& u) const { const int r = i / 3, n = i - 3 * r; const bool ok = PanelOrder::next(r, u); if (ok) { u.pm += n * NPAN; u.pn += 8 * n; } return ok; }    __device__ __forceinline__ bool keep(int i) const { return (i % 3) != 2; }
};
template <class Epi> __device__ __forceinline__ void run_gemm(Frame& F, const bf16_t* A, const bf16_t* Bt, int N, int K, const Epi& E, bool skipctx = false) {
    pg8::Gemm g{A, Bt, MR, N, K}; PanelOrder S; S.init(skipctx ? MR - 512 : MR, N, F.G, F.bid); S.skip = skipctx ? 1 : 0;
    pg8::gemm_phase<Epi, PanelOrder, false>(F.lds, g, S, E, nullptr);
}
__device__ __forceinline__ EpiIn make_epi_in(Frame& F, int l, int pt0) {
    EpiIn E; E.pt0 = pt0;
    E.rq = WSP(bf16_t, DY_QKV); E.r2 = WSP(bf16_t, DY_PB); E.r1 = WSP(bf16_t, DY_PC);
    E.qkn = inp(F, I_QKN) + l * 128; E.ropeA = WSP(f32x2, WS_ROPEA); E.ropeB = WSP(f32x2, WS_ROPEB);
    return E;
}
__device__ __forceinline__ EpiRes make_epi_res(Frame& F, int l, int use_inputs, int gidx) {
    EpiRes E; E.srcx = use_inputs ? inp(F, I_X) : outp(F); E.srcc = use_inputs ? inp(F, I_CTX) : WSP(float, WS_XC); E.dstx = outp(F); E.dstc = WSP(float, WS_XC);
    E.gate0 = WSP(float, WS_MODV) + ((size_t)(l * 3) * 6 + gidx) * D; return E;
}

template <int PH> __device__ __forceinline__ void run_phase(Frame& F, int l) {
    frame_refresh(F);
    const bf16_t* h = WSP(bf16_t, WS_H); const bf16_t* wt = WSP(bf16_t, WS_WT);
    const bf16_t* wt_in = wt + WT_IN / 2;
    if constexpr (PH == PH_PRO) { p0_mod_partial(F); p0_tables(F); convert_weights(F, 0); }
    if constexpr (PH == PH_MODFIN) { p1_mod_final(F); }
    if constexpr (PH == PH_N1) { if (l == 1) convert_weights(F, 1); norm_phase(F, l, 0); }
    if constexpr (PH == PH_GA) { const EpiIn E = make_epi_in(F, l, PT_DQ); run_gemm(F, h, wt_in, 9216, D, E); }
#ifndef ATT_PROBE
#define ATT_PROBE -1
#endif
    if constexpr (PH == PH_ATT) { if (ATT_PROBE >= 0) { attn_phase<(ATT_PROBE < 0 ? 0 : ATT_PROBE)>(F, l); __syncthreads(); } attn_phase<0>(F, l); }
    if constexpr (PH == PH_GB) { }
    if constexpr (PH == PH_SA) { sa_phase(F, l); }
    if constexpr (PH == PH_SB) { scn::scan_states(F, true, true); }
    if constexpr (PH == PH_SC) { sc_phase(F, l); }
    if constexpr (PH == PH_OG) { EpiGates E; E.oB = WSP(bf16_t, DY_OB); E.oC = WSP(bf16_t, DY_OC); E.G = WSP(bf16_t, DY_MG); E.bias = inp(F, I_BGATE) + (size_t)l * 3 * D;
        run_gemm(F, h, wt_in + (size_t)PT_RG * 256 * D, 8192, D, E, l == 1); }
    if constexpr (PH == PH_MG) {
        EpiProjAll E{WSP(bf16_t, DY_MG), WSP(bf16_t, DY_YO)};
        pg8::Gemm g{WSP(bf16_t, DY_OA), wt + WT_BR / 2, MR, 2048, 1024}; ProjOrder S; const bool sk = (l == 1); S.init(sk ? MR - 512 : MR, 2048, F.G, F.bid); S.skip = sk ? 1 : 0;
        pg8::gemm_phase<EpiProjAll, ProjOrder, false>(F.lds, g, S, E, nullptr);
    }
    if constexpr (PH == PH_WO) { const EpiRes E = make_epi_res(F, l, l == 0, 2); run_gemm(F, WSP(bf16_t, DY_YO), wt + WT_OUT / 2, 2048, D, E, l == 1); }
    if constexpr (PH == PH_N2) { norm_phase(F, l, 1); }
    if constexpr (PH == PH_UP) { EpiConv E; E.g = WSP(bf16_t, DY_G); E.raw = WSP(float, DY_RAW); E.cw = inp(F, I_CONVW) + (size_t)l * 3 * NUP; E.cb = inp(F, I_CONVB) + (size_t)l * NUP;
        run_gemm(F, h, wt + WT_UP / 2, NUP, D, E, l == 1); }
    if constexpr (PH == PH_FIX) { ffn_fixup(F, l); }
    if constexpr (PH == PH_DN) { const EpiRes E = make_epi_res(F, l, 0, 5); run_gemm(F, WSP(bf16_t, DY_G), wt + WT_DOWN / 2, 2048, DFF, E, l == 1); }
}

__device__ __forceinline__ void frame_init(Frame& F, const Args& a, unsigned char* lds) {
    F.lds = (LAS unsigned char*)lds; F.a = &a; F.G = gridDim.x; F.bid = blockIdx.x; frame_refresh(F);
}
template <int PH> __global__ void __launch_bounds__(NTHR, 2) k_phase(Args a) {
    extern __shared__ __attribute__((aligned(16))) unsigned char lds[];
    Frame F; frame_init(F, a, lds);
    run_phase<PH>(F, a.layer);
}
#ifndef MK_SINGLE
#define MK_SINGLE 1
#endif
__global__ void __launch_bounds__(NTHR, 2) k_all(Args a) {
    extern __shared__ __attribute__((aligned(16))) unsigned char lds[];
    Frame F; frame_init(F, a, lds);
    for (int u = F.tid; u < (LDS_BYTES - LDSCTL_OFF) / 4; u += NTHR) ((LAS unsigned*)(F.lds + LDSCTL_OFF))[u] = 0u;
    __syncthreads();
    (void)xcd_barrier_post((unsigned*)(a.ws + WS_CTL) + CW_BAR, (volatile LAS unsigned*)(F.lds + MISC_OFF + 32));
#define GRID_BAR() do { XcdBarrier b_; unsigned* bp_ = (unsigned*)(a.ws + WS_CTL) + CW_BAR; asm volatile("" : "+s"(bp_)); b_.bar = bp_; b_.x = xb_xcc_id(); \
        b_.st = (volatile LAS unsigned*)(F.lds + MISC_OFF + 32); xcd_barrier(b_); } while (0)
#ifndef PROBE_MASK
#define PROBE_MASK 0
#endif
#ifndef PROBE_T
#define PROBE_T 0
#endif
    unsigned long long pt0 = 0, pt1 = 0, pc0 = 0, pc1 = 0;
#define TSTART(ph, l_) do { if (PROBE_T && (ph) == PROBE_T - 1 && (l_) == 0) { pt0 = __builtin_amdgcn_s_memrealtime(); pc0 = (unsigned long long)clock64(); } } while (0)
#define TSTOP(ph, l_)  do { if (PROBE_T && (ph) == PROBE_T - 1 && (l_) == 0) { pt1 = __builtin_amdgcn_s_memrealtime(); pc1 = (unsigned long long)clock64(); } } while (0)
#define RUN(ph, l_, grp) do { TSTART(ph, l_); run_phase<ph>(F, l_); GRID_BAR(); TSTOP(ph, l_); if ((PROBE_MASK >> (grp)) & 1) { run_phase<ph>(F, l_); GRID_BAR(); } } while (0)
    RUN(PH_PRO, 0, 0); RUN(PH_MODFIN, 0, 0);
#pragma unroll 1
    for (int l = 0; l < 2; ++l) {
        RUN(PH_N1, l, 0);
        RUN(PH_GA, l, 1);
        RUN(PH_ATT, l, 2);
        RUN(PH_SA, l, 3);
        run_phase<PH_SB>(F, l); GRID_BAR();
        RUN(PH_SC, l, 4);
        run_phase<PH_OG>(F, l); GRID_BAR();
        RUN(PH_MG, l, 5);
        run_phase<PH_WO>(F, l); GRID_BAR();
        RUN(PH_N2, l, 0);
        RUN(PH_UP, l, 6);
        RUN(PH_FIX, l, 0);
        run_phase<PH_DN>(F, l); GRID_BAR();
    }
#undef RUN
    if (PROBE_T) {
        float* slot = (float*)(F.ws + WS_SCAL) + 64;
        if (F.bid == 0 && threadIdx.x == 0) { const float mhz = (float)(pc1 - pc0) / ((float)(pt1 - pt0) * 0.01f); *slot = floorf(mhz / 50.0f) * 50.0f; }
        GRID_BAR();
        const float v = *slot;
        for (size_t i = (size_t)F.bid * NTHR + threadIdx.x; i < (size_t)NB * T * D; i += (size_t)F.G * NTHR) a.out[i] = v;
    }
#undef GRID_BAR
}
__global__ void k_fill(float* out, size_t n, float v) { for (size_t i = (size_t)blockIdx.x * blockDim.x + threadIdx.x; i < n; i += (size_t)gridDim.x * blockDim.x) out[i] = v; }

template <int PH> static void launch_phase(const Args& a0, int layer, int grid, hipStream_t stream) {
    static bool attr = false;
    if (!attr) { if (hipFuncSetAttribute((const void*)k_phase<PH>, hipFuncAttributeMaxDynamicSharedMemorySize, LDS_BYTES) != hipSuccess) fprintf(stderr, "kernel_launch: hipFuncSetAttribute failed for phase %d\n", PH); attr = true; }
    Args a = a0; a.layer = layer;
    hipLaunchKernelGGL(k_phase<PH>, dim3(grid), dim3(NTHR), LDS_BYTES, stream, a);
    const hipError_t e = hipPeekAtLastError(); if (e != hipSuccess) fprintf(stderr, "kernel_launch: phase %d launch failed: %s\n", PH, hipGetErrorName(e));
}
extern "C" void kernel_launch(void* const* d_in, const int* in_sizes, int n_in, void* d_out, int out_size, void* d_ws, size_t ws_size, hipStream_t stream) {
    static int grid = 0;
    if (grid == 0) { int dev = 0, cus = 0; if (hipGetDevice(&dev) != hipSuccess || hipDeviceGetAttribute(&cus, hipDeviceAttributeMultiprocessorCount, dev) != hipSuccess || cus < 1) cus = 256; grid = cus; }
    if (n_in != N_INPUTS || out_size != NB * T * D || ws_size < WS_END) {
        fprintf(stderr, "kernel_launch: unexpected shapes: n_in %d out %d ws %zu (need %zu)\n", n_in, out_size, ws_size, (size_t)WS_END);
        hipLaunchKernelGGL(k_fill, dim3(1024), dim3(256), 0, stream, (float*)d_out, (size_t)out_size, (float)(ws_size >> 20));
        return;
    }
    Args a{};
    for (int i = 0; i < N_INPUTS; ++i) a.in[i] = (const float*)d_in[i];
    a.out = (float*)d_out; a.ws = (unsigned char*)d_ws; a.layer = 0; a.ph_lo = 0; a.ph_hi = 0; a.pad = 0;
#if MK_SINGLE
    {
        static bool attr = false;
        if (!attr) { if (hipFuncSetAttribute((const void*)k_all, hipFuncAttributeMaxDynamicSharedMemorySize, LDS_BYTES) != hipSuccess) fprintf(stderr, "kernel_launch: hipFuncSetAttribute failed\n");
            int per_cu = 0; if (hipOccupancyMaxActiveBlocksPerMultiprocessor(&per_cu, (const void*)k_all, NTHR, LDS_BYTES) != hipSuccess || per_cu < 1) fprintf(stderr, "kernel_launch: occupancy query says %d blocks per CU\n", per_cu);
            (void)hipGetLastError(); attr = true; }
        if (hipMemsetAsync((char*)d_ws + WS_CTL, 0, CTL_ZERO_BYTES, stream) != hipSuccess) { fprintf(stderr, "kernel_launch: memset failed\n"); return; }
        hipLaunchKernelGGL(k_all, dim3(grid), dim3(NTHR), LDS_BYTES, stream, a);
        const hipError_t e = hipPeekAtLastError(); if (e != hipSuccess) fprintf(stderr, "kernel_launch: launch failed: %s\n", hipGetErrorName(e));
        return;
    }
#endif
    launch_phase<PH_PRO>(a, 0, grid, stream);
    launch_phase<PH_MODFIN>(a, 0, grid, stream);
    for (int l = 0; l < 2; ++l) {
        launch_phase<PH_N1>(a, l, grid, stream); launch_phase<PH_GA>(a, l, grid, stream); launch_phase<PH_ATT>(a, l, grid, stream); launch_phase<PH_GB>(a, l, grid, stream);
        launch_phase<PH_SA>(a, l, grid, stream); launch_phase<PH_SB>(a, l, grid, stream); launch_phase<PH_SC>(a, l, grid, stream);
        launch_phase<PH_OG>(a, l, grid, stream); launch_phase<PH_MG>(a, l, grid, stream);
        launch_phase<PH_WO>(a, l, grid, stream); launch_phase<PH_N2>(a, l, grid, stream); launch_phase<PH_UP>(a, l, grid, stream); launch_phase<PH_FIX>(a, l, grid, stream);
        launch_phase<PH_DN>(a, l, grid, stream);
    }
}
```

```cpp
#include <hip/hip_runtime.h>
#include <cstdio>
#include <cstdint>
namespace pg8 {
#define PG8_LAS __attribute__((address_space(3)))
typedef unsigned short bf16_t;
typedef short bf16x8 __attribute__((ext_vector_type(8)));
typedef float f32x4 __attribute__((ext_vector_type(4)));
typedef unsigned u32x4 __attribute__((ext_vector_type(4)));
constexpr int BM = 256, BK = 64, HALF = 128, HTB = HALF * BK * 2  , STAGE_BYTES = 8 * HTB, NXCD = 8, WGM = 8;

__host__ __device__ __forceinline__ int lds_byte(int r, int c) { const int st = (r >> 4) * 2 + (c >> 5), rr = r & 15, cc = c & 31, ob = rr * 64 + cc * 2; return st * 1024 + (ob ^ (((ob >> 9) & 1) << 5)); }
__host__ __device__ __forceinline__ void stage_rc(int b, int& R, int& C) { const int st = b / 1024, sb = b % 1024, swz = sb ^ (((sb >> 9) & 1) << 5); R = (st >> 1) * 16 + swz / 64; C = (st & 1) * 32 + (swz % 64) / 2; }
__host__ __device__ __forceinline__ int perm32(int rho) { const int n = rho >> 4, i = rho & 15; return 8 * (i >> 2) + 4 * n + (i & 3); }

struct Unit { int pm, pn; };
struct Gemm { const bf16_t* A; const bf16_t* Bt; int M, N, K; };

struct StaticOrder {
    int nM, nN, nwg, G, c, wgm;
    __host__ __device__ void init(int M, int N, int G_, int c_) { nM = M / BM; nN = N / BM; nwg = nM * nN; G = G_; c = c_; wgm = WGM; }
    __host__ __device__ bool next(int i, Unit& u) const {
        const long L = (long)i * G + c; if (L >= nwg) return false;
        int wgid = (int)L; { const int q = nwg / NXCD, r = nwg % NXCD, xcd = wgid % NXCD, off = wgid / NXCD; wgid = (xcd < r ? xcd * (q + 1) : r * (q + 1) + (xcd - r) * q) + off; }
        const int nig = wgm * nN, gid = wgid / nig, fm = gid * wgm, gsz = (nM - fm) < wgm ? (nM - fm) : wgm;
        u.pm = fm + ((wgid % nig) % gsz); u.pn = (wgid % nig) / gsz; return true;
    }
    __device__ __forceinline__ void a_ready(const Unit&) const {}
    __device__ __forceinline__ void done(const Unit&) const {}
};
struct CountedOrder : StaticOrder {
    const unsigned* ready; unsigned need; unsigned* tmo;
    __device__ __forceinline__ void a_ready(const Unit& u) const {
        if (threadIdx.x < 64) {
            const unsigned long long t0 = __builtin_amdgcn_s_memrealtime(); unsigned polls = 0;
            while ((unsigned)__builtin_amdgcn_readfirstlane(__hip_atomic_load(ready + 64 * u.pm, __ATOMIC_RELAXED, __HIP_MEMORY_SCOPE_AGENT)) < need) {
                if ((++polls & 255u) == 0u && __builtin_amdgcn_readfirstlane(__hip_atomic_load(tmo, __ATOMIC_RELAXED, __HIP_MEMORY_SCOPE_AGENT)) != 0u) break;
                if (__builtin_amdgcn_s_memrealtime() - t0 > 2000000ull) {
                    if (threadIdx.x == 0) { unsigned expect = 0u; __hip_atomic_compare_exchange_strong(tmo + 1, &expect, 0x600u | (unsigned)(u.pm & 0xff), __ATOMIC_RELAXED, __ATOMIC_RELAXED, __HIP_MEMORY_SCOPE_AGENT); __hip_atomic_store(tmo, 1u, __ATOMIC_RELAXED, __HIP_MEMORY_SCOPE_AGENT); }
                    break; }
                __builtin_amdgcn_s_sleep(2); }
            __builtin_amdgcn_fence(__ATOMIC_ACQUIRE, "agent");
            asm volatile("s_waitcnt vmcnt(0)" ::: "memory");
        }
#if !defined(BROKEN_HOOK_NO_BARRIER)
        asm volatile("" ::: "memory"); __builtin_amdgcn_s_barrier(); asm volatile("" ::: "memory");
#endif
    }
};

template <class T, class = void> struct keeps_acc { static constexpr bool value = false; };
template <class T> struct keeps_acc<T, decltype((void)T::KEEPS_ACC)> { static constexpr bool value = true; };
template <class Epi, class Sched, bool STAMP = false>
__device__ __forceinline__ void gemm_phase(PG8_LAS unsigned char* lds, const Gemm g, const Sched& S, const Epi& E, unsigned long long* stamps) {
    int tid_ = threadIdx.x; asm volatile("" : "+v"(tid_));
    const int tid = tid_, wid = __builtin_amdgcn_readfirstlane(tid >> 6), lane = tid & 63, wr = wid >> 2, wc = wid & 3, fr = lane & 15, fq = lane >> 4;
    const int K = g.K, nt = K / BK;
    int ts_lo = 0, ts_hi = 0, nts = 0; const unsigned long long rt_entry = STAMP ? (unsigned long long)wall_clock64() : 0ull;
#define PG8_STAMP() do { if (STAMP && wid == 0 && nts < 64) { const unsigned long long _c = (unsigned long long)clock64(); \
        ts_lo = (lane == nts) ? (int)(unsigned)_c : ts_lo; ts_hi = (lane == nts) ? (int)(unsigned)(_c >> 32) : ts_hi; ++nts; } } while (0)
    PG8_STAMP();
    unsigned voffA[2], voffB[2];
#pragma unroll
    for (int i = 0; i < 2; ++i) { int R, C; stage_rc(tid * 16 + i * 8192, R, C); const int Rb = Epi::PERM ? ((R & ~31) + perm32(R & 31)) : R;
        voffA[i] = (unsigned)(R * K + C) * 2u; voffB[i] = (unsigned)(Rb * K + C) * 2u; }
    const size_t kstep = (size_t)(BK * 2);
    const size_t hstep = (size_t)HALF * K * 2;
    const size_t tstep = 2 * hstep;
    const unsigned ldsw = (unsigned)wid * 1024u;
    const int aoff = lds_byte(wr * 64 + fr, fq * 8), boff = lds_byte(wc * 32 + fr, fq * 8);
#define PG8_SA(b, h) (((b) * 2 + (h)) * HTB)
#define PG8_SB(b, h) ((4 + (b) * 2 + (h)) * HTB)
#define PG8_STAGE(bufoff, gbase, voff) do { const char* g_ = (const char*)(gbase); asm volatile("" : "+s"(g_));     \
        _Pragma("unroll") for (int _i = 0; _i < 2; ++_i) { asm volatile("" : "+v"((voff)[_i]));                         \
        __builtin_amdgcn_global_load_lds((const unsigned*)(g_ + (voff)[_i]), (PG8_LAS unsigned*)(lds + (bufoff) + ldsw + _i * 8192), 16, 0, 0); } } while (0)
#define PG8_LDA(dst, b, h) do { _Pragma("unroll") for (int m = 0; m < 4; ++m) _Pragma("unroll") for (int k = 0; k < 2; ++k) dst[m][k] = *(const PG8_LAS bf16x8*)(lds + PG8_SA(b, h) + aoff + m * 2048 + k * 1024); } while (0)
#define PG8_LDB(dst, b, h) do { _Pragma("unroll") for (int n = 0; n < 2; ++n) _Pragma("unroll") for (int k = 0; k < 2; ++k) dst[n][k] = *(const PG8_LAS bf16x8*)(lds + PG8_SB(b, h) + boff + n * 2048 + k * 1024); } while (0)
#define PG8_MMA(ai, bj, At, Bt) do { __builtin_amdgcn_s_setprio(1); _Pragma("unroll") for (int m = 0; m < 4; ++m) _Pragma("unroll") for (int n = 0; n < 2; ++n) _Pragma("unroll") for (int k = 0; k < 2; ++k) \
        acc[ai][bj][m][n] = __builtin_amdgcn_mfma_f32_16x16x32_bf16(Bt[n][k], At[m][k], acc[ai][bj][m][n], 0, 0, 0); __builtin_amdgcn_s_setprio(0); } while (0)
#define PG8_WAIT_V(n) asm volatile("s_waitcnt vmcnt(" #n ")" ::: "memory")
#define PG8_WAIT_L(n) asm volatile("s_waitcnt lgkmcnt(" #n ")" ::: "memory")
#define PG8_BAR __builtin_amdgcn_s_barrier()
#define PG8_SCHED __builtin_amdgcn_sched_barrier(0)
    Unit cur, nxt; int ui = 0;
    if (!S.next(0, cur)) return;
    f32x4 acc[2][2][4][2];
#pragma unroll
    for (int a = 0; a < 2; ++a)
#pragma unroll
        for (int b = 0; b < 2; ++b)
#pragma unroll
            for (int m = 0; m < 4; ++m)
#pragma unroll
                for (int n = 0; n < 2; ++n) acc[a][b][m][n] = (f32x4){0.f, 0.f, 0.f, 0.f};
    bf16x8 At[4][2], B0[2][2], B1[2][2];
    const char* cA = (const char*)g.A + (size_t)cur.pm * tstep; const char* cB = (const char*)g.Bt + (size_t)cur.pn * tstep;
    S.a_ready(cur);
    PG8_STAGE(PG8_SB(0, 0), cB, voffB); PG8_STAGE(PG8_SA(0, 0), cA, voffA); PG8_STAGE(PG8_SB(0, 1), cB + hstep, voffB); PG8_STAGE(PG8_SA(0, 1), cA + hstep, voffA);
    if (wr == 1) PG8_BAR;
    PG8_WAIT_V(4); PG8_BAR;
    PG8_STAGE(PG8_SB(1, 0), cB + kstep, voffB); PG8_STAGE(PG8_SA(1, 0), cA + kstep, voffA); PG8_STAGE(PG8_SB(1, 1), cB + hstep + kstep, voffB);
    PG8_WAIT_V(6); PG8_BAR;
    PG8_STAMP();
    for (;;) {
        const bool has_next = S.next(ui + 1, nxt);
        const char* nA = has_next ? (const char*)g.A + (size_t)nxt.pm * tstep : cA; const char* nB = has_next ? (const char*)g.Bt + (size_t)nxt.pn * tstep : cB;
        for (int t = 0; t < nt; t += 2) {
            const bool last = (t == nt - 2);
            const char* a1 = cA + (size_t)(t + 1) * kstep;
            const char* a2 = last ? nA : cA + (size_t)(t + 2) * kstep; const char* b2 = last ? nB : cB + (size_t)(t + 2) * kstep;
            const char* a3 = a2 + kstep; const char* b3 = b2 + kstep;
            if (last && has_next) S.a_ready(nxt);
            PG8_LDB(B0, 0, 0); PG8_SCHED; PG8_LDA(At, 0, 0); PG8_STAGE(PG8_SA(1, 1), a1 + hstep, voffA);
            PG8_WAIT_L(8); PG8_BAR; PG8_WAIT_L(0); PG8_MMA(0, 0, At, B0); PG8_BAR; PG8_SCHED;
            PG8_LDB(B1, 0, 1); PG8_STAGE(PG8_SB(0, 0), b2, voffB);
            PG8_BAR; PG8_WAIT_L(0); PG8_MMA(0, 1, At, B1); PG8_BAR;
            PG8_LDA(At, 0, 1); PG8_STAGE(PG8_SA(0, 0), a2, voffA);
            PG8_BAR; PG8_WAIT_L(0); PG8_MMA(1, 0, At, B0); PG8_BAR; PG8_SCHED;
            PG8_STAGE(PG8_SB(0, 1), b2 + hstep, voffB);
            PG8_WAIT_V(6); PG8_BAR; PG8_MMA(1, 1, At, B1); PG8_BAR;
            PG8_LDB(B0, 1, 0); PG8_SCHED; PG8_LDA(At, 1, 0); PG8_STAGE(PG8_SA(0, 1), a2 + hstep, voffA);
            PG8_WAIT_L(8); PG8_BAR; PG8_WAIT_L(0); PG8_MMA(0, 0, At, B0); PG8_BAR; PG8_SCHED;
            PG8_LDB(B1, 1, 1); PG8_STAGE(PG8_SB(1, 0), b3, voffB);
            PG8_BAR; PG8_WAIT_L(0); PG8_MMA(0, 1, At, B1); PG8_BAR;
            PG8_LDA(At, 1, 1); PG8_STAGE(PG8_SA(1, 0), a3, voffA);
            PG8_BAR; PG8_WAIT_L(0); PG8_MMA(1, 0, At, B0); PG8_BAR; PG8_SCHED;
            PG8_STAGE(PG8_SB(1, 1), b3 + hstep, voffB);
            PG8_WAIT_V(6); PG8_BAR; PG8_MMA(1, 1, At, B1); PG8_BAR;
        }
        PG8_STAMP();
        if constexpr (!Epi::AFTER_DRAIN) { E(acc, cur, wr, wc, fr, fq); S.done(cur); }
        PG8_STAMP();
        if (!has_next) break;
        bool keep_acc = false;
        if constexpr (keeps_acc<Epi>::value) keep_acc = S.keep(ui);
        if (!keep_acc) {
#pragma unroll
        for (int a = 0; a < 2; ++a)
#pragma unroll
            for (int b = 0; b < 2; ++b)
#pragma unroll
                for (int m = 0; m < 4; ++m)
#pragma unroll
                    for (int n = 0; n < 2; ++n) acc[a][b][m][n] = (f32x4){0.f, 0.f, 0.f, 0.f};
        }
        cur = nxt; cA = nA; cB = nB; ++ui;
    }
    PG8_WAIT_V(0);
    if (wr == 0) PG8_BAR;
    PG8_BAR;
    if constexpr (Epi::AFTER_DRAIN) { E.fused(acc, cur, wr, wc, fr, fq, lds, wid, lane); S.done(cur); }
    PG8_STAMP();
    if (STAMP && wid == 0) { stamps[lane] = lane < nts ? (((unsigned long long)(unsigned)ts_hi << 32) | (unsigned)ts_lo) : 0ull;
        if (lane == 62) stamps[62] = rt_entry; if (lane == 63) stamps[63] = (unsigned long long)wall_clock64(); }
#undef PG8_STAMP
#undef PG8_SA
#undef PG8_SB
#undef PG8_STAGE
#undef PG8_LDA
#undef PG8_LDB
#undef PG8_MMA
#undef PG8_WAIT_V
#undef PG8_WAIT_L
#undef PG8_BAR
#undef PG8_SCHED
}
}

#define GAS __attribute__((address_space(1)))
#define LAS __attribute__((address_space(3)))
typedef unsigned short bf16_t;
typedef short bf16x8 __attribute__((ext_vector_type(8)));
typedef short s16x4 __attribute__((ext_vector_type(4)));
typedef float f32x4 __attribute__((ext_vector_type(4)));
typedef float f32x2 __attribute__((ext_vector_type(2)));
typedef float f32x16 __attribute__((ext_vector_type(16)));
typedef unsigned u32x4 __attribute__((ext_vector_type(4)));
typedef unsigned u32x2 __attribute__((ext_vector_type(2)));

typedef __bf16 bf16x2_t __attribute__((ext_vector_type(2)));
__device__ __forceinline__ unsigned cvtpk_c(float lo, float hi) { const f32x2 v = {lo, hi}; return __builtin_bit_cast(unsigned, __builtin_convertvector(v, bf16x2_t)); }
__device__ __forceinline__ unsigned cvtpk(float lo, float hi) { unsigned r; asm volatile("v_cvt_pk_bf16_f32 %0, %1, %2" : "=v"(r) : "v"(lo), "v"(hi)); return r; }
__device__ __forceinline__ float bf2f(unsigned short b) { return __uint_as_float(((unsigned)b) << 16); }
__device__ __forceinline__ float bflo(unsigned w) { return __uint_as_float(w << 16); }
__device__ __forceinline__ float bfhi(unsigned w) { return __uint_as_float(w & 0xffff0000u); }
__device__ __forceinline__ float wave_sum(float v) {
#pragma unroll
    for (int o = 1; o < 64; o <<= 1) v += __shfl_xor(v, o);
    return v;
}
__device__ __forceinline__ float sigmoidf_(float x) { return __builtin_amdgcn_rcpf(1.0f + __builtin_amdgcn_exp2f(-1.4426950408889634f * x)); }
__device__ __forceinline__ float siluf_(float x) { return x * __builtin_amdgcn_rcpf(1.0f + __builtin_amdgcn_exp2f(-1.4426950408889634f * x)); }

#define XB_TMO      128
#define XB_XCNT(j)  (256  + 64 * (j))
#define XB_XSUB(j)  (1280 + 64 * (j))
#define XB_XGEN(j)  (2304 + 64 * (j))
#define XB_TOP      3328
#define XB_TOPGEN   3392
#define XCD_BAR_WORDS 3456
#define XB_SPIN_CAP (1u << 18)

__device__ __forceinline__ unsigned xb_ld(unsigned* p)              { return __hip_atomic_load(p, __ATOMIC_RELAXED, __HIP_MEMORY_SCOPE_AGENT); }
__device__ __forceinline__ unsigned xb_add(unsigned* p, unsigned v) { return __hip_atomic_fetch_add(p, v, __ATOMIC_RELAXED, __HIP_MEMORY_SCOPE_AGENT); }
__device__ __forceinline__ unsigned xb_xcc_id() { return (unsigned)__builtin_amdgcn_s_getreg((3 << 11) | 20) & 0xFu; }
#define XB_SPIN(cond, bar) do { unsigned _sp = 0; while (cond) { __builtin_amdgcn_s_sleep(1); \
    if ((++_sp & 255u) == 0u) { if (xb_ld(&(bar)[XB_TMO])) break; if (_sp > XB_SPIN_CAP) { atomicAdd(&(bar)[XB_TMO], 1u); break; } } } } while (0)

struct XcdBarrier {
    unsigned* bar; unsigned x;
    volatile LAS unsigned* st;
};
__device__ __forceinline__ XcdBarrier xcd_barrier_post(unsigned* bar, volatile LAS unsigned* st) {
    XcdBarrier b; b.bar = bar; b.x = xb_xcc_id(); b.st = st;
    if (threadIdx.x == 0) (void)xb_add(&bar[XB_XCNT(b.x)], 1u);
    return b;
}
__device__ __forceinline__ void xcd_barrier_complete(unsigned* bar, unsigned x, unsigned& nloc, unsigned& nx) {
    const unsigned G = gridDim.x * gridDim.y * gridDim.z;
    unsigned sum, cnt, mine, sp = 0u;
    for (;;) {
        sum = 0u; cnt = 0u; mine = 0u;
#pragma unroll
        for (unsigned j = 0; j < 16; ++j) { const unsigned c = xb_ld(&bar[XB_XCNT(j)]); sum += c; cnt += (c > 0u) ? 1u : 0u; mine = (j == x) ? c : mine; }
        if (sum == G) break;
        __builtin_amdgcn_s_sleep(1);
        if ((++sp & 255u) == 0u) { if (xb_ld(&bar[XB_TMO])) break; if (sp > XB_SPIN_CAP) { atomicAdd(&bar[XB_TMO], 1u); break; } }
    }
    nloc = mine > 0u ? mine : 1u; nx = cnt > 0u ? cnt : 1u;
}
__device__ __forceinline__ void xcd_barrier(const XcdBarrier& b) {
    asm volatile("s_waitcnt vmcnt(0)" ::: "memory");
    __syncthreads();
    if (threadIdx.x == 0) {
        unsigned* bar = b.bar;
        __builtin_amdgcn_s_waitcnt(0);
        unsigned nloc = b.st[0], nx = b.st[1];
        if (nloc == 0u) { xcd_barrier_complete(bar, b.x, nloc, nx); b.st[0] = nloc; b.st[1] = nx; }
        const unsigned old = xb_add(&bar[XB_XSUB(b.x)], 1u);
        const unsigned gen = old / nloc;
        if (old + 1u == (gen + 1u) * nloc) {
            __builtin_amdgcn_fence(__ATOMIC_RELEASE, "agent");
            asm volatile("s_waitcnt vmcnt(0)" ::: "memory");
            const unsigned og = xb_add(&bar[XB_TOP], 1u);
            const unsigned tg = og / nx;
            if (og + 1u == (tg + 1u) * nx) xb_add(&bar[XB_TOPGEN], 1u);
            else XB_SPIN(xb_ld(&bar[XB_TOPGEN]) == tg, bar);
            __builtin_amdgcn_fence(__ATOMIC_ACQUIRE, "agent");
            xb_add(&bar[XB_XGEN(b.x)], 1u);
            asm volatile("s_waitcnt vmcnt(0)" ::: "memory");
        } else {
            XB_SPIN(xb_ld(&bar[XB_XGEN(b.x)]) == gen, bar);
            __builtin_amdgcn_fence(__ATOMIC_ACQUIRE, "agent");
            asm volatile("s_waitcnt vmcnt(0)" ::: "memory");
        }
    }
    __syncthreads();
}

constexpr int D = 2048, NB = 2, T = 16384, LC = 256, TT = T + LC  , MR = NB * TT  ;
constexpr int NPAN = MR / 256  , PPB = TT / 256  ;
constexpr int NIN = 17408, DFF = 5504, NUP = 2 * DFF;
constexpr int NWAVES = 8, NTHR = 512;
constexpr float EPS = 1e-6f;
constexpr float LOG2E = 1.4426950408889634f;

enum { I_X = 0, I_C, I_CTX, I_CCTX, I_WMOD, I_BMOD, I_WIN, I_BGATE, I_QKN, I_LAMBDA, I_SUBLN, I_RNORM, I_GLB, I_GNORM, I_WBR, I_WOUT, I_WUP, I_CONVW, I_CONVB, I_WDOWN, N_INPUTS };

enum { TY_ROPE64 = 0, TY_ROPE128 = 1, TY_PLAIN = 2 };
enum { PT_DQ = 0, PT_DK = 4, PT_DV = 8, PT_RQ = 12, PT_RK = 14, PT_RV = 16, PT_GQ = 20, PT_GF = 24, PT_GB = 28, PT_GI = 32, PT_RG = 36, PT_GG = 40, PT_MA = 44, PT_MB = 52, PT_MC = 60, PT_END = 68 };
__host__ __device__ __forceinline__ int pt_logical_base(int pt) {
    if (pt < PT_RQ) return 256 * pt;
    if (pt < PT_RV) return 3072 + 256 * (pt - PT_RQ);
    if (pt < PT_GQ) return 4096 + 256 * (pt - PT_RV);
    if (pt < PT_RG) return 6144 + 256 * (pt - PT_GQ);
    if (pt < PT_GG) return 5120 + 256 * (pt - PT_RG);
    if (pt < PT_MA) return 10240 + 256 * (pt - PT_GG);
    return 11264 + 256 * (pt - PT_MA);
}
__host__ __device__ __forceinline__ int pt_type(int pt) { return pt < PT_DV ? TY_ROPE64 : (pt >= PT_RQ && pt < PT_RV) ? TY_ROPE128 : TY_PLAIN; }
__host__ __device__ __forceinline__ int perm_col(int type, int p) {
    const int bj = p >> 7, wc = (p >> 5) & 3, n = (p >> 4) & 1, fq = (p >> 2) & 3, e = p & 3;
    if (type == TY_ROPE64)  return 64 * wc + 32 * (fq >> 1) + 16 * bj + 8 * (fq & 1) + 4 * n + e;
    if (type == TY_ROPE128) return 128 * (wc >> 1) + 64 * (wc & 1) + 32 * bj + 8 * fq + 4 * n + e;
    return 64 * wc + 32 * bj + 8 * fq + 4 * n + e;
}
__host__ __device__ __forceinline__ int perm_col_up(int p) { const int bj = p >> 7, wc = (p >> 5) & 3, n = (p >> 4) & 1, fq = (p >> 2) & 3, e = p & 3; return 128 * bj + 32 * wc + 8 * fq + 4 * n + e; }

constexpr size_t MiB = 1u << 20;
constexpr size_t WS_CTL = 0, CTL_ZERO_BYTES = 1 * MiB;
constexpr size_t WS_MODP = 1 * MiB;
constexpr size_t WS_MODV = 6 * MiB;
constexpr size_t WS_ROPEA = 7 * MiB;
constexpr size_t WS_ROPEB = 7 * MiB + 64 * 1024;
constexpr size_t WS_LB = 7 * MiB + 256 * 1024;
constexpr size_t WS_SCAL = 7 * MiB + 512 * 1024;
constexpr size_t WS_XC = 9 * MiB;
constexpr size_t WS_WT = 13 * MiB;
constexpr size_t WT_IN = 0, WT_BR = 68 * MiB, WT_OUT = 80 * MiB, WT_UP = 88 * MiB, WT_DOWN = 131 * MiB;
constexpr size_t WS_H = 166 * MiB;
constexpr size_t WS_DYN = 296 * MiB;
constexpr size_t DY_OA = WS_DYN, DY_OB = WS_DYN + 65 * MiB, DY_OC = WS_DYN + 130 * MiB;
constexpr size_t DY_OSUB = WS_DYN + 195 * MiB;
constexpr size_t DY_US = DY_OSUB;
constexpr size_t DY_QKV = WS_DYN + 65 * MiB;
constexpr size_t DY_O1 = WS_DYN + 260 * MiB;
constexpr size_t DY_PC = WS_DYN + 325 * MiB;
constexpr size_t DY_PB = WS_DYN + 585 * MiB;
constexpr size_t DY_MG = WS_DYN + 325 * MiB;
constexpr size_t DY_Y = DY_OSUB, DY_YO = DY_OSUB;
constexpr size_t DY_G = WS_DYN, DY_RAW = WS_DYN + 350 * MiB;
constexpr size_t WS_END = WS_DYN + 715 * MiB;
constexpr size_t SZ_ROWS1K = (size_t)MR * 1024 * 2;

constexpr int CW_BAR = 4096;

constexpr int RING_BYTES = 131072, LDSCTL_OFF = RING_BYTES, MISC_OFF = LDSCTL_OFF + 320, LDS_BYTES = 147456;

struct Args { const float* in[N_INPUTS]; float* out; unsigned char* ws; int layer, ph_lo, ph_hi, pad; };

struct Frame {
    LAS unsigned char* lds;
    int tid, lane, wave, G, bid;
    const Args* a; unsigned char* ws;
};
__device__ __forceinline__ float* outp(const Frame& F) { GAS float* p = (GAS float*)F.a->out; asm volatile("" : "+s"(p)); return (float*)p; }
__device__ __forceinline__ const float* inp(const Frame& F, int i) { const GAS float* p = (const GAS float*)F.a->in[i]; asm volatile("" : "+s"(p)); return (const float*)p; }
__device__ __forceinline__ int opaque_tid() { int t = threadIdx.x; asm volatile("" : "+v"(t)); return t; }
__device__ __forceinline__ void frame_refresh(Frame& F) { GAS unsigned char* w_ = (GAS unsigned char*)F.a->ws; asm volatile("" : "+s"(w_)); F.ws = (unsigned char*)w_; F.tid = opaque_tid(); F.lane = F.tid & 63; F.wave = __builtin_amdgcn_readfirstlane(F.tid >> 6); }
#define WSP(T_, off) ((T_*)(F.ws + (off)))

__device__ __forceinline__ void p0_mod_partial(Frame& F) {
    LAS float* sv = (LAS float*)F.lds;
    for (int i = F.tid; i < 3 * D; i += NTHR) { const int v = i / D, k = i % D; const float c = v < 2 ? inp(F, I_C)[v * D + k] : inp(F, I_CCTX)[k]; sv[i] = siluf_(c); }
    __syncthreads();
    float* part = WSP(float, WS_MODP);
    const int total = 2 * 16 * 3072;
    for (int task = F.bid * NTHR + F.tid; task < total; task += F.G * NTHR) {
        const int q = task % 3072, ks = (task / 3072) % 16, l = task / (3072 * 16);
        const float* W = inp(F, I_WMOD) + ((size_t)l * D + ks * 128) * (6 * D) + q * 4;
        f32x4 a0 = {0, 0, 0, 0}, a1 = a0, a2 = a0;
#pragma unroll 8
        for (int k = 0; k < 128; ++k) { const f32x4 w = *(const f32x4*)(W + (size_t)k * (6 * D)); const float s0 = sv[ks * 128 + k], s1 = sv[D + ks * 128 + k], s2 = sv[2 * D + ks * 128 + k];
            a0 += w * s0; a1 += w * s1; a2 += w * s2; }
        float* o = part + ((size_t)(ks * 2 + l) * 3) * (6 * D) + q * 4;
        *(f32x4*)(o) = a0; *(f32x4*)(o + 6 * D) = a1; *(f32x4*)(o + 12 * D) = a2;
    }
    __syncthreads();
}
__device__ __forceinline__ void p0_tables(Frame& F) {
    const int gt = F.bid * NTHR + F.tid, NGT = F.G * NTHR;
    f32x2* ra = WSP(f32x2, WS_ROPEA); f32x2* rb = WSP(f32x2, WS_ROPEB);
    for (int i = gt; i < 256 * 16; i += NGT) { const int pos = i >> 4, f = i & 15; const float inv = powf(10000.0f, -(float)f / 16.0f); const float ang = (float)pos * inv; ra[i] = (f32x2){cosf(ang), sinf(ang)}; }
    for (int i = gt; i < 256 * 32; i += NGT) { const int pos = i >> 5, f = i & 31; const float inv = powf(10000.0f, -(float)f / 32.0f); const float ang = (float)pos * inv; rb[i] = (f32x2){cosf(ang), sinf(ang)}; }
    float* lb = WSP(float, WS_LB);
    for (int i = gt; i < 2 * 1024; i += NGT) { const float g0 = inp(F, I_GLB)[i], g1 = inp(F, I_GLB)[2048 + i]; const float m = fmaxf(g0, g1); const float e0 = expf(g0 - m), e1 = expf(g1 - m);
        lb[i] = 0.0f; lb[2048 + i] = e1 / (e0 + e1); }
    if (gt == 0) {
        float* sc = WSP(float, WS_SCAL);
        for (int l = 0; l < 2; ++l) {
            const float* al = inp(F, I_LAMBDA) + l * 256; float s1 = 0.f, s2 = 0.f;
            for (int i = 0; i < 64; ++i) { s1 += al[i] * al[64 + i]; s2 += al[128 + i] * al[192 + i]; }
            const float lam_init = 0.8f - 0.6f * expf(-0.3f * (float)l);
            sc[l] = expf(s1) - expf(s2) + lam_init;
            const float* g = inp(F, I_QKN) + l * 128; float mq = 0.f, mk = 0.f;
            for (int i = 0; i < 64; ++i) { mq = fmaxf(mq, fabsf(g[i])); mk = fmaxf(mk, fabsf(g[64 + i])); }
            sc[2 + l] = -(8.0f * mq * mk * 1.02f) * LOG2E;
        }
    }
}
__device__ __forceinline__ void convert_tile(Frame& F, const float* W, int N, int K, bf16_t* WT, int prow0, int k0, int base0, int base1, int ptype  ) {
    LAS float* t = (LAS float*)F.lds;
    { float wv[32];
#pragma unroll
      for (int i = 0; i < 32; ++i) { const int idx = i * NTHR + F.tid, kk = idx >> 8, c = idx & 255; const int col = c < 128 ? base0 + c : base1 + (c - 128);
          wv[i] = W[(size_t)(k0 + kk) * N + col]; }
#pragma unroll
      for (int i = 0; i < 32; ++i) { const int idx = i * NTHR + F.tid, kk = idx >> 8, c = idx & 255; t[kk * 257 + c] = wv[i]; } }
    __syncthreads();
#pragma unroll
    for (int i = 0; i < 4; ++i) { const int item = i * NTHR + F.tid, ch = item & 7, p = item >> 3; const int lc = ptype < 0 ? perm_col_up(p) : perm_col(ptype, p);
        const LAS float* s = t + (8 * ch) * 257 + lc;
        u32x4 o; o.x = cvtpk(s[0], s[257]); o.y = cvtpk(s[2 * 257], s[3 * 257]); o.z = cvtpk(s[4 * 257], s[5 * 257]); o.w = cvtpk(s[6 * 257], s[7 * 257]);
        *(u32x4*)(WT + (size_t)(prow0 + p) * K + k0 + 8 * ch) = o; }
    __syncthreads();
}
__device__ __forceinline__ void convert_weights(Frame& F, int l) {
    bf16_t* wt = WSP(bf16_t, WS_WT);
    constexpr int T_IN = 68 * 32, T_BR = 3 * 8 * 16, T_OUT = 8 * 32, T_UP = 43 * 32, T_DN = 8 * 86, T_ALL = T_IN + T_BR + T_OUT + T_UP + T_DN;
    for (int it = F.bid; it < T_ALL; it += F.G) {
        int r = it;
        if (r < T_IN) { const int pt = r / 32, kb = r % 32; const int lb = pt_logical_base(pt);
            convert_tile(F, inp(F, I_WIN) + (size_t)l * D * NIN, NIN, D, wt + WT_IN / 2, pt * 256, kb * 64, lb, lb + 128, pt_type(pt)); continue; } r -= T_IN;
        if (r < T_BR) { const int n = r / 128, pt = (r % 128) / 16, kb = r % 16;
            convert_tile(F, inp(F, I_WBR) + ((size_t)l * 3 + n) * 1024 * D, D, 1024, wt + WT_BR / 2 + (size_t)n * D * 1024, pt * 256, kb * 64, pt * 256, pt * 256 + 128, TY_PLAIN); continue; } r -= T_BR;
        if (r < T_OUT) { const int pt = r / 32, kb = r % 32;
            convert_tile(F, inp(F, I_WOUT) + (size_t)l * D * D, D, D, wt + WT_OUT / 2, pt * 256, kb * 64, pt * 256, pt * 256 + 128, TY_PLAIN); continue; } r -= T_OUT;
        if (r < T_UP) { const int pt = r / 32, kb = r % 32;
            convert_tile(F, inp(F, I_WUP) + (size_t)l * D * NUP, NUP, D, wt + WT_UP / 2, pt * 256, kb * 64, pt * 128, DFF + pt * 128, -1); continue; } r -= T_UP;
        { const int pt = r / 86, kb = r % 86;
            convert_tile(F, inp(F, I_WDOWN) + (size_t)l * DFF * D, D, DFF, wt + WT_DOWN / 2, pt * 256, kb * 64, pt * 256, pt * 256 + 128, TY_PLAIN); }
    }
}
__device__ __forceinline__ void p1_mod_final(Frame& F) {
    const float* part = WSP(float, WS_MODP); float* mv = WSP(float, WS_MODV);
    for (int i = F.bid * NTHR + F.tid; i < 2 * 3 * 6 * D; i += F.G * NTHR) { const int n = i % (6 * D), l = i / (3 * 6 * D);
        float s = inp(F, I_BMOD)[l * 6 * D + n];
#pragma unroll
        for (int ks = 0; ks < 16; ++ks) s += part[(size_t)ks * (2 * 3 * 6 * D) + i];
        mv[i] = s; }
}

__device__ __forceinline__ const float* xrow_src(Frame& F, int R, int use_inputs) {
    const int b = R / TT, t = R % TT;
    if (t < T) return (use_inputs ? inp(F, I_X) : (const float*)outp(F)) + ((size_t)b * T + t) * D;
    return (use_inputs ? inp(F, I_CTX) : (const float*)WSP(float, WS_XC)) + ((size_t)b * LC + (t - T)) * D;
}
__device__ __forceinline__ void norm_phase(Frame& F, int l, int which  ) {
    const int gw = F.bid * NWAVES + F.wave, NGW = F.G * NWAVES;
    bf16_t* h = WSP(bf16_t, WS_H); const float* mv = WSP(float, WS_MODV);
    const int use_inputs = (l == 0 && which == 0);
    f32x4 x[8], xn[8], sc1[8], sh[8]; int vcur = -1;
    if (gw < MR) { const f32x4* xr = (const f32x4*)xrow_src(F, gw, use_inputs) + F.lane;
#pragma unroll
        for (int j = 0; j < 8; ++j) x[j] = xr[64 * j]; }
    for (int R = gw; R < MR; R += NGW) {
        const int Rn = R + NGW;
        if (Rn < MR) { const f32x4* xr = (const f32x4*)xrow_src(F, Rn, use_inputs) + F.lane;
#pragma unroll
            for (int j = 0; j < 8; ++j) xn[j] = xr[64 * j]; }
        const int b = R / TT, t = R % TT, v = t < T ? b : 2;
        if (v != vcur) {
            const float* shift = mv + ((size_t)(l * 3 + v) * 6 + (which ? 3 : 0)) * D; const float* scale = shift + D;
#pragma unroll
            for (int j = 0; j < 8; ++j) { sc1[j] = *((const f32x4*)scale + F.lane + 64 * j) + 1.0f; sh[j] = *((const f32x4*)shift + F.lane + 64 * j); }
            vcur = v;
        }
        float ss = 0.f;
#pragma unroll
        for (int j = 0; j < 8; ++j) ss += (x[j].x * x[j].x + x[j].y * x[j].y) + (x[j].z * x[j].z + x[j].w * x[j].w);
        const float rstd = rsqrtf(wave_sum(ss) * (1.0f / D) + EPS);
        u32x2* o = (u32x2*)(h + (size_t)R * D) + F.lane;
#pragma unroll
        for (int j = 0; j < 8; ++j) { const f32x4 y = x[j] * rstd * sc1[j] + sh[j]; u32x2 w; w.x = cvtpk(y.x, y.y); w.y = cvtpk(y.z, y.w); o[64 * j] = w; }
#pragma unroll
        for (int j = 0; j < 8; ++j) x[j] = xn[j];
    }
}

typedef f32x4 acc_t[2][2][4][2];
__device__ __forceinline__ u32x4 pack8(const f32x4 a, const f32x4 b) { u32x4 w; w.x = cvtpk(a[0], a[1]); w.y = cvtpk(a[2], a[3]); w.z = cvtpk(b[0], b[1]); w.w = cvtpk(b[2], b[3]); return w; }

struct EpiIn {
    static constexpr bool PERM = false, AFTER_DRAIN = false;
    int pt0;
    bf16_t *rq, *r2, *r1;
    const float* qkn;
    const f32x2 *ropeA, *ropeB;
    __device__ __forceinline__ void operator()(const acc_t& acc, const pg8::Unit& u, int wr, int wc, int fr, int fq) const {
        const int pt = pt0 + u.pn, b = u.pm / PPB, tb = (u.pm % PPB) * 256 + wr * 64 + fr;
        if (pt < PT_DV) {
            const int isk = pt >= PT_DK, sh = 4 * (pt - (isk ? PT_DK : PT_DQ)) + wc, d0 = 32 * (fq >> 1) + 8 * (fq & 1);
            bf16_t* base = rq + (isk ? (size_t)MR * 1024 : (size_t)0) + ((size_t)(b * 16 + sh) * TT) * 64 + d0;
            const float* gp = qkn + isk * 64 + d0; const float osc = isk ? 1.0f : LOG2E * 0.125f;
            f32x4 g[2][2];
#pragma unroll
            for (int s = 0; s < 2; ++s)
#pragma unroll
                for (int n = 0; n < 2; ++n) g[s][n] = *(const f32x4*)(gp + 16 * s + 4 * n) * osc;
            const bool lat = (u.pm % PPB) != PPB - 1;
            f32x4 c0_[4], c1_[4], c2_[4];
#define R64_LD(buf, it) do { const int t = lat ? tb + ((it) >> 2) * 128 + ((it) & 3) * 16 : 0; const int pos = (fq < 2) ? (t >> 6) : (t & 63);                                              \
                const f32x4* rp = (const f32x4*)(ropeA + pos * 16 + 8 * (fq & 1)); _Pragma("unroll") for (int k = 0; k < 4; ++k) buf[k] = rp[k]; } while (0)
#define R64_DO(buf, it) do { constexpr int ai = (it) >> 2, m = (it) & 3; const int t = tb + ai * 128 + m * 16;                                                                                  \
                f32x4 x[2][2]; float ss = 0.f;                                                                                                                                                    \
                _Pragma("unroll") for (int s = 0; s < 2; ++s) _Pragma("unroll") for (int n = 0; n < 2; ++n) { x[s][n] = acc[ai][s][m][n];                                                         \
                    ss += (x[s][n][0] * x[s][n][0] + x[s][n][1] * x[s][n][1]) + (x[s][n][2] * x[s][n][2] + x[s][n][3] * x[s][n][3]); }                                                            \
                ss += __shfl_xor(ss, 16); ss += __shfl_xor(ss, 32);                                                                                                                               \
                const float rstd = rsqrtf(ss * (1.0f / 64.0f) + EPS);                                                                                                                             \
                _Pragma("unroll") for (int s = 0; s < 2; ++s) _Pragma("unroll") for (int n = 0; n < 2; ++n) x[s][n] = x[s][n] * rstd * g[s][n];                                                   \
                if (lat) { _Pragma("unroll") for (int n = 0; n < 2; ++n) { const f32x4 c01 = buf[2 * n], c23 = buf[2 * n + 1];               \
                    const f32x4 cs = {c01[0], c01[2], c23[0], c23[2]}, sn = {c01[1], c01[3], c23[1], c23[3]};                                                                                     \
                    const f32x4 u1 = x[0][n], u2 = x[1][n]; x[0][n] = u1 * cs - u2 * sn; x[1][n] = u1 * sn + u2 * cs; } }                                                                         \
                bf16_t* rowp = base + (size_t)t * 64;                                                                                                                                             \
                *(u32x4*)(rowp) = pack8(x[0][0], x[0][1]); *(u32x4*)(rowp + 16) = pack8(x[1][0], x[1][1]); } while (0)
            R64_LD(c0_, 0); R64_LD(c1_, 1); R64_LD(c2_, 2); R64_DO(c0_, 0); R64_LD(c0_, 3); R64_DO(c1_, 1); R64_LD(c1_, 4); R64_DO(c2_, 2); R64_LD(c2_, 5);
            R64_DO(c0_, 3); R64_LD(c0_, 6); R64_DO(c1_, 4); R64_LD(c1_, 7); R64_DO(c2_, 5); R64_DO(c0_, 6); R64_DO(c1_, 7);
#undef R64_LD
#undef R64_DO
        } else if (pt >= PT_RQ && pt < PT_RV) {
            const int isk = pt >= PT_RK, head = 2 * (pt - (isk ? PT_RK : PT_RQ)) + (wc >> 1), d0 = 64 * (wc & 1) + 8 * fq;
            bf16_t* base = r2 + (isk ? (size_t)MR * 512 : (size_t)0) + ((size_t)(b * 4 + head) * TT) * 128 + d0;
            const float osc = isk ? 0.08838834764831845f : 1.0f;
            const bool lat = (u.pm % PPB) != PPB - 1;
            f32x4 c0_[4], c1_[4], c2_[4];
#define R128_LD(buf, it) do { const int t = lat ? tb + ((it) >> 2) * 128 + ((it) & 3) * 16 : 0; const int pos = ((wc & 1) == 0) ? (t >> 6) : (t & 63);                                          \
                const f32x4* rp = (const f32x4*)(ropeB + pos * 32 + 8 * fq); _Pragma("unroll") for (int k = 0; k < 4; ++k) buf[k] = rp[k]; } while (0)
#define R128_DO(buf, it) do { constexpr int ai = (it) >> 2, m = (it) & 3; const int t = tb + ai * 128 + m * 16;                                                                                  \
                f32x4 x[2][2];                                                                                                                                                                    \
                _Pragma("unroll") for (int s = 0; s < 2; ++s) _Pragma("unroll") for (int n = 0; n < 2; ++n) x[s][n] = acc[ai][s][m][n] * osc;                                                     \
                if (lat) { _Pragma("unroll") for (int n = 0; n < 2; ++n) { const f32x4 c01 = buf[2 * n], c23 = buf[2 * n + 1];                                                                     \
                    const f32x4 cs = {c01[0], c01[2], c23[0], c23[2]}, sn = {c01[1], c01[3], c23[1], c23[3]};                                                                                     \
                    const f32x4 u1 = x[0][n], u2 = x[1][n]; x[0][n] = u1 * cs - u2 * sn; x[1][n] = u1 * sn + u2 * cs; } }                                                                         \
                bf16_t* rowp = base + (size_t)t * 128;                                                                                                                                            \
                *(u32x4*)(rowp) = pack8(x[0][0], x[0][1]); *(u32x4*)(rowp + 32) = pack8(x[1][0], x[1][1]); } while (0)
            R128_LD(c0_, 0); R128_LD(c1_, 1); R128_LD(c2_, 2); R128_DO(c0_, 0); R128_LD(c0_, 3); R128_DO(c1_, 1); R128_LD(c1_, 4); R128_DO(c2_, 2); R128_LD(c2_, 5);
            R128_DO(c0_, 3); R128_LD(c0_, 6); R128_DO(c1_, 4); R128_LD(c1_, 7); R128_DO(c2_, 5); R128_DO(c0_, 6); R128_DO(c1_, 7);
#undef R128_LD
#undef R128_DO
        } else {
            int pts, hd; bf16_t* sb;
            if (pt < PT_RQ) { sb = rq + (size_t)MR * 2048; pts = PT_DV; hd = 128; } else if (pt < PT_GQ) { sb = r2 + (size_t)MR * 1024; pts = PT_RV; hd = 256; }
            else { const int s4 = (pt - PT_GQ) >> 2; sb = r1 + (size_t)s4 * MR * 1024; pts = PT_GQ + 4 * s4; hd = 128; }
            const int c = 256 * (pt - pts) + 64 * wc + 8 * fq, head = c / hd, dim = c % hd, H = 1024 / hd;
            bf16_t* base = sb + ((size_t)(b * H + head) * TT) * hd + dim;
            const bool isq = (pt >= PT_GQ && pt < PT_GF);
#pragma unroll
            for (int ai = 0; ai < 2; ++ai)
#pragma unroll
                for (int m = 0; m < 4; ++m) {
                    const int t = tb + ai * 128 + m * 16; bf16_t* rowp = base + (size_t)t * hd;
#pragma unroll
                    for (int bj = 0; bj < 2; ++bj) { f32x4 a = acc[ai][bj][m][0], c2 = acc[ai][bj][m][1];
                        if (isq) {
#pragma unroll
                            for (int e = 0; e < 4; ++e) { a[e] = siluf_(a[e]) * 0.08838834764831845f; c2[e] = siluf_(c2[e]) * 0.08838834764831845f; } }
                        *(u32x4*)(rowp + 32 * bj) = pack8(a, c2); }
                }
        }
    }
};

struct EpiGates {
    static constexpr bool PERM = false, AFTER_DRAIN = false;
    bf16_t *oB, *oC, *G; const float* bias;
    __device__ __forceinline__ void operator()(const acc_t& acc, const pg8::Unit& u, int wr, int wc, int fr, int fq) const {
        const int R0 = u.pm * 256 + wr * 64 + fr;
        if (u.pn < 8) {
            bf16_t* o = (u.pn < 4 ? oB : oC) + 256 * (u.pn & 3) + 64 * wc + 8 * fq + (size_t)R0 * 1024;
            u32x4 wv[2][4][2];
#pragma unroll
            for (int ai = 0; ai < 2; ++ai)
#pragma unroll
                for (int m = 0; m < 4; ++m)
#pragma unroll
                    for (int bj = 0; bj < 2; ++bj) wv[ai][m][bj] = *(const u32x4*)(o + (size_t)(ai * 128 + m * 16) * 1024 + 32 * bj);
#pragma unroll
            for (int ai = 0; ai < 2; ++ai)
#pragma unroll
                for (int m = 0; m < 4; ++m) { bf16_t* rowp = o + (size_t)(ai * 128 + m * 16) * 1024;
#pragma unroll
                    for (int bj = 0; bj < 2; ++bj) { const u32x4 w = wv[ai][m][bj]; const f32x4 a = acc[ai][bj][m][0], c = acc[ai][bj][m][1];
                        const f32x4 r0 = {bflo(w.x) * siluf_(a[0]), bfhi(w.x) * siluf_(a[1]), bflo(w.y) * siluf_(a[2]), bfhi(w.y) * siluf_(a[3])};
                        const f32x4 r1 = {bflo(w.z) * siluf_(c[0]), bfhi(w.z) * siluf_(c[1]), bflo(w.w) * siluf_(c[2]), bfhi(w.w) * siluf_(c[3])};
                        *(u32x4*)(rowp + 32 * bj) = pack8(r0, r1); } }
        } else {
            const int t = u.pn - 8, n = t >> 3, c0 = 256 * (t & 7) + 64 * wc + 8 * fq;
            const float* bp = bias + n * D + c0; bf16_t* Gn = G + (size_t)n * MR * D + c0;
            f32x4 bv[2][2];
#pragma unroll
            for (int bj = 0; bj < 2; ++bj)
#pragma unroll
                for (int k = 0; k < 2; ++k) bv[bj][k] = *(const f32x4*)(bp + 32 * bj + 4 * k);
#pragma unroll
            for (int ai = 0; ai < 2; ++ai)
#pragma unroll
                for (int m = 0; m < 4; ++m) { bf16_t* rowp = Gn + (size_t)(R0 + ai * 128 + m * 16) * D;
#pragma unroll
                    for (int bj = 0; bj < 2; ++bj) { f32x4 a = acc[ai][bj][m][0] + bv[bj][0], c = acc[ai][bj][m][1] + bv[bj][1];
#pragma unroll
                        for (int e = 0; e < 4; ++e) { a[e] = fmaxf(sigmoidf_(a[e]), 7.888609052210118e-31f); c[e] = fmaxf(sigmoidf_(c[e]), 7.888609052210118e-31f); }
                        u32x4 w; w.x = cvtpk_c(a[0], a[1]); w.y = cvtpk_c(a[2], a[3]); w.z = cvtpk_c(c[0], c[1]); w.w = cvtpk_c(c[2], c[3]);
                        *(u32x4*)(rowp + 32 * bj) = w; } }
        }
    }
};
struct EpiProjAll {
    static constexpr bool PERM = false, AFTER_DRAIN = false, KEEPS_ACC = true;
    const bf16_t* G; bf16_t* y;
    __device__ __forceinline__ void operator()(acc_t& acc, const pg8::Unit& u, int wr, int wc, int fr, int fq) const {
        const int n = u.pm / NPAN, pm = u.pm - n * NPAN, pn = u.pn & 7;
        const int c0 = 256 * pn + 64 * wc + 8 * fq, R0 = pm * 256 + wr * 64 + fr;
        const bf16_t* Gn = G + (size_t)n * MR * D + (size_t)R0 * D + c0; const bf16_t* Gx = Gn + (size_t)MR * D;
        bf16_t* yp = y + (size_t)R0 * D + c0;
        u32x4 wa[4], xa[4], wb[4], xb[4];
#define PJ_LD(GW_, GX_, ai, bj) do { _Pragma("unroll") for (int m = 0; m < 4; ++m) { const size_t ro = (size_t)((ai) * 128 + m * 16) * D + 32 * (bj); GW_[m] = *(const u32x4*)(Gn + ro); GX_[m] = *(const u32x4*)(Gx + ro); } } while (0)
#define PJ_LD1(GW_, ai, bj) do { _Pragma("unroll") for (int m = 0; m < 4; ++m) { const size_t ro = (size_t)((ai) * 128 + m * 16) * D + 32 * (bj); GW_[m] = *(const u32x4*)(Gn + ro); } } while (0)
#define PJ_RATIO(GW_, GX_, ai, bj) do { _Pragma("unroll") for (int m = 0; m < 4; ++m) {                                                     \
            const float g[8] = {bflo(GW_[m].x), bfhi(GW_[m].x), bflo(GW_[m].y), bfhi(GW_[m].y), bflo(GW_[m].z), bfhi(GW_[m].z), bflo(GW_[m].w), bfhi(GW_[m].w)};            \
            const float d[8] = {bflo(GX_[m].x), bfhi(GX_[m].x), bflo(GX_[m].y), bfhi(GX_[m].y), bflo(GX_[m].z), bfhi(GX_[m].z), bflo(GX_[m].w), bfhi(GX_[m].w)};            \
            f32x4 r0 = acc[ai][bj][m][0], r1 = acc[ai][bj][m][1];                                                                                                         \
            _Pragma("unroll") for (int e = 0; e < 4; ++e) { r0[e] *= g[e] * __builtin_amdgcn_rcpf(d[e]); r1[e] *= g[4 + e] * __builtin_amdgcn_rcpf(d[4 + e]); }           \
            acc[ai][bj][m][0] = r0; acc[ai][bj][m][1] = r1; } } while (0)
#define PJ_FINAL(GW_, ai, bj) do { _Pragma("unroll") for (int m = 0; m < 4; ++m) {                                                           \
            const float g[8] = {bflo(GW_[m].x), bfhi(GW_[m].x), bflo(GW_[m].y), bfhi(GW_[m].y), bflo(GW_[m].z), bfhi(GW_[m].z), bflo(GW_[m].w), bfhi(GW_[m].w)};            \
            f32x4 r0 = acc[ai][bj][m][0], r1 = acc[ai][bj][m][1];                                                                                                         \
            _Pragma("unroll") for (int e = 0; e < 4; ++e) { r0[e] *= g[e]; r1[e] *= g[4 + e]; }                                                                           \
            *(u32x4*)(yp + (size_t)((ai) * 128 + m * 16) * D + 32 * (bj)) = pack8(r0, r1); } } while (0)
        if (n < 2) { PJ_LD(wa, xa, 0, 0); PJ_LD(wb, xb, 0, 1); PJ_RATIO(wa, xa, 0, 0); PJ_LD(wa, xa, 1, 0); PJ_RATIO(wb, xb, 0, 1); PJ_LD(wb, xb, 1, 1); PJ_RATIO(wa, xa, 1, 0); PJ_RATIO(wb, xb, 1, 1); }
        else { PJ_LD1(wa, 0, 0); PJ_LD1(wb, 0, 1); PJ_LD1(xa, 1, 0); PJ_LD1(xb, 1, 1); PJ_FINAL(wa, 0, 0); PJ_FINAL(wb, 0, 1); PJ_FINAL(xa, 1, 0); PJ_FINAL(xb, 1, 1); }
#undef PJ_LD
#undef PJ_LD1
#undef PJ_RATIO
#undef PJ_FINAL
    }
};
struct EpiRes {
    static constexpr bool PERM = false, AFTER_DRAIN = false;
    const float *srcx, *srcc; float *dstx, *dstc; const float* gate0;
    __device__ __forceinline__ void operator()(const acc_t& acc, const pg8::Unit& u, int wr, int wc, int fr, int fq) const {
        const int b = u.pm / PPB, lp = u.pm % PPB, c0 = 256 * u.pn + 64 * wc + 8 * fq, r0 = wr * 64 + fr;
        const bool isc = (lp == PPB - 1);
        const size_t rb = isc ? (size_t)(b * LC) : (size_t)(b * T + lp * 256);
        const float* s = (isc ? srcc : srcx) + (rb + r0) * D + c0; float* d = (isc ? dstc : dstx) + (rb + r0) * D + c0;
        const float* gp = gate0 + (size_t)(isc ? 2 : b) * 6 * D + c0;
        f32x4 gv[2][2];
#pragma unroll
        for (int bj = 0; bj < 2; ++bj)
#pragma unroll
            for (int n = 0; n < 2; ++n) gv[bj][n] = *(const f32x4*)(gp + 32 * bj + 4 * n);
        f32x4 sa[4][2], sb[4][2];
#define RES_LD(buf, ai, bj) do { _Pragma("unroll") for (int m = 0; m < 4; ++m) _Pragma("unroll") for (int n = 0; n < 2; ++n) buf[m][n] = *(const f32x4*)(s + (size_t)((ai) * 128 + m * 16) * D + 32 * (bj) + 4 * n); } while (0)
#define RES_ST(buf, ai, bj) do { _Pragma("unroll") for (int m = 0; m < 4; ++m) _Pragma("unroll") for (int n = 0; n < 2; ++n) *(f32x4*)(d + (size_t)((ai) * 128 + m * 16) * D + 32 * (bj) + 4 * n) = buf[m][n] + gv[bj][n] * acc[ai][bj][m][n]; } while (0)
        RES_LD(sa, 0, 0); RES_LD(sb, 0, 1); RES_ST(sa, 0, 0); RES_LD(sa, 1, 0); RES_ST(sb, 0, 1); RES_LD(sb, 1, 1); RES_ST(sa, 1, 0); RES_ST(sb, 1, 1);
#undef RES_LD
#undef RES_ST
    }
};
__device__ __forceinline__ float dpp_up1(float cur, float prev) {
    const int old = __builtin_amdgcn_mov_dpp(__float_as_int(prev), 0x121  , 0xf, 0xf, false);
    return __int_as_float(__builtin_amdgcn_update_dpp(old, __float_as_int(cur), 0x111  , 0xf, 0xf, false));
}
__device__ __forceinline__ float dpp_dn1(float cur, float next) {
    const int old = __builtin_amdgcn_mov_dpp(__float_as_int(next), 0x12F  , 0xf, 0xf, false);
    return __int_as_float(__builtin_amdgcn_update_dpp(old, __float_as_int(cur), 0x101  , 0xf, 0xf, false));
}
struct EpiConv {
    static constexpr bool PERM = false, AFTER_DRAIN = false;
    bf16_t* g; float* raw; const float* cw; const float* cb;
    __device__ __forceinline__ void operator()(const acc_t& acc, const pg8::Unit& u, int wr, int wc, int fr, int fq) const {
        const int jc = 128 * u.pn + 32 * wc + 8 * fq, R0 = u.pm * 256 + wr * 64 + fr;
        u32x2 keep[2][4];
        f32x4 cwv[2][8];
#pragma unroll
        for (int n = 0; n < 2; ++n) { const int j = jc + 4 * n;
            cwv[n][0] = *(const f32x4*)(cw + j); cwv[n][1] = *(const f32x4*)(cw + NUP + j); cwv[n][2] = *(const f32x4*)(cw + 2 * NUP + j); cwv[n][3] = *(const f32x4*)(cb + j);
            cwv[n][4] = *(const f32x4*)(cw + DFF + j); cwv[n][5] = *(const f32x4*)(cw + NUP + DFF + j); cwv[n][6] = *(const f32x4*)(cw + 2 * NUP + DFF + j); cwv[n][7] = *(const f32x4*)(cb + DFF + j); }
        const float m0 = (fr == 0) ? 1.0f : 0.0f, m15 = (fr == 15) ? 1.0f : 0.0f;
#define FMAC_DPP(y, x, w, CTRL) asm("v_fmac_f32_dpp %0, %1, %2 " CTRL " row_mask:0xf bank_mask:0xf bound_ctrl:1" : "+v"(y) : "v"(x), "v"(w))
#pragma unroll
        for (int n = 0; n < 2; ++n) {
            const int j = jc + 4 * n;
            const f32x4 wg0 = cwv[n][0], wg1 = cwv[n][1], wg2 = cwv[n][2], bg = cwv[n][3];
            const f32x4 wu0 = cwv[n][4], wu1 = cwv[n][5], wu2 = cwv[n][6], bu = cwv[n][7];
            const f32x4 wg0e = wg0 * m0, wg2e = wg2 * m15, wu0e = wu0 * m0, wu2e = wu2 * m15;
#pragma unroll
            for (int ai = 0; ai < 2; ++ai)
#pragma unroll
                for (int m = 0; m < 4; ++m) {
                    const f32x4 xg = acc[ai][0][m][n], xu = acc[ai][1][m][n];
                    const f32x4 pg = acc[ai][0][m > 0 ? m - 1 : 0][n], ng = acc[ai][0][m < 3 ? m + 1 : 3][n], pu = acc[ai][1][m > 0 ? m - 1 : 0][n], nu = acc[ai][1][m < 3 ? m + 1 : 3][n];
                    f32x4 yg, yu;
#pragma unroll
                    for (int e = 0; e < 4; ++e) {
                        float g_ = wg1[e] * xg[e] + bg[e], u_ = wu1[e] * xu[e] + bu[e];
                        { const float a0 = xg[e], a1 = pg[e], a2 = ng[e], c0 = wg0[e], c1 = wg0e[e], c2 = wg2[e], c3 = wg2e[e];
                          FMAC_DPP(g_, a0, c0, "row_shr:1"); FMAC_DPP(g_, a1, c1, "row_mirror"); FMAC_DPP(g_, a0, c2, "row_shl:1"); FMAC_DPP(g_, a2, c3, "row_mirror"); }
                        { const float a0 = xu[e], a1 = pu[e], a2 = nu[e], c0 = wu0[e], c1 = wu0e[e], c2 = wu2[e], c3 = wu2e[e];
                          FMAC_DPP(u_, a0, c0, "row_shr:1"); FMAC_DPP(u_, a1, c1, "row_mirror"); FMAC_DPP(u_, a0, c2, "row_shl:1"); FMAC_DPP(u_, a2, c3, "row_mirror"); }
                        yg[e] = g_; yu[e] = u_;
                    }
                    f32x4 r;
#pragma unroll
                    for (int e = 0; e < 4; ++e) r[e] = siluf_(yg[e]) * yu[e];
                    u32x2 pk; pk.x = cvtpk(r[0], r[1]); pk.y = cvtpk(r[2], r[3]);
                    if (n == 0) keep[ai][m] = pk;
                    else { u32x4 w; w.x = keep[ai][m].x; w.y = keep[ai][m].y; w.z = pk.x; w.w = pk.y; *(u32x4*)(g + (size_t)(R0 + ai * 128 + m * 16) * DFF + jc) = w; }
                    if ((m == 0 && fr < 2) || (m == 3 && fr >= 14)) {
                        const int slot = (m == 0) ? fr : fr - 12; float* rp = raw + ((size_t)(u.pm * 4 + ai * 2 + wr) * 4 + slot) * NUP + j;
                        *(f32x4*)(rp) = xg; *(f32x4*)(rp + DFF) = xu;
                    }
                }
        }
#undef FMAC_DPP
    }
};

namespace att {
constexpr int KVBLK = 64;
constexpr int SHM_V = 64 * 128 * 2, SHM_K = 64 * 64 * 2;
#define KSWZ64(row, colB) ((row) * 128 + ((colB) ^ ((((row) >> 1) & 7) << 4)))
#define SBAR() __builtin_amdgcn_sched_barrier(0)
__device__ __forceinline__ int crow(int r, int hi) { return (r & 3) + 8 * (r >> 2) + 4 * hi; }
template <int SK = 0> __device__ __forceinline__ void exp16(f32x16& p) {
    if (SK & 1) return;
#pragma unroll
    for (int r = 0; r < 16; ++r) p[r] = __builtin_amdgcn_exp2f(p[r]);
}
template <int BASE> __device__ __forceinline__ void exp8(f32x16& p) {
    float e[8];
#pragma unroll
    for (int r = 0; r < 8; ++r) e[r] = __builtin_amdgcn_exp2f(p[BASE + r]);
    asm volatile("" : "+v"(e[0]), "+v"(e[1]), "+v"(e[2]), "+v"(e[3]), "+v"(e[4]), "+v"(e[5]), "+v"(e[6]), "+v"(e[7]));
#pragma unroll
    for (int r = 0; r < 8; ++r) p[BASE + r] = e[r];
}
template <int SK = 0> __device__ __forceinline__ void finishSM(f32x16& p0, f32x16& p1, float& lsum, bf16x8& pa0, bf16x8& pa1, bf16x8& pa2, bf16x8& pa3) {
    if (SK & 8) { lsum += p0[0] + p1[0]; const unsigned c_ = cvtpk(p0[1], p1[1]); u32x4 w_ = {c_, c_, c_, c_}; pa0 = pa1 = pa2 = pa3 = *reinterpret_cast<bf16x8*>(&w_); return; }
    float ps = 0;
#pragma unroll
    for (int r = 0; r < 16; ++r) ps += p0[r];
#pragma unroll
    for (int r = 0; r < 16; ++r) ps += p1[r];
    lsum += ps;
#define PK4(P, BASE, OUT) do { unsigned a0 = cvtpk(P[BASE + 0], P[BASE + 1]), a1 = cvtpk(P[BASE + 2], P[BASE + 3]);   \
    unsigned b0 = cvtpk(P[BASE + 4], P[BASE + 5]), b1 = cvtpk(P[BASE + 6], P[BASE + 7]);                              \
    auto r0 = __builtin_amdgcn_permlane32_swap(a0, b0, false, false); auto r1 = __builtin_amdgcn_permlane32_swap(a1, b1, false, false); \
    u32x4 w = {r0[0], r1[0], r0[1], r1[1]}; OUT = *reinterpret_cast<bf16x8*>(&w); } while (0)
    PK4(p0, 0, pa0); PK4(p0, 8, pa1); PK4(p1, 0, pa2); PK4(p1, 8, pa3);
#undef PK4
}
template <int SK = 0> __device__ __forceinline__ void qkt(f32x16& p0, f32x16& p1, const LAS char* Ks, const bf16x8* qr, int r32, int hi, float negM) {
#pragma unroll
    for (int r = 0; r < 16; ++r) { p0[r] = 0.f; p1[r] = 0.f; }
    if (SK & 4) return;
#pragma unroll
    for (int d0 = 0; d0 < 4; ++d0) { const int cb = (d0 * 16 + hi * 8) * 2;
        const bf16x8 b0 = *(const LAS bf16x8*)(Ks + KSWZ64(r32, cb));
        const bf16x8 b1 = *(const LAS bf16x8*)(Ks + KSWZ64(32 + r32, cb));
        p0 = __builtin_amdgcn_mfma_f32_32x32x16_bf16(b0, qr[d0], p0, 0, 0, 0);
        p1 = __builtin_amdgcn_mfma_f32_32x32x16_bf16(b1, qr[d0], p1, 0, 0, 0); }
}
__device__ __forceinline__ int v_st(int k, int c) { const int kk = (k & ~0xC) | ((k & 4) << 1) | ((k & 8) >> 1); return ((kk >> 3) * 4 + (c >> 5)) * 512 + ((kk & 7) * 32 + (c & 31)) * 2; }
__device__ __forceinline__ int v_rd_base(int lane) { return ((lane & 3) << 3) | (((lane >> 2) & 3) << 6) | (((lane >> 4) & 1) << 5) | (((lane >> 5) & 1) << 8); }
constexpr int v_rd_off(int d0, int ks, int half) { return d0 * 512 + ks * 4096 + half * 2048; }
template <int OFF> __device__ __forceinline__ s16x4 tr_read(int vb) {
  s16x4 r; asm volatile("ds_read_b64_tr_b16 %0, %1 offset:%2" : "=&v"(r) : "v"(vb), "i"(OFF) : "memory"); return r;
}
template <int D0> __device__ __forceinline__ void pv_one(f32x16& od, int vb, bf16x8 pa0, bf16x8 pa1, bf16x8 pa2, bf16x8 pa3) {
  const s16x4 l0 = tr_read<v_rd_off(D0, 0, 0)>(vb), h0 = tr_read<v_rd_off(D0, 0, 1)>(vb), l1 = tr_read<v_rd_off(D0, 1, 0)>(vb), h1 = tr_read<v_rd_off(D0, 1, 1)>(vb);
  const s16x4 l2 = tr_read<v_rd_off(D0, 2, 0)>(vb), h2 = tr_read<v_rd_off(D0, 2, 1)>(vb), l3 = tr_read<v_rd_off(D0, 3, 0)>(vb), h3 = tr_read<v_rd_off(D0, 3, 1)>(vb);
  asm volatile("s_waitcnt lgkmcnt(0)" ::: "memory"); SBAR();
#define PK(L, H) (bf16x8){L[0], L[1], L[2], L[3], H[0], H[1], H[2], H[3]}
  od = __builtin_amdgcn_mfma_f32_32x32x16_bf16(pa0, PK(l0, h0), od, 0, 0, 0);
  od = __builtin_amdgcn_mfma_f32_32x32x16_bf16(pa1, PK(l1, h1), od, 0, 0, 0);
  od = __builtin_amdgcn_mfma_f32_32x32x16_bf16(pa2, PK(l2, h2), od, 0, 0, 0);
  od = __builtin_amdgcn_mfma_f32_32x32x16_bf16(pa3, PK(l3, h3), od, 0, 0, 0);
#undef PK
}
template <int SK = 0> __device__ __forceinline__ void pv_d0(f32x16* o, int vb, bf16x8 pa0, bf16x8 pa1, bf16x8 pa2, bf16x8 pa3) {
  if (SK & 2) { o[0][0] += __builtin_bit_cast(float, (int)pa0[0] << 16); return; }
  pv_one<0>(o[0], vb, pa0, pa1, pa2, pa3); pv_one<1>(o[1], vb, pa0, pa1, pa2, pa3); pv_one<2>(o[2], vb, pa0, pa1, pa2, pa3); pv_one<3>(o[3], vb, pa0, pa1, pa2, pa3);
}
#define ATT_WAITL(n) asm volatile("s_waitcnt lgkmcnt(" #n ")" ::: "memory")
template <int D0> __device__ __forceinline__ void readv(s16x4 (&v)[8], int vb) {
  v[0] = tr_read<v_rd_off(D0, 0, 0)>(vb); v[1] = tr_read<v_rd_off(D0, 0, 1)>(vb); v[2] = tr_read<v_rd_off(D0, 1, 0)>(vb); v[3] = tr_read<v_rd_off(D0, 1, 1)>(vb);
  v[4] = tr_read<v_rd_off(D0, 2, 0)>(vb); v[5] = tr_read<v_rd_off(D0, 2, 1)>(vb); v[6] = tr_read<v_rd_off(D0, 3, 0)>(vb); v[7] = tr_read<v_rd_off(D0, 3, 1)>(vb);
}
__device__ __forceinline__ void pvm(f32x16& od, const s16x4 (&v)[8], bf16x8 pa0, bf16x8 pa1, bf16x8 pa2, bf16x8 pa3) {
#define PK(L, H) (bf16x8){L[0], L[1], L[2], L[3], H[0], H[1], H[2], H[3]}
  od = __builtin_amdgcn_mfma_f32_32x32x16_bf16(pa0, PK(v[0], v[1]), od, 0, 0, 0);
  od = __builtin_amdgcn_mfma_f32_32x32x16_bf16(pa1, PK(v[2], v[3]), od, 0, 0, 0);
  od = __builtin_amdgcn_mfma_f32_32x32x16_bf16(pa2, PK(v[4], v[5]), od, 0, 0, 0);
  od = __builtin_amdgcn_mfma_f32_32x32x16_bf16(pa3, PK(v[6], v[7]), od, 0, 0, 0);
#undef PK
}
template <int SK, bool HASNEXT> __device__ __forceinline__ void tile_step(f32x16& pN0, f32x16& pN1, f32x16 (&o)[4], const bf16x8 (&qr)[4], float& lsum,
                                                                         const LAS char* ksn, int vbc, float negM, int r32, int hi) {
  bf16x8 kf0[4], kf1[4], pa0, pa1, pa2, pa3; s16x4 va[8], vc[8], vd[8];
  if (HASNEXT && !(SK & 4)) {
#pragma unroll
    for (int d0 = 0; d0 < 4; ++d0) { const int cb = (d0 * 16 + hi * 8) * 2; kf0[d0] = *(const LAS bf16x8*)(ksn + KSWZ64(r32, cb)); kf1[d0] = *(const LAS bf16x8*)(ksn + KSWZ64(32 + r32, cb)); }
  }
  SBAR();
  finishSM<SK>(pN0, pN1, lsum, pa0, pa1, pa2, pa3);
  SBAR();
  if (SK & 2) { o[0][0] += __builtin_bit_cast(float, (int)pa0[0] << 16); }
  else { readv<0>(va, vbc); readv<1>(vc, vbc); }
  SBAR();
  if (HASNEXT) {
#pragma unroll
    for (int r = 0; r < 16; ++r) { pN0[r] = 0.f; pN1[r] = 0.f; }
    if (!(SK & 4)) {
      if (SK & 2) ATT_WAITL(0); else ATT_WAITL(15);
      SBAR();
#pragma unroll
      for (int d0 = 0; d0 < 4; ++d0) { pN0 = __builtin_amdgcn_mfma_f32_32x32x16_bf16(kf0[d0], qr[d0], pN0, 0, 0, 0); pN1 = __builtin_amdgcn_mfma_f32_32x32x16_bf16(kf1[d0], qr[d0], pN1, 0, 0, 0); }
    }
  }
  SBAR();
  if (!(SK & 2)) {
    readv<2>(vd, vbc); SBAR(); ATT_WAITL(15); SBAR(); pvm(o[0], va, pa0, pa1, pa2, pa3); if (HASNEXT && !(SK & 1)) exp8<0>(pN0); SBAR();
    readv<3>(va, vbc); SBAR(); ATT_WAITL(15); SBAR(); pvm(o[1], vc, pa0, pa1, pa2, pa3); if (HASNEXT && !(SK & 1)) exp8<8>(pN0); SBAR();
    ATT_WAITL(8); SBAR(); pvm(o[2], vd, pa0, pa1, pa2, pa3); if (HASNEXT && !(SK & 1)) exp8<0>(pN1); SBAR();
    ATT_WAITL(0); SBAR(); pvm(o[3], va, pa0, pa1, pa2, pa3); if (HASNEXT && !(SK & 1)) exp8<8>(pN1); SBAR();
  } else if (HASNEXT && !(SK & 1)) { exp8<0>(pN0); exp8<8>(pN0); exp8<0>(pN1); exp8<8>(pN1); }
}
constexpr int SLOT = SHM_K + SHM_V, NSLOT = 4;
#define ATT_WAITV(n) asm volatile("s_waitcnt vmcnt(" #n ")" ::: "memory")
template <int SK = 0> __device__ __forceinline__ void attn_unit(const bf16_t* __restrict__ Qb, const bf16_t* __restrict__ Kh, const bf16_t* __restrict__ Vh, bf16_t* Ob, bf16_t* oAb, int second, float lam, float post,
                                                                const float* __restrict__ subln, int nkeys, float negM, LAS char* lds) {
  int tid_ = threadIdx.x; asm volatile("" : "+v"(tid_));
  const int tid = tid_, wid = __builtin_amdgcn_readfirstlane(tid >> 6), lane = tid & 63, r32 = lane & 31, hi = lane >> 5;
  LAS float* li_l = (LAS float*)(lds + NSLOT * SLOT) + wid * 64;
  float lsum = 0; f32x16 o[4];
#pragma unroll
  for (int d = 0; d < 4; ++d)
#pragma unroll
    for (int r = 0; r < 16; ++r) o[d][r] = 0.f;
  bf16x8 qr[4];
  const bf16_t* Qw = Qb + (long)(wid * 32 + r32) * 64 + hi * 8;
#pragma unroll
  for (int d0 = 0; d0 < 4; ++d0) qr[d0] = *reinterpret_cast<const bf16x8*>(Qw + d0 * 16);
  unsigned offK, offV[2];
  { const int row = 8 * wid + (lane >> 3), ch = (lane & 7) ^ ((row >> 1) & 7); offK = (unsigned)(row * 64 + ch * 8); }
#pragma unroll
  for (int i = 0; i < 2; ++i) { const int piece = wid + 8 * i, sub = piece * 2 + (lane >> 5), kk = (sub >> 2) * 8 + ((lane & 31) >> 2), k = (kk & ~0xC) | ((kk & 4) << 1) | ((kk & 8) >> 1), c = (sub & 3) * 32 + 8 * (lane & 3);
      offV[i] = (unsigned)(k * 128 + c); }
  const int vbase = (int)(uintptr_t)lds + SHM_K + v_rd_base(lane);
#define ISSUE(t) do { const int s_ = (t) & (NSLOT - 1); const long k0_ = (long)(t) * KVBLK; \
    __builtin_amdgcn_global_load_lds((const unsigned*)(Kh + k0_ * 64 + offK), (LAS unsigned*)(lds + s_ * SLOT + wid * 1024), 16, 0, 0); \
    __builtin_amdgcn_global_load_lds((const unsigned*)(Vh + k0_ * 128 + offV[0]), (LAS unsigned*)(lds + s_ * SLOT + SHM_K + wid * 1024), 16, 0, 0); \
    __builtin_amdgcn_global_load_lds((const unsigned*)(Vh + k0_ * 128 + offV[1]), (LAS unsigned*)(lds + s_ * SLOT + SHM_K + 8192 + wid * 1024), 16, 0, 0); } while (0)
#define KS(t) (lds + ((t) & (NSLOT - 1)) * SLOT)
#define VB(t) (vbase + ((t) & (NSLOT - 1)) * SLOT)
  f32x16 pA0, pA1; const int NT = nkeys / KVBLK;
  if (wid >= 4) __builtin_amdgcn_s_setprio(1);
  ATT_WAITV(0);
  ISSUE(0); ISSUE(1); ISSUE(2);
  ATT_WAITV(6); __builtin_amdgcn_s_barrier(); asm volatile("" ::: "memory");
  qkt<SK>(pA0, pA1, KS(0), qr, r32, hi, negM); exp16<SK>(pA0); exp16<SK>(pA1);
  for (int j = 0; j + 2 < NT; ++j) {
    if (j + 2 < NT) ATT_WAITV(3); else ATT_WAITV(0);
    __builtin_amdgcn_s_barrier(); asm volatile("" ::: "memory");
    if (!(SK & 16) && j + 3 < NT) ISSUE(j + 3);
    tile_step<SK, true>(pA0, pA1, o, qr, lsum, KS(j + 1), VB(j), negM, r32, hi);
  }
  ATT_WAITV(0); __builtin_amdgcn_s_barrier(); asm volatile("" ::: "memory");
  tile_step<SK, true>(pA0, pA1, o, qr, lsum, KS(NT - 1), VB(NT - 2), negM, r32, hi);
  tile_step<SK, false>(pA0, pA1, o, qr, lsum, KS(NT - 1), VB(NT - 1), negM, r32, hi);
  { auto rr = __builtin_amdgcn_permlane32_swap(__float_as_uint(lsum), __float_as_uint(lsum), false, false); lsum = __uint_as_float(rr[0]) + __uint_as_float(rr[1]); }
  if (hi == 0) li_l[r32] = lsum; asm volatile("s_waitcnt lgkmcnt(0)" ::: "memory");
  float rli[16];
#pragma unroll
  for (int r = 0; r < 16; ++r) rli[r] = __builtin_amdgcn_rcpf(li_l[crow(r, hi)]);
  bf16_t* Ow = Ob + (long)(wid * 32) * 1024;
  if (!second) {
#pragma unroll
    for (int r = 0; r < 16; ++r) { const int orow = crow(r, hi);
#pragma unroll
      for (int d0 = 0; d0 < 4; ++d0) Ow[(long)orow * 1024 + d0 * 32 + r32] = (bf16_t)(cvtpk(o[d0][r] * rli[r], 0.f) & 0xffffu); }
  } else {
    float sl[4];
#pragma unroll
    for (int d0 = 0; d0 < 4; ++d0) sl[d0] = subln[d0 * 32 + r32];
    bf16_t* Aw = oAb + (long)(wid * 32) * 1024;
#pragma unroll
    for (int rg = 0; rg < 4; ++rg) {
      unsigned short o1[4][4];
#pragma unroll
      for (int j = 0; j < 4; ++j)
#pragma unroll
        for (int d0 = 0; d0 < 4; ++d0) o1[j][d0] = *(const unsigned short*)(Ow + (long)crow(4 * rg + j, hi) * 1024 + d0 * 32 + r32);
#pragma unroll
      for (int j = 0; j < 4; ++j) { const int r = 4 * rg + j; float dd[4], ss = 0.f;
#pragma unroll
        for (int d0 = 0; d0 < 4; ++d0) { dd[d0] = __uint_as_float((unsigned)o1[j][d0] << 16) - lam * (o[d0][r] * rli[r]); ss += dd[d0] * dd[d0]; }
        ss += __shfl_xor(ss, 1); ss += __shfl_xor(ss, 2); ss += __shfl_xor(ss, 4); ss += __shfl_xor(ss, 8); ss += __shfl_xor(ss, 16);
        const float rs = rsqrtf(ss * (1.0f / 128.0f) + EPS) * post; bf16_t* rowp = Aw + (long)crow(r, hi) * 1024;
#pragma unroll
        for (int d0 = 0; d0 < 4; ++d0) { const float y = dd[d0] * rs; rowp[d0 * 32 + r32] = (bf16_t)(cvtpk(y * sl[d0], 0.f) & 0xffffu); } }
    }
  }
  __builtin_amdgcn_s_setprio(0);
  __builtin_amdgcn_s_barrier(); asm volatile("" ::: "memory");
#undef ISSUE
#undef KS
#undef VB
#undef ITER
}
}

template <int SK = 0> __device__ __forceinline__ void attn_phase(Frame& F, int l) {
    const bf16_t* Q = WSP(bf16_t, DY_QKV); const bf16_t* K = Q + (size_t)MR * 1024; const bf16_t* V = K + (size_t)MR * 1024;
    bf16_t* O = WSP(bf16_t, DY_O1); bf16_t* oA = WSP(bf16_t, DY_OA); const float negM = 0.f;
    const float lam = WSP(float, WS_SCAL)[l]; const float post = 1.0f - (0.8f - 0.6f * expf(-0.3f * (float)l)); const float* subln = inp(F, I_SUBLN) + l * 128;
    const int NL = NB * 8 * 64, NU = NL + (l == 0 ? NB * 8 : 0);
    for (int i = 0; i * F.G < NU; ++i) {
        int u = i * F.G + F.bid;
        if (F.G == 256 && i < 4) { const int hh = i * 8 + (F.bid & 7); u = (hh >> 1) * 64 + (hh & 1) * 32 + (F.bid >> 3); }
        if (u >= NU) break;
        int p, q0, k0, nk;
        if (u < NL) { p = u / 64; q0 = (u % 64) * 256; k0 = 0; nk = TT; }
        else { p = u - NL; q0 = T; k0 = T; nk = LC; }
        const int b = p >> 3, h = p & 7;
        for (int sm = 0; sm < 2; ++sm) {
            const size_t hb = (size_t)(b * 16 + 2 * h + sm) * TT;
            att::attn_unit<SK>(Q + (hb + q0) * 64, K + (hb + k0) * 64, V + ((size_t)(b * 8 + h) * TT + k0) * 128, O + ((size_t)b * TT + q0) * 1024 + h * 128, oA + ((size_t)b * TT + q0) * 1024 + h * 128,
                               sm, lam, post, subln, nk, negM, (LAS char*)F.lds);
        }
    }
}
__device__ __forceinline__ void ffn_fixup(Frame& F, int l) {
    const float* raw = WSP(float, DY_RAW); bf16_t* g = WSP(bf16_t, DY_G);
    const float* cw = inp(F, I_CONVW) + (size_t)l * 3 * NUP; const float* cb = inp(F, I_CONVB) + (size_t)l * NUP;
    const int NBLK = MR / 64, per = DFF / 4;
    const size_t total = (size_t)NBLK * 2 * per;
    for (size_t it = (size_t)F.bid * NTHR + F.tid; it < total; it += (size_t)F.G * NTHR) {
        const int cq = (int)(it % per), rb = (int)(it / per), blk = rb >> 1, last = rb & 1, j = cq * 4;
        const int bl = blk % (TT / 64);
        const bool seq_first = (bl == 0 || bl == T / 64), seq_last = (bl == T / 64 - 1 || bl == TT / 64 - 1);
        const float* rc = raw + ((size_t)blk * 4 + (last ? 3 : 0)) * NUP;
        const float* rp = last ? raw + ((size_t)blk * 4 + 2) * NUP : raw + ((size_t)(blk - 1) * 4 + 3) * NUP;
        const float* rn = last ? raw + ((size_t)(blk + 1) * 4 + 0) * NUP : raw + ((size_t)blk * 4 + 1) * NUP;
        const bool zp = (!last && seq_first), zn = (last && seq_last);
        const f32x4 z4 = {0.f, 0.f, 0.f, 0.f};
        f32x4 v[14];
        { const float* rpp = zp ? rc : rp; const float* rnn = zn ? rc : rn;
          v[0] = *(const f32x4*)(rpp + j); v[1] = *(const f32x4*)(rpp + DFF + j); v[2] = *(const f32x4*)(rnn + j); v[3] = *(const f32x4*)(rnn + DFF + j);
          v[4] = *(const f32x4*)(rc + j); v[5] = *(const f32x4*)(rc + DFF + j);
          v[6] = *(const f32x4*)(cw + j); v[7] = *(const f32x4*)(cw + NUP + j); v[8] = *(const f32x4*)(cw + 2 * NUP + j); v[9] = *(const f32x4*)(cb + j);
          v[10] = *(const f32x4*)(cw + DFF + j); v[11] = *(const f32x4*)(cw + NUP + DFF + j); v[12] = *(const f32x4*)(cw + 2 * NUP + DFF + j); v[13] = *(const f32x4*)(cb + DFF + j); }
#pragma unroll
        for (int k = 0; k < 14; ++k) asm volatile("" : "+v"(v[k]));
        const f32x4 pg = zp ? z4 : v[0], pu = zp ? z4 : v[1], ng = zn ? z4 : v[2], nu = zn ? z4 : v[3], xg = v[4], xu = v[5];
        const f32x4 yg = v[6] * pg + v[7] * xg + v[8] * ng + v[9];
        const f32x4 yu = v[10] * pu + v[11] * xu + v[12] * nu + v[13];
        u32x2 w; w.x = cvtpk(siluf_(yg[0]) * yu[0], siluf_(yg[1]) * yu[1]); w.y = cvtpk(siluf_(yg[2]) * yu[2], siluf_(yg[3]) * yu[3]);
        *(u32x2*)(g + (size_t)(blk * 64 + (last ? 63 : 0)) * DFF + j) = w;
    }
}

namespace scn {
using att::crow; using att::v_st; using att::v_rd_base; using att::v_rd_off; using att::tr_read;
__device__ __forceinline__ int cp_of(int c, int dir) { return c == PPB - 1 ? 0 : (dir ? (PPB - 1) - c : c + 1); }
#define KSWZ256(row, colB) ((row) * 256 + ((colB) ^ (((row) & 7) << 4)))
#define PKF(L, H) (bf16x8){L[0], L[1], L[2], L[3], H[0], H[1], H[2], H[3]}
__device__ __forceinline__ u32x4 scale8(const u32x4 w, float s) { u32x4 o; o.x = cvtpk(bflo(w.x) * s, bfhi(w.x) * s); o.y = cvtpk(bflo(w.y) * s, bfhi(w.y) * s); o.z = cvtpk(bflo(w.z) * s, bfhi(w.z) * s); o.w = cvtpk(bflo(w.w) * s, bfhi(w.w) * s); return o; }
__device__ __forceinline__ float ret_lg2(int h, int dir) { const int hh = dir ? 3 - h : h; return log1pf(-exp2f(-5.0f - (float)hh)) * LOG2E; }
constexpr size_t RET_US_ELEMS = (size_t)128 * 256, HG_US_ELEMS = (size_t)128 * 128;
constexpr size_t US_RET_OFF = DY_US, US_HG_OFF = DY_US + 65 * MiB;
constexpr size_t HG_A_OFF = WS_MODP;

__device__ __forceinline__ void store_state_tile(bf16_t* us, const f32x16& a, int rb, int d0, int nd0, int c32, int hi) {
#pragma unroll
    for (int g = 0; g < 4; ++g) { const int ks = 2 * rb + (g >> 1), ln = c32 + 32 * (g & 1);
        u32x2 w; w.x = cvtpk_c(a[4 * g], a[4 * g + 1]); w.y = cvtpk_c(a[4 * g + 2], a[4 * g + 3]);
        *(u32x2*)(us + ((size_t)(ks * nd0 + d0) * 64 + ln) * 8 + 4 * hi) = w; }
}

template <int TILE, int KST> __device__ __forceinline__ void ra_step(f32x16 (&acc)[4][2], int vbK, const int (&vbV)[2]) {
    bf16x8 A[4], Bv[2];
    { const s16x4 lo = tr_read<TILE * 16384 + v_rd_off(0, KST, 0)>(vbK), h4 = tr_read<TILE * 16384 + v_rd_off(0, KST, 1)>(vbK); A[0] = PKF(lo, h4); }
    { const s16x4 lo = tr_read<TILE * 16384 + v_rd_off(1, KST, 0)>(vbK), h4 = tr_read<TILE * 16384 + v_rd_off(1, KST, 1)>(vbK); A[1] = PKF(lo, h4); }
    { const s16x4 lo = tr_read<TILE * 16384 + v_rd_off(2, KST, 0)>(vbK), h4 = tr_read<TILE * 16384 + v_rd_off(2, KST, 1)>(vbK); A[2] = PKF(lo, h4); }
    { const s16x4 lo = tr_read<TILE * 16384 + v_rd_off(3, KST, 0)>(vbK), h4 = tr_read<TILE * 16384 + v_rd_off(3, KST, 1)>(vbK); A[3] = PKF(lo, h4); }
    { const s16x4 lo = tr_read<TILE * 32768 + v_rd_off(0, KST, 0)>(vbV[0]), h4 = tr_read<TILE * 32768 + v_rd_off(0, KST, 1)>(vbV[0]); Bv[0] = PKF(lo, h4); }
    { const s16x4 lo = tr_read<TILE * 32768 + v_rd_off(0, KST, 0)>(vbV[1]), h4 = tr_read<TILE * 32768 + v_rd_off(0, KST, 1)>(vbV[1]); Bv[1] = PKF(lo, h4); }
    asm volatile("s_waitcnt lgkmcnt(0)" ::: "memory"); __builtin_amdgcn_sched_barrier(0);
#pragma unroll
    for (int rb = 0; rb < 4; ++rb)
#pragma unroll
        for (int cb = 0; cb < 2; ++cb) acc[rb][cb] = __builtin_amdgcn_mfma_f32_32x32x16_bf16(A[rb], Bv[cb], acc[rb][cb], 0, 0, 0);
}
__device__ __forceinline__ void ret_local_unit(Frame& F, int b, int h, int c) {
    const bf16_t* RK = WSP(bf16_t, DY_PB) + (size_t)MR * 512; const bf16_t* RV = RK + (size_t)MR * 512;
    const size_t hb = (size_t)(b * 4 + h) * TT + (size_t)c * 256;
    const float lgf = ret_lg2(h, 0), lgb = ret_lg2(h, 1);
    const int w = F.wave, lane = F.lane, c32 = lane & 31, hi = lane >> 5, dir = w >> 2, dvq = w & 3;
    LAS char* lds = (LAS char*)F.lds;
    f32x16 acc[4][2];
#pragma unroll
    for (int rb = 0; rb < 4; ++rb)
#pragma unroll
        for (int cb = 0; cb < 2; ++cb)
#pragma unroll
            for (int r = 0; r < 16; ++r) acc[rb][cb][r] = 0.f;
    const int vbK = (int)(uintptr_t)lds + dir * 32768 + v_rd_base(lane);
    int vbV[2];
#pragma unroll
    for (int cb = 0; cb < 2; ++cb) { const int colblk = 2 * dvq + cb; vbV[cb] = (int)(uintptr_t)lds + 65536 + (colblk >> 2) * 16384 + (colblk & 3) * 512 + v_rd_base(lane); }
    for (int hh = 0; hh < 2; ++hh) {
        __syncthreads();
        u32x4 kq[4];
#pragma unroll
        for (int i = 0; i < 4; ++i) { const int idx = i * NTHR + F.tid, row = idx >> 4, ch = idx & 15, p = 128 * hh + row; kq[i] = *(const u32x4*)(RK + (hb + p) * 128 + ch * 8); }
#pragma unroll
        for (int i = 0; i < 4; ++i) asm volatile("" : "+v"(kq[i]));
#pragma unroll
        for (int i = 0; i < 4; ++i) { const int idx = i * NTHR + F.tid, row = idx >> 4, ch = idx & 15, p = 128 * hh + row;
            const u32x4 kv = kq[i];
            const float ff = __builtin_amdgcn_exp2f(lgf * (float)(255 - p)), fb = __builtin_amdgcn_exp2f(lgb * (float)p);
            const int off = (row >> 6) * 16384 + v_st(row & 63, ch * 8);
            *(LAS u32x4*)(lds + off) = scale8(kv, ff); *(LAS u32x4*)(lds + 32768 + off) = scale8(kv, fb); }
        { u32x4 vq[8];
#pragma unroll
          for (int i = 0; i < 8; ++i) { const int idx = i * NTHR + F.tid, row = idx >> 5, col = (idx & 31) * 8, p = 128 * hh + row; vq[i] = *(const u32x4*)(RV + (hb + p) * 256 + col); }
#pragma unroll
          for (int i = 0; i < 8; ++i) asm volatile("" : "+v"(vq[i]));
#pragma unroll
          for (int i = 0; i < 8; ++i) { const int idx = i * NTHR + F.tid, row = idx >> 5, col = (idx & 31) * 8;
            *(LAS u32x4*)(lds + 65536 + ((row >> 6) * 2 + (col >> 7)) * 16384 + v_st(row & 63, col & 127)) = vq[i]; } }
        __syncthreads();
        ra_step<0, 0>(acc, vbK, vbV); ra_step<0, 1>(acc, vbK, vbV); ra_step<0, 2>(acc, vbK, vbV); ra_step<0, 3>(acc, vbK, vbV);
        ra_step<1, 0>(acc, vbK, vbV); ra_step<1, 1>(acc, vbK, vbV); ra_step<1, 2>(acc, vbK, vbV); ra_step<1, 3>(acc, vbK, vbV);
    }
    bf16_t* us = (bf16_t*)(F.ws + US_RET_OFF) + ((size_t)((b * 4 + h) * 2 + dir) * PPB + cp_of(c, dir)) * RET_US_ELEMS;
#pragma unroll
    for (int rb = 0; rb < 4; ++rb)
#pragma unroll
        for (int cb = 0; cb < 2; ++cb) store_state_tile(us, acc[rb][cb], rb, 2 * dvq + cb, 8, c32, hi);
}

__device__ __forceinline__ void scan_states(Frame& F, bool do_ret, bool do_hg) {
  for (int gt = F.bid * NTHR + F.tid; gt < 131072; gt += F.G * NTHR) {
    if (gt < 65536) {
        if (!do_ret) continue;
        const int seq = gt >> 12, vec = gt & 4095, dir = seq & 1, h = (seq >> 1) & 3;
        const float g = exp2f(ret_lg2(h, dir) * 256.0f);
        u32x4* p = (u32x4*)(F.ws + US_RET_OFF) + (size_t)seq * PPB * 4096 + vec;
        float S[8];
#pragma unroll
        for (int e = 0; e < 8; ++e) S[e] = 0.f;
        for (int cp0 = 0; cp0 < PPB; cp0 += 13) {
            u32x4 ub[13];
#pragma unroll
            for (int k = 0; k < 13; ++k) ub[k] = p[(size_t)(cp0 + k) * 4096];
#pragma unroll
            for (int k = 0; k < 13; ++k) { const u32x4 u = ub[k];
                u32x4 o; o.x = cvtpk(S[0], S[1]); o.y = cvtpk(S[2], S[3]); o.z = cvtpk(S[4], S[5]); o.w = cvtpk(S[6], S[7]); p[(size_t)(cp0 + k) * 4096] = o;
                S[0] = g * S[0] + bflo(u.x); S[1] = g * S[1] + bfhi(u.x); S[2] = g * S[2] + bflo(u.y); S[3] = g * S[3] + bfhi(u.y);
                S[4] = g * S[4] + bflo(u.z); S[5] = g * S[5] + bfhi(u.z); S[6] = g * S[6] + bflo(u.w); S[7] = g * S[7] + bfhi(u.w); } }
    } else {
        if (!do_hg) continue;
        const int gv = gt - 65536, seq = gv >> 11, vec = gv & 2047;
        const int ks = vec >> 8, hi = (vec >> 5) & 1, dk0 = 16 * ks + 8 * hi;
        u32x4* p = (u32x4*)(F.ws + US_HG_OFF) + (size_t)seq * PPB * 2048 + vec;
        const f32x4* ap = (const f32x4*)((const float*)(F.ws + HG_A_OFF) + (size_t)seq * PPB * 128 + dk0);
        float S[8];
#pragma unroll
        for (int e = 0; e < 8; ++e) S[e] = 0.f;
        for (int cp0 = 0; cp0 < PPB; cp0 += 5) {
            u32x4 ub[5]; f32x4 a0b[5], a1b[5];
#pragma unroll
            for (int k = 0; k < 5; ++k) { ub[k] = p[(size_t)(cp0 + k) * 2048]; a0b[k] = ap[(cp0 + k) * 32]; a1b[k] = ap[(cp0 + k) * 32 + 1]; }
#pragma unroll
            for (int k = 0; k < 5; ++k) { const u32x4 u = ub[k]; const f32x4 a0 = a0b[k], a1 = a1b[k];
                u32x4 o; o.x = cvtpk(S[0], S[1]); o.y = cvtpk(S[2], S[3]); o.z = cvtpk(S[4], S[5]); o.w = cvtpk(S[6], S[7]); p[(size_t)(cp0 + k) * 2048] = o;
                S[0] = a0[0] * S[0] + bflo(u.x); S[1] = a0[1] * S[1] + bfhi(u.x); S[2] = a0[2] * S[2] + bflo(u.y); S[3] = a0[3] * S[3] + bfhi(u.y);
                S[4] = a1[0] * S[4] + bflo(u.z); S[5] = a1[1] * S[5] + bfhi(u.z); S[6] = a1[2] * S[6] + bflo(u.w); S[7] = a1[3] * S[7] + bfhi(u.w); } }
    }
  }
}

__device__ __forceinline__ void ret_out_unit(Frame& F, int l, int b, int h, int c) {
    const bf16_t* RQ = WSP(bf16_t, DY_PB); const bf16_t* RK = RQ + (size_t)MR * 512; const bf16_t* RV = RK + (size_t)MR * 512;
    const size_t hb = (size_t)(b * 4 + h) * TT + (size_t)c * 256;
    const float lgf = ret_lg2(h, 0), lgb = ret_lg2(h, 1);
    const int w = F.wave, lane = F.lane, r32 = lane & 31, hi = lane >> 5, irow = 32 * w + r32;
    LAS char* lds = (LAS char*)F.lds;
    bf16x8 qr[8];
#pragma unroll
    for (int d0 = 0; d0 < 8; ++d0) qr[d0] = *(const bf16x8*)(RQ + (hb + irow) * 128 + d0 * 16 + hi * 8);
    const int vb = (int)(uintptr_t)lds + 16384 + v_rd_base(lane);
    unsigned okk[2], ovv[2];
#pragma unroll
    for (int i = 0; i < 2; ++i) { const int P = w + 8 * i, row = 4 * P + (lane >> 4), ch = (lane & 15) ^ (row & 7); okk[i] = (unsigned)(row * 128 + ch * 8);
        const int sub = P * 2 + (lane >> 5), kk = (sub >> 2) * 8 + ((lane & 31) >> 2), k = (kk & ~0xC) | ((kk & 4) << 1) | ((kk & 8) >> 1), c = (sub & 3) * 32 + 8 * (lane & 3); ovv[i] = (unsigned)(k * 256 + c); }
    float ssq[16]; LAS unsigned* keep = (LAS unsigned*)(lds + 65536 + w * 8192) + lane;
#pragma unroll
    for (int r = 0; r < 16; ++r) ssq[r] = 0.f;
    f32x16 o[4];
#pragma unroll 1
    for (int half = 0; half < 2; ++half) {
#pragma unroll
        for (int d = 0; d < 4; ++d)
#pragma unroll
            for (int r = 0; r < 16; ++r) o[d][r] = 0.f;
#define RSC_ISSUE(J_, buf_) do { const size_t kb_ = (hb + 64 * (J_)) * 128, vbs_ = (hb + 64 * (J_)) * 256 + half * 128; \
            __builtin_amdgcn_global_load_lds((const unsigned*)(RK + kb_ + okk[0]), (LAS unsigned*)(lds + (buf_) * 32768 + w * 1024), 16, 0, 0); \
            __builtin_amdgcn_global_load_lds((const unsigned*)(RK + kb_ + okk[1]), (LAS unsigned*)(lds + (buf_) * 32768 + (w + 8) * 1024), 16, 0, 0); \
            __builtin_amdgcn_global_load_lds((const unsigned*)(RV + vbs_ + ovv[0]), (LAS unsigned*)(lds + (buf_) * 32768 + 16384 + w * 1024), 16, 0, 0); \
            __builtin_amdgcn_global_load_lds((const unsigned*)(RV + vbs_ + ovv[1]), (LAS unsigned*)(lds + (buf_) * 32768 + 16384 + (w + 8) * 1024), 16, 0, 0); } while (0)
        asm volatile("s_waitcnt vmcnt(0)" ::: "memory");
        RSC_ISSUE(0, 0);
#pragma unroll 1
        for (int J = 0; J < 4; ++J) {
            const int buf = J & 1;
            asm volatile("s_waitcnt lgkmcnt(0)" ::: "memory"); __builtin_amdgcn_s_barrier(); asm volatile("" ::: "memory");
            if (J < 3) { RSC_ISSUE(J + 1, buf ^ 1); asm volatile("s_waitcnt vmcnt(4)" ::: "memory"); } else asm volatile("s_waitcnt vmcnt(0)" ::: "memory");
            __builtin_amdgcn_s_barrier(); asm volatile("" ::: "memory");
            LAS char* kb = lds + buf * 32768; const int vbj = vb + buf * 32768;
            f32x16 p0, p1;
#pragma unroll
            for (int r = 0; r < 16; ++r) { p0[r] = 0.f; p1[r] = 0.f; }
#pragma unroll
            for (int d0 = 0; d0 < 8; ++d0) { const int cb = (d0 * 16 + hi * 8) * 2;
                const bf16x8 b0 = *(const LAS bf16x8*)(kb + KSWZ256(r32, cb)), b1 = *(const LAS bf16x8*)(kb + KSWZ256(32 + r32, cb));
                p0 = __builtin_amdgcn_mfma_f32_32x32x16_bf16(b0, qr[d0], p0, 0, 0, 0); p1 = __builtin_amdgcn_mfma_f32_32x32x16_bf16(b1, qr[d0], p1, 0, 0, 0); }
#pragma unroll
            for (int r = 0; r < 16; ++r) { const int d0i = irow - (64 * J + crow(r, hi)), d1i = d0i - 32;
                const float e0 = d0i >= 0 ? lgf * (float)d0i : -lgb * (float)d0i, e1 = d1i >= 0 ? lgf * (float)d1i : -lgb * (float)d1i;
                float m0 = __builtin_amdgcn_exp2f(e0), m1 = __builtin_amdgcn_exp2f(e1); if (d0i == 0) m0 = 2.0f; if (d1i == 0) m1 = 2.0f;
                p0[r] *= m0; p1[r] *= m1; }
            bf16x8 pa0, pa1, pa2, pa3;
#define PK4(P, BASE, OUT) do { unsigned a0 = cvtpk(P[BASE + 0], P[BASE + 1]), a1 = cvtpk(P[BASE + 2], P[BASE + 3]);   \
    unsigned b0_ = cvtpk(P[BASE + 4], P[BASE + 5]), b1_ = cvtpk(P[BASE + 6], P[BASE + 7]);                              \
    auto r0 = __builtin_amdgcn_permlane32_swap(a0, b0_, false, false); auto r1 = __builtin_amdgcn_permlane32_swap(a1, b1_, false, false); \
    u32x4 w_ = {r0[0], r1[0], r0[1], r1[1]}; OUT = *reinterpret_cast<bf16x8*>(&w_); } while (0)
            PK4(p0, 0, pa0); PK4(p0, 8, pa1); PK4(p1, 0, pa2); PK4(p1, 8, pa3);
            att::pv_d0(o, vbj, pa0, pa1, pa2, pa3);
        }
#undef RSC_ISSUE
#pragma unroll 1
        for (int dir = 0; dir < 2; ++dir) {
            const float sc = dir ? __builtin_amdgcn_exp2f(lgb * (float)(256 - irow)) : __builtin_amdgcn_exp2f(lgf * (float)(irow + 1));
            const bf16_t* us = (const bf16_t*)(F.ws + US_RET_OFF) + ((size_t)((b * 4 + h) * 2 + dir) * PPB + cp_of(c, dir)) * RET_US_ELEMS;
            __syncthreads();
#pragma unroll
            for (int i = 0; i < 4; ++i) { const int idx = i * NTHR + F.tid, fr_ = idx >> 6, ln = idx & 63, ks = fr_ >> 2, d0 = fr_ & 3;
                *(LAS u32x4*)(lds + 32768 + idx * 16) = *(const u32x4*)(us + ((size_t)(ks * 8 + half * 4 + d0) * 64 + ln) * 8); }
            __syncthreads();
#pragma unroll
            for (int ks = 0; ks < 8; ++ks) { const u32x4 qs = scale8(*reinterpret_cast<const u32x4*>(&qr[ks]), sc); const bf16x8 qa = *reinterpret_cast<const bf16x8*>(&qs);
#pragma unroll
                for (int d0 = 0; d0 < 4; ++d0) { const bf16x8 sf = *(const LAS bf16x8*)(lds + 32768 + ((ks * 4 + d0) * 64 + lane) * 16);
                    o[d0] = __builtin_amdgcn_mfma_f32_32x32x16_bf16(qa, sf, o[d0], 0, 0, 0); } }
        }
#pragma unroll
        for (int d0 = 0; d0 < 4; ++d0)
#pragma unroll
            for (int r = 0; r < 16; ++r) ssq[r] += o[d0][r] * o[d0][r];
        if (half == 0) {
#pragma unroll
            for (int d0 = 0; d0 < 4; ++d0)
#pragma unroll
                for (int r = 0; r < 8; ++r) keep[(d0 * 8 + r) * 64] = cvtpk_c(o[d0][2 * r], o[d0][2 * r + 1]);
        }
    }
    const float* rn = inp(F, I_RNORM) + l * 256;
    bf16_t* ob = WSP(bf16_t, DY_OB) + ((size_t)b * TT + (size_t)c * 256 + 32 * w) * 1024 + h * 256 + r32;
    float wn[8];
#pragma unroll
    for (int j = 0; j < 8; ++j) wn[j] = rn[32 * j + r32];
#pragma unroll
    for (int r = 0; r < 16; ++r) { float s = ssq[r];
        s += __shfl_xor(s, 1); s += __shfl_xor(s, 2); s += __shfl_xor(s, 4); s += __shfl_xor(s, 8); s += __shfl_xor(s, 16);
        const float rs = rsqrtf(s * (1.0f / 256.0f) + EPS); bf16_t* rowp = ob + (size_t)crow(r, hi) * 1024;
#pragma unroll
        for (int d0 = 0; d0 < 4; ++d0) { const unsigned pw = keep[(d0 * 8 + (r >> 1)) * 64]; const float v0 = (r & 1) ? bfhi(pw) : bflo(pw);
            rowp[32 * d0] = (bf16_t)(cvtpk(v0 * rs * wn[d0], 0.f) & 0xffffu);
            rowp[128 + 32 * d0] = (bf16_t)(cvtpk(o[d0][r] * rs * wn[4 + d0], 0.f) & 0xffffu); } }
    __syncthreads();
#undef PK4
}
}


namespace hgm {
using att::crow; using att::v_st; using att::v_rd_base; using att::v_rd_off; using att::tr_read;
constexpr int TTAB_OFF = RING_BYTES + 1024;
__device__ __forceinline__ float dpp_shr0(float v, int) { return v; }
template <int CTRL> __device__ __forceinline__ float dppz(float v) { return __int_as_float(__builtin_amdgcn_update_dpp(0, __float_as_int(v), CTRL, 0xf, 0xf, true)); }
template <bool REV> __device__ __forceinline__ void scan32x8(float (&v)[8], int lane, float (&tot)[8]) {
#pragma unroll
    for (int e = 0; e < 8; ++e) v[e] += REV ? dppz<0x101>(v[e]) : dppz<0x111>(v[e]);
#pragma unroll
    for (int e = 0; e < 8; ++e) v[e] += REV ? dppz<0x102>(v[e]) : dppz<0x112>(v[e]);
#pragma unroll
    for (int e = 0; e < 8; ++e) v[e] += REV ? dppz<0x104>(v[e]) : dppz<0x114>(v[e]);
#pragma unroll
    for (int e = 0; e < 8; ++e) v[e] += REV ? dppz<0x108>(v[e]) : dppz<0x118>(v[e]);
    const bool up = (lane & 32) != 0, addrow = REV ? ((lane & 16) == 0) : ((lane & 16) != 0);
    float cr[8];
#pragma unroll
    for (int e = 0; e < 8; ++e) { const float t0 = __int_as_float(__builtin_amdgcn_readlane(__float_as_int(v[e]), REV ? 16 : 15)), t1 = __int_as_float(__builtin_amdgcn_readlane(__float_as_int(v[e]), REV ? 48 : 47)); cr[e] = up ? t1 : t0; }
#pragma unroll
    for (int e = 0; e < 8; ++e) v[e] += addrow ? cr[e] : 0.f;
#pragma unroll
    for (int e = 0; e < 8; ++e) { const float t0 = __int_as_float(__builtin_amdgcn_readlane(__float_as_int(v[e]), REV ? 0 : 31)), t1 = __int_as_float(__builtin_amdgcn_readlane(__float_as_int(v[e]), REV ? 32 : 63)); tot[e] = up ? t1 : t0; }
}
constexpr int LBT_OFF = TTAB_OFF + 4096 + 4608;
template <bool REV, int LAYOUT> __device__ __forceinline__ void prep(const bf16_t* zrow, const LAS float* lbl, int lane, LAS float* ttab_w, float (&E)[64], LAS char* lds, int row) {
    const int hi = lane >> 5;
    u32x4 zw[8];
#pragma unroll
    for (int d0 = 0; d0 < 8; ++d0) zw[d0] = *(const u32x4*)(zrow + 16 * d0);
#pragma unroll
    for (int d0 = 0; d0 < 8; ++d0) {
        const f32x4 l0 = *(const LAS f32x4*)(lbl + 16 * d0), l1 = *(const LAS f32x4*)(lbl + 16 * d0 + 4);
        const float z[8] = {bflo(zw[d0].x), bfhi(zw[d0].x), bflo(zw[d0].y), bfhi(zw[d0].y), bflo(zw[d0].z), bfhi(zw[d0].z), bflo(zw[d0].w), bfhi(zw[d0].w)};
        const float lb[8] = {l0[0], l0[1], l0[2], l0[3], l1[0], l1[1], l1[2], l1[3]};
        float kk[8], Bv[8], tot[8];
#pragma unroll
        for (int e = 0; e < 8; ++e) { const float sg = sigmoidf_(z[e]); const float f = fmaxf(lb[e] + (1.0f - lb[e]) * sg, 1e-20f); Bv[e] = __builtin_amdgcn_logf(f); kk[e] = (1.0f - lb[e]) * (1.0f - sg); }
        scan32x8<REV>(Bv, lane, tot);
        float kv[8];
#pragma unroll
        for (int e = 0; e < 8; ++e) { const float ee = Bv[e] - tot[e]; E[d0 * 8 + e] = ee; kv[e] = kk[e] * __builtin_amdgcn_exp2f(-ee); }
        if ((lane & 31) == 0) { *(LAS f32x4*)(ttab_w + 16 * d0 + 8 * hi) = (f32x4){tot[0], tot[1], tot[2], tot[3]}; *(LAS f32x4*)(ttab_w + 16 * d0 + 8 * hi + 4) = (f32x4){tot[4], tot[5], tot[6], tot[7]}; }
        u32x4 kh; kh.x = cvtpk(kv[0], kv[1]); kh.y = cvtpk(kv[2], kv[3]); kh.z = cvtpk(kv[4], kv[5]); kh.w = cvtpk(kv[6], kv[7]);
        if (LAYOUT == 0) *(LAS u32x4*)(lds + KSWZ256(row, (16 * d0 + 8 * hi) * 2)) = kh;
        else *(LAS u32x4*)(lds + (row >> 6) * 16384 + v_st(row & 63, 16 * d0 + 8 * hi)) = kh;
        __builtin_amdgcn_sched_barrier(0);
    }
}
__device__ __forceinline__ u32x4 qscale(const u32x4 q, const float* Ek) {
    u32x4 o; o.x = cvtpk(bflo(q.x) * __builtin_amdgcn_exp2f(Ek[0]), bfhi(q.x) * __builtin_amdgcn_exp2f(Ek[1])); o.y = cvtpk(bflo(q.y) * __builtin_amdgcn_exp2f(Ek[2]), bfhi(q.y) * __builtin_amdgcn_exp2f(Ek[3]));
    o.z = cvtpk(bflo(q.z) * __builtin_amdgcn_exp2f(Ek[4]), bfhi(q.z) * __builtin_amdgcn_exp2f(Ek[5])); o.w = cvtpk(bflo(q.w) * __builtin_amdgcn_exp2f(Ek[6]), bfhi(q.w) * __builtin_amdgcn_exp2f(Ek[7])); return o;
}
#define HG_PK4(P, BASE, OUT) do { unsigned a0 = cvtpk_c(P[BASE + 0], P[BASE + 1]), a1 = cvtpk_c(P[BASE + 2], P[BASE + 3]);     \
    unsigned b0_ = cvtpk_c(P[BASE + 4], P[BASE + 5]), b1_ = cvtpk_c(P[BASE + 6], P[BASE + 7]);                              \
    auto r0 = __builtin_amdgcn_permlane32_swap(a0, b0_, false, false); auto r1 = __builtin_amdgcn_permlane32_swap(a1, b1_, false, false); \
    u32x4 w_ = {r0[0], r1[0], r0[1], r1[1]}; OUT = *reinterpret_cast<bf16x8*>(&w_); } while (0)
template <int D0> __device__ __forceinline__ void pv32(f32x16& od, int vb, bf16x8 pa0, bf16x8 pa1) {
    const s16x4 l0 = tr_read<v_rd_off(D0, 0, 0)>(vb), h0 = tr_read<v_rd_off(D0, 0, 1)>(vb), l1 = tr_read<v_rd_off(D0, 1, 0)>(vb), h1 = tr_read<v_rd_off(D0, 1, 1)>(vb);
    asm volatile("s_waitcnt lgkmcnt(0)" ::: "memory"); __builtin_amdgcn_sched_barrier(0);
    od = __builtin_amdgcn_mfma_f32_32x32x16_bf16(pa0, (bf16x8){l0[0], l0[1], l0[2], l0[3], h0[0], h0[1], h0[2], h0[3]}, od, 0, 0, 0);
    od = __builtin_amdgcn_mfma_f32_32x32x16_bf16(pa1, (bf16x8){l1[0], l1[1], l1[2], l1[3], h1[0], h1[1], h1[2], h1[3]}, od, 0, 0, 0);
}

constexpr int PTAB_OFF = TTAB_OFF + 4096;
__device__ __forceinline__ u32x4 qfac(u32x4 Q, const LAS float* ca, const LAS float* cb, bool sub) {
    asm volatile("" : "+v"(Q.x), "+v"(Q.y), "+v"(Q.z), "+v"(Q.w));
    f32x4 a0 = *(const LAS f32x4*)(ca), a1 = *(const LAS f32x4*)(ca + 4);
    if (sub) { a0 -= *(const LAS f32x4*)(cb); a1 -= *(const LAS f32x4*)(cb + 4); }
    u32x4 o; o.x = cvtpk(bflo(Q.x) * __builtin_amdgcn_exp2f(a0[0]), bfhi(Q.x) * __builtin_amdgcn_exp2f(a0[1])); o.y = cvtpk(bflo(Q.y) * __builtin_amdgcn_exp2f(a0[2]), bfhi(Q.y) * __builtin_amdgcn_exp2f(a0[3]));
    o.z = cvtpk(bflo(Q.z) * __builtin_amdgcn_exp2f(a1[0]), bfhi(Q.z) * __builtin_amdgcn_exp2f(a1[1])); o.w = cvtpk(bflo(Q.w) * __builtin_amdgcn_exp2f(a1[2]), bfhi(Q.w) * __builtin_amdgcn_exp2f(a1[3])); return o;
}
constexpr int FTAB_OFF = LBT_OFF + 1024;
__device__ __forceinline__ u32x4 qmul(u32x4 Q, const LAS float* f) {
    asm volatile("" : "+v"(Q.x), "+v"(Q.y), "+v"(Q.z), "+v"(Q.w));
    const f32x4 a0 = *(const LAS f32x4*)(f), a1 = *(const LAS f32x4*)(f + 4);
    u32x4 o; o.x = cvtpk(bflo(Q.x) * a0[0], bfhi(Q.x) * a0[1]); o.y = cvtpk(bflo(Q.y) * a0[2], bfhi(Q.y) * a0[3]);
    o.z = cvtpk(bflo(Q.z) * a1[0], bfhi(Q.z) * a1[1]); o.w = cvtpk(bflo(Q.w) * a1[2], bfhi(Q.w) * a1[3]); return o;
}
template <bool REV, int SK = 0> __device__ __forceinline__ void out_dir(Frame& F, int l, int b, int h, int c, f32x16 (&o)[4]) {
    const int w = F.wave, lane = F.lane, r32 = lane & 31, hi = lane >> 5, dir = REV ? 1 : 0;
    LAS char* lds = (LAS char*)F.lds; LAS float* ttab = (LAS float*)(lds + TTAB_OFF); LAS float* ptab = (LAS float*)(lds + PTAB_OFF);
    const size_t rowoff = ((size_t)(b * 8 + h) * TT + (size_t)c * 256 + 32 * w + r32) * 128 + 8 * hi;
    const bf16_t* Z = WSP(bf16_t, DY_PC) + (size_t)(1 + dir) * MR * 1024 + rowoff; const bf16_t* GQ = WSP(bf16_t, DY_PC) + rowoff;
    LAS float* lbt = (LAS float*)(lds + LBT_OFF) + dir * 128;
    __syncthreads();
    u32x4 Qp[8];
    { float E[64];
      prep<REV, 0>(Z, lbt + 8 * hi, lane, ttab + w * 128, E, lds, 32 * w + r32);
#pragma unroll
      for (int d0 = 0; d0 < 8; ++d0) Qp[d0] = *(const u32x4*)(GQ + 16 * d0);
#pragma unroll
      for (int d0 = 0; d0 < 8; ++d0) asm volatile("" : "+v"(Qp[d0]));
#pragma unroll
      for (int d0 = 0; d0 < 8; ++d0) Qp[d0] = qscale(Qp[d0], &E[d0 * 8]); }
    __syncthreads();
    if (F.tid < 128) { float s = 0.f;
#pragma unroll
        for (int pi = 0; pi < 8; ++pi) { ptab[pi * 128 + F.tid] = s; s += ttab[(REV ? 7 - pi : pi) * 128 + F.tid]; }
        ptab[8 * 128 + F.tid] = s; }
    __syncthreads();
    const int vbase = (int)(uintptr_t)lds + 65536 + v_rd_base(lane);
    const int piw = REV ? 7 - w : w; const LAS float* cw = ptab + (piw + 1) * 128 + 8 * hi; LAS float* ftab = (LAS float*)(lds + FTAB_OFF) + w * 128;
    for (int pi = (SK & 1) ? -1 : piw; pi >= 0; --pi) {
        const int J = REV ? 7 - pi : pi; const LAS float* cj = ptab + (pi + 1) * 128 + 8 * hi;
        { const LAS float* pw = ptab + (piw + 1) * 128, *pj = ptab + (pi + 1) * 128;
          ftab[lane] = __builtin_amdgcn_exp2f(pw[lane] - pj[lane]); ftab[lane + 64] = __builtin_amdgcn_exp2f(pw[lane + 64] - pj[lane + 64]); }
        asm volatile("s_waitcnt lgkmcnt(0)" ::: "memory");
        f32x16 p;
#pragma unroll
        for (int r = 0; r < 16; ++r) p[r] = 0.f;
#pragma unroll
        for (int d0 = 0; d0 < 8; ++d0) { const u32x4 qt = qmul(Qp[d0], ftab + 8 * hi + 16 * d0); const bf16x8 a = *(const LAS bf16x8*)(lds + KSWZ256(32 * J + r32, (16 * d0 + 8 * hi) * 2));
            p = __builtin_amdgcn_mfma_f32_32x32x16_bf16(a, *reinterpret_cast<const bf16x8*>(&qt), p, 0, 0, 0);
            if (d0 & 1) __builtin_amdgcn_sched_barrier(0); }
        if (pi == piw) {
#pragma unroll
            for (int r = 0; r < 16; ++r) { const int jj = crow(r, hi); const bool keep = REV ? (jj >= r32) : (jj <= r32); p[r] = keep ? p[r] : 0.f; } }
        bf16x8 pa0, pa1; HG_PK4(p, 0, pa0); HG_PK4(p, 8, pa1);
        const int vb = vbase + (J >> 1) * 16384 + (J & 1) * 8192;
        pv32<0>(o[0], vb, pa0, pa1); pv32<1>(o[1], vb, pa0, pa1); pv32<2>(o[2], vb, pa0, pa1); pv32<3>(o[3], vb, pa0, pa1);
    }
    const bf16_t* us = (const bf16_t*)(F.ws + scn::US_HG_OFF) + ((size_t)((b * 8 + h) * 2 + dir) * PPB + scn::cp_of(c, dir)) * scn::HG_US_ELEMS + (size_t)lane * 8;
    if (!(SK & 2)) {
        bf16x8 sfa[2][4], sfb[2][4];
#define HG_SLD(buf, kq) do { _Pragma("unroll") for (int k2 = 0; k2 < 2; ++k2) _Pragma("unroll") for (int d0 = 0; d0 < 4; ++d0) buf[k2][d0] = *(const bf16x8*)(us + (size_t)((2 * (kq) + k2) * 4 + d0) * 512); } while (0)
#define HG_SMM(buf, kq) do { _Pragma("unroll") for (int k2 = 0; k2 < 2; ++k2) { const u32x4 qe = qfac(Qp[2 * (kq) + k2], cw + 16 * (2 * (kq) + k2), cw, false);                                  \
            _Pragma("unroll") for (int d0 = 0; d0 < 4; ++d0) o[d0] = __builtin_amdgcn_mfma_f32_32x32x16_bf16(*reinterpret_cast<const bf16x8*>(&qe), buf[k2][d0], o[d0], 0, 0, 0); } } while (0)
        HG_SLD(sfa, 0); HG_SLD(sfb, 1); __builtin_amdgcn_sched_barrier(0);
        HG_SMM(sfa, 0); __builtin_amdgcn_sched_barrier(0); HG_SLD(sfa, 2); __builtin_amdgcn_sched_barrier(0);
        HG_SMM(sfb, 1); __builtin_amdgcn_sched_barrier(0); HG_SLD(sfb, 3); __builtin_amdgcn_sched_barrier(0);
        HG_SMM(sfa, 2); __builtin_amdgcn_sched_barrier(0); HG_SMM(sfb, 3); __builtin_amdgcn_sched_barrier(0);
#undef HG_SLD
#undef HG_SMM
    }
    __syncthreads();
}
template <int SK = 0> __device__ __forceinline__ void out_unit(Frame& F, int l, int b, int h, int c) {
    const int w = F.wave, lane = F.lane, r32 = lane & 31, hi = lane >> 5;
    LAS char* lds = (LAS char*)F.lds;
    const size_t rowoff = ((size_t)(b * 8 + h) * TT + (size_t)c * 256 + 32 * w + r32) * 128 + 8 * hi;
    const bf16_t* GI = WSP(bf16_t, DY_PC) + (size_t)3 * MR * 1024 + rowoff;
    { u32x4 gv[8];
#pragma unroll
      for (int d0 = 0; d0 < 8; ++d0) gv[d0] = *(const u32x4*)(GI + 16 * d0);
      float lbv = 0.f; if (F.tid < 256) lbv = WSP(float, WS_LB)[l * 2048 + (F.tid >> 7) * 1024 + h * 128 + (F.tid & 127)];
#pragma unroll
      for (int d0 = 0; d0 < 8; ++d0) asm volatile("" : "+v"(gv[d0]));
      if (F.tid < 256) ((LAS float*)(lds + LBT_OFF))[F.tid] = lbv;
#pragma unroll
      for (int d0 = 0; d0 < 8; ++d0) { const int row = 32 * w + r32; *(LAS u32x4*)(lds + 65536 + (row >> 6) * 16384 + v_st(row & 63, 16 * d0 + 8 * hi)) = gv[d0]; } }
    f32x16 o[4];
#pragma unroll
    for (int d = 0; d < 4; ++d)
#pragma unroll
        for (int r = 0; r < 16; ++r) o[d][r] = 0.f;
    out_dir<false, SK>(F, l, b, h, c, o);
    if (!(SK & 4)) out_dir<true, SK>(F, l, b, h, c, o);
    const float* gn = inp(F, I_GNORM) + l * 128;
    bf16_t* oc = WSP(bf16_t, DY_OC) + ((size_t)b * TT + (size_t)c * 256 + 32 * w) * 1024 + h * 128 + r32;
    float wn[4];
#pragma unroll
    for (int j = 0; j < 4; ++j) wn[j] = gn[32 * j + r32];
#pragma unroll
    for (int r = 0; r < 16; ++r) { float s = 0.f;
#pragma unroll
        for (int d0 = 0; d0 < 4; ++d0) s += o[d0][r] * o[d0][r];
        s += __shfl_xor(s, 1); s += __shfl_xor(s, 2); s += __shfl_xor(s, 4); s += __shfl_xor(s, 8); s += __shfl_xor(s, 16);
        const float rs = rsqrtf(s * (1.0f / 128.0f) + EPS); bf16_t* rowp = oc + (size_t)crow(r, hi) * 1024;
#pragma unroll
        for (int d0 = 0; d0 < 4; ++d0) rowp[32 * d0] = (bf16_t)(cvtpk(o[d0][r] * rs * wn[d0], 0.f) & 0xffffu); }
}

template <bool REV> __device__ __forceinline__ void local_dir(Frame& F, int l, int b, int h, int c) {
    const int w = F.wave, lane = F.lane, r32 = lane & 31, hi = lane >> 5, dir = REV ? 1 : 0, rb = w >> 1, cb0 = 2 * (w & 1);
    LAS char* lds = (LAS char*)F.lds; LAS float* ttab = (LAS float*)(lds + TTAB_OFF);
    const bf16_t* Z = WSP(bf16_t, DY_PC) + (size_t)(1 + dir) * MR * 1024 + ((size_t)(b * 8 + h) * TT + (size_t)c * 256 + 32 * w + r32) * 128 + 8 * hi;
    LAS float* lbt = (LAS float*)(lds + LBT_OFF) + dir * 128;
    __syncthreads();
    { float E[64]; prep<REV, 1>(Z, lbt + 8 * hi, lane, ttab + w * 128, E, lds, 32 * w + r32); }
    __syncthreads();
    f32x16 acc[2];
#pragma unroll
    for (int cb = 0; cb < 2; ++cb)
#pragma unroll
        for (int r = 0; r < 16; ++r) acc[cb][r] = 0.f;
    const int vbK0 = (int)(uintptr_t)lds + rb * 512 + v_rd_base(lane), vbV0 = (int)(uintptr_t)lds + 65536 + cb0 * 512 + v_rd_base(lane);
    for (int i = 0; i < 8; ++i) { const int blk = REV ? 7 - i : i;
        if (i > 0) { const LAS float* tb = ttab + blk * 128 + 32 * rb + 4 * hi;
#pragma unroll
            for (int g = 0; g < 4; ++g) { const f32x4 t = *(const LAS f32x4*)(tb + 8 * g);
#pragma unroll
                for (int j = 0; j < 4; ++j) { const float s = __builtin_amdgcn_exp2f(t[j]); acc[0][4 * g + j] *= s; acc[1][4 * g + j] *= s; } } }
        const int off = (blk >> 1) * 16384 + (blk & 1) * 8192; const int vk = vbK0 + off, vv = vbV0 + off;
#define HL_STEP(KS2) { const s16x4 al = tr_read<v_rd_off(0, KS2, 0)>(vk), ah = tr_read<v_rd_off(0, KS2, 1)>(vk), b0l = tr_read<v_rd_off(0, KS2, 0)>(vv), b0h = tr_read<v_rd_off(0, KS2, 1)>(vv), \
            b1l = tr_read<v_rd_off(1, KS2, 0)>(vv), b1h = tr_read<v_rd_off(1, KS2, 1)>(vv); \
            asm volatile("s_waitcnt lgkmcnt(0)" ::: "memory"); __builtin_amdgcn_sched_barrier(0); \
            const bf16x8 A_ = {al[0], al[1], al[2], al[3], ah[0], ah[1], ah[2], ah[3]}; \
            acc[0] = __builtin_amdgcn_mfma_f32_32x32x16_bf16(A_, (bf16x8){b0l[0], b0l[1], b0l[2], b0l[3], b0h[0], b0h[1], b0h[2], b0h[3]}, acc[0], 0, 0, 0); \
            acc[1] = __builtin_amdgcn_mfma_f32_32x32x16_bf16(A_, (bf16x8){b1l[0], b1l[1], b1l[2], b1l[3], b1h[0], b1h[1], b1h[2], b1h[3]}, acc[1], 0, 0, 0); }
        HL_STEP(0) HL_STEP(1)
#undef HL_STEP
    }
    const size_t slot = (size_t)((b * 8 + h) * 2 + dir) * PPB + scn::cp_of(c, dir);
    bf16_t* us = (bf16_t*)(F.ws + scn::US_HG_OFF) + slot * scn::HG_US_ELEMS;
    scn::store_state_tile(us, acc[0], rb, cb0, 4, r32, hi); scn::store_state_tile(us, acc[1], rb, cb0 + 1, 4, r32, hi);
    if (F.tid < 128) { float s = 0.f;
#pragma unroll
        for (int k = 0; k < 8; ++k) s += ttab[k * 128 + F.tid];
        ((float*)(F.ws + scn::HG_A_OFF))[slot * 128 + F.tid] = __builtin_amdgcn_exp2f(s); }
    __syncthreads();
}
__device__ __forceinline__ void local_unit(Frame& F, int l, int b, int h, int c) {
    const int w = F.wave, lane = F.lane, r32 = lane & 31, hi = lane >> 5;
    LAS char* lds = (LAS char*)F.lds;
    const bf16_t* GI = WSP(bf16_t, DY_PC) + (size_t)3 * MR * 1024 + ((size_t)(b * 8 + h) * TT + (size_t)c * 256 + 32 * w + r32) * 128 + 8 * hi;
    { u32x4 gv[8];
#pragma unroll
      for (int d0 = 0; d0 < 8; ++d0) gv[d0] = *(const u32x4*)(GI + 16 * d0);
      float lbv = 0.f; if (F.tid < 256) lbv = WSP(float, WS_LB)[l * 2048 + (F.tid >> 7) * 1024 + h * 128 + (F.tid & 127)];
#pragma unroll
      for (int d0 = 0; d0 < 8; ++d0) asm volatile("" : "+v"(gv[d0]));
      if (F.tid < 256) ((LAS float*)(lds + LBT_OFF))[F.tid] = lbv;
#pragma unroll
      for (int d0 = 0; d0 < 8; ++d0) { const int row = 32 * w + r32; *(LAS u32x4*)(lds + 65536 + (row >> 6) * 16384 + v_st(row & 63, 16 * d0 + 8 * hi)) = gv[d0]; } }
    local_dir<false>(F, l, b, h, c);
    local_dir<true>(F, l, b, h, c);
}
}

__device__ __forceinline__ void sa_phase(Frame& F, int l) {
    for (int u = F.bid; u < NB * 4 * PPB; u += F.G) { const int c = u % PPB, h = (u / PPB) & 3, b = u / (PPB * 4); scn::ret_local_unit(F, b, h, c); __syncthreads(); }
    frame_refresh(F);
    for (int u = F.G - 1 - F.bid; u < NB * 8 * PPB; u += F.G) { const int c = u % PPB, h = (u / PPB) & 7, b = u / (PPB * 8); hgm::local_unit(F, l, b, h, c); }
}
__device__ __forceinline__ void sc_phase(Frame& F, int l) {
    const int NC = (l == 1) ? PPB - 1 : PPB;
    for (int u = F.bid; u < NB * 4 * NC; u += F.G) { const int c = u % NC, h = (u / NC) & 3, b = u / (NC * 4); scn::ret_out_unit(F, l, b, h, c); }
    frame_refresh(F);
#ifndef HG_PROBE
#define HG_PROBE -1
#endif
    if (HG_PROBE >= 0) { for (int u = F.G - 1 - F.bid; u < NB * 8 * NC; u += F.G) { const int c = u % NC, h = (u / NC) & 7, b = u / (NC * 8); hgm::out_unit<(HG_PROBE < 0 ? 0 : HG_PROBE)>(F, l, b, h, c); } frame_refresh(F); }
    for (int u = F.G - 1 - F.bid; u < NB * 8 * NC; u += F.G) { const int c = u % NC, h = (u / NC) & 7, b = u / (NC * 8); hgm::out_unit<0>(F, l, b, h, c); }
}

#ifndef RET_MFMA
#define RET_MFMA 1
#endif
enum { PH_PRO = 0, PH_MODFIN, PH_N1, PH_GA, PH_ATT, PH_GB, PH_SA, PH_SB, PH_SC, PH_OG, PH_MG, PH_WO, PH_N2, PH_UP, PH_FIX, PH_DN, PH_COUNT };

struct PanelOrder : pg8::StaticOrder {
    int skip;
    __device__ __forceinline__ bool next(int i, pg8::Unit& u) const { const bool ok = pg8::StaticOrder::next(i, u); if (ok && skip) u.pm += (u.pm >= PPB - 1) ? 1 : 0; return ok; }
};
struct ProjOrder : PanelOrder {
    __device__ __forceinline__ bool next(int i, pg8::Unit& u) const { const int r = i / 3, n = i - 3 * r; const bool ok = PanelOrder::next(r, u); if (ok) { u.pm += n * NPAN; u.pn += 8 * n; } return ok; }    __device__ __forceinline__ bool keep(int i) const { return (i % 3) != 2; }
};
template <class Epi> __device__ __forceinline__ void run_gemm(Frame& F, const bf16_t* A, const bf16_t* Bt, int N, int K, const Epi& E, bool skipctx = false) {
    pg8::Gemm g{A, Bt, MR, N, K}; PanelOrder S; S.init(skipctx ? MR - 512 : MR, N, F.G, F.bid); S.skip = skipctx ? 1 : 0; if (N == 2048) S.wgm = 4;
    pg8::gemm_phase<Epi, PanelOrder, false>(F.lds, g, S, E, nullptr);
}
__device__ __forceinline__ EpiIn make_epi_in(Frame& F, int l, int pt0) {
    EpiIn E; E.pt0 = pt0;
    E.rq = WSP(bf16_t, DY_QKV); E.r2 = WSP(bf16_t, DY_PB); E.r1 = WSP(bf16_t, DY_PC);
    E.qkn = inp(F, I_QKN) + l * 128; E.ropeA = WSP(f32x2, WS_ROPEA); E.ropeB = WSP(f32x2, WS_ROPEB);
    return E;
}
__device__ __forceinline__ EpiRes make_epi_res(Frame& F, int l, int use_inputs, int gidx) {
    EpiRes E; E.srcx = use_inputs ? inp(F, I_X) : outp(F); E.srcc = use_inputs ? inp(F, I_CTX) : WSP(float, WS_XC); E.dstx = outp(F); E.dstc = WSP(float, WS_XC);
    E.gate0 = WSP(float, WS_MODV) + ((size_t)(l * 3) * 6 + gidx) * D; return E;
}

template <int PH> __device__ __forceinline__ void run_phase(Frame& F, int l) {
    frame_refresh(F);
    const bf16_t* h = WSP(bf16_t, WS_H); const bf16_t* wt = WSP(bf16_t, WS_WT);
    const bf16_t* wt_in = wt + WT_IN / 2;
    if constexpr (PH == PH_PRO) { p0_mod_partial(F); p0_tables(F); convert_weights(F, 0); }
    if constexpr (PH == PH_MODFIN) { p1_mod_final(F); }
    if constexpr (PH == PH_N1) { if (l == 1) convert_weights(F, 1); norm_phase(F, l, 0); }
    if constexpr (PH == PH_GA) { const EpiIn E = make_epi_in(F, l, PT_DQ); run_gemm(F, h, wt_in, 9216, D, E); }
#ifndef ATT_PROBE
#define ATT_PROBE -1
#endif
    if constexpr (PH == PH_ATT) { if (ATT_PROBE >= 0) { attn_phase<(ATT_PROBE < 0 ? 0 : ATT_PROBE)>(F, l); __syncthreads(); } attn_phase<0>(F, l); }
    if constexpr (PH == PH_GB) { }
    if constexpr (PH == PH_SA) { sa_phase(F, l); }
    if constexpr (PH == PH_SB) { scn::scan_states(F, true, true); }
    if constexpr (PH == PH_SC) { sc_phase(F, l); }
    if constexpr (PH == PH_OG) { EpiGates E; E.oB = WSP(bf16_t, DY_OB); E.oC = WSP(bf16_t, DY_OC); E.G = WSP(bf16_t, DY_MG); E.bias = inp(F, I_BGATE) + (size_t)l * 3 * D;
        run_gemm(F, h, wt_in + (size_t)PT_RG * 256 * D, 8192, D, E, l == 1); }
    if constexpr (PH == PH_MG) {
        EpiProjAll E{WSP(bf16_t, DY_MG), WSP(bf16_t, DY_YO)};
        pg8::Gemm g{WSP(bf16_t, DY_OA), wt + WT_BR / 2, MR, 2048, 1024}; ProjOrder S; const bool sk = (l == 1); S.init(sk ? MR - 512 : MR, 2048, F.G, F.bid); S.skip = sk ? 1 : 0; S.wgm = 4;
        pg8::gemm_phase<EpiProjAll, ProjOrder, false>(F.lds, g, S, E, nullptr);
    }
    if constexpr (PH == PH_WO) { const EpiRes E = make_epi_res(F, l, l == 0, 2); run_gemm(F, WSP(bf16_t, DY_YO), wt + WT_OUT / 2, 2048, D, E, l == 1); }
    if constexpr (PH == PH_N2) { norm_phase(F, l, 1); }
    if constexpr (PH == PH_UP) { EpiConv E; E.g = WSP(bf16_t, DY_G); E.raw = WSP(float, DY_RAW); E.cw = inp(F, I_CONVW) + (size_t)l * 3 * NUP; E.cb = inp(F, I_CONVB) + (size_t)l * NUP;
        run_gemm(F, h, wt + WT_UP / 2, NUP, D, E, l == 1); }
    if constexpr (PH == PH_FIX) { ffn_fixup(F, l); }
    if constexpr (PH == PH_DN) { const EpiRes E = make_epi_res(F, l, 0, 5); run_gemm(F, WSP(bf16_t, DY_G), wt + WT_DOWN / 2, 2048, DFF, E, l == 1); }
}

__device__ __forceinline__ void frame_init(Frame& F, const Args& a, unsigned char* lds) {
    F.lds = (LAS unsigned char*)lds; F.a = &a; F.G = gridDim.x; F.bid = blockIdx.x; frame_refresh(F);
}
template <int PH> __global__ void __launch_bounds__(NTHR, 2) k_phase(Args a) {
    extern __shared__ __attribute__((aligned(16))) unsigned char lds[];
    Frame F; frame_init(F, a, lds);
    run_phase<PH>(F, a.layer);
}
#ifndef MK_SINGLE
#define MK_SINGLE 1
#endif
__global__ void __launch_bounds__(NTHR, 2) k_all(Args a) {
    extern __shared__ __attribute__((aligned(16))) unsigned char lds[];
    Frame F; frame_init(F, a, lds);
    for (int u = F.tid; u < (LDS_BYTES - LDSCTL_OFF) / 4; u += NTHR) ((LAS unsigned*)(F.lds + LDSCTL_OFF))[u] = 0u;
    __syncthreads();
    (void)xcd_barrier_post((unsigned*)(a.ws + WS_CTL) + CW_BAR, (volatile LAS unsigned*)(F.lds + MISC_OFF + 32));
#define GRID_BAR() do { XcdBarrier b_; unsigned* bp_ = (unsigned*)(a.ws + WS_CTL) + CW_BAR; asm volatile("" : "+s"(bp_)); b_.bar = bp_; b_.x = xb_xcc_id(); \
        b_.st = (volatile LAS unsigned*)(F.lds + MISC_OFF + 32); xcd_barrier(b_); } while (0)
#ifndef PROBE_MASK
#define PROBE_MASK 0
#endif
#ifndef PROBE_T
#define PROBE_T 0
#endif
    unsigned long long pt0 = 0, pt1 = 0, pc0 = 0, pc1 = 0;
#define TSTART(ph, l_) do { if (PROBE_T && (ph) == PROBE_T - 1 && (l_) == 0) { pt0 = __builtin_amdgcn_s_memrealtime(); pc0 = (unsigned long long)clock64(); } } while (0)
#define TSTOP(ph, l_)  do { if (PROBE_T && (ph) == PROBE_T - 1 && (l_) == 0) { pt1 = __builtin_amdgcn_s_memrealtime(); pc1 = (unsigned long long)clock64(); } } while (0)
#define RUN(ph, l_, grp) do { TSTART(ph, l_); run_phase<ph>(F, l_); GRID_BAR(); TSTOP(ph, l_); if ((PROBE_MASK >> (grp)) & 1) { run_phase<ph>(F, l_); GRID_BAR(); } } while (0)
    RUN(PH_PRO, 0, 0); RUN(PH_MODFIN, 0, 0);
#pragma unroll 1
    for (int l = 0; l < 2; ++l) {
        RUN(PH_N1, l, 0);
        RUN(PH_GA, l, 1);
        RUN(PH_ATT, l, 2);
        RUN(PH_SA, l, 3);
        run_phase<PH_SB>(F, l); GRID_BAR();
        RUN(PH_SC, l, 4);
        run_phase<PH_OG>(F, l); GRID_BAR();
        RUN(PH_MG, l, 5);
        run_phase<PH_WO>(F, l); GRID_BAR();
        RUN(PH_N2, l, 0);
        RUN(PH_UP, l, 6);
        RUN(PH_FIX, l, 0);
        run_phase<PH_DN>(F, l); GRID_BAR();
    }
#undef RUN
    if (PROBE_T) {
        float* slot = (float*)(F.ws + WS_SCAL) + 64;
        if (F.bid == 0 && threadIdx.x == 0) { const float mhz = (float)(pc1 - pc0) / ((float)(pt1 - pt0) * 0.01f); *slot = floorf(mhz / 50.0f) * 50.0f; }
        GRID_BAR();
        const float v = *slot;
        for (size_t i = (size_t)F.bid * NTHR + threadIdx.x; i < (size_t)NB * T * D; i += (size_t)F.G * NTHR) a.out[i] = v;
    }
#undef GRID_BAR
}
__global__ void k_fill(float* out, size_t n, float v) { for (size_t i = (size_t)blockIdx.x * blockDim.x + threadIdx.x; i < n; i += (size_t)gridDim.x * blockDim.x) out[i] = v; }

template <int PH> static void launch_phase(const Args& a0, int layer, int grid, hipStream_t stream) {
    static bool attr = false;
    if (!attr) { if (hipFuncSetAttribute((const void*)k_phase<PH>, hipFuncAttributeMaxDynamicSharedMemorySize, LDS_BYTES) != hipSuccess) fprintf(stderr, "kernel_launch: hipFuncSetAttribute failed for phase %d\n", PH); attr = true; }
    Args a = a0; a.layer = layer;
    hipLaunchKernelGGL(k_phase<PH>, dim3(grid), dim3(NTHR), LDS_BYTES, stream, a);
    const hipError_t e = hipPeekAtLastError(); if (e != hipSuccess) fprintf(stderr, "kernel_launch: phase %d launch failed: %s\n", PH, hipGetErrorName(e));
}
extern "C" void kernel_launch(void* const* d_in, const int* in_sizes, int n_in, void* d_out, int out_size, void* d_ws, size_t ws_size, hipStream_t stream) {
    static int grid = 0;
    if (grid == 0) { int dev = 0, cus = 0; if (hipGetDevice(&dev) != hipSuccess || hipDeviceGetAttribute(&cus, hipDeviceAttributeMultiprocessorCount, dev) != hipSuccess || cus < 1) cus = 256; grid = cus; }
    if (n_in != N_INPUTS || out_size != NB * T * D || ws_size < WS_END) {
        fprintf(stderr, "kernel_launch: unexpected shapes: n_in %d out %d ws %zu (need %zu)\n", n_in, out_size, ws_size, (size_t)WS_END);
        hipLaunchKernelGGL(k_fill, dim3(1024), dim3(256), 0, stream, (float*)d_out, (size_t)out_size, (float)(ws_size >> 20));
        return;
    }
    Args a{};
    for (int i = 0; i < N_INPUTS; ++i) a.in[i] = (const float*)d_in[i];
    a.out = (float*)d_out; a.ws = (unsigned char*)d_ws; a.layer = 0; a.ph_lo = 0; a.ph_hi = 0; a.pad = 0;
#if MK_SINGLE
    {
        static bool attr = false;
        if (!attr) { if (hipFuncSetAttribute((const void*)k_all, hipFuncAttributeMaxDynamicSharedMemorySize, LDS_BYTES) != hipSuccess) fprintf(stderr, "kernel_launch: hipFuncSetAttribute failed\n");
            int per_cu = 0; if (hipOccupancyMaxActiveBlocksPerMultiprocessor(&per_cu, (const void*)k_all, NTHR, LDS_BYTES) != hipSuccess || per_cu < 1) fprintf(stderr, "kernel_launch: occupancy query says %d blocks per CU\n", per_cu);
            (void)hipGetLastError(); attr = true; }
        if (hipMemsetAsync((char*)d_ws + WS_CTL, 0, CTL_ZERO_BYTES, stream) != hipSuccess) { fprintf(stderr, "kernel_launch: memset failed\n"); return; }
        hipLaunchKernelGGL(k_all, dim3(grid), dim3(NTHR), LDS_BYTES, stream, a);
        const hipError_t e = hipPeekAtLastError(); if (e != hipSuccess) fprintf(stderr, "kernel_launch: launch failed: %s\n", hipGetErrorName(e));
        return;
    }
#endif
    launch_phase<PH_PRO>(a, 0, grid, stream);
    launch_phase<PH_MODFIN>(a, 0, grid, stream);
    for (int l = 0; l < 2; ++l) {
        launch_phase<PH_N1>(a, l, grid, stream); launch_phase<PH_GA>(a, l, grid, stream); launch_phase<PH_ATT>(a, l, grid, stream); launch_phase<PH_GB>(a, l, grid, stream);
        launch_phase<PH_SA>(a, l, grid, stream); launch_phase<PH_SB>(a, l, grid, stream); launch_phase<PH_SC>(a, l, grid, stream);
        launch_phase<PH_OG>(a, l, grid, stream); launch_phase<PH_MG>(a, l, grid, stream);
        launch_phase<PH_WO>(a, l, grid, stream); launch_phase<PH_N2>(a, l, grid, stream); launch_phase<PH_UP>(a, l, grid, stream); launch_phase<PH_FIX>(a, l, grid, stream);
        launch_phase<PH_DN>(a, l, grid, stream);
    }
}
```

```cpp
#include <hip/hip_runtime.h>
#include <cstdio>
#include <cstdint>
namespace pg8 {
#define PG8_LAS __attribute__((address_space(3)))
typedef unsigned short bf16_t;
typedef short bf16x8 __attribute__((ext_vector_type(8)));
typedef float f32x4 __attribute__((ext_vector_type(4)));
typedef unsigned u32x4 __attribute__((ext_vector_type(4)));
constexpr int BM = 256, BK = 64, HALF = 128, HTB = HALF * BK * 2  , STAGE_BYTES = 8 * HTB, NXCD = 8, WGM = 8;

__host__ __device__ __forceinline__ int lds_byte(int r, int c) { const int st = (r >> 4) * 2 + (c >> 5), rr = r & 15, cc = c & 31, ob = rr * 64 + cc * 2; return st * 1024 + (ob ^ (((ob >> 9) & 1) << 5)); }
__host__ __device__ __forceinline__ void stage_rc(int b, int& R, int& C) { const int st = b / 1024, sb = b % 1024, swz = sb ^ (((sb >> 9) & 1) << 5); R = (st >> 1) * 16 + swz / 64; C = (st & 1) * 32 + (swz % 64) / 2; }
__host__ __device__ __forceinline__ int perm32(int rho) { const int n = rho >> 4, i = rho & 15; return 8 * (i >> 2) + 4 * n + (i & 3); }

struct Unit { int pm, pn; };
struct Gemm { const bf16_t* A; const bf16_t* Bt; int M, N, K; };

struct StaticOrder {
    int nM, nN, nwg, G, c, wgm;
    __host__ __device__ void init(int M, int N, int G_, int c_) { nM = M / BM; nN = N / BM; nwg = nM * nN; G = G_; c = c_; wgm = WGM; }
    __host__ __device__ bool next(int i, Unit& u) const {
        const long L = (long)i * G + c; if (L >= nwg) return false;
        int wgid = (int)L; { const int q = nwg / NXCD, r = nwg % NXCD, xcd = wgid % NXCD, off = wgid / NXCD; wgid = (xcd < r ? xcd * (q + 1) : r * (q + 1) + (xcd - r) * q) + off; }
        const int nig = wgm * nN, gid = wgid / nig, fm = gid * wgm, gsz = (nM - fm) < wgm ? (nM - fm) : wgm;
        u.pm = fm + ((wgid % nig) % gsz); u.pn = (wgid % nig) / gsz; return true;
    }
    __device__ __forceinline__ void a_ready(const Unit&) const {}
    __device__ __forceinline__ void done(const Unit&) const {}
};
struct CountedOrder : StaticOrder {
    const unsigned* ready; unsigned need; unsigned* tmo;
    __device__ __forceinline__ void a_ready(const Unit& u) const {
        if (threadIdx.x < 64) {
            const unsigned long long t0 = __builtin_amdgcn_s_memrealtime(); unsigned polls = 0;
            while ((unsigned)__builtin_amdgcn_readfirstlane(__hip_atomic_load(ready + 64 * u.pm, __ATOMIC_RELAXED, __HIP_MEMORY_SCOPE_AGENT)) < need) {
                if ((++polls & 255u) == 0u && __builtin_amdgcn_readfirstlane(__hip_atomic_load(tmo, __ATOMIC_RELAXED, __HIP_MEMORY_SCOPE_AGENT)) != 0u) break;
                if (__builtin_amdgcn_s_memrealtime() - t0 > 2000000ull) {
                    if (threadIdx.x == 0) { unsigned expect = 0u; __hip_atomic_compare_exchange_strong(tmo + 1, &expect, 0x600u | (unsigned)(u.pm & 0xff), __ATOMIC_RELAXED, __ATOMIC_RELAXED, __HIP_MEMORY_SCOPE_AGENT); __hip_atomic_store(tmo, 1u, __ATOMIC_RELAXED, __HIP_MEMORY_SCOPE_AGENT); }
                    break; }
                __builtin_amdgcn_s_sleep(2); }
            __builtin_amdgcn_fence(__ATOMIC_ACQUIRE, "agent");
            asm volatile("s_waitcnt vmcnt(0)" ::: "memory");
        }
#if !defined(BROKEN_HOOK_NO_BARRIER)
        asm volatile("" ::: "memory"); __builtin_amdgcn_s_barrier(); asm volatile("" ::: "memory");
#endif
    }
};

template <class T, class = void> struct keeps_acc { static constexpr bool value = false; };
template <class T> struct keeps_acc<T, decltype((void)T::KEEPS_ACC)> { static constexpr bool value = true; };
template <class Epi, class Sched, bool STAMP = false>
__device__ __forceinline__ void gemm_phase(PG8_LAS unsigned char* lds, const Gemm g, const Sched& S, const Epi& E, unsigned long long* stamps) {
    int tid_ = threadIdx.x; asm volatile("" : "+v"(tid_));
    const int tid = tid_, wid = __builtin_amdgcn_readfirstlane(tid >> 6), lane = tid & 63, wr = wid >> 2, wc = wid & 3, fr = lane & 15, fq = lane >> 4;
    const int K = g.K, nt = K / BK;
    int ts_lo = 0, ts_hi = 0, nts = 0; const unsigned long long rt_entry = STAMP ? (unsigned long long)wall_clock64() : 0ull;
#define PG8_STAMP() do { if (STAMP && wid == 0 && nts < 64) { const unsigned long long _c = (unsigned long long)clock64(); \
        ts_lo = (lane == nts) ? (int)(unsigned)_c : ts_lo; ts_hi = (lane == nts) ? (int)(unsigned)(_c >> 32) : ts_hi; ++nts; } } while (0)
    PG8_STAMP();
    unsigned voffA[2], voffB[2];
#pragma unroll
    for (int i = 0; i < 2; ++i) { int R, C; stage_rc(tid * 16 + i * 8192, R, C); const int Rb = Epi::PERM ? ((R & ~31) + perm32(R & 31)) : R;
        voffA[i] = (unsigned)(R * K + C) * 2u; voffB[i] = (unsigned)(Rb * K + C) * 2u; }
    const size_t kstep = (size_t)(BK * 2);
    const size_t hstep = (size_t)HALF * K * 2;
    const size_t tstep = 2 * hstep;
    const unsigned ldsw = (unsigned)wid * 1024u;
    const int aoff = lds_byte(wr * 64 + fr, fq * 8), boff = lds_byte(wc * 32 + fr, fq * 8);
#define PG8_SA(b, h) (((b) * 2 + (h)) * HTB)
#define PG8_SB(b, h) ((4 + (b) * 2 + (h)) * HTB)
#define PG8_STAGE(bufoff, gbase, voff) do { const char* g_ = (const char*)(gbase); asm volatile("" : "+s"(g_));     \
        _Pragma("unroll") for (int _i = 0; _i < 2; ++_i) { asm volatile("" : "+v"((voff)[_i]));                         \
        __builtin_amdgcn_global_load_lds((const unsigned*)(g_ + (voff)[_i]), (PG8_LAS unsigned*)(lds + (bufoff) + ldsw + _i * 8192), 16, 0, 0); } } while (0)
#define PG8_LDA(dst, b, h) do { _Pragma("unroll") for (int m = 0; m < 4; ++m) _Pragma("unroll") for (int k = 0; k < 2; ++k) dst[m][k] = *(const PG8_LAS bf16x8*)(lds + PG8_SA(b, h) + aoff + m * 2048 + k * 1024); } while (0)
#define PG8_LDB(dst, b, h) do { _Pragma("unroll") for (int n = 0; n < 2; ++n) _Pragma("unroll") for (int k = 0; k < 2; ++k) dst[n][k] = *(const PG8_LAS bf16x8*)(lds + PG8_SB(b, h) + boff + n * 2048 + k * 1024); } while (0)
#define PG8_MMA(ai, bj, At, Bt) do { __builtin_amdgcn_s_setprio(1); _Pragma("unroll") for (int m = 0; m < 4; ++m) _Pragma("unroll") for (int n = 0; n < 2; ++n) _Pragma("unroll") for (int k = 0; k < 2; ++k) \
        acc[ai][bj][m][n] = __builtin_amdgcn_mfma_f32_16x16x32_bf16(Bt[n][k], At[m][k], acc[ai][bj][m][n], 0, 0, 0); __builtin_amdgcn_s_setprio(0); } while (0)
#define PG8_WAIT_V(n) asm volatile("s_waitcnt vmcnt(" #n ")" ::: "memory")
#define PG8_WAIT_L(n) asm volatile("s_waitcnt lgkmcnt(" #n ")" ::: "memory")
#define PG8_BAR __builtin_amdgcn_s_barrier()
#define PG8_SCHED __builtin_amdgcn_sched_barrier(0)
    Unit cur, nxt; int ui = 0;
    if (!S.next(0, cur)) return;
    f32x4 acc[2][2][4][2];
#pragma unroll
    for (int a = 0; a < 2; ++a)
#pragma unroll
        for (int b = 0; b < 2; ++b)
#pragma unroll
            for (int m = 0; m < 4; ++m)
#pragma unroll
                for (int n = 0; n < 2; ++n) acc[a][b][m][n] = (f32x4){0.f, 0.f, 0.f, 0.f};
    bf16x8 At[4][2], B0[2][2], B1[2][2];
    const char* cA = (const char*)g.A + (size_t)cur.pm * tstep; const char* cB = (const char*)g.Bt + (size_t)cur.pn * tstep;
    S.a_ready(cur);
    PG8_STAGE(PG8_SB(0, 0), cB, voffB); PG8_STAGE(PG8_SA(0, 0), cA, voffA); PG8_STAGE(PG8_SB(0, 1), cB + hstep, voffB); PG8_STAGE(PG8_SA(0, 1), cA + hstep, voffA);
    if (wr == 1) PG8_BAR;
    PG8_WAIT_V(4); PG8_BAR;
    PG8_STAGE(PG8_SB(1, 0), cB + kstep, voffB); PG8_STAGE(PG8_SA(1, 0), cA + kstep, voffA); PG8_STAGE(PG8_SB(1, 1), cB + hstep + kstep, voffB);
    PG8_WAIT_V(6); PG8_BAR;
    PG8_STAMP();
    for (;;) {
        const bool has_next = S.next(ui + 1, nxt);
        const char* nA = has_next ? (const char*)g.A + (size_t)nxt.pm * tstep : cA; const char* nB = has_next ? (const char*)g.Bt + (size_t)nxt.pn * tstep : cB;
        for (int t = 0; t < nt; t += 2) {
            const bool last = (t == nt - 2);
            const char* a1 = cA + (size_t)(t + 1) * kstep;
            const char* a2 = last ? nA : cA + (size_t)(t + 2) * kstep; const char* b2 = last ? nB : cB + (size_t)(t + 2) * kstep;
            const char* a3 = a2 + kstep; const char* b3 = b2 + kstep;
            if (last && has_next) S.a_ready(nxt);
            PG8_LDB(B0, 0, 0); PG8_SCHED; PG8_LDA(At, 0, 0); PG8_STAGE(PG8_SA(1, 1), a1 + hstep, voffA);
            PG8_WAIT_L(8); PG8_BAR; PG8_WAIT_L(0); PG8_MMA(0, 0, At, B0); PG8_BAR; PG8_SCHED;
            PG8_LDB(B1, 0, 1); PG8_STAGE(PG8_SB(0, 0), b2, voffB);
            PG8_BAR; PG8_WAIT_L(0); PG8_MMA(0, 1, At, B1); PG8_BAR;
            PG8_LDA(At, 0, 1); PG8_STAGE(PG8_SA(0, 0), a2, voffA);
            PG8_BAR; PG8_WAIT_L(0); PG8_MMA(1, 0, At, B0); PG8_BAR; PG8_SCHED;
            PG8_STAGE(PG8_SB(0, 1), b2 + hstep, voffB);
            PG8_WAIT_V(6); PG8_BAR; PG8_MMA(1, 1, At, B1); PG8_BAR;
            PG8_LDB(B0, 1, 0); PG8_SCHED; PG8_LDA(At, 1, 0); PG8_STAGE(PG8_SA(0, 1), a2 + hstep, voffA);
            PG8_WAIT_L(8); PG8_BAR; PG8_WAIT_L(0); PG8_MMA(0, 0, At, B0); PG8_BAR; PG8_SCHED;
            PG8_LDB(B1, 1, 1); PG8_STAGE(PG8_SB(1, 0), b3, voffB);
            PG8_BAR; PG8_WAIT_L(0); PG8_MMA(0, 1, At, B1); PG8_BAR;
            PG8_LDA(At, 1, 1); PG8_STAGE(PG8_SA(1, 0), a3, voffA);
            PG8_BAR; PG8_WAIT_L(0); PG8_MMA(1, 0, At, B0); PG8_BAR; PG8_SCHED;
            PG8_STAGE(PG8_SB(1, 1), b3 + hstep, voffB);
            PG8_WAIT_V(6); PG8_BAR; PG8_MMA(1, 1, At, B1); PG8_BAR;
        }
        PG8_STAMP();
        if constexpr (!Epi::AFTER_DRAIN) { E(acc, cur, wr, wc, fr, fq); S.done(cur); }
        PG8_STAMP();
        if (!has_next) break;
        bool keep_acc = false;
        if constexpr (keeps_acc<Epi>::value) keep_acc = S.keep(ui);
        if (!keep_acc) {
#pragma unroll
        for (int a = 0; a < 2; ++a)
#pragma unroll
            for (int b = 0; b < 2; ++b)
#pragma unroll
                for (int m = 0; m < 4; ++m)
#pragma unroll
                    for (int n = 0; n < 2; ++n) acc[a][b][m][n] = (f32x4){0.f, 0.f, 0.f, 0.f};
        }
        cur = nxt; cA = nA; cB = nB; ++ui;
    }
    PG8_WAIT_V(0);
    if (wr == 0) PG8_BAR;
    PG8_BAR;
    if constexpr (Epi::AFTER_DRAIN) { E.fused(acc, cur, wr, wc, fr, fq, lds, wid, lane); S.done(cur); }
    PG8_STAMP();
    if (STAMP && wid == 0) { stamps[lane] = lane < nts ? (((unsigned long long)(unsigned)ts_hi << 32) | (unsigned)ts_lo) : 0ull;
        if (lane == 62) stamps[62] = rt_entry; if (lane == 63) stamps[63] = (unsigned long long)wall_clock64(); }
#undef PG8_STAMP
#undef PG8_SA
#undef PG8_SB
#undef PG8_STAGE
#undef PG8_LDA
#undef PG8_LDB
#undef PG8_MMA
#undef PG8_WAIT_V
#undef PG8_WAIT_L
#undef PG8_BAR
#undef PG8_SCHED
}
}

#define GAS __attribute__((address_space(1)))
#define LAS __attribute__((address_space(3)))
typedef unsigned short bf16_t;
typedef short bf16x8 __attribute__((ext_vector_type(8)));
typedef short s16x4 __attribute__((ext_vector_type(4)));
typedef float f32x4 __attribute__((ext_vector_type(4)));
typedef float f32x2 __attribute__((ext_vector_type(2)));
typedef float f32x16 __attribute__((ext_vector_type(16)));
typedef unsigned u32x4 __attribute__((ext_vector_type(4)));
typedef unsigned u32x2 __attribute__((ext_vector_type(2)));

typedef __bf16 bf16x2_t __attribute__((ext_vector_type(2)));
__device__ __forceinline__ unsigned cvtpk_c(float lo, float hi) { const f32x2 v = {lo, hi}; return __builtin_bit_cast(unsigned, __builtin_convertvector(v, bf16x2_t)); }
__device__ __forceinline__ unsigned cvtpk(float lo, float hi) { unsigned r; asm volatile("v_cvt_pk_bf16_f32 %0, %1, %2" : "=v"(r) : "v"(lo), "v"(hi)); return r; }
__device__ __forceinline__ float bf2f(unsigned short b) { return __uint_as_float(((unsigned)b) << 16); }
__device__ __forceinline__ float bflo(unsigned w) { return __uint_as_float(w << 16); }
__device__ __forceinline__ float bfhi(unsigned w) { return __uint_as_float(w & 0xffff0000u); }
__device__ __forceinline__ float wave_sum(float v) {
#pragma unroll
    for (int o = 1; o < 64; o <<= 1) v += __shfl_xor(v, o);
    return v;
}
__device__ __forceinline__ float sigmoidf_(float x) { return __builtin_amdgcn_rcpf(1.0f + __builtin_amdgcn_exp2f(-1.4426950408889634f * x)); }
__device__ __forceinline__ float siluf_(float x) { return x * __builtin_amdgcn_rcpf(1.0f + __builtin_amdgcn_exp2f(-1.4426950408889634f * x)); }

#define XB_TMO      128
#define XB_XCNT(j)  (256  + 64 * (j))
#define XB_XSUB(j)  (1280 + 64 * (j))
#define XB_XGEN(j)  (2304 + 64 * (j))
#define XB_TOP      3328
#define XB_TOPGEN   3392
#define XCD_BAR_WORDS 3456
#define XB_SPIN_CAP (1u << 18)

__device__ __forceinline__ unsigned xb_ld(unsigned* p)              { return __hip_atomic_load(p, __ATOMIC_RELAXED, __HIP_MEMORY_SCOPE_AGENT); }
__device__ __forceinline__ unsigned xb_add(unsigned* p, unsigned v) { return __hip_atomic_fetch_add(p, v, __ATOMIC_RELAXED, __HIP_MEMORY_SCOPE_AGENT); }
__device__ __forceinline__ unsigned xb_xcc_id() { return (unsigned)__builtin_amdgcn_s_getreg((3 << 11) | 20) & 0xFu; }
#define XB_SPIN(cond, bar) do { unsigned _sp = 0; while (cond) { __builtin_amdgcn_s_sleep(1); \
    if ((++_sp & 255u) == 0u) { if (xb_ld(&(bar)[XB_TMO])) break; if (_sp > XB_SPIN_CAP) { atomicAdd(&(bar)[XB_TMO], 1u); break; } } } } while (0)

struct XcdBarrier {
    unsigned* bar; unsigned x;
    volatile LAS unsigned* st;
};
__device__ __forceinline__ XcdBarrier xcd_barrier_post(unsigned* bar, volatile LAS unsigned* st) {
    XcdBarrier b; b.bar = bar; b.x = xb_xcc_id(); b.st = st;
    if (threadIdx.x == 0) (void)xb_add(&bar[XB_XCNT(b.x)], 1u);
    return b;
}
__device__ __forceinline__ void xcd_barrier_complete(unsigned* bar, unsigned x, unsigned& nloc, unsigned& nx) {
    const unsigned G = gridDim.x * gridDim.y * gridDim.z;
    unsigned sum, cnt, mine, sp = 0u;
    for (;;) {
        sum = 0u; cnt = 0u; mine = 0u;
#pragma unroll
        for (unsigned j = 0; j < 16; ++j) { const unsigned c = xb_ld(&bar[XB_XCNT(j)]); sum += c; cnt += (c > 0u) ? 1u : 0u; mine = (j == x) ? c : mine; }
        if (sum == G) break;
        __builtin_amdgcn_s_sleep(1);
        if ((++sp & 255u) == 0u) { if (xb_ld(&bar[XB_TMO])) break; if (sp > XB_SPIN_CAP) { atomicAdd(&bar[XB_TMO], 1u); break; } }
    }
    nloc = mine > 0u ? mine : 1u; nx = cnt > 0u ? cnt : 1u;
}
__device__ __forceinline__ void xcd_barrier(const XcdBarrier& b) {
    asm volatile("s_waitcnt vmcnt(0)" ::: "memory");
    __syncthreads();
    if (threadIdx.x == 0) {
        unsigned* bar = b.bar;
        __builtin_amdgcn_s_waitcnt(0);
        unsigned nloc = b.st[0], nx = b.st[1];
        if (nloc == 0u) { xcd_barrier_complete(bar, b.x, nloc, nx); b.st[0] = nloc; b.st[1] = nx; }
        const unsigned old = xb_add(&bar[XB_XSUB(b.x)], 1u);
        const unsigned gen = old / nloc;
        if (old + 1u == (gen + 1u) * nloc) {
            __builtin_amdgcn_fence(__ATOMIC_RELEASE, "agent");
            asm volatile("s_waitcnt vmcnt(0)" ::: "memory");
            const unsigned og = xb_add(&bar[XB_TOP], 1u);
            const unsigned tg = og / nx;
            if (og + 1u == (tg + 1u) * nx) xb_add(&bar[XB_TOPGEN], 1u);
            else XB_SPIN(xb_ld(&bar[XB_TOPGEN]) == tg, bar);
            __builtin_amdgcn_fence(__ATOMIC_ACQUIRE, "agent");
            xb_add(&bar[XB_XGEN(b.x)], 1u);
            asm volatile("s_waitcnt vmcnt(0)" ::: "memory");
        } else {
            XB_SPIN(xb_ld(&bar[XB_XGEN(b.x)]) == gen, bar);
            __builtin_amdgcn_fence(__ATOMIC_ACQUIRE, "agent");
            asm volatile("s_waitcnt vmcnt(0)" ::: "memory");
        }
    }
    __syncthreads();
}

constexpr int D = 2048, NB = 2, T = 16384, LC = 256, TT = T + LC  , MR = NB * TT  ;
constexpr int NPAN = MR / 256  , PPB = TT / 256  ;
constexpr int NIN = 17408, DFF = 5504, NUP = 2 * DFF;
constexpr int NWAVES = 8, NTHR = 512;
constexpr float EPS = 1e-6f;
constexpr float LOG2E = 1.4426950408889634f;

enum { I_X = 0, I_C, I_CTX, I_CCTX, I_WMOD, I_BMOD, I_WIN, I_BGATE, I_QKN, I_LAMBDA, I_SUBLN, I_RNORM, I_GLB, I_GNORM, I_WBR, I_WOUT, I_WUP, I_CONVW, I_CONVB, I_WDOWN, N_INPUTS };

enum { TY_ROPE64 = 0, TY_ROPE128 = 1, TY_PLAIN = 2 };
enum { PT_DQ = 0, PT_DK = 4, PT_DV = 8, PT_RQ = 12, PT_RK = 14, PT_RV = 16, PT_GQ = 20, PT_GF = 24, PT_GB = 28, PT_GI = 32, PT_RG = 36, PT_GG = 40, PT_MA = 44, PT_MB = 52, PT_MC = 60, PT_END = 68 };
__host__ __device__ __forceinline__ int pt_logical_base(int pt) {
    if (pt < PT_RQ) return 256 * pt;
    if (pt < PT_RV) return 3072 + 256 * (pt - PT_RQ);
    if (pt < PT_GQ) return 4096 + 256 * (pt - PT_RV);
    if (pt < PT_RG) return 6144 + 256 * (pt - PT_GQ);
    if (pt < PT_GG) return 5120 + 256 * (pt - PT_RG);
    if (pt < PT_MA) return 10240 + 256 * (pt - PT_GG);
    return 11264 + 256 * (pt - PT_MA);
}
__host__ __device__ __forceinline__ int pt_type(int pt) { return pt < PT_DV ? TY_ROPE64 : (pt >= PT_RQ && pt < PT_RV) ? TY_ROPE128 : TY_PLAIN; }
__host__ __device__ __forceinline__ int perm_col(int type, int p) {
    const int bj = p >> 7, wc = (p >> 5) & 3, n = (p >> 4) & 1, fq = (p >> 2) & 3, e = p & 3;
    if (type == TY_ROPE64)  return 64 * wc + 32 * (fq >> 1) + 16 * bj + 8 * (fq & 1) + 4 * n + e;
    if (type == TY_ROPE128) return 128 * (wc >> 1) + 64 * (wc & 1) + 32 * bj + 8 * fq + 4 * n + e;
    return 64 * wc + 32 * bj + 8 * fq + 4 * n + e;
}
__host__ __device__ __forceinline__ int perm_col_up(int p) { const int bj = p >> 7, wc = (p >> 5) & 3, n = (p >> 4) & 1, fq = (p >> 2) & 3, e = p & 3; return 128 * bj + 32 * wc + 8 * fq + 4 * n + e; }

constexpr size_t MiB = 1u << 20;
constexpr size_t WS_CTL = 0, CTL_ZERO_BYTES = 1 * MiB;
constexpr size_t WS_MODP = 1 * MiB;
constexpr size_t WS_MODV = 6 * MiB;
constexpr size_t WS_ROPEA = 7 * MiB;
constexpr size_t WS_ROPEB = 7 * MiB + 64 * 1024;
constexpr size_t WS_LB = 7 * MiB + 256 * 1024;
constexpr size_t WS_SCAL = 7 * MiB + 512 * 1024;
constexpr size_t WS_XC = 9 * MiB;
constexpr size_t WS_WT = 13 * MiB;
constexpr size_t WT_IN = 0, WT_BR = 68 * MiB, WT_OUT = 80 * MiB, WT_UP = 88 * MiB, WT_DOWN = 131 * MiB;
constexpr size_t WS_H = 166 * MiB;
constexpr size_t WS_DYN = 296 * MiB;
constexpr size_t DY_OA = WS_DYN, DY_OB = WS_DYN + 65 * MiB, DY_OC = WS_DYN + 130 * MiB;
constexpr size_t DY_OSUB = WS_DYN + 195 * MiB;
constexpr size_t DY_US = DY_OSUB;
constexpr size_t DY_QKV = WS_DYN + 65 * MiB;
constexpr size_t DY_O1 = WS_DYN + 260 * MiB;
constexpr size_t DY_PC = WS_DYN + 325 * MiB;
constexpr size_t DY_PB = WS_DYN + 585 * MiB;
constexpr size_t DY_MG = WS_DYN + 325 * MiB;
constexpr size_t DY_Y = DY_OSUB, DY_YO = DY_OSUB;
constexpr size_t DY_G = WS_DYN, DY_RAW = WS_DYN + 350 * MiB;
constexpr size_t WS_END = WS_DYN + 715 * MiB;
constexpr size_t SZ_ROWS1K = (size_t)MR * 1024 * 2;

constexpr int CW_BAR = 4096;

constexpr int RING_BYTES = 131072, LDSCTL_OFF = RING_BYTES, MISC_OFF = LDSCTL_OFF + 320, LDS_BYTES = 147456;

struct Args { const float* in[N_INPUTS]; float* out; unsigned char* ws; int layer, ph_lo, ph_hi, pad; };

struct Frame {
    LAS unsigned char* lds;
    int tid, lane, wave, G, bid;
    const Args* a; unsigned char* ws;
};
__device__ __forceinline__ float* outp(const Frame& F) { GAS float* p = (GAS float*)F.a->out; asm volatile("" : "+s"(p)); return (float*)p; }
__device__ __forceinline__ const float* inp(const Frame& F, int i) { const GAS float* p = (const GAS float*)F.a->in[i]; asm volatile("" : "+s"(p)); return (const float*)p; }
__device__ __forceinline__ int opaque_tid() { int t = threadIdx.x; asm volatile("" : "+v"(t)); return t; }
__device__ __forceinline__ void frame_refresh(Frame& F) { GAS unsigned char* w_ = (GAS unsigned char*)F.a->ws; asm volatile("" : "+s"(w_)); F.ws = (unsigned char*)w_; F.tid = opaque_tid(); F.lane = F.tid & 63; F.wave = __builtin_amdgcn_readfirstlane(F.tid >> 6); }
#define WSP(T_, off) ((T_*)(F.ws + (off)))

__device__ __forceinline__ void p0_mod_partial(Frame& F) {
    LAS float* sv = (LAS float*)F.lds;
    for (int i = F.tid; i < 3 * D; i += NTHR) { const int v = i / D, k = i % D; const float c = v < 2 ? inp(F, I_C)[v * D + k] : inp(F, I_CCTX)[k]; sv[i] = siluf_(c); }
    __syncthreads();
    float* part = WSP(float, WS_MODP);
    const int total = 2 * 16 * 3072;
    for (int task = F.bid * NTHR + F.tid; task < total; task += F.G * NTHR) {
        const int q = task % 3072, ks = (task / 3072) % 16, l = task / (3072 * 16);
        const float* W = inp(F, I_WMOD) + ((size_t)l * D + ks * 128) * (6 * D) + q * 4;
        f32x4 a0 = {0, 0, 0, 0}, a1 = a0, a2 = a0;
#pragma unroll 8
        for (int k = 0; k < 128; ++k) { const f32x4 w = *(const f32x4*)(W + (size_t)k * (6 * D)); const float s0 = sv[ks * 128 + k], s1 = sv[D + ks * 128 + k], s2 = sv[2 * D + ks * 128 + k];
            a0 += w * s0; a1 += w * s1; a2 += w * s2; }
        float* o = part + ((size_t)(ks * 2 + l) * 3) * (6 * D) + q * 4;
        *(f32x4*)(o) = a0; *(f32x4*)(o + 6 * D) = a1; *(f32x4*)(o + 12 * D) = a2;
    }
    __syncthreads();
}
__device__ __forceinline__ void p0_tables(Frame& F) {
    const int gt = F.bid * NTHR + F.tid, NGT = F.G * NTHR;
    f32x2* ra = WSP(f32x2, WS_ROPEA); f32x2* rb = WSP(f32x2, WS_ROPEB);
    for (int i = gt; i < 256 * 16; i += NGT) { const int pos = i >> 4, f = i & 15; const float inv = powf(10000.0f, -(float)f / 16.0f); const float ang = (float)pos * inv; ra[i] = (f32x2){cosf(ang), sinf(ang)}; }
    for (int i = gt; i < 256 * 32; i += NGT) { const int pos = i >> 5, f = i & 31; const float inv = powf(10000.0f, -(float)f / 32.0f); const float ang = (float)pos * inv; rb[i] = (f32x2){cosf(ang), sinf(ang)}; }
    float* lb = WSP(float, WS_LB);
    for (int i = gt; i < 2 * 1024; i += NGT) { const float g0 = inp(F, I_GLB)[i], g1 = inp(F, I_GLB)[2048 + i]; const float m = fmaxf(g0, g1); const float e0 = expf(g0 - m), e1 = expf(g1 - m);
        lb[i] = 0.0f; lb[2048 + i] = e1 / (e0 + e1); }
    if (gt == 0) {
        float* sc = WSP(float, WS_SCAL);
        for (int l = 0; l < 2; ++l) {
            const float* al = inp(F, I_LAMBDA) + l * 256; float s1 = 0.f, s2 = 0.f;
            for (int i = 0; i < 64; ++i) { s1 += al[i] * al[64 + i]; s2 += al[128 + i] * al[192 + i]; }
            const float lam_init = 0.8f - 0.6f * expf(-0.3f * (float)l);
            sc[l] = expf(s1) - expf(s2) + lam_init;
            const float* g = inp(F, I_QKN) + l * 128; float mq = 0.f, mk = 0.f;
            for (int i = 0; i < 64; ++i) { mq = fmaxf(mq, fabsf(g[i])); mk = fmaxf(mk, fabsf(g[64 + i])); }
            sc[2 + l] = -(8.0f * mq * mk * 1.02f) * LOG2E;
        }
    }
}
__device__ __forceinline__ void convert_tile(Frame& F, const float* W, int N, int K, bf16_t* WT, int prow0, int k0, int base0, int base1, int ptype  ) {
    LAS float* t = (LAS float*)F.lds;
    { float wv[32];
#pragma unroll
      for (int i = 0; i < 32; ++i) { const int idx = i * NTHR + F.tid, kk = idx >> 8, c = idx & 255; const int col = c < 128 ? base0 + c : base1 + (c - 128);
          wv[i] = W[(size_t)(k0 + kk) * N + col]; }
#pragma unroll
      for (int i = 0; i < 32; ++i) { const int idx = i * NTHR + F.tid, kk = idx >> 8, c = idx & 255; t[kk * 257 + c] = wv[i]; } }
    __syncthreads();
#pragma unroll
    for (int i = 0; i < 4; ++i) { const int item = i * NTHR + F.tid, ch = item & 7, p = item >> 3; const int lc = ptype < 0 ? perm_col_up(p) : perm_col(ptype, p);
        const LAS float* s = t + (8 * ch) * 257 + lc;
        u32x4 o; o.x = cvtpk(s[0], s[257]); o.y = cvtpk(s[2 * 257], s[3 * 257]); o.z = cvtpk(s[4 * 257], s[5 * 257]); o.w = cvtpk(s[6 * 257], s[7 * 257]);
        *(u32x4*)(WT + (size_t)(prow0 + p) * K + k0 + 8 * ch) = o; }
    __syncthreads();
}
__device__ __forceinline__ void convert_weights(Frame& F, int l) {
    bf16_t* wt = WSP(bf16_t, WS_WT);
    constexpr int T_IN = 68 * 32, T_BR = 3 * 8 * 16, T_OUT = 8 * 32, T_UP = 43 * 32, T_DN = 8 * 86, T_ALL = T_IN + T_BR + T_OUT + T_UP + T_DN;
    for (int it = F.bid; it < T_ALL; it += F.G) {
        int r = it;
        if (r < T_IN) { const int pt = r / 32, kb = r % 32; const int lb = pt_logical_base(pt);
            convert_tile(F, inp(F, I_WIN) + (size_t)l * D * NIN, NIN, D, wt + WT_IN / 2, pt * 256, kb * 64, lb, lb + 128, pt_type(pt)); continue; } r -= T_IN;
        if (r < T_BR) { const int n = r / 128, pt = (r % 128) / 16, kb = r % 16;
            convert_tile(F, inp(F, I_WBR) + ((size_t)l * 3 + n) * 1024 * D, D, 1024, wt + WT_BR / 2 + (size_t)n * D * 1024, pt * 256, kb * 64, pt * 256, pt * 256 + 128, TY_PLAIN); continue; } r -= T_BR;
        if (r < T_OUT) { const int pt = r / 32, kb = r % 32;
            convert_tile(F, inp(F, I_WOUT) + (size_t)l * D * D, D, D, wt + WT_OUT / 2, pt * 256, kb * 64, pt * 256, pt * 256 + 128, TY_PLAIN); continue; } r -= T_OUT;
        if (r < T_UP) { const int pt = r / 32, kb = r % 32;
            convert_tile(F, inp(F, I_WUP) + (size_t)l * D * NUP, NUP, D, wt + WT_UP / 2, pt * 256, kb * 64, pt * 128, DFF + pt * 128, -1); continue; } r -= T_UP;
        { const int pt = r / 86, kb = r % 86;
            convert_tile(F, inp(F, I_WDOWN) + (size_t)l * DFF * D, D, DFF, wt + WT_DOWN / 2, pt * 256, kb * 64, pt * 256, pt * 256 + 128, TY_PLAIN); }
    }
}
__device__ __forceinline__ void p1_mod_final(Frame& F) {
    const float* part = WSP(float, WS_MODP); float* mv = WSP(float, WS_MODV);
    for (int i = F.bid * NTHR + F.tid; i < 2 * 3 * 6 * D; i += F.G * NTHR) { const int n = i % (6 * D), l = i / (3 * 6 * D);
        float s = inp(F, I_BMOD)[l * 6 * D + n];
#pragma unroll
        for (int ks = 0; ks < 16; ++ks) s += part[(size_t)ks * (2 * 3 * 6 * D) + i];
        mv[i] = s; }
}

__device__ __forceinline__ const float* xrow_src(Frame& F, int R, int use_inputs) {
    const int b = R / TT, t = R % TT;
    if (t < T) return (use_inputs ? inp(F, I_X) : (const float*)outp(F)) + ((size_t)b * T + t) * D;
    return (use_inputs ? inp(F, I_CTX) : (const float*)WSP(float, WS_XC)) + ((size_t)b * LC + (t - T)) * D;
}
__device__ __forceinline__ void norm_phase(Frame& F, int l, int which  ) {
    const int gw = F.bid * NWAVES + F.wave, NGW = F.G * NWAVES;
    bf16_t* h = WSP(bf16_t, WS_H); const float* mv = WSP(float, WS_MODV);
    const int use_inputs = (l == 0 && which == 0);
    f32x4 x[8], xn[8], sc1[8], sh[8]; int vcur = -1;
    if (gw < MR) { const f32x4* xr = (const f32x4*)xrow_src(F, gw, use_inputs) + F.lane;
#pragma unroll
        for (int j = 0; j < 8; ++j) x[j] = xr[64 * j]; }
    for (int R = gw; R < MR; R += NGW) {
        const int Rn = R + NGW;
        if (Rn < MR) { const f32x4* xr = (const f32x4*)xrow_src(F, Rn, use_inputs) + F.lane;
#pragma unroll
            for (int j = 0; j < 8; ++j) xn[j] = xr[64 * j]; }
        const int b = R / TT, t = R % TT, v = t < T ? b : 2;
        if (v != vcur) {
            const float* shift = mv + ((size_t)(l * 3 + v) * 6 + (which ? 3 : 0)) * D; const float* scale = shift + D;
#pragma unroll
            for (int j = 0; j < 8; ++j) { sc1[j] = *((const f32x4*)scale + F.lane + 64 * j) + 1.0f; sh[j] = *((const f32x4*)shift + F.lane + 64 * j); }
            vcur = v;
        }
        float ss = 0.f;
#pragma unroll
        for (int j = 0; j < 8; ++j) ss += (x[j].x * x[j].x + x[j].y * x[j].y) + (x[j].z * x[j].z + x[j].w * x[j].w);
        const float rstd = rsqrtf(wave_sum(ss) * (1.0f / D) + EPS);
        u32x2* o = (u32x2*)(h + (size_t)R * D) + F.lane;
#pragma unroll
        for (int j = 0; j < 8; ++j) { const f32x4 y = x[j] * rstd * sc1[j] + sh[j]; u32x2 w; w.x = cvtpk(y.x, y.y); w.y = cvtpk(y.z, y.w); o[64 * j] = w; }
#pragma unroll
        for (int j = 0; j < 8; ++j) x[j] = xn[j];
    }
}

typedef f32x4 acc_t[2][2][4][2];
__device__ __forceinline__ u32x4 pack8(const f32x4 a, const f32x4 b) { u32x4 w; w.x = cvtpk(a[0], a[1]); w.y = cvtpk(a[2], a[3]); w.z = cvtpk(b[0], b[1]); w.w = cvtpk(b[2], b[3]); return w; }

struct EpiIn {
    static constexpr bool PERM = false, AFTER_DRAIN = false;
    int pt0;
    bf16_t *rq, *r2, *r1;
    const float* qkn;
    const f32x2 *ropeA, *ropeB;
    __device__ __forceinline__ void operator()(const acc_t& acc, const pg8::Unit& u, int wr, int wc, int fr, int fq) const {
        const int pt = pt0 + u.pn, b = u.pm / PPB, tb = (u.pm % PPB) * 256 + wr * 64 + fr;
        if (pt < PT_DV) {
            const int isk = pt >= PT_DK, sh = 4 * (pt - (isk ? PT_DK : PT_DQ)) + wc, d0 = 32 * (fq >> 1) + 8 * (fq & 1);
            bf16_t* base = rq + (isk ? (size_t)MR * 1024 : (size_t)0) + ((size_t)(b * 16 + sh) * TT) * 64 + d0;
            const float* gp = qkn + isk * 64 + d0; const float osc = isk ? 1.0f : LOG2E * 0.125f;
            f32x4 g[2][2];
#pragma unroll
            for (int s = 0; s < 2; ++s)
#pragma unroll
                for (int n = 0; n < 2; ++n) g[s][n] = *(const f32x4*)(gp + 16 * s + 4 * n) * osc;
            const bool lat = (u.pm % PPB) != PPB - 1;
            f32x4 c0_[4], c1_[4], c2_[4];
#define R64_LD(buf, it) do { const int t = lat ? tb + ((it) >> 2) * 128 + ((it) & 3) * 16 : 0; const int pos = (fq < 2) ? (t >> 6) : (t & 63);                                              \
                const f32x4* rp = (const f32x4*)(ropeA + pos * 16 + 8 * (fq & 1)); _Pragma("unroll") for (int k = 0; k < 4; ++k) buf[k] = rp[k]; } while (0)
#define R64_DO(buf, it) do { constexpr int ai = (it) >> 2, m = (it) & 3; const int t = tb + ai * 128 + m * 16;                                                                                  \
                f32x4 x[2][2]; float ss = 0.f;                                                                                                                                                    \
                _Pragma("unroll") for (int s = 0; s < 2; ++s) _Pragma("unroll") for (int n = 0; n < 2; ++n) { x[s][n] = acc[ai][s][m][n];                                                         \
                    ss += (x[s][n][0] * x[s][n][0] + x[s][n][1] * x[s][n][1]) + (x[s][n][2] * x[s][n][2] + x[s][n][3] * x[s][n][3]); }                                                            \
                ss += __shfl_xor(ss, 16); ss += __shfl_xor(ss, 32);                                                                                                                               \
                const float rstd = rsqrtf(ss * (1.0f / 64.0f) + EPS);                                                                                                                             \
                _Pragma("unroll") for (int s = 0; s < 2; ++s) _Pragma("unroll") for (int n = 0; n < 2; ++n) x[s][n] = x[s][n] * rstd * g[s][n];                                                   \
                if (lat) { _Pragma("unroll") for (int n = 0; n < 2; ++n) { const f32x4 c01 = buf[2 * n], c23 = buf[2 * n + 1];               \
                    const f32x4 cs = {c01[0], c01[2], c23[0], c23[2]}, sn = {c01[1], c01[3], c23[1], c23[3]};                                                                                     \
                    const f32x4 u1 = x[0][n], u2 = x[1][n]; x[0][n] = u1 * cs - u2 * sn; x[1][n] = u1 * sn + u2 * cs; } }                                                                         \
                bf16_t* rowp = base + (size_t)t * 64;                                                                                                                                             \
                *(u32x4*)(rowp) = pack8(x[0][0], x[0][1]); *(u32x4*)(rowp + 16) = pack8(x[1][0], x[1][1]); } while (0)
            R64_LD(c0_, 0); R64_LD(c1_, 1); R64_LD(c2_, 2); R64_DO(c0_, 0); R64_LD(c0_, 3); R64_DO(c1_, 1); R64_LD(c1_, 4); R64_DO(c2_, 2); R64_LD(c2_, 5);
            R64_DO(c0_, 3); R64_LD(c0_, 6); R64_DO(c1_, 4); R64_LD(c1_, 7); R64_DO(c2_, 5); R64_DO(c0_, 6); R64_DO(c1_, 7);
#undef R64_LD
#undef R64_DO
        } else if (pt >= PT_RQ && pt < PT_RV) {
            const int isk = pt >= PT_RK, head = 2 * (pt - (isk ? PT_RK : PT_RQ)) + (wc >> 1), d0 = 64 * (wc & 1) + 8 * fq;
            bf16_t* base = r2 + (isk ? (size_t)MR * 512 : (size_t)0) + ((size_t)(b * 4 + head) * TT) * 128 + d0;
            const float osc = isk ? 0.08838834764831845f : 1.0f;
            const bool lat = (u.pm % PPB) != PPB - 1;
            f32x4 c0_[4], c1_[4], c2_[4];
#define R128_LD(buf, it) do { const int t = lat ? tb + ((it) >> 2) * 128 + ((it) & 3) * 16 : 0; const int pos = ((wc & 1) == 0) ? (t >> 6) : (t & 63);                                          \
                const f32x4* rp = (const f32x4*)(ropeB + pos * 32 + 8 * fq); _Pragma("unroll") for (int k = 0; k < 4; ++k) buf[k] = rp[k]; } while (0)
#define R128_DO(buf, it) do { constexpr int ai = (it) >> 2, m = (it) & 3; const int t = tb + ai * 128 + m * 16;                                                                                  \
                f32x4 x[2][2];                                                                                                                                                                    \
                _Pragma("unroll") for (int s = 0; s < 2; ++s) _Pragma("unroll") for (int n = 0; n < 2; ++n) x[s][n] = acc[ai][s][m][n] * osc;                                                     \
                if (lat) { _Pragma("unroll") for (int n = 0; n < 2; ++n) { const f32x4 c01 = buf[2 * n], c23 = buf[2 * n + 1];                                                                     \
                    const f32x4 cs = {c01[0], c01[2], c23[0], c23[2]}, sn = {c01[1], c01[3], c23[1], c23[3]};                                                                                     \
                    const f32x4 u1 = x[0][n], u2 = x[1][n]; x[0][n] = u1 * cs - u2 * sn; x[1][n] = u1 * sn + u2 * cs; } }                                                                         \
                bf16_t* rowp = base + (size_t)t * 128;                                                                                                                                            \
                *(u32x4*)(rowp) = pack8(x[0][0], x[0][1]); *(u32x4*)(rowp + 32) = pack8(x[1][0], x[1][1]); } while (0)
            R128_LD(c0_, 0); R128_LD(c1_, 1); R128_LD(c2_, 2); R128_DO(c0_, 0); R128_LD(c0_, 3); R128_DO(c1_, 1); R128_LD(c1_, 4); R128_DO(c2_, 2); R128_LD(c2_, 5);
            R128_DO(c0_, 3); R128_LD(c0_, 6); R128_DO(c1_, 4); R128_LD(c1_, 7); R128_DO(c2_, 5); R128_DO(c0_, 6); R128_DO(c1_, 7);
#undef R128_LD
#undef R128_DO
        } else {
            int pts, hd; bf16_t* sb;
            if (pt < PT_RQ) { sb = rq + (size_t)MR * 2048; pts = PT_DV; hd = 128; } else if (pt < PT_GQ) { sb = r2 + (size_t)MR * 1024; pts = PT_RV; hd = 256; }
            else { const int s4 = (pt - PT_GQ) >> 2; sb = r1 + (size_t)s4 * MR * 1024; pts = PT_GQ + 4 * s4; hd = 128; }
            const int c = 256 * (pt - pts) + 64 * wc + 8 * fq, head = c / hd, dim = c % hd, H = 1024 / hd;
            bf16_t* base = sb + ((size_t)(b * H + head) * TT) * hd + dim;
            const bool isq = (pt >= PT_GQ && pt < PT_GF);
#pragma unroll
            for (int ai = 0; ai < 2; ++ai)
#pragma unroll
                for (int m = 0; m < 4; ++m) {
                    const int t = tb + ai * 128 + m * 16; bf16_t* rowp = base + (size_t)t * hd;
#pragma unroll
                    for (int bj = 0; bj < 2; ++bj) { f32x4 a = acc[ai][bj][m][0], c2 = acc[ai][bj][m][1];
                        if (isq) {
#pragma unroll
                            for (int e = 0; e < 4; ++e) { a[e] = siluf_(a[e]) * 0.08838834764831845f; c2[e] = siluf_(c2[e]) * 0.08838834764831845f; } }
                        *(u32x4*)(rowp + 32 * bj) = pack8(a, c2); }
                }
        }
    }
};

struct EpiGates {
    static constexpr bool PERM = false, AFTER_DRAIN = false;
    bf16_t *oB, *oC, *G; const float* bias;
    __device__ __forceinline__ void operator()(const acc_t& acc, const pg8::Unit& u, int wr, int wc, int fr, int fq) const {
        const int R0 = u.pm * 256 + wr * 64 + fr;
        if (u.pn < 8) {
            bf16_t* o = (u.pn < 4 ? oB : oC) + 256 * (u.pn & 3) + 64 * wc + 8 * fq + (size_t)R0 * 1024;
            u32x4 wv[2][4][2];
#pragma unroll
            for (int ai = 0; ai < 2; ++ai)
#pragma unroll
                for (int m = 0; m < 4; ++m)
#pragma unroll
                    for (int bj = 0; bj < 2; ++bj) wv[ai][m][bj] = *(const u32x4*)(o + (size_t)(ai * 128 + m * 16) * 1024 + 32 * bj);
#pragma unroll
            for (int ai = 0; ai < 2; ++ai)
#pragma unroll
                for (int m = 0; m < 4; ++m) { bf16_t* rowp = o + (size_t)(ai * 128 + m * 16) * 1024;
#pragma unroll
                    for (int bj = 0; bj < 2; ++bj) { const u32x4 w = wv[ai][m][bj]; const f32x4 a = acc[ai][bj][m][0], c = acc[ai][bj][m][1];
                        const f32x4 r0 = {bflo(w.x) * siluf_(a[0]), bfhi(w.x) * siluf_(a[1]), bflo(w.y) * siluf_(a[2]), bfhi(w.y) * siluf_(a[3])};
                        const f32x4 r1 = {bflo(w.z) * siluf_(c[0]), bfhi(w.z) * siluf_(c[1]), bflo(w.w) * siluf_(c[2]), bfhi(w.w) * siluf_(c[3])};
                        *(u32x4*)(rowp + 32 * bj) = pack8(r0, r1); } }
        } else {
            const int t = u.pn - 8, n = t >> 3, c0 = 256 * (t & 7) + 64 * wc + 8 * fq;
            const float* bp = bias + n * D + c0; bf16_t* Gn = G + (size_t)n * MR * D + c0;
            f32x4 bv[2][2];
#pragma unroll
            for (int bj = 0; bj < 2; ++bj)
#pragma unroll
                for (int k = 0; k < 2; ++k) bv[bj][k] = *(const f32x4*)(bp + 32 * bj + 4 * k);
#pragma unroll
            for (int ai = 0; ai < 2; ++ai)
#pragma unroll
                for (int m = 0; m < 4; ++m) { bf16_t* rowp = Gn + (size_t)(R0 + ai * 128 + m * 16) * D;
#pragma unroll
                    for (int bj = 0; bj < 2; ++bj) { f32x4 a = acc[ai][bj][m][0] + bv[bj][0], c = acc[ai][bj][m][1] + bv[bj][1];
#pragma unroll
                        for (int e = 0; e < 4; ++e) { a[e] = fmaxf(sigmoidf_(a[e]), 7.888609052210118e-31f); c[e] = fmaxf(sigmoidf_(c[e]), 7.888609052210118e-31f); }
                        u32x4 w; w.x = cvtpk_c(a[0], a[1]); w.y = cvtpk_c(a[2], a[3]); w.z = cvtpk_c(c[0], c[1]); w.w = cvtpk_c(c[2], c[3]);
                        *(u32x4*)(rowp + 32 * bj) = w; } }
        }
    }
};
struct EpiProjAll {
    static constexpr bool PERM = false, AFTER_DRAIN = false, KEEPS_ACC = true;
    const bf16_t* G; bf16_t* y;
    __device__ __forceinline__ void operator()(acc_t& acc, const pg8::Unit& u, int wr, int wc, int fr, int fq) const {
        const int n = u.pm / NPAN, pm = u.pm - n * NPAN, pn = u.pn & 7;
        const int c0 = 256 * pn + 64 * wc + 8 * fq, R0 = pm * 256 + wr * 64 + fr;
        const bf16_t* Gn = G + (size_t)n * MR * D + (size_t)R0 * D + c0; const bf16_t* Gx = Gn + (size_t)MR * D;
        bf16_t* yp = y + (size_t)R0 * D + c0;
        u32x4 wa[4], xa[4], wb[4], xb[4];
#define PJ_LD(GW_, GX_, ai, bj) do { _Pragma("unroll") for (int m = 0; m < 4; ++m) { const size_t ro = (size_t)((ai) * 128 + m * 16) * D + 32 * (bj); GW_[m] = *(const u32x4*)(Gn + ro); GX_[m] = *(const u32x4*)(Gx + ro); } } while (0)
#define PJ_LD1(GW_, ai, bj) do { _Pragma("unroll") for (int m = 0; m < 4; ++m) { const size_t ro = (size_t)((ai) * 128 + m * 16) * D + 32 * (bj); GW_[m] = *(const u32x4*)(Gn + ro); } } while (0)
#define PJ_RATIO(GW_, GX_, ai, bj) do { _Pragma("unroll") for (int m = 0; m < 4; ++m) {                                                     \
            const float g[8] = {bflo(GW_[m].x), bfhi(GW_[m].x), bflo(GW_[m].y), bfhi(GW_[m].y), bflo(GW_[m].z), bfhi(GW_[m].z), bflo(GW_[m].w), bfhi(GW_[m].w)};            \
            const float d[8] = {bflo(GX_[m].x), bfhi(GX_[m].x), bflo(GX_[m].y), bfhi(GX_[m].y), bflo(GX_[m].z), bfhi(GX_[m].z), bflo(GX_[m].w), bfhi(GX_[m].w)};            \
            f32x4 r0 = acc[ai][bj][m][0], r1 = acc[ai][bj][m][1];                                                                                                         \
            _Pragma("unroll") for (int e = 0; e < 4; ++e) { r0[e] *= g[e] * __builtin_amdgcn_rcpf(d[e]); r1[e] *= g[4 + e] * __builtin_amdgcn_rcpf(d[4 + e]); }           \
            acc[ai][bj][m][0] = r0; acc[ai][bj][m][1] = r1; } } while (0)
#define PJ_FINAL(GW_, ai, bj) do { _Pragma("unroll") for (int m = 0; m < 4; ++m) {                                                           \
            const float g[8] = {bflo(GW_[m].x), bfhi(GW_[m].x), bflo(GW_[m].y), bfhi(GW_[m].y), bflo(GW_[m].z), bfhi(GW_[m].z), bflo(GW_[m].w), bfhi(GW_[m].w)};            \
            f32x4 r0 = acc[ai][bj][m][0], r1 = acc[ai][bj][m][1];                                                                                                         \
            _Pragma("unroll") for (int e = 0; e < 4; ++e) { r0[e] *= g[e]; r1[e] *= g[4 + e]; }                                                                           \
            *(u32x4*)(yp + (size_t)((ai) * 128 + m * 16) * D + 32 * (bj)) = pack8(r0, r1); } } while (0)
        if (n < 2) { PJ_LD(wa, xa, 0, 0); PJ_LD(wb, xb, 0, 1); PJ_RATIO(wa, xa, 0, 0); PJ_LD(wa, xa, 1, 0); PJ_RATIO(wb, xb, 0, 1); PJ_LD(wb, xb, 1, 1); PJ_RATIO(wa, xa, 1, 0); PJ_RATIO(wb, xb, 1, 1); }
        else { PJ_LD1(wa, 0, 0); PJ_LD1(wb, 0, 1); PJ_LD1(xa, 1, 0); PJ_LD1(xb, 1, 1); PJ_FINAL(wa, 0, 0); PJ_FINAL(wb, 0, 1); PJ_FINAL(xa, 1, 0); PJ_FINAL(xb, 1, 1); }
#undef PJ_LD
#undef PJ_LD1
#undef PJ_RATIO
#undef PJ_FINAL
    }
};
struct EpiRes {
    static constexpr bool PERM = false, AFTER_DRAIN = false;
    const float *srcx, *srcc; float *dstx, *dstc; const float* gate0;
    __device__ __forceinline__ void operator()(const acc_t& acc, const pg8::Unit& u, int wr, int wc, int fr, int fq) const {
        const int b = u.pm / PPB, lp = u.pm % PPB, c0 = 256 * u.pn + 64 * wc + 8 * fq, r0 = wr * 64 + fr;
        const bool isc = (lp == PPB - 1);
        const size_t rb = isc ? (size_t)(b * LC) : (size_t)(b * T + lp * 256);
        const float* s = (isc ? srcc : srcx) + (rb + r0) * D + c0; float* d = (isc ? dstc : dstx) + (rb + r0) * D + c0;
        const float* gp = gate0 + (size_t)(isc ? 2 : b) * 6 * D + c0;
        f32x4 gv[2][2];
#pragma unroll
        for (int bj = 0; bj < 2; ++bj)
#pragma unroll
            for (int n = 0; n < 2; ++n) gv[bj][n] = *(const f32x4*)(gp + 32 * bj + 4 * n);
        f32x4 sa[4][2], sb[4][2];
#define RES_LD(buf, ai, bj) do { _Pragma("unroll") for (int m = 0; m < 4; ++m) _Pragma("unroll") for (int n = 0; n < 2; ++n) buf[m][n] = *(const f32x4*)(s + (size_t)((ai) * 128 + m * 16) * D + 32 * (bj) + 4 * n); } while (0)
#define RES_ST(buf, ai, bj) do { _Pragma("unroll") for (int m = 0; m < 4; ++m) _Pragma("unroll") for (int n = 0; n < 2; ++n) *(f32x4*)(d + (size_t)((ai) * 128 + m * 16) * D + 32 * (bj) + 4 * n) = buf[m][n] + gv[bj][n] * acc[ai][bj][m][n]; } while (0)
        RES_LD(sa, 0, 0); RES_LD(sb, 0, 1); RES_ST(sa, 0, 0); RES_LD(sa, 1, 0); RES_ST(sb, 0, 1); RES_LD(sb, 1, 1); RES_ST(sa, 1, 0); RES_ST(sb, 1, 1);
#undef RES_LD
#undef RES_ST
    }
};
__device__ __forceinline__ float dpp_up1(float cur, float prev) {
    const int old = __builtin_amdgcn_mov_dpp(__float_as_int(prev), 0x121  , 0xf, 0xf, false);
    return __int_as_float(__builtin_amdgcn_update_dpp(old, __float_as_int(cur), 0x111  , 0xf, 0xf, false));
}
__device__ __forceinline__ float dpp_dn1(float cur, float next) {
    const int old = __builtin_amdgcn_mov_dpp(__float_as_int(next), 0x12F  , 0xf, 0xf, false);
    return __int_as_float(__builtin_amdgcn_update_dpp(old, __float_as_int(cur), 0x101  , 0xf, 0xf, false));
}
struct EpiConv {
    static constexpr bool PERM = false, AFTER_DRAIN = false;
    bf16_t* g; float* raw; const float* cw; const float* cb;
    __device__ __forceinline__ void operator()(const acc_t& acc, const pg8::Unit& u, int wr, int wc, int fr, int fq) const {
        const int jc = 128 * u.pn + 32 * wc + 8 * fq, R0 = u.pm * 256 + wr * 64 + fr;
        u32x2 keep[2][4];
        f32x4 cwv[2][8];
#pragma unroll
        for (int n = 0; n < 2; ++n) { const int j = jc + 4 * n;
            cwv[n][0] = *(const f32x4*)(cw + j); cwv[n][1] = *(const f32x4*)(cw + NUP + j); cwv[n][2] = *(const f32x4*)(cw + 2 * NUP + j); cwv[n][3] = *(const f32x4*)(cb + j);
            cwv[n][4] = *(const f32x4*)(cw + DFF + j); cwv[n][5] = *(const f32x4*)(cw + NUP + DFF + j); cwv[n][6] = *(const f32x4*)(cw + 2 * NUP + DFF + j); cwv[n][7] = *(const f32x4*)(cb + DFF + j); }
        const float m0 = (fr == 0) ? 1.0f : 0.0f, m15 = (fr == 15) ? 1.0f : 0.0f;
#define FMAC_DPP(y, x, w, CTRL) asm("v_fmac_f32_dpp %0, %1, %2 " CTRL " row_mask:0xf bank_mask:0xf bound_ctrl:1" : "+v"(y) : "v"(x), "v"(w))
#pragma unroll
        for (int n = 0; n < 2; ++n) {
            const int j = jc + 4 * n;
            const f32x4 wg0 = cwv[n][0], wg1 = cwv[n][1], wg2 = cwv[n][2], bg = cwv[n][3];
            const f32x4 wu0 = cwv[n][4], wu1 = cwv[n][5], wu2 = cwv[n][6], bu = cwv[n][7];
            const f32x4 wg0e = wg0 * m0, wg2e = wg2 * m15, wu0e = wu0 * m0, wu2e = wu2 * m15;
#pragma unroll
            for (int ai = 0; ai < 2; ++ai)
#pragma unroll
                for (int m = 0; m < 4; ++m) {
                    const f32x4 xg = acc[ai][0][m][n], xu = acc[ai][1][m][n];
                    const f32x4 pg = acc[ai][0][m > 0 ? m - 1 : 0][n], ng = acc[ai][0][m < 3 ? m + 1 : 3][n], pu = acc[ai][1][m > 0 ? m - 1 : 0][n], nu = acc[ai][1][m < 3 ? m + 1 : 3][n];
                    f32x4 yg, yu;
#pragma unroll
                    for (int e = 0; e < 4; ++e) {
                        float g_ = wg1[e] * xg[e] + bg[e], u_ = wu1[e] * xu[e] + bu[e];
                        { const float a0 = xg[e], a1 = pg[e], a2 = ng[e], c0 = wg0[e], c1 = wg0e[e], c2 = wg2[e], c3 = wg2e[e];
                          FMAC_DPP(g_, a0, c0, "row_shr:1"); FMAC_DPP(g_, a1, c1, "row_mirror"); FMAC_DPP(g_, a0, c2, "row_shl:1"); FMAC_DPP(g_, a2, c3, "row_mirror"); }
                        { const float a0 = xu[e], a1 = pu[e], a2 = nu[e], c0 = wu0[e], c1 = wu0e[e], c2 = wu2[e], c3 = wu2e[e];
                          FMAC_DPP(u_, a0, c0, "row_shr:1"); FMAC_DPP(u_, a1, c1, "row_mirror"); FMAC_DPP(u_, a0, c2, "row_shl:1"); FMAC_DPP(u_, a2, c3, "row_mirror"); }
                        yg[e] = g_; yu[e] = u_;
                    }
                    f32x4 r;
#pragma unroll
                    for (int e = 0; e < 4; ++e) r[e] = siluf_(yg[e]) * yu[e];
                    u32x2 pk; pk.x = cvtpk(r[0], r[1]); pk.y = cvtpk(r[2], r[3]);
                    if (n == 0) keep[ai][m] = pk;
                    else { u32x4 w; w.x = keep[ai][m].x; w.y = keep[ai][m].y; w.z = pk.x; w.w = pk.y; *(u32x4*)(g + (size_t)(R0 + ai * 128 + m * 16) * DFF + jc) = w; }
                    if ((m == 0 && fr < 2) || (m == 3 && fr >= 14)) {
                        const int slot = (m == 0) ? fr : fr - 12; float* rp = raw + ((size_t)(u.pm * 4 + ai * 2 + wr) * 4 + slot) * NUP + j;
                        *(f32x4*)(rp) = xg; *(f32x4*)(rp + DFF) = xu;
                    }
                }
        }
#undef FMAC_DPP
    }
};

namespace att {
constexpr int KVBLK = 64;
constexpr int SHM_V = 64 * 128 * 2, SHM_K = 64 * 64 * 2;
#define KSWZ64(row, colB) ((row) * 128 + ((colB) ^ ((((row) >> 1) & 7) << 4)))
#define SBAR() __builtin_amdgcn_sched_barrier(0)
__device__ __forceinline__ int crow(int r, int hi) { return (r & 3) + 8 * (r >> 2) + 4 * hi; }
template <int SK = 0> __device__ __forceinline__ void exp16(f32x16& p) {
    if (SK & 1) return;
#pragma unroll
    for (int r = 0; r < 16; ++r) p[r] = __builtin_amdgcn_exp2f(p[r]);
}
template <int BASE> __device__ __forceinline__ void exp8(f32x16& p) {
    float e[8];
#pragma unroll
    for (int r = 0; r < 8; ++r) e[r] = __builtin_amdgcn_exp2f(p[BASE + r]);
    asm volatile("" : "+v"(e[0]), "+v"(e[1]), "+v"(e[2]), "+v"(e[3]), "+v"(e[4]), "+v"(e[5]), "+v"(e[6]), "+v"(e[7]));
#pragma unroll
    for (int r = 0; r < 8; ++r) p[BASE + r] = e[r];
}
template <int SK = 0> __device__ __forceinline__ void finishSM(f32x16& p0, f32x16& p1, float& lsum, bf16x8& pa0, bf16x8& pa1, bf16x8& pa2, bf16x8& pa3) {
    if (SK & 8) { lsum += p0[0] + p1[0]; const unsigned c_ = cvtpk(p0[1], p1[1]); u32x4 w_ = {c_, c_, c_, c_}; pa0 = pa1 = pa2 = pa3 = *reinterpret_cast<bf16x8*>(&w_); return; }
    float ps = 0;
#pragma unroll
    for (int r = 0; r < 16; ++r) ps += p0[r];
#pragma unroll
    for (int r = 0; r < 16; ++r) ps += p1[r];
    lsum += ps;
#define PK4(P, BASE, OUT) do { unsigned a0 = cvtpk(P[BASE + 0], P[BASE + 1]), a1 = cvtpk(P[BASE + 2], P[BASE + 3]);   \
    unsigned b0 = cvtpk(P[BASE + 4], P[BASE + 5]), b1 = cvtpk(P[BASE + 6], P[BASE + 7]);                              \
    auto r0 = __builtin_amdgcn_permlane32_swap(a0, b0, false, false); auto r1 = __builtin_amdgcn_permlane32_swap(a1, b1, false, false); \
    u32x4 w = {r0[0], r1[0], r0[1], r1[1]}; OUT = *reinterpret_cast<bf16x8*>(&w); } while (0)
    PK4(p0, 0, pa0); PK4(p0, 8, pa1); PK4(p1, 0, pa2); PK4(p1, 8, pa3);
#undef PK4
}
template <int SK = 0> __device__ __forceinline__ void qkt(f32x16& p0, f32x16& p1, const LAS char* Ks, const bf16x8* qr, int r32, int hi, float negM) {
#pragma unroll
    for (int r = 0; r < 16; ++r) { p0[r] = 0.f; p1[r] = 0.f; }
    if (SK & 4) return;
#pragma unroll
    for (int d0 = 0; d0 < 4; ++d0) { const int cb = (d0 * 16 + hi * 8) * 2;
        const bf16x8 b0 = *(const LAS bf16x8*)(Ks + KSWZ64(r32, cb));
        const bf16x8 b1 = *(const LAS bf16x8*)(Ks + KSWZ64(32 + r32, cb));
        p0 = __builtin_amdgcn_mfma_f32_32x32x16_bf16(b0, qr[d0], p0, 0, 0, 0);
        p1 = __builtin_amdgcn_mfma_f32_32x32x16_bf16(b1, qr[d0], p1, 0, 0, 0); }
}
__device__ __forceinline__ int v_st(int k, int c) { const int kk = (k & ~0xC) | ((k & 4) << 1) | ((k & 8) >> 1); return ((kk >> 3) * 4 + (c >> 5)) * 512 + ((kk & 7) * 32 + (c & 31)) * 2; }
__device__ __forceinline__ int v_rd_base(int lane) { return ((lane & 3) << 3) | (((lane >> 2) & 3) << 6) | (((lane >> 4) & 1) << 5) | (((lane >> 5) & 1) << 8); }
constexpr int v_rd_off(int d0, int ks, int half) { return d0 * 512 + ks * 4096 + half * 2048; }
template <int OFF> __device__ __forceinline__ s16x4 tr_read(int vb) {
  s16x4 r; asm volatile("ds_read_b64_tr_b16 %0, %1 offset:%2" : "=&v"(r) : "v"(vb), "i"(OFF) : "memory"); return r;
}
template <int D0> __device__ __forceinline__ void pv_one(f32x16& od, int vb, bf16x8 pa0, bf16x8 pa1, bf16x8 pa2, bf16x8 pa3) {
  const s16x4 l0 = tr_read<v_rd_off(D0, 0, 0)>(vb), h0 = tr_read<v_rd_off(D0, 0, 1)>(vb), l1 = tr_read<v_rd_off(D0, 1, 0)>(vb), h1 = tr_read<v_rd_off(D0, 1, 1)>(vb);
  const s16x4 l2 = tr_read<v_rd_off(D0, 2, 0)>(vb), h2 = tr_read<v_rd_off(D0, 2, 1)>(vb), l3 = tr_read<v_rd_off(D0, 3, 0)>(vb), h3 = tr_read<v_rd_off(D0, 3, 1)>(vb);
  asm volatile("s_waitcnt lgkmcnt(0)" ::: "memory"); SBAR();
#define PK(L, H) (bf16x8){L[0], L[1], L[2], L[3], H[0], H[1], H[2], H[3]}
  od = __builtin_amdgcn_mfma_f32_32x32x16_bf16(pa0, PK(l0, h0), od, 0, 0, 0);
  od = __builtin_amdgcn_mfma_f32_32x32x16_bf16(pa1, PK(l1, h1), od, 0, 0, 0);
  od = __builtin_amdgcn_mfma_f32_32x32x16_bf16(pa2, PK(l2, h2), od, 0, 0, 0);
  od = __builtin_amdgcn_mfma_f32_32x32x16_bf16(pa3, PK(l3, h3), od, 0, 0, 0);
#undef PK
}
template <int SK = 0> __device__ __forceinline__ void pv_d0(f32x16* o, int vb, bf16x8 pa0, bf16x8 pa1, bf16x8 pa2, bf16x8 pa3) {
  if (SK & 2) { o[0][0] += __builtin_bit_cast(float, (int)pa0[0] << 16); return; }
  pv_one<0>(o[0], vb, pa0, pa1, pa2, pa3); pv_one<1>(o[1], vb, pa0, pa1, pa2, pa3); pv_one<2>(o[2], vb, pa0, pa1, pa2, pa3); pv_one<3>(o[3], vb, pa0, pa1, pa2, pa3);
}
#define ATT_WAITL(n) asm volatile("s_waitcnt lgkmcnt(" #n ")" ::: "memory")
template <int D0> __device__ __forceinline__ void readv(s16x4 (&v)[8], int vb) {
  v[0] = tr_read<v_rd_off(D0, 0, 0)>(vb); v[1] = tr_read<v_rd_off(D0, 0, 1)>(vb); v[2] = tr_read<v_rd_off(D0, 1, 0)>(vb); v[3] = tr_read<v_rd_off(D0, 1, 1)>(vb);
  v[4] = tr_read<v_rd_off(D0, 2, 0)>(vb); v[5] = tr_read<v_rd_off(D0, 2, 1)>(vb); v[6] = tr_read<v_rd_off(D0, 3, 0)>(vb); v[7] = tr_read<v_rd_off(D0, 3, 1)>(vb);
}
__device__ __forceinline__ void pvm(f32x16& od, const s16x4 (&v)[8], bf16x8 pa0, bf16x8 pa1, bf16x8 pa2, bf16x8 pa3) {
#define PK(L, H) (bf16x8){L[0], L[1], L[2], L[3], H[0], H[1], H[2], H[3]}
  od = __builtin_amdgcn_mfma_f32_32x32x16_bf16(pa0, PK(v[0], v[1]), od, 0, 0, 0);
  od = __builtin_amdgcn_mfma_f32_32x32x16_bf16(pa1, PK(v[2], v[3]), od, 0, 0, 0);
  od = __builtin_amdgcn_mfma_f32_32x32x16_bf16(pa2, PK(v[4], v[5]), od, 0, 0, 0);
  od = __builtin_amdgcn_mfma_f32_32x32x16_bf16(pa3, PK(v[6], v[7]), od, 0, 0, 0);
#undef PK
}
template <int SK, bool HASNEXT> __device__ __forceinline__ void tile_step(f32x16& pN0, f32x16& pN1, f32x16 (&o)[4], const bf16x8 (&qr)[4], float& lsum,
                                                                         const LAS char* ksn, int vbc, float negM, int r32, int hi) {
  bf16x8 kf0[4], kf1[4], pa0, pa1, pa2, pa3; s16x4 va[8], vc[8], vd[8];
  if (HASNEXT && !(SK & 4)) {
#pragma unroll
    for (int d0 = 0; d0 < 4; ++d0) { const int cb = (d0 * 16 + hi * 8) * 2; kf0[d0] = *(const LAS bf16x8*)(ksn + KSWZ64(r32, cb)); kf1[d0] = *(const LAS bf16x8*)(ksn + KSWZ64(32 + r32, cb)); }
  }
  SBAR();
  finishSM<SK>(pN0, pN1, lsum, pa0, pa1, pa2, pa3);
  SBAR();
  if (SK & 2) { o[0][0] += __builtin_bit_cast(float, (int)pa0[0] << 16); }
  else { readv<0>(va, vbc); readv<1>(vc, vbc); }
  SBAR();
  if (HASNEXT) {
#pragma unroll
    for (int r = 0; r < 16; ++r) { pN0[r] = 0.f; pN1[r] = 0.f; }
    if (!(SK & 4)) {
      if (SK & 2) ATT_WAITL(0); else ATT_WAITL(15);
      SBAR();
#pragma unroll
      for (int d0 = 0; d0 < 4; ++d0) { pN0 = __builtin_amdgcn_mfma_f32_32x32x16_bf16(kf0[d0], qr[d0], pN0, 0, 0, 0); pN1 = __builtin_amdgcn_mfma_f32_32x32x16_bf16(kf1[d0], qr[d0], pN1, 0, 0, 0); }
    }
  }
  SBAR();
  if (!(SK & 2)) {
    readv<2>(vd, vbc); SBAR(); ATT_WAITL(15); SBAR(); pvm(o[0], va, pa0, pa1, pa2, pa3); if (HASNEXT && !(SK & 1)) exp8<0>(pN0); SBAR();
    readv<3>(va, vbc); SBAR(); ATT_WAITL(15); SBAR(); pvm(o[1], vc, pa0, pa1, pa2, pa3); if (HASNEXT && !(SK & 1)) exp8<8>(pN0); SBAR();
    ATT_WAITL(8); SBAR(); pvm(o[2], vd, pa0, pa1, pa2, pa3); if (HASNEXT && !(SK & 1)) exp8<0>(pN1); SBAR();
    ATT_WAITL(0); SBAR(); pvm(o[3], va, pa0, pa1, pa2, pa3); if (HASNEXT && !(SK & 1)) exp8<8>(pN1); SBAR();
  } else if (HASNEXT && !(SK & 1)) { exp8<0>(pN0); exp8<8>(pN0); exp8<0>(pN1); exp8<8>(pN1); }
}
constexpr int SLOT = SHM_K + SHM_V, NSLOT = 4;
#define ATT_WAITV(n) asm volatile("s_waitcnt vmcnt(" #n ")" ::: "memory")
template <int SK = 0> __device__ __forceinline__ void attn_unit(const bf16_t* __restrict__ Qb, const bf16_t* __restrict__ Kh, const bf16_t* __restrict__ Vh, bf16_t* Ob, bf16_t* oAb, int second, float lam, float post,
                                                                const float* __restrict__ subln, int nkeys, float negM, LAS char* lds) {
  int tid_ = threadIdx.x; asm volatile("" : "+v"(tid_));
  const int tid = tid_, wid = __builtin_amdgcn_readfirstlane(tid >> 6), lane = tid & 63, r32 = lane & 31, hi = lane >> 5;
  LAS float* li_l = (LAS float*)(lds + NSLOT * SLOT) + wid * 64;
  float lsum = 0; f32x16 o[4];
#pragma unroll
  for (int d = 0; d < 4; ++d)
#pragma unroll
    for (int r = 0; r < 16; ++r) o[d][r] = 0.f;
  bf16x8 qr[4];
  const bf16_t* Qw = Qb + (long)(wid * 32 + r32) * 64 + hi * 8;
#pragma unroll
  for (int d0 = 0; d0 < 4; ++d0) qr[d0] = *reinterpret_cast<const bf16x8*>(Qw + d0 * 16);
  unsigned offK, offV[2];
  { const int row = 8 * wid + (lane >> 3), ch = (lane & 7) ^ ((row >> 1) & 7); offK = (unsigned)(row * 64 + ch * 8); }
#pragma unroll
  for (int i = 0; i < 2; ++i) { const int piece = wid + 8 * i, sub = piece * 2 + (lane >> 5), kk = (sub >> 2) * 8 + ((lane & 31) >> 2), k = (kk & ~0xC) | ((kk & 4) << 1) | ((kk & 8) >> 1), c = (sub & 3) * 32 + 8 * (lane & 3);
      offV[i] = (unsigned)(k * 128 + c); }
  const int vbase = (int)(uintptr_t)lds + SHM_K + v_rd_base(lane);
#define ISSUE(t) do { const int s_ = (t) & (NSLOT - 1); const long k0_ = (long)(t) * KVBLK; \
    __builtin_amdgcn_global_load_lds((const unsigned*)(Kh + k0_ * 64 + offK), (LAS unsigned*)(lds + s_ * SLOT + wid * 1024), 16, 0, 0); \
    __builtin_amdgcn_global_load_lds((const unsigned*)(Vh + k0_ * 128 + offV[0]), (LAS unsigned*)(lds + s_ * SLOT + SHM_K + wid * 1024), 16, 0, 0); \
    __builtin_amdgcn_global_load_lds((const unsigned*)(Vh + k0_ * 128 + offV[1]), (LAS unsigned*)(lds + s_ * SLOT + SHM_K + 8192 + wid * 1024), 16, 0, 0); } while (0)
#define KS(t) (lds + ((t) & (NSLOT - 1)) * SLOT)
#define VB(t) (vbase + ((t) & (NSLOT - 1)) * SLOT)
  f32x16 pA0, pA1; const int NT = nkeys / KVBLK;
  if (wid >= 4) __builtin_amdgcn_s_setprio(1);
  ATT_WAITV(0);
  ISSUE(0); ISSUE(1); ISSUE(2);
  ATT_WAITV(6); __builtin_amdgcn_s_barrier(); asm volatile("" ::: "memory");
  qkt<SK>(pA0, pA1, KS(0), qr, r32, hi, negM); exp16<SK>(pA0); exp16<SK>(pA1);
  for (int j = 0; j + 2 < NT; ++j) {
    if (j + 2 < NT) ATT_WAITV(3); else ATT_WAITV(0);
    __builtin_amdgcn_s_barrier(); asm volatile("" ::: "memory");
    if (!(SK & 16) && j + 3 < NT) ISSUE(j + 3);
    tile_step<SK, true>(pA0, pA1, o, qr, lsum, KS(j + 1), VB(j), negM, r32, hi);
  }
  ATT_WAITV(0); __builtin_amdgcn_s_barrier(); asm volatile("" ::: "memory");
  tile_step<SK, true>(pA0, pA1, o, qr, lsum, KS(NT - 1), VB(NT - 2), negM, r32, hi);
  tile_step<SK, false>(pA0, pA1, o, qr, lsum, KS(NT - 1), VB(NT - 1), negM, r32, hi);
  { auto rr = __builtin_amdgcn_permlane32_swap(__float_as_uint(lsum), __float_as_uint(lsum), false, false); lsum = __uint_as_float(rr[0]) + __uint_as_float(rr[1]); }
  if (hi == 0) li_l[r32] = lsum; asm volatile("s_waitcnt lgkmcnt(0)" ::: "memory");
  float rli[16];
#pragma unroll
  for (int r = 0; r < 16; ++r) rli[r] = __builtin_amdgcn_rcpf(li_l[crow(r, hi)]);
  bf16_t* Ow = Ob + (long)(wid * 32) * 1024;
  if (!second) {
#pragma unroll
    for (int r = 0; r < 16; ++r) { const int orow = crow(r, hi);
#pragma unroll
      for (int d0 = 0; d0 < 4; ++d0) Ow[(long)orow * 1024 + d0 * 32 + r32] = (bf16_t)(cvtpk(o[d0][r] * rli[r], 0.f) & 0xffffu); }
  } else {
    float sl[4];
#pragma unroll
    for (int d0 = 0; d0 < 4; ++d0) sl[d0] = subln[d0 * 32 + r32];
    bf16_t* Aw = oAb + (long)(wid * 32) * 1024;
#pragma unroll
    for (int rg = 0; rg < 4; ++rg) {
      unsigned short o1[4][4];
#pragma unroll
      for (int j = 0; j < 4; ++j)
#pragma unroll
        for (int d0 = 0; d0 < 4; ++d0) o1[j][d0] = *(const unsigned short*)(Ow + (long)crow(4 * rg + j, hi) * 1024 + d0 * 32 + r32);
#pragma unroll
      for (int j = 0; j < 4; ++j) { const int r = 4 * rg + j; float dd[4], ss = 0.f;
#pragma unroll
        for (int d0 = 0; d0 < 4; ++d0) { dd[d0] = __uint_as_float((unsigned)o1[j][d0] << 16) - lam * (o[d0][r] * rli[r]); ss += dd[d0] * dd[d0]; }
        ss += __shfl_xor(ss, 1); ss += __shfl_xor(ss, 2); ss += __shfl_xor(ss, 4); ss += __shfl_xor(ss, 8); ss += __shfl_xor(ss, 16);
        const float rs = rsqrtf(ss * (1.0f / 128.0f) + EPS) * post; bf16_t* rowp = Aw + (long)crow(r, hi) * 1024;
#pragma unroll
        for (int d0 = 0; d0 < 4; ++d0) { const float y = dd[d0] * rs; rowp[d0 * 32 + r32] = (bf16_t)(cvtpk(y * sl[d0], 0.f) & 0xffffu); } }
    }
  }
  __builtin_amdgcn_s_setprio(0);
  __builtin_amdgcn_s_barrier(); asm volatile("" ::: "memory");
#undef ISSUE
#undef KS
#undef VB
#undef ITER
}
}

template <int SK = 0> __device__ __forceinline__ void attn_phase(Frame& F, int l) {
    const bf16_t* Q = WSP(bf16_t, DY_QKV); const bf16_t* K = Q + (size_t)MR * 1024; const bf16_t* V = K + (size_t)MR * 1024;
    bf16_t* O = WSP(bf16_t, DY_O1); bf16_t* oA = WSP(bf16_t, DY_OA); const float negM = 0.f;
    const float lam = WSP(float, WS_SCAL)[l]; const float post = 1.0f - (0.8f - 0.6f * expf(-0.3f * (float)l)); const float* subln = inp(F, I_SUBLN) + l * 128;
    const int NL = NB * 8 * 64, NU = NL + (l == 0 ? NB * 8 : 0);
    for (int i = 0; i * F.G < NU; ++i) {
        int u = i * F.G + F.bid;
        if (F.G == 256 && i < 4) { const int hh = i * 8 + (F.bid & 7); u = (hh >> 1) * 64 + (hh & 1) * 32 + (F.bid >> 3); }
        if (u >= NU) break;
        int p, q0, k0, nk;
        if (u < NL) { p = u / 64; q0 = (u % 64) * 256; k0 = 0; nk = TT; }
        else { p = u - NL; q0 = T; k0 = T; nk = LC; }
        const int b = p >> 3, h = p & 7;
        for (int sm = 0; sm < 2; ++sm) {
            const size_t hb = (size_t)(b * 16 + 2 * h + sm) * TT;
            att::attn_unit<SK>(Q + (hb + q0) * 64, K + (hb + k0) * 64, V + ((size_t)(b * 8 + h) * TT + k0) * 128, O + ((size_t)b * TT + q0) * 1024 + h * 128, oA + ((size_t)b * TT + q0) * 1024 + h * 128,
                               sm, lam, post, subln, nk, negM, (LAS char*)F.lds);
        }
    }
}
__device__ __forceinline__ void ffn_fixup(Frame& F, int l) {
    const float* raw = WSP(float, DY_RAW); bf16_t* g = WSP(bf16_t, DY_G);
    const float* cw = inp(F, I_CONVW) + (size_t)l * 3 * NUP; const float* cb = inp(F, I_CONVB) + (size_t)l * NUP;
    const int NBLK = MR / 64, per = DFF / 4;
    const size_t total = (size_t)NBLK * 2 * per;
    for (size_t it = (size_t)F.bid * NTHR + F.tid; it < total; it += (size_t)F.G * NTHR) {
        const int cq = (int)(it % per), rb = (int)(it / per), blk = rb >> 1, last = rb & 1, j = cq * 4;
        const int bl = blk % (TT / 64);
        const bool seq_first = (bl == 0 || bl == T / 64), seq_last = (bl == T / 64 - 1 || bl == TT / 64 - 1);
        const float* rc = raw + ((size_t)blk * 4 + (last ? 3 : 0)) * NUP;
        const float* rp = last ? raw + ((size_t)blk * 4 + 2) * NUP : raw + ((size_t)(blk - 1) * 4 + 3) * NUP;
        const float* rn = last ? raw + ((size_t)(blk + 1) * 4 + 0) * NUP : raw + ((size_t)blk * 4 + 1) * NUP;
        const bool zp = (!last && seq_first), zn = (last && seq_last);
        const f32x4 z4 = {0.f, 0.f, 0.f, 0.f};
        f32x4 v[14];
        { const float* rpp = zp ? rc : rp; const float* rnn = zn ? rc : rn;
          v[0] = *(const f32x4*)(rpp + j); v[1] = *(const f32x4*)(rpp + DFF + j); v[2] = *(const f32x4*)(rnn + j); v[3] = *(const f32x4*)(rnn + DFF + j);
          v[4] = *(const f32x4*)(rc + j); v[5] = *(const f32x4*)(rc + DFF + j);
          v[6] = *(const f32x4*)(cw + j); v[7] = *(const f32x4*)(cw + NUP + j); v[8] = *(const f32x4*)(cw + 2 * NUP + j); v[9] = *(const f32x4*)(cb + j);
          v[10] = *(const f32x4*)(cw + DFF + j); v[11] = *(const f32x4*)(cw + NUP + DFF + j); v[12] = *(const f32x4*)(cw + 2 * NUP + DFF + j); v[13] = *(const f32x4*)(cb + DFF + j); }
#pragma unroll
        for (int k = 0; k < 14; ++k) asm volatile("" : "+v"(v[k]));
        const f32x4 pg = zp ? z4 : v[0], pu = zp ? z4 : v[1], ng = zn ? z4 : v[2], nu = zn ? z4 : v[3], xg = v[4], xu = v[5];
        const f32x4 yg = v[6] * pg + v[7] * xg + v[8] * ng + v[9];
        const f32x4 yu = v[10] * pu + v[11] * xu + v[12] * nu + v[13];
        u32x2 w; w.x = cvtpk(siluf_(yg[0]) * yu[0], siluf_(yg[1]) * yu[1]); w.y = cvtpk(siluf_(yg[2]) * yu[2], siluf_(yg[3]) * yu[3]);
        *(u32x2*)(g + (size_t)(blk * 64 + (last ? 63 : 0)) * DFF + j) = w;
    }
}

namespace scn {
using att::crow; using att::v_st; using att::v_rd_base; using att::v_rd_off; using att::tr_read;
__device__ __forceinline__ int cp_of(int c, int dir) { return c == PPB - 1 ? 0 : (dir ? (PPB - 1) - c : c + 1); }
#define KSWZ256(row, colB) ((row) * 256 + ((colB) ^ (((row) & 7) << 4)))
#define PKF(L, H) (bf16x8){L[0], L[1], L[2], L[3], H[0], H[1], H[2], H[3]}
__device__ __forceinline__ u32x4 scale8(const u32x4 w, float s) { u32x4 o; o.x = cvtpk(bflo(w.x) * s, bfhi(w.x) * s); o.y = cvtpk(bflo(w.y) * s, bfhi(w.y) * s); o.z = cvtpk(bflo(w.z) * s, bfhi(w.z) * s); o.w = cvtpk(bflo(w.w) * s, bfhi(w.w) * s); return o; }
__device__ __forceinline__ float ret_lg2(int h, int dir) { const int hh = dir ? 3 - h : h; return log1pf(-exp2f(-5.0f - (float)hh)) * LOG2E; }
constexpr size_t RET_US_ELEMS = (size_t)128 * 256, HG_US_ELEMS = (size_t)128 * 128;
constexpr size_t US_RET_OFF = DY_US, US_HG_OFF = DY_US + 65 * MiB;
constexpr size_t HG_A_OFF = WS_MODP;

__device__ __forceinline__ void store_state_tile(bf16_t* us, const f32x16& a, int rb, int d0, int nd0, int c32, int hi) {
#pragma unroll
    for (int g = 0; g < 4; ++g) { const int ks = 2 * rb + (g >> 1), ln = c32 + 32 * (g & 1);
        u32x2 w; w.x = cvtpk_c(a[4 * g], a[4 * g + 1]); w.y = cvtpk_c(a[4 * g + 2], a[4 * g + 3]);
        *(u32x2*)(us + ((size_t)(ks * nd0 + d0) * 64 + ln) * 8 + 4 * hi) = w; }
}

template <int TILE, int KST> __device__ __forceinline__ void ra_step(f32x16 (&acc)[4][2], int vbK, const int (&vbV)[2]) {
    bf16x8 A[4], Bv[2];
    { const s16x4 lo = tr_read<TILE * 16384 + v_rd_off(0, KST, 0)>(vbK), h4 = tr_read<TILE * 16384 + v_rd_off(0, KST, 1)>(vbK); A[0] = PKF(lo, h4); }
    { const s16x4 lo = tr_read<TILE * 16384 + v_rd_off(1, KST, 0)>(vbK), h4 = tr_read<TILE * 16384 + v_rd_off(1, KST, 1)>(vbK); A[1] = PKF(lo, h4); }
    { const s16x4 lo = tr_read<TILE * 16384 + v_rd_off(2, KST, 0)>(vbK), h4 = tr_read<TILE * 16384 + v_rd_off(2, KST, 1)>(vbK); A[2] = PKF(lo, h4); }
    { const s16x4 lo = tr_read<TILE * 16384 + v_rd_off(3, KST, 0)>(vbK), h4 = tr_read<TILE * 16384 + v_rd_off(3, KST, 1)>(vbK); A[3] = PKF(lo, h4); }
    { const s16x4 lo = tr_read<TILE * 32768 + v_rd_off(0, KST, 0)>(vbV[0]), h4 = tr_read<TILE * 32768 + v_rd_off(0, KST, 1)>(vbV[0]); Bv[0] = PKF(lo, h4); }
    { const s16x4 lo = tr_read<TILE * 32768 + v_rd_off(0, KST, 0)>(vbV[1]), h4 = tr_read<TILE * 32768 + v_rd_off(0, KST, 1)>(vbV[1]); Bv[1] = PKF(lo, h4); }
    asm volatile("s_waitcnt lgkmcnt(0)" ::: "memory"); __builtin_amdgcn_sched_barrier(0);
#pragma unroll
    for (int rb = 0; rb < 4; ++rb)
#pragma unroll
        for (int cb = 0; cb < 2; ++cb) acc[rb][cb] = __builtin_amdgcn_mfma_f32_32x32x16_bf16(A[rb], Bv[cb], acc[rb][cb], 0, 0, 0);
}
__device__ __forceinline__ void ret_local_unit(Frame& F, int b, int h, int c) {
    const bf16_t* RK = WSP(bf16_t, DY_PB) + (size_t)MR * 512; const bf16_t* RV = RK + (size_t)MR * 512;
    const size_t hb = (size_t)(b * 4 + h) * TT + (size_t)c * 256;
    const float lgf = ret_lg2(h, 0), lgb = ret_lg2(h, 1);
    const int w = F.wave, lane = F.lane, c32 = lane & 31, hi = lane >> 5, dir = w >> 2, dvq = w & 3;
    LAS char* lds = (LAS char*)F.lds;
    f32x16 acc[4][2];
#pragma unroll
    for (int rb = 0; rb < 4; ++rb)
#pragma unroll
        for (int cb = 0; cb < 2; ++cb)
#pragma unroll
            for (int r = 0; r < 16; ++r) acc[rb][cb][r] = 0.f;
    const int vbK = (int)(uintptr_t)lds + dir * 32768 + v_rd_base(lane);
    int vbV[2];
#pragma unroll
    for (int cb = 0; cb < 2; ++cb) { const int colblk = 2 * dvq + cb; vbV[cb] = (int)(uintptr_t)lds + 65536 + (colblk >> 2) * 16384 + (colblk & 3) * 512 + v_rd_base(lane); }
    for (int hh = 0; hh < 2; ++hh) {
        __syncthreads();
        u32x4 kq[4];
#pragma unroll
        for (int i = 0; i < 4; ++i) { const int idx = i * NTHR + F.tid, row = idx >> 4, ch = idx & 15, p = 128 * hh + row; kq[i] = *(const u32x4*)(RK + (hb + p) * 128 + ch * 8); }
#pragma unroll
        for (int i = 0; i < 4; ++i) asm volatile("" : "+v"(kq[i]));
#pragma unroll
        for (int i = 0; i < 4; ++i) { const int idx = i * NTHR + F.tid, row = idx >> 4, ch = idx & 15, p = 128 * hh + row;
            const u32x4 kv = kq[i];
            const float ff = __builtin_amdgcn_exp2f(lgf * (float)(255 - p)), fb = __builtin_amdgcn_exp2f(lgb * (float)p);
            const int off = (row >> 6) * 16384 + v_st(row & 63, ch * 8);
            *(LAS u32x4*)(lds + off) = scale8(kv, ff); *(LAS u32x4*)(lds + 32768 + off) = scale8(kv, fb); }
        { u32x4 vq[8];
#pragma unroll
          for (int i = 0; i < 8; ++i) { const int idx = i * NTHR + F.tid, row = idx >> 5, col = (idx & 31) * 8, p = 128 * hh + row; vq[i] = *(const u32x4*)(RV + (hb + p) * 256 + col); }
#pragma unroll
          for (int i = 0; i < 8; ++i) asm volatile("" : "+v"(vq[i]));
#pragma unroll
          for (int i = 0; i < 8; ++i) { const int idx = i * NTHR + F.tid, row = idx >> 5, col = (idx & 31) * 8;
            *(LAS u32x4*)(lds + 65536 + ((row >> 6) * 2 + (col >> 7)) * 16384 + v_st(row & 63, col & 127)) = vq[i]; } }
        __syncthreads();
        ra_step<0, 0>(acc, vbK, vbV); ra_step<0, 1>(acc, vbK, vbV); ra_step<0, 2>(acc, vbK, vbV); ra_step<0, 3>(acc, vbK, vbV);
        ra_step<1, 0>(acc, vbK, vbV); ra_step<1, 1>(acc, vbK, vbV); ra_step<1, 2>(acc, vbK, vbV); ra_step<1, 3>(acc, vbK, vbV);
    }
    bf16_t* us = (bf16_t*)(F.ws + US_RET_OFF) + ((size_t)((b * 4 + h) * 2 + dir) * PPB + cp_of(c, dir)) * RET_US_ELEMS;
#pragma unroll
    for (int rb = 0; rb < 4; ++rb)
#pragma unroll
        for (int cb = 0; cb < 2; ++cb) store_state_tile(us, acc[rb][cb], rb, 2 * dvq + cb, 8, c32, hi);
}

__device__ __forceinline__ void scan_states(Frame& F, bool do_ret, bool do_hg) {
  for (int gt = F.bid * NTHR + F.tid; gt < 131072; gt += F.G * NTHR) {
    if (gt < 65536) {
        if (!do_ret) continue;
        const int seq = gt >> 12, vec = gt & 4095, dir = seq & 1, h = (seq >> 1) & 3;
        const float g = exp2f(ret_lg2(h, dir) * 256.0f);
        u32x4* p = (u32x4*)(F.ws + US_RET_OFF) + (size_t)seq * PPB * 4096 + vec;
        float S[8];
#pragma unroll
        for (int e = 0; e < 8; ++e) S[e] = 0.f;
        for (int cp0 = 0; cp0 < PPB; cp0 += 13) {
            u32x4 ub[13];
#pragma unroll
            for (int k = 0; k < 13; ++k) ub[k] = p[(size_t)(cp0 + k) * 4096];
#pragma unroll
            for (int k = 0; k < 13; ++k) { const u32x4 u = ub[k];
                u32x4 o; o.x = cvtpk(S[0], S[1]); o.y = cvtpk(S[2], S[3]); o.z = cvtpk(S[4], S[5]); o.w = cvtpk(S[6], S[7]); p[(size_t)(cp0 + k) * 4096] = o;
                S[0] = g * S[0] + bflo(u.x); S[1] = g * S[1] + bfhi(u.x); S[2] = g * S[2] + bflo(u.y); S[3] = g * S[3] + bfhi(u.y);
                S[4] = g * S[4] + bflo(u.z); S[5] = g * S[5] + bfhi(u.z); S[6] = g * S[6] + bflo(u.w); S[7] = g * S[7] + bfhi(u.w); } }
    } else {
        if (!do_hg) continue;
        const int gv = gt - 65536, seq = gv >> 11, vec = gv & 2047;
        const int ks = vec >> 8, hi = (vec >> 5) & 1, dk0 = 16 * ks + 8 * hi;
        u32x4* p = (u32x4*)(F.ws + US_HG_OFF) + (size_t)seq * PPB * 2048 + vec;
        const f32x4* ap = (const f32x4*)((const float*)(F.ws + HG_A_OFF) + (size_t)seq * PPB * 128 + dk0);
        float S[8];
#pragma unroll
        for (int e = 0; e < 8; ++e) S[e] = 0.f;
        for (int cp0 = 0; cp0 < PPB; cp0 += 5) {
            u32x4 ub[5]; f32x4 a0b[5], a1b[5];
#pragma unroll
            for (int k = 0; k < 5; ++k) { ub[k] = p[(size_t)(cp0 + k) * 2048]; a0b[k] = ap[(cp0 + k) * 32]; a1b[k] = ap[(cp0 + k) * 32 + 1]; }
#pragma unroll
            for (int k = 0; k < 5; ++k) { const u32x4 u = ub[k]; const f32x4 a0 = a0b[k], a1 = a1b[k];
                u32x4 o; o.x = cvtpk(S[0], S[1]); o.y = cvtpk(S[2], S[3]); o.z = cvtpk(S[4], S[5]); o.w = cvtpk(S[6], S[7]); p[(size_t)(cp0 + k) * 2048] = o;
                S[0] = a0[0] * S[0] + bflo(u.x); S[1] = a0[1] * S[1] + bfhi(u.x); S[2] = a0[2] * S[2] + bflo(u.y); S[3] = a0[3] * S[3] + bfhi(u.y);
                S[4] = a1[0] * S[4] + bflo(u.z); S[5] = a1[1] * S[5] + bfhi(u.z); S[6] = a1[2] * S[6] + bflo(u.w); S[7] = a1[3] * S[7] + bfhi(u.w); } }
    }
  }
}

__device__ __forceinline__ void ret_out_unit(Frame& F, int l, int b, int h, int c) {
    const bf16_t* RQ = WSP(bf16_t, DY_PB); const bf16_t* RK = RQ + (size_t)MR * 512; const bf16_t* RV = RK + (size_t)MR * 512;
    const size_t hb = (size_t)(b * 4 + h) * TT + (size_t)c * 256;
    const float lgf = ret_lg2(h, 0), lgb = ret_lg2(h, 1);
    const int w = F.wave, lane = F.lane, r32 = lane & 31, hi = lane >> 5, irow = 32 * w + r32;
    LAS char* lds = (LAS char*)F.lds;
    bf16x8 qr[8];
#pragma unroll
    for (int d0 = 0; d0 < 8; ++d0) qr[d0] = *(const bf16x8*)(RQ + (hb + irow) * 128 + d0 * 16 + hi * 8);
    const int vb = (int)(uintptr_t)lds + 16384 + v_rd_base(lane);
    unsigned okk[2], ovv[2];
#pragma unroll
    for (int i = 0; i < 2; ++i) { const int P = w + 8 * i, row = 4 * P + (lane >> 4), ch = (lane & 15) ^ (row & 7); okk[i] = (unsigned)(row * 128 + ch * 8);
        const int sub = P * 2 + (lane >> 5), kk = (sub >> 2) * 8 + ((lane & 31) >> 2), k = (kk & ~0xC) | ((kk & 4) << 1) | ((kk & 8) >> 1), c = (sub & 3) * 32 + 8 * (lane & 3); ovv[i] = (unsigned)(k * 256 + c); }
    float ssq[16]; LAS unsigned* keep = (LAS unsigned*)(lds + 65536 + w * 8192) + lane;
#pragma unroll
    for (int r = 0; r < 16; ++r) ssq[r] = 0.f;
    f32x16 o[4];
#pragma unroll 1
    for (int half = 0; half < 2; ++half) {
#pragma unroll
        for (int d = 0; d < 4; ++d)
#pragma unroll
            for (int r = 0; r < 16; ++r) o[d][r] = 0.f;
#define RSC_ISSUE(J_, buf_) do { const size_t kb_ = (hb + 64 * (J_)) * 128, vbs_ = (hb + 64 * (J_)) * 256 + half * 128; \
            __builtin_amdgcn_global_load_lds((const unsigned*)(RK + kb_ + okk[0]), (LAS unsigned*)(lds + (buf_) * 32768 + w * 1024), 16, 0, 0); \
            __builtin_amdgcn_global_load_lds((const unsigned*)(RK + kb_ + okk[1]), (LAS unsigned*)(lds + (buf_) * 32768 + (w + 8) * 1024), 16, 0, 0); \
            __builtin_amdgcn_global_load_lds((const unsigned*)(RV + vbs_ + ovv[0]), (LAS unsigned*)(lds + (buf_) * 32768 + 16384 + w * 1024), 16, 0, 0); \
            __builtin_amdgcn_global_load_lds((const unsigned*)(RV + vbs_ + ovv[1]), (LAS unsigned*)(lds + (buf_) * 32768 + 16384 + (w + 8) * 1024), 16, 0, 0); } while (0)
        asm volatile("s_waitcnt vmcnt(0)" ::: "memory");
        RSC_ISSUE(0, 0);
#pragma unroll 1
        for (int J = 0; J < 4; ++J) {
            const int buf = J & 1;
            asm volatile("s_waitcnt lgkmcnt(0)" ::: "memory"); __builtin_amdgcn_s_barrier(); asm volatile("" ::: "memory");
            if (J < 3) { RSC_ISSUE(J + 1, buf ^ 1); asm volatile("s_waitcnt vmcnt(4)" ::: "memory"); } else asm volatile("s_waitcnt vmcnt(0)" ::: "memory");
            __builtin_amdgcn_s_barrier(); asm volatile("" ::: "memory");
            LAS char* kb = lds + buf * 32768; const int vbj = vb + buf * 32768;
            f32x16 p0, p1;
#pragma unroll
            for (int r = 0; r < 16; ++r) { p0[r] = 0.f; p1[r] = 0.f; }
#pragma unroll
            for (int d0 = 0; d0 < 8; ++d0) { const int cb = (d0 * 16 + hi * 8) * 2;
                const bf16x8 b0 = *(const LAS bf16x8*)(kb + KSWZ256(r32, cb)), b1 = *(const LAS bf16x8*)(kb + KSWZ256(32 + r32, cb));
                p0 = __builtin_amdgcn_mfma_f32_32x32x16_bf16(b0, qr[d0], p0, 0, 0, 0); p1 = __builtin_amdgcn_mfma_f32_32x32x16_bf16(b1, qr[d0], p1, 0, 0, 0); }
#pragma unroll
            for (int r = 0; r < 16; ++r) { const int d0i = irow - (64 * J + crow(r, hi)), d1i = d0i - 32;
                const float e0 = d0i >= 0 ? lgf * (float)d0i : -lgb * (float)d0i, e1 = d1i >= 0 ? lgf * (float)d1i : -lgb * (float)d1i;
                float m0 = __builtin_amdgcn_exp2f(e0), m1 = __builtin_amdgcn_exp2f(e1); if (d0i == 0) m0 = 2.0f; if (d1i == 0) m1 = 2.0f;
                p0[r] *= m0; p1[r] *= m1; }
            bf16x8 pa0, pa1, pa2, pa3;
#define PK4(P, BASE, OUT) do { unsigned a0 = cvtpk(P[BASE + 0], P[BASE + 1]), a1 = cvtpk(P[BASE + 2], P[BASE + 3]);   \
    unsigned b0_ = cvtpk(P[BASE + 4], P[BASE + 5]), b1_ = cvtpk(P[BASE + 6], P[BASE + 7]);                              \
    auto r0 = __builtin_amdgcn_permlane32_swap(a0, b0_, false, false); auto r1 = __builtin_amdgcn_permlane32_swap(a1, b1_, false, false); \
    u32x4 w_ = {r0[0], r1[0], r0[1], r1[1]}; OUT = *reinterpret_cast<bf16x8*>(&w_); } while (0)
            PK4(p0, 0, pa0); PK4(p0, 8, pa1); PK4(p1, 0, pa2); PK4(p1, 8, pa3);
            att::pv_d0(o, vbj, pa0, pa1, pa2, pa3);
        }
#undef RSC_ISSUE
#pragma unroll 1
        for (int dir = 0; dir < 2; ++dir) {
            const float sc = dir ? __builtin_amdgcn_exp2f(lgb * (float)(256 - irow)) : __builtin_amdgcn_exp2f(lgf * (float)(irow + 1));
            const bf16_t* us = (const bf16_t*)(F.ws + US_RET_OFF) + ((size_t)((b * 4 + h) * 2 + dir) * PPB + cp_of(c, dir)) * RET_US_ELEMS;
            __syncthreads();
#pragma unroll
            for (int i = 0; i < 4; ++i) { const int idx = i * NTHR + F.tid, fr_ = idx >> 6, ln = idx & 63, ks = fr_ >> 2, d0 = fr_ & 3;
                *(LAS u32x4*)(lds + 32768 + idx * 16) = *(const u32x4*)(us + ((size_t)(ks * 8 + half * 4 + d0) * 64 + ln) * 8); }
            __syncthreads();
#pragma unroll
            for (int ks = 0; ks < 8; ++ks) { const u32x4 qs = scale8(*reinterpret_cast<const u32x4*>(&qr[ks]), sc); const bf16x8 qa = *reinterpret_cast<const bf16x8*>(&qs);
#pragma unroll
                for (int d0 = 0; d0 < 4; ++d0) { const bf16x8 sf = *(const LAS bf16x8*)(lds + 32768 + ((ks * 4 + d0) * 64 + lane) * 16);
                    o[d0] = __builtin_amdgcn_mfma_f32_32x32x16_bf16(qa, sf, o[d0], 0, 0, 0); } }
        }
#pragma unroll
        for (int d0 = 0; d0 < 4; ++d0)
#pragma unroll
            for (int r = 0; r < 16; ++r) ssq[r] += o[d0][r] * o[d0][r];
        if (half == 0) {
#pragma unroll
            for (int d0 = 0; d0 < 4; ++d0)
#pragma unroll
                for (int r = 0; r < 8; ++r) keep[(d0 * 8 + r) * 64] = cvtpk_c(o[d0][2 * r], o[d0][2 * r + 1]);
        }
    }
    const float* rn = inp(F, I_RNORM) + l * 256;
    bf16_t* ob = WSP(bf16_t, DY_OB) + ((size_t)b * TT + (size_t)c * 256 + 32 * w) * 1024 + h * 256 + r32;
    float wn[8];
#pragma unroll
    for (int j = 0; j < 8; ++j) wn[j] = rn[32 * j + r32];
#pragma unroll
    for (int r = 0; r < 16; ++r) { float s = ssq[r];
        s += __shfl_xor(s, 1); s += __shfl_xor(s, 2); s += __shfl_xor(s, 4); s += __shfl_xor(s, 8); s += __shfl_xor(s, 16);
        const float rs = rsqrtf(s * (1.0f / 256.0f) + EPS); bf16_t* rowp = ob + (size_t)crow(r, hi) * 1024;
#pragma unroll
        for (int d0 = 0; d0 < 4; ++d0) { const unsigned pw = keep[(d0 * 8 + (r >> 1)) * 64]; const float v0 = (r & 1) ? bfhi(pw) : bflo(pw);
            rowp[32 * d0] = (bf16_t)(cvtpk(v0 * rs * wn[d0], 0.f) & 0xffffu);
            rowp[128 + 32 * d0] = (bf16_t)(cvtpk(o[d0][r] * rs * wn[4 + d0], 0.f) & 0xffffu); } }
    __syncthreads();
#undef PK4
}
}


namespace hgm {
using att::crow; using att::v_st; using att::v_rd_base; using att::v_rd_off; using att::tr_read;
constexpr int TTAB_OFF = RING_BYTES + 1024;
__device__ __forceinline__ float dpp_shr0(float v, int) { return v; }
template <int CTRL> __device__ __forceinline__ float dppz(float v) { return __int_as_float(__builtin_amdgcn_update_dpp(0, __float_as_int(v), CTRL, 0xf, 0xf, true)); }
template <bool REV> __device__ __forceinline__ void scan32x8(float (&v)[8], int lane, float (&tot)[8]) {
#pragma unroll
    for (int e = 0; e < 8; ++e) v[e] += REV ? dppz<0x101>(v[e]) : dppz<0x111>(v[e]);
#pragma unroll
    for (int e = 0; e < 8; ++e) v[e] += REV ? dppz<0x102>(v[e]) : dppz<0x112>(v[e]);
#pragma unroll
    for (int e = 0; e < 8; ++e) v[e] += REV ? dppz<0x104>(v[e]) : dppz<0x114>(v[e]);
#pragma unroll
    for (int e = 0; e < 8; ++e) v[e] += REV ? dppz<0x108>(v[e]) : dppz<0x118>(v[e]);
    const bool up = (lane & 32) != 0, addrow = REV ? ((lane & 16) == 0) : ((lane & 16) != 0);
    float cr[8];
#pragma unroll
    for (int e = 0; e < 8; ++e) { const float t0 = __int_as_float(__builtin_amdgcn_readlane(__float_as_int(v[e]), REV ? 16 : 15)), t1 = __int_as_float(__builtin_amdgcn_readlane(__float_as_int(v[e]), REV ? 48 : 47)); cr[e] = up ? t1 : t0; }
#pragma unroll
    for (int e = 0; e < 8; ++e) v[e] += addrow ? cr[e] : 0.f;
#pragma unroll
    for (int e = 0; e < 8; ++e) { const float t0 = __int_as_float(__builtin_amdgcn_readlane(__float_as_int(v[e]), REV ? 0 : 31)), t1 = __int_as_float(__builtin_amdgcn_readlane(__float_as_int(v[e]), REV ? 32 : 63)); tot[e] = up ? t1 : t0; }
}
constexpr int LBT_OFF = TTAB_OFF + 4096 + 4608;
template <bool REV, int LAYOUT> __device__ __forceinline__ void prep(const bf16_t* zrow, const LAS float* lbl, int lane, LAS float* ttab_w, float (&E)[64], LAS char* lds, int row) {
    const int hi = lane >> 5;
    u32x4 zw[8];
#pragma unroll
    for (int d0 = 0; d0 < 8; ++d0) zw[d0] = *(const u32x4*)(zrow + 16 * d0);
#pragma unroll
    for (int d0 = 0; d0 < 8; ++d0) {
        const f32x4 l0 = *(const LAS f32x4*)(lbl + 16 * d0), l1 = *(const LAS f32x4*)(lbl + 16 * d0 + 4);
        const float z[8] = {bflo(zw[d0].x), bfhi(zw[d0].x), bflo(zw[d0].y), bfhi(zw[d0].y), bflo(zw[d0].z), bfhi(zw[d0].z), bflo(zw[d0].w), bfhi(zw[d0].w)};
        const float lb[8] = {l0[0], l0[1], l0[2], l0[3], l1[0], l1[1], l1[2], l1[3]};
        float kk[8], Bv[8], tot[8];
#pragma unroll
        for (int e = 0; e < 8; ++e) { const float sg = sigmoidf_(z[e]); const float f = fmaxf(lb[e] + (1.0f - lb[e]) * sg, 1e-20f); Bv[e] = __builtin_amdgcn_logf(f); kk[e] = (1.0f - lb[e]) * (1.0f - sg); }
        scan32x8<REV>(Bv, lane, tot);
        float kv[8];
#pragma unroll
        for (int e = 0; e < 8; ++e) { const float ee = Bv[e] - tot[e]; E[d0 * 8 + e] = ee; kv[e] = kk[e] * __builtin_amdgcn_exp2f(-ee); }
        if ((lane & 31) == 0) { *(LAS f32x4*)(ttab_w + 16 * d0 + 8 * hi) = (f32x4){tot[0], tot[1], tot[2], tot[3]}; *(LAS f32x4*)(ttab_w + 16 * d0 + 8 * hi + 4) = (f32x4){tot[4], tot[5], tot[6], tot[7]}; }
        u32x4 kh; kh.x = cvtpk(kv[0], kv[1]); kh.y = cvtpk(kv[2], kv[3]); kh.z = cvtpk(kv[4], kv[5]); kh.w = cvtpk(kv[6], kv[7]);
        if (LAYOUT == 0) *(LAS u32x4*)(lds + KSWZ256(row, (16 * d0 + 8 * hi) * 2)) = kh;
        else *(LAS u32x4*)(lds + (row >> 6) * 16384 + v_st(row & 63, 16 * d0 + 8 * hi)) = kh;
        __builtin_amdgcn_sched_barrier(0);
    }
}
__device__ __forceinline__ u32x4 qscale(const u32x4 q, const float* Ek) {
    u32x4 o; o.x = cvtpk(bflo(q.x) * __builtin_amdgcn_exp2f(Ek[0]), bfhi(q.x) * __builtin_amdgcn_exp2f(Ek[1])); o.y = cvtpk(bflo(q.y) * __builtin_amdgcn_exp2f(Ek[2]), bfhi(q.y) * __builtin_amdgcn_exp2f(Ek[3]));
    o.z = cvtpk(bflo(q.z) * __builtin_amdgcn_exp2f(Ek[4]), bfhi(q.z) * __builtin_amdgcn_exp2f(Ek[5])); o.w = cvtpk(bflo(q.w) * __builtin_amdgcn_exp2f(Ek[6]), bfhi(q.w) * __builtin_amdgcn_exp2f(Ek[7])); return o;
}
#define HG_PK4(P, BASE, OUT) do { unsigned a0 = cvtpk_c(P[BASE + 0], P[BASE + 1]), a1 = cvtpk_c(P[BASE + 2], P[BASE + 3]);     \
    unsigned b0_ = cvtpk_c(P[BASE + 4], P[BASE + 5]), b1_ = cvtpk_c(P[BASE + 6], P[BASE + 7]);                              \
    auto r0 = __builtin_amdgcn_permlane32_swap(a0, b0_, false, false); auto r1 = __builtin_amdgcn_permlane32_swap(a1, b1_, false, false); \
    u32x4 w_ = {r0[0], r1[0], r0[1], r1[1]}; OUT = *reinterpret_cast<bf16x8*>(&w_); } while (0)
template <int D0> __device__ __forceinline__ void pv32(f32x16& od, int vb, bf16x8 pa0, bf16x8 pa1) {
    const s16x4 l0 = tr_read<v_rd_off(D0, 0, 0)>(vb), h0 = tr_read<v_rd_off(D0, 0, 1)>(vb), l1 = tr_read<v_rd_off(D0, 1, 0)>(vb), h1 = tr_read<v_rd_off(D0, 1, 1)>(vb);
    asm volatile("s_waitcnt lgkmcnt(0)" ::: "memory"); __builtin_amdgcn_sched_barrier(0);
    od = __builtin_amdgcn_mfma_f32_32x32x16_bf16(pa0, (bf16x8){l0[0], l0[1], l0[2], l0[3], h0[0], h0[1], h0[2], h0[3]}, od, 0, 0, 0);
    od = __builtin_amdgcn_mfma_f32_32x32x16_bf16(pa1, (bf16x8){l1[0], l1[1], l1[2], l1[3], h1[0], h1[1], h1[2], h1[3]}, od, 0, 0, 0);
}

constexpr int PTAB_OFF = TTAB_OFF + 4096;
__device__ __forceinline__ u32x4 qfac(u32x4 Q, const LAS float* ca, const LAS float* cb, bool sub) {
    asm volatile("" : "+v"(Q.x), "+v"(Q.y), "+v"(Q.z), "+v"(Q.w));
    f32x4 a0 = *(const LAS f32x4*)(ca), a1 = *(const LAS f32x4*)(ca + 4);
    if (sub) { a0 -= *(const LAS f32x4*)(cb); a1 -= *(const LAS f32x4*)(cb + 4); }
    u32x4 o; o.x = cvtpk(bflo(Q.x) * __builtin_amdgcn_exp2f(a0[0]), bfhi(Q.x) * __builtin_amdgcn_exp2f(a0[1])); o.y = cvtpk(bflo(Q.y) * __builtin_amdgcn_exp2f(a0[2]), bfhi(Q.y) * __builtin_amdgcn_exp2f(a0[3]));
    o.z = cvtpk(bflo(Q.z) * __builtin_amdgcn_exp2f(a1[0]), bfhi(Q.z) * __builtin_amdgcn_exp2f(a1[1])); o.w = cvtpk(bflo(Q.w) * __builtin_amdgcn_exp2f(a1[2]), bfhi(Q.w) * __builtin_amdgcn_exp2f(a1[3])); return o;
}
constexpr int FTAB_OFF = LBT_OFF + 1024;
__device__ __forceinline__ u32x4 qmul(u32x4 Q, const LAS float* f) {
    asm volatile("" : "+v"(Q.x), "+v"(Q.y), "+v"(Q.z), "+v"(Q.w));
    const f32x4 a0 = *(const LAS f32x4*)(f), a1 = *(const LAS f32x4*)(f + 4);
    u32x4 o; o.x = cvtpk(bflo(Q.x) * a0[0], bfhi(Q.x) * a0[1]); o.y = cvtpk(bflo(Q.y) * a0[2], bfhi(Q.y) * a0[3]);
    o.z = cvtpk(bflo(Q.z) * a1[0], bfhi(Q.z) * a1[1]); o.w = cvtpk(bflo(Q.w) * a1[2], bfhi(Q.w) * a1[3]); return o;
}
template <bool REV, int SK = 0> __device__ __forceinline__ void out_dir(Frame& F, int l, int b, int h, int c, f32x16 (&o)[4]) {
    const int w = F.wave, lane = F.lane, r32 = lane & 31, hi = lane >> 5, dir = REV ? 1 : 0;
    LAS char* lds = (LAS char*)F.lds; LAS float* ttab = (LAS float*)(lds + TTAB_OFF); LAS float* ptab = (LAS float*)(lds + PTAB_OFF);
    const size_t rowoff = ((size_t)(b * 8 + h) * TT + (size_t)c * 256 + 32 * w + r32) * 128 + 8 * hi;
    const bf16_t* Z = WSP(bf16_t, DY_PC) + (size_t)(1 + dir) * MR * 1024 + rowoff; const bf16_t* GQ = WSP(bf16_t, DY_PC) + rowoff;
    LAS float* lbt = (LAS float*)(lds + LBT_OFF) + dir * 128;
    __syncthreads();
    u32x4 Qp[8];
    { float E[64];
      prep<REV, 0>(Z, lbt + 8 * hi, lane, ttab + w * 128, E, lds, 32 * w + r32);
#pragma unroll
      for (int d0 = 0; d0 < 8; ++d0) Qp[d0] = *(const u32x4*)(GQ + 16 * d0);
#pragma unroll
      for (int d0 = 0; d0 < 8; ++d0) asm volatile("" : "+v"(Qp[d0]));
#pragma unroll
      for (int d0 = 0; d0 < 8; ++d0) Qp[d0] = qscale(Qp[d0], &E[d0 * 8]); }
    __syncthreads();
    if (F.tid < 128) { float s = 0.f;
#pragma unroll
        for (int pi = 0; pi < 8; ++pi) { ptab[pi * 128 + F.tid] = s; s += ttab[(REV ? 7 - pi : pi) * 128 + F.tid]; }
        ptab[8 * 128 + F.tid] = s; }
    __syncthreads();
    const int vbase = (int)(uintptr_t)lds + 65536 + v_rd_base(lane);
    const int piw = REV ? 7 - w : w; const LAS float* cw = ptab + (piw + 1) * 128 + 8 * hi; LAS float* ftab = (LAS float*)(lds + FTAB_OFF) + w * 128;
    for (int pi = (SK & 1) ? -1 : piw; pi >= 0; --pi) {
        const int J = REV ? 7 - pi : pi; const LAS float* cj = ptab + (pi + 1) * 128 + 8 * hi;
        { const LAS float* pw = ptab + (piw + 1) * 128, *pj = ptab + (pi + 1) * 128;
          ftab[lane] = __builtin_amdgcn_exp2f(pw[lane] - pj[lane]); ftab[lane + 64] = __builtin_amdgcn_exp2f(pw[lane + 64] - pj[lane + 64]); }
        asm volatile("s_waitcnt lgkmcnt(0)" ::: "memory");
        f32x16 p;
#pragma unroll
        for (int r = 0; r < 16; ++r) p[r] = 0.f;
#pragma unroll
        for (int d0 = 0; d0 < 8; ++d0) { const u32x4 qt = qmul(Qp[d0], ftab + 8 * hi + 16 * d0); const bf16x8 a = *(const LAS bf16x8*)(lds + KSWZ256(32 * J + r32, (16 * d0 + 8 * hi) * 2));
            p = __builtin_amdgcn_mfma_f32_32x32x16_bf16(a, *reinterpret_cast<const bf16x8*>(&qt), p, 0, 0, 0);
            if (d0 & 1) __builtin_amdgcn_sched_barrier(0); }
        if (pi == piw) {
#pragma unroll
            for (int r = 0; r < 16; ++r) { const int jj = crow(r, hi); const bool keep = REV ? (jj >= r32) : (jj <= r32); p[r] = keep ? p[r] : 0.f; } }
        bf16x8 pa0, pa1; HG_PK4(p, 0, pa0); HG_PK4(p, 8, pa1);
        const int vb = vbase + (J >> 1) * 16384 + (J & 1) * 8192;
        pv32<0>(o[0], vb, pa0, pa1); pv32<1>(o[1], vb, pa0, pa1); pv32<2>(o[2], vb, pa0, pa1); pv32<3>(o[3], vb, pa0, pa1);
    }
    const bf16_t* us = (const bf16_t*)(F.ws + scn::US_HG_OFF) + ((size_t)((b * 8 + h) * 2 + dir) * PPB + scn::cp_of(c, dir)) * scn::HG_US_ELEMS + (size_t)lane * 8;
    if (!(SK & 2)) {
        bf16x8 sfa[2][4], sfb[2][4];
#define HG_SLD(buf, kq) do { _Pragma("unroll") for (int k2 = 0; k2 < 2; ++k2) _Pragma("unroll") for (int d0 = 0; d0 < 4; ++d0) buf[k2][d0] = *(const bf16x8*)(us + (size_t)((2 * (kq) + k2) * 4 + d0) * 512); } while (0)
#define HG_SMM(buf, kq) do { _Pragma("unroll") for (int k2 = 0; k2 < 2; ++k2) { const u32x4 qe = qfac(Qp[2 * (kq) + k2], cw + 16 * (2 * (kq) + k2), cw, false);                                  \
            _Pragma("unroll") for (int d0 = 0; d0 < 4; ++d0) o[d0] = __builtin_amdgcn_mfma_f32_32x32x16_bf16(*reinterpret_cast<const bf16x8*>(&qe), buf[k2][d0], o[d0], 0, 0, 0); } } while (0)
        HG_SLD(sfa, 0); HG_SLD(sfb, 1); __builtin_amdgcn_sched_barrier(0);
        HG_SMM(sfa, 0); __builtin_amdgcn_sched_barrier(0); HG_SLD(sfa, 2); __builtin_amdgcn_sched_barrier(0);
        HG_SMM(sfb, 1); __builtin_amdgcn_sched_barrier(0); HG_SLD(sfb, 3); __builtin_amdgcn_sched_barrier(0);
        HG_SMM(sfa, 2); __builtin_amdgcn_sched_barrier(0); HG_SMM(sfb, 3); __builtin_amdgcn_sched_barrier(0);
#undef HG_SLD
#undef HG_SMM
    }
    __syncthreads();
}
template <int SK = 0> __device__ __forceinline__ void out_unit(Frame& F, int l, int b, int h, int c) {
    const int w = F.wave, lane = F.lane, r32 = lane & 31, hi = lane >> 5;
    LAS char* lds = (LAS char*)F.lds;
    const size_t rowoff = ((size_t)(b * 8 + h) * TT + (size_t)c * 256 + 32 * w + r32) * 128 + 8 * hi;
    const bf16_t* GI = WSP(bf16_t, DY_PC) + (size_t)3 * MR * 1024 + rowoff;
    { u32x4 gv[8];
#pragma unroll
      for (int d0 = 0; d0 < 8; ++d0) gv[d0] = *(const u32x4*)(GI + 16 * d0);
      float lbv = 0.f; if (F.tid < 256) lbv = WSP(float, WS_LB)[l * 2048 + (F.tid >> 7) * 1024 + h * 128 + (F.tid & 127)];
#pragma unroll
      for (int d0 = 0; d0 < 8; ++d0) asm volatile("" : "+v"(gv[d0]));
      if (F.tid < 256) ((LAS float*)(lds + LBT_OFF))[F.tid] = lbv;
#pragma unroll
      for (int d0 = 0; d0 < 8; ++d0) { const int row = 32 * w + r32; *(LAS u32x4*)(lds + 65536 + (row >> 6) * 16384 + v_st(row & 63, 16 * d0 + 8 * hi)) = gv[d0]; } }
    f32x16 o[4];
#pragma unroll
    for (int d = 0; d < 4; ++d)
#pragma unroll
        for (int r = 0; r < 16; ++r) o[d][r] = 0.f;
    out_dir<false, SK>(F, l, b, h, c, o);
    if (!(SK & 4)) out_dir<true, SK>(F, l, b, h, c, o);
    const float* gn = inp(F, I_GNORM) + l * 128;
    bf16_t* oc = WSP(bf16_t, DY_OC) + ((size_t)b * TT + (size_t)c * 256 + 32 * w) * 1024 + h * 128 + r32;
    float wn[4];
#pragma unroll
    for (int j = 0; j < 4; ++j) wn[j] = gn[32 * j + r32];
#pragma unroll
    for (int r = 0; r < 16; ++r) { float s = 0.f;
#pragma unroll
        for (int d0 = 0; d0 < 4; ++d0) s += o[d0][r] * o[d0][r];
        s += __shfl_xor(s, 1); s += __shfl_xor(s, 2); s += __shfl_xor(s, 4); s += __shfl_xor(s, 8); s += __shfl_xor(s, 16);
        const float rs = rsqrtf(s * (1.0f / 128.0f) + EPS); bf16_t* rowp = oc + (size_t)crow(r, hi) * 1024;
#pragma unroll
        for (int d0 = 0; d0 < 4; ++d0) rowp[32 * d0] = (bf16_t)(cvtpk(o[d0][r] * rs * wn[d0], 0.f) & 0xffffu); }
}

template <bool REV> __device__ __forceinline__ void local_dir(Frame& F, int l, int b, int h, int c) {
    const int w = F.wave, lane = F.lane, r32 = lane & 31, hi = lane >> 5, dir = REV ? 1 : 0, rb = w >> 1, cb0 = 2 * (w & 1);
    LAS char* lds = (LAS char*)F.lds; LAS float* ttab = (LAS float*)(lds + TTAB_OFF);
    const bf16_t* Z = WSP(bf16_t, DY_PC) + (size_t)(1 + dir) * MR * 1024 + ((size_t)(b * 8 + h) * TT + (size_t)c * 256 + 32 * w + r32) * 128 + 8 * hi;
    LAS float* lbt = (LAS float*)(lds + LBT_OFF) + dir * 128;
    __syncthreads();
    { float E[64]; prep<REV, 1>(Z, lbt + 8 * hi, lane, ttab + w * 128, E, lds, 32 * w + r32); }
    __syncthreads();
    f32x16 acc[2];
#pragma unroll
    for (int cb = 0; cb < 2; ++cb)
#pragma unroll
        for (int r = 0; r < 16; ++r) acc[cb][r] = 0.f;
    const int vbK0 = (int)(uintptr_t)lds + rb * 512 + v_rd_base(lane), vbV0 = (int)(uintptr_t)lds + 65536 + cb0 * 512 + v_rd_base(lane);
    for (int i = 0; i < 8; ++i) { const int blk = REV ? 7 - i : i;
        if (i > 0) { const LAS float* tb = ttab + blk * 128 + 32 * rb + 4 * hi;
#pragma unroll
            for (int g = 0; g < 4; ++g) { const f32x4 t = *(const LAS f32x4*)(tb + 8 * g);
#pragma unroll
                for (int j = 0; j < 4; ++j) { const float s = __builtin_amdgcn_exp2f(t[j]); acc[0][4 * g + j] *= s; acc[1][4 * g + j] *= s; } } }
        const int off = (blk >> 1) * 16384 + (blk & 1) * 8192; const int vk = vbK0 + off, vv = vbV0 + off;
#define HL_STEP(KS2) { const s16x4 al = tr_read<v_rd_off(0, KS2, 0)>(vk), ah = tr_read<v_rd_off(0, KS2, 1)>(vk), b0l = tr_read<v_rd_off(0, KS2, 0)>(vv), b0h = tr_read<v_rd_off(0, KS2, 1)>(vv), \
            b1l = tr_read<v_rd_off(1, KS2, 0)>(vv), b1h = tr_read<v_rd_off(1, KS2, 1)>(vv); \
            asm volatile("s_waitcnt lgkmcnt(0)" ::: "memory"); __builtin_amdgcn_sched_barrier(0); \
            const bf16x8 A_ = {al[0], al[1], al[2], al[3], ah[0], ah[1], ah[2], ah[3]}; \
            acc[0] = __builtin_amdgcn_mfma_f32_32x32x16_bf16(A_, (bf16x8){b0l[0], b0l[1], b0l[2], b0l[3], b0h[0], b0h[1], b0h[2], b0h[3]}, acc[0], 0, 0, 0); \
            acc[1] = __builtin_amdgcn_mfma_f32_32x32x16_bf16(A_, (bf16x8){b1l[0], b1l[1], b1l[2], b1l[3], b1h[0], b1h[1], b1h[2], b1h[3]}, acc[1], 0, 0, 0); }
        HL_STEP(0) HL_STEP(1)
#undef HL_STEP
    }
    const size_t slot = (size_t)((b * 8 + h) * 2 + dir) * PPB + scn::cp_of(c, dir);
    bf16_t* us = (bf16_t*)(F.ws + scn::US_HG_OFF) + slot * scn::HG_US_ELEMS;
    scn::store_state_tile(us, acc[0], rb, cb0, 4, r32, hi); scn::store_state_tile(us, acc[1], rb, cb0 + 1, 4, r32, hi);
    if (F.tid < 128) { float s = 0.f;
#pragma unroll
        for (int k = 0; k < 8; ++k) s += ttab[k * 128 + F.tid];
        ((float*)(F.ws + scn::HG_A_OFF))[slot * 128 + F.tid] = __builtin_amdgcn_exp2f(s); }
    __syncthreads();
}
__device__ __forceinline__ void local_unit(Frame& F, int l, int b, int h, int c) {
    const int w = F.wave, lane = F.lane, r32 = lane & 31, hi = lane >> 5;
    LAS char* lds = (LAS char*)F.lds;
    const bf16_t* GI = WSP(bf16_t, DY_PC) + (size_t)3 * MR * 1024 + ((size_t)(b * 8 + h) * TT + (size_t)c * 256 + 32 * w + r32) * 128 + 8 * hi;
    { u32x4 gv[8];
#pragma unroll
      for (int d0 = 0; d0 < 8; ++d0) gv[d0] = *(const u32x4*)(GI + 16 * d0);
      float lbv = 0.f; if (F.tid < 256) lbv = WSP(float, WS_LB)[l * 2048 + (F.tid >> 7) * 1024 + h * 128 + (F.tid & 127)];
#pragma unroll
      for (int d0 = 0; d0 < 8; ++d0) asm volatile("" : "+v"(gv[d0]));
      if (F.tid < 256) ((LAS float*)(lds + LBT_OFF))[F.tid] = lbv;
#pragma unroll
      for (int d0 = 0; d0 < 8; ++d0) { const int row = 32 * w + r32; *(LAS u32x4*)(lds + 65536 + (row >> 6) * 16384 + v_st(row & 63, 16 * d0 + 8 * hi)) = gv[d0]; } }
    local_dir<false>(F, l, b, h, c);
    local_dir<true>(F, l, b, h, c);
}
}

__device__ __forceinline__ void sa_phase(Frame& F, int l) {
    for (int u = F.bid; u < NB * 4 * PPB; u += F.G) { const int c = u % PPB, h = (u / PPB) & 3, b = u / (PPB * 4); scn::ret_local_unit(F, b, h, c); __syncthreads(); }
    frame_refresh(F);
    for (int u = F.G - 1 - F.bid; u < NB * 8 * PPB; u += F.G) { const int c = u % PPB, h = (u / PPB) & 7, b = u / (PPB * 8); hgm::local_unit(F, l, b, h, c); }
}
__device__ __forceinline__ void sc_phase(Frame& F, int l) {
    const int NC = (l == 1) ? PPB - 1 : PPB;
    for (int u = F.bid; u < NB * 4 * NC; u += F.G) { const int c = u % NC, h = (u / NC) & 3, b = u / (NC * 4); scn::ret_out_unit(F, l, b, h, c); }
    frame_refresh(F);
#ifndef HG_PROBE
#define HG_PROBE -1
#endif
    if (HG_PROBE >= 0) { for (int u = F.G - 1 - F.bid; u < NB * 8 * NC; u += F.G) { const int c = u % NC, h = (u / NC) & 7, b = u / (NC * 8); hgm::out_unit<(HG_PROBE < 0 ? 0 : HG_PROBE)>(F, l, b, h, c); } frame_refresh(F); }
    for (int u = F.G - 1 - F.bid; u < NB * 8 * NC; u += F.G) { const int c = u % NC, h = (u / NC) & 7, b = u / (NC * 8); hgm::out_unit<0>(F, l, b, h, c); }
}

#ifndef RET_MFMA
#define RET_MFMA 1
#endif
enum { PH_PRO = 0, PH_MODFIN, PH_N1, PH_GA, PH_ATT, PH_GB, PH_SA, PH_SB, PH_SC, PH_OG, PH_MG, PH_WO, PH_N2, PH_UP, PH_FIX, PH_DN, PH_COUNT };

struct PanelOrder : pg8::StaticOrder {
    int skip;
    __device__ __forceinline__ bool next(int i, pg8::Unit& u) const { const bool ok = pg8::StaticOrder::next(i, u); if (ok && skip) u.pm += (u.pm >= PPB - 1) ? 1 : 0; return ok; }
};
struct ProjOrder : PanelOrder {
    __device__ __forceinline__ bool next(int i, pg8::Unit& u) const { const int r = i / 3, n = i - 3 * r; const bool ok = PanelOrder::next(r, u); if (ok) { u.pm += n * NPAN; u.pn += 8 * n; } return ok; }    __device__ __forceinline__ bool keep(int i) const { return (i % 3) != 2; }
};
template <class Epi> __device__ __forceinline__ void run_gemm(Frame& F, const bf16_t* A, const bf16_t* Bt, int N, int K, const Epi& E, bool skipctx = false) {
    pg8::Gemm g{A, Bt, MR, N, K}; PanelOrder S; S.init(skipctx ? MR - 512 : MR, N, F.G, F.bid); S.skip = skipctx ? 1 : 0; if (N == 2048 || N == 8192) S.wgm = 4;
    pg8::gemm_phase<Epi, PanelOrder, false>(F.lds, g, S, E, nullptr);
}
__device__ __forceinline__ EpiIn make_epi_in(Frame& F, int l, int pt0) {
    EpiIn E; E.pt0 = pt0;
    E.rq = WSP(bf16_t, DY_QKV); E.r2 = WSP(bf16_t, DY_PB); E.r1 = WSP(bf16_t, DY_PC);
    E.qkn = inp(F, I_QKN) + l * 128; E.ropeA = WSP(f32x2, WS_ROPEA); E.ropeB = WSP(f32x2, WS_ROPEB);
    return E;
}
__device__ __forceinline__ EpiRes make_epi_res(Frame& F, int l, int use_inputs, int gidx) {
    EpiRes E; E.srcx = use_inputs ? inp(F, I_X) : outp(F); E.srcc = use_inputs ? inp(F, I_CTX) : WSP(float, WS_XC); E.dstx = outp(F); E.dstc = WSP(float, WS_XC);
    E.gate0 = WSP(float, WS_MODV) + ((size_t)(l * 3) * 6 + gidx) * D; return E;
}

template <int PH> __device__ __forceinline__ void run_phase(Frame& F, int l) {
    frame_refresh(F);
    const bf16_t* h = WSP(bf16_t, WS_H); const bf16_t* wt = WSP(bf16_t, WS_WT);
    const bf16_t* wt_in = wt + WT_IN / 2;
    if constexpr (PH == PH_PRO) { p0_mod_partial(F); p0_tables(F); convert_weights(F, 0); }
    if constexpr (PH == PH_MODFIN) { p1_mod_final(F); }
    if constexpr (PH == PH_N1) { if (l == 1) convert_weights(F, 1); norm_phase(F, l, 0); }
    if constexpr (PH == PH_GA) { const EpiIn E = make_epi_in(F, l, PT_DQ); run_gemm(F, h, wt_in, 9216, D, E); }
#ifndef ATT_PROBE
#define ATT_PROBE -1
#endif
    if constexpr (PH == PH_ATT) { if (ATT_PROBE >= 0) { attn_phase<(ATT_PROBE < 0 ? 0 : ATT_PROBE)>(F, l); __syncthreads(); } attn_phase<0>(F, l); }
    if constexpr (PH == PH_GB) { }
    if constexpr (PH == PH_SA) { sa_phase(F, l); }
    if constexpr (PH == PH_SB) { scn::scan_states(F, true, true); }
    if constexpr (PH == PH_SC) { sc_phase(F, l); }
    if constexpr (PH == PH_OG) { EpiGates E; E.oB = WSP(bf16_t, DY_OB); E.oC = WSP(bf16_t, DY_OC); E.G = WSP(bf16_t, DY_MG); E.bias = inp(F, I_BGATE) + (size_t)l * 3 * D;
        run_gemm(F, h, wt_in + (size_t)PT_RG * 256 * D, 8192, D, E, l == 1); }
    if constexpr (PH == PH_MG) {
        EpiProjAll E{WSP(bf16_t, DY_MG), WSP(bf16_t, DY_YO)};
        pg8::Gemm g{WSP(bf16_t, DY_OA), wt + WT_BR / 2, MR, 2048, 1024}; ProjOrder S; const bool sk = (l == 1); S.init(sk ? MR - 512 : MR, 2048, F.G, F.bid); S.skip = sk ? 1 : 0; S.wgm = 4;
        pg8::gemm_phase<EpiProjAll, ProjOrder, false>(F.lds, g, S, E, nullptr);
    }
    if constexpr (PH == PH_WO) { const EpiRes E = make_epi_res(F, l, l == 0, 2); run_gemm(F, WSP(bf16_t, DY_YO), wt + WT_OUT / 2, 2048, D, E, l == 1); }
    if constexpr (PH == PH_N2) { norm_phase(F, l, 1); }
    if constexpr (PH == PH_UP) { EpiConv E; E.g = WSP(bf16_t, DY_G); E.raw = WSP(float, DY_RAW); E.cw = inp(F, I_CONVW) + (size_t)l * 3 * NUP; E.cb = inp(F, I_CONVB) + (size_t)l * NUP;
        run_gemm(F, h, wt + WT_UP / 2, NUP, D, E, l == 1); }
    if constexpr (PH == PH_FIX) { ffn_fixup(F, l); }
    if constexpr (PH == PH_DN) { const EpiRes E = make_epi_res(F, l, 0, 5); run_gemm(F, WSP(bf16_t, DY_G), wt + WT_DOWN / 2, 2048, DFF, E, l == 1); }
}

__device__ __forceinline__ void frame_init(Frame& F, const Args& a, unsigned char* lds) {
    F.lds = (LAS unsigned char*)lds; F.a = &a; F.G = gridDim.x; F.bid = blockIdx.x; frame_refresh(F);
}
template <int PH> __global__ void __launch_bounds__(NTHR, 2) k_phase(Args a) {
    extern __shared__ __attribute__((aligned(16))) unsigned char lds[];
    Frame F; frame_init(F, a, lds);
    run_phase<PH>(F, a.layer);
}
#ifndef MK_SINGLE
#define MK_SINGLE 1
#endif
__global__ void __launch_bounds__(NTHR, 2) k_all(Args a) {
    extern __shared__ __attribute__((aligned(16))) unsigned char lds[];
    Frame F; frame_init(F, a, lds);
    for (int u = F.tid; u < (LDS_BYTES - LDSCTL_OFF) / 4; u += NTHR) ((LAS unsigned*)(F.lds + LDSCTL_OFF))[u] = 0u;
    __syncthreads();
    (void)xcd_barrier_post((unsigned*)(a.ws + WS_CTL) + CW_BAR, (volatile LAS unsigned*)(F.lds + MISC_OFF + 32));
#define GRID_BAR() do { XcdBarrier b_; unsigned* bp_ = (unsigned*)(a.ws + WS_CTL) + CW_BAR; asm volatile("" : "+s"(bp_)); b_.bar = bp_; b_.x = xb_xcc_id(); \
        b_.st = (volatile LAS unsigned*)(F.lds + MISC_OFF + 32); xcd_barrier(b_); } while (0)
#ifndef PROBE_MASK
#define PROBE_MASK 0
#endif
#ifndef PROBE_T
#define PROBE_T 0
#endif
    unsigned long long pt0 = 0, pt1 = 0, pc0 = 0, pc1 = 0;
#define TSTART(ph, l_) do { if (PROBE_T && (ph) == PROBE_T - 1 && (l_) == 0) { pt0 = __builtin_amdgcn_s_memrealtime(); pc0 = (unsigned long long)clock64(); } } while (0)
#define TSTOP(ph, l_)  do { if (PROBE_T && (ph) == PROBE_T - 1 && (l_) == 0) { pt1 = __builtin_amdgcn_s_memrealtime(); pc1 = (unsigned long long)clock64(); } } while (0)
#define RUN(ph, l_, grp) do { TSTART(ph, l_); run_phase<ph>(F, l_); GRID_BAR(); TSTOP(ph, l_); if ((PROBE_MASK >> (grp)) & 1) { run_phase<ph>(F, l_); GRID_BAR(); } } while (0)
    RUN(PH_PRO, 0, 0); RUN(PH_MODFIN, 0, 0);
#pragma unroll 1
    for (int l = 0; l < 2; ++l) {
        RUN(PH_N1, l, 0);
        RUN(PH_GA, l, 1);
        RUN(PH_ATT, l, 2);
        RUN(PH_SA, l, 3);
        run_phase<PH_SB>(F, l); GRID_BAR();
        RUN(PH_SC, l, 4);
        run_phase<PH_OG>(F, l); GRID_BAR();
        RUN(PH_MG, l, 5);
        run_phase<PH_WO>(F, l); GRID_BAR();
        RUN(PH_N2, l, 0);
        RUN(PH_UP, l, 6);
        RUN(PH_FIX, l, 0);
        run_phase<PH_DN>(F, l); GRID_BAR();
    }
#undef RUN
    if (PROBE_T) {
        float* slot = (float*)(F.ws + WS_SCAL) + 64;
        if (F.bid == 0 && threadIdx.x == 0) { const float mhz = (float)(pc1 - pc0) / ((float)(pt1 - pt0) * 0.01f); *slot = floorf(mhz / 50.0f) * 50.0f; }
        GRID_BAR();
        const float v = *slot;
        for (size_t i = (size_t)F.bid * NTHR + threadIdx.x; i < (size_t)NB * T * D; i += (size_t)F.G * NTHR) a.out[i] = v;
    }
#undef GRID_BAR
}
__global__ void k_fill(float* out, size_t n, float v) { for (size_t i = (size_t)blockIdx.x * blockDim.x + threadIdx.x; i < n; i += (size_t)gridDim.x * blockDim.x) out[i] = v; }

template <int PH> static void launch_phase(const Args& a0, int layer, int grid, hipStream_t stream) {
    static bool attr = false;
    if (!attr) { if (hipFuncSetAttribute((const void*)k_phase<PH>, hipFuncAttributeMaxDynamicSharedMemorySize, LDS_BYTES) != hipSuccess) fprintf(stderr, "kernel_launch: hipFuncSetAttribute failed for phase %d\n", PH); attr = true; }
    Args a = a0; a.layer = layer;
    hipLaunchKernelGGL(k_phase<PH>, dim3(grid), dim3(NTHR), LDS_BYTES, stream, a);
    const hipError_t e = hipPeekAtLastError(); if (e != hipSuccess) fprintf(stderr, "kernel_launch: phase %d launch failed: %s\n", PH, hipGetErrorName(e));
}
extern "C" void kernel_launch(void* const* d_in, const int* in_sizes, int n_in, void* d_out, int out_size, void* d_ws, size_t ws_size, hipStream_t stream) {
    static int grid = 0;
    if (grid == 0) { int dev = 0, cus = 0; if (hipGetDevice(&dev) != hipSuccess || hipDeviceGetAttribute(&cus, hipDeviceAttributeMultiprocessorCount, dev) != hipSuccess || cus < 1) cus = 256; grid = cus; }
    if (n_in != N_INPUTS || out_size != NB * T * D || ws_size < WS_END) {
        fprintf(stderr, "kernel_launch: unexpected shapes: n_in %d out %d ws %zu (need %zu)\n", n_in, out_size, ws_size, (size_t)WS_END);
        hipLaunchKernelGGL(k_fill, dim3(1024), dim3(256), 0, stream, (float*)d_out, (size_t)out_size, (float)(ws_size >> 20));
        return;
    }
    Args a{};
    for (int i = 0; i < N_INPUTS; ++i) a.in[i] = (const float*)d_in[i];
    a.out = (float*)d_out; a.ws = (unsigned char*)d_ws; a.layer = 0; a.ph_lo = 0; a.ph_hi = 0; a.pad = 0;
#if MK_SINGLE
    {
        static bool attr = false;
        if (!attr) { if (hipFuncSetAttribute((const void*)k_all, hipFuncAttributeMaxDynamicSharedMemorySize, LDS_BYTES) != hipSuccess) fprintf(stderr, "kernel_launch: hipFuncSetAttribute failed\n");
            int per_cu = 0; if (hipOccupancyMaxActiveBlocksPerMultiprocessor(&per_cu, (const void*)k_all, NTHR, LDS_BYTES) != hipSuccess || per_cu < 1) fprintf(stderr, "kernel_launch: occupancy query says %d blocks per CU\n", per_cu);
            (void)hipGetLastError(); attr = true; }
        if (hipMemsetAsync((char*)d_ws + WS_CTL, 0, CTL_ZERO_BYTES, stream) != hipSuccess) { fprintf(stderr, "kernel_launch: memset failed\n"); return; }
        hipLaunchKernelGGL(k_all, dim3(grid), dim3(NTHR), LDS_BYTES, stream, a);
        const hipError_t e = hipPeekAtLastError(); if (e != hipSuccess) fprintf(stderr, "kernel_launch: launch failed: %s\n", hipGetErrorName(e));
        return;
    }
#endif
    launch_phase<PH_PRO>(a, 0, grid, stream);
    launch_phase<PH_MODFIN>(a, 0, grid, stream);
    for (int l = 0; l < 2; ++l) {
        launch_phase<PH_N1>(a, l, grid, stream); launch_phase<PH_GA>(a, l, grid, stream); launch_phase<PH_ATT>(a, l, grid, stream); launch_phase<PH_GB>(a, l, grid, stream);
        launch_phase<PH_SA>(a, l, grid, stream); launch_phase<PH_SB>(a, l, grid, stream); launch_phase<PH_SC>(a, l, grid, stream);
        launch_phase<PH_OG>(a, l, grid, stream); launch_phase<PH_MG>(a, l, grid, stream);
        launch_phase<PH_WO>(a, l, grid, stream); launch_phase<PH_N2>(a, l, grid, stream); launch_phase<PH_UP>(a, l, grid, stream); launch_phase<PH_FIX>(a, l, grid, stream);
        launch_phase<PH_DN>(a, l, grid, stream);
    }
}
```

```cpp
#include <hip/hip_runtime.h>
#include <cstdio>
#include <cstdint>
namespace pg8 {
#define PG8_LAS __attribute__((address_space(3)))
typedef unsigned short bf16_t;
typedef short bf16x8 __attribute__((ext_vector_type(8)));
typedef float f32x4 __attribute__((ext_vector_type(4)));
typedef unsigned u32x4 __attribute__((ext_vector_type(4)));
constexpr int BM = 256, BK = 64, HALF = 128, HTB = HALF * BK * 2  , STAGE_BYTES = 8 * HTB, NXCD = 8, WGM = 8;

__host__ __device__ __forceinline__ int lds_byte(int r, int c) { const int st = (r >> 4) * 2 + (c >> 5), rr = r & 15, cc = c & 31, ob = rr * 64 + cc * 2; return st * 1024 + (ob ^ (((ob >> 9) & 1) << 5)); }
__host__ __device__ __forceinline__ void stage_rc(int b, int& R, int& C) { const int st = b / 1024, sb = b % 1024, swz = sb ^ (((sb >> 9) & 1) << 5); R = (st >> 1) * 16 + swz / 64; C = (st & 1) * 32 + (swz % 64) / 2; }
__host__ __device__ __forceinline__ int perm32(int rho) { const int n = rho >> 4, i = rho & 15; return 8 * (i >> 2) + 4 * n + (i & 3); }

struct Unit { int pm, pn; };
struct Gemm { const bf16_t* A; const bf16_t* Bt; int M, N, K; };

struct StaticOrder {
    int nM, nN, nwg, G, c, wgm;
    __host__ __device__ void init(int M, int N, int G_, int c_) { nM = M / BM; nN = N / BM; nwg = nM * nN; G = G_; c = c_; wgm = WGM; }
    __host__ __device__ bool next(int i, Unit& u) const {
        const long L = (long)i * G + c; if (L >= nwg) return false;
        int wgid = (int)L; { const int q = nwg / NXCD, r = nwg % NXCD, xcd = wgid % NXCD, off = wgid / NXCD; wgid = (xcd < r ? xcd * (q + 1) : r * (q + 1) + (xcd - r) * q) + off; }
        const int nig = wgm * nN, gid = wgid / nig, fm = gid * wgm, gsz = (nM - fm) < wgm ? (nM - fm) : wgm;
        u.pm = fm + ((wgid % nig) % gsz); u.pn = (wgid % nig) / gsz; return true;
    }
    __device__ __forceinline__ void a_ready(const Unit&) const {}
    __device__ __forceinline__ void done(const Unit&) const {}
};
template <int NN, int WG> struct TileOrder {
    int nM, G;
    __host__ __device__ void init(int M, int, int G_, int) { nM = M / BM; G = G_; }
    __device__ __forceinline__ bool next(int i, Unit& u) const {
        const int nwg = nM * NN; const long L = (long)i * G + (int)blockIdx.x; if (L >= nwg) return false;
        constexpr int gsz = WG * NN; const int share = ((nwg / NXCD) / gsz) * gsz;
        int wgid = (int)L; if (wgid < NXCD * share) wgid = (wgid % NXCD) * share + wgid / NXCD;
        const int gid = wgid / gsz, fm = gid * WG, gh = (nM - fm) < WG ? (nM - fm) : WG, in = wgid - gid * gsz;
        u.pm = fm + in % gh; u.pn = in / gh; return true;
    }
    __device__ __forceinline__ void a_ready(const Unit&) const {}
    __device__ __forceinline__ void done(const Unit&) const {}
};
struct CountedOrder : StaticOrder {
    const unsigned* ready; unsigned need; unsigned* tmo;
    __device__ __forceinline__ void a_ready(const Unit& u) const {
        if (threadIdx.x < 64) {
            const unsigned long long t0 = __builtin_amdgcn_s_memrealtime(); unsigned polls = 0;
            while ((unsigned)__builtin_amdgcn_readfirstlane(__hip_atomic_load(ready + 64 * u.pm, __ATOMIC_RELAXED, __HIP_MEMORY_SCOPE_AGENT)) < need) {
                if ((++polls & 255u) == 0u && __builtin_amdgcn_readfirstlane(__hip_atomic_load(tmo, __ATOMIC_RELAXED, __HIP_MEMORY_SCOPE_AGENT)) != 0u) break;
                if (__builtin_amdgcn_s_memrealtime() - t0 > 2000000ull) {
                    if (threadIdx.x == 0) { unsigned expect = 0u; __hip_atomic_compare_exchange_strong(tmo + 1, &expect, 0x600u | (unsigned)(u.pm & 0xff), __ATOMIC_RELAXED, __ATOMIC_RELAXED, __HIP_MEMORY_SCOPE_AGENT); __hip_atomic_store(tmo, 1u, __ATOMIC_RELAXED, __HIP_MEMORY_SCOPE_AGENT); }
                    break; }
                __builtin_amdgcn_s_sleep(2); }
            __builtin_amdgcn_fence(__ATOMIC_ACQUIRE, "agent");
            asm volatile("s_waitcnt vmcnt(0)" ::: "memory");
        }
#if !defined(BROKEN_HOOK_NO_BARRIER)
        asm volatile("" ::: "memory"); __builtin_amdgcn_s_barrier(); asm volatile("" ::: "memory");
#endif
    }
};

template <class T, class = void> struct keeps_acc { static constexpr bool value = false; };
template <class T> struct keeps_acc<T, decltype((void)T::KEEPS_ACC)> { static constexpr bool value = true; };
template <class Epi, class Sched, bool STAMP = false>
__device__ __forceinline__ void gemm_phase(PG8_LAS unsigned char* lds, const Gemm g, const Sched& S, const Epi& E, unsigned long long* stamps) {
    int tid_ = threadIdx.x; asm volatile("" : "+v"(tid_));
    const int tid = tid_, wid = __builtin_amdgcn_readfirstlane(tid >> 6), lane = tid & 63, wr = wid >> 2, wc = wid & 3, fr = lane & 15, fq = lane >> 4;
    const int K = g.K, nt = K / BK;
    int ts_lo = 0, ts_hi = 0, nts = 0; const unsigned long long rt_entry = STAMP ? (unsigned long long)wall_clock64() : 0ull;
#define PG8_STAMP() do { if (STAMP && wid == 0 && nts < 64) { const unsigned long long _c = (unsigned long long)clock64(); \
        ts_lo = (lane == nts) ? (int)(unsigned)_c : ts_lo; ts_hi = (lane == nts) ? (int)(unsigned)(_c >> 32) : ts_hi; ++nts; } } while (0)
    PG8_STAMP();
    unsigned voffA[2], voffB[2];
#pragma unroll
    for (int i = 0; i < 2; ++i) { int R, C; stage_rc(tid * 16 + i * 8192, R, C); const int Rb = Epi::PERM ? ((R & ~31) + perm32(R & 31)) : R;
        voffA[i] = (unsigned)(R * K + C) * 2u; voffB[i] = (unsigned)(Rb * K + C) * 2u; }
    const size_t kstep = (size_t)(BK * 2);
    const size_t hstep = (size_t)HALF * K * 2;
    const size_t tstep = 2 * hstep;
    const unsigned ldsw = (unsigned)wid * 1024u;
    const int aoff = lds_byte(wr * 64 + fr, fq * 8), boff = lds_byte(wc * 32 + fr, fq * 8);
#define PG8_SA(b, h) (((b) * 2 + (h)) * HTB)
#define PG8_SB(b, h) ((4 + (b) * 2 + (h)) * HTB)
#define PG8_STAGE(bufoff, gbase, voff) do { const char* g_ = (const char*)(gbase); asm volatile("" : "+s"(g_));     \
        _Pragma("unroll") for (int _i = 0; _i < 2; ++_i) { asm volatile("" : "+v"((voff)[_i]));                         \
        __builtin_amdgcn_global_load_lds((const unsigned*)(g_ + (voff)[_i]), (PG8_LAS unsigned*)(lds + (bufoff) + ldsw + _i * 8192), 16, 0, 0); } } while (0)
#define PG8_LDA(dst, b, h) do { _Pragma("unroll") for (int m = 0; m < 4; ++m) _Pragma("unroll") for (int k = 0; k < 2; ++k) dst[m][k] = *(const PG8_LAS bf16x8*)(lds + PG8_SA(b, h) + aoff + m * 2048 + k * 1024); } while (0)
#define PG8_LDB(dst, b, h) do { _Pragma("unroll") for (int n = 0; n < 2; ++n) _Pragma("unroll") for (int k = 0; k < 2; ++k) dst[n][k] = *(const PG8_LAS bf16x8*)(lds + PG8_SB(b, h) + boff + n * 2048 + k * 1024); } while (0)
#define PG8_MMA(ai, bj, At, Bt) do { __builtin_amdgcn_s_setprio(1); _Pragma("unroll") for (int m = 0; m < 4; ++m) _Pragma("unroll") for (int n = 0; n < 2; ++n) _Pragma("unroll") for (int k = 0; k < 2; ++k) \
        acc[ai][bj][m][n] = __builtin_amdgcn_mfma_f32_16x16x32_bf16(Bt[n][k], At[m][k], acc[ai][bj][m][n], 0, 0, 0); __builtin_amdgcn_s_setprio(0); } while (0)
#define PG8_WAIT_V(n) asm volatile("s_waitcnt vmcnt(" #n ")" ::: "memory")
#define PG8_WAIT_L(n) asm volatile("s_waitcnt lgkmcnt(" #n ")" ::: "memory")
#define PG8_BAR __builtin_amdgcn_s_barrier()
#define PG8_SCHED __builtin_amdgcn_sched_barrier(0)
    Unit cur, nxt; int ui = 0;
    if (!S.next(0, cur)) return;
    f32x4 acc[2][2][4][2];
#pragma unroll
    for (int a = 0; a < 2; ++a)
#pragma unroll
        for (int b = 0; b < 2; ++b)
#pragma unroll
            for (int m = 0; m < 4; ++m)
#pragma unroll
                for (int n = 0; n < 2; ++n) acc[a][b][m][n] = (f32x4){0.f, 0.f, 0.f, 0.f};
    bf16x8 At[4][2], B0[2][2], B1[2][2];
    const char* cA = (const char*)g.A + (size_t)cur.pm * tstep; const char* cB = (const char*)g.Bt + (size_t)cur.pn * tstep;
    S.a_ready(cur);
    PG8_STAGE(PG8_SB(0, 0), cB, voffB); PG8_STAGE(PG8_SA(0, 0), cA, voffA); PG8_STAGE(PG8_SB(0, 1), cB + hstep, voffB); PG8_STAGE(PG8_SA(0, 1), cA + hstep, voffA);
    if (wr == 1) PG8_BAR;
    PG8_WAIT_V(4); PG8_BAR;
    PG8_STAGE(PG8_SB(1, 0), cB + kstep, voffB); PG8_STAGE(PG8_SA(1, 0), cA + kstep, voffA); PG8_STAGE(PG8_SB(1, 1), cB + hstep + kstep, voffB);
    PG8_WAIT_V(6); PG8_BAR;
    PG8_STAMP();
    for (;;) {
        const bool has_next = S.next(ui + 1, nxt);
        const char* nA = has_next ? (const char*)g.A + (size_t)nxt.pm * tstep : cA; const char* nB = has_next ? (const char*)g.Bt + (size_t)nxt.pn * tstep : cB;
        for (int t = 0; t < nt; t += 2) {
            const bool last = (t == nt - 2);
            const char* a1 = cA + (size_t)(t + 1) * kstep;
            const char* a2 = last ? nA : cA + (size_t)(t + 2) * kstep; const char* b2 = last ? nB : cB + (size_t)(t + 2) * kstep;
            const char* a3 = a2 + kstep; const char* b3 = b2 + kstep;
            if (last && has_next) S.a_ready(nxt);
            PG8_LDB(B0, 0, 0); PG8_SCHED; PG8_LDA(At, 0, 0); PG8_STAGE(PG8_SA(1, 1), a1 + hstep, voffA);
            PG8_WAIT_L(8); PG8_BAR; PG8_WAIT_L(0); PG8_MMA(0, 0, At, B0); PG8_BAR; PG8_SCHED;
            PG8_LDB(B1, 0, 1); PG8_STAGE(PG8_SB(0, 0), b2, voffB);
            PG8_BAR; PG8_WAIT_L(0); PG8_MMA(0, 1, At, B1); PG8_BAR;
            PG8_LDA(At, 0, 1); PG8_STAGE(PG8_SA(0, 0), a2, voffA);
            PG8_BAR; PG8_WAIT_L(0); PG8_MMA(1, 0, At, B0); PG8_BAR; PG8_SCHED;
            PG8_STAGE(PG8_SB(0, 1), b2 + hstep, voffB);
            PG8_WAIT_V(6); PG8_BAR; PG8_MMA(1, 1, At, B1); PG8_BAR;
            PG8_LDB(B0, 1, 0); PG8_SCHED; PG8_LDA(At, 1, 0); PG8_STAGE(PG8_SA(0, 1), a2 + hstep, voffA);
            PG8_WAIT_L(8); PG8_BAR; PG8_WAIT_L(0); PG8_MMA(0, 0, At, B0); PG8_BAR; PG8_SCHED;
            PG8_LDB(B1, 1, 1); PG8_STAGE(PG8_SB(1, 0), b3, voffB);
            PG8_BAR; PG8_WAIT_L(0); PG8_MMA(0, 1, At, B1); PG8_BAR;
            PG8_LDA(At, 1, 1); PG8_STAGE(PG8_SA(1, 0), a3, voffA);
            PG8_BAR; PG8_WAIT_L(0); PG8_MMA(1, 0, At, B0); PG8_BAR; PG8_SCHED;
            PG8_STAGE(PG8_SB(1, 1), b3 + hstep, voffB);
            PG8_WAIT_V(6); PG8_BAR; PG8_MMA(1, 1, At, B1); PG8_BAR;
        }
        PG8_STAMP();
        if constexpr (!Epi::AFTER_DRAIN) { E(acc, cur, wr, wc, fr, fq); S.done(cur); }
        PG8_STAMP();
        if (!has_next) break;
        bool keep_acc = false;
        if constexpr (keeps_acc<Epi>::value) keep_acc = S.keep(ui);
        if (!keep_acc) {
#pragma unroll
        for (int a = 0; a < 2; ++a)
#pragma unroll
            for (int b = 0; b < 2; ++b)
#pragma unroll
                for (int m = 0; m < 4; ++m)
#pragma unroll
                    for (int n = 0; n < 2; ++n) acc[a][b][m][n] = (f32x4){0.f, 0.f, 0.f, 0.f};
        }
        cur = nxt; cA = nA; cB = nB; ++ui;
    }
    PG8_WAIT_V(0);
    if (wr == 0) PG8_BAR;
    PG8_BAR;
    if constexpr (Epi::AFTER_DRAIN) { E.fused(acc, cur, wr, wc, fr, fq, lds, wid, lane); S.done(cur); }
    PG8_STAMP();
    if (STAMP && wid == 0) { stamps[lane] = lane < nts ? (((unsigned long long)(unsigned)ts_hi << 32) | (unsigned)ts_lo) : 0ull;
        if (lane == 62) stamps[62] = rt_entry; if (lane == 63) stamps[63] = (unsigned long long)wall_clock64(); }
#undef PG8_STAMP
#undef PG8_SA
#undef PG8_SB
#undef PG8_STAGE
#undef PG8_LDA
#undef PG8_LDB
#undef PG8_MMA
#undef PG8_WAIT_V
#undef PG8_WAIT_L
#undef PG8_BAR
#undef PG8_SCHED
}
}

#define GAS __attribute__((address_space(1)))
#define LAS __attribute__((address_space(3)))
typedef unsigned short bf16_t;
typedef short bf16x8 __attribute__((ext_vector_type(8)));
typedef short s16x4 __attribute__((ext_vector_type(4)));
typedef float f32x4 __attribute__((ext_vector_type(4)));
typedef float f32x2 __attribute__((ext_vector_type(2)));
typedef float f32x16 __attribute__((ext_vector_type(16)));
typedef unsigned u32x4 __attribute__((ext_vector_type(4)));
typedef unsigned u32x2 __attribute__((ext_vector_type(2)));

typedef __bf16 bf16x2_t __attribute__((ext_vector_type(2)));
__device__ __forceinline__ unsigned cvtpk_c(float lo, float hi) { const f32x2 v = {lo, hi}; return __builtin_bit_cast(unsigned, __builtin_convertvector(v, bf16x2_t)); }
__device__ __forceinline__ unsigned cvtpk(float lo, float hi) { unsigned r; asm volatile("v_cvt_pk_bf16_f32 %0, %1, %2" : "=v"(r) : "v"(lo), "v"(hi)); return r; }
__device__ __forceinline__ float bf2f(unsigned short b) { return __uint_as_float(((unsigned)b) << 16); }
__device__ __forceinline__ float bflo(unsigned w) { return __uint_as_float(w << 16); }
__device__ __forceinline__ float bfhi(unsigned w) { return __uint_as_float(w & 0xffff0000u); }
__device__ __forceinline__ float wave_sum(float v) {
#pragma unroll
    for (int o = 1; o < 64; o <<= 1) v += __shfl_xor(v, o);
    return v;
}
__device__ __forceinline__ float sigmoidf_(float x) { return __builtin_amdgcn_rcpf(1.0f + __builtin_amdgcn_exp2f(-1.4426950408889634f * x)); }
__device__ __forceinline__ float siluf_(float x) { return x * __builtin_amdgcn_rcpf(1.0f + __builtin_amdgcn_exp2f(-1.4426950408889634f * x)); }

#define XB_TMO      128
#define XB_XCNT(j)  (256  + 64 * (j))
#define XB_XSUB(j)  (1280 + 64 * (j))
#define XB_XGEN(j)  (2304 + 64 * (j))
#define XB_TOP      3328
#define XB_TOPGEN   3392
#define XCD_BAR_WORDS 3456
#define XB_SPIN_CAP (1u << 18)

__device__ __forceinline__ unsigned xb_ld(unsigned* p)              { return __hip_atomic_load(p, __ATOMIC_RELAXED, __HIP_MEMORY_SCOPE_AGENT); }
__device__ __forceinline__ unsigned xb_add(unsigned* p, unsigned v) { return __hip_atomic_fetch_add(p, v, __ATOMIC_RELAXED, __HIP_MEMORY_SCOPE_AGENT); }
__device__ __forceinline__ unsigned xb_xcc_id() { return (unsigned)__builtin_amdgcn_s_getreg((3 << 11) | 20) & 0xFu; }
#define XB_SPIN(cond, bar) do { unsigned _sp = 0; while (cond) { __builtin_amdgcn_s_sleep(1); \
    if ((++_sp & 255u) == 0u) { if (xb_ld(&(bar)[XB_TMO])) break; if (_sp > XB_SPIN_CAP) { atomicAdd(&(bar)[XB_TMO], 1u); break; } } } } while (0)

struct XcdBarrier {
    unsigned* bar; unsigned x;
    volatile LAS unsigned* st;
};
__device__ __forceinline__ XcdBarrier xcd_barrier_post(unsigned* bar, volatile LAS unsigned* st) {
    XcdBarrier b; b.bar = bar; b.x = xb_xcc_id(); b.st = st;
    if (threadIdx.x == 0) (void)xb_add(&bar[XB_XCNT(b.x)], 1u);
    return b;
}
__device__ __forceinline__ void xcd_barrier_complete(unsigned* bar, unsigned x, unsigned& nloc, unsigned& nx) {
    const unsigned G = gridDim.x * gridDim.y * gridDim.z;
    unsigned sum, cnt, mine, sp = 0u;
    for (;;) {
        sum = 0u; cnt = 0u; mine = 0u;
#pragma unroll
        for (unsigned j = 0; j < 16; ++j) { const unsigned c = xb_ld(&bar[XB_XCNT(j)]); sum += c; cnt += (c > 0u) ? 1u : 0u; mine = (j == x) ? c : mine; }
        if (sum == G) break;
        __builtin_amdgcn_s_sleep(1);
        if ((++sp & 255u) == 0u) { if (xb_ld(&bar[XB_TMO])) break; if (sp > XB_SPIN_CAP) { atomicAdd(&bar[XB_TMO], 1u); break; } }
    }
    nloc = mine > 0u ? mine : 1u; nx = cnt > 0u ? cnt : 1u;
}
__device__ __forceinline__ void xcd_barrier(const XcdBarrier& b) {
    asm volatile("s_waitcnt vmcnt(0)" ::: "memory");
    __syncthreads();
    if (threadIdx.x == 0) {
        unsigned* bar = b.bar;
        __builtin_amdgcn_s_waitcnt(0);
        unsigned nloc = b.st[0], nx = b.st[1];
        if (nloc == 0u) { xcd_barrier_complete(bar, b.x, nloc, nx); b.st[0] = nloc; b.st[1] = nx; }
        const unsigned old = xb_add(&bar[XB_XSUB(b.x)], 1u);
        const unsigned gen = old / nloc;
        if (old + 1u == (gen + 1u) * nloc) {
            __builtin_amdgcn_fence(__ATOMIC_RELEASE, "agent");
            asm volatile("s_waitcnt vmcnt(0)" ::: "memory");
            const unsigned og = xb_add(&bar[XB_TOP], 1u);
            const unsigned tg = og / nx;
            if (og + 1u == (tg + 1u) * nx) xb_add(&bar[XB_TOPGEN], 1u);
            else XB_SPIN(xb_ld(&bar[XB_TOPGEN]) == tg, bar);
            __builtin_amdgcn_fence(__ATOMIC_ACQUIRE, "agent");
            xb_add(&bar[XB_XGEN(b.x)], 1u);
            asm volatile("s_waitcnt vmcnt(0)" ::: "memory");
        } else {
            XB_SPIN(xb_ld(&bar[XB_XGEN(b.x)]) == gen, bar);
            __builtin_amdgcn_fence(__ATOMIC_ACQUIRE, "agent");
            asm volatile("s_waitcnt vmcnt(0)" ::: "memory");
        }
    }
    __syncthreads();
}

constexpr int D = 2048, NB = 2, T = 16384, LC = 256, TT = T + LC  , MR = NB * TT  ;
constexpr int NPAN = MR / 256  , PPB = TT / 256  ;
constexpr int NIN = 17408, DFF = 5504, NUP = 2 * DFF;
constexpr int NWAVES = 8, NTHR = 512;
constexpr float EPS = 1e-6f;
constexpr float LOG2E = 1.4426950408889634f;

enum { I_X = 0, I_C, I_CTX, I_CCTX, I_WMOD, I_BMOD, I_WIN, I_BGATE, I_QKN, I_LAMBDA, I_SUBLN, I_RNORM, I_GLB, I_GNORM, I_WBR, I_WOUT, I_WUP, I_CONVW, I_CONVB, I_WDOWN, N_INPUTS };

enum { TY_ROPE64 = 0, TY_ROPE128 = 1, TY_PLAIN = 2 };
enum { PT_DQ = 0, PT_DK = 4, PT_DV = 8, PT_RQ = 12, PT_RK = 14, PT_RV = 16, PT_GQ = 20, PT_GF = 24, PT_GB = 28, PT_GI = 32, PT_RG = 36, PT_GG = 40, PT_MA = 44, PT_MB = 52, PT_MC = 60, PT_END = 68 };
__host__ __device__ __forceinline__ int pt_logical_base(int pt) {
    if (pt < PT_RQ) return 256 * pt;
    if (pt < PT_RV) return 3072 + 256 * (pt - PT_RQ);
    if (pt < PT_GQ) return 4096 + 256 * (pt - PT_RV);
    if (pt < PT_RG) return 6144 + 256 * (pt - PT_GQ);
    if (pt < PT_GG) return 5120 + 256 * (pt - PT_RG);
    if (pt < PT_MA) return 10240 + 256 * (pt - PT_GG);
    return 11264 + 256 * (pt - PT_MA);
}
__host__ __device__ __forceinline__ int pt_type(int pt) { return pt < PT_DV ? TY_ROPE64 : (pt >= PT_RQ && pt < PT_RV) ? TY_ROPE128 : TY_PLAIN; }
__host__ __device__ __forceinline__ int perm_col(int type, int p) {
    const int bj = p >> 7, wc = (p >> 5) & 3, n = (p >> 4) & 1, fq = (p >> 2) & 3, e = p & 3;
    if (type == TY_ROPE64)  return 64 * wc + 32 * (fq >> 1) + 16 * bj + 8 * (fq & 1) + 4 * n + e;
    if (type == TY_ROPE128) return 128 * (wc >> 1) + 64 * (wc & 1) + 32 * bj + 8 * fq + 4 * n + e;
    return 64 * wc + 32 * bj + 8 * fq + 4 * n + e;
}
__host__ __device__ __forceinline__ int perm_col_up(int p) { const int bj = p >> 7, wc = (p >> 5) & 3, n = (p >> 4) & 1, fq = (p >> 2) & 3, e = p & 3; return 128 * bj + 32 * wc + 8 * fq + 4 * n + e; }

constexpr size_t MiB = 1u << 20;
constexpr size_t WS_CTL = 0, CTL_ZERO_BYTES = 1 * MiB;
constexpr size_t WS_MODP = 1 * MiB;
constexpr size_t WS_MODV = 6 * MiB;
constexpr size_t WS_ROPEA = 7 * MiB;
constexpr size_t WS_ROPEB = 7 * MiB + 64 * 1024;
constexpr size_t WS_LB = 7 * MiB + 256 * 1024;
constexpr size_t WS_SCAL = 7 * MiB + 512 * 1024;
constexpr size_t WS_XC = 9 * MiB;
constexpr size_t WS_WT = 13 * MiB;
constexpr size_t WT_IN = 0, WT_BR = 68 * MiB, WT_OUT = 80 * MiB, WT_UP = 88 * MiB, WT_DOWN = 131 * MiB;
constexpr size_t WS_H = 166 * MiB;
constexpr size_t WS_DYN = 296 * MiB;
constexpr size_t DY_OA = WS_DYN, DY_OB = WS_DYN + 65 * MiB, DY_OC = WS_DYN + 130 * MiB;
constexpr size_t DY_OSUB = WS_DYN + 195 * MiB;
constexpr size_t DY_US = DY_OSUB;
constexpr size_t DY_QKV = WS_DYN + 65 * MiB;
constexpr size_t DY_O1 = WS_DYN + 260 * MiB;
constexpr size_t DY_PC = WS_DYN + 325 * MiB;
constexpr size_t DY_PB = WS_DYN + 585 * MiB;
constexpr size_t DY_MG = WS_DYN + 325 * MiB;
constexpr size_t DY_Y = DY_OSUB, DY_YO = DY_OSUB;
constexpr size_t DY_G = WS_DYN, DY_RAW = WS_DYN + 350 * MiB;
constexpr size_t WS_END = WS_DYN + 715 * MiB;
constexpr size_t SZ_ROWS1K = (size_t)MR * 1024 * 2;

constexpr int CW_BAR = 4096;

constexpr int RING_BYTES = 131072, LDSCTL_OFF = RING_BYTES, MISC_OFF = LDSCTL_OFF + 320, LDS_BYTES = 147456;

struct Args { const float* in[N_INPUTS]; float* out; unsigned char* ws; int layer, ph_lo, ph_hi, pad; };

struct Frame {
    LAS unsigned char* lds;
    int tid, lane, wave, G, bid;
    const Args* a; unsigned char* ws;
};
__device__ __forceinline__ float* outp(const Frame& F) { GAS float* p = (GAS float*)F.a->out; asm volatile("" : "+s"(p)); return (float*)p; }
__device__ __forceinline__ const float* inp(const Frame& F, int i) { const GAS float* p = (const GAS float*)F.a->in[i]; asm volatile("" : "+s"(p)); return (const float*)p; }
__device__ __forceinline__ int opaque_tid() { int t = threadIdx.x; asm volatile("" : "+v"(t)); return t; }
__device__ __forceinline__ void frame_refresh(Frame& F) { GAS unsigned char* w_ = (GAS unsigned char*)F.a->ws; asm volatile("" : "+s"(w_)); F.ws = (unsigned char*)w_; F.tid = opaque_tid(); F.lane = F.tid & 63; F.wave = __builtin_amdgcn_readfirstlane(F.tid >> 6); }
#define WSP(T_, off) ((T_*)(F.ws + (off)))

__device__ __forceinline__ void p0_mod_partial(Frame& F) {
    LAS float* sv = (LAS float*)F.lds;
    for (int i = F.tid; i < 3 * D; i += NTHR) { const int v = i / D, k = i % D; const float c = v < 2 ? inp(F, I_C)[v * D + k] : inp(F, I_CCTX)[k]; sv[i] = siluf_(c); }
    __syncthreads();
    float* part = WSP(float, WS_MODP);
    const int total = 2 * 16 * 3072;
    for (int task = F.bid * NTHR + F.tid; task < total; task += F.G * NTHR) {
        const int q = task % 3072, ks = (task / 3072) % 16, l = task / (3072 * 16);
        const float* W = inp(F, I_WMOD) + ((size_t)l * D + ks * 128) * (6 * D) + q * 4;
        f32x4 a0 = {0, 0, 0, 0}, a1 = a0, a2 = a0;
#pragma unroll 8
        for (int k = 0; k < 128; ++k) { const f32x4 w = *(const f32x4*)(W + (size_t)k * (6 * D)); const float s0 = sv[ks * 128 + k], s1 = sv[D + ks * 128 + k], s2 = sv[2 * D + ks * 128 + k];
            a0 += w * s0; a1 += w * s1; a2 += w * s2; }
        float* o = part + ((size_t)(ks * 2 + l) * 3) * (6 * D) + q * 4;
        *(f32x4*)(o) = a0; *(f32x4*)(o + 6 * D) = a1; *(f32x4*)(o + 12 * D) = a2;
    }
    __syncthreads();
}
__device__ __forceinline__ void p0_tables(Frame& F) {
    const int gt = F.bid * NTHR + F.tid, NGT = F.G * NTHR;
    f32x2* ra = WSP(f32x2, WS_ROPEA); f32x2* rb = WSP(f32x2, WS_ROPEB);
    for (int i = gt; i < 256 * 16; i += NGT) { const int pos = i >> 4, f = i & 15; const float inv = powf(10000.0f, -(float)f / 16.0f); const float ang = (float)pos * inv; ra[i] = (f32x2){cosf(ang), sinf(ang)}; }
    for (int i = gt; i < 256 * 32; i += NGT) { const int pos = i >> 5, f = i & 31; const float inv = powf(10000.0f, -(float)f / 32.0f); const float ang = (float)pos * inv; rb[i] = (f32x2){cosf(ang), sinf(ang)}; }
    float* lb = WSP(float, WS_LB);
    for (int i = gt; i < 2 * 1024; i += NGT) { const float g0 = inp(F, I_GLB)[i], g1 = inp(F, I_GLB)[2048 + i]; const float m = fmaxf(g0, g1); const float e0 = expf(g0 - m), e1 = expf(g1 - m);
        lb[i] = 0.0f; lb[2048 + i] = e1 / (e0 + e1); }
    if (gt == 0) {
        float* sc = WSP(float, WS_SCAL);
        for (int l = 0; l < 2; ++l) {
            const float* al = inp(F, I_LAMBDA) + l * 256; float s1 = 0.f, s2 = 0.f;
            for (int i = 0; i < 64; ++i) { s1 += al[i] * al[64 + i]; s2 += al[128 + i] * al[192 + i]; }
            const float lam_init = 0.8f - 0.6f * expf(-0.3f * (float)l);
            sc[l] = expf(s1) - expf(s2) + lam_init;
            const float* g = inp(F, I_QKN) + l * 128; float mq = 0.f, mk = 0.f;
            for (int i = 0; i < 64; ++i) { mq = fmaxf(mq, fabsf(g[i])); mk = fmaxf(mk, fabsf(g[64 + i])); }
            sc[2 + l] = -(8.0f * mq * mk * 1.02f) * LOG2E;
        }
    }
}
__device__ __forceinline__ void convert_tile(Frame& F, const float* W, int N, int K, bf16_t* WT, int prow0, int k0, int base0, int base1, int ptype  ) {
    LAS float* t = (LAS float*)F.lds;
    { float wv[32];
#pragma unroll
      for (int i = 0; i < 32; ++i) { const int idx = i * NTHR + F.tid, kk = idx >> 8, c = idx & 255; const int col = c < 128 ? base0 + c : base1 + (c - 128);
          wv[i] = W[(size_t)(k0 + kk) * N + col]; }
#pragma unroll
      for (int i = 0; i < 32; ++i) { const int idx = i * NTHR + F.tid, kk = idx >> 8, c = idx & 255; t[kk * 257 + c] = wv[i]; } }
    __syncthreads();
#pragma unroll
    for (int i = 0; i < 4; ++i) { const int item = i * NTHR + F.tid, ch = item & 7, p = item >> 3; const int lc = ptype < 0 ? perm_col_up(p) : perm_col(ptype, p);
        const LAS float* s = t + (8 * ch) * 257 + lc;
        u32x4 o; o.x = cvtpk(s[0], s[257]); o.y = cvtpk(s[2 * 257], s[3 * 257]); o.z = cvtpk(s[4 * 257], s[5 * 257]); o.w = cvtpk(s[6 * 257], s[7 * 257]);
        *(u32x4*)(WT + (size_t)(prow0 + p) * K + k0 + 8 * ch) = o; }
    __syncthreads();
}
__device__ __forceinline__ void convert_weights(Frame& F, int l) {
    bf16_t* wt = WSP(bf16_t, WS_WT);
    constexpr int T_IN = 68 * 32, T_BR = 3 * 8 * 16, T_OUT = 8 * 32, T_UP = 43 * 32, T_DN = 8 * 86, T_ALL = T_IN + T_BR + T_OUT + T_UP + T_DN;
    for (int it = F.bid; it < T_ALL; it += F.G) {
        int r = it;
        if (r < T_IN) { const int pt = r / 32, kb = r % 32; const int lb = pt_logical_base(pt);
            convert_tile(F, inp(F, I_WIN) + (size_t)l * D * NIN, NIN, D, wt + WT_IN / 2, pt * 256, kb * 64, lb, lb + 128, pt_type(pt)); continue; } r -= T_IN;
        if (r < T_BR) { const int n = r / 128, pt = (r % 128) / 16, kb = r % 16;
            convert_tile(F, inp(F, I_WBR) + ((size_t)l * 3 + n) * 1024 * D, D, 1024, wt + WT_BR / 2 + (size_t)n * D * 1024, pt * 256, kb * 64, pt * 256, pt * 256 + 128, TY_PLAIN); continue; } r -= T_BR;
        if (r < T_OUT) { const int pt = r / 32, kb = r % 32;
            convert_tile(F, inp(F, I_WOUT) + (size_t)l * D * D, D, D, wt + WT_OUT / 2, pt * 256, kb * 64, pt * 256, pt * 256 + 128, TY_PLAIN); continue; } r -= T_OUT;
        if (r < T_UP) { const int pt = r / 32, kb = r % 32;
            convert_tile(F, inp(F, I_WUP) + (size_t)l * D * NUP, NUP, D, wt + WT_UP / 2, pt * 256, kb * 64, pt * 128, DFF + pt * 128, -1); continue; } r -= T_UP;
        { const int pt = r / 86, kb = r % 86;
            convert_tile(F, inp(F, I_WDOWN) + (size_t)l * DFF * D, D, DFF, wt + WT_DOWN / 2, pt * 256, kb * 64, pt * 256, pt * 256 + 128, TY_PLAIN); }
    }
}
__device__ __forceinline__ void p1_mod_final(Frame& F) {
    const float* part = WSP(float, WS_MODP); float* mv = WSP(float, WS_MODV);
    for (int i = F.bid * NTHR + F.tid; i < 2 * 3 * 6 * D; i += F.G * NTHR) { const int n = i % (6 * D), l = i / (3 * 6 * D);
        float s = inp(F, I_BMOD)[l * 6 * D + n];
#pragma unroll
        for (int ks = 0; ks < 16; ++ks) s += part[(size_t)ks * (2 * 3 * 6 * D) + i];
        mv[i] = s; }
}

__device__ __forceinline__ const float* xrow_src(Frame& F, int R, int use_inputs) {
    const int b = R / TT, t = R % TT;
    if (t < T) return (use_inputs ? inp(F, I_X) : (const float*)outp(F)) + ((size_t)b * T + t) * D;
    return (use_inputs ? inp(F, I_CTX) : (const float*)WSP(float, WS_XC)) + ((size_t)b * LC + (t - T)) * D;
}
__device__ __forceinline__ void norm_phase(Frame& F, int l, int which  ) {
    const int gw = F.bid * NWAVES + F.wave, NGW = F.G * NWAVES;
    bf16_t* h = WSP(bf16_t, WS_H); const float* mv = WSP(float, WS_MODV);
    const int use_inputs = (l == 0 && which == 0);
    f32x4 x[8], xn[8], sc1[8], sh[8]; int vcur = -1;
    if (gw < MR) { const f32x4* xr = (const f32x4*)xrow_src(F, gw, use_inputs) + F.lane;
#pragma unroll
        for (int j = 0; j < 8; ++j) x[j] = xr[64 * j]; }
    for (int R = gw; R < MR; R += NGW) {
        const int Rn = R + NGW;
        if (Rn < MR) { const f32x4* xr = (const f32x4*)xrow_src(F, Rn, use_inputs) + F.lane;
#pragma unroll
            for (int j = 0; j < 8; ++j) xn[j] = xr[64 * j]; }
        const int b = R / TT, t = R % TT, v = t < T ? b : 2;
        if (v != vcur) {
            const float* shift = mv + ((size_t)(l * 3 + v) * 6 + (which ? 3 : 0)) * D; const float* scale = shift + D;
#pragma unroll
            for (int j = 0; j < 8; ++j) { sc1[j] = *((const f32x4*)scale + F.lane + 64 * j) + 1.0f; sh[j] = *((const f32x4*)shift + F.lane + 64 * j); }
            vcur = v;
        }
        float ss = 0.f;
#pragma unroll
        for (int j = 0; j < 8; ++j) ss += (x[j].x * x[j].x + x[j].y * x[j].y) + (x[j].z * x[j].z + x[j].w * x[j].w);
        const float rstd = rsqrtf(wave_sum(ss) * (1.0f / D) + EPS);
        u32x2* o = (u32x2*)(h + (size_t)R * D) + F.lane;
#pragma unroll
        for (int j = 0; j < 8; ++j) { const f32x4 y = x[j] * rstd * sc1[j] + sh[j]; u32x2 w; w.x = cvtpk(y.x, y.y); w.y = cvtpk(y.z, y.w); o[64 * j] = w; }
#pragma unroll
        for (int j = 0; j < 8; ++j) x[j] = xn[j];
    }
}

typedef f32x4 acc_t[2][2][4][2];
__device__ __forceinline__ u32x4 pack8(const f32x4 a, const f32x4 b) { u32x4 w; w.x = cvtpk(a[0], a[1]); w.y = cvtpk(a[2], a[3]); w.z = cvtpk(b[0], b[1]); w.w = cvtpk(b[2], b[3]); return w; }

struct EpiIn {
    static constexpr bool PERM = false, AFTER_DRAIN = false;
    int pt0;
    bf16_t *rq, *r2, *r1;
    const float* qkn;
    const f32x2 *ropeA, *ropeB;
    __device__ __forceinline__ void operator()(const acc_t& acc, const pg8::Unit& u, int wr, int wc, int fr, int fq) const {
        const int pt = pt0 + u.pn, b = u.pm / PPB, tb = (u.pm % PPB) * 256 + wr * 64 + fr;
        if (pt < PT_DV) {
            const int isk = pt >= PT_DK, sh = 4 * (pt - (isk ? PT_DK : PT_DQ)) + wc, d0 = 32 * (fq >> 1) + 8 * (fq & 1);
            bf16_t* base = rq + (isk ? (size_t)MR * 1024 : (size_t)0) + ((size_t)(b * 16 + sh) * TT) * 64 + d0;
            const float* gp = qkn + isk * 64 + d0; const float osc = isk ? 1.0f : LOG2E * 0.125f;
            f32x4 g[2][2];
#pragma unroll
            for (int s = 0; s < 2; ++s)
#pragma unroll
                for (int n = 0; n < 2; ++n) g[s][n] = *(const f32x4*)(gp + 16 * s + 4 * n) * osc;
            const bool lat = (u.pm % PPB) != PPB - 1;
            f32x4 c0_[4], c1_[4], c2_[4];
#define R64_LD(buf, it) do { const int t = lat ? tb + ((it) >> 2) * 128 + ((it) & 3) * 16 : 0; const int pos = (fq < 2) ? (t >> 6) : (t & 63);                                              \
                const f32x4* rp = (const f32x4*)(ropeA + pos * 16 + 8 * (fq & 1)); _Pragma("unroll") for (int k = 0; k < 4; ++k) buf[k] = rp[k]; } while (0)
#define R64_DO(buf, it) do { constexpr int ai = (it) >> 2, m = (it) & 3; const int t = tb + ai * 128 + m * 16;                                                                                  \
                f32x4 x[2][2]; float ss = 0.f;                                                                                                                                                    \
                _Pragma("unroll") for (int s = 0; s < 2; ++s) _Pragma("unroll") for (int n = 0; n < 2; ++n) { x[s][n] = acc[ai][s][m][n];                                                         \
                    ss += (x[s][n][0] * x[s][n][0] + x[s][n][1] * x[s][n][1]) + (x[s][n][2] * x[s][n][2] + x[s][n][3] * x[s][n][3]); }                                                            \
                ss += __shfl_xor(ss, 16); ss += __shfl_xor(ss, 32);                                                                                                                               \
                const float rstd = rsqrtf(ss * (1.0f / 64.0f) + EPS);                                                                                                                             \
                _Pragma("unroll") for (int s = 0; s < 2; ++s) _Pragma("unroll") for (int n = 0; n < 2; ++n) x[s][n] = x[s][n] * rstd * g[s][n];                                                   \
                if (lat) { _Pragma("unroll") for (int n = 0; n < 2; ++n) { const f32x4 c01 = buf[2 * n], c23 = buf[2 * n + 1];               \
                    const f32x4 cs = {c01[0], c01[2], c23[0], c23[2]}, sn = {c01[1], c01[3], c23[1], c23[3]};                                                                                     \
                    const f32x4 u1 = x[0][n], u2 = x[1][n]; x[0][n] = u1 * cs - u2 * sn; x[1][n] = u1 * sn + u2 * cs; } }                                                                         \
                bf16_t* rowp = base + (size_t)t * 64;                                                                                                                                             \
                *(u32x4*)(rowp) = pack8(x[0][0], x[0][1]); *(u32x4*)(rowp + 16) = pack8(x[1][0], x[1][1]); } while (0)
            R64_LD(c0_, 0); R64_LD(c1_, 1); R64_LD(c2_, 2); R64_DO(c0_, 0); R64_LD(c0_, 3); R64_DO(c1_, 1); R64_LD(c1_, 4); R64_DO(c2_, 2); R64_LD(c2_, 5);
            R64_DO(c0_, 3); R64_LD(c0_, 6); R64_DO(c1_, 4); R64_LD(c1_, 7); R64_DO(c2_, 5); R64_DO(c0_, 6); R64_DO(c1_, 7);
#undef R64_LD
#undef R64_DO
        } else if (pt >= PT_RQ && pt < PT_RV) {
            const int isk = pt >= PT_RK, head = 2 * (pt - (isk ? PT_RK : PT_RQ)) + (wc >> 1), d0 = 64 * (wc & 1) + 8 * fq;
            bf16_t* base = r2 + (isk ? (size_t)MR * 512 : (size_t)0) + ((size_t)(b * 4 + head) * TT) * 128 + d0;
            const float osc = isk ? 0.08838834764831845f : 1.0f;
            const bool lat = (u.pm % PPB) != PPB - 1;
            f32x4 c0_[4], c1_[4], c2_[4];
#define R128_LD(buf, it) do { const int t = lat ? tb + ((it) >> 2) * 128 + ((it) & 3) * 16 : 0; const int pos = ((wc & 1) == 0) ? (t >> 6) : (t & 63);                                          \
                const f32x4* rp = (const f32x4*)(ropeB + pos * 32 + 8 * fq); _Pragma("unroll") for (int k = 0; k < 4; ++k) buf[k] = rp[k]; } while (0)
#define R128_DO(buf, it) do { constexpr int ai = (it) >> 2, m = (it) & 3; const int t = tb + ai * 128 + m * 16;                                                                                  \
                f32x4 x[2][2];                                                                                                                                                                    \
                _Pragma("unroll") for (int s = 0; s < 2; ++s) _Pragma("unroll") for (int n = 0; n < 2; ++n) x[s][n] = acc[ai][s][m][n] * osc;                                                     \
                if (lat) { _Pragma("unroll") for (int n = 0; n < 2; ++n) { const f32x4 c01 = buf[2 * n], c23 = buf[2 * n + 1];                                                                     \
                    const f32x4 cs = {c01[0], c01[2], c23[0], c23[2]}, sn = {c01[1], c01[3], c23[1], c23[3]};                                                                                     \
                    const f32x4 u1 = x[0][n], u2 = x[1][n]; x[0][n] = u1 * cs - u2 * sn; x[1][n] = u1 * sn + u2 * cs; } }                                                                         \
                bf16_t* rowp = base + (size_t)t * 128;                                                                                                                                            \
                *(u32x4*)(rowp) = pack8(x[0][0], x[0][1]); *(u32x4*)(rowp + 32) = pack8(x[1][0], x[1][1]); } while (0)
            R128_LD(c0_, 0); R128_LD(c1_, 1); R128_LD(c2_, 2); R128_DO(c0_, 0); R128_LD(c0_, 3); R128_DO(c1_, 1); R128_LD(c1_, 4); R128_DO(c2_, 2); R128_LD(c2_, 5);
            R128_DO(c0_, 3); R128_LD(c0_, 6); R128_DO(c1_, 4); R128_LD(c1_, 7); R128_DO(c2_, 5); R128_DO(c0_, 6); R128_DO(c1_, 7);
#undef R128_LD
#undef R128_DO
        } else {
            int pts, hd; bf16_t* sb;
            if (pt < PT_RQ) { sb = rq + (size_t)MR * 2048; pts = PT_DV; hd = 128; } else if (pt < PT_GQ) { sb = r2 + (size_t)MR * 1024; pts = PT_RV; hd = 256; }
            else { const int s4 = (pt - PT_GQ) >> 2; sb = r1 + (size_t)s4 * MR * 1024; pts = PT_GQ + 4 * s4; hd = 128; }
            const int c = 256 * (pt - pts) + 64 * wc + 8 * fq, head = c / hd, dim = c % hd, H = 1024 / hd;
            bf16_t* base = sb + ((size_t)(b * H + head) * TT) * hd + dim;
            const bool isq = (pt >= PT_GQ && pt < PT_GF);
#pragma unroll
            for (int ai = 0; ai < 2; ++ai)
#pragma unroll
                for (int m = 0; m < 4; ++m) {
                    const int t = tb + ai * 128 + m * 16; bf16_t* rowp = base + (size_t)t * hd;
#pragma unroll
                    for (int bj = 0; bj < 2; ++bj) { f32x4 a = acc[ai][bj][m][0], c2 = acc[ai][bj][m][1];
                        if (isq) {
#pragma unroll
                            for (int e = 0; e < 4; ++e) { a[e] = siluf_(a[e]) * 0.08838834764831845f; c2[e] = siluf_(c2[e]) * 0.08838834764831845f; } }
                        *(u32x4*)(rowp + 32 * bj) = pack8(a, c2); }
                }
        }
    }
};

struct EpiGates {
    static constexpr bool PERM = false, AFTER_DRAIN = false;
    bf16_t *oB, *oC, *G; const float* bias;
    __device__ __forceinline__ void operator()(const acc_t& acc, const pg8::Unit& u, int wr, int wc, int fr, int fq) const {
        const int R0 = u.pm * 256 + wr * 64 + fr;
        if (u.pn < 8) {
            bf16_t* o = (u.pn < 4 ? oB : oC) + 256 * (u.pn & 3) + 64 * wc + 8 * fq + (size_t)R0 * 1024;
            u32x4 wv[2][4][2];
#pragma unroll
            for (int ai = 0; ai < 2; ++ai)
#pragma unroll
                for (int m = 0; m < 4; ++m)
#pragma unroll
                    for (int bj = 0; bj < 2; ++bj) wv[ai][m][bj] = *(const u32x4*)(o + (size_t)(ai * 128 + m * 16) * 1024 + 32 * bj);
#pragma unroll
            for (int ai = 0; ai < 2; ++ai)
#pragma unroll
                for (int m = 0; m < 4; ++m) { bf16_t* rowp = o + (size_t)(ai * 128 + m * 16) * 1024;
#pragma unroll
                    for (int bj = 0; bj < 2; ++bj) { const u32x4 w = wv[ai][m][bj]; const f32x4 a = acc[ai][bj][m][0], c = acc[ai][bj][m][1];
                        const f32x4 r0 = {bflo(w.x) * siluf_(a[0]), bfhi(w.x) * siluf_(a[1]), bflo(w.y) * siluf_(a[2]), bfhi(w.y) * siluf_(a[3])};
                        const f32x4 r1 = {bflo(w.z) * siluf_(c[0]), bfhi(w.z) * siluf_(c[1]), bflo(w.w) * siluf_(c[2]), bfhi(w.w) * siluf_(c[3])};
                        *(u32x4*)(rowp + 32 * bj) = pack8(r0, r1); } }
        } else {
            const int t = u.pn - 8, n = t >> 3, c0 = 256 * (t & 7) + 64 * wc + 8 * fq;
            const float* bp = bias + n * D + c0; bf16_t* Gn = G + (size_t)n * MR * D + c0;
            f32x4 bv[2][2];
#pragma unroll
            for (int bj = 0; bj < 2; ++bj)
#pragma unroll
                for (int k = 0; k < 2; ++k) bv[bj][k] = *(const f32x4*)(bp + 32 * bj + 4 * k);
#pragma unroll
            for (int ai = 0; ai < 2; ++ai)
#pragma unroll
                for (int m = 0; m < 4; ++m) { bf16_t* rowp = Gn + (size_t)(R0 + ai * 128 + m * 16) * D;
#pragma unroll
                    for (int bj = 0; bj < 2; ++bj) { f32x4 a = acc[ai][bj][m][0] + bv[bj][0], c = acc[ai][bj][m][1] + bv[bj][1];
#pragma unroll
                        for (int e = 0; e < 4; ++e) { a[e] = fmaxf(sigmoidf_(a[e]), 7.888609052210118e-31f); c[e] = fmaxf(sigmoidf_(c[e]), 7.888609052210118e-31f); }
                        u32x4 w; w.x = cvtpk_c(a[0], a[1]); w.y = cvtpk_c(a[2], a[3]); w.z = cvtpk_c(c[0], c[1]); w.w = cvtpk_c(c[2], c[3]);
                        *(u32x4*)(rowp + 32 * bj) = w; } }
        }
    }
};
struct EpiProjAll {
    static constexpr bool PERM = false, AFTER_DRAIN = false, KEEPS_ACC = true;
    const bf16_t* G; bf16_t* y;
    __device__ __forceinline__ void operator()(acc_t& acc, const pg8::Unit& u, int wr, int wc, int fr, int fq) const {
        const int n = u.pm / NPAN, pm = u.pm - n * NPAN, pn = u.pn & 7;
        const int c0 = 256 * pn + 64 * wc + 8 * fq, R0 = pm * 256 + wr * 64 + fr;
        const bf16_t* Gn = G + (size_t)n * MR * D + (size_t)R0 * D + c0; const bf16_t* Gx = Gn + (size_t)MR * D;
        bf16_t* yp = y + (size_t)R0 * D + c0;
        u32x4 wa[4], xa[4], wb[4], xb[4];
#define PJ_LD(GW_, GX_, ai, bj) do { _Pragma("unroll") for (int m = 0; m < 4; ++m) { const size_t ro = (size_t)((ai) * 128 + m * 16) * D + 32 * (bj); GW_[m] = *(const u32x4*)(Gn + ro); GX_[m] = *(const u32x4*)(Gx + ro); } } while (0)
#define PJ_LD1(GW_, ai, bj) do { _Pragma("unroll") for (int m = 0; m < 4; ++m) { const size_t ro = (size_t)((ai) * 128 + m * 16) * D + 32 * (bj); GW_[m] = *(const u32x4*)(Gn + ro); } } while (0)
#define PJ_RATIO(GW_, GX_, ai, bj) do { _Pragma("unroll") for (int m = 0; m < 4; ++m) {                                                     \
            const float g[8] = {bflo(GW_[m].x), bfhi(GW_[m].x), bflo(GW_[m].y), bfhi(GW_[m].y), bflo(GW_[m].z), bfhi(GW_[m].z), bflo(GW_[m].w), bfhi(GW_[m].w)};            \
            const float d[8] = {bflo(GX_[m].x), bfhi(GX_[m].x), bflo(GX_[m].y), bfhi(GX_[m].y), bflo(GX_[m].z), bfhi(GX_[m].z), bflo(GX_[m].w), bfhi(GX_[m].w)};            \
            f32x4 r0 = acc[ai][bj][m][0], r1 = acc[ai][bj][m][1];                                                                                                         \
            _Pragma("unroll") for (int e = 0; e < 4; ++e) { r0[e] *= g[e] * __builtin_amdgcn_rcpf(d[e]); r1[e] *= g[4 + e] * __builtin_amdgcn_rcpf(d[4 + e]); }           \
            acc[ai][bj][m][0] = r0; acc[ai][bj][m][1] = r1; } } while (0)
#define PJ_FINAL(GW_, ai, bj) do { _Pragma("unroll") for (int m = 0; m < 4; ++m) {                                                           \
            const float g[8] = {bflo(GW_[m].x), bfhi(GW_[m].x), bflo(GW_[m].y), bfhi(GW_[m].y), bflo(GW_[m].z), bfhi(GW_[m].z), bflo(GW_[m].w), bfhi(GW_[m].w)};            \
            f32x4 r0 = acc[ai][bj][m][0], r1 = acc[ai][bj][m][1];                                                                                                         \
            _Pragma("unroll") for (int e = 0; e < 4; ++e) { r0[e] *= g[e]; r1[e] *= g[4 + e]; }                                                                           \
            *(u32x4*)(yp + (size_t)((ai) * 128 + m * 16) * D + 32 * (bj)) = pack8(r0, r1); } } while (0)
        if (n < 2) { PJ_LD(wa, xa, 0, 0); PJ_LD(wb, xb, 0, 1); PJ_RATIO(wa, xa, 0, 0); PJ_LD(wa, xa, 1, 0); PJ_RATIO(wb, xb, 0, 1); PJ_LD(wb, xb, 1, 1); PJ_RATIO(wa, xa, 1, 0); PJ_RATIO(wb, xb, 1, 1); }
        else { PJ_LD1(wa, 0, 0); PJ_LD1(wb, 0, 1); PJ_LD1(xa, 1, 0); PJ_LD1(xb, 1, 1); PJ_FINAL(wa, 0, 0); PJ_FINAL(wb, 0, 1); PJ_FINAL(xa, 1, 0); PJ_FINAL(xb, 1, 1); }
#undef PJ_LD
#undef PJ_LD1
#undef PJ_RATIO
#undef PJ_FINAL
    }
};
struct EpiRes {
    static constexpr bool PERM = false, AFTER_DRAIN = false;
    const float *srcx, *srcc; float *dstx, *dstc; const float* gate0;
    __device__ __forceinline__ void operator()(const acc_t& acc, const pg8::Unit& u, int wr, int wc, int fr, int fq) const {
        const int b = u.pm / PPB, lp = u.pm % PPB, c0 = 256 * u.pn + 64 * wc + 8 * fq, r0 = wr * 64 + fr;
        const bool isc = (lp == PPB - 1);
        const size_t rb = isc ? (size_t)(b * LC) : (size_t)(b * T + lp * 256);
        const float* s = (isc ? srcc : srcx) + (rb + r0) * D + c0; float* d = (isc ? dstc : dstx) + (rb + r0) * D + c0;
        const float* gp = gate0 + (size_t)(isc ? 2 : b) * 6 * D + c0;
        f32x4 gv[2][2];
#pragma unroll
        for (int bj = 0; bj < 2; ++bj)
#pragma unroll
            for (int n = 0; n < 2; ++n) gv[bj][n] = *(const f32x4*)(gp + 32 * bj + 4 * n);
        f32x4 sa[4][2], sb[4][2];
#define RES_LD(buf, ai, bj) do { _Pragma("unroll") for (int m = 0; m < 4; ++m) _Pragma("unroll") for (int n = 0; n < 2; ++n) buf[m][n] = *(const f32x4*)(s + (size_t)((ai) * 128 + m * 16) * D + 32 * (bj) + 4 * n); } while (0)
#define RES_ST(buf, ai, bj) do { _Pragma("unroll") for (int m = 0; m < 4; ++m) _Pragma("unroll") for (int n = 0; n < 2; ++n) *(f32x4*)(d + (size_t)((ai) * 128 + m * 16) * D + 32 * (bj) + 4 * n) = buf[m][n] + gv[bj][n] * acc[ai][bj][m][n]; } while (0)
        RES_LD(sa, 0, 0); RES_LD(sb, 0, 1); RES_ST(sa, 0, 0); RES_LD(sa, 1, 0); RES_ST(sb, 0, 1); RES_LD(sb, 1, 1); RES_ST(sa, 1, 0); RES_ST(sb, 1, 1);
#undef RES_LD
#undef RES_ST
    }
};
__device__ __forceinline__ float dpp_up1(float cur, float prev) {
    const int old = __builtin_amdgcn_mov_dpp(__float_as_int(prev), 0x121  , 0xf, 0xf, false);
    return __int_as_float(__builtin_amdgcn_update_dpp(old, __float_as_int(cur), 0x111  , 0xf, 0xf, false));
}
__device__ __forceinline__ float dpp_dn1(float cur, float next) {
    const int old = __builtin_amdgcn_mov_dpp(__float_as_int(next), 0x12F  , 0xf, 0xf, false);
    return __int_as_float(__builtin_amdgcn_update_dpp(old, __float_as_int(cur), 0x101  , 0xf, 0xf, false));
}
struct EpiConv {
    static constexpr bool PERM = false, AFTER_DRAIN = false;
    bf16_t* g; float* raw; const float* cw; const float* cb;
    __device__ __forceinline__ void operator()(const acc_t& acc, const pg8::Unit& u, int wr, int wc, int fr, int fq) const {
        const int jc = 128 * u.pn + 32 * wc + 8 * fq, R0 = u.pm * 256 + wr * 64 + fr;
        u32x2 keep[2][4];
        f32x4 cwv[2][8];
#pragma unroll
        for (int n = 0; n < 2; ++n) { const int j = jc + 4 * n;
            cwv[n][0] = *(const f32x4*)(cw + j); cwv[n][1] = *(const f32x4*)(cw + NUP + j); cwv[n][2] = *(const f32x4*)(cw + 2 * NUP + j); cwv[n][3] = *(const f32x4*)(cb + j);
            cwv[n][4] = *(const f32x4*)(cw + DFF + j); cwv[n][5] = *(const f32x4*)(cw + NUP + DFF + j); cwv[n][6] = *(const f32x4*)(cw + 2 * NUP + DFF + j); cwv[n][7] = *(const f32x4*)(cb + DFF + j); }
        const float m0 = (fr == 0) ? 1.0f : 0.0f, m15 = (fr == 15) ? 1.0f : 0.0f;
#define FMAC_DPP(y, x, w, CTRL) asm("v_fmac_f32_dpp %0, %1, %2 " CTRL " row_mask:0xf bank_mask:0xf bound_ctrl:1" : "+v"(y) : "v"(x), "v"(w))
#pragma unroll
        for (int n = 0; n < 2; ++n) {
            const int j = jc + 4 * n;
            const f32x4 wg0 = cwv[n][0], wg1 = cwv[n][1], wg2 = cwv[n][2], bg = cwv[n][3];
            const f32x4 wu0 = cwv[n][4], wu1 = cwv[n][5], wu2 = cwv[n][6], bu = cwv[n][7];
            const f32x4 wg0e = wg0 * m0, wg2e = wg2 * m15, wu0e = wu0 * m0, wu2e = wu2 * m15;
#pragma unroll
            for (int ai = 0; ai < 2; ++ai)
#pragma unroll
                for (int m = 0; m < 4; ++m) {
                    const f32x4 xg = acc[ai][0][m][n], xu = acc[ai][1][m][n];
                    const f32x4 pg = acc[ai][0][m > 0 ? m - 1 : 0][n], ng = acc[ai][0][m < 3 ? m + 1 : 3][n], pu = acc[ai][1][m > 0 ? m - 1 : 0][n], nu = acc[ai][1][m < 3 ? m + 1 : 3][n];
                    f32x4 yg, yu;
#pragma unroll
                    for (int e = 0; e < 4; ++e) {
                        float g_ = wg1[e] * xg[e] + bg[e], u_ = wu1[e] * xu[e] + bu[e];
                        { const float a0 = xg[e], a1 = pg[e], a2 = ng[e], c0 = wg0[e], c1 = wg0e[e], c2 = wg2[e], c3 = wg2e[e];
                          FMAC_DPP(g_, a0, c0, "row_shr:1"); FMAC_DPP(g_, a1, c1, "row_mirror"); FMAC_DPP(g_, a0, c2, "row_shl:1"); FMAC_DPP(g_, a2, c3, "row_mirror"); }
                        { const float a0 = xu[e], a1 = pu[e], a2 = nu[e], c0 = wu0[e], c1 = wu0e[e], c2 = wu2[e], c3 = wu2e[e];
                          FMAC_DPP(u_, a0, c0, "row_shr:1"); FMAC_DPP(u_, a1, c1, "row_mirror"); FMAC_DPP(u_, a0, c2, "row_shl:1"); FMAC_DPP(u_, a2, c3, "row_mirror"); }
                        yg[e] = g_; yu[e] = u_;
                    }
                    f32x4 r;
#pragma unroll
                    for (int e = 0; e < 4; ++e) r[e] = siluf_(yg[e]) * yu[e];
                    u32x2 pk; pk.x = cvtpk(r[0], r[1]); pk.y = cvtpk(r[2], r[3]);
                    if (n == 0) keep[ai][m] = pk;
                    else { u32x4 w; w.x = keep[ai][m].x; w.y = keep[ai][m].y; w.z = pk.x; w.w = pk.y; *(u32x4*)(g + (size_t)(R0 + ai * 128 + m * 16) * DFF + jc) = w; }
                    if ((m == 0 && fr < 2) || (m == 3 && fr >= 14)) {
                        const int slot = (m == 0) ? fr : fr - 12; float* rp = raw + ((size_t)(u.pm * 4 + ai * 2 + wr) * 4 + slot) * NUP + j;
                        *(f32x4*)(rp) = xg; *(f32x4*)(rp + DFF) = xu;
                    }
                }
        }
#undef FMAC_DPP
    }
};

namespace att {
constexpr int KVBLK = 64;
constexpr int SHM_V = 64 * 128 * 2, SHM_K = 64 * 64 * 2;
#define KSWZ64(row, colB) ((row) * 128 + ((colB) ^ ((((row) >> 1) & 7) << 4)))
#define SBAR() __builtin_amdgcn_sched_barrier(0)
__device__ __forceinline__ int crow(int r, int hi) { return (r & 3) + 8 * (r >> 2) + 4 * hi; }
template <int SK = 0> __device__ __forceinline__ void exp16(f32x16& p) {
    if (SK & 1) return;
#pragma unroll
    for (int r = 0; r < 16; ++r) p[r] = __builtin_amdgcn_exp2f(p[r]);
}
template <int BASE> __device__ __forceinline__ void exp8(f32x16& p) {
    float e[8];
#pragma unroll
    for (int r = 0; r < 8; ++r) e[r] = __builtin_amdgcn_exp2f(p[BASE + r]);
    asm volatile("" : "+v"(e[0]), "+v"(e[1]), "+v"(e[2]), "+v"(e[3]), "+v"(e[4]), "+v"(e[5]), "+v"(e[6]), "+v"(e[7]));
#pragma unroll
    for (int r = 0; r < 8; ++r) p[BASE + r] = e[r];
}
template <int SK = 0> __device__ __forceinline__ void finishSM(f32x16& p0, f32x16& p1, float& lsum, bf16x8& pa0, bf16x8& pa1, bf16x8& pa2, bf16x8& pa3) {
    if (SK & 8) { lsum += p0[0] + p1[0]; const unsigned c_ = cvtpk(p0[1], p1[1]); u32x4 w_ = {c_, c_, c_, c_}; pa0 = pa1 = pa2 = pa3 = *reinterpret_cast<bf16x8*>(&w_); return; }
    float ps = 0;
#pragma unroll
    for (int r = 0; r < 16; ++r) ps += p0[r];
#pragma unroll
    for (int r = 0; r < 16; ++r) ps += p1[r];
    lsum += ps;
#define PK4(P, BASE, OUT) do { unsigned a0 = cvtpk(P[BASE + 0], P[BASE + 1]), a1 = cvtpk(P[BASE + 2], P[BASE + 3]);   \
    unsigned b0 = cvtpk(P[BASE + 4], P[BASE + 5]), b1 = cvtpk(P[BASE + 6], P[BASE + 7]);                              \
    auto r0 = __builtin_amdgcn_permlane32_swap(a0, b0, false, false); auto r1 = __builtin_amdgcn_permlane32_swap(a1, b1, false, false); \
    u32x4 w = {r0[0], r1[0], r0[1], r1[1]}; OUT = *reinterpret_cast<bf16x8*>(&w); } while (0)
    PK4(p0, 0, pa0); PK4(p0, 8, pa1); PK4(p1, 0, pa2); PK4(p1, 8, pa3);
#undef PK4
}
template <int SK = 0> __device__ __forceinline__ void qkt(f32x16& p0, f32x16& p1, const LAS char* Ks, const bf16x8* qr, int r32, int hi, float negM) {
#pragma unroll
    for (int r = 0; r < 16; ++r) { p0[r] = 0.f; p1[r] = 0.f; }
    if (SK & 4) return;
#pragma unroll
    for (int d0 = 0; d0 < 4; ++d0) { const int cb = (d0 * 16 + hi * 8) * 2;
        const bf16x8 b0 = *(const LAS bf16x8*)(Ks + KSWZ64(r32, cb));
        const bf16x8 b1 = *(const LAS bf16x8*)(Ks + KSWZ64(32 + r32, cb));
        p0 = __builtin_amdgcn_mfma_f32_32x32x16_bf16(b0, qr[d0], p0, 0, 0, 0);
        p1 = __builtin_amdgcn_mfma_f32_32x32x16_bf16(b1, qr[d0], p1, 0, 0, 0); }
}
__device__ __forceinline__ int v_st(int k, int c) { const int kk = (k & ~0xC) | ((k & 4) << 1) | ((k & 8) >> 1); return ((kk >> 3) * 4 + (c >> 5)) * 512 + ((kk & 7) * 32 + (c & 31)) * 2; }
__device__ __forceinline__ int v_rd_base(int lane) { return ((lane & 3) << 3) | (((lane >> 2) & 3) << 6) | (((lane >> 4) & 1) << 5) | (((lane >> 5) & 1) << 8); }
constexpr int v_rd_off(int d0, int ks, int half) { return d0 * 512 + ks * 4096 + half * 2048; }
template <int OFF> __device__ __forceinline__ s16x4 tr_read(int vb) {
  s16x4 r; asm volatile("ds_read_b64_tr_b16 %0, %1 offset:%2" : "=&v"(r) : "v"(vb), "i"(OFF) : "memory"); return r;
}
template <int D0> __device__ __forceinline__ void pv_one(f32x16& od, int vb, bf16x8 pa0, bf16x8 pa1, bf16x8 pa2, bf16x8 pa3) {
  const s16x4 l0 = tr_read<v_rd_off(D0, 0, 0)>(vb), h0 = tr_read<v_rd_off(D0, 0, 1)>(vb), l1 = tr_read<v_rd_off(D0, 1, 0)>(vb), h1 = tr_read<v_rd_off(D0, 1, 1)>(vb);
  const s16x4 l2 = tr_read<v_rd_off(D0, 2, 0)>(vb), h2 = tr_read<v_rd_off(D0, 2, 1)>(vb), l3 = tr_read<v_rd_off(D0, 3, 0)>(vb), h3 = tr_read<v_rd_off(D0, 3, 1)>(vb);
  asm volatile("s_waitcnt lgkmcnt(0)" ::: "memory"); SBAR();
#define PK(L, H) (bf16x8){L[0], L[1], L[2], L[3], H[0], H[1], H[2], H[3]}
  od = __builtin_amdgcn_mfma_f32_32x32x16_bf16(pa0, PK(l0, h0), od, 0, 0, 0);
  od = __builtin_amdgcn_mfma_f32_32x32x16_bf16(pa1, PK(l1, h1), od, 0, 0, 0);
  od = __builtin_amdgcn_mfma_f32_32x32x16_bf16(pa2, PK(l2, h2), od, 0, 0, 0);
  od = __builtin_amdgcn_mfma_f32_32x32x16_bf16(pa3, PK(l3, h3), od, 0, 0, 0);
#undef PK
}
template <int SK = 0> __device__ __forceinline__ void pv_d0(f32x16* o, int vb, bf16x8 pa0, bf16x8 pa1, bf16x8 pa2, bf16x8 pa3) {
  if (SK & 2) { o[0][0] += __builtin_bit_cast(float, (int)pa0[0] << 16); return; }
  pv_one<0>(o[0], vb, pa0, pa1, pa2, pa3); pv_one<1>(o[1], vb, pa0, pa1, pa2, pa3); pv_one<2>(o[2], vb, pa0, pa1, pa2, pa3); pv_one<3>(o[3], vb, pa0, pa1, pa2, pa3);
}
#define ATT_WAITL(n) asm volatile("s_waitcnt lgkmcnt(" #n ")" ::: "memory")
template <int D0> __device__ __forceinline__ void readv(s16x4 (&v)[8], int vb) {
  v[0] = tr_read<v_rd_off(D0, 0, 0)>(vb); v[1] = tr_read<v_rd_off(D0, 0, 1)>(vb); v[2] = tr_read<v_rd_off(D0, 1, 0)>(vb); v[3] = tr_read<v_rd_off(D0, 1, 1)>(vb);
  v[4] = tr_read<v_rd_off(D0, 2, 0)>(vb); v[5] = tr_read<v_rd_off(D0, 2, 1)>(vb); v[6] = tr_read<v_rd_off(D0, 3, 0)>(vb); v[7] = tr_read<v_rd_off(D0, 3, 1)>(vb);
}
__device__ __forceinline__ void pvm(f32x16& od, const s16x4 (&v)[8], bf16x8 pa0, bf16x8 pa1, bf16x8 pa2, bf16x8 pa3) {
#define PK(L, H) (bf16x8){L[0], L[1], L[2], L[3], H[0], H[1], H[2], H[3]}
  od = __builtin_amdgcn_mfma_f32_32x32x16_bf16(pa0, PK(v[0], v[1]), od, 0, 0, 0);
  od = __builtin_amdgcn_mfma_f32_32x32x16_bf16(pa1, PK(v[2], v[3]), od, 0, 0, 0);
  od = __builtin_amdgcn_mfma_f32_32x32x16_bf16(pa2, PK(v[4], v[5]), od, 0, 0, 0);
  od = __builtin_amdgcn_mfma_f32_32x32x16_bf16(pa3, PK(v[6], v[7]), od, 0, 0, 0);
#undef PK
}
template <int SK, bool HASNEXT> __device__ __forceinline__ void tile_step(f32x16& pN0, f32x16& pN1, f32x16 (&o)[4], const bf16x8 (&qr)[4], float& lsum,
                                                                         const LAS char* ksn, int vbc, float negM, int r32, int hi) {
  bf16x8 kf0[4], kf1[4], pa0, pa1, pa2, pa3; s16x4 va[8], vc[8], vd[8];
  if (HASNEXT && !(SK & 4)) {
#pragma unroll
    for (int d0 = 0; d0 < 4; ++d0) { const int cb = (d0 * 16 + hi * 8) * 2; kf0[d0] = *(const LAS bf16x8*)(ksn + KSWZ64(r32, cb)); kf1[d0] = *(const LAS bf16x8*)(ksn + KSWZ64(32 + r32, cb)); }
  }
  SBAR();
  finishSM<SK>(pN0, pN1, lsum, pa0, pa1, pa2, pa3);
  SBAR();
  if (SK & 2) { o[0][0] += __builtin_bit_cast(float, (int)pa0[0] << 16); }
  else { readv<0>(va, vbc); readv<1>(vc, vbc); }
  SBAR();
  if (HASNEXT) {
#pragma unroll
    for (int r = 0; r < 16; ++r) { pN0[r] = 0.f; pN1[r] = 0.f; }
    if (!(SK & 4)) {
      if (SK & 2) ATT_WAITL(0); else ATT_WAITL(15);
      SBAR();
#pragma unroll
      for (int d0 = 0; d0 < 4; ++d0) { pN0 = __builtin_amdgcn_mfma_f32_32x32x16_bf16(kf0[d0], qr[d0], pN0, 0, 0, 0); pN1 = __builtin_amdgcn_mfma_f32_32x32x16_bf16(kf1[d0], qr[d0], pN1, 0, 0, 0); }
    }
  }
  SBAR();
  if (!(SK & 2)) {
    readv<2>(vd, vbc); SBAR(); ATT_WAITL(15); SBAR(); pvm(o[0], va, pa0, pa1, pa2, pa3); if (HASNEXT && !(SK & 1)) exp8<0>(pN0); SBAR();
    readv<3>(va, vbc); SBAR(); ATT_WAITL(15); SBAR(); pvm(o[1], vc, pa0, pa1, pa2, pa3); if (HASNEXT && !(SK & 1)) exp8<8>(pN0); SBAR();
    ATT_WAITL(8); SBAR(); pvm(o[2], vd, pa0, pa1, pa2, pa3); if (HASNEXT && !(SK & 1)) exp8<0>(pN1); SBAR();
    ATT_WAITL(0); SBAR(); pvm(o[3], va, pa0, pa1, pa2, pa3); if (HASNEXT && !(SK & 1)) exp8<8>(pN1); SBAR();
  } else if (HASNEXT && !(SK & 1)) { exp8<0>(pN0); exp8<8>(pN0); exp8<0>(pN1); exp8<8>(pN1); }
}
constexpr int SLOT = SHM_K + SHM_V, NSLOT = 4;
#define ATT_WAITV(n) asm volatile("s_waitcnt vmcnt(" #n ")" ::: "memory")
template <int SK = 0> __device__ __forceinline__ void attn_unit(const bf16_t* __restrict__ Qb, const bf16_t* __restrict__ Kh, const bf16_t* __restrict__ Vh, bf16_t* Ob, bf16_t* oAb, int second, float lam, float post,
                                                                const float* __restrict__ subln, int nkeys, float negM, LAS char* lds) {
  int tid_ = threadIdx.x; asm volatile("" : "+v"(tid_));
  const int tid = tid_, wid = __builtin_amdgcn_readfirstlane(tid >> 6), lane = tid & 63, r32 = lane & 31, hi = lane >> 5;
  LAS float* li_l = (LAS float*)(lds + NSLOT * SLOT) + wid * 64;
  float lsum = 0; f32x16 o[4];
#pragma unroll
  for (int d = 0; d < 4; ++d)
#pragma unroll
    for (int r = 0; r < 16; ++r) o[d][r] = 0.f;
  bf16x8 qr[4];
  const bf16_t* Qw = Qb + (long)(wid * 32 + r32) * 64 + hi * 8;
#pragma unroll
  for (int d0 = 0; d0 < 4; ++d0) qr[d0] = *reinterpret_cast<const bf16x8*>(Qw + d0 * 16);
  unsigned offK, offV[2];
  { const int row = 8 * wid + (lane >> 3), ch = (lane & 7) ^ ((row >> 1) & 7); offK = (unsigned)(row * 64 + ch * 8); }
#pragma unroll
  for (int i = 0; i < 2; ++i) { const int piece = wid + 8 * i, sub = piece * 2 + (lane >> 5), kk = (sub >> 2) * 8 + ((lane & 31) >> 2), k = (kk & ~0xC) | ((kk & 4) << 1) | ((kk & 8) >> 1), c = (sub & 3) * 32 + 8 * (lane & 3);
      offV[i] = (unsigned)(k * 128 + c); }
  const int vbase = (int)(uintptr_t)lds + SHM_K + v_rd_base(lane);
#define ISSUE(t) do { const int s_ = (t) & (NSLOT - 1); const long k0_ = (long)(t) * KVBLK; \
    __builtin_amdgcn_global_load_lds((const unsigned*)(Kh + k0_ * 64 + offK), (LAS unsigned*)(lds + s_ * SLOT + wid * 1024), 16, 0, 0); \
    __builtin_amdgcn_global_load_lds((const unsigned*)(Vh + k0_ * 128 + offV[0]), (LAS unsigned*)(lds + s_ * SLOT + SHM_K + wid * 1024), 16, 0, 0); \
    __builtin_amdgcn_global_load_lds((const unsigned*)(Vh + k0_ * 128 + offV[1]), (LAS unsigned*)(lds + s_ * SLOT + SHM_K + 8192 + wid * 1024), 16, 0, 0); } while (0)
#define KS(t) (lds + ((t) & (NSLOT - 1)) * SLOT)
#define VB(t) (vbase + ((t) & (NSLOT - 1)) * SLOT)
  f32x16 pA0, pA1; const int NT = nkeys / KVBLK;
  if (wid >= 4) __builtin_amdgcn_s_setprio(1);
  ATT_WAITV(0);
  ISSUE(0); ISSUE(1); ISSUE(2);
  ATT_WAITV(6); __builtin_amdgcn_s_barrier(); asm volatile("" ::: "memory");
  qkt<SK>(pA0, pA1, KS(0), qr, r32, hi, negM); exp16<SK>(pA0); exp16<SK>(pA1);
  for (int j = 0; j + 2 < NT; ++j) {
    if (j + 2 < NT) ATT_WAITV(3); else ATT_WAITV(0);
    __builtin_amdgcn_s_barrier(); asm volatile("" ::: "memory");
    if (!(SK & 16) && j + 3 < NT) ISSUE(j + 3);
    tile_step<SK, true>(pA0, pA1, o, qr, lsum, KS(j + 1), VB(j), negM, r32, hi);
  }
  ATT_WAITV(0); __builtin_amdgcn_s_barrier(); asm volatile("" ::: "memory");
  tile_step<SK, true>(pA0, pA1, o, qr, lsum, KS(NT - 1), VB(NT - 2), negM, r32, hi);
  tile_step<SK, false>(pA0, pA1, o, qr, lsum, KS(NT - 1), VB(NT - 1), negM, r32, hi);
  { auto rr = __builtin_amdgcn_permlane32_swap(__float_as_uint(lsum), __float_as_uint(lsum), false, false); lsum = __uint_as_float(rr[0]) + __uint_as_float(rr[1]); }
  if (hi == 0) li_l[r32] = lsum; asm volatile("s_waitcnt lgkmcnt(0)" ::: "memory");
  float rli[16];
#pragma unroll
  for (int r = 0; r < 16; ++r) rli[r] = __builtin_amdgcn_rcpf(li_l[crow(r, hi)]);
  bf16_t* Ow = Ob + (long)(wid * 32) * 1024;
  if (!second) {
#pragma unroll
    for (int r = 0; r < 16; ++r) { const int orow = crow(r, hi);
#pragma unroll
      for (int d0 = 0; d0 < 4; ++d0) Ow[(long)orow * 1024 + d0 * 32 + r32] = (bf16_t)(cvtpk(o[d0][r] * rli[r], 0.f) & 0xffffu); }
  } else {
    float sl[4];
#pragma unroll
    for (int d0 = 0; d0 < 4; ++d0) sl[d0] = subln[d0 * 32 + r32];
    bf16_t* Aw = oAb + (long)(wid * 32) * 1024;
#pragma unroll
    for (int rg = 0; rg < 4; ++rg) {
      unsigned short o1[4][4];
#pragma unroll
      for (int j = 0; j < 4; ++j)
#pragma unroll
        for (int d0 = 0; d0 < 4; ++d0) o1[j][d0] = *(const unsigned short*)(Ow + (long)crow(4 * rg + j, hi) * 1024 + d0 * 32 + r32);
#pragma unroll
      for (int j = 0; j < 4; ++j) { const int r = 4 * rg + j; float dd[4], ss = 0.f;
#pragma unroll
        for (int d0 = 0; d0 < 4; ++d0) { dd[d0] = __uint_as_float((unsigned)o1[j][d0] << 16) - lam * (o[d0][r] * rli[r]); ss += dd[d0] * dd[d0]; }
        ss += __shfl_xor(ss, 1); ss += __shfl_xor(ss, 2); ss += __shfl_xor(ss, 4); ss += __shfl_xor(ss, 8); ss += __shfl_xor(ss, 16);
        const float rs = rsqrtf(ss * (1.0f / 128.0f) + EPS) * post; bf16_t* rowp = Aw + (long)crow(r, hi) * 1024;
#pragma unroll
        for (int d0 = 0; d0 < 4; ++d0) { const float y = dd[d0] * rs; rowp[d0 * 32 + r32] = (bf16_t)(cvtpk(y * sl[d0], 0.f) & 0xffffu); } }
    }
  }
  __builtin_amdgcn_s_setprio(0);
  __builtin_amdgcn_s_barrier(); asm volatile("" ::: "memory");
#undef ISSUE
#undef KS
#undef VB
#undef ITER
}
}

template <int SK = 0> __device__ __forceinline__ void attn_phase(Frame& F, int l) {
    const bf16_t* Q = WSP(bf16_t, DY_QKV); const bf16_t* K = Q + (size_t)MR * 1024; const bf16_t* V = K + (size_t)MR * 1024;
    bf16_t* O = WSP(bf16_t, DY_O1); bf16_t* oA = WSP(bf16_t, DY_OA); const float negM = 0.f;
    const float lam = WSP(float, WS_SCAL)[l]; const float post = 1.0f - (0.8f - 0.6f * expf(-0.3f * (float)l)); const float* subln = inp(F, I_SUBLN) + l * 128;
    const int NL = NB * 8 * 64, NU = NL + (l == 0 ? NB * 8 : 0);
    for (int i = 0; i * F.G < NU; ++i) {
        int u = i * F.G + F.bid;
        if (F.G == 256 && i < 4) { const int hh = i * 8 + (F.bid & 7); u = (hh >> 1) * 64 + (hh & 1) * 32 + (F.bid >> 3); }
        if (u >= NU) break;
        int p, q0, k0, nk;
        if (u < NL) { p = u / 64; q0 = (u % 64) * 256; k0 = 0; nk = TT; }
        else { p = u - NL; q0 = T; k0 = T; nk = LC; }
        const int b = p >> 3, h = p & 7;
        for (int sm = 0; sm < 2; ++sm) {
            const size_t hb = (size_t)(b * 16 + 2 * h + sm) * TT;
            att::attn_unit<SK>(Q + (hb + q0) * 64, K + (hb + k0) * 64, V + ((size_t)(b * 8 + h) * TT + k0) * 128, O + ((size_t)b * TT + q0) * 1024 + h * 128, oA + ((size_t)b * TT + q0) * 1024 + h * 128,
                               sm, lam, post, subln, nk, negM, (LAS char*)F.lds);
        }
    }
}
__device__ __forceinline__ void ffn_fixup(Frame& F, int l) {
    const float* raw = WSP(float, DY_RAW); bf16_t* g = WSP(bf16_t, DY_G);
    const float* cw = inp(F, I_CONVW) + (size_t)l * 3 * NUP; const float* cb = inp(F, I_CONVB) + (size_t)l * NUP;
    const int NBLK = MR / 64, per = DFF / 4;
    const size_t total = (size_t)NBLK * 2 * per;
    for (size_t it = (size_t)F.bid * NTHR + F.tid; it < total; it += (size_t)F.G * NTHR) {
        const int cq = (int)(it % per), rb = (int)(it / per), blk = rb >> 1, last = rb & 1, j = cq * 4;
        const int bl = blk % (TT / 64);
        const bool seq_first = (bl == 0 || bl == T / 64), seq_last = (bl == T / 64 - 1 || bl == TT / 64 - 1);
        const float* rc = raw + ((size_t)blk * 4 + (last ? 3 : 0)) * NUP;
        const float* rp = last ? raw + ((size_t)blk * 4 + 2) * NUP : raw + ((size_t)(blk - 1) * 4 + 3) * NUP;
        const float* rn = last ? raw + ((size_t)(blk + 1) * 4 + 0) * NUP : raw + ((size_t)blk * 4 + 1) * NUP;
        const bool zp = (!last && seq_first), zn = (last && seq_last);
        const f32x4 z4 = {0.f, 0.f, 0.f, 0.f};
        f32x4 v[14];
        { const float* rpp = zp ? rc : rp; const float* rnn = zn ? rc : rn;
          v[0] = *(const f32x4*)(rpp + j); v[1] = *(const f32x4*)(rpp + DFF + j); v[2] = *(const f32x4*)(rnn + j); v[3] = *(const f32x4*)(rnn + DFF + j);
          v[4] = *(const f32x4*)(rc + j); v[5] = *(const f32x4*)(rc + DFF + j);
          v[6] = *(const f32x4*)(cw + j); v[7] = *(const f32x4*)(cw + NUP + j); v[8] = *(const f32x4*)(cw + 2 * NUP + j); v[9] = *(const f32x4*)(cb + j);
          v[10] = *(const f32x4*)(cw + DFF + j); v[11] = *(const f32x4*)(cw + NUP + DFF + j); v[12] = *(const f32x4*)(cw + 2 * NUP + DFF + j); v[13] = *(const f32x4*)(cb + DFF + j); }
#pragma unroll
        for (int k = 0; k < 14; ++k) asm volatile("" : "+v"(v[k]));
        const f32x4 pg = zp ? z4 : v[0], pu = zp ? z4 : v[1], ng = zn ? z4 : v[2], nu = zn ? z4 : v[3], xg = v[4], xu = v[5];
        const f32x4 yg = v[6] * pg + v[7] * xg + v[8] * ng + v[9];
        const f32x4 yu = v[10] * pu + v[11] * xu + v[12] * nu + v[13];
        u32x2 w; w.x = cvtpk(siluf_(yg[0]) * yu[0], siluf_(yg[1]) * yu[1]); w.y = cvtpk(siluf_(yg[2]) * yu[2], siluf_(yg[3]) * yu[3]);
        *(u32x2*)(g + (size_t)(blk * 64 + (last ? 63 : 0)) * DFF + j) = w;
    }
}

namespace scn {
using att::crow; using att::v_st; using att::v_rd_base; using att::v_rd_off; using att::tr_read;
__device__ __forceinline__ int cp_of(int c, int dir) { return c == PPB - 1 ? 0 : (dir ? (PPB - 1) - c : c + 1); }
#define KSWZ256(row, colB) ((row) * 256 + ((colB) ^ (((row) & 7) << 4)))
#define PKF(L, H) (bf16x8){L[0], L[1], L[2], L[3], H[0], H[1], H[2], H[3]}
__device__ __forceinline__ u32x4 scale8(const u32x4 w, float s) { u32x4 o; o.x = cvtpk(bflo(w.x) * s, bfhi(w.x) * s); o.y = cvtpk(bflo(w.y) * s, bfhi(w.y) * s); o.z = cvtpk(bflo(w.z) * s, bfhi(w.z) * s); o.w = cvtpk(bflo(w.w) * s, bfhi(w.w) * s); return o; }
__device__ __forceinline__ float ret_lg2(int h, int dir) { const int hh = dir ? 3 - h : h; return log1pf(-exp2f(-5.0f - (float)hh)) * LOG2E; }
constexpr size_t RET_US_ELEMS = (size_t)128 * 256, HG_US_ELEMS = (size_t)128 * 128;
constexpr size_t US_RET_OFF = DY_US, US_HG_OFF = DY_US + 65 * MiB;
constexpr size_t HG_A_OFF = WS_MODP;

__device__ __forceinline__ void store_state_tile(bf16_t* us, const f32x16& a, int rb, int d0, int nd0, int c32, int hi) {
#pragma unroll
    for (int g = 0; g < 4; ++g) { const int ks = 2 * rb + (g >> 1), ln = c32 + 32 * (g & 1);
        u32x2 w; w.x = cvtpk_c(a[4 * g], a[4 * g + 1]); w.y = cvtpk_c(a[4 * g + 2], a[4 * g + 3]);
        *(u32x2*)(us + ((size_t)(ks * nd0 + d0) * 64 + ln) * 8 + 4 * hi) = w; }
}

template <int TILE, int KST> __device__ __forceinline__ void ra_step(f32x16 (&acc)[4][2], int vbK, const int (&vbV)[2]) {
    bf16x8 A[4], Bv[2];
    { const s16x4 lo = tr_read<TILE * 16384 + v_rd_off(0, KST, 0)>(vbK), h4 = tr_read<TILE * 16384 + v_rd_off(0, KST, 1)>(vbK); A[0] = PKF(lo, h4); }
    { const s16x4 lo = tr_read<TILE * 16384 + v_rd_off(1, KST, 0)>(vbK), h4 = tr_read<TILE * 16384 + v_rd_off(1, KST, 1)>(vbK); A[1] = PKF(lo, h4); }
    { const s16x4 lo = tr_read<TILE * 16384 + v_rd_off(2, KST, 0)>(vbK), h4 = tr_read<TILE * 16384 + v_rd_off(2, KST, 1)>(vbK); A[2] = PKF(lo, h4); }
    { const s16x4 lo = tr_read<TILE * 16384 + v_rd_off(3, KST, 0)>(vbK), h4 = tr_read<TILE * 16384 + v_rd_off(3, KST, 1)>(vbK); A[3] = PKF(lo, h4); }
    { const s16x4 lo = tr_read<TILE * 32768 + v_rd_off(0, KST, 0)>(vbV[0]), h4 = tr_read<TILE * 32768 + v_rd_off(0, KST, 1)>(vbV[0]); Bv[0] = PKF(lo, h4); }
    { const s16x4 lo = tr_read<TILE * 32768 + v_rd_off(0, KST, 0)>(vbV[1]), h4 = tr_read<TILE * 32768 + v_rd_off(0, KST, 1)>(vbV[1]); Bv[1] = PKF(lo, h4); }
    asm volatile("s_waitcnt lgkmcnt(0)" ::: "memory"); __builtin_amdgcn_sched_barrier(0);
#pragma unroll
    for (int rb = 0; rb < 4; ++rb)
#pragma unroll
        for (int cb = 0; cb < 2; ++cb) acc[rb][cb] = __builtin_amdgcn_mfma_f32_32x32x16_bf16(A[rb], Bv[cb], acc[rb][cb], 0, 0, 0);
}
__device__ __forceinline__ void ret_local_unit(Frame& F, int b, int h, int c) {
    const bf16_t* RK = WSP(bf16_t, DY_PB) + (size_t)MR * 512; const bf16_t* RV = RK + (size_t)MR * 512;
    const size_t hb = (size_t)(b * 4 + h) * TT + (size_t)c * 256;
    const float lgf = ret_lg2(h, 0), lgb = ret_lg2(h, 1);
    const int w = F.wave, lane = F.lane, c32 = lane & 31, hi = lane >> 5, dir = w >> 2, dvq = w & 3;
    LAS char* lds = (LAS char*)F.lds;
    f32x16 acc[4][2];
#pragma unroll
    for (int rb = 0; rb < 4; ++rb)
#pragma unroll
        for (int cb = 0; cb < 2; ++cb)
#pragma unroll
            for (int r = 0; r < 16; ++r) acc[rb][cb][r] = 0.f;
    const int vbK = (int)(uintptr_t)lds + dir * 32768 + v_rd_base(lane);
    int vbV[2];
#pragma unroll
    for (int cb = 0; cb < 2; ++cb) { const int colblk = 2 * dvq + cb; vbV[cb] = (int)(uintptr_t)lds + 65536 + (colblk >> 2) * 16384 + (colblk & 3) * 512 + v_rd_base(lane); }
    for (int hh = 0; hh < 2; ++hh) {
        __syncthreads();
        u32x4 kq[4];
#pragma unroll
        for (int i = 0; i < 4; ++i) { const int idx = i * NTHR + F.tid, row = idx >> 4, ch = idx & 15, p = 128 * hh + row; kq[i] = *(const u32x4*)(RK + (hb + p) * 128 + ch * 8); }
#pragma unroll
        for (int i = 0; i < 4; ++i) asm volatile("" : "+v"(kq[i]));
#pragma unroll
        for (int i = 0; i < 4; ++i) { const int idx = i * NTHR + F.tid, row = idx >> 4, ch = idx & 15, p = 128 * hh + row;
            const u32x4 kv = kq[i];
            const float ff = __builtin_amdgcn_exp2f(lgf * (float)(255 - p)), fb = __builtin_amdgcn_exp2f(lgb * (float)p);
            const int off = (row >> 6) * 16384 + v_st(row & 63, ch * 8);
            *(LAS u32x4*)(lds + off) = scale8(kv, ff); *(LAS u32x4*)(lds + 32768 + off) = scale8(kv, fb); }
        { u32x4 vq[8];
#pragma unroll
          for (int i = 0; i < 8; ++i) { const int idx = i * NTHR + F.tid, row = idx >> 5, col = (idx & 31) * 8, p = 128 * hh + row; vq[i] = *(const u32x4*)(RV + (hb + p) * 256 + col); }
#pragma unroll
          for (int i = 0; i < 8; ++i) asm volatile("" : "+v"(vq[i]));
#pragma unroll
          for (int i = 0; i < 8; ++i) { const int idx = i * NTHR + F.tid, row = idx >> 5, col = (idx & 31) * 8;
            *(LAS u32x4*)(lds + 65536 + ((row >> 6) * 2 + (col >> 7)) * 16384 + v_st(row & 63, col & 127)) = vq[i]; } }
        __syncthreads();
        ra_step<0, 0>(acc, vbK, vbV); ra_step<0, 1>(acc, vbK, vbV); ra_step<0, 2>(acc, vbK, vbV); ra_step<0, 3>(acc, vbK, vbV);
        ra_step<1, 0>(acc, vbK, vbV); ra_step<1, 1>(acc, vbK, vbV); ra_step<1, 2>(acc, vbK, vbV); ra_step<1, 3>(acc, vbK, vbV);
    }
    bf16_t* us = (bf16_t*)(F.ws + US_RET_OFF) + ((size_t)((b * 4 + h) * 2 + dir) * PPB + cp_of(c, dir)) * RET_US_ELEMS;
#pragma unroll
    for (int rb = 0; rb < 4; ++rb)
#pragma unroll
        for (int cb = 0; cb < 2; ++cb) store_state_tile(us, acc[rb][cb], rb, 2 * dvq + cb, 8, c32, hi);
}

__device__ __forceinline__ void scan_states(Frame& F, bool do_ret, bool do_hg) {
  for (int gt = F.bid * NTHR + F.tid; gt < 131072; gt += F.G * NTHR) {
    if (gt < 65536) {
        if (!do_ret) continue;
        const int seq = gt >> 12, vec = gt & 4095, dir = seq & 1, h = (seq >> 1) & 3;
        const float g = exp2f(ret_lg2(h, dir) * 256.0f);
        u32x4* p = (u32x4*)(F.ws + US_RET_OFF) + (size_t)seq * PPB * 4096 + vec;
        float S[8];
#pragma unroll
        for (int e = 0; e < 8; ++e) S[e] = 0.f;
        for (int cp0 = 0; cp0 < PPB; cp0 += 13) {
            u32x4 ub[13];
#pragma unroll
            for (int k = 0; k < 13; ++k) ub[k] = p[(size_t)(cp0 + k) * 4096];
#pragma unroll
            for (int k = 0; k < 13; ++k) { const u32x4 u = ub[k];
                u32x4 o; o.x = cvtpk(S[0], S[1]); o.y = cvtpk(S[2], S[3]); o.z = cvtpk(S[4], S[5]); o.w = cvtpk(S[6], S[7]); p[(size_t)(cp0 + k) * 4096] = o;
                S[0] = g * S[0] + bflo(u.x); S[1] = g * S[1] + bfhi(u.x); S[2] = g * S[2] + bflo(u.y); S[3] = g * S[3] + bfhi(u.y);
                S[4] = g * S[4] + bflo(u.z); S[5] = g * S[5] + bfhi(u.z); S[6] = g * S[6] + bflo(u.w); S[7] = g * S[7] + bfhi(u.w); } }
    } else {
        if (!do_hg) continue;
        const int gv = gt - 65536, seq = gv >> 11, vec = gv & 2047;
        const int ks = vec >> 8, hi = (vec >> 5) & 1, dk0 = 16 * ks + 8 * hi;
        u32x4* p = (u32x4*)(F.ws + US_HG_OFF) + (size_t)seq * PPB * 2048 + vec;
        const f32x4* ap = (const f32x4*)((const float*)(F.ws + HG_A_OFF) + (size_t)seq * PPB * 128 + dk0);
        float S[8];
#pragma unroll
        for (int e = 0; e < 8; ++e) S[e] = 0.f;
        for (int cp0 = 0; cp0 < PPB; cp0 += 5) {
            u32x4 ub[5]; f32x4 a0b[5], a1b[5];
#pragma unroll
            for (int k = 0; k < 5; ++k) { ub[k] = p[(size_t)(cp0 + k) * 2048]; a0b[k] = ap[(cp0 + k) * 32]; a1b[k] = ap[(cp0 + k) * 32 + 1]; }
#pragma unroll
            for (int k = 0; k < 5; ++k) { const u32x4 u = ub[k]; const f32x4 a0 = a0b[k], a1 = a1b[k];
                u32x4 o; o.x = cvtpk(S[0], S[1]); o.y = cvtpk(S[2], S[3]); o.z = cvtpk(S[4], S[5]); o.w = cvtpk(S[6], S[7]); p[(size_t)(cp0 + k) * 2048] = o;
                S[0] = a0[0] * S[0] + bflo(u.x); S[1] = a0[1] * S[1] + bfhi(u.x); S[2] = a0[2] * S[2] + bflo(u.y); S[3] = a0[3] * S[3] + bfhi(u.y);
                S[4] = a1[0] * S[4] + bflo(u.z); S[5] = a1[1] * S[5] + bfhi(u.z); S[6] = a1[2] * S[6] + bflo(u.w); S[7] = a1[3] * S[7] + bfhi(u.w); } }
    }
  }
}

__device__ __forceinline__ void ret_out_unit(Frame& F, int l, int b, int h, int c) {
    const bf16_t* RQ = WSP(bf16_t, DY_PB); const bf16_t* RK = RQ + (size_t)MR * 512; const bf16_t* RV = RK + (size_t)MR * 512;
    const size_t hb = (size_t)(b * 4 + h) * TT + (size_t)c * 256;
    const float lgf = ret_lg2(h, 0), lgb = ret_lg2(h, 1);
    const int w = F.wave, lane = F.lane, r32 = lane & 31, hi = lane >> 5, irow = 32 * w + r32;
    LAS char* lds = (LAS char*)F.lds;
    bf16x8 qr[8];
#pragma unroll
    for (int d0 = 0; d0 < 8; ++d0) qr[d0] = *(const bf16x8*)(RQ + (hb + irow) * 128 + d0 * 16 + hi * 8);
    const int vb = (int)(uintptr_t)lds + 16384 + v_rd_base(lane);
    unsigned okk[2], ovv[2];
#pragma unroll
    for (int i = 0; i < 2; ++i) { const int P = w + 8 * i, row = 4 * P + (lane >> 4), ch = (lane & 15) ^ (row & 7); okk[i] = (unsigned)(row * 128 + ch * 8);
        const int sub = P * 2 + (lane >> 5), kk = (sub >> 2) * 8 + ((lane & 31) >> 2), k = (kk & ~0xC) | ((kk & 4) << 1) | ((kk & 8) >> 1), c = (sub & 3) * 32 + 8 * (lane & 3); ovv[i] = (unsigned)(k * 256 + c); }
    float ssq[16]; LAS unsigned* keep = (LAS unsigned*)(lds + 65536 + w * 8192) + lane;
#pragma unroll
    for (int r = 0; r < 16; ++r) ssq[r] = 0.f;
    f32x16 o[4];
#pragma unroll 1
    for (int half = 0; half < 2; ++half) {
#pragma unroll
        for (int d = 0; d < 4; ++d)
#pragma unroll
            for (int r = 0; r < 16; ++r) o[d][r] = 0.f;
#define RSC_ISSUE(J_, buf_) do { const size_t kb_ = (hb + 64 * (J_)) * 128, vbs_ = (hb + 64 * (J_)) * 256 + half * 128; \
            __builtin_amdgcn_global_load_lds((const unsigned*)(RK + kb_ + okk[0]), (LAS unsigned*)(lds + (buf_) * 32768 + w * 1024), 16, 0, 0); \
            __builtin_amdgcn_global_load_lds((const unsigned*)(RK + kb_ + okk[1]), (LAS unsigned*)(lds + (buf_) * 32768 + (w + 8) * 1024), 16, 0, 0); \
            __builtin_amdgcn_global_load_lds((const unsigned*)(RV + vbs_ + ovv[0]), (LAS unsigned*)(lds + (buf_) * 32768 + 16384 + w * 1024), 16, 0, 0); \
            __builtin_amdgcn_global_load_lds((const unsigned*)(RV + vbs_ + ovv[1]), (LAS unsigned*)(lds + (buf_) * 32768 + 16384 + (w + 8) * 1024), 16, 0, 0); } while (0)
        asm volatile("s_waitcnt vmcnt(0)" ::: "memory");
        RSC_ISSUE(0, 0);
#pragma unroll 1
        for (int J = 0; J < 4; ++J) {
            const int buf = J & 1;
            asm volatile("s_waitcnt lgkmcnt(0)" ::: "memory"); __builtin_amdgcn_s_barrier(); asm volatile("" ::: "memory");
            if (J < 3) { RSC_ISSUE(J + 1, buf ^ 1); asm volatile("s_waitcnt vmcnt(4)" ::: "memory"); } else asm volatile("s_waitcnt vmcnt(0)" ::: "memory");
            __builtin_amdgcn_s_barrier(); asm volatile("" ::: "memory");
            LAS char* kb = lds + buf * 32768; const int vbj = vb + buf * 32768;
            f32x16 p0, p1;
#pragma unroll
            for (int r = 0; r < 16; ++r) { p0[r] = 0.f; p1[r] = 0.f; }
#pragma unroll
            for (int d0 = 0; d0 < 8; ++d0) { const int cb = (d0 * 16 + hi * 8) * 2;
                const bf16x8 b0 = *(const LAS bf16x8*)(kb + KSWZ256(r32, cb)), b1 = *(const LAS bf16x8*)(kb + KSWZ256(32 + r32, cb));
                p0 = __builtin_amdgcn_mfma_f32_32x32x16_bf16(b0, qr[d0], p0, 0, 0, 0); p1 = __builtin_amdgcn_mfma_f32_32x32x16_bf16(b1, qr[d0], p1, 0, 0, 0); }
#pragma unroll
            for (int r = 0; r < 16; ++r) { const int d0i = irow - (64 * J + crow(r, hi)), d1i = d0i - 32;
                const float e0 = d0i >= 0 ? lgf * (float)d0i : -lgb * (float)d0i, e1 = d1i >= 0 ? lgf * (float)d1i : -lgb * (float)d1i;
                float m0 = __builtin_amdgcn_exp2f(e0), m1 = __builtin_amdgcn_exp2f(e1); if (d0i == 0) m0 = 2.0f; if (d1i == 0) m1 = 2.0f;
                p0[r] *= m0; p1[r] *= m1; }
            bf16x8 pa0, pa1, pa2, pa3;
#define PK4(P, BASE, OUT) do { unsigned a0 = cvtpk(P[BASE + 0], P[BASE + 1]), a1 = cvtpk(P[BASE + 2], P[BASE + 3]);   \
    unsigned b0_ = cvtpk(P[BASE + 4], P[BASE + 5]), b1_ = cvtpk(P[BASE + 6], P[BASE + 7]);                              \
    auto r0 = __builtin_amdgcn_permlane32_swap(a0, b0_, false, false); auto r1 = __builtin_amdgcn_permlane32_swap(a1, b1_, false, false); \
    u32x4 w_ = {r0[0], r1[0], r0[1], r1[1]}; OUT = *reinterpret_cast<bf16x8*>(&w_); } while (0)
            PK4(p0, 0, pa0); PK4(p0, 8, pa1); PK4(p1, 0, pa2); PK4(p1, 8, pa3);
            att::pv_d0(o, vbj, pa0, pa1, pa2, pa3);
        }
#undef RSC_ISSUE
#pragma unroll 1
        for (int dir = 0; dir < 2; ++dir) {
            const float sc = dir ? __builtin_amdgcn_exp2f(lgb * (float)(256 - irow)) : __builtin_amdgcn_exp2f(lgf * (float)(irow + 1));
            const bf16_t* us = (const bf16_t*)(F.ws + US_RET_OFF) + ((size_t)((b * 4 + h) * 2 + dir) * PPB + cp_of(c, dir)) * RET_US_ELEMS;
            __syncthreads();
#pragma unroll
            for (int i = 0; i < 4; ++i) { const int idx = i * NTHR + F.tid, fr_ = idx >> 6, ln = idx & 63, ks = fr_ >> 2, d0 = fr_ & 3;
                *(LAS u32x4*)(lds + 32768 + idx * 16) = *(const u32x4*)(us + ((size_t)(ks * 8 + half * 4 + d0) * 64 + ln) * 8); }
            __syncthreads();
#pragma unroll
            for (int ks = 0; ks < 8; ++ks) { const u32x4 qs = scale8(*reinterpret_cast<const u32x4*>(&qr[ks]), sc); const bf16x8 qa = *reinterpret_cast<const bf16x8*>(&qs);
#pragma unroll
                for (int d0 = 0; d0 < 4; ++d0) { const bf16x8 sf = *(const LAS bf16x8*)(lds + 32768 + ((ks * 4 + d0) * 64 + lane) * 16);
                    o[d0] = __builtin_amdgcn_mfma_f32_32x32x16_bf16(qa, sf, o[d0], 0, 0, 0); } }
        }
#pragma unroll
        for (int d0 = 0; d0 < 4; ++d0)
#pragma unroll
            for (int r = 0; r < 16; ++r) ssq[r] += o[d0][r] * o[d0][r];
        if (half == 0) {
#pragma unroll
            for (int d0 = 0; d0 < 4; ++d0)
#pragma unroll
                for (int r = 0; r < 8; ++r) keep[(d0 * 8 + r) * 64] = cvtpk_c(o[d0][2 * r], o[d0][2 * r + 1]);
        }
    }
    const float* rn = inp(F, I_RNORM) + l * 256;
    bf16_t* ob = WSP(bf16_t, DY_OB) + ((size_t)b * TT + (size_t)c * 256 + 32 * w) * 1024 + h * 256 + r32;
    float wn[8];
#pragma unroll
    for (int j = 0; j < 8; ++j) wn[j] = rn[32 * j + r32];
#pragma unroll
    for (int r = 0; r < 16; ++r) { float s = ssq[r];
        s += __shfl_xor(s, 1); s += __shfl_xor(s, 2); s += __shfl_xor(s, 4); s += __shfl_xor(s, 8); s += __shfl_xor(s, 16);
        const float rs = rsqrtf(s * (1.0f / 256.0f) + EPS); bf16_t* rowp = ob + (size_t)crow(r, hi) * 1024;
#pragma unroll
        for (int d0 = 0; d0 < 4; ++d0) { const unsigned pw = keep[(d0 * 8 + (r >> 1)) * 64]; const float v0 = (r & 1) ? bfhi(pw) : bflo(pw);
            rowp[32 * d0] = (bf16_t)(cvtpk(v0 * rs * wn[d0], 0.f) & 0xffffu);
            rowp[128 + 32 * d0] = (bf16_t)(cvtpk(o[d0][r] * rs * wn[4 + d0], 0.f) & 0xffffu); } }
    __syncthreads();
#undef PK4
}
}


namespace hgm {
using att::crow; using att::v_st; using att::v_rd_base; using att::v_rd_off; using att::tr_read;
constexpr int TTAB_OFF = RING_BYTES + 1024;
__device__ __forceinline__ float dpp_shr0(float v, int) { return v; }
template <int CTRL> __device__ __forceinline__ float dppz(float v) { return __int_as_float(__builtin_amdgcn_update_dpp(0, __float_as_int(v), CTRL, 0xf, 0xf, true)); }
template <bool REV> __device__ __forceinline__ void scan32x8(float (&v)[8], int lane, float (&tot)[8]) {
#pragma unroll
    for (int e = 0; e < 8; ++e) v[e] += REV ? dppz<0x101>(v[e]) : dppz<0x111>(v[e]);
#pragma unroll
    for (int e = 0; e < 8; ++e) v[e] += REV ? dppz<0x102>(v[e]) : dppz<0x112>(v[e]);
#pragma unroll
    for (int e = 0; e < 8; ++e) v[e] += REV ? dppz<0x104>(v[e]) : dppz<0x114>(v[e]);
#pragma unroll
    for (int e = 0; e < 8; ++e) v[e] += REV ? dppz<0x108>(v[e]) : dppz<0x118>(v[e]);
    const bool up = (lane & 32) != 0, addrow = REV ? ((lane & 16) == 0) : ((lane & 16) != 0);
    float cr[8];
#pragma unroll
    for (int e = 0; e < 8; ++e) { const float t0 = __int_as_float(__builtin_amdgcn_readlane(__float_as_int(v[e]), REV ? 16 : 15)), t1 = __int_as_float(__builtin_amdgcn_readlane(__float_as_int(v[e]), REV ? 48 : 47)); cr[e] = up ? t1 : t0; }
#pragma unroll
    for (int e = 0; e < 8; ++e) v[e] += addrow ? cr[e] : 0.f;
#pragma unroll
    for (int e = 0; e < 8; ++e) { const float t0 = __int_as_float(__builtin_amdgcn_readlane(__float_as_int(v[e]), REV ? 0 : 31)), t1 = __int_as_float(__builtin_amdgcn_readlane(__float_as_int(v[e]), REV ? 32 : 63)); tot[e] = up ? t1 : t0; }
}
constexpr int LBT_OFF = TTAB_OFF + 4096 + 4608;
template <bool REV, int LAYOUT> __device__ __forceinline__ void prep(const bf16_t* zrow, const LAS float* lbl, int lane, LAS float* ttab_w, float (&E)[64], LAS char* lds, int row) {
    const int hi = lane >> 5;
    u32x4 zw[8];
#pragma unroll
    for (int d0 = 0; d0 < 8; ++d0) zw[d0] = *(const u32x4*)(zrow + 16 * d0);
#pragma unroll
    for (int d0 = 0; d0 < 8; ++d0) {
        const f32x4 l0 = *(const LAS f32x4*)(lbl + 16 * d0), l1 = *(const LAS f32x4*)(lbl + 16 * d0 + 4);
        const float z[8] = {bflo(zw[d0].x), bfhi(zw[d0].x), bflo(zw[d0].y), bfhi(zw[d0].y), bflo(zw[d0].z), bfhi(zw[d0].z), bflo(zw[d0].w), bfhi(zw[d0].w)};
        const float lb[8] = {l0[0], l0[1], l0[2], l0[3], l1[0], l1[1], l1[2], l1[3]};
        float kk[8], Bv[8], tot[8];
#pragma unroll
        for (int e = 0; e < 8; ++e) { const float sg = sigmoidf_(z[e]); const float f = fmaxf(lb[e] + (1.0f - lb[e]) * sg, 1e-20f); Bv[e] = __builtin_amdgcn_logf(f); kk[e] = (1.0f - lb[e]) * (1.0f - sg); }
        scan32x8<REV>(Bv, lane, tot);
        float kv[8];
#pragma unroll
        for (int e = 0; e < 8; ++e) { const float ee = Bv[e] - tot[e]; E[d0 * 8 + e] = ee; kv[e] = kk[e] * __builtin_amdgcn_exp2f(-ee); }
        if ((lane & 31) == 0) { *(LAS f32x4*)(ttab_w + 16 * d0 + 8 * hi) = (f32x4){tot[0], tot[1], tot[2], tot[3]}; *(LAS f32x4*)(ttab_w + 16 * d0 + 8 * hi + 4) = (f32x4){tot[4], tot[5], tot[6], tot[7]}; }
        u32x4 kh; kh.x = cvtpk(kv[0], kv[1]); kh.y = cvtpk(kv[2], kv[3]); kh.z = cvtpk(kv[4], kv[5]); kh.w = cvtpk(kv[6], kv[7]);
        if (LAYOUT == 0) *(LAS u32x4*)(lds + KSWZ256(row, (16 * d0 + 8 * hi) * 2)) = kh;
        else *(LAS u32x4*)(lds + (row >> 6) * 16384 + v_st(row & 63, 16 * d0 + 8 * hi)) = kh;
        __builtin_amdgcn_sched_barrier(0);
    }
}
__device__ __forceinline__ u32x4 qscale(const u32x4 q, const float* Ek) {
    u32x4 o; o.x = cvtpk(bflo(q.x) * __builtin_amdgcn_exp2f(Ek[0]), bfhi(q.x) * __builtin_amdgcn_exp2f(Ek[1])); o.y = cvtpk(bflo(q.y) * __builtin_amdgcn_exp2f(Ek[2]), bfhi(q.y) * __builtin_amdgcn_exp2f(Ek[3]));
    o.z = cvtpk(bflo(q.z) * __builtin_amdgcn_exp2f(Ek[4]), bfhi(q.z) * __builtin_amdgcn_exp2f(Ek[5])); o.w = cvtpk(bflo(q.w) * __builtin_amdgcn_exp2f(Ek[6]), bfhi(q.w) * __builtin_amdgcn_exp2f(Ek[7])); return o;
}
#define HG_PK4(P, BASE, OUT) do { unsigned a0 = cvtpk_c(P[BASE + 0], P[BASE + 1]), a1 = cvtpk_c(P[BASE + 2], P[BASE + 3]);     \
    unsigned b0_ = cvtpk_c(P[BASE + 4], P[BASE + 5]), b1_ = cvtpk_c(P[BASE + 6], P[BASE + 7]);                              \
    auto r0 = __builtin_amdgcn_permlane32_swap(a0, b0_, false, false); auto r1 = __builtin_amdgcn_permlane32_swap(a1, b1_, false, false); \
    u32x4 w_ = {r0[0], r1[0], r0[1], r1[1]}; OUT = *reinterpret_cast<bf16x8*>(&w_); } while (0)
template <int D0> __device__ __forceinline__ void pv32(f32x16& od, int vb, bf16x8 pa0, bf16x8 pa1) {
    const s16x4 l0 = tr_read<v_rd_off(D0, 0, 0)>(vb), h0 = tr_read<v_rd_off(D0, 0, 1)>(vb), l1 = tr_read<v_rd_off(D0, 1, 0)>(vb), h1 = tr_read<v_rd_off(D0, 1, 1)>(vb);
    asm volatile("s_waitcnt lgkmcnt(0)" ::: "memory"); __builtin_amdgcn_sched_barrier(0);
    od = __builtin_amdgcn_mfma_f32_32x32x16_bf16(pa0, (bf16x8){l0[0], l0[1], l0[2], l0[3], h0[0], h0[1], h0[2], h0[3]}, od, 0, 0, 0);
    od = __builtin_amdgcn_mfma_f32_32x32x16_bf16(pa1, (bf16x8){l1[0], l1[1], l1[2], l1[3], h1[0], h1[1], h1[2], h1[3]}, od, 0, 0, 0);
}

constexpr int PTAB_OFF = TTAB_OFF + 4096;
__device__ __forceinline__ u32x4 qfac(u32x4 Q, const LAS float* ca, const LAS float* cb, bool sub) {
    asm volatile("" : "+v"(Q.x), "+v"(Q.y), "+v"(Q.z), "+v"(Q.w));
    f32x4 a0 = *(const LAS f32x4*)(ca), a1 = *(const LAS f32x4*)(ca + 4);
    if (sub) { a0 -= *(const LAS f32x4*)(cb); a1 -= *(const LAS f32x4*)(cb + 4); }
    u32x4 o; o.x = cvtpk(bflo(Q.x) * __builtin_amdgcn_exp2f(a0[0]), bfhi(Q.x) * __builtin_amdgcn_exp2f(a0[1])); o.y = cvtpk(bflo(Q.y) * __builtin_amdgcn_exp2f(a0[2]), bfhi(Q.y) * __builtin_amdgcn_exp2f(a0[3]));
    o.z = cvtpk(bflo(Q.z) * __builtin_amdgcn_exp2f(a1[0]), bfhi(Q.z) * __builtin_amdgcn_exp2f(a1[1])); o.w = cvtpk(bflo(Q.w) * __builtin_amdgcn_exp2f(a1[2]), bfhi(Q.w) * __builtin_amdgcn_exp2f(a1[3])); return o;
}
constexpr int FTAB_OFF = LBT_OFF + 1024;
__device__ __forceinline__ u32x4 qmul(u32x4 Q, const LAS float* f) {
    asm volatile("" : "+v"(Q.x), "+v"(Q.y), "+v"(Q.z), "+v"(Q.w));
    const f32x4 a0 = *(const LAS f32x4*)(f), a1 = *(const LAS f32x4*)(f + 4);
    u32x4 o; o.x = cvtpk(bflo(Q.x) * a0[0], bfhi(Q.x) * a0[1]); o.y = cvtpk(bflo(Q.y) * a0[2], bfhi(Q.y) * a0[3]);
    o.z = cvtpk(bflo(Q.z) * a1[0], bfhi(Q.z) * a1[1]); o.w = cvtpk(bflo(Q.w) * a1[2], bfhi(Q.w) * a1[3]); return o;
}
template <bool REV, int SK = 0> __device__ __forceinline__ void out_dir(Frame& F, int l, int b, int h, int c, f32x16 (&o)[4]) {
    const int w = F.wave, lane = F.lane, r32 = lane & 31, hi = lane >> 5, dir = REV ? 1 : 0;
    LAS char* lds = (LAS char*)F.lds; LAS float* ttab = (LAS float*)(lds + TTAB_OFF); LAS float* ptab = (LAS float*)(lds + PTAB_OFF);
    const size_t rowoff = ((size_t)(b * 8 + h) * TT + (size_t)c * 256 + 32 * w + r32) * 128 + 8 * hi;
    const bf16_t* Z = WSP(bf16_t, DY_PC) + (size_t)(1 + dir) * MR * 1024 + rowoff; const bf16_t* GQ = WSP(bf16_t, DY_PC) + rowoff;
    LAS float* lbt = (LAS float*)(lds + LBT_OFF) + dir * 128;
    __syncthreads();
    u32x4 Qp[8];
    { float E[64];
      prep<REV, 0>(Z, lbt + 8 * hi, lane, ttab + w * 128, E, lds, 32 * w + r32);
#pragma unroll
      for (int d0 = 0; d0 < 8; ++d0) Qp[d0] = *(const u32x4*)(GQ + 16 * d0);
#pragma unroll
      for (int d0 = 0; d0 < 8; ++d0) asm volatile("" : "+v"(Qp[d0]));
#pragma unroll
      for (int d0 = 0; d0 < 8; ++d0) Qp[d0] = qscale(Qp[d0], &E[d0 * 8]); }
    __syncthreads();
    if (F.tid < 128) { float s = 0.f;
#pragma unroll
        for (int pi = 0; pi < 8; ++pi) { ptab[pi * 128 + F.tid] = s; s += ttab[(REV ? 7 - pi : pi) * 128 + F.tid]; }
        ptab[8 * 128 + F.tid] = s; }
    __syncthreads();
    const int vbase = (int)(uintptr_t)lds + 65536 + v_rd_base(lane);
    const int piw = REV ? 7 - w : w; const LAS float* cw = ptab + (piw + 1) * 128 + 8 * hi; LAS float* ftab = (LAS float*)(lds + FTAB_OFF) + w * 128;
    for (int pi = (SK & 1) ? -1 : piw; pi >= 0; --pi) {
        const int J = REV ? 7 - pi : pi; const LAS float* cj = ptab + (pi + 1) * 128 + 8 * hi;
        { const LAS float* pw = ptab + (piw + 1) * 128, *pj = ptab + (pi + 1) * 128;
          ftab[lane] = __builtin_amdgcn_exp2f(pw[lane] - pj[lane]); ftab[lane + 64] = __builtin_amdgcn_exp2f(pw[lane + 64] - pj[lane + 64]); }
        asm volatile("s_waitcnt lgkmcnt(0)" ::: "memory");
        f32x16 p;
#pragma unroll
        for (int r = 0; r < 16; ++r) p[r] = 0.f;
#pragma unroll
        for (int d0 = 0; d0 < 8; ++d0) { const u32x4 qt = qmul(Qp[d0], ftab + 8 * hi + 16 * d0); const bf16x8 a = *(const LAS bf16x8*)(lds + KSWZ256(32 * J + r32, (16 * d0 + 8 * hi) * 2));
            p = __builtin_amdgcn_mfma_f32_32x32x16_bf16(a, *reinterpret_cast<const bf16x8*>(&qt), p, 0, 0, 0);
            if (d0 & 1) __builtin_amdgcn_sched_barrier(0); }
        if (pi == piw) {
#pragma unroll
            for (int r = 0; r < 16; ++r) { const int jj = crow(r, hi); const bool keep = REV ? (jj >= r32) : (jj <= r32); p[r] = keep ? p[r] : 0.f; } }
        bf16x8 pa0, pa1; HG_PK4(p, 0, pa0); HG_PK4(p, 8, pa1);
        const int vb = vbase + (J >> 1) * 16384 + (J & 1) * 8192;
        pv32<0>(o[0], vb, pa0, pa1); pv32<1>(o[1], vb, pa0, pa1); pv32<2>(o[2], vb, pa0, pa1); pv32<3>(o[3], vb, pa0, pa1);
    }
    const bf16_t* us = (const bf16_t*)(F.ws + scn::US_HG_OFF) + ((size_t)((b * 8 + h) * 2 + dir) * PPB + scn::cp_of(c, dir)) * scn::HG_US_ELEMS + (size_t)lane * 8;
    if (!(SK & 2)) {
        bf16x8 sfa[2][4], sfb[2][4];
#define HG_SLD(buf, kq) do { _Pragma("unroll") for (int k2 = 0; k2 < 2; ++k2) _Pragma("unroll") for (int d0 = 0; d0 < 4; ++d0) buf[k2][d0] = *(const bf16x8*)(us + (size_t)((2 * (kq) + k2) * 4 + d0) * 512); } while (0)
#define HG_SMM(buf, kq) do { _Pragma("unroll") for (int k2 = 0; k2 < 2; ++k2) { const u32x4 qe = qfac(Qp[2 * (kq) + k2], cw + 16 * (2 * (kq) + k2), cw, false);                                  \
            _Pragma("unroll") for (int d0 = 0; d0 < 4; ++d0) o[d0] = __builtin_amdgcn_mfma_f32_32x32x16_bf16(*reinterpret_cast<const bf16x8*>(&qe), buf[k2][d0], o[d0], 0, 0, 0); } } while (0)
        HG_SLD(sfa, 0); HG_SLD(sfb, 1); __builtin_amdgcn_sched_barrier(0);
        HG_SMM(sfa, 0); __builtin_amdgcn_sched_barrier(0); HG_SLD(sfa, 2); __builtin_amdgcn_sched_barrier(0);
        HG_SMM(sfb, 1); __builtin_amdgcn_sched_barrier(0); HG_SLD(sfb, 3); __builtin_amdgcn_sched_barrier(0);
        HG_SMM(sfa, 2); __builtin_amdgcn_sched_barrier(0); HG_SMM(sfb, 3); __builtin_amdgcn_sched_barrier(0);
#undef HG_SLD
#undef HG_SMM
    }
    __syncthreads();
}
template <int SK = 0> __device__ __forceinline__ void out_unit(Frame& F, int l, int b, int h, int c) {
    const int w = F.wave, lane = F.lane, r32 = lane & 31, hi = lane >> 5;
    LAS char* lds = (LAS char*)F.lds;
    const size_t rowoff = ((size_t)(b * 8 + h) * TT + (size_t)c * 256 + 32 * w + r32) * 128 + 8 * hi;
    const bf16_t* GI = WSP(bf16_t, DY_PC) + (size_t)3 * MR * 1024 + rowoff;
    { u32x4 gv[8];
#pragma unroll
      for (int d0 = 0; d0 < 8; ++d0) gv[d0] = *(const u32x4*)(GI + 16 * d0);
      float lbv = 0.f; if (F.tid < 256) lbv = WSP(float, WS_LB)[l * 2048 + (F.tid >> 7) * 1024 + h * 128 + (F.tid & 127)];
#pragma unroll
      for (int d0 = 0; d0 < 8; ++d0) asm volatile("" : "+v"(gv[d0]));
      if (F.tid < 256) ((LAS float*)(lds + LBT_OFF))[F.tid] = lbv;
#pragma unroll
      for (int d0 = 0; d0 < 8; ++d0) { const int row = 32 * w + r32; *(LAS u32x4*)(lds + 65536 + (row >> 6) * 16384 + v_st(row & 63, 16 * d0 + 8 * hi)) = gv[d0]; } }
    f32x16 o[4];
#pragma unroll
    for (int d = 0; d < 4; ++d)
#pragma unroll
        for (int r = 0; r < 16; ++r) o[d][r] = 0.f;
    out_dir<false, SK>(F, l, b, h, c, o);
    if (!(SK & 4)) out_dir<true, SK>(F, l, b, h, c, o);
    const float* gn = inp(F, I_GNORM) + l * 128;
    bf16_t* oc = WSP(bf16_t, DY_OC) + ((size_t)b * TT + (size_t)c * 256 + 32 * w) * 1024 + h * 128 + r32;
    float wn[4];
#pragma unroll
    for (int j = 0; j < 4; ++j) wn[j] = gn[32 * j + r32];
#pragma unroll
    for (int r = 0; r < 16; ++r) { float s = 0.f;
#pragma unroll
        for (int d0 = 0; d0 < 4; ++d0) s += o[d0][r] * o[d0][r];
        s += __shfl_xor(s, 1); s += __shfl_xor(s, 2); s += __shfl_xor(s, 4); s += __shfl_xor(s, 8); s += __shfl_xor(s, 16);
        const float rs = rsqrtf(s * (1.0f / 128.0f) + EPS); bf16_t* rowp = oc + (size_t)crow(r, hi) * 1024;
#pragma unroll
        for (int d0 = 0; d0 < 4; ++d0) rowp[32 * d0] = (bf16_t)(cvtpk(o[d0][r] * rs * wn[d0], 0.f) & 0xffffu); }
}

template <bool REV> __device__ __forceinline__ void local_dir(Frame& F, int l, int b, int h, int c) {
    const int w = F.wave, lane = F.lane, r32 = lane & 31, hi = lane >> 5, dir = REV ? 1 : 0, rb = w >> 1, cb0 = 2 * (w & 1);
    LAS char* lds = (LAS char*)F.lds; LAS float* ttab = (LAS float*)(lds + TTAB_OFF);
    const bf16_t* Z = WSP(bf16_t, DY_PC) + (size_t)(1 + dir) * MR * 1024 + ((size_t)(b * 8 + h) * TT + (size_t)c * 256 + 32 * w + r32) * 128 + 8 * hi;
    LAS float* lbt = (LAS float*)(lds + LBT_OFF) + dir * 128;
    __syncthreads();
    { float E[64]; prep<REV, 1>(Z, lbt + 8 * hi, lane, ttab + w * 128, E, lds, 32 * w + r32); }
    __syncthreads();
    f32x16 acc[2];
#pragma unroll
    for (int cb = 0; cb < 2; ++cb)
#pragma unroll
        for (int r = 0; r < 16; ++r) acc[cb][r] = 0.f;
    const int vbK0 = (int)(uintptr_t)lds + rb * 512 + v_rd_base(lane), vbV0 = (int)(uintptr_t)lds + 65536 + cb0 * 512 + v_rd_base(lane);
    for (int i = 0; i < 8; ++i) { const int blk = REV ? 7 - i : i;
        if (i > 0) { const LAS float* tb = ttab + blk * 128 + 32 * rb + 4 * hi;
#pragma unroll
            for (int g = 0; g < 4; ++g) { const f32x4 t = *(const LAS f32x4*)(tb + 8 * g);
#pragma unroll
                for (int j = 0; j < 4; ++j) { const float s = __builtin_amdgcn_exp2f(t[j]); acc[0][4 * g + j] *= s; acc[1][4 * g + j] *= s; } } }
        const int off = (blk >> 1) * 16384 + (blk & 1) * 8192; const int vk = vbK0 + off, vv = vbV0 + off;
#define HL_STEP(KS2) { const s16x4 al = tr_read<v_rd_off(0, KS2, 0)>(vk), ah = tr_read<v_rd_off(0, KS2, 1)>(vk), b0l = tr_read<v_rd_off(0, KS2, 0)>(vv), b0h = tr_read<v_rd_off(0, KS2, 1)>(vv), \
            b1l = tr_read<v_rd_off(1, KS2, 0)>(vv), b1h = tr_read<v_rd_off(1, KS2, 1)>(vv); \
            asm volatile("s_waitcnt lgkmcnt(0)" ::: "memory"); __builtin_amdgcn_sched_barrier(0); \
            const bf16x8 A_ = {al[0], al[1], al[2], al[3], ah[0], ah[1], ah[2], ah[3]}; \
            acc[0] = __builtin_amdgcn_mfma_f32_32x32x16_bf16(A_, (bf16x8){b0l[0], b0l[1], b0l[2], b0l[3], b0h[0], b0h[1], b0h[2], b0h[3]}, acc[0], 0, 0, 0); \
            acc[1] = __builtin_amdgcn_mfma_f32_32x32x16_bf16(A_, (bf16x8){b1l[0], b1l[1], b1l[2], b1l[3], b1h[0], b1h[1], b1h[2], b1h[3]}, acc[1], 0, 0, 0); }
        HL_STEP(0) HL_STEP(1)
#undef HL_STEP
    }
    const size_t slot = (size_t)((b * 8 + h) * 2 + dir) * PPB + scn::cp_of(c, dir);
    bf16_t* us = (bf16_t*)(F.ws + scn::US_HG_OFF) + slot * scn::HG_US_ELEMS;
    scn::store_state_tile(us, acc[0], rb, cb0, 4, r32, hi); scn::store_state_tile(us, acc[1], rb, cb0 + 1, 4, r32, hi);
    if (F.tid < 128) { float s = 0.f;
#pragma unroll
        for (int k = 0; k < 8; ++k) s += ttab[k * 128 + F.tid];
        ((float*)(F.ws + scn::HG_A_OFF))[slot * 128 + F.tid] = __builtin_amdgcn_exp2f(s); }
    __syncthreads();
}
__device__ __forceinline__ void local_unit(Frame& F, int l, int b, int h, int c) {
    const int w = F.wave, lane = F.lane, r32 = lane & 31, hi = lane >> 5;
    LAS char* lds = (LAS char*)F.lds;
    const bf16_t* GI = WSP(bf16_t, DY_PC) + (size_t)3 * MR * 1024 + ((size_t)(b * 8 + h) * TT + (size_t)c * 256 + 32 * w + r32) * 128 + 8 * hi;
    { u32x4 gv[8];
#pragma unroll
      for (int d0 = 0; d0 < 8; ++d0) gv[d0] = *(const u32x4*)(GI + 16 * d0);
      float lbv = 0.f; if (F.tid < 256) lbv = WSP(float, WS_LB)[l * 2048 + (F.tid >> 7) * 1024 + h * 128 + (F.tid & 127)];
#pragma unroll
      for (int d0 = 0; d0 < 8; ++d0) asm volatile("" : "+v"(gv[d0]));
      if (F.tid < 256) ((LAS float*)(lds + LBT_OFF))[F.tid] = lbv;
#pragma unroll
      for (int d0 = 0; d0 < 8; ++d0) { const int row = 32 * w + r32; *(LAS u32x4*)(lds + 65536 + (row >> 6) * 16384 + v_st(row & 63, 16 * d0 + 8 * hi)) = gv[d0]; } }
    local_dir<false>(F, l, b, h, c);
    local_dir<true>(F, l, b, h, c);
}
}

__device__ __forceinline__ void sa_phase(Frame& F, int l) {
    for (int u = F.bid; u < NB * 4 * PPB; u += F.G) { const int c = u % PPB, h = (u / PPB) & 3, b = u / (PPB * 4); scn::ret_local_unit(F, b, h, c); __syncthreads(); }
    frame_refresh(F);
    for (int u = F.G - 1 - F.bid; u < NB * 8 * PPB; u += F.G) { const int c = u % PPB, h = (u / PPB) & 7, b = u / (PPB * 8); hgm::local_unit(F, l, b, h, c); }
}
__device__ __forceinline__ void sc_phase(Frame& F, int l) {
    const int NC = (l == 1) ? PPB - 1 : PPB;
    for (int u = F.bid; u < NB * 4 * NC; u += F.G) { const int c = u % NC, h = (u / NC) & 3, b = u / (NC * 4); scn::ret_out_unit(F, l, b, h, c); }
    frame_refresh(F);
#ifndef HG_PROBE
#define HG_PROBE -1
#endif
    if (HG_PROBE >= 0) { for (int u = F.G - 1 - F.bid; u < NB * 8 * NC; u += F.G) { const int c = u % NC, h = (u / NC) & 7, b = u / (NC * 8); hgm::out_unit<(HG_PROBE < 0 ? 0 : HG_PROBE)>(F, l, b, h, c); } frame_refresh(F); }
    for (int u = F.G - 1 - F.bid; u < NB * 8 * NC; u += F.G) { const int c = u % NC, h = (u / NC) & 7, b = u / (NC * 8); hgm::out_unit<0>(F, l, b, h, c); }
}

#ifndef RET_MFMA
#define RET_MFMA 1
#endif
enum { PH_PRO = 0, PH_MODFIN, PH_N1, PH_GA, PH_ATT, PH_GB, PH_SA, PH_SB, PH_SC, PH_OG, PH_MG, PH_WO, PH_N2, PH_UP, PH_FIX, PH_DN, PH_COUNT };

template <int NN, int WG> struct PanelOrder : pg8::TileOrder<NN, WG> {
    int skip;
    __device__ __forceinline__ bool next(int i, pg8::Unit& u) const { const bool ok = pg8::TileOrder<NN, WG>::next(i, u); if (ok && skip) u.pm += (u.pm >= PPB - 1) ? 1 : 0; return ok; }
};
struct ProjOrder : PanelOrder<8, 4> {
    __device__ __forceinline__ bool next(int i, pg8::Unit& u) const { const int r = i / 3, n = i - 3 * r; const bool ok = PanelOrder<8, 4>::next(r, u); if (ok) { u.pm += n * NPAN; u.pn += 8 * n; } return ok; }
    __device__ __forceinline__ bool keep(int i) const { return (i % 3) != 2; }
};
template <int N, int WG, class Epi> __device__ __forceinline__ void run_gemm(Frame& F, const bf16_t* A, const bf16_t* Bt, int K, const Epi& E, bool skipctx = false) {
    pg8::Gemm g{A, Bt, MR, N, K}; PanelOrder<N / 256, WG> S; S.init(skipctx ? MR - 512 : MR, N, F.G, F.bid); S.skip = skipctx ? 1 : 0;
    pg8::gemm_phase<Epi, PanelOrder<N / 256, WG>, false>(F.lds, g, S, E, nullptr);
}
__device__ __forceinline__ EpiIn make_epi_in(Frame& F, int l, int pt0) {
    EpiIn E; E.pt0 = pt0;
    E.rq = WSP(bf16_t, DY_QKV); E.r2 = WSP(bf16_t, DY_PB); E.r1 = WSP(bf16_t, DY_PC);
    E.qkn = inp(F, I_QKN) + l * 128; E.ropeA = WSP(f32x2, WS_ROPEA); E.ropeB = WSP(f32x2, WS_ROPEB);
    return E;
}
__device__ __forceinline__ EpiRes make_epi_res(Frame& F, int l, int use_inputs, int gidx) {
    EpiRes E; E.srcx = use_inputs ? inp(F, I_X) : outp(F); E.srcc = use_inputs ? inp(F, I_CTX) : WSP(float, WS_XC); E.dstx = outp(F); E.dstc = WSP(float, WS_XC);
    E.gate0 = WSP(float, WS_MODV) + ((size_t)(l * 3) * 6 + gidx) * D; return E;
}

template <int PH> __device__ __forceinline__ void run_phase(Frame& F, int l) {
    frame_refresh(F);
    const bf16_t* h = WSP(bf16_t, WS_H); const bf16_t* wt = WSP(bf16_t, WS_WT);
    const bf16_t* wt_in = wt + WT_IN / 2;
    if constexpr (PH == PH_PRO) { p0_mod_partial(F); p0_tables(F); convert_weights(F, 0); }
    if constexpr (PH == PH_MODFIN) { p1_mod_final(F); }
    if constexpr (PH == PH_N1) { if (l == 1) convert_weights(F, 1); norm_phase(F, l, 0); }
    if constexpr (PH == PH_GA) { const EpiIn E = make_epi_in(F, l, PT_DQ); run_gemm<9216, 8>(F, h, wt_in, D, E); }
#ifndef ATT_PROBE
#define ATT_PROBE -1
#endif
    if constexpr (PH == PH_ATT) { if (ATT_PROBE >= 0) { attn_phase<(ATT_PROBE < 0 ? 0 : ATT_PROBE)>(F, l); __syncthreads(); } attn_phase<0>(F, l); }
    if constexpr (PH == PH_GB) { }
    if constexpr (PH == PH_SA) { sa_phase(F, l); }
    if constexpr (PH == PH_SB) { scn::scan_states(F, true, true); }
    if constexpr (PH == PH_SC) { sc_phase(F, l); }
    if constexpr (PH == PH_OG) { EpiGates E; E.oB = WSP(bf16_t, DY_OB); E.oC = WSP(bf16_t, DY_OC); E.G = WSP(bf16_t, DY_MG); E.bias = inp(F, I_BGATE) + (size_t)l * 3 * D;
        run_gemm<8192, 4>(F, h, wt_in + (size_t)PT_RG * 256 * D, D, E, l == 1); }
    if constexpr (PH == PH_MG) {
        EpiProjAll E{WSP(bf16_t, DY_MG), WSP(bf16_t, DY_YO)};
        pg8::Gemm g{WSP(bf16_t, DY_OA), wt + WT_BR / 2, MR, 2048, 1024}; ProjOrder S; const bool sk = (l == 1); S.init(sk ? MR - 512 : MR, 2048, F.G, F.bid); S.skip = sk ? 1 : 0;
        pg8::gemm_phase<EpiProjAll, ProjOrder, false>(F.lds, g, S, E, nullptr);
    }
    if constexpr (PH == PH_WO) { const EpiRes E = make_epi_res(F, l, l == 0, 2); run_gemm<2048, 4>(F, WSP(bf16_t, DY_YO), wt + WT_OUT / 2, D, E, l == 1); }
    if constexpr (PH == PH_N2) { norm_phase(F, l, 1); }
    if constexpr (PH == PH_UP) { EpiConv E; E.g = WSP(bf16_t, DY_G); E.raw = WSP(float, DY_RAW); E.cw = inp(F, I_CONVW) + (size_t)l * 3 * NUP; E.cb = inp(F, I_CONVB) + (size_t)l * NUP;
        run_gemm<NUP, 8>(F, h, wt + WT_UP / 2, D, E, l == 1); }
    if constexpr (PH == PH_FIX) { ffn_fixup(F, l); }
    if constexpr (PH == PH_DN) { const EpiRes E = make_epi_res(F, l, 0, 5); run_gemm<2048, 4>(F, WSP(bf16_t, DY_G), wt + WT_DOWN / 2, DFF, E, l == 1); }
}

__device__ __forceinline__ void frame_init(Frame& F, const Args& a, unsigned char* lds) {
    F.lds = (LAS unsigned char*)lds; F.a = &a; F.G = gridDim.x; F.bid = blockIdx.x; frame_refresh(F);
}
template <int PH> __global__ void __launch_bounds__(NTHR, 2) k_phase(Args a) {
    extern __shared__ __attribute__((aligned(16))) unsigned char lds[];
    Frame F; frame_init(F, a, lds);
    run_phase<PH>(F, a.layer);
}
#ifndef MK_SINGLE
#define MK_SINGLE 1
#endif
__global__ void __launch_bounds__(NTHR, 2) k_all(Args a) {
    extern __shared__ __attribute__((aligned(16))) unsigned char lds[];
    Frame F; frame_init(F, a, lds);
    for (int u = F.tid; u < (LDS_BYTES - LDSCTL_OFF) / 4; u += NTHR) ((LAS unsigned*)(F.lds + LDSCTL_OFF))[u] = 0u;
    __syncthreads();
    (void)xcd_barrier_post((unsigned*)(a.ws + WS_CTL) + CW_BAR, (volatile LAS unsigned*)(F.lds + MISC_OFF + 32));
#define GRID_BAR() do { XcdBarrier b_; unsigned* bp_ = (unsigned*)(a.ws + WS_CTL) + CW_BAR; asm volatile("" : "+s"(bp_)); b_.bar = bp_; b_.x = xb_xcc_id(); \
        b_.st = (volatile LAS unsigned*)(F.lds + MISC_OFF + 32); xcd_barrier(b_); } while (0)
#ifndef PROBE_MASK
#define PROBE_MASK 0
#endif
#ifndef PROBE_T
#define PROBE_T 0
#endif
    unsigned long long pt0 = 0, pt1 = 0, pc0 = 0, pc1 = 0;
#define TSTART(ph, l_) do { if (PROBE_T && (ph) == PROBE_T - 1 && (l_) == 0) { pt0 = __builtin_amdgcn_s_memrealtime(); pc0 = (unsigned long long)clock64(); } } while (0)
#define TSTOP(ph, l_)  do { if (PROBE_T && (ph) == PROBE_T - 1 && (l_) == 0) { pt1 = __builtin_amdgcn_s_memrealtime(); pc1 = (unsigned long long)clock64(); } } while (0)
#define RUN(ph, l_, grp) do { TSTART(ph, l_); run_phase<ph>(F, l_); GRID_BAR(); TSTOP(ph, l_); if ((PROBE_MASK >> (grp)) & 1) { run_phase<ph>(F, l_); GRID_BAR(); } } while (0)
    RUN(PH_PRO, 0, 0); RUN(PH_MODFIN, 0, 0);
#pragma unroll 1
    for (int l = 0; l < 2; ++l) {
        RUN(PH_N1, l, 0);
        RUN(PH_GA, l, 1);
        RUN(PH_ATT, l, 2);
        RUN(PH_SA, l, 3);
        run_phase<PH_SB>(F, l); GRID_BAR();
        RUN(PH_SC, l, 4);
        run_phase<PH_OG>(F, l); GRID_BAR();
        RUN(PH_MG, l, 5);
        run_phase<PH_WO>(F, l); GRID_BAR();
        RUN(PH_N2, l, 0);
        RUN(PH_UP, l, 6);
        RUN(PH_FIX, l, 0);
        run_phase<PH_DN>(F, l); GRID_BAR();
    }
#undef RUN
    if (PROBE_T) {
        float* slot = (float*)(F.ws + WS_SCAL) + 64;
        if (F.bid == 0 && threadIdx.x == 0) { const float mhz = (float)(pc1 - pc0) / ((float)(pt1 - pt0) * 0.01f); *slot = floorf(mhz / 50.0f) * 50.0f; }
        GRID_BAR();
        const float v = *slot;
        for (size_t i = (size_t)F.bid * NTHR + threadIdx.x; i < (size_t)NB * T * D; i += (size_t)F.G * NTHR) a.out[i] = v;
    }
#undef GRID_BAR
}
__global__ void k_fill(float* out, size_t n, float v) { for (size_t i = (size_t)blockIdx.x * blockDim.x + threadIdx.x; i < n; i += (size_t)gridDim.x * blockDim.x) out[i] = v; }

template <int PH> static void launch_phase(const Args& a0, int layer, int grid, hipStream_t stream) {
    static bool attr = false;
    if (!attr) { if (hipFuncSetAttribute((const void*)k_phase<PH>, hipFuncAttributeMaxDynamicSharedMemorySize, LDS_BYTES) != hipSuccess) fprintf(stderr, "kernel_launch: hipFuncSetAttribute failed for phase %d\n", PH); attr = true; }
    Args a = a0; a.layer = layer;
    hipLaunchKernelGGL(k_phase<PH>, dim3(grid), dim3(NTHR), LDS_BYTES, stream, a);
    const hipError_t e = hipPeekAtLastError(); if (e != hipSuccess) fprintf(stderr, "kernel_launch: phase %d launch failed: %s\n", PH, hipGetErrorName(e));
}
extern "C" void kernel_launch(void* const* d_in, const int* in_sizes, int n_in, void* d_out, int out_size, void* d_ws, size_t ws_size, hipStream_t stream) {
    static int grid = 0;
    if (grid == 0) { int dev = 0, cus = 0; if (hipGetDevice(&dev) != hipSuccess || hipDeviceGetAttribute(&cus, hipDeviceAttributeMultiprocessorCount, dev) != hipSuccess || cus < 1) cus = 256; grid = cus; }
    if (n_in != N_INPUTS || out_size != NB * T * D || ws_size < WS_END) {
        fprintf(stderr, "kernel_launch: unexpected shapes: n_in %d out %d ws %zu (need %zu)\n", n_in, out_size, ws_size, (size_t)WS_END);
        hipLaunchKernelGGL(k_fill, dim3(1024), dim3(256), 0, stream, (float*)d_out, (size_t)out_size, (float)(ws_size >> 20));
        return;
    }
    Args a{};
    for (int i = 0; i < N_INPUTS; ++i) a.in[i] = (const float*)d_in[i];
    a.out = (float*)d_out; a.ws = (unsigned char*)d_ws; a.layer = 0; a.ph_lo = 0; a.ph_hi = 0; a.pad = 0;
#if MK_SINGLE
    {
        static bool attr = false;
        if (!attr) { if (hipFuncSetAttribute((const void*)k_all, hipFuncAttributeMaxDynamicSharedMemorySize, LDS_BYTES) != hipSuccess) fprintf(stderr, "kernel_launch: hipFuncSetAttribute failed\n");
            int per_cu = 0; if (hipOccupancyMaxActiveBlocksPerMultiprocessor(&per_cu, (const void*)k_all, NTHR, LDS_BYTES) != hipSuccess || per_cu < 1) fprintf(stderr, "kernel_launch: occupancy query says %d blocks per CU\n", per_cu);
            (void)hipGetLastError(); attr = true; }
        if (hipMemsetAsync((char*)d_ws + WS_CTL, 0, CTL_ZERO_BYTES, stream) != hipSuccess) { fprintf(stderr, "kernel_launch: memset failed\n"); return; }
        hipLaunchKernelGGL(k_all, dim3(grid), dim3(NTHR), LDS_BYTES, stream, a);
        const hipError_t e = hipPeekAtLastError(); if (e != hipSuccess) fprintf(stderr, "kernel_launch: launch failed: %s\n", hipGetErrorName(e));
        return;
    }
#endif
    launch_phase<PH_PRO>(a, 0, grid, stream);
    launch_phase<PH_MODFIN>(a, 0, grid, stream);
    for (int l = 0; l < 2; ++l) {
        launch_phase<PH_N1>(a, l, grid, stream); launch_phase<PH_GA>(a, l, grid, stream); launch_phase<PH_ATT>(a, l, grid, stream); launch_phase<PH_GB>(a, l, grid, stream);
        launch_phase<PH_SA>(a, l, grid, stream); launch_phase<PH_SB>(a, l, grid, stream); launch_phase<PH_SC>(a, l, grid, stream);
        launch_phase<PH_OG>(a, l, grid, stream); launch_phase<PH_MG>(a, l, grid, stream);
        launch_phase<PH_WO>(a, l, grid, stream); launch_phase<PH_N2>(a, l, grid, stream); launch_phase<PH_UP>(a, l, grid, stream); launch_phase<PH_FIX>(a, l, grid, stream);
        launch_phase<PH_DN>(a, l, grid, stream);
    }
}
```

```cpp
#include <hip/hip_runtime.h>
#include <cstdio>
#include <cstdint>
namespace pg8 {
#define PG8_LAS __attribute__((address_space(3)))
typedef unsigned short bf16_t;
typedef short bf16x8 __attribute__((ext_vector_type(8)));
typedef float f32x4 __attribute__((ext_vector_type(4)));
typedef unsigned u32x4 __attribute__((ext_vector_type(4)));
constexpr int BM = 256, BK = 64, HALF = 128, HTB = HALF * BK * 2  , STAGE_BYTES = 8 * HTB, NXCD = 8, WGM = 8;

__host__ __device__ __forceinline__ int lds_byte(int r, int c) { const int st = (r >> 4) * 2 + (c >> 5), rr = r & 15, cc = c & 31, ob = rr * 64 + cc * 2; return st * 1024 + (ob ^ (((ob >> 9) & 1) << 5)); }
__host__ __device__ __forceinline__ void stage_rc(int b, int& R, int& C) { const int st = b / 1024, sb = b % 1024, swz = sb ^ (((sb >> 9) & 1) << 5); R = (st >> 1) * 16 + swz / 64; C = (st & 1) * 32 + (swz % 64) / 2; }
__host__ __device__ __forceinline__ int perm32(int rho) { const int n = rho >> 4, i = rho & 15; return 8 * (i >> 2) + 4 * n + (i & 3); }

struct Unit { int pm, pn; };
struct Gemm { const bf16_t* A; const bf16_t* Bt; int M, N, K; };

struct StaticOrder {
    int nM, nN, nwg, G, c, wgm;
    __host__ __device__ void init(int M, int N, int G_, int c_) { nM = M / BM; nN = N / BM; nwg = nM * nN; G = G_; c = c_; wgm = WGM; }
    __host__ __device__ bool next(int i, Unit& u) const {
        const long L = (long)i * G + c; if (L >= nwg) return false;
        int wgid = (int)L; { const int q = nwg / NXCD, r = nwg % NXCD, xcd = wgid % NXCD, off = wgid / NXCD; wgid = (xcd < r ? xcd * (q + 1) : r * (q + 1) + (xcd - r) * q) + off; }
        const int nig = wgm * nN, gid = wgid / nig, fm = gid * wgm, gsz = (nM - fm) < wgm ? (nM - fm) : wgm;
        u.pm = fm + ((wgid % nig) % gsz); u.pn = (wgid % nig) / gsz; return true;
    }
    __device__ __forceinline__ void a_ready(const Unit&) const {}
    __device__ __forceinline__ void done(const Unit&) const {}
};
template <int NN, int WG> struct TileOrder {
    int nM, G;
    __host__ __device__ void init(int M, int, int G_, int) { nM = M / BM; G = G_; }
    __device__ __forceinline__ bool next(int i, Unit& u) const {
        const int nwg = nM * NN; const long L = (long)i * G + (int)blockIdx.x; if (L >= nwg) return false;
        constexpr int gsz = WG * NN; const int share = ((nwg / NXCD) / gsz) * gsz;
        int wgid = (int)L; if (wgid < NXCD * share) wgid = (wgid % NXCD) * share + wgid / NXCD;
        const int gid = wgid / gsz, fm = gid * WG, gh = (nM - fm) < WG ? (nM - fm) : WG, in = wgid - gid * gsz;
        u.pm = fm + in % gh; u.pn = in / gh; return true;
    }
    __device__ __forceinline__ void a_ready(const Unit&) const {}
    __device__ __forceinline__ void done(const Unit&) const {}
};
struct CountedOrder : StaticOrder {
    const unsigned* ready; unsigned need; unsigned* tmo;
    __device__ __forceinline__ void a_ready(const Unit& u) const {
        if (threadIdx.x < 64) {
            const unsigned long long t0 = __builtin_amdgcn_s_memrealtime(); unsigned polls = 0;
            while ((unsigned)__builtin_amdgcn_readfirstlane(__hip_atomic_load(ready + 64 * u.pm, __ATOMIC_RELAXED, __HIP_MEMORY_SCOPE_AGENT)) < need) {
                if ((++polls & 255u) == 0u && __builtin_amdgcn_readfirstlane(__hip_atomic_load(tmo, __ATOMIC_RELAXED, __HIP_MEMORY_SCOPE_AGENT)) != 0u) break;
                if (__builtin_amdgcn_s_memrealtime() - t0 > 2000000ull) {
                    if (threadIdx.x == 0) { unsigned expect = 0u; __hip_atomic_compare_exchange_strong(tmo + 1, &expect, 0x600u | (unsigned)(u.pm & 0xff), __ATOMIC_RELAXED, __ATOMIC_RELAXED, __HIP_MEMORY_SCOPE_AGENT); __hip_atomic_store(tmo, 1u, __ATOMIC_RELAXED, __HIP_MEMORY_SCOPE_AGENT); }
                    break; }
                __builtin_amdgcn_s_sleep(2); }
            __builtin_amdgcn_fence(__ATOMIC_ACQUIRE, "agent");
            asm volatile("s_waitcnt vmcnt(0)" ::: "memory");
        }
#if !defined(BROKEN_HOOK_NO_BARRIER)
        asm volatile("" ::: "memory"); __builtin_amdgcn_s_barrier(); asm volatile("" ::: "memory");
#endif
    }
};

template <class T, class = void> struct keeps_acc { static constexpr bool value = false; };
template <class T> struct keeps_acc<T, decltype((void)T::KEEPS_ACC)> { static constexpr bool value = true; };
template <class Epi, class Sched, bool STAMP = false>
__device__ __forceinline__ void gemm_phase(PG8_LAS unsigned char* lds, const Gemm g, const Sched& S, const Epi& E, unsigned long long* stamps) {
    int tid_ = threadIdx.x; asm volatile("" : "+v"(tid_));
    const int tid = tid_, wid = __builtin_amdgcn_readfirstlane(tid >> 6), lane = tid & 63, wr = wid >> 2, wc = wid & 3, fr = lane & 15, fq = lane >> 4;
    const int K = g.K, nt = K / BK;
    int ts_lo = 0, ts_hi = 0, nts = 0; const unsigned long long rt_entry = STAMP ? (unsigned long long)wall_clock64() : 0ull;
#define PG8_STAMP() do { if (STAMP && wid == 0 && nts < 64) { const unsigned long long _c = (unsigned long long)clock64(); \
        ts_lo = (lane == nts) ? (int)(unsigned)_c : ts_lo; ts_hi = (lane == nts) ? (int)(unsigned)(_c >> 32) : ts_hi; ++nts; } } while (0)
    PG8_STAMP();
    unsigned voffA[2], voffB[2];
#pragma unroll
    for (int i = 0; i < 2; ++i) { int R, C; stage_rc(tid * 16 + i * 8192, R, C); const int Rb = Epi::PERM ? ((R & ~31) + perm32(R & 31)) : R;
        voffA[i] = (unsigned)(R * K + C) * 2u; voffB[i] = (unsigned)(Rb * K + C) * 2u; }
    const size_t kstep = (size_t)(BK * 2);
    const size_t hstep = (size_t)HALF * K * 2;
    const size_t tstep = 2 * hstep;
    const unsigned ldsw = (unsigned)wid * 1024u;
    const int aoff = lds_byte(wr * 64 + fr, fq * 8), boff = lds_byte(wc * 32 + fr, fq * 8);
#define PG8_SA(b, h) (((b) * 2 + (h)) * HTB)
#define PG8_SB(b, h) ((4 + (b) * 2 + (h)) * HTB)
#define PG8_STAGE(bufoff, gbase, voff) do { const char* g_ = (const char*)(gbase); asm volatile("" : "+s"(g_));     \
        _Pragma("unroll") for (int _i = 0; _i < 2; ++_i) { asm volatile("" : "+v"((voff)[_i]));                         \
        __builtin_amdgcn_global_load_lds((const unsigned*)(g_ + (voff)[_i]), (PG8_LAS unsigned*)(lds + (bufoff) + ldsw + _i * 8192), 16, 0, 0); } } while (0)
#define PG8_LDA(dst, b, h) do { _Pragma("unroll") for (int m = 0; m < 4; ++m) _Pragma("unroll") for (int k = 0; k < 2; ++k) dst[m][k] = *(const PG8_LAS bf16x8*)(lds + PG8_SA(b, h) + aoff + m * 2048 + k * 1024); } while (0)
#define PG8_LDB(dst, b, h) do { _Pragma("unroll") for (int n = 0; n < 2; ++n) _Pragma("unroll") for (int k = 0; k < 2; ++k) dst[n][k] = *(const PG8_LAS bf16x8*)(lds + PG8_SB(b, h) + boff + n * 2048 + k * 1024); } while (0)
#define PG8_MMA(ai, bj, At, Bt) do { __builtin_amdgcn_s_setprio(1); _Pragma("unroll") for (int m = 0; m < 4; ++m) _Pragma("unroll") for (int n = 0; n < 2; ++n) _Pragma("unroll") for (int k = 0; k < 2; ++k) \
        acc[ai][bj][m][n] = __builtin_amdgcn_mfma_f32_16x16x32_bf16(Bt[n][k], At[m][k], acc[ai][bj][m][n], 0, 0, 0); __builtin_amdgcn_s_setprio(0); } while (0)
#define PG8_WAIT_V(n) asm volatile("s_waitcnt vmcnt(" #n ")" ::: "memory")
#define PG8_WAIT_L(n) asm volatile("s_waitcnt lgkmcnt(" #n ")" ::: "memory")
#define PG8_BAR __builtin_amdgcn_s_barrier()
#define PG8_SCHED __builtin_amdgcn_sched_barrier(0)
    Unit cur, nxt; int ui = 0;
    if (!S.next(0, cur)) return;
    f32x4 acc[2][2][4][2];
#pragma unroll
    for (int a = 0; a < 2; ++a)
#pragma unroll
        for (int b = 0; b < 2; ++b)
#pragma unroll
            for (int m = 0; m < 4; ++m)
#pragma unroll
                for (int n = 0; n < 2; ++n) acc[a][b][m][n] = (f32x4){0.f, 0.f, 0.f, 0.f};
    bf16x8 At[4][2], B0[2][2], B1[2][2];
    const char* cA = (const char*)g.A + (size_t)cur.pm * tstep; const char* cB = (const char*)g.Bt + (size_t)cur.pn * tstep;
    S.a_ready(cur);
    PG8_STAGE(PG8_SB(0, 0), cB, voffB); PG8_STAGE(PG8_SA(0, 0), cA, voffA); PG8_STAGE(PG8_SB(0, 1), cB + hstep, voffB); PG8_STAGE(PG8_SA(0, 1), cA + hstep, voffA);
    if (wr == 1) PG8_BAR;
    PG8_WAIT_V(4); PG8_BAR;
    PG8_STAGE(PG8_SB(1, 0), cB + kstep, voffB); PG8_STAGE(PG8_SA(1, 0), cA + kstep, voffA); PG8_STAGE(PG8_SB(1, 1), cB + hstep + kstep, voffB);
    PG8_WAIT_V(6); PG8_BAR;
    PG8_STAMP();
    for (;;) {
        const bool has_next = S.next(ui + 1, nxt);
        const char* nA = has_next ? (const char*)g.A + (size_t)nxt.pm * tstep : cA; const char* nB = has_next ? (const char*)g.Bt + (size_t)nxt.pn * tstep : cB;
        for (int t = 0; t < nt; t += 2) {
            const bool last = (t == nt - 2);
            const char* a1 = cA + (size_t)(t + 1) * kstep;
            const char* a2 = last ? nA : cA + (size_t)(t + 2) * kstep; const char* b2 = last ? nB : cB + (size_t)(t + 2) * kstep;
            const char* a3 = a2 + kstep; const char* b3 = b2 + kstep;
            if (last && has_next) S.a_ready(nxt);
            PG8_LDB(B0, 0, 0); PG8_SCHED; PG8_LDA(At, 0, 0); PG8_STAGE(PG8_SA(1, 1), a1 + hstep, voffA);
            PG8_WAIT_L(8); PG8_BAR; PG8_WAIT_L(0); PG8_MMA(0, 0, At, B0); PG8_BAR; PG8_SCHED;
            PG8_LDB(B1, 0, 1); PG8_STAGE(PG8_SB(0, 0), b2, voffB);
            PG8_BAR; PG8_WAIT_L(0); PG8_MMA(0, 1, At, B1); PG8_BAR;
            PG8_LDA(At, 0, 1); PG8_STAGE(PG8_SA(0, 0), a2, voffA);
            PG8_BAR; PG8_WAIT_L(0); PG8_MMA(1, 0, At, B0); PG8_BAR; PG8_SCHED;
            PG8_STAGE(PG8_SB(0, 1), b2 + hstep, voffB);
            PG8_WAIT_V(6); PG8_BAR; PG8_MMA(1, 1, At, B1); PG8_BAR;
            PG8_LDB(B0, 1, 0); PG8_SCHED; PG8_LDA(At, 1, 0); PG8_STAGE(PG8_SA(0, 1), a2 + hstep, voffA);
            PG8_WAIT_L(8); PG8_BAR; PG8_WAIT_L(0); PG8_MMA(0, 0, At, B0); PG8_BAR; PG8_SCHED;
            PG8_LDB(B1, 1, 1); PG8_STAGE(PG8_SB(1, 0), b3, voffB);
            PG8_BAR; PG8_WAIT_L(0); PG8_MMA(0, 1, At, B1); PG8_BAR;
            PG8_LDA(At, 1, 1); PG8_STAGE(PG8_SA(1, 0), a3, voffA);
            PG8_BAR; PG8_WAIT_L(0); PG8_MMA(1, 0, At, B0); PG8_BAR; PG8_SCHED;
            PG8_STAGE(PG8_SB(1, 1), b3 + hstep, voffB);
            PG8_WAIT_V(6); PG8_BAR; PG8_MMA(1, 1, At, B1); PG8_BAR;
        }
        PG8_STAMP();
        if constexpr (!Epi::AFTER_DRAIN) { E(acc, cur, wr, wc, fr, fq); S.done(cur); }
        PG8_STAMP();
        if (!has_next) break;
        bool keep_acc = false;
        if constexpr (keeps_acc<Epi>::value) keep_acc = S.keep(ui);
        if (!keep_acc) {
#pragma unroll
        for (int a = 0; a < 2; ++a)
#pragma unroll
            for (int b = 0; b < 2; ++b)
#pragma unroll
                for (int m = 0; m < 4; ++m)
#pragma unroll
                    for (int n = 0; n < 2; ++n) acc[a][b][m][n] = (f32x4){0.f, 0.f, 0.f, 0.f};
        }
        cur = nxt; cA = nA; cB = nB; ++ui;
    }
    PG8_WAIT_V(0);
    if (wr == 0) PG8_BAR;
    PG8_BAR;
    if constexpr (Epi::AFTER_DRAIN) { E.fused(acc, cur, wr, wc, fr, fq, lds, wid, lane); S.done(cur); }
    PG8_STAMP();
    if (STAMP && wid == 0) { stamps[lane] = lane < nts ? (((unsigned long long)(unsigned)ts_hi << 32) | (unsigned)ts_lo) : 0ull;
        if (lane == 62) stamps[62] = rt_entry; if (lane == 63) stamps[63] = (unsigned long long)wall_clock64(); }
#undef PG8_STAMP
#undef PG8_SA
#undef PG8_SB
#undef PG8_STAGE
#undef PG8_LDA
#undef PG8_LDB
#undef PG8_MMA
#undef PG8_WAIT_V
#undef PG8_WAIT_L
#undef PG8_BAR
#undef PG8_SCHED
}
}

#define GAS __attribute__((address_space(1)))
#define LAS __attribute__((address_space(3)))
typedef unsigned short bf16_t;
typedef short bf16x8 __attribute__((ext_vector_type(8)));
typedef short s16x4 __attribute__((ext_vector_type(4)));
typedef float f32x4 __attribute__((ext_vector_type(4)));
typedef float f32x2 __attribute__((ext_vector_type(2)));
typedef float f32x16 __attribute__((ext_vector_type(16)));
typedef unsigned u32x4 __attribute__((ext_vector_type(4)));
typedef unsigned u32x2 __attribute__((ext_vector_type(2)));

typedef __bf16 bf16x2_t __attribute__((ext_vector_type(2)));
__device__ __forceinline__ unsigned cvtpk_c(float lo, float hi) { const f32x2 v = {lo, hi}; return __builtin_bit_cast(unsigned, __builtin_convertvector(v, bf16x2_t)); }
__device__ __forceinline__ unsigned cvtpk(float lo, float hi) { unsigned r; asm volatile("v_cvt_pk_bf16_f32 %0, %1, %2" : "=v"(r) : "v"(lo), "v"(hi)); return r; }
__device__ __forceinline__ float bf2f(unsigned short b) { return __uint_as_float(((unsigned)b) << 16); }
__device__ __forceinline__ float bflo(unsigned w) { return __uint_as_float(w << 16); }
__device__ __forceinline__ float bfhi(unsigned w) { return __uint_as_float(w & 0xffff0000u); }
__device__ __forceinline__ float wave_sum(float v) {
#pragma unroll
    for (int o = 1; o < 64; o <<= 1) v += __shfl_xor(v, o);
    return v;
}
__device__ __forceinline__ float sigmoidf_(float x) { return __builtin_amdgcn_rcpf(1.0f + __builtin_amdgcn_exp2f(-1.4426950408889634f * x)); }
__device__ __forceinline__ float siluf_(float x) { return x * __builtin_amdgcn_rcpf(1.0f + __builtin_amdgcn_exp2f(-1.4426950408889634f * x)); }

#define XB_TMO      128
#define XB_XCNT(j)  (256  + 64 * (j))
#define XB_XSUB(j)  (1280 + 64 * (j))
#define XB_XGEN(j)  (2304 + 64 * (j))
#define XB_TOP      3328
#define XB_TOPGEN   3392
#define XCD_BAR_WORDS 3456
#define XB_SPIN_CAP (1u << 18)

__device__ __forceinline__ unsigned xb_ld(unsigned* p)              { return __hip_atomic_load(p, __ATOMIC_RELAXED, __HIP_MEMORY_SCOPE_AGENT); }
__device__ __forceinline__ unsigned xb_add(unsigned* p, unsigned v) { return __hip_atomic_fetch_add(p, v, __ATOMIC_RELAXED, __HIP_MEMORY_SCOPE_AGENT); }
__device__ __forceinline__ unsigned xb_xcc_id() { return (unsigned)__builtin_amdgcn_s_getreg((3 << 11) | 20) & 0xFu; }
#define XB_SPIN(cond, bar) do { unsigned _sp = 0; while (cond) { __builtin_amdgcn_s_sleep(1); \
    if ((++_sp & 255u) == 0u) { if (xb_ld(&(bar)[XB_TMO])) break; if (_sp > XB_SPIN_CAP) { atomicAdd(&(bar)[XB_TMO], 1u); break; } } } } while (0)

struct XcdBarrier {
    unsigned* bar; unsigned x;
    volatile LAS unsigned* st;
};
__device__ __forceinline__ XcdBarrier xcd_barrier_post(unsigned* bar, volatile LAS unsigned* st) {
    XcdBarrier b; b.bar = bar; b.x = xb_xcc_id(); b.st = st;
    if (threadIdx.x == 0) (void)xb_add(&bar[XB_XCNT(b.x)], 1u);
    return b;
}
__device__ __forceinline__ void xcd_barrier_complete(unsigned* bar, unsigned x, unsigned& nloc, unsigned& nx) {
    const unsigned G = gridDim.x * gridDim.y * gridDim.z;
    unsigned sum, cnt, mine, sp = 0u;
    for (;;) {
        sum = 0u; cnt = 0u; mine = 0u;
#pragma unroll
        for (unsigned j = 0; j < 16; ++j) { const unsigned c = xb_ld(&bar[XB_XCNT(j)]); sum += c; cnt += (c > 0u) ? 1u : 0u; mine = (j == x) ? c : mine; }
        if (sum == G) break;
        __builtin_amdgcn_s_sleep(1);
        if ((++sp & 255u) == 0u) { if (xb_ld(&bar[XB_TMO])) break; if (sp > XB_SPIN_CAP) { atomicAdd(&bar[XB_TMO], 1u); break; } }
    }
    nloc = mine > 0u ? mine : 1u; nx = cnt > 0u ? cnt : 1u;
}
__device__ __forceinline__ void xcd_barrier(const XcdBarrier& b) {
    asm volatile("s_waitcnt vmcnt(0)" ::: "memory");
    __syncthreads();
    if (threadIdx.x == 0) {
        unsigned* bar = b.bar;
        __builtin_amdgcn_s_waitcnt(0);
        unsigned nloc = b.st[0], nx = b.st[1];
        if (nloc == 0u) { xcd_barrier_complete(bar, b.x, nloc, nx); b.st[0] = nloc; b.st[1] = nx; }
        const unsigned old = xb_add(&bar[XB_XSUB(b.x)], 1u);
        const unsigned gen = old / nloc;
        if (old + 1u == (gen + 1u) * nloc) {
            __builtin_amdgcn_fence(__ATOMIC_RELEASE, "agent");
            asm volatile("s_waitcnt vmcnt(0)" ::: "memory");
            const unsigned og = xb_add(&bar[XB_TOP], 1u);
            const unsigned tg = og / nx;
            if (og + 1u == (tg + 1u) * nx) xb_add(&bar[XB_TOPGEN], 1u);
            else XB_SPIN(xb_ld(&bar[XB_TOPGEN]) == tg, bar);
            __builtin_amdgcn_fence(__ATOMIC_ACQUIRE, "agent");
            xb_add(&bar[XB_XGEN(b.x)], 1u);
            asm volatile("s_waitcnt vmcnt(0)" ::: "memory");
        } else {
            XB_SPIN(xb_ld(&bar[XB_XGEN(b.x)]) == gen, bar);
            __builtin_amdgcn_fence(__ATOMIC_ACQUIRE, "agent");
            asm volatile("s_waitcnt vmcnt(0)" ::: "memory");
        }
    }
    __syncthreads();
}

constexpr int D = 2048, NB = 2, T = 16384, LC = 256, TT = T + LC  , MR = NB * TT  ;
constexpr int NPAN = MR / 256  , PPB = TT / 256  ;
constexpr int NIN = 17408, DFF = 5504, NUP = 2 * DFF;
constexpr int NWAVES = 8, NTHR = 512;
constexpr float EPS = 1e-6f;
constexpr float LOG2E = 1.4426950408889634f;

enum { I_X = 0, I_C, I_CTX, I_CCTX, I_WMOD, I_BMOD, I_WIN, I_BGATE, I_QKN, I_LAMBDA, I_SUBLN, I_RNORM, I_GLB, I_GNORM, I_WBR, I_WOUT, I_WUP, I_CONVW, I_CONVB, I_WDOWN, N_INPUTS };

enum { TY_ROPE64 = 0, TY_ROPE128 = 1, TY_PLAIN = 2 };
enum { PT_DQ = 0, PT_DK = 4, PT_DV = 8, PT_RQ = 12, PT_RK = 14, PT_RV = 16, PT_GQ = 20, PT_GF = 24, PT_GB = 28, PT_GI = 32, PT_RG = 36, PT_GG = 40, PT_MA = 44, PT_MB = 52, PT_MC = 60, PT_END = 68 };
__host__ __device__ __forceinline__ int pt_logical_base(int pt) {
    if (pt < PT_RQ) return 256 * pt;
    if (pt < PT_RV) return 3072 + 256 * (pt - PT_RQ);
    if (pt < PT_GQ) return 4096 + 256 * (pt - PT_RV);
    if (pt < PT_RG) return 6144 + 256 * (pt - PT_GQ);
    if (pt < PT_GG) return 5120 + 256 * (pt - PT_RG);
    if (pt < PT_MA) return 10240 + 256 * (pt - PT_GG);
    return 11264 + 256 * (pt - PT_MA);
}
__host__ __device__ __forceinline__ int pt_type(int pt) { return pt < PT_DV ? TY_ROPE64 : (pt >= PT_RQ && pt < PT_RV) ? TY_ROPE128 : TY_PLAIN; }
__host__ __device__ __forceinline__ int perm_col(int type, int p) {
    const int bj = p >> 7, wc = (p >> 5) & 3, n = (p >> 4) & 1, fq = (p >> 2) & 3, e = p & 3;
    if (type == TY_ROPE64)  return 64 * wc + 32 * (fq >> 1) + 16 * bj + 8 * (fq & 1) + 4 * n + e;
    if (type == TY_ROPE128) return 128 * (wc >> 1) + 64 * (wc & 1) + 32 * bj + 8 * fq + 4 * n + e;
    return 64 * wc + 32 * bj + 8 * fq + 4 * n + e;
}
__host__ __device__ __forceinline__ int perm_col_up(int p) { const int bj = p >> 7, wc = (p >> 5) & 3, n = (p >> 4) & 1, fq = (p >> 2) & 3, e = p & 3; return 128 * bj + 32 * wc + 8 * fq + 4 * n + e; }

constexpr size_t MiB = 1u << 20;
constexpr size_t WS_CTL = 0, CTL_ZERO_BYTES = 1 * MiB;
constexpr size_t WS_MODP = 1 * MiB;
constexpr size_t WS_MODV = 6 * MiB;
constexpr size_t WS_ROPEA = 7 * MiB;
constexpr size_t WS_ROPEB = 7 * MiB + 64 * 1024;
constexpr size_t WS_LB = 7 * MiB + 256 * 1024;
constexpr size_t WS_SCAL = 7 * MiB + 512 * 1024;
constexpr size_t WS_XC = 9 * MiB;
constexpr size_t WS_WT = 13 * MiB;
constexpr size_t WT_IN = 0, WT_BR = 68 * MiB, WT_OUT = 80 * MiB, WT_UP = 88 * MiB, WT_DOWN = 131 * MiB;
constexpr size_t WS_H = 166 * MiB;
constexpr size_t WS_DYN = 296 * MiB;
constexpr size_t DY_OA = WS_DYN, DY_OB = WS_DYN + 65 * MiB, DY_OC = WS_DYN + 130 * MiB;
constexpr size_t DY_OSUB = WS_DYN + 195 * MiB;
constexpr size_t DY_US = DY_OSUB;
constexpr size_t DY_QKV = WS_DYN + 65 * MiB;
constexpr size_t DY_O1 = WS_DYN + 260 * MiB;
constexpr size_t DY_PC = WS_DYN + 325 * MiB;
constexpr size_t DY_PB = WS_DYN + 585 * MiB;
constexpr size_t DY_MG = WS_DYN + 325 * MiB;
constexpr size_t DY_Y = DY_OSUB, DY_YO = DY_OSUB;
constexpr size_t DY_G = WS_DYN, DY_RAW = WS_DYN + 350 * MiB;
constexpr size_t WS_END = WS_DYN + 715 * MiB;
constexpr size_t SZ_ROWS1K = (size_t)MR * 1024 * 2;

constexpr int CW_BAR = 4096;

constexpr int RING_BYTES = 131072, LDSCTL_OFF = RING_BYTES, MISC_OFF = LDSCTL_OFF + 320, LDS_BYTES = 147456;

struct Args { const float* in[N_INPUTS]; float* out; unsigned char* ws; int layer, ph_lo, ph_hi, pad; };

struct Frame {
    LAS unsigned char* lds;
    int tid, lane, wave, G, bid;
    const Args* a; unsigned char* ws;
};
__device__ __forceinline__ float* outp(const Frame& F) { GAS float* p = (GAS float*)F.a->out; asm volatile("" : "+s"(p)); return (float*)p; }
__device__ __forceinline__ const float* inp(const Frame& F, int i) { const GAS float* p = (const GAS float*)F.a->in[i]; asm volatile("" : "+s"(p)); return (const float*)p; }
__device__ __forceinline__ int opaque_tid() { int t = threadIdx.x; asm volatile("" : "+v"(t)); return t; }
__device__ __forceinline__ void frame_refresh(Frame& F) { GAS unsigned char* w_ = (GAS unsigned char*)F.a->ws; asm volatile("" : "+s"(w_)); F.ws = (unsigned char*)w_; F.tid = opaque_tid(); F.lane = F.tid & 63; F.wave = __builtin_amdgcn_readfirstlane(F.tid >> 6); }
#define WSP(T_, off) ((T_*)(F.ws + (off)))

__device__ __forceinline__ void p0_mod_partial(Frame& F) {
    LAS float* sv = (LAS float*)F.lds;
    for (int i = F.tid; i < 3 * D; i += NTHR) { const int v = i / D, k = i % D; const float c = v < 2 ? inp(F, I_C)[v * D + k] : inp(F, I_CCTX)[k]; sv[i] = siluf_(c); }
    __syncthreads();
    float* part = WSP(float, WS_MODP);
    const int total = 2 * 16 * 3072;
    for (int task = F.bid * NTHR + F.tid; task < total; task += F.G * NTHR) {
        const int q = task % 3072, ks = (task / 3072) % 16, l = task / (3072 * 16);
        const float* W = inp(F, I_WMOD) + ((size_t)l * D + ks * 128) * (6 * D) + q * 4;
        f32x4 a0 = {0, 0, 0, 0}, a1 = a0, a2 = a0;
#pragma unroll 8
        for (int k = 0; k < 128; ++k) { const f32x4 w = *(const f32x4*)(W + (size_t)k * (6 * D)); const float s0 = sv[ks * 128 + k], s1 = sv[D + ks * 128 + k], s2 = sv[2 * D + ks * 128 + k];
            a0 += w * s0; a1 += w * s1; a2 += w * s2; }
        float* o = part + ((size_t)(ks * 2 + l) * 3) * (6 * D) + q * 4;
        *(f32x4*)(o) = a0; *(f32x4*)(o + 6 * D) = a1; *(f32x4*)(o + 12 * D) = a2;
    }
    __syncthreads();
}
__device__ __forceinline__ void p0_tables(Frame& F) {
    const int gt = F.bid * NTHR + F.tid, NGT = F.G * NTHR;
    f32x2* ra = WSP(f32x2, WS_ROPEA); f32x2* rb = WSP(f32x2, WS_ROPEB);
    for (int i = gt; i < 256 * 16; i += NGT) { const int pos = i >> 4, f = i & 15; const float inv = powf(10000.0f, -(float)f / 16.0f); const float ang = (float)pos * inv; ra[i] = (f32x2){cosf(ang), sinf(ang)}; }
    for (int i = gt; i < 256 * 32; i += NGT) { const int pos = i >> 5, f = i & 31; const float inv = powf(10000.0f, -(float)f / 32.0f); const float ang = (float)pos * inv; rb[i] = (f32x2){cosf(ang), sinf(ang)}; }
    float* lb = WSP(float, WS_LB);
    for (int i = gt; i < 2 * 1024; i += NGT) { const float g0 = inp(F, I_GLB)[i], g1 = inp(F, I_GLB)[2048 + i]; const float m = fmaxf(g0, g1); const float e0 = expf(g0 - m), e1 = expf(g1 - m);
        lb[i] = 0.0f; lb[2048 + i] = e1 / (e0 + e1); }
    if (gt == 0) {
        float* sc = WSP(float, WS_SCAL);
        for (int l = 0; l < 2; ++l) {
            const float* al = inp(F, I_LAMBDA) + l * 256; float s1 = 0.f, s2 = 0.f;
            for (int i = 0; i < 64; ++i) { s1 += al[i] * al[64 + i]; s2 += al[128 + i] * al[192 + i]; }
            const float lam_init = 0.8f - 0.6f * expf(-0.3f * (float)l);
            sc[l] = expf(s1) - expf(s2) + lam_init;
            const float* g = inp(F, I_QKN) + l * 128; float mq = 0.f, mk = 0.f;
            for (int i = 0; i < 64; ++i) { mq = fmaxf(mq, fabsf(g[i])); mk = fmaxf(mk, fabsf(g[64 + i])); }
            sc[2 + l] = -(8.0f * mq * mk * 1.02f) * LOG2E;
        }
    }
}
__device__ __forceinline__ void convert_tile(Frame& F, const float* W, int N, int K, bf16_t* WT, int prow0, int k0, int base0, int base1, int ptype  ) {
    LAS float* t = (LAS float*)F.lds;
    { float wv[32];
#pragma unroll
      for (int i = 0; i < 32; ++i) { const int idx = i * NTHR + F.tid, kk = idx >> 8, c = idx & 255; const int col = c < 128 ? base0 + c : base1 + (c - 128);
          wv[i] = W[(size_t)(k0 + kk) * N + col]; }
#pragma unroll
      for (int i = 0; i < 32; ++i) { const int idx = i * NTHR + F.tid, kk = idx >> 8, c = idx & 255; t[kk * 257 + c] = wv[i]; } }
    __syncthreads();
#pragma unroll
    for (int i = 0; i < 4; ++i) { const int item = i * NTHR + F.tid, ch = item & 7, p = item >> 3; const int lc = ptype < 0 ? perm_col_up(p) : perm_col(ptype, p);
        const LAS float* s = t + (8 * ch) * 257 + lc;
        u32x4 o; o.x = cvtpk(s[0], s[257]); o.y = cvtpk(s[2 * 257], s[3 * 257]); o.z = cvtpk(s[4 * 257], s[5 * 257]); o.w = cvtpk(s[6 * 257], s[7 * 257]);
        *(u32x4*)(WT + (size_t)(prow0 + p) * K + k0 + 8 * ch) = o; }
    __syncthreads();
}
__device__ __forceinline__ void convert_weights(Frame& F, int l, int part = 0) {
    bf16_t* wt = WSP(bf16_t, WS_WT);
    constexpr int T_IN = 68 * 32, T_BR = 3 * 8 * 16, T_OUT = 8 * 32, T_UP = 43 * 32, T_DN = 8 * 86, T_ALL = T_IN + T_BR + T_OUT + T_UP + T_DN;
    const int c0 = (part == 1 && F.G > 32) ? 16 : 0, first = (part == 2) ? T_ALL - T_DN : 0, last = (part == 1) ? T_ALL - T_DN : T_ALL;
    if (F.bid < c0) return;
    for (int it = first + F.bid - c0; it < last; it += F.G - c0) {
        int r = it;
        if (r < T_IN) { const int pt = r / 32, kb = r % 32; const int lb = pt_logical_base(pt);
            convert_tile(F, inp(F, I_WIN) + (size_t)l * D * NIN, NIN, D, wt + WT_IN / 2, pt * 256, kb * 64, lb, lb + 128, pt_type(pt)); continue; } r -= T_IN;
        if (r < T_BR) { const int n = r / 128, pt = (r % 128) / 16, kb = r % 16;
            convert_tile(F, inp(F, I_WBR) + ((size_t)l * 3 + n) * 1024 * D, D, 1024, wt + WT_BR / 2 + (size_t)n * D * 1024, pt * 256, kb * 64, pt * 256, pt * 256 + 128, TY_PLAIN); continue; } r -= T_BR;
        if (r < T_OUT) { const int pt = r / 32, kb = r % 32;
            convert_tile(F, inp(F, I_WOUT) + (size_t)l * D * D, D, D, wt + WT_OUT / 2, pt * 256, kb * 64, pt * 256, pt * 256 + 128, TY_PLAIN); continue; } r -= T_OUT;
        if (r < T_UP) { const int pt = r / 32, kb = r % 32;
            convert_tile(F, inp(F, I_WUP) + (size_t)l * D * NUP, NUP, D, wt + WT_UP / 2, pt * 256, kb * 64, pt * 128, DFF + pt * 128, -1); continue; } r -= T_UP;
        { const int pt = r / 86, kb = r % 86;
            convert_tile(F, inp(F, I_WDOWN) + (size_t)l * DFF * D, D, DFF, wt + WT_DOWN / 2, pt * 256, kb * 64, pt * 256, pt * 256 + 128, TY_PLAIN); }
    }
}
__device__ __forceinline__ void p1_mod_final(Frame& F) {
    const float* part = WSP(float, WS_MODP); float* mv = WSP(float, WS_MODV);
    for (int i = F.bid * NTHR + F.tid; i < 2 * 3 * 6 * D; i += F.G * NTHR) { const int n = i % (6 * D), l = i / (3 * 6 * D);
        float s = inp(F, I_BMOD)[l * 6 * D + n];
#pragma unroll
        for (int ks = 0; ks < 16; ++ks) s += part[(size_t)ks * (2 * 3 * 6 * D) + i];
        mv[i] = s; }
}

__device__ __forceinline__ const float* xrow_src(Frame& F, int R, int use_inputs) {
    const int b = R / TT, t = R % TT;
    if (t < T) return (use_inputs ? inp(F, I_X) : (const float*)outp(F)) + ((size_t)b * T + t) * D;
    return (use_inputs ? inp(F, I_CTX) : (const float*)WSP(float, WS_XC)) + ((size_t)b * LC + (t - T)) * D;
}
__device__ __forceinline__ void norm_phase(Frame& F, int l, int which  ) {
    const int gw = F.bid * NWAVES + F.wave, NGW = F.G * NWAVES;
    bf16_t* h = WSP(bf16_t, WS_H); const float* mv = WSP(float, WS_MODV);
    const int use_inputs = (l == 0 && which == 0);
    f32x4 x[8], xn[8], sc1[8], sh[8]; int vcur = -1;
    if (gw < MR) { const f32x4* xr = (const f32x4*)xrow_src(F, gw, use_inputs) + F.lane;
#pragma unroll
        for (int j = 0; j < 8; ++j) x[j] = xr[64 * j]; }
    for (int R = gw; R < MR; R += NGW) {
        const int Rn = R + NGW;
        if (Rn < MR) { const f32x4* xr = (const f32x4*)xrow_src(F, Rn, use_inputs) + F.lane;
#pragma unroll
            for (int j = 0; j < 8; ++j) xn[j] = xr[64 * j]; }
        const int b = R / TT, t = R % TT, v = t < T ? b : 2;
        if (v != vcur) {
            const float* shift = mv + ((size_t)(l * 3 + v) * 6 + (which ? 3 : 0)) * D; const float* scale = shift + D;
#pragma unroll
            for (int j = 0; j < 8; ++j) { sc1[j] = *((const f32x4*)scale + F.lane + 64 * j) + 1.0f; sh[j] = *((const f32x4*)shift + F.lane + 64 * j); }
            vcur = v;
        }
        float ss = 0.f;
#pragma unroll
        for (int j = 0; j < 8; ++j) ss += (x[j].x * x[j].x + x[j].y * x[j].y) + (x[j].z * x[j].z + x[j].w * x[j].w);
        const float rstd = rsqrtf(wave_sum(ss) * (1.0f / D) + EPS);
        u32x2* o = (u32x2*)(h + (size_t)R * D) + F.lane;
#pragma unroll
        for (int j = 0; j < 8; ++j) { const f32x4 y = x[j] * rstd * sc1[j] + sh[j]; u32x2 w; w.x = cvtpk(y.x, y.y); w.y = cvtpk(y.z, y.w); o[64 * j] = w; }
#pragma unroll
        for (int j = 0; j < 8; ++j) x[j] = xn[j];
    }
}

typedef f32x4 acc_t[2][2][4][2];
__device__ __forceinline__ u32x4 pack8(const f32x4 a, const f32x4 b) { u32x4 w; w.x = cvtpk(a[0], a[1]); w.y = cvtpk(a[2], a[3]); w.z = cvtpk(b[0], b[1]); w.w = cvtpk(b[2], b[3]); return w; }

struct EpiIn {
    static constexpr bool PERM = false, AFTER_DRAIN = false;
    int pt0;
    bf16_t *rq, *r2, *r1;
    const float* qkn;
    const f32x2 *ropeA, *ropeB;
    __device__ __forceinline__ void operator()(const acc_t& acc, const pg8::Unit& u, int wr, int wc, int fr, int fq) const {
        const int pt = pt0 + u.pn, b = u.pm / PPB, tb = (u.pm % PPB) * 256 + wr * 64 + fr;
        if (pt < PT_DV) {
            const int isk = pt >= PT_DK, sh = 4 * (pt - (isk ? PT_DK : PT_DQ)) + wc, d0 = 32 * (fq >> 1) + 8 * (fq & 1);
            bf16_t* base = rq + (isk ? (size_t)MR * 1024 : (size_t)0) + ((size_t)(b * 16 + sh) * TT) * 64 + d0;
            const float* gp = qkn + isk * 64 + d0; const float osc = isk ? 1.0f : LOG2E * 0.125f;
            f32x4 g[2][2];
#pragma unroll
            for (int s = 0; s < 2; ++s)
#pragma unroll
                for (int n = 0; n < 2; ++n) g[s][n] = *(const f32x4*)(gp + 16 * s + 4 * n) * osc;
            const bool lat = (u.pm % PPB) != PPB - 1;
            f32x4 c0_[4], c1_[4], c2_[4];
#define R64_LD(buf, it) do { const int t = lat ? tb + ((it) >> 2) * 128 + ((it) & 3) * 16 : 0; const int pos = (fq < 2) ? (t >> 6) : (t & 63);                                              \
                const f32x4* rp = (const f32x4*)(ropeA + pos * 16 + 8 * (fq & 1)); _Pragma("unroll") for (int k = 0; k < 4; ++k) buf[k] = rp[k]; } while (0)
#define R64_DO(buf, it) do { constexpr int ai = (it) >> 2, m = (it) & 3; const int t = tb + ai * 128 + m * 16;                                                                                  \
                f32x4 x[2][2]; float ss = 0.f;                                                                                                                                                    \
                _Pragma("unroll") for (int s = 0; s < 2; ++s) _Pragma("unroll") for (int n = 0; n < 2; ++n) { x[s][n] = acc[ai][s][m][n];                                                         \
                    ss += (x[s][n][0] * x[s][n][0] + x[s][n][1] * x[s][n][1]) + (x[s][n][2] * x[s][n][2] + x[s][n][3] * x[s][n][3]); }                                                            \
                ss += __shfl_xor(ss, 16); ss += __shfl_xor(ss, 32);                                                                                                                               \
                const float rstd = rsqrtf(ss * (1.0f / 64.0f) + EPS);                                                                                                                             \
                _Pragma("unroll") for (int s = 0; s < 2; ++s) _Pragma("unroll") for (int n = 0; n < 2; ++n) x[s][n] = x[s][n] * rstd * g[s][n];                                                   \
                if (lat) { _Pragma("unroll") for (int n = 0; n < 2; ++n) { const f32x4 c01 = buf[2 * n], c23 = buf[2 * n + 1];               \
                    const f32x4 cs = {c01[0], c01[2], c23[0], c23[2]}, sn = {c01[1], c01[3], c23[1], c23[3]};                                                                                     \
                    const f32x4 u1 = x[0][n], u2 = x[1][n]; x[0][n] = u1 * cs - u2 * sn; x[1][n] = u1 * sn + u2 * cs; } }                                                                         \
                bf16_t* rowp = base + (size_t)t * 64;                                                                                                                                             \
                *(u32x4*)(rowp) = pack8(x[0][0], x[0][1]); *(u32x4*)(rowp + 16) = pack8(x[1][0], x[1][1]); } while (0)
            R64_LD(c0_, 0); R64_LD(c1_, 1); R64_LD(c2_, 2); R64_DO(c0_, 0); R64_LD(c0_, 3); R64_DO(c1_, 1); R64_LD(c1_, 4); R64_DO(c2_, 2); R64_LD(c2_, 5);
            R64_DO(c0_, 3); R64_LD(c0_, 6); R64_DO(c1_, 4); R64_LD(c1_, 7); R64_DO(c2_, 5); R64_DO(c0_, 6); R64_DO(c1_, 7);
#undef R64_LD
#undef R64_DO
        } else if (pt >= PT_RQ && pt < PT_RV) {
            const int isk = pt >= PT_RK, head = 2 * (pt - (isk ? PT_RK : PT_RQ)) + (wc >> 1), d0 = 64 * (wc & 1) + 8 * fq;
            bf16_t* base = r2 + (isk ? (size_t)MR * 512 : (size_t)0) + ((size_t)(b * 4 + head) * TT) * 128 + d0;
            const float osc = isk ? 0.08838834764831845f : 1.0f;
            const bool lat = (u.pm % PPB) != PPB - 1;
            f32x4 c0_[4], c1_[4], c2_[4];
#define R128_LD(buf, it) do { const int t = lat ? tb + ((it) >> 2) * 128 + ((it) & 3) * 16 : 0; const int pos = ((wc & 1) == 0) ? (t >> 6) : (t & 63);                                          \
                const f32x4* rp = (const f32x4*)(ropeB + pos * 32 + 8 * fq); _Pragma("unroll") for (int k = 0; k < 4; ++k) buf[k] = rp[k]; } while (0)
#define R128_DO(buf, it) do { constexpr int ai = (it) >> 2, m = (it) & 3; const int t = tb + ai * 128 + m * 16;                                                                                  \
                f32x4 x[2][2];                                                                                                                                                                    \
                _Pragma("unroll") for (int s = 0; s < 2; ++s) _Pragma("unroll") for (int n = 0; n < 2; ++n) x[s][n] = acc[ai][s][m][n] * osc;                                                     \
                if (lat) { _Pragma("unroll") for (int n = 0; n < 2; ++n) { const f32x4 c01 = buf[2 * n], c23 = buf[2 * n + 1];                                                                     \
                    const f32x4 cs = {c01[0], c01[2], c23[0], c23[2]}, sn = {c01[1], c01[3], c23[1], c23[3]};                                                                                     \
                    const f32x4 u1 = x[0][n], u2 = x[1][n]; x[0][n] = u1 * cs - u2 * sn; x[1][n] = u1 * sn + u2 * cs; } }                                                                         \
                bf16_t* rowp = base + (size_t)t * 128;                                                                                                                                            \
                *(u32x4*)(rowp) = pack8(x[0][0], x[0][1]); *(u32x4*)(rowp + 32) = pack8(x[1][0], x[1][1]); } while (0)
            R128_LD(c0_, 0); R128_LD(c1_, 1); R128_LD(c2_, 2); R128_DO(c0_, 0); R128_LD(c0_, 3); R128_DO(c1_, 1); R128_LD(c1_, 4); R128_DO(c2_, 2); R128_LD(c2_, 5);
            R128_DO(c0_, 3); R128_LD(c0_, 6); R128_DO(c1_, 4); R128_LD(c1_, 7); R128_DO(c2_, 5); R128_DO(c0_, 6); R128_DO(c1_, 7);
#undef R128_LD
#undef R128_DO
        } else {
            int pts, hd; bf16_t* sb;
            if (pt < PT_RQ) { sb = rq + (size_t)MR * 2048; pts = PT_DV; hd = 128; } else if (pt < PT_GQ) { sb = r2 + (size_t)MR * 1024; pts = PT_RV; hd = 256; }
            else { const int s4 = (pt - PT_GQ) >> 2; sb = r1 + (size_t)s4 * MR * 1024; pts = PT_GQ + 4 * s4; hd = 128; }
            const int c = 256 * (pt - pts) + 64 * wc + 8 * fq, head = c / hd, dim = c % hd, H = 1024 / hd;
            bf16_t* base = sb + ((size_t)(b * H + head) * TT) * hd + dim;
            const bool isq = (pt >= PT_GQ && pt < PT_GF);
#pragma unroll
            for (int ai = 0; ai < 2; ++ai)
#pragma unroll
                for (int m = 0; m < 4; ++m) {
                    const int t = tb + ai * 128 + m * 16; bf16_t* rowp = base + (size_t)t * hd;
#pragma unroll
                    for (int bj = 0; bj < 2; ++bj) { f32x4 a = acc[ai][bj][m][0], c2 = acc[ai][bj][m][1];
                        if (isq) {
#pragma unroll
                            for (int e = 0; e < 4; ++e) { a[e] = siluf_(a[e]) * 0.08838834764831845f; c2[e] = siluf_(c2[e]) * 0.08838834764831845f; } }
                        *(u32x4*)(rowp + 32 * bj) = pack8(a, c2); }
                }
        }
    }
};

struct EpiGates {
    static constexpr bool PERM = false, AFTER_DRAIN = false;
    bf16_t *oB, *oC, *G; const float* bias;
    __device__ __forceinline__ void operator()(const acc_t& acc, const pg8::Unit& u, int wr, int wc, int fr, int fq) const {
        const int R0 = u.pm * 256 + wr * 64 + fr;
        if (u.pn < 8) {
            bf16_t* o = (u.pn < 4 ? oB : oC) + 256 * (u.pn & 3) + 64 * wc + 8 * fq + (size_t)R0 * 1024;
            u32x4 wv[2][4][2];
#pragma unroll
            for (int ai = 0; ai < 2; ++ai)
#pragma unroll
                for (int m = 0; m < 4; ++m)
#pragma unroll
                    for (int bj = 0; bj < 2; ++bj) wv[ai][m][bj] = *(const u32x4*)(o + (size_t)(ai * 128 + m * 16) * 1024 + 32 * bj);
#pragma unroll
            for (int ai = 0; ai < 2; ++ai)
#pragma unroll
                for (int m = 0; m < 4; ++m) { bf16_t* rowp = o + (size_t)(ai * 128 + m * 16) * 1024;
#pragma unroll
                    for (int bj = 0; bj < 2; ++bj) { const u32x4 w = wv[ai][m][bj]; const f32x4 a = acc[ai][bj][m][0], c = acc[ai][bj][m][1];
                        const f32x4 r0 = {bflo(w.x) * siluf_(a[0]), bfhi(w.x) * siluf_(a[1]), bflo(w.y) * siluf_(a[2]), bfhi(w.y) * siluf_(a[3])};
                        const f32x4 r1 = {bflo(w.z) * siluf_(c[0]), bfhi(w.z) * siluf_(c[1]), bflo(w.w) * siluf_(c[2]), bfhi(w.w) * siluf_(c[3])};
                        *(u32x4*)(rowp + 32 * bj) = pack8(r0, r1); } }
        } else {
            const int t = u.pn - 8, n = t >> 3, c0 = 256 * (t & 7) + 64 * wc + 8 * fq;
            const float* bp = bias + n * D + c0; bf16_t* Gn = G + (size_t)n * MR * D + c0;
            f32x4 bv[2][2];
#pragma unroll
            for (int bj = 0; bj < 2; ++bj)
#pragma unroll
                for (int k = 0; k < 2; ++k) bv[bj][k] = *(const f32x4*)(bp + 32 * bj + 4 * k);
#pragma unroll
            for (int ai = 0; ai < 2; ++ai)
#pragma unroll
                for (int m = 0; m < 4; ++m) { bf16_t* rowp = Gn + (size_t)(R0 + ai * 128 + m * 16) * D;
#pragma unroll
                    for (int bj = 0; bj < 2; ++bj) { f32x4 a = acc[ai][bj][m][0] + bv[bj][0], c = acc[ai][bj][m][1] + bv[bj][1];
#pragma unroll
                        for (int e = 0; e < 4; ++e) { a[e] = fmaxf(sigmoidf_(a[e]), 7.888609052210118e-31f); c[e] = fmaxf(sigmoidf_(c[e]), 7.888609052210118e-31f); }
                        u32x4 w; w.x = cvtpk_c(a[0], a[1]); w.y = cvtpk_c(a[2], a[3]); w.z = cvtpk_c(c[0], c[1]); w.w = cvtpk_c(c[2], c[3]);
                        *(u32x4*)(rowp + 32 * bj) = w; } }
        }
    }
};
struct EpiProjAll {
    static constexpr bool PERM = false, AFTER_DRAIN = false, KEEPS_ACC = true;
    const bf16_t* G; bf16_t* y;
    __device__ __forceinline__ void operator()(acc_t& acc, const pg8::Unit& u, int wr, int wc, int fr, int fq) const {
        const int n = u.pm / NPAN, pm = u.pm - n * NPAN, pn = u.pn & 7;
        const int c0 = 256 * pn + 64 * wc + 8 * fq, R0 = pm * 256 + wr * 64 + fr;
        const bf16_t* Gn = G + (size_t)n * MR * D + (size_t)R0 * D + c0; const bf16_t* Gx = Gn + (size_t)MR * D;
        bf16_t* yp = y + (size_t)R0 * D + c0;
        u32x4 wa[4], xa[4], wb[4], xb[4];
#define PJ_LD(GW_, GX_, ai, bj) do { _Pragma("unroll") for (int m = 0; m < 4; ++m) { const size_t ro = (size_t)((ai) * 128 + m * 16) * D + 32 * (bj); GW_[m] = *(const u32x4*)(Gn + ro); GX_[m] = *(const u32x4*)(Gx + ro); } } while (0)
#define PJ_LD1(GW_, ai, bj) do { _Pragma("unroll") for (int m = 0; m < 4; ++m) { const size_t ro = (size_t)((ai) * 128 + m * 16) * D + 32 * (bj); GW_[m] = *(const u32x4*)(Gn + ro); } } while (0)
#define PJ_RATIO(GW_, GX_, ai, bj) do { _Pragma("unroll") for (int m = 0; m < 4; ++m) {                                                     \
            const float g[8] = {bflo(GW_[m].x), bfhi(GW_[m].x), bflo(GW_[m].y), bfhi(GW_[m].y), bflo(GW_[m].z), bfhi(GW_[m].z), bflo(GW_[m].w), bfhi(GW_[m].w)};            \
            const float d[8] = {bflo(GX_[m].x), bfhi(GX_[m].x), bflo(GX_[m].y), bfhi(GX_[m].y), bflo(GX_[m].z), bfhi(GX_[m].z), bflo(GX_[m].w), bfhi(GX_[m].w)};            \
            f32x4 r0 = acc[ai][bj][m][0], r1 = acc[ai][bj][m][1];                                                                                                         \
            _Pragma("unroll") for (int e = 0; e < 4; ++e) { r0[e] *= g[e] * __builtin_amdgcn_rcpf(d[e]); r1[e] *= g[4 + e] * __builtin_amdgcn_rcpf(d[4 + e]); }           \
            acc[ai][bj][m][0] = r0; acc[ai][bj][m][1] = r1; } } while (0)
#define PJ_FINAL(GW_, ai, bj) do { _Pragma("unroll") for (int m = 0; m < 4; ++m) {                                                           \
            const float g[8] = {bflo(GW_[m].x), bfhi(GW_[m].x), bflo(GW_[m].y), bfhi(GW_[m].y), bflo(GW_[m].z), bfhi(GW_[m].z), bflo(GW_[m].w), bfhi(GW_[m].w)};            \
            f32x4 r0 = acc[ai][bj][m][0], r1 = acc[ai][bj][m][1];                                                                                                         \
            _Pragma("unroll") for (int e = 0; e < 4; ++e) { r0[e] *= g[e]; r1[e] *= g[4 + e]; }                                                                           \
            *(u32x4*)(yp + (size_t)((ai) * 128 + m * 16) * D + 32 * (bj)) = pack8(r0, r1); } } while (0)
        if (n < 2) { PJ_LD(wa, xa, 0, 0); PJ_LD(wb, xb, 0, 1); PJ_RATIO(wa, xa, 0, 0); PJ_LD(wa, xa, 1, 0); PJ_RATIO(wb, xb, 0, 1); PJ_LD(wb, xb, 1, 1); PJ_RATIO(wa, xa, 1, 0); PJ_RATIO(wb, xb, 1, 1); }
        else { PJ_LD1(wa, 0, 0); PJ_LD1(wb, 0, 1); PJ_LD1(xa, 1, 0); PJ_LD1(xb, 1, 1); PJ_FINAL(wa, 0, 0); PJ_FINAL(wb, 0, 1); PJ_FINAL(xa, 1, 0); PJ_FINAL(xb, 1, 1); }
#undef PJ_LD
#undef PJ_LD1
#undef PJ_RATIO
#undef PJ_FINAL
    }
};
struct EpiRes {
    static constexpr bool PERM = false, AFTER_DRAIN = false;
    const float *srcx, *srcc; float *dstx, *dstc; const float* gate0;
    __device__ __forceinline__ void operator()(const acc_t& acc, const pg8::Unit& u, int wr, int wc, int fr, int fq) const {
        const int b = u.pm / PPB, lp = u.pm % PPB, c0 = 256 * u.pn + 64 * wc + 8 * fq, r0 = wr * 64 + fr;
        const bool isc = (lp == PPB - 1);
        const size_t rb = isc ? (size_t)(b * LC) : (size_t)(b * T + lp * 256);
        const float* s = (isc ? srcc : srcx) + (rb + r0) * D + c0; float* d = (isc ? dstc : dstx) + (rb + r0) * D + c0;
        const float* gp = gate0 + (size_t)(isc ? 2 : b) * 6 * D + c0;
        f32x4 gv[2][2];
#pragma unroll
        for (int bj = 0; bj < 2; ++bj)
#pragma unroll
            for (int n = 0; n < 2; ++n) gv[bj][n] = *(const f32x4*)(gp + 32 * bj + 4 * n);
        f32x4 sa[4][2], sb[4][2];
#define RES_LD(buf, ai, bj) do { _Pragma("unroll") for (int m = 0; m < 4; ++m) _Pragma("unroll") for (int n = 0; n < 2; ++n) buf[m][n] = *(const f32x4*)(s + (size_t)((ai) * 128 + m * 16) * D + 32 * (bj) + 4 * n); } while (0)
#define RES_ST(buf, ai, bj) do { _Pragma("unroll") for (int m = 0; m < 4; ++m) _Pragma("unroll") for (int n = 0; n < 2; ++n) *(f32x4*)(d + (size_t)((ai) * 128 + m * 16) * D + 32 * (bj) + 4 * n) = buf[m][n] + gv[bj][n] * acc[ai][bj][m][n]; } while (0)
        RES_LD(sa, 0, 0); RES_LD(sb, 0, 1); RES_ST(sa, 0, 0); RES_LD(sa, 1, 0); RES_ST(sb, 0, 1); RES_LD(sb, 1, 1); RES_ST(sa, 1, 0); RES_ST(sb, 1, 1);
#undef RES_LD
#undef RES_ST
    }
};
__device__ __forceinline__ float dpp_up1(float cur, float prev) {
    const int old = __builtin_amdgcn_mov_dpp(__float_as_int(prev), 0x121  , 0xf, 0xf, false);
    return __int_as_float(__builtin_amdgcn_update_dpp(old, __float_as_int(cur), 0x111  , 0xf, 0xf, false));
}
__device__ __forceinline__ float dpp_dn1(float cur, float next) {
    const int old = __builtin_amdgcn_mov_dpp(__float_as_int(next), 0x12F  , 0xf, 0xf, false);
    return __int_as_float(__builtin_amdgcn_update_dpp(old, __float_as_int(cur), 0x101  , 0xf, 0xf, false));
}
struct EpiConv {
    static constexpr bool PERM = false, AFTER_DRAIN = false;
    bf16_t* g; float* raw; const float* cw; const float* cb;
    __device__ __forceinline__ void operator()(const acc_t& acc, const pg8::Unit& u, int wr, int wc, int fr, int fq) const {
        const int jc = 128 * u.pn + 32 * wc + 8 * fq, R0 = u.pm * 256 + wr * 64 + fr;
        u32x2 keep[2][4];
        f32x4 cwv[2][8];
#pragma unroll
        for (int n = 0; n < 2; ++n) { const int j = jc + 4 * n;
            cwv[n][0] = *(const f32x4*)(cw + j); cwv[n][1] = *(const f32x4*)(cw + NUP + j); cwv[n][2] = *(const f32x4*)(cw + 2 * NUP + j); cwv[n][3] = *(const f32x4*)(cb + j);
            cwv[n][4] = *(const f32x4*)(cw + DFF + j); cwv[n][5] = *(const f32x4*)(cw + NUP + DFF + j); cwv[n][6] = *(const f32x4*)(cw + 2 * NUP + DFF + j); cwv[n][7] = *(const f32x4*)(cb + DFF + j); }
        const float m0 = (fr == 0) ? 1.0f : 0.0f, m15 = (fr == 15) ? 1.0f : 0.0f;
#define FMAC_DPP(y, x, w, CTRL) asm("v_fmac_f32_dpp %0, %1, %2 " CTRL " row_mask:0xf bank_mask:0xf bound_ctrl:1" : "+v"(y) : "v"(x), "v"(w))
#pragma unroll
        for (int n = 0; n < 2; ++n) {
            const int j = jc + 4 * n;
            const f32x4 wg0 = cwv[n][0], wg1 = cwv[n][1], wg2 = cwv[n][2], bg = cwv[n][3];
            const f32x4 wu0 = cwv[n][4], wu1 = cwv[n][5], wu2 = cwv[n][6], bu = cwv[n][7];
            const f32x4 wg0e = wg0 * m0, wg2e = wg2 * m15, wu0e = wu0 * m0, wu2e = wu2 * m15;
#pragma unroll
            for (int ai = 0; ai < 2; ++ai)
#pragma unroll
                for (int m = 0; m < 4; ++m) {
                    const f32x4 xg = acc[ai][0][m][n], xu = acc[ai][1][m][n];
                    const f32x4 pg = acc[ai][0][m > 0 ? m - 1 : 0][n], ng = acc[ai][0][m < 3 ? m + 1 : 3][n], pu = acc[ai][1][m > 0 ? m - 1 : 0][n], nu = acc[ai][1][m < 3 ? m + 1 : 3][n];
                    f32x4 yg, yu;
#pragma unroll
                    for (int e = 0; e < 4; ++e) {
                        float g_ = wg1[e] * xg[e] + bg[e], u_ = wu1[e] * xu[e] + bu[e];
                        { const float a0 = xg[e], a1 = pg[e], a2 = ng[e], c0 = wg0[e], c1 = wg0e[e], c2 = wg2[e], c3 = wg2e[e];
                          FMAC_DPP(g_, a0, c0, "row_shr:1"); FMAC_DPP(g_, a1, c1, "row_mirror"); FMAC_DPP(g_, a0, c2, "row_shl:1"); FMAC_DPP(g_, a2, c3, "row_mirror"); }
                        { const float a0 = xu[e], a1 = pu[e], a2 = nu[e], c0 = wu0[e], c1 = wu0e[e], c2 = wu2[e], c3 = wu2e[e];
                          FMAC_DPP(u_, a0, c0, "row_shr:1"); FMAC_DPP(u_, a1, c1, "row_mirror"); FMAC_DPP(u_, a0, c2, "row_shl:1"); FMAC_DPP(u_, a2, c3, "row_mirror"); }
                        yg[e] = g_; yu[e] = u_;
                    }
                    f32x4 r;
#pragma unroll
                    for (int e = 0; e < 4; ++e) r[e] = siluf_(yg[e]) * yu[e];
                    u32x2 pk; pk.x = cvtpk(r[0], r[1]); pk.y = cvtpk(r[2], r[3]);
                    if (n == 0) keep[ai][m] = pk;
                    else { u32x4 w; w.x = keep[ai][m].x; w.y = keep[ai][m].y; w.z = pk.x; w.w = pk.y; *(u32x4*)(g + (size_t)(R0 + ai * 128 + m * 16) * DFF + jc) = w; }
                    if ((m == 0 && fr < 2) || (m == 3 && fr >= 14)) {
                        const int slot = (m == 0) ? fr : fr - 12; float* rp = raw + ((size_t)(u.pm * 4 + ai * 2 + wr) * 4 + slot) * NUP + j;
                        *(f32x4*)(rp) = xg; *(f32x4*)(rp + DFF) = xu;
                    }
                }
        }
#undef FMAC_DPP
    }
};

namespace att {
constexpr int KVBLK = 64;
constexpr int SHM_V = 64 * 128 * 2, SHM_K = 64 * 64 * 2;
#define KSWZ64(row, colB) ((row) * 128 + ((colB) ^ ((((row) >> 1) & 7) << 4)))
#define SBAR() __builtin_amdgcn_sched_barrier(0)
__device__ __forceinline__ int crow(int r, int hi) { return (r & 3) + 8 * (r >> 2) + 4 * hi; }
template <int SK = 0> __device__ __forceinline__ void exp16(f32x16& p) {
    if (SK & 1) return;
#pragma unroll
    for (int r = 0; r < 16; ++r) p[r] = __builtin_amdgcn_exp2f(p[r]);
}
template <int BASE> __device__ __forceinline__ void exp8(f32x16& p) {
    float e[8];
#pragma unroll
    for (int r = 0; r < 8; ++r) e[r] = __builtin_amdgcn_exp2f(p[BASE + r]);
    asm volatile("" : "+v"(e[0]), "+v"(e[1]), "+v"(e[2]), "+v"(e[3]), "+v"(e[4]), "+v"(e[5]), "+v"(e[6]), "+v"(e[7]));
#pragma unroll
    for (int r = 0; r < 8; ++r) p[BASE + r] = e[r];
}
template <int SK = 0> __device__ __forceinline__ void finishSM(f32x16& p0, f32x16& p1, float& lsum, bf16x8& pa0, bf16x8& pa1, bf16x8& pa2, bf16x8& pa3) {
    if (SK & 8) { lsum += p0[0] + p1[0]; const unsigned c_ = cvtpk(p0[1], p1[1]); u32x4 w_ = {c_, c_, c_, c_}; pa0 = pa1 = pa2 = pa3 = *reinterpret_cast<bf16x8*>(&w_); return; }
    float ps = 0;
#pragma unroll
    for (int r = 0; r < 16; ++r) ps += p0[r];
#pragma unroll
    for (int r = 0; r < 16; ++r) ps += p1[r];
    lsum += ps;
#define PK4(P, BASE, OUT) do { unsigned a0 = cvtpk(P[BASE + 0], P[BASE + 1]), a1 = cvtpk(P[BASE + 2], P[BASE + 3]);   \
    unsigned b0 = cvtpk(P[BASE + 4], P[BASE + 5]), b1 = cvtpk(P[BASE + 6], P[BASE + 7]);                              \
    auto r0 = __builtin_amdgcn_permlane32_swap(a0, b0, false, false); auto r1 = __builtin_amdgcn_permlane32_swap(a1, b1, false, false); \
    u32x4 w = {r0[0], r1[0], r0[1], r1[1]}; OUT = *reinterpret_cast<bf16x8*>(&w); } while (0)
    PK4(p0, 0, pa0); PK4(p0, 8, pa1); PK4(p1, 0, pa2); PK4(p1, 8, pa3);
#undef PK4
}
template <int SK = 0> __device__ __forceinline__ void qkt(f32x16& p0, f32x16& p1, const LAS char* Ks, const bf16x8* qr, int r32, int hi, float negM) {
#pragma unroll
    for (int r = 0; r < 16; ++r) { p0[r] = 0.f; p1[r] = 0.f; }
    if (SK & 4) return;
#pragma unroll
    for (int d0 = 0; d0 < 4; ++d0) { const int cb = (d0 * 16 + hi * 8) * 2;
        const bf16x8 b0 = *(const LAS bf16x8*)(Ks + KSWZ64(r32, cb));
        const bf16x8 b1 = *(const LAS bf16x8*)(Ks + KSWZ64(32 + r32, cb));
        p0 = __builtin_amdgcn_mfma_f32_32x32x16_bf16(b0, qr[d0], p0, 0, 0, 0);
        p1 = __builtin_amdgcn_mfma_f32_32x32x16_bf16(b1, qr[d0], p1, 0, 0, 0); }
}
__device__ __forceinline__ int v_st(int k, int c) { const int kk = (k & ~0xC) | ((k & 4) << 1) | ((k & 8) >> 1); return ((kk >> 3) * 4 + (c >> 5)) * 512 + ((kk & 7) * 32 + (c & 31)) * 2; }
__device__ __forceinline__ int v_rd_base(int lane) { return ((lane & 3) << 3) | (((lane >> 2) & 3) << 6) | (((lane >> 4) & 1) << 5) | (((lane >> 5) & 1) << 8); }
constexpr int v_rd_off(int d0, int ks, int half) { return d0 * 512 + ks * 4096 + half * 2048; }
template <int OFF> __device__ __forceinline__ s16x4 tr_read(int vb) {
  s16x4 r; asm volatile("ds_read_b64_tr_b16 %0, %1 offset:%2" : "=&v"(r) : "v"(vb), "i"(OFF) : "memory"); return r;
}
template <int D0> __device__ __forceinline__ void pv_one(f32x16& od, int vb, bf16x8 pa0, bf16x8 pa1, bf16x8 pa2, bf16x8 pa3) {
  const s16x4 l0 = tr_read<v_rd_off(D0, 0, 0)>(vb), h0 = tr_read<v_rd_off(D0, 0, 1)>(vb), l1 = tr_read<v_rd_off(D0, 1, 0)>(vb), h1 = tr_read<v_rd_off(D0, 1, 1)>(vb);
  const s16x4 l2 = tr_read<v_rd_off(D0, 2, 0)>(vb), h2 = tr_read<v_rd_off(D0, 2, 1)>(vb), l3 = tr_read<v_rd_off(D0, 3, 0)>(vb), h3 = tr_read<v_rd_off(D0, 3, 1)>(vb);
  asm volatile("s_waitcnt lgkmcnt(0)" ::: "memory"); SBAR();
#define PK(L, H) (bf16x8){L[0], L[1], L[2], L[3], H[0], H[1], H[2], H[3]}
  od = __builtin_amdgcn_mfma_f32_32x32x16_bf16(pa0, PK(l0, h0), od, 0, 0, 0);
  od = __builtin_amdgcn_mfma_f32_32x32x16_bf16(pa1, PK(l1, h1), od, 0, 0, 0);
  od = __builtin_amdgcn_mfma_f32_32x32x16_bf16(pa2, PK(l2, h2), od, 0, 0, 0);
  od = __builtin_amdgcn_mfma_f32_32x32x16_bf16(pa3, PK(l3, h3), od, 0, 0, 0);
#undef PK
}
template <int SK = 0> __device__ __forceinline__ void pv_d0(f32x16* o, int vb, bf16x8 pa0, bf16x8 pa1, bf16x8 pa2, bf16x8 pa3) {
  if (SK & 2) { o[0][0] += __builtin_bit_cast(float, (int)pa0[0] << 16); return; }
  pv_one<0>(o[0], vb, pa0, pa1, pa2, pa3); pv_one<1>(o[1], vb, pa0, pa1, pa2, pa3); pv_one<2>(o[2], vb, pa0, pa1, pa2, pa3); pv_one<3>(o[3], vb, pa0, pa1, pa2, pa3);
}
#define ATT_WAITL(n) asm volatile("s_waitcnt lgkmcnt(" #n ")" ::: "memory")
template <int D0> __device__ __forceinline__ void readv(s16x4 (&v)[8], int vb) {
  v[0] = tr_read<v_rd_off(D0, 0, 0)>(vb); v[1] = tr_read<v_rd_off(D0, 0, 1)>(vb); v[2] = tr_read<v_rd_off(D0, 1, 0)>(vb); v[3] = tr_read<v_rd_off(D0, 1, 1)>(vb);
  v[4] = tr_read<v_rd_off(D0, 2, 0)>(vb); v[5] = tr_read<v_rd_off(D0, 2, 1)>(vb); v[6] = tr_read<v_rd_off(D0, 3, 0)>(vb); v[7] = tr_read<v_rd_off(D0, 3, 1)>(vb);
}
__device__ __forceinline__ void pvm(f32x16& od, const s16x4 (&v)[8], bf16x8 pa0, bf16x8 pa1, bf16x8 pa2, bf16x8 pa3) {
#define PK(L, H) (bf16x8){L[0], L[1], L[2], L[3], H[0], H[1], H[2], H[3]}
  od = __builtin_amdgcn_mfma_f32_32x32x16_bf16(pa0, PK(v[0], v[1]), od, 0, 0, 0);
  od = __builtin_amdgcn_mfma_f32_32x32x16_bf16(pa1, PK(v[2], v[3]), od, 0, 0, 0);
  od = __builtin_amdgcn_mfma_f32_32x32x16_bf16(pa2, PK(v[4], v[5]), od, 0, 0, 0);
  od = __builtin_amdgcn_mfma_f32_32x32x16_bf16(pa3, PK(v[6], v[7]), od, 0, 0, 0);
#undef PK
}
template <int SK, bool HASNEXT> __device__ __forceinline__ void tile_step(f32x16& pN0, f32x16& pN1, f32x16 (&o)[4], const bf16x8 (&qr)[4], float& lsum,
                                                                         const LAS char* ksn, int vbc, float negM, int r32, int hi) {
  bf16x8 kf0[4], kf1[4], pa0, pa1, pa2, pa3; s16x4 va[8], vc[8], vd[8];
  if (HASNEXT && !(SK & 4)) {
#pragma unroll
    for (int d0 = 0; d0 < 4; ++d0) { const int cb = (d0 * 16 + hi * 8) * 2; kf0[d0] = *(const LAS bf16x8*)(ksn + KSWZ64(r32, cb)); kf1[d0] = *(const LAS bf16x8*)(ksn + KSWZ64(32 + r32, cb)); }
  }
  SBAR();
  finishSM<SK>(pN0, pN1, lsum, pa0, pa1, pa2, pa3);
  SBAR();
  if (SK & 2) { o[0][0] += __builtin_bit_cast(float, (int)pa0[0] << 16); }
  else { readv<0>(va, vbc); readv<1>(vc, vbc); }
  SBAR();
  if (HASNEXT) {
#pragma unroll
    for (int r = 0; r < 16; ++r) { pN0[r] = 0.f; pN1[r] = 0.f; }
    if (!(SK & 4)) {
      if (SK & 2) ATT_WAITL(0); else ATT_WAITL(15);
      SBAR();
#pragma unroll
      for (int d0 = 0; d0 < 4; ++d0) { pN0 = __builtin_amdgcn_mfma_f32_32x32x16_bf16(kf0[d0], qr[d0], pN0, 0, 0, 0); pN1 = __builtin_amdgcn_mfma_f32_32x32x16_bf16(kf1[d0], qr[d0], pN1, 0, 0, 0); }
    }
  }
  SBAR();
  if (!(SK & 2)) {
    readv<2>(vd, vbc); SBAR(); ATT_WAITL(15); SBAR(); pvm(o[0], va, pa0, pa1, pa2, pa3); if (HASNEXT && !(SK & 1)) exp8<0>(pN0); SBAR();
    readv<3>(va, vbc); SBAR(); ATT_WAITL(15); SBAR(); pvm(o[1], vc, pa0, pa1, pa2, pa3); if (HASNEXT && !(SK & 1)) exp8<8>(pN0); SBAR();
    ATT_WAITL(8); SBAR(); pvm(o[2], vd, pa0, pa1, pa2, pa3); if (HASNEXT && !(SK & 1)) exp8<0>(pN1); SBAR();
    ATT_WAITL(0); SBAR(); pvm(o[3], va, pa0, pa1, pa2, pa3); if (HASNEXT && !(SK & 1)) exp8<8>(pN1); SBAR();
  } else if (HASNEXT && !(SK & 1)) { exp8<0>(pN0); exp8<8>(pN0); exp8<0>(pN1); exp8<8>(pN1); }
}
constexpr int SLOT = SHM_K + SHM_V, NSLOT = 4;
#define ATT_WAITV(n) asm volatile("s_waitcnt vmcnt(" #n ")" ::: "memory")
template <int SK = 0> __device__ __forceinline__ void attn_unit(const bf16_t* __restrict__ Qb, const bf16_t* __restrict__ Kh, const bf16_t* __restrict__ Vh, bf16_t* Ob, bf16_t* oAb, int second, float lam, float post,
                                                                const float* __restrict__ subln, int nkeys, float negM, LAS char* lds) {
  int tid_ = threadIdx.x; asm volatile("" : "+v"(tid_));
  const int tid = tid_, wid = __builtin_amdgcn_readfirstlane(tid >> 6), lane = tid & 63, r32 = lane & 31, hi = lane >> 5;
  LAS float* li_l = (LAS float*)(lds + NSLOT * SLOT) + wid * 64;
  float lsum = 0; f32x16 o[4];
#pragma unroll
  for (int d = 0; d < 4; ++d)
#pragma unroll
    for (int r = 0; r < 16; ++r) o[d][r] = 0.f;
  bf16x8 qr[4];
  const bf16_t* Qw = Qb + (long)(wid * 32 + r32) * 64 + hi * 8;
#pragma unroll
  for (int d0 = 0; d0 < 4; ++d0) qr[d0] = *reinterpret_cast<const bf16x8*>(Qw + d0 * 16);
  unsigned offK, offV[2];
  { const int row = 8 * wid + (lane >> 3), ch = (lane & 7) ^ ((row >> 1) & 7); offK = (unsigned)(row * 64 + ch * 8); }
#pragma unroll
  for (int i = 0; i < 2; ++i) { const int piece = wid + 8 * i, sub = piece * 2 + (lane >> 5), kk = (sub >> 2) * 8 + ((lane & 31) >> 2), k = (kk & ~0xC) | ((kk & 4) << 1) | ((kk & 8) >> 1), c = (sub & 3) * 32 + 8 * (lane & 3);
      offV[i] = (unsigned)(k * 128 + c); }
  const int vbase = (int)(uintptr_t)lds + SHM_K + v_rd_base(lane);
#define ISSUE(t) do { const int s_ = (t) & (NSLOT - 1); const long k0_ = (long)(t) * KVBLK; \
    __builtin_amdgcn_global_load_lds((const unsigned*)(Kh + k0_ * 64 + offK), (LAS unsigned*)(lds + s_ * SLOT + wid * 1024), 16, 0, 0); \
    __builtin_amdgcn_global_load_lds((const unsigned*)(Vh + k0_ * 128 + offV[0]), (LAS unsigned*)(lds + s_ * SLOT + SHM_K + wid * 1024), 16, 0, 0); \
    __builtin_amdgcn_global_load_lds((const unsigned*)(Vh + k0_ * 128 + offV[1]), (LAS unsigned*)(lds + s_ * SLOT + SHM_K + 8192 + wid * 1024), 16, 0, 0); } while (0)
#define KS(t) (lds + ((t) & (NSLOT - 1)) * SLOT)
#define VB(t) (vbase + ((t) & (NSLOT - 1)) * SLOT)
  f32x16 pA0, pA1; const int NT = nkeys / KVBLK;
  if (wid >= 4) __builtin_amdgcn_s_setprio(1);
  ATT_WAITV(0);
  ISSUE(0); ISSUE(1); ISSUE(2);
  ATT_WAITV(6); __builtin_amdgcn_s_barrier(); asm volatile("" ::: "memory");
  qkt<SK>(pA0, pA1, KS(0), qr, r32, hi, negM); exp16<SK>(pA0); exp16<SK>(pA1);
  for (int j = 0; j + 2 < NT; ++j) {
    if (j + 2 < NT) ATT_WAITV(3); else ATT_WAITV(0);
    __builtin_amdgcn_s_barrier(); asm volatile("" ::: "memory");
    if (!(SK & 16) && j + 3 < NT) ISSUE(j + 3);
    tile_step<SK, true>(pA0, pA1, o, qr, lsum, KS(j + 1), VB(j), negM, r32, hi);
  }
  ATT_WAITV(0); __builtin_amdgcn_s_barrier(); asm volatile("" ::: "memory");
  tile_step<SK, true>(pA0, pA1, o, qr, lsum, KS(NT - 1), VB(NT - 2), negM, r32, hi);
  tile_step<SK, false>(pA0, pA1, o, qr, lsum, KS(NT - 1), VB(NT - 1), negM, r32, hi);
  { auto rr = __builtin_amdgcn_permlane32_swap(__float_as_uint(lsum), __float_as_uint(lsum), false, false); lsum = __uint_as_float(rr[0]) + __uint_as_float(rr[1]); }
  if (hi == 0) li_l[r32] = lsum; asm volatile("s_waitcnt lgkmcnt(0)" ::: "memory");
  float rli[16];
#pragma unroll
  for (int r = 0; r < 16; ++r) rli[r] = __builtin_amdgcn_rcpf(li_l[crow(r, hi)]);
  bf16_t* Ow = Ob + (long)(wid * 32) * 1024;
  if (!second) {
#pragma unroll
    for (int r = 0; r < 16; ++r) { const int orow = crow(r, hi);
#pragma unroll
      for (int d0 = 0; d0 < 4; ++d0) Ow[(long)orow * 1024 + d0 * 32 + r32] = (bf16_t)(cvtpk(o[d0][r] * rli[r], 0.f) & 0xffffu); }
  } else {
    float sl[4];
#pragma unroll
    for (int d0 = 0; d0 < 4; ++d0) sl[d0] = subln[d0 * 32 + r32];
    bf16_t* Aw = oAb + (long)(wid * 32) * 1024;
#pragma unroll
    for (int rg = 0; rg < 4; ++rg) {
      unsigned short o1[4][4];
#pragma unroll
      for (int j = 0; j < 4; ++j)
#pragma unroll
        for (int d0 = 0; d0 < 4; ++d0) o1[j][d0] = *(const unsigned short*)(Ow + (long)crow(4 * rg + j, hi) * 1024 + d0 * 32 + r32);
#pragma unroll
      for (int j = 0; j < 4; ++j) { const int r = 4 * rg + j; float dd[4], ss = 0.f;
#pragma unroll
        for (int d0 = 0; d0 < 4; ++d0) { dd[d0] = __uint_as_float((unsigned)o1[j][d0] << 16) - lam * (o[d0][r] * rli[r]); ss += dd[d0] * dd[d0]; }
        ss += __shfl_xor(ss, 1); ss += __shfl_xor(ss, 2); ss += __shfl_xor(ss, 4); ss += __shfl_xor(ss, 8); ss += __shfl_xor(ss, 16);
        const float rs = rsqrtf(ss * (1.0f / 128.0f) + EPS) * post; bf16_t* rowp = Aw + (long)crow(r, hi) * 1024;
#pragma unroll
        for (int d0 = 0; d0 < 4; ++d0) { const float y = dd[d0] * rs; rowp[d0 * 32 + r32] = (bf16_t)(cvtpk(y * sl[d0], 0.f) & 0xffffu); } }
    }
  }
  __builtin_amdgcn_s_setprio(0);
  __builtin_amdgcn_s_barrier(); asm volatile("" ::: "memory");
#undef ISSUE
#undef KS
#undef VB
#undef ITER
}
}

template <int SK = 0> __device__ __forceinline__ void attn_phase(Frame& F, int l) {
    const bf16_t* Q = WSP(bf16_t, DY_QKV); const bf16_t* K = Q + (size_t)MR * 1024; const bf16_t* V = K + (size_t)MR * 1024;
    bf16_t* O = WSP(bf16_t, DY_O1); bf16_t* oA = WSP(bf16_t, DY_OA); const float negM = 0.f;
    const float lam = WSP(float, WS_SCAL)[l]; const float post = 1.0f - (0.8f - 0.6f * expf(-0.3f * (float)l)); const float* subln = inp(F, I_SUBLN) + l * 128;
    const int NL = NB * 8 * 64, NU = NL + (l == 0 ? NB * 8 : 0);
    for (int i = 0; i * F.G < NU; ++i) {
        int u = i * F.G + F.bid;
        if (F.G == 256 && i < 4) { const int hh = i * 8 + (F.bid & 7); u = (hh >> 1) * 64 + (hh & 1) * 32 + (F.bid >> 3); }
        if (u >= NU) break;
        int p, q0, k0, nk;
        if (u < NL) { p = u / 64; q0 = (u % 64) * 256; k0 = 0; nk = TT; }
        else { p = u - NL; q0 = T; k0 = T; nk = LC; }
        const int b = p >> 3, h = p & 7;
        for (int sm = 0; sm < 2; ++sm) {
            const size_t hb = (size_t)(b * 16 + 2 * h + sm) * TT;
            att::attn_unit<SK>(Q + (hb + q0) * 64, K + (hb + k0) * 64, V + ((size_t)(b * 8 + h) * TT + k0) * 128, O + ((size_t)b * TT + q0) * 1024 + h * 128, oA + ((size_t)b * TT + q0) * 1024 + h * 128,
                               sm, lam, post, subln, nk, negM, (LAS char*)F.lds);
        }
    }
}
__device__ __forceinline__ void ffn_fixup(Frame& F, int l) {
    const float* raw = WSP(float, DY_RAW); bf16_t* g = WSP(bf16_t, DY_G);
    const float* cw = inp(F, I_CONVW) + (size_t)l * 3 * NUP; const float* cb = inp(F, I_CONVB) + (size_t)l * NUP;
    const int NBLK = MR / 64, per = DFF / 4;
    const size_t total = (size_t)NBLK * 2 * per;
    for (size_t it = (size_t)F.bid * NTHR + F.tid; it < total; it += (size_t)F.G * NTHR) {
        const int cq = (int)(it % per), rb = (int)(it / per), blk = rb >> 1, last = rb & 1, j = cq * 4;
        const int bl = blk % (TT / 64);
        const bool seq_first = (bl == 0 || bl == T / 64), seq_last = (bl == T / 64 - 1 || bl == TT / 64 - 1);
        const float* rc = raw + ((size_t)blk * 4 + (last ? 3 : 0)) * NUP;
        const float* rp = last ? raw + ((size_t)blk * 4 + 2) * NUP : raw + ((size_t)(blk - 1) * 4 + 3) * NUP;
        const float* rn = last ? raw + ((size_t)(blk + 1) * 4 + 0) * NUP : raw + ((size_t)blk * 4 + 1) * NUP;
        const bool zp = (!last && seq_first), zn = (last && seq_last);
        const f32x4 z4 = {0.f, 0.f, 0.f, 0.f};
        f32x4 v[14];
        { const float* rpp = zp ? rc : rp; const float* rnn = zn ? rc : rn;
          v[0] = *(const f32x4*)(rpp + j); v[1] = *(const f32x4*)(rpp + DFF + j); v[2] = *(const f32x4*)(rnn + j); v[3] = *(const f32x4*)(rnn + DFF + j);
          v[4] = *(const f32x4*)(rc + j); v[5] = *(const f32x4*)(rc + DFF + j);
          v[6] = *(const f32x4*)(cw + j); v[7] = *(const f32x4*)(cw + NUP + j); v[8] = *(const f32x4*)(cw + 2 * NUP + j); v[9] = *(const f32x4*)(cb + j);
          v[10] = *(const f32x4*)(cw + DFF + j); v[11] = *(const f32x4*)(cw + NUP + DFF + j); v[12] = *(const f32x4*)(cw + 2 * NUP + DFF + j); v[13] = *(const f32x4*)(cb + DFF + j); }
#pragma unroll
        for (int k = 0; k < 14; ++k) asm volatile("" : "+v"(v[k]));
        const f32x4 pg = zp ? z4 : v[0], pu = zp ? z4 : v[1], ng = zn ? z4 : v[2], nu = zn ? z4 : v[3], xg = v[4], xu = v[5];
        const f32x4 yg = v[6] * pg + v[7] * xg + v[8] * ng + v[9];
        const f32x4 yu = v[10] * pu + v[11] * xu + v[12] * nu + v[13];
        u32x2 w; w.x = cvtpk(siluf_(yg[0]) * yu[0], siluf_(yg[1]) * yu[1]); w.y = cvtpk(siluf_(yg[2]) * yu[2], siluf_(yg[3]) * yu[3]);
        *(u32x2*)(g + (size_t)(blk * 64 + (last ? 63 : 0)) * DFF + j) = w;
    }
}

namespace scn {
using att::crow; using att::v_st; using att::v_rd_base; using att::v_rd_off; using att::tr_read;
__device__ __forceinline__ int cp_of(int c, int dir) { return c == PPB - 1 ? 0 : (dir ? (PPB - 1) - c : c + 1); }
#define KSWZ256(row, colB) ((row) * 256 + ((colB) ^ (((row) & 7) << 4)))
#define PKF(L, H) (bf16x8){L[0], L[1], L[2], L[3], H[0], H[1], H[2], H[3]}
__device__ __forceinline__ u32x4 scale8(const u32x4 w, float s) { u32x4 o; o.x = cvtpk(bflo(w.x) * s, bfhi(w.x) * s); o.y = cvtpk(bflo(w.y) * s, bfhi(w.y) * s); o.z = cvtpk(bflo(w.z) * s, bfhi(w.z) * s); o.w = cvtpk(bflo(w.w) * s, bfhi(w.w) * s); return o; }
__device__ __forceinline__ float ret_lg2(int h, int dir) { const int hh = dir ? 3 - h : h; return log1pf(-exp2f(-5.0f - (float)hh)) * LOG2E; }
constexpr size_t RET_US_ELEMS = (size_t)128 * 256, HG_US_ELEMS = (size_t)128 * 128;
constexpr size_t US_RET_OFF = DY_US, US_HG_OFF = DY_US + 65 * MiB;
constexpr size_t HG_A_OFF = WS_MODP;

__device__ __forceinline__ void store_state_tile(bf16_t* us, const f32x16& a, int rb, int d0, int nd0, int c32, int hi) {
#pragma unroll
    for (int g = 0; g < 4; ++g) { const int ks = 2 * rb + (g >> 1), ln = c32 + 32 * (g & 1);
        u32x2 w; w.x = cvtpk_c(a[4 * g], a[4 * g + 1]); w.y = cvtpk_c(a[4 * g + 2], a[4 * g + 3]);
        *(u32x2*)(us + ((size_t)(ks * nd0 + d0) * 64 + ln) * 8 + 4 * hi) = w; }
}

template <int TILE, int KST> __device__ __forceinline__ void ra_step(f32x16 (&acc)[4][2], int vbK, const int (&vbV)[2]) {
    bf16x8 A[4], Bv[2];
    { const s16x4 lo = tr_read<TILE * 16384 + v_rd_off(0, KST, 0)>(vbK), h4 = tr_read<TILE * 16384 + v_rd_off(0, KST, 1)>(vbK); A[0] = PKF(lo, h4); }
    { const s16x4 lo = tr_read<TILE * 16384 + v_rd_off(1, KST, 0)>(vbK), h4 = tr_read<TILE * 16384 + v_rd_off(1, KST, 1)>(vbK); A[1] = PKF(lo, h4); }
    { const s16x4 lo = tr_read<TILE * 16384 + v_rd_off(2, KST, 0)>(vbK), h4 = tr_read<TILE * 16384 + v_rd_off(2, KST, 1)>(vbK); A[2] = PKF(lo, h4); }
    { const s16x4 lo = tr_read<TILE * 16384 + v_rd_off(3, KST, 0)>(vbK), h4 = tr_read<TILE * 16384 + v_rd_off(3, KST, 1)>(vbK); A[3] = PKF(lo, h4); }
    { const s16x4 lo = tr_read<TILE * 32768 + v_rd_off(0, KST, 0)>(vbV[0]), h4 = tr_read<TILE * 32768 + v_rd_off(0, KST, 1)>(vbV[0]); Bv[0] = PKF(lo, h4); }
    { const s16x4 lo = tr_read<TILE * 32768 + v_rd_off(0, KST, 0)>(vbV[1]), h4 = tr_read<TILE * 32768 + v_rd_off(0, KST, 1)>(vbV[1]); Bv[1] = PKF(lo, h4); }
    asm volatile("s_waitcnt lgkmcnt(0)" ::: "memory"); __builtin_amdgcn_sched_barrier(0);
#pragma unroll
    for (int rb = 0; rb < 4; ++rb)
#pragma unroll
        for (int cb = 0; cb < 2; ++cb) acc[rb][cb] = __builtin_amdgcn_mfma_f32_32x32x16_bf16(A[rb], Bv[cb], acc[rb][cb], 0, 0, 0);
}
__device__ __forceinline__ void ret_local_unit(Frame& F, int b, int h, int c) {
    const bf16_t* RK = WSP(bf16_t, DY_PB) + (size_t)MR * 512; const bf16_t* RV = RK + (size_t)MR * 512;
    const size_t hb = (size_t)(b * 4 + h) * TT + (size_t)c * 256;
    const float lgf = ret_lg2(h, 0), lgb = ret_lg2(h, 1);
    const int w = F.wave, lane = F.lane, c32 = lane & 31, hi = lane >> 5, dir = w >> 2, dvq = w & 3;
    LAS char* lds = (LAS char*)F.lds;
    f32x16 acc[4][2];
#pragma unroll
    for (int rb = 0; rb < 4; ++rb)
#pragma unroll
        for (int cb = 0; cb < 2; ++cb)
#pragma unroll
            for (int r = 0; r < 16; ++r) acc[rb][cb][r] = 0.f;
    const int vbK = (int)(uintptr_t)lds + dir * 32768 + v_rd_base(lane);
    int vbV[2];
#pragma unroll
    for (int cb = 0; cb < 2; ++cb) { const int colblk = 2 * dvq + cb; vbV[cb] = (int)(uintptr_t)lds + 65536 + (colblk >> 2) * 16384 + (colblk & 3) * 512 + v_rd_base(lane); }
    for (int hh = 0; hh < 2; ++hh) {
        __syncthreads();
        u32x4 kq[4];
#pragma unroll
        for (int i = 0; i < 4; ++i) { const int idx = i * NTHR + F.tid, row = idx >> 4, ch = idx & 15, p = 128 * hh + row; kq[i] = *(const u32x4*)(RK + (hb + p) * 128 + ch * 8); }
#pragma unroll
        for (int i = 0; i < 4; ++i) asm volatile("" : "+v"(kq[i]));
#pragma unroll
        for (int i = 0; i < 4; ++i) { const int idx = i * NTHR + F.tid, row = idx >> 4, ch = idx & 15, p = 128 * hh + row;
            const u32x4 kv = kq[i];
            const float ff = __builtin_amdgcn_exp2f(lgf * (float)(255 - p)), fb = __builtin_amdgcn_exp2f(lgb * (float)p);
            const int off = (row >> 6) * 16384 + v_st(row & 63, ch * 8);
            *(LAS u32x4*)(lds + off) = scale8(kv, ff); *(LAS u32x4*)(lds + 32768 + off) = scale8(kv, fb); }
        { u32x4 vq[8];
#pragma unroll
          for (int i = 0; i < 8; ++i) { const int idx = i * NTHR + F.tid, row = idx >> 5, col = (idx & 31) * 8, p = 128 * hh + row; vq[i] = *(const u32x4*)(RV + (hb + p) * 256 + col); }
#pragma unroll
          for (int i = 0; i < 8; ++i) asm volatile("" : "+v"(vq[i]));
#pragma unroll
          for (int i = 0; i < 8; ++i) { const int idx = i * NTHR + F.tid, row = idx >> 5, col = (idx & 31) * 8;
            *(LAS u32x4*)(lds + 65536 + ((row >> 6) * 2 + (col >> 7)) * 16384 + v_st(row & 63, col & 127)) = vq[i]; } }
        __syncthreads();
        ra_step<0, 0>(acc, vbK, vbV); ra_step<0, 1>(acc, vbK, vbV); ra_step<0, 2>(acc, vbK, vbV); ra_step<0, 3>(acc, vbK, vbV);
        ra_step<1, 0>(acc, vbK, vbV); ra_step<1, 1>(acc, vbK, vbV); ra_step<1, 2>(acc, vbK, vbV); ra_step<1, 3>(acc, vbK, vbV);
    }
    bf16_t* us = (bf16_t*)(F.ws + US_RET_OFF) + ((size_t)((b * 4 + h) * 2 + dir) * PPB + cp_of(c, dir)) * RET_US_ELEMS;
#pragma unroll
    for (int rb = 0; rb < 4; ++rb)
#pragma unroll
        for (int cb = 0; cb < 2; ++cb) store_state_tile(us, acc[rb][cb], rb, 2 * dvq + cb, 8, c32, hi);
}

__device__ __forceinline__ void scan_states(Frame& F, bool do_ret, bool do_hg) {
  for (int gt = F.bid * NTHR + F.tid; gt < 131072; gt += F.G * NTHR) {
    if (gt < 65536) {
        if (!do_ret) continue;
        const int seq = gt >> 12, vec = gt & 4095, dir = seq & 1, h = (seq >> 1) & 3;
        const float g = exp2f(ret_lg2(h, dir) * 256.0f);
        u32x4* p = (u32x4*)(F.ws + US_RET_OFF) + (size_t)seq * PPB * 4096 + vec;
        float S[8];
#pragma unroll
        for (int e = 0; e < 8; ++e) S[e] = 0.f;
        for (int cp0 = 0; cp0 < PPB; cp0 += 13) {
            u32x4 ub[13];
#pragma unroll
            for (int k = 0; k < 13; ++k) ub[k] = p[(size_t)(cp0 + k) * 4096];
#pragma unroll
            for (int k = 0; k < 13; ++k) { const u32x4 u = ub[k];
                u32x4 o; o.x = cvtpk(S[0], S[1]); o.y = cvtpk(S[2], S[3]); o.z = cvtpk(S[4], S[5]); o.w = cvtpk(S[6], S[7]); p[(size_t)(cp0 + k) * 4096] = o;
                S[0] = g * S[0] + bflo(u.x); S[1] = g * S[1] + bfhi(u.x); S[2] = g * S[2] + bflo(u.y); S[3] = g * S[3] + bfhi(u.y);
                S[4] = g * S[4] + bflo(u.z); S[5] = g * S[5] + bfhi(u.z); S[6] = g * S[6] + bflo(u.w); S[7] = g * S[7] + bfhi(u.w); } }
    } else {
        if (!do_hg) continue;
        const int gv = gt - 65536, seq = gv >> 11, vec = gv & 2047;
        const int ks = vec >> 8, hi = (vec >> 5) & 1, dk0 = 16 * ks + 8 * hi;
        u32x4* p = (u32x4*)(F.ws + US_HG_OFF) + (size_t)seq * PPB * 2048 + vec;
        const f32x4* ap = (const f32x4*)((const float*)(F.ws + HG_A_OFF) + (size_t)seq * PPB * 128 + dk0);
        float S[8];
#pragma unroll
        for (int e = 0; e < 8; ++e) S[e] = 0.f;
        for (int cp0 = 0; cp0 < PPB; cp0 += 5) {
            u32x4 ub[5]; f32x4 a0b[5], a1b[5];
#pragma unroll
            for (int k = 0; k < 5; ++k) { ub[k] = p[(size_t)(cp0 + k) * 2048]; a0b[k] = ap[(cp0 + k) * 32]; a1b[k] = ap[(cp0 + k) * 32 + 1]; }
#pragma unroll
            for (int k = 0; k < 5; ++k) { const u32x4 u = ub[k]; const f32x4 a0 = a0b[k], a1 = a1b[k];
                u32x4 o; o.x = cvtpk(S[0], S[1]); o.y = cvtpk(S[2], S[3]); o.z = cvtpk(S[4], S[5]); o.w = cvtpk(S[6], S[7]); p[(size_t)(cp0 + k) * 2048] = o;
                S[0] = a0[0] * S[0] + bflo(u.x); S[1] = a0[1] * S[1] + bfhi(u.x); S[2] = a0[2] * S[2] + bflo(u.y); S[3] = a0[3] * S[3] + bfhi(u.y);
                S[4] = a1[0] * S[4] + bflo(u.z); S[5] = a1[1] * S[5] + bfhi(u.z); S[6] = a1[2] * S[6] + bflo(u.w); S[7] = a1[3] * S[7] + bfhi(u.w); } }
    }
  }
}

__device__ __forceinline__ void ret_out_unit(Frame& F, int l, int b, int h, int c) {
    const bf16_t* RQ = WSP(bf16_t, DY_PB); const bf16_t* RK = RQ + (size_t)MR * 512; const bf16_t* RV = RK + (size_t)MR * 512;
    const size_t hb = (size_t)(b * 4 + h) * TT + (size_t)c * 256;
    const float lgf = ret_lg2(h, 0), lgb = ret_lg2(h, 1);
    const int w = F.wave, lane = F.lane, r32 = lane & 31, hi = lane >> 5, irow = 32 * w + r32;
    LAS char* lds = (LAS char*)F.lds;
    bf16x8 qr[8];
#pragma unroll
    for (int d0 = 0; d0 < 8; ++d0) qr[d0] = *(const bf16x8*)(RQ + (hb + irow) * 128 + d0 * 16 + hi * 8);
    const int vb = (int)(uintptr_t)lds + 16384 + v_rd_base(lane);
    unsigned okk[2], ovv[2];
#pragma unroll
    for (int i = 0; i < 2; ++i) { const int P = w + 8 * i, row = 4 * P + (lane >> 4), ch = (lane & 15) ^ (row & 7); okk[i] = (unsigned)(row * 128 + ch * 8);
        const int sub = P * 2 + (lane >> 5), kk = (sub >> 2) * 8 + ((lane & 31) >> 2), k = (kk & ~0xC) | ((kk & 4) << 1) | ((kk & 8) >> 1), c = (sub & 3) * 32 + 8 * (lane & 3); ovv[i] = (unsigned)(k * 256 + c); }
    float ssq[16]; LAS unsigned* keep = (LAS unsigned*)(lds + 65536 + w * 8192) + lane;
#pragma unroll
    for (int r = 0; r < 16; ++r) ssq[r] = 0.f;
    f32x16 o[4];
#pragma unroll 1
    for (int half = 0; half < 2; ++half) {
#pragma unroll
        for (int d = 0; d < 4; ++d)
#pragma unroll
            for (int r = 0; r < 16; ++r) o[d][r] = 0.f;
#define RSC_ISSUE(J_, buf_) do { const size_t kb_ = (hb + 64 * (J_)) * 128, vbs_ = (hb + 64 * (J_)) * 256 + half * 128; \
            __builtin_amdgcn_global_load_lds((const unsigned*)(RK + kb_ + okk[0]), (LAS unsigned*)(lds + (buf_) * 32768 + w * 1024), 16, 0, 0); \
            __builtin_amdgcn_global_load_lds((const unsigned*)(RK + kb_ + okk[1]), (LAS unsigned*)(lds + (buf_) * 32768 + (w + 8) * 1024), 16, 0, 0); \
            __builtin_amdgcn_global_load_lds((const unsigned*)(RV + vbs_ + ovv[0]), (LAS unsigned*)(lds + (buf_) * 32768 + 16384 + w * 1024), 16, 0, 0); \
            __builtin_amdgcn_global_load_lds((const unsigned*)(RV + vbs_ + ovv[1]), (LAS unsigned*)(lds + (buf_) * 32768 + 16384 + (w + 8) * 1024), 16, 0, 0); } while (0)
        asm volatile("s_waitcnt vmcnt(0)" ::: "memory");
        RSC_ISSUE(0, 0);
#pragma unroll 1
        for (int J = 0; J < 4; ++J) {
            const int buf = J & 1;
            asm volatile("s_waitcnt lgkmcnt(0)" ::: "memory"); __builtin_amdgcn_s_barrier(); asm volatile("" ::: "memory");
            if (J < 3) { RSC_ISSUE(J + 1, buf ^ 1); asm volatile("s_waitcnt vmcnt(4)" ::: "memory"); } else asm volatile("s_waitcnt vmcnt(0)" ::: "memory");
            __builtin_amdgcn_s_barrier(); asm volatile("" ::: "memory");
            LAS char* kb = lds + buf * 32768; const int vbj = vb + buf * 32768;
            f32x16 p0, p1;
#pragma unroll
            for (int r = 0; r < 16; ++r) { p0[r] = 0.f; p1[r] = 0.f; }
#pragma unroll
            for (int d0 = 0; d0 < 8; ++d0) { const int cb = (d0 * 16 + hi * 8) * 2;
                const bf16x8 b0 = *(const LAS bf16x8*)(kb + KSWZ256(r32, cb)), b1 = *(const LAS bf16x8*)(kb + KSWZ256(32 + r32, cb));
                p0 = __builtin_amdgcn_mfma_f32_32x32x16_bf16(b0, qr[d0], p0, 0, 0, 0); p1 = __builtin_amdgcn_mfma_f32_32x32x16_bf16(b1, qr[d0], p1, 0, 0, 0); }
#pragma unroll
            for (int r = 0; r < 16; ++r) { const int d0i = irow - (64 * J + crow(r, hi)), d1i = d0i - 32;
                const float e0 = d0i >= 0 ? lgf * (float)d0i : -lgb * (float)d0i, e1 = d1i >= 0 ? lgf * (float)d1i : -lgb * (float)d1i;
                float m0 = __builtin_amdgcn_exp2f(e0), m1 = __builtin_amdgcn_exp2f(e1); if (d0i == 0) m0 = 2.0f; if (d1i == 0) m1 = 2.0f;
                p0[r] *= m0; p1[r] *= m1; }
            bf16x8 pa0, pa1, pa2, pa3;
#define PK4(P, BASE, OUT) do { unsigned a0 = cvtpk(P[BASE + 0], P[BASE + 1]), a1 = cvtpk(P[BASE + 2], P[BASE + 3]);   \
    unsigned b0_ = cvtpk(P[BASE + 4], P[BASE + 5]), b1_ = cvtpk(P[BASE + 6], P[BASE + 7]);                              \
    auto r0 = __builtin_amdgcn_permlane32_swap(a0, b0_, false, false); auto r1 = __builtin_amdgcn_permlane32_swap(a1, b1_, false, false); \
    u32x4 w_ = {r0[0], r1[0], r0[1], r1[1]}; OUT = *reinterpret_cast<bf16x8*>(&w_); } while (0)
            PK4(p0, 0, pa0); PK4(p0, 8, pa1); PK4(p1, 0, pa2); PK4(p1, 8, pa3);
            att::pv_d0(o, vbj, pa0, pa1, pa2, pa3);
        }
#undef RSC_ISSUE
#pragma unroll 1
        for (int dir = 0; dir < 2; ++dir) {
            const float sc = dir ? __builtin_amdgcn_exp2f(lgb * (float)(256 - irow)) : __builtin_amdgcn_exp2f(lgf * (float)(irow + 1));
            const bf16_t* us = (const bf16_t*)(F.ws + US_RET_OFF) + ((size_t)((b * 4 + h) * 2 + dir) * PPB + cp_of(c, dir)) * RET_US_ELEMS;
            __syncthreads();
#pragma unroll
            for (int i = 0; i < 4; ++i) { const int idx = i * NTHR + F.tid, fr_ = idx >> 6, ln = idx & 63, ks = fr_ >> 2, d0 = fr_ & 3;
                *(LAS u32x4*)(lds + 32768 + idx * 16) = *(const u32x4*)(us + ((size_t)(ks * 8 + half * 4 + d0) * 64 + ln) * 8); }
            __syncthreads();
#pragma unroll
            for (int ks = 0; ks < 8; ++ks) { const u32x4 qs = scale8(*reinterpret_cast<const u32x4*>(&qr[ks]), sc); const bf16x8 qa = *reinterpret_cast<const bf16x8*>(&qs);
#pragma unroll
                for (int d0 = 0; d0 < 4; ++d0) { const bf16x8 sf = *(const LAS bf16x8*)(lds + 32768 + ((ks * 4 + d0) * 64 + lane) * 16);
                    o[d0] = __builtin_amdgcn_mfma_f32_32x32x16_bf16(qa, sf, o[d0], 0, 0, 0); } }
        }
#pragma unroll
        for (int d0 = 0; d0 < 4; ++d0)
#pragma unroll
            for (int r = 0; r < 16; ++r) ssq[r] += o[d0][r] * o[d0][r];
        if (half == 0) {
#pragma unroll
            for (int d0 = 0; d0 < 4; ++d0)
#pragma unroll
                for (int r = 0; r < 8; ++r) keep[(d0 * 8 + r) * 64] = cvtpk_c(o[d0][2 * r], o[d0][2 * r + 1]);
        }
    }
    const float* rn = inp(F, I_RNORM) + l * 256;
    bf16_t* ob = WSP(bf16_t, DY_OB) + ((size_t)b * TT + (size_t)c * 256 + 32 * w) * 1024 + h * 256 + r32;
    float wn[8];
#pragma unroll
    for (int j = 0; j < 8; ++j) wn[j] = rn[32 * j + r32];
#pragma unroll
    for (int r = 0; r < 16; ++r) { float s = ssq[r];
        s += __shfl_xor(s, 1); s += __shfl_xor(s, 2); s += __shfl_xor(s, 4); s += __shfl_xor(s, 8); s += __shfl_xor(s, 16);
        const float rs = rsqrtf(s * (1.0f / 256.0f) + EPS); bf16_t* rowp = ob + (size_t)crow(r, hi) * 1024;
#pragma unroll
        for (int d0 = 0; d0 < 4; ++d0) { const unsigned pw = keep[(d0 * 8 + (r >> 1)) * 64]; const float v0 = (r & 1) ? bfhi(pw) : bflo(pw);
            rowp[32 * d0] = (bf16_t)(cvtpk(v0 * rs * wn[d0], 0.f) & 0xffffu);
            rowp[128 + 32 * d0] = (bf16_t)(cvtpk(o[d0][r] * rs * wn[4 + d0], 0.f) & 0xffffu); } }
    __syncthreads();
#undef PK4
}
}


namespace hgm {
using att::crow; using att::v_st; using att::v_rd_base; using att::v_rd_off; using att::tr_read;
constexpr int TTAB_OFF = RING_BYTES + 1024;
__device__ __forceinline__ float dpp_shr0(float v, int) { return v; }
template <int CTRL> __device__ __forceinline__ float dppz(float v) { return __int_as_float(__builtin_amdgcn_update_dpp(0, __float_as_int(v), CTRL, 0xf, 0xf, true)); }
template <bool REV> __device__ __forceinline__ void scan32x8(float (&v)[8], int lane, float (&tot)[8]) {
#pragma unroll
    for (int e = 0; e < 8; ++e) v[e] += REV ? dppz<0x101>(v[e]) : dppz<0x111>(v[e]);
#pragma unroll
    for (int e = 0; e < 8; ++e) v[e] += REV ? dppz<0x102>(v[e]) : dppz<0x112>(v[e]);
#pragma unroll
    for (int e = 0; e < 8; ++e) v[e] += REV ? dppz<0x104>(v[e]) : dppz<0x114>(v[e]);
#pragma unroll
    for (int e = 0; e < 8; ++e) v[e] += REV ? dppz<0x108>(v[e]) : dppz<0x118>(v[e]);
    const bool up = (lane & 32) != 0, addrow = REV ? ((lane & 16) == 0) : ((lane & 16) != 0);
    float cr[8];
#pragma unroll
    for (int e = 0; e < 8; ++e) { const float t0 = __int_as_float(__builtin_amdgcn_readlane(__float_as_int(v[e]), REV ? 16 : 15)), t1 = __int_as_float(__builtin_amdgcn_readlane(__float_as_int(v[e]), REV ? 48 : 47)); cr[e] = up ? t1 : t0; }
#pragma unroll
    for (int e = 0; e < 8; ++e) v[e] += addrow ? cr[e] : 0.f;
#pragma unroll
    for (int e = 0; e < 8; ++e) { const float t0 = __int_as_float(__builtin_amdgcn_readlane(__float_as_int(v[e]), REV ? 0 : 31)), t1 = __int_as_float(__builtin_amdgcn_readlane(__float_as_int(v[e]), REV ? 32 : 63)); tot[e] = up ? t1 : t0; }
}
constexpr int LBT_OFF = TTAB_OFF + 4096 + 4608;
template <bool REV, int LAYOUT> __device__ __forceinline__ void prep(const bf16_t* zrow, const LAS float* lbl, int lane, LAS float* ttab_w, float (&E)[64], LAS char* lds, int row) {
    const int hi = lane >> 5;
    u32x4 zw[8];
#pragma unroll
    for (int d0 = 0; d0 < 8; ++d0) zw[d0] = *(const u32x4*)(zrow + 16 * d0);
#pragma unroll
    for (int d0 = 0; d0 < 8; ++d0) {
        const f32x4 l0 = *(const LAS f32x4*)(lbl + 16 * d0), l1 = *(const LAS f32x4*)(lbl + 16 * d0 + 4);
        const float z[8] = {bflo(zw[d0].x), bfhi(zw[d0].x), bflo(zw[d0].y), bfhi(zw[d0].y), bflo(zw[d0].z), bfhi(zw[d0].z), bflo(zw[d0].w), bfhi(zw[d0].w)};
        const float lb[8] = {l0[0], l0[1], l0[2], l0[3], l1[0], l1[1], l1[2], l1[3]};
        float kk[8], Bv[8], tot[8];
#pragma unroll
        for (int e = 0; e < 8; ++e) { const float sg = sigmoidf_(z[e]); const float f = fmaxf(lb[e] + (1.0f - lb[e]) * sg, 1e-20f); Bv[e] = __builtin_amdgcn_logf(f); kk[e] = (1.0f - lb[e]) * (1.0f - sg); }
        scan32x8<REV>(Bv, lane, tot);
        float kv[8];
#pragma unroll
        for (int e = 0; e < 8; ++e) { const float ee = Bv[e] - tot[e]; E[d0 * 8 + e] = ee; kv[e] = kk[e] * __builtin_amdgcn_exp2f(-ee); }
        if ((lane & 31) == 0) { *(LAS f32x4*)(ttab_w + 16 * d0 + 8 * hi) = (f32x4){tot[0], tot[1], tot[2], tot[3]}; *(LAS f32x4*)(ttab_w + 16 * d0 + 8 * hi + 4) = (f32x4){tot[4], tot[5], tot[6], tot[7]}; }
        u32x4 kh; kh.x = cvtpk(kv[0], kv[1]); kh.y = cvtpk(kv[2], kv[3]); kh.z = cvtpk(kv[4], kv[5]); kh.w = cvtpk(kv[6], kv[7]);
        if (LAYOUT == 0) *(LAS u32x4*)(lds + KSWZ256(row, (16 * d0 + 8 * hi) * 2)) = kh;
        else *(LAS u32x4*)(lds + (row >> 6) * 16384 + v_st(row & 63, 16 * d0 + 8 * hi)) = kh;
        __builtin_amdgcn_sched_barrier(0);
    }
}
__device__ __forceinline__ u32x4 qscale(const u32x4 q, const float* Ek) {
    u32x4 o; o.x = cvtpk(bflo(q.x) * __builtin_amdgcn_exp2f(Ek[0]), bfhi(q.x) * __builtin_amdgcn_exp2f(Ek[1])); o.y = cvtpk(bflo(q.y) * __builtin_amdgcn_exp2f(Ek[2]), bfhi(q.y) * __builtin_amdgcn_exp2f(Ek[3]));
    o.z = cvtpk(bflo(q.z) * __builtin_amdgcn_exp2f(Ek[4]), bfhi(q.z) * __builtin_amdgcn_exp2f(Ek[5])); o.w = cvtpk(bflo(q.w) * __builtin_amdgcn_exp2f(Ek[6]), bfhi(q.w) * __builtin_amdgcn_exp2f(Ek[7])); return o;
}
#define HG_PK4(P, BASE, OUT) do { unsigned a0 = cvtpk_c(P[BASE + 0], P[BASE + 1]), a1 = cvtpk_c(P[BASE + 2], P[BASE + 3]);     \
    unsigned b0_ = cvtpk_c(P[BASE + 4], P[BASE + 5]), b1_ = cvtpk_c(P[BASE + 6], P[BASE + 7]);                              \
    auto r0 = __builtin_amdgcn_permlane32_swap(a0, b0_, false, false); auto r1 = __builtin_amdgcn_permlane32_swap(a1, b1_, false, false); \
    u32x4 w_ = {r0[0], r1[0], r0[1], r1[1]}; OUT = *reinterpret_cast<bf16x8*>(&w_); } while (0)
template <int D0> __device__ __forceinline__ void pv32(f32x16& od, int vb, bf16x8 pa0, bf16x8 pa1) {
    const s16x4 l0 = tr_read<v_rd_off(D0, 0, 0)>(vb), h0 = tr_read<v_rd_off(D0, 0, 1)>(vb), l1 = tr_read<v_rd_off(D0, 1, 0)>(vb), h1 = tr_read<v_rd_off(D0, 1, 1)>(vb);
    asm volatile("s_waitcnt lgkmcnt(0)" ::: "memory"); __builtin_amdgcn_sched_barrier(0);
    od = __builtin_amdgcn_mfma_f32_32x32x16_bf16(pa0, (bf16x8){l0[0], l0[1], l0[2], l0[3], h0[0], h0[1], h0[2], h0[3]}, od, 0, 0, 0);
    od = __builtin_amdgcn_mfma_f32_32x32x16_bf16(pa1, (bf16x8){l1[0], l1[1], l1[2], l1[3], h1[0], h1[1], h1[2], h1[3]}, od, 0, 0, 0);
}

constexpr int PTAB_OFF = TTAB_OFF + 4096;
__device__ __forceinline__ u32x4 qfac(u32x4 Q, const LAS float* ca, const LAS float* cb, bool sub) {
    asm volatile("" : "+v"(Q.x), "+v"(Q.y), "+v"(Q.z), "+v"(Q.w));
    f32x4 a0 = *(const LAS f32x4*)(ca), a1 = *(const LAS f32x4*)(ca + 4);
    if (sub) { a0 -= *(const LAS f32x4*)(cb); a1 -= *(const LAS f32x4*)(cb + 4); }
    u32x4 o; o.x = cvtpk(bflo(Q.x) * __builtin_amdgcn_exp2f(a0[0]), bfhi(Q.x) * __builtin_amdgcn_exp2f(a0[1])); o.y = cvtpk(bflo(Q.y) * __builtin_amdgcn_exp2f(a0[2]), bfhi(Q.y) * __builtin_amdgcn_exp2f(a0[3]));
    o.z = cvtpk(bflo(Q.z) * __builtin_amdgcn_exp2f(a1[0]), bfhi(Q.z) * __builtin_amdgcn_exp2f(a1[1])); o.w = cvtpk(bflo(Q.w) * __builtin_amdgcn_exp2f(a1[2]), bfhi(Q.w) * __builtin_amdgcn_exp2f(a1[3])); return o;
}
constexpr int FTAB_OFF = LBT_OFF + 1024;
__device__ __forceinline__ u32x4 qmul(u32x4 Q, const LAS float* f) {
    asm volatile("" : "+v"(Q.x), "+v"(Q.y), "+v"(Q.z), "+v"(Q.w));
    const f32x4 a0 = *(const LAS f32x4*)(f), a1 = *(const LAS f32x4*)(f + 4);
    u32x4 o; o.x = cvtpk(bflo(Q.x) * a0[0], bfhi(Q.x) * a0[1]); o.y = cvtpk(bflo(Q.y) * a0[2], bfhi(Q.y) * a0[3]);
    o.z = cvtpk(bflo(Q.z) * a1[0], bfhi(Q.z) * a1[1]); o.w = cvtpk(bflo(Q.w) * a1[2], bfhi(Q.w) * a1[3]); return o;
}
template <bool REV, int SK = 0> __device__ __forceinline__ void out_dir(Frame& F, int l, int b, int h, int c, f32x16 (&o)[4]) {
    const int w = F.wave, lane = F.lane, r32 = lane & 31, hi = lane >> 5, dir = REV ? 1 : 0;
    LAS char* lds = (LAS char*)F.lds; LAS float* ttab = (LAS float*)(lds + TTAB_OFF); LAS float* ptab = (LAS float*)(lds + PTAB_OFF);
    const size_t rowoff = ((size_t)(b * 8 + h) * TT + (size_t)c * 256 + 32 * w + r32) * 128 + 8 * hi;
    const bf16_t* Z = WSP(bf16_t, DY_PC) + (size_t)(1 + dir) * MR * 1024 + rowoff; const bf16_t* GQ = WSP(bf16_t, DY_PC) + rowoff;
    LAS float* lbt = (LAS float*)(lds + LBT_OFF) + dir * 128;
    __syncthreads();
    u32x4 Qp[8];
    { float E[64];
      prep<REV, 0>(Z, lbt + 8 * hi, lane, ttab + w * 128, E, lds, 32 * w + r32);
#pragma unroll
      for (int d0 = 0; d0 < 8; ++d0) Qp[d0] = *(const u32x4*)(GQ + 16 * d0);
#pragma unroll
      for (int d0 = 0; d0 < 8; ++d0) asm volatile("" : "+v"(Qp[d0]));
#pragma unroll
      for (int d0 = 0; d0 < 8; ++d0) Qp[d0] = qscale(Qp[d0], &E[d0 * 8]); }
    __syncthreads();
    if (F.tid < 128) { float s = 0.f;
#pragma unroll
        for (int pi = 0; pi < 8; ++pi) { ptab[pi * 128 + F.tid] = s; s += ttab[(REV ? 7 - pi : pi) * 128 + F.tid]; }
        ptab[8 * 128 + F.tid] = s; }
    __syncthreads();
    const int vbase = (int)(uintptr_t)lds + 65536 + v_rd_base(lane);
    const int piw = REV ? 7 - w : w; const LAS float* cw = ptab + (piw + 1) * 128 + 8 * hi; LAS float* ftab = (LAS float*)(lds + FTAB_OFF) + w * 128;
    for (int pi = (SK & 1) ? -1 : piw; pi >= 0; --pi) {
        const int J = REV ? 7 - pi : pi; const LAS float* cj = ptab + (pi + 1) * 128 + 8 * hi;
        { const LAS float* pw = ptab + (piw + 1) * 128, *pj = ptab + (pi + 1) * 128;
          ftab[lane] = __builtin_amdgcn_exp2f(pw[lane] - pj[lane]); ftab[lane + 64] = __builtin_amdgcn_exp2f(pw[lane + 64] - pj[lane + 64]); }
        asm volatile("s_waitcnt lgkmcnt(0)" ::: "memory");
        f32x16 p;
#pragma unroll
        for (int r = 0; r < 16; ++r) p[r] = 0.f;
#pragma unroll
        for (int d0 = 0; d0 < 8; ++d0) { const u32x4 qt = qmul(Qp[d0], ftab + 8 * hi + 16 * d0); const bf16x8 a = *(const LAS bf16x8*)(lds + KSWZ256(32 * J + r32, (16 * d0 + 8 * hi) * 2));
            p = __builtin_amdgcn_mfma_f32_32x32x16_bf16(a, *reinterpret_cast<const bf16x8*>(&qt), p, 0, 0, 0);
            if (d0 & 1) __builtin_amdgcn_sched_barrier(0); }
        if (pi == piw) {
#pragma unroll
            for (int r = 0; r < 16; ++r) { const int jj = crow(r, hi); const bool keep = REV ? (jj >= r32) : (jj <= r32); p[r] = keep ? p[r] : 0.f; } }
        bf16x8 pa0, pa1; HG_PK4(p, 0, pa0); HG_PK4(p, 8, pa1);
        const int vb = vbase + (J >> 1) * 16384 + (J & 1) * 8192;
        pv32<0>(o[0], vb, pa0, pa1); pv32<1>(o[1], vb, pa0, pa1); pv32<2>(o[2], vb, pa0, pa1); pv32<3>(o[3], vb, pa0, pa1);
    }
    const bf16_t* us = (const bf16_t*)(F.ws + scn::US_HG_OFF) + ((size_t)((b * 8 + h) * 2 + dir) * PPB + scn::cp_of(c, dir)) * scn::HG_US_ELEMS + (size_t)lane * 8;
    if (!(SK & 2)) {
        bf16x8 sfa[2][4], sfb[2][4];
#define HG_SLD(buf, kq) do { _Pragma("unroll") for (int k2 = 0; k2 < 2; ++k2) _Pragma("unroll") for (int d0 = 0; d0 < 4; ++d0) buf[k2][d0] = *(const bf16x8*)(us + (size_t)((2 * (kq) + k2) * 4 + d0) * 512); } while (0)
#define HG_SMM(buf, kq) do { _Pragma("unroll") for (int k2 = 0; k2 < 2; ++k2) { const u32x4 qe = qfac(Qp[2 * (kq) + k2], cw + 16 * (2 * (kq) + k2), cw, false);                                  \
            _Pragma("unroll") for (int d0 = 0; d0 < 4; ++d0) o[d0] = __builtin_amdgcn_mfma_f32_32x32x16_bf16(*reinterpret_cast<const bf16x8*>(&qe), buf[k2][d0], o[d0], 0, 0, 0); } } while (0)
        HG_SLD(sfa, 0); HG_SLD(sfb, 1); __builtin_amdgcn_sched_barrier(0);
        HG_SMM(sfa, 0); __builtin_amdgcn_sched_barrier(0); HG_SLD(sfa, 2); __builtin_amdgcn_sched_barrier(0);
        HG_SMM(sfb, 1); __builtin_amdgcn_sched_barrier(0); HG_SLD(sfb, 3); __builtin_amdgcn_sched_barrier(0);
        HG_SMM(sfa, 2); __builtin_amdgcn_sched_barrier(0); HG_SMM(sfb, 3); __builtin_amdgcn_sched_barrier(0);
#undef HG_SLD
#undef HG_SMM
    }
    __syncthreads();
}
template <int SK = 0> __device__ __forceinline__ void out_unit(Frame& F, int l, int b, int h, int c) {
    const int w = F.wave, lane = F.lane, r32 = lane & 31, hi = lane >> 5;
    LAS char* lds = (LAS char*)F.lds;
    const size_t rowoff = ((size_t)(b * 8 + h) * TT + (size_t)c * 256 + 32 * w + r32) * 128 + 8 * hi;
    const bf16_t* GI = WSP(bf16_t, DY_PC) + (size_t)3 * MR * 1024 + rowoff;
    { u32x4 gv[8];
#pragma unroll
      for (int d0 = 0; d0 < 8; ++d0) gv[d0] = *(const u32x4*)(GI + 16 * d0);
      float lbv = 0.f; if (F.tid < 256) lbv = WSP(float, WS_LB)[l * 2048 + (F.tid >> 7) * 1024 + h * 128 + (F.tid & 127)];
#pragma unroll
      for (int d0 = 0; d0 < 8; ++d0) asm volatile("" : "+v"(gv[d0]));
      if (F.tid < 256) ((LAS float*)(lds + LBT_OFF))[F.tid] = lbv;
#pragma unroll
      for (int d0 = 0; d0 < 8; ++d0) { const int row = 32 * w + r32; *(LAS u32x4*)(lds + 65536 + (row >> 6) * 16384 + v_st(row & 63, 16 * d0 + 8 * hi)) = gv[d0]; } }
    f32x16 o[4];
#pragma unroll
    for (int d = 0; d < 4; ++d)
#pragma unroll
        for (int r = 0; r < 16; ++r) o[d][r] = 0.f;
    out_dir<false, SK>(F, l, b, h, c, o);
    if (!(SK & 4)) out_dir<true, SK>(F, l, b, h, c, o);
    const float* gn = inp(F, I_GNORM) + l * 128;
    bf16_t* oc = WSP(bf16_t, DY_OC) + ((size_t)b * TT + (size_t)c * 256 + 32 * w) * 1024 + h * 128 + r32;
    float wn[4];
#pragma unroll
    for (int j = 0; j < 4; ++j) wn[j] = gn[32 * j + r32];
#pragma unroll
    for (int r = 0; r < 16; ++r) { float s = 0.f;
#pragma unroll
        for (int d0 = 0; d0 < 4; ++d0) s += o[d0][r] * o[d0][r];
        s += __shfl_xor(s, 1); s += __shfl_xor(s, 2); s += __shfl_xor(s, 4); s += __shfl_xor(s, 8); s += __shfl_xor(s, 16);
        const float rs = rsqrtf(s * (1.0f / 128.0f) + EPS); bf16_t* rowp = oc + (size_t)crow(r, hi) * 1024;
#pragma unroll
        for (int d0 = 0; d0 < 4; ++d0) rowp[32 * d0] = (bf16_t)(cvtpk(o[d0][r] * rs * wn[d0], 0.f) & 0xffffu); }
}

template <bool REV> __device__ __forceinline__ void local_dir(Frame& F, int l, int b, int h, int c) {
    const int w = F.wave, lane = F.lane, r32 = lane & 31, hi = lane >> 5, dir = REV ? 1 : 0, rb = w >> 1, cb0 = 2 * (w & 1);
    LAS char* lds = (LAS char*)F.lds; LAS float* ttab = (LAS float*)(lds + TTAB_OFF);
    const bf16_t* Z = WSP(bf16_t, DY_PC) + (size_t)(1 + dir) * MR * 1024 + ((size_t)(b * 8 + h) * TT + (size_t)c * 256 + 32 * w + r32) * 128 + 8 * hi;
    LAS float* lbt = (LAS float*)(lds + LBT_OFF) + dir * 128;
    __syncthreads();
    { float E[64]; prep<REV, 1>(Z, lbt + 8 * hi, lane, ttab + w * 128, E, lds, 32 * w + r32); }
    __syncthreads();
    f32x16 acc[2];
#pragma unroll
    for (int cb = 0; cb < 2; ++cb)
#pragma unroll
        for (int r = 0; r < 16; ++r) acc[cb][r] = 0.f;
    const int vbK0 = (int)(uintptr_t)lds + rb * 512 + v_rd_base(lane), vbV0 = (int)(uintptr_t)lds + 65536 + cb0 * 512 + v_rd_base(lane);
    for (int i = 0; i < 8; ++i) { const int blk = REV ? 7 - i : i;
        if (i > 0) { const LAS float* tb = ttab + blk * 128 + 32 * rb + 4 * hi;
#pragma unroll
            for (int g = 0; g < 4; ++g) { const f32x4 t = *(const LAS f32x4*)(tb + 8 * g);
#pragma unroll
                for (int j = 0; j < 4; ++j) { const float s = __builtin_amdgcn_exp2f(t[j]); acc[0][4 * g + j] *= s; acc[1][4 * g + j] *= s; } } }
        const int off = (blk >> 1) * 16384 + (blk & 1) * 8192; const int vk = vbK0 + off, vv = vbV0 + off;
#define HL_STEP(KS2) { const s16x4 al = tr_read<v_rd_off(0, KS2, 0)>(vk), ah = tr_read<v_rd_off(0, KS2, 1)>(vk), b0l = tr_read<v_rd_off(0, KS2, 0)>(vv), b0h = tr_read<v_rd_off(0, KS2, 1)>(vv), \
            b1l = tr_read<v_rd_off(1, KS2, 0)>(vv), b1h = tr_read<v_rd_off(1, KS2, 1)>(vv); \
            asm volatile("s_waitcnt lgkmcnt(0)" ::: "memory"); __builtin_amdgcn_sched_barrier(0); \
            const bf16x8 A_ = {al[0], al[1], al[2], al[3], ah[0], ah[1], ah[2], ah[3]}; \
            acc[0] = __builtin_amdgcn_mfma_f32_32x32x16_bf16(A_, (bf16x8){b0l[0], b0l[1], b0l[2], b0l[3], b0h[0], b0h[1], b0h[2], b0h[3]}, acc[0], 0, 0, 0); \
            acc[1] = __builtin_amdgcn_mfma_f32_32x32x16_bf16(A_, (bf16x8){b1l[0], b1l[1], b1l[2], b1l[3], b1h[0], b1h[1], b1h[2], b1h[3]}, acc[1], 0, 0, 0); }
        HL_STEP(0) HL_STEP(1)
#undef HL_STEP
    }
    const size_t slot = (size_t)((b * 8 + h) * 2 + dir) * PPB + scn::cp_of(c, dir);
    bf16_t* us = (bf16_t*)(F.ws + scn::US_HG_OFF) + slot * scn::HG_US_ELEMS;
    scn::store_state_tile(us, acc[0], rb, cb0, 4, r32, hi); scn::store_state_tile(us, acc[1], rb, cb0 + 1, 4, r32, hi);
    if (F.tid < 128) { float s = 0.f;
#pragma unroll
        for (int k = 0; k < 8; ++k) s += ttab[k * 128 + F.tid];
        ((float*)(F.ws + scn::HG_A_OFF))[slot * 128 + F.tid] = __builtin_amdgcn_exp2f(s); }
    __syncthreads();
}
__device__ __forceinline__ void local_unit(Frame& F, int l, int b, int h, int c) {
    const int w = F.wave, lane = F.lane, r32 = lane & 31, hi = lane >> 5;
    LAS char* lds = (LAS char*)F.lds;
    const bf16_t* GI = WSP(bf16_t, DY_PC) + (size_t)3 * MR * 1024 + ((size_t)(b * 8 + h) * TT + (size_t)c * 256 + 32 * w + r32) * 128 + 8 * hi;
    { u32x4 gv[8];
#pragma unroll
      for (int d0 = 0; d0 < 8; ++d0) gv[d0] = *(const u32x4*)(GI + 16 * d0);
      float lbv = 0.f; if (F.tid < 256) lbv = WSP(float, WS_LB)[l * 2048 + (F.tid >> 7) * 1024 + h * 128 + (F.tid & 127)];
#pragma unroll
      for (int d0 = 0; d0 < 8; ++d0) asm volatile("" : "+v"(gv[d0]));
      if (F.tid < 256) ((LAS float*)(lds + LBT_OFF))[F.tid] = lbv;
#pragma unroll
      for (int d0 = 0; d0 < 8; ++d0) { const int row = 32 * w + r32; *(LAS u32x4*)(lds + 65536 + (row >> 6) * 16384 + v_st(row & 63, 16 * d0 + 8 * hi)) = gv[d0]; } }
    local_dir<false>(F, l, b, h, c);
    local_dir<true>(F, l, b, h, c);
}
}

__device__ __forceinline__ void sa_phase(Frame& F, int l) {
    for (int u = F.bid; u < NB * 4 * PPB; u += F.G) { const int c = u % PPB, h = (u / PPB) & 3, b = u / (PPB * 4); scn::ret_local_unit(F, b, h, c); __syncthreads(); }
    frame_refresh(F);
    for (int u = F.G - 1 - F.bid; u < NB * 8 * PPB; u += F.G) { const int c = u % PPB, h = (u / PPB) & 7, b = u / (PPB * 8); hgm::local_unit(F, l, b, h, c); }
}
__device__ __forceinline__ void sc_phase(Frame& F, int l) {
    const int NC = (l == 1) ? PPB - 1 : PPB;
    for (int u = F.bid; u < NB * 4 * NC; u += F.G) { const int c = u % NC, h = (u / NC) & 3, b = u / (NC * 4); scn::ret_out_unit(F, l, b, h, c); }
    frame_refresh(F);
#ifndef HG_PROBE
#define HG_PROBE -1
#endif
    if (HG_PROBE >= 0) { for (int u = F.G - 1 - F.bid; u < NB * 8 * NC; u += F.G) { const int c = u % NC, h = (u / NC) & 7, b = u / (NC * 8); hgm::out_unit<(HG_PROBE < 0 ? 0 : HG_PROBE)>(F, l, b, h, c); } frame_refresh(F); }
    for (int u = F.G - 1 - F.bid; u < NB * 8 * NC; u += F.G) { const int c = u % NC, h = (u / NC) & 7, b = u / (NC * 8); hgm::out_unit<0>(F, l, b, h, c); }
}

#ifndef RET_MFMA
#define RET_MFMA 1
#endif
enum { PH_PRO = 0, PH_MODFIN, PH_N1, PH_GA, PH_ATT, PH_GB, PH_SA, PH_SB, PH_SC, PH_OG, PH_MG, PH_WO, PH_N2, PH_UP, PH_FIX, PH_DN, PH_COUNT };

template <int NN, int WG> struct PanelOrder : pg8::TileOrder<NN, WG> {
    int skip;
    __device__ __forceinline__ bool next(int i, pg8::Unit& u) const { const bool ok = pg8::TileOrder<NN, WG>::next(i, u); if (ok && skip) u.pm += (u.pm >= PPB - 1) ? 1 : 0; return ok; }
};
struct ProjOrder : PanelOrder<8, 4> {
    __device__ __forceinline__ bool next(int i, pg8::Unit& u) const { const int r = i / 3, n = i - 3 * r; const bool ok = PanelOrder<8, 4>::next(r, u); if (ok) { u.pm += n * NPAN; u.pn += 8 * n; } return ok; }
    __device__ __forceinline__ bool keep(int i) const { return (i % 3) != 2; }
};
template <int N, int WG, class Epi> __device__ __forceinline__ void run_gemm(Frame& F, const bf16_t* A, const bf16_t* Bt, int K, const Epi& E, bool skipctx = false) {
    pg8::Gemm g{A, Bt, MR, N, K}; PanelOrder<N / 256, WG> S; S.init(skipctx ? MR - 512 : MR, N, F.G, F.bid); S.skip = skipctx ? 1 : 0;
    pg8::gemm_phase<Epi, PanelOrder<N / 256, WG>, false>(F.lds, g, S, E, nullptr);
}
__device__ __forceinline__ EpiIn make_epi_in(Frame& F, int l, int pt0) {
    EpiIn E; E.pt0 = pt0;
    E.rq = WSP(bf16_t, DY_QKV); E.r2 = WSP(bf16_t, DY_PB); E.r1 = WSP(bf16_t, DY_PC);
    E.qkn = inp(F, I_QKN) + l * 128; E.ropeA = WSP(f32x2, WS_ROPEA); E.ropeB = WSP(f32x2, WS_ROPEB);
    return E;
}
__device__ __forceinline__ EpiRes make_epi_res(Frame& F, int l, int use_inputs, int gidx) {
    EpiRes E; E.srcx = use_inputs ? inp(F, I_X) : outp(F); E.srcc = use_inputs ? inp(F, I_CTX) : WSP(float, WS_XC); E.dstx = outp(F); E.dstc = WSP(float, WS_XC);
    E.gate0 = WSP(float, WS_MODV) + ((size_t)(l * 3) * 6 + gidx) * D; return E;
}

template <int PH> __device__ __forceinline__ void run_phase(Frame& F, int l) {
    frame_refresh(F);
    const bf16_t* h = WSP(bf16_t, WS_H); const bf16_t* wt = WSP(bf16_t, WS_WT);
    const bf16_t* wt_in = wt + WT_IN / 2;
    if constexpr (PH == PH_PRO) { p0_mod_partial(F); p0_tables(F); convert_weights(F, 0); }
    if constexpr (PH == PH_MODFIN) { p1_mod_final(F); }
    if constexpr (PH == PH_N1) { if (l == 1) convert_weights(F, 1, 2); norm_phase(F, l, 0); }
    if constexpr (PH == PH_GA) { const EpiIn E = make_epi_in(F, l, PT_DQ); run_gemm<9216, 8>(F, h, wt_in, D, E); }
#ifndef ATT_PROBE
#define ATT_PROBE -1
#endif
    if constexpr (PH == PH_ATT) { if (ATT_PROBE >= 0) { attn_phase<(ATT_PROBE < 0 ? 0 : ATT_PROBE)>(F, l); __syncthreads(); } attn_phase<0>(F, l); }
    if constexpr (PH == PH_GB) { }
    if constexpr (PH == PH_SA) { sa_phase(F, l); }
    if constexpr (PH == PH_SB) { scn::scan_states(F, true, true); }
    if constexpr (PH == PH_SC) { sc_phase(F, l); }
    if constexpr (PH == PH_OG) { EpiGates E; E.oB = WSP(bf16_t, DY_OB); E.oC = WSP(bf16_t, DY_OC); E.G = WSP(bf16_t, DY_MG); E.bias = inp(F, I_BGATE) + (size_t)l * 3 * D;
        run_gemm<8192, 4>(F, h, wt_in + (size_t)PT_RG * 256 * D, D, E, l == 1); }
    if constexpr (PH == PH_MG) {
        EpiProjAll E{WSP(bf16_t, DY_MG), WSP(bf16_t, DY_YO)};
        pg8::Gemm g{WSP(bf16_t, DY_OA), wt + WT_BR / 2, MR, 2048, 1024}; ProjOrder S; const bool sk = (l == 1); S.init(sk ? MR - 512 : MR, 2048, F.G, F.bid); S.skip = sk ? 1 : 0;
        pg8::gemm_phase<EpiProjAll, ProjOrder, false>(F.lds, g, S, E, nullptr);
    }
    if constexpr (PH == PH_WO) { const EpiRes E = make_epi_res(F, l, l == 0, 2); run_gemm<2048, 4>(F, WSP(bf16_t, DY_YO), wt + WT_OUT / 2, D, E, l == 1); }
    if constexpr (PH == PH_N2) { norm_phase(F, l, 1); }
    if constexpr (PH == PH_UP) { EpiConv E; E.g = WSP(bf16_t, DY_G); E.raw = WSP(float, DY_RAW); E.cw = inp(F, I_CONVW) + (size_t)l * 3 * NUP; E.cb = inp(F, I_CONVB) + (size_t)l * NUP;
        run_gemm<NUP, 8>(F, h, wt + WT_UP / 2, D, E, l == 1); }
    if constexpr (PH == PH_FIX) { ffn_fixup(F, l); }
    if constexpr (PH == PH_DN) { const EpiRes E = make_epi_res(F, l, 0, 5); run_gemm<2048, 4>(F, WSP(bf16_t, DY_G), wt + WT_DOWN / 2, DFF, E, l == 1);
        if (l == 0) { frame_refresh(F); convert_weights(F, 1, 1); } }
}

__device__ __forceinline__ void frame_init(Frame& F, const Args& a, unsigned char* lds) {
    F.lds = (LAS unsigned char*)lds; F.a = &a; F.G = gridDim.x; F.bid = blockIdx.x; frame_refresh(F);
}
template <int PH> __global__ void __launch_bounds__(NTHR, 2) k_phase(Args a) {
    extern __shared__ __attribute__((aligned(16))) unsigned char lds[];
    Frame F; frame_init(F, a, lds);
    run_phase<PH>(F, a.layer);
}
#ifndef MK_SINGLE
#define MK_SINGLE 1
#endif
__global__ void __launch_bounds__(NTHR, 2) k_all(Args a) {
    extern __shared__ __attribute__((aligned(16))) unsigned char lds[];
    Frame F; frame_init(F, a, lds);
    for (int u = F.tid; u < (LDS_BYTES - LDSCTL_OFF) / 4; u += NTHR) ((LAS unsigned*)(F.lds + LDSCTL_OFF))[u] = 0u;
    __syncthreads();
    (void)xcd_barrier_post((unsigned*)(a.ws + WS_CTL) + CW_BAR, (volatile LAS unsigned*)(F.lds + MISC_OFF + 32));
#define GRID_BAR() do { XcdBarrier b_; unsigned* bp_ = (unsigned*)(a.ws + WS_CTL) + CW_BAR; asm volatile("" : "+s"(bp_)); b_.bar = bp_; b_.x = xb_xcc_id(); \
        b_.st = (volatile LAS unsigned*)(F.lds + MISC_OFF + 32); xcd_barrier(b_); } while (0)
#ifndef PROBE_MASK
#define PROBE_MASK 0
#endif
#ifndef PROBE_T
#define PROBE_T 0
#endif
    unsigned long long pt0 = 0, pt1 = 0, pc0 = 0, pc1 = 0;
#define TSTART(ph, l_) do { if (PROBE_T && (ph) == PROBE_T - 1 && (l_) == 0) { pt0 = __builtin_amdgcn_s_memrealtime(); pc0 = (unsigned long long)clock64(); } } while (0)
#define TSTOP(ph, l_)  do { if (PROBE_T && (ph) == PROBE_T - 1 && (l_) == 0) { pt1 = __builtin_amdgcn_s_memrealtime(); pc1 = (unsigned long long)clock64(); } } while (0)
#define RUN(ph, l_, grp) do { TSTART(ph, l_); run_phase<ph>(F, l_); GRID_BAR(); TSTOP(ph, l_); if ((PROBE_MASK >> (grp)) & 1) { run_phase<ph>(F, l_); GRID_BAR(); } } while (0)
    RUN(PH_PRO, 0, 0); RUN(PH_MODFIN, 0, 0);
#pragma unroll 1
    for (int l = 0; l < 2; ++l) {
        RUN(PH_N1, l, 0);
        RUN(PH_GA, l, 1);
        RUN(PH_ATT, l, 2);
        RUN(PH_SA, l, 3);
        run_phase<PH_SB>(F, l); GRID_BAR();
        RUN(PH_SC, l, 4);
        run_phase<PH_OG>(F, l); GRID_BAR();
        RUN(PH_MG, l, 5);
        run_phase<PH_WO>(F, l); GRID_BAR();
        RUN(PH_N2, l, 0);
        RUN(PH_UP, l, 6);
        RUN(PH_FIX, l, 0);
        run_phase<PH_DN>(F, l); GRID_BAR();
    }
#undef RUN
    if (PROBE_T) {
        float* slot = (float*)(F.ws + WS_SCAL) + 64;
        if (F.bid == 0 && threadIdx.x == 0) { const float mhz = (float)(pc1 - pc0) / ((float)(pt1 - pt0) * 0.01f); *slot = floorf(mhz / 50.0f) * 50.0f; }
        GRID_BAR();
        const float v = *slot;
        for (size_t i = (size_t)F.bid * NTHR + threadIdx.x; i < (size_t)NB * T * D; i += (size_t)F.G * NTHR) a.out[i] = v;
    }
#undef GRID_BAR
}
__global__ void k_fill(float* out, size_t n, float v) { for (size_t i = (size_t)blockIdx.x * blockDim.x + threadIdx.x; i < n; i += (size_t)gridDim.x * blockDim.x) out[i] = v; }

template <int PH> static void launch_phase(const Args& a0, int layer, int grid, hipStream_t stream) {
    static bool attr = false;
    if (!attr) { if (hipFuncSetAttribute((const void*)k_phase<PH>, hipFuncAttributeMaxDynamicSharedMemorySize, LDS_BYTES) != hipSuccess) fprintf(stderr, "kernel_launch: hipFuncSetAttribute failed for phase %d\n", PH); attr = true; }
    Args a = a0; a.layer = layer;
    hipLaunchKernelGGL(k_phase<PH>, dim3(grid), dim3(NTHR), LDS_BYTES, stream, a);
    const hipError_t e = hipPeekAtLastError(); if (e != hipSuccess) fprintf(stderr, "kernel_launch: phase %d launch failed: %s\n", PH, hipGetErrorName(e));
}
extern "C" void kernel_launch(void* const* d_in, const int* in_sizes, int n_in, void* d_out, int out_size, void* d_ws, size_t ws_size, hipStream_t stream) {
    static int grid = 0;
    if (grid == 0) { int dev = 0, cus = 0; if (hipGetDevice(&dev) != hipSuccess || hipDeviceGetAttribute(&cus, hipDeviceAttributeMultiprocessorCount, dev) != hipSuccess || cus < 1) cus = 256; grid = cus; }
    if (n_in != N_INPUTS || out_size != NB * T * D || ws_size < WS_END) {
        fprintf(stderr, "kernel_launch: unexpected shapes: n_in %d out %d ws %zu (need %zu)\n", n_in, out_size, ws_size, (size_t)WS_END);
        hipLaunchKernelGGL(k_fill, dim3(1024), dim3(256), 0, stream, (float*)d_out, (size_t)out_size, (float)(ws_size >> 20));
        return;
    }
    Args a{};
    for (int i = 0; i < N_INPUTS; ++i) a.in[i] = (const float*)d_in[i];
    a.out = (float*)d_out; a.ws = (unsigned char*)d_ws; a.layer = 0; a.ph_lo = 0; a.ph_hi = 0; a.pad = 0;
#if MK_SINGLE
    {
        static bool attr = false;
        if (!attr) { if (hipFuncSetAttribute((const void*)k_all, hipFuncAttributeMaxDynamicSharedMemorySize, LDS_BYTES) != hipSuccess) fprintf(stderr, "kernel_launch: hipFuncSetAttribute failed\n");
            int per_cu = 0; if (hipOccupancyMaxActiveBlocksPerMultiprocessor(&per_cu, (const void*)k_all, NTHR, LDS_BYTES) != hipSuccess || per_cu < 1) fprintf(stderr, "kernel_launch: occupancy query says %d blocks per CU\n", per_cu);
            (void)hipGetLastError(); attr = true; }
        if (hipMemsetAsync((char*)d_ws + WS_CTL, 0, CTL_ZERO_BYTES, stream) != hipSuccess) { fprintf(stderr, "kernel_launch: memset failed\n"); return; }
        hipLaunchKernelGGL(k_all, dim3(grid), dim3(NTHR), LDS_BYTES, stream, a);
        const hipError_t e = hipPeekAtLastError(); if (e != hipSuccess) fprintf(stderr, "kernel_launch: launch failed: %s\n", hipGetErrorName(e));
        return;
    }
#endif
    launch_phase<PH_PRO>(a, 0, grid, stream);
    launch_phase<PH_MODFIN>(a, 0, grid, stream);
    for (int l = 0; l < 2; ++l) {
        launch_phase<PH_N1>(a, l, grid, stream); launch_phase<PH_GA>(a, l, grid, stream); launch_phase<PH_ATT>(a, l, grid, stream); launch_phase<PH_GB>(a, l, grid, stream);
        launch_phase<PH_SA>(a, l, grid, stream); launch_phase<PH_SB>(a, l, grid, stream); launch_phase<PH_SC>(a, l, grid, stream);
        launch_phase<PH_OG>(a, l, grid, stream); launch_phase<PH_MG>(a, l, grid, stream);
        launch_phase<PH_WO>(a, l, grid, stream); launch_phase<PH_N2>(a, l, grid, stream); launch_phase<PH_UP>(a, l, grid, stream); launch_phase<PH_FIX>(a, l, grid, stream);
        launch_phase<PH_DN>(a, l, grid, stream);
    }
}
```

```cpp
#include <hip/hip_runtime.h>
#include <cstdio>
#include <cstdint>
namespace pg8 {
#define PG8_LAS __attribute__((address_space(3)))
typedef unsigned short bf16_t;
typedef short bf16x8 __attribute__((ext_vector_type(8)));
typedef float f32x4 __attribute__((ext_vector_type(4)));
typedef unsigned u32x4 __attribute__((ext_vector_type(4)));
constexpr int BM = 256, BK = 64, HALF = 128, HTB = HALF * BK * 2  , STAGE_BYTES = 8 * HTB, NXCD = 8, WGM = 8;

__host__ __device__ __forceinline__ int lds_byte(int r, int c) { const int st = (r >> 4) * 2 + (c >> 5), rr = r & 15, cc = c & 31, ob = rr * 64 + cc * 2; return st * 1024 + (ob ^ (((ob >> 9) & 1) << 5)); }
__host__ __device__ __forceinline__ void stage_rc(int b, int& R, int& C) { const int st = b / 1024, sb = b % 1024, swz = sb ^ (((sb >> 9) & 1) << 5); R = (st >> 1) * 16 + swz / 64; C = (st & 1) * 32 + (swz % 64) / 2; }
__host__ __device__ __forceinline__ int perm32(int rho) { const int n = rho >> 4, i = rho & 15; return 8 * (i >> 2) + 4 * n + (i & 3); }

struct Unit { int pm, pn; };
struct Gemm { const bf16_t* A; const bf16_t* Bt; int M, N, K; };

struct StaticOrder {
    int nM, nN, nwg, G, c, wgm;
    __host__ __device__ void init(int M, int N, int G_, int c_) { nM = M / BM; nN = N / BM; nwg = nM * nN; G = G_; c = c_; wgm = WGM; }
    __host__ __device__ bool next(int i, Unit& u) const {
        const long L = (long)i * G + c; if (L >= nwg) return false;
        int wgid = (int)L; { const int q = nwg / NXCD, r = nwg % NXCD, xcd = wgid % NXCD, off = wgid / NXCD; wgid = (xcd < r ? xcd * (q + 1) : r * (q + 1) + (xcd - r) * q) + off; }
        const int nig = wgm * nN, gid = wgid / nig, fm = gid * wgm, gsz = (nM - fm) < wgm ? (nM - fm) : wgm;
        u.pm = fm + ((wgid % nig) % gsz); u.pn = (wgid % nig) / gsz; return true;
    }
    __device__ __forceinline__ void a_ready(const Unit&) const {}
    __device__ __forceinline__ void done(const Unit&) const {}
};
template <int NN, int WG> struct TileOrder {
    int nM, G;
    __host__ __device__ void init(int M, int, int G_, int) { nM = M / BM; G = G_; }
    __device__ __forceinline__ bool next(int i, Unit& u) const {
        const int nwg = nM * NN; const long L = (long)i * G + (int)blockIdx.x; if (L >= nwg) return false;
        constexpr int gsz = WG * NN; const int share = ((nwg / NXCD) / gsz) * gsz;
        int wgid = (int)L; if (wgid < NXCD * share) wgid = (wgid % NXCD) * share + wgid / NXCD;
        const int gid = wgid / gsz, fm = gid * WG, gh = (nM - fm) < WG ? (nM - fm) : WG, in = wgid - gid * gsz;
        u.pm = fm + in % gh; u.pn = in / gh; return true;
    }
    __device__ __forceinline__ void a_ready(const Unit&) const {}
    __device__ __forceinline__ void done(const Unit&) const {}
};
struct CountedOrder : StaticOrder {
    const unsigned* ready; unsigned need; unsigned* tmo;
    __device__ __forceinline__ void a_ready(const Unit& u) const {
        if (threadIdx.x < 64) {
            const unsigned long long t0 = __builtin_amdgcn_s_memrealtime(); unsigned polls = 0;
            while ((unsigned)__builtin_amdgcn_readfirstlane(__hip_atomic_load(ready + 64 * u.pm, __ATOMIC_RELAXED, __HIP_MEMORY_SCOPE_AGENT)) < need) {
                if ((++polls & 255u) == 0u && __builtin_amdgcn_readfirstlane(__hip_atomic_load(tmo, __ATOMIC_RELAXED, __HIP_MEMORY_SCOPE_AGENT)) != 0u) break;
                if (__builtin_amdgcn_s_memrealtime() - t0 > 2000000ull) {
                    if (threadIdx.x == 0) { unsigned expect = 0u; __hip_atomic_compare_exchange_strong(tmo + 1, &expect, 0x600u | (unsigned)(u.pm & 0xff), __ATOMIC_RELAXED, __ATOMIC_RELAXED, __HIP_MEMORY_SCOPE_AGENT); __hip_atomic_store(tmo, 1u, __ATOMIC_RELAXED, __HIP_MEMORY_SCOPE_AGENT); }
                    break; }
                __builtin_amdgcn_s_sleep(2); }
            __builtin_amdgcn_fence(__ATOMIC_ACQUIRE, "agent");
            asm volatile("s_waitcnt vmcnt(0)" ::: "memory");
        }
#if !defined(BROKEN_HOOK_NO_BARRIER)
        asm volatile("" ::: "memory"); __builtin_amdgcn_s_barrier(); asm volatile("" ::: "memory");
#endif
    }
};

template <class T, class = void> struct keeps_acc { static constexpr bool value = false; };
template <class T> struct keeps_acc<T, decltype((void)T::KEEPS_ACC)> { static constexpr bool value = true; };
template <class Epi, class Sched, bool STAMP = false>
__device__ __forceinline__ void gemm_phase(PG8_LAS unsigned char* lds, const Gemm g, const Sched& S, const Epi& E, unsigned long long* stamps) {
    int tid_ = threadIdx.x; asm volatile("" : "+v"(tid_));
    const int tid = tid_, wid = __builtin_amdgcn_readfirstlane(tid >> 6), lane = tid & 63, wr = wid >> 2, wc = wid & 3, fr = lane & 15, fq = lane >> 4;
    const int K = g.K, nt = K / BK;
    int ts_lo = 0, ts_hi = 0, nts = 0; const unsigned long long rt_entry = STAMP ? (unsigned long long)wall_clock64() : 0ull;
#define PG8_STAMP() do { if (STAMP && wid == 0 && nts < 64) { const unsigned long long _c = (unsigned long long)clock64(); \
        ts_lo = (lane == nts) ? (int)(unsigned)_c : ts_lo; ts_hi = (lane == nts) ? (int)(unsigned)(_c >> 32) : ts_hi; ++nts; } } while (0)
    PG8_STAMP();
    unsigned voffA[2], voffB[2];
#pragma unroll
    for (int i = 0; i < 2; ++i) { int R, C; stage_rc(tid * 16 + i * 8192, R, C); const int Rb = Epi::PERM ? ((R & ~31) + perm32(R & 31)) : R;
        voffA[i] = (unsigned)(R * K + C) * 2u; voffB[i] = (unsigned)(Rb * K + C) * 2u; }
    const size_t kstep = (size_t)(BK * 2);
    const size_t hstep = (size_t)HALF * K * 2;
    const size_t tstep = 2 * hstep;
    const unsigned ldsw = (unsigned)wid * 1024u;
    const int aoff = lds_byte(wr * 64 + fr, fq * 8), boff = lds_byte(wc * 32 + fr, fq * 8);
#define PG8_SA(b, h) (((b) * 2 + (h)) * HTB)
#define PG8_SB(b, h) ((4 + (b) * 2 + (h)) * HTB)
#define PG8_STAGE(bufoff, gbase, voff) do { const char* g_ = (const char*)(gbase); asm volatile("" : "+s"(g_));     \
        _Pragma("unroll") for (int _i = 0; _i < 2; ++_i) { asm volatile("" : "+v"((voff)[_i]));                         \
        __builtin_amdgcn_global_load_lds((const unsigned*)(g_ + (voff)[_i]), (PG8_LAS unsigned*)(lds + (bufoff) + ldsw + _i * 8192), 16, 0, 0); } } while (0)
#define PG8_LDA(dst, b, h) do { _Pragma("unroll") for (int m = 0; m < 4; ++m) _Pragma("unroll") for (int k = 0; k < 2; ++k) dst[m][k] = *(const PG8_LAS bf16x8*)(lds + PG8_SA(b, h) + aoff + m * 2048 + k * 1024); } while (0)
#define PG8_LDB(dst, b, h) do { _Pragma("unroll") for (int n = 0; n < 2; ++n) _Pragma("unroll") for (int k = 0; k < 2; ++k) dst[n][k] = *(const PG8_LAS bf16x8*)(lds + PG8_SB(b, h) + boff + n * 2048 + k * 1024); } while (0)
#define PG8_MMA(ai, bj, At, Bt) do { __builtin_amdgcn_s_setprio(1); _Pragma("unroll") for (int m = 0; m < 4; ++m) _Pragma("unroll") for (int n = 0; n < 2; ++n) _Pragma("unroll") for (int k = 0; k < 2; ++k) \
        acc[ai][bj][m][n] = __builtin_amdgcn_mfma_f32_16x16x32_bf16(Bt[n][k], At[m][k], acc[ai][bj][m][n], 0, 0, 0); __builtin_amdgcn_s_setprio(0); } while (0)
#define PG8_WAIT_V(n) asm volatile("s_waitcnt vmcnt(" #n ")" ::: "memory")
#define PG8_WAIT_L(n) asm volatile("s_waitcnt lgkmcnt(" #n ")" ::: "memory")
#define PG8_BAR __builtin_amdgcn_s_barrier()
#define PG8_SCHED __builtin_amdgcn_sched_barrier(0)
    Unit cur, nxt; int ui = 0;
    if (!S.next(0, cur)) return;
    f32x4 acc[2][2][4][2];
#pragma unroll
    for (int a = 0; a < 2; ++a)
#pragma unroll
        for (int b = 0; b < 2; ++b)
#pragma unroll
            for (int m = 0; m < 4; ++m)
#pragma unroll
                for (int n = 0; n < 2; ++n) acc[a][b][m][n] = (f32x4){0.f, 0.f, 0.f, 0.f};
    bf16x8 At[4][2], B0[2][2], B1[2][2];
    const char* cA = (const char*)g.A + (size_t)cur.pm * tstep; const char* cB = (const char*)g.Bt + (size_t)cur.pn * tstep;
    S.a_ready(cur);
    PG8_STAGE(PG8_SB(0, 0), cB, voffB); PG8_STAGE(PG8_SA(0, 0), cA, voffA); PG8_STAGE(PG8_SB(0, 1), cB + hstep, voffB); PG8_STAGE(PG8_SA(0, 1), cA + hstep, voffA);
    if (wr == 1) PG8_BAR;
    PG8_WAIT_V(4); PG8_BAR;
    PG8_STAGE(PG8_SB(1, 0), cB + kstep, voffB); PG8_STAGE(PG8_SA(1, 0), cA + kstep, voffA); PG8_STAGE(PG8_SB(1, 1), cB + hstep + kstep, voffB);
    PG8_WAIT_V(6); PG8_BAR;
    PG8_STAMP();
    for (;;) {
        const bool has_next = S.next(ui + 1, nxt);
        const char* nA = has_next ? (const char*)g.A + (size_t)nxt.pm * tstep : cA; const char* nB = has_next ? (const char*)g.Bt + (size_t)nxt.pn * tstep : cB;
        for (int t = 0; t < nt; t += 2) {
            const bool last = (t == nt - 2);
            const char* a1 = cA + (size_t)(t + 1) * kstep;
            const char* a2 = last ? nA : cA + (size_t)(t + 2) * kstep; const char* b2 = last ? nB : cB + (size_t)(t + 2) * kstep;
            const char* a3 = a2 + kstep; const char* b3 = b2 + kstep;
            if (last && has_next) S.a_ready(nxt);
            PG8_LDB(B0, 0, 0); PG8_SCHED; PG8_LDA(At, 0, 0); PG8_STAGE(PG8_SA(1, 1), a1 + hstep, voffA);
            PG8_WAIT_L(8); PG8_BAR; PG8_WAIT_L(0); PG8_MMA(0, 0, At, B0); PG8_BAR; PG8_SCHED;
            PG8_LDB(B1, 0, 1); PG8_STAGE(PG8_SB(0, 0), b2, voffB);
            PG8_BAR; PG8_WAIT_L(0); PG8_MMA(0, 1, At, B1); PG8_BAR;
            PG8_LDA(At, 0, 1); PG8_STAGE(PG8_SA(0, 0), a2, voffA);
            PG8_BAR; PG8_WAIT_L(0); PG8_MMA(1, 0, At, B0); PG8_BAR; PG8_SCHED;
            PG8_STAGE(PG8_SB(0, 1), b2 + hstep, voffB);
            PG8_WAIT_V(6); PG8_BAR; PG8_MMA(1, 1, At, B1); PG8_BAR;
            PG8_LDB(B0, 1, 0); PG8_SCHED; PG8_LDA(At, 1, 0); PG8_STAGE(PG8_SA(0, 1), a2 + hstep, voffA);
            PG8_WAIT_L(8); PG8_BAR; PG8_WAIT_L(0); PG8_MMA(0, 0, At, B0); PG8_BAR; PG8_SCHED;
            PG8_LDB(B1, 1, 1); PG8_STAGE(PG8_SB(1, 0), b3, voffB);
            PG8_BAR; PG8_WAIT_L(0); PG8_MMA(0, 1, At, B1); PG8_BAR;
            PG8_LDA(At, 1, 1); PG8_STAGE(PG8_SA(1, 0), a3, voffA);
            PG8_BAR; PG8_WAIT_L(0); PG8_MMA(1, 0, At, B0); PG8_BAR; PG8_SCHED;
            PG8_STAGE(PG8_SB(1, 1), b3 + hstep, voffB);
            PG8_WAIT_V(6); PG8_BAR; PG8_MMA(1, 1, At, B1); PG8_BAR;
        }
        PG8_STAMP();
        if constexpr (!Epi::AFTER_DRAIN) { E(acc, cur, wr, wc, fr, fq); S.done(cur); }
        PG8_STAMP();
        if (!has_next) break;
        bool keep_acc = false;
        if constexpr (keeps_acc<Epi>::value) keep_acc = S.keep(ui);
        if (!keep_acc) {
#pragma unroll
        for (int a = 0; a < 2; ++a)
#pragma unroll
            for (int b = 0; b < 2; ++b)
#pragma unroll
                for (int m = 0; m < 4; ++m)
#pragma unroll
                    for (int n = 0; n < 2; ++n) acc[a][b][m][n] = (f32x4){0.f, 0.f, 0.f, 0.f};
        }
        cur = nxt; cA = nA; cB = nB; ++ui;
    }
    PG8_WAIT_V(0);
    if (wr == 0) PG8_BAR;
    PG8_BAR;
    if constexpr (Epi::AFTER_DRAIN) { E.fused(acc, cur, wr, wc, fr, fq, lds, wid, lane); S.done(cur); }
    PG8_STAMP();
    if (STAMP && wid == 0) { stamps[lane] = lane < nts ? (((unsigned long long)(unsigned)ts_hi << 32) | (unsigned)ts_lo) : 0ull;
        if (lane == 62) stamps[62] = rt_entry; if (lane == 63) stamps[63] = (unsigned long long)wall_clock64(); }
#undef PG8_STAMP
#undef PG8_SA
#undef PG8_SB
#undef PG8_STAGE
#undef PG8_LDA
#undef PG8_LDB
#undef PG8_MMA
#undef PG8_WAIT_V
#undef PG8_WAIT_L
#undef PG8_BAR
#undef PG8_SCHED
}
}

#define GAS __attribute__((address_space(1)))
#define LAS __attribute__((address_space(3)))
typedef unsigned short bf16_t;
typedef short bf16x8 __attribute__((ext_vector_type(8)));
typedef short s16x4 __attribute__((ext_vector_type(4)));
typedef float f32x4 __attribute__((ext_vector_type(4)));
typedef float f32x2 __attribute__((ext_vector_type(2)));
typedef float f32x16 __attribute__((ext_vector_type(16)));
typedef unsigned u32x4 __attribute__((ext_vector_type(4)));
typedef unsigned u32x2 __attribute__((ext_vector_type(2)));

typedef __bf16 bf16x2_t __attribute__((ext_vector_type(2)));
__device__ __forceinline__ unsigned cvtpk_c(float lo, float hi) { const f32x2 v = {lo, hi}; return __builtin_bit_cast(unsigned, __builtin_convertvector(v, bf16x2_t)); }
__device__ __forceinline__ unsigned cvtpk(float lo, float hi) { unsigned r; asm volatile("v_cvt_pk_bf16_f32 %0, %1, %2" : "=v"(r) : "v"(lo), "v"(hi)); return r; }
__device__ __forceinline__ float bf2f(unsigned short b) { return __uint_as_float(((unsigned)b) << 16); }
__device__ __forceinline__ float bflo(unsigned w) { return __uint_as_float(w << 16); }
__device__ __forceinline__ float bfhi(unsigned w) { return __uint_as_float(w & 0xffff0000u); }
__device__ __forceinline__ float wave_sum(float v) {
#pragma unroll
    for (int o = 1; o < 64; o <<= 1) v += __shfl_xor(v, o);
    return v;
}
__device__ __forceinline__ float sigmoidf_(float x) { return __builtin_amdgcn_rcpf(1.0f + __builtin_amdgcn_exp2f(-1.4426950408889634f * x)); }
__device__ __forceinline__ float siluf_(float x) { return x * __builtin_amdgcn_rcpf(1.0f + __builtin_amdgcn_exp2f(-1.4426950408889634f * x)); }

#define XB_TMO      128
#define XB_XCNT(j)  (256  + 64 * (j))
#define XB_XSUB(j)  (1280 + 64 * (j))
#define XB_XGEN(j)  (2304 + 64 * (j))
#define XB_TOP      3328
#define XB_TOPGEN   3392
#define XCD_BAR_WORDS 3456
#define XB_SPIN_CAP (1u << 18)

__device__ __forceinline__ unsigned xb_ld(unsigned* p)              { return __hip_atomic_load(p, __ATOMIC_RELAXED, __HIP_MEMORY_SCOPE_AGENT); }
__device__ __forceinline__ unsigned xb_add(unsigned* p, unsigned v) { return __hip_atomic_fetch_add(p, v, __ATOMIC_RELAXED, __HIP_MEMORY_SCOPE_AGENT); }
__device__ __forceinline__ unsigned xb_xcc_id() { return (unsigned)__builtin_amdgcn_s_getreg((3 << 11) | 20) & 0xFu; }
#define XB_SPIN(cond, bar) do { unsigned _sp = 0; while (cond) { __builtin_amdgcn_s_sleep(1); \
    if ((++_sp & 255u) == 0u) { if (xb_ld(&(bar)[XB_TMO])) break; if (_sp > XB_SPIN_CAP) { atomicAdd(&(bar)[XB_TMO], 1u); break; } } } } while (0)

struct XcdBarrier {
    unsigned* bar; unsigned x;
    volatile LAS unsigned* st;
};
__device__ __forceinline__ XcdBarrier xcd_barrier_post(unsigned* bar, volatile LAS unsigned* st) {
    XcdBarrier b; b.bar = bar; b.x = xb_xcc_id(); b.st = st;
    if (threadIdx.x == 0) (void)xb_add(&bar[XB_XCNT(b.x)], 1u);
    return b;
}
__device__ __forceinline__ void xcd_barrier_complete(unsigned* bar, unsigned x, unsigned& nloc, unsigned& nx) {
    const unsigned G = gridDim.x * gridDim.y * gridDim.z;
    unsigned sum, cnt, mine, sp = 0u;
    for (;;) {
        sum = 0u; cnt = 0u; mine = 0u;
#pragma unroll
        for (unsigned j = 0; j < 16; ++j) { const unsigned c = xb_ld(&bar[XB_XCNT(j)]); sum += c; cnt += (c > 0u) ? 1u : 0u; mine = (j == x) ? c : mine; }
        if (sum == G) break;
        __builtin_amdgcn_s_sleep(1);
        if ((++sp & 255u) == 0u) { if (xb_ld(&bar[XB_TMO])) break; if (sp > XB_SPIN_CAP) { atomicAdd(&bar[XB_TMO], 1u); break; } }
    }
    nloc = mine > 0u ? mine : 1u; nx = cnt > 0u ? cnt : 1u;
}
__device__ __forceinline__ void xcd_barrier(const XcdBarrier& b) {
    asm volatile("s_waitcnt vmcnt(0)" ::: "memory");
    __syncthreads();
    if (threadIdx.x == 0) {
        unsigned* bar = b.bar;
        __builtin_amdgcn_s_waitcnt(0);
        unsigned nloc = b.st[0], nx = b.st[1];
        if (nloc == 0u) { xcd_barrier_complete(bar, b.x, nloc, nx); b.st[0] = nloc; b.st[1] = nx; }
        const unsigned old = xb_add(&bar[XB_XSUB(b.x)], 1u);
        const unsigned gen = old / nloc;
        if (old + 1u == (gen + 1u) * nloc) {
            __builtin_amdgcn_fence(__ATOMIC_RELEASE, "agent");
            asm volatile("s_waitcnt vmcnt(0)" ::: "memory");
            const unsigned og = xb_add(&bar[XB_TOP], 1u);
            const unsigned tg = og / nx;
            if (og + 1u == (tg + 1u) * nx) xb_add(&bar[XB_TOPGEN], 1u);
            else XB_SPIN(xb_ld(&bar[XB_TOPGEN]) == tg, bar);
            __builtin_amdgcn_fence(__ATOMIC_ACQUIRE, "agent");
            xb_add(&bar[XB_XGEN(b.x)], 1u);
            asm volatile("s_waitcnt vmcnt(0)" ::: "memory");
        } else {
            XB_SPIN(xb_ld(&bar[XB_XGEN(b.x)]) == gen, bar);
            __builtin_amdgcn_fence(__ATOMIC_ACQUIRE, "agent");
            asm volatile("s_waitcnt vmcnt(0)" ::: "memory");
        }
    }
    __syncthreads();
}

constexpr int D = 2048, NB = 2, T = 16384, LC = 256, TT = T + LC  , MR = NB * TT  ;
constexpr int NPAN = MR / 256  , PPB = TT / 256  ;
constexpr int NIN = 17408, DFF = 5504, NUP = 2 * DFF;
constexpr int NWAVES = 8, NTHR = 512;
constexpr float EPS = 1e-6f;
constexpr float LOG2E = 1.4426950408889634f;

enum { I_X = 0, I_C, I_CTX, I_CCTX, I_WMOD, I_BMOD, I_WIN, I_BGATE, I_QKN, I_LAMBDA, I_SUBLN, I_RNORM, I_GLB, I_GNORM, I_WBR, I_WOUT, I_WUP, I_CONVW, I_CONVB, I_WDOWN, N_INPUTS };

enum { TY_ROPE64 = 0, TY_ROPE128 = 1, TY_PLAIN = 2 };
enum { PT_DQ = 0, PT_DK = 4, PT_DV = 8, PT_RQ = 12, PT_RK = 14, PT_RV = 16, PT_GQ = 20, PT_GF = 24, PT_GB = 28, PT_GI = 32, PT_RG = 36, PT_GG = 40, PT_MA = 44, PT_MB = 52, PT_MC = 60, PT_END = 68 };
__host__ __device__ __forceinline__ int pt_logical_base(int pt) {
    if (pt < PT_RQ) return 256 * pt;
    if (pt < PT_RV) return 3072 + 256 * (pt - PT_RQ);
    if (pt < PT_GQ) return 4096 + 256 * (pt - PT_RV);
    if (pt < PT_RG) return 6144 + 256 * (pt - PT_GQ);
    if (pt < PT_GG) return 5120 + 256 * (pt - PT_RG);
    if (pt < PT_MA) return 10240 + 256 * (pt - PT_GG);
    return 11264 + 256 * (pt - PT_MA);
}
__host__ __device__ __forceinline__ int pt_type(int pt) { return pt < PT_DV ? TY_ROPE64 : (pt >= PT_RQ && pt < PT_RV) ? TY_ROPE128 : TY_PLAIN; }
__host__ __device__ __forceinline__ int perm_col(int type, int p) {
    const int bj = p >> 7, wc = (p >> 5) & 3, n = (p >> 4) & 1, fq = (p >> 2) & 3, e = p & 3;
    if (type == TY_ROPE64)  return 64 * wc + 32 * (fq >> 1) + 16 * bj + 8 * (fq & 1) + 4 * n + e;
    if (type == TY_ROPE128) return 128 * (wc >> 1) + 64 * (wc & 1) + 32 * bj + 8 * fq + 4 * n + e;
    return 64 * wc + 32 * bj + 8 * fq + 4 * n + e;
}
__host__ __device__ __forceinline__ int perm_col_up(int p) { const int bj = p >> 7, wc = (p >> 5) & 3, n = (p >> 4) & 1, fq = (p >> 2) & 3, e = p & 3; return 128 * bj + 32 * wc + 8 * fq + 4 * n + e; }

constexpr size_t MiB = 1u << 20;
constexpr size_t WS_CTL = 0, CTL_ZERO_BYTES = 1 * MiB;
constexpr size_t WS_MODP = 1 * MiB;
constexpr size_t WS_MODV = 6 * MiB;
constexpr size_t WS_ROPEA = 7 * MiB;
constexpr size_t WS_ROPEB = 7 * MiB + 64 * 1024;
constexpr size_t WS_LB = 7 * MiB + 256 * 1024;
constexpr size_t WS_SCAL = 7 * MiB + 512 * 1024;
constexpr size_t WS_XC = 9 * MiB;
constexpr size_t WS_WT = 13 * MiB;
constexpr size_t WT_IN = 0, WT_BR = 68 * MiB, WT_OUT = 80 * MiB, WT_UP = 88 * MiB, WT_DOWN = 131 * MiB;
constexpr size_t WS_H = 166 * MiB;
constexpr size_t WS_DYN = 296 * MiB;
constexpr size_t DY_OA = WS_DYN, DY_OB = WS_DYN + 65 * MiB, DY_OC = WS_DYN + 130 * MiB;
constexpr size_t DY_OSUB = WS_DYN + 195 * MiB;
constexpr size_t DY_US = DY_OSUB;
constexpr size_t DY_QKV = WS_DYN + 65 * MiB;
constexpr size_t DY_O1 = WS_DYN + 260 * MiB;
constexpr size_t DY_PC = WS_DYN + 325 * MiB;
constexpr size_t DY_PB = WS_DYN + 585 * MiB;
constexpr size_t DY_MG = WS_DYN + 325 * MiB;
constexpr size_t DY_Y = DY_OSUB, DY_YO = DY_OSUB;
constexpr size_t DY_G = WS_DYN, DY_RAW = WS_DYN + 350 * MiB;
constexpr size_t WS_END = WS_DYN + 715 * MiB;
constexpr size_t SZ_ROWS1K = (size_t)MR * 1024 * 2;

constexpr int CW_BAR = 4096;

constexpr int RING_BYTES = 131072, LDSCTL_OFF = RING_BYTES, MISC_OFF = LDSCTL_OFF + 320, LDS_BYTES = 147456;

struct Args { const float* in[N_INPUTS]; float* out; unsigned char* ws; int layer, ph_lo, ph_hi, pad; };

struct Frame {
    LAS unsigned char* lds;
    int tid, lane, wave, G, bid;
    const Args* a; unsigned char* ws;
};
__device__ __forceinline__ float* outp(const Frame& F) { GAS float* p = (GAS float*)F.a->out; asm volatile("" : "+s"(p)); return (float*)p; }
__device__ __forceinline__ const float* inp(const Frame& F, int i) { const GAS float* p = (const GAS float*)F.a->in[i]; asm volatile("" : "+s"(p)); return (const float*)p; }
__device__ __forceinline__ int opaque_tid() { int t = threadIdx.x; asm volatile("" : "+v"(t)); return t; }
__device__ __forceinline__ void frame_refresh(Frame& F) { GAS unsigned char* w_ = (GAS unsigned char*)F.a->ws; asm volatile("" : "+s"(w_)); F.ws = (unsigned char*)w_; F.tid = opaque_tid(); F.lane = F.tid & 63; F.wave = __builtin_amdgcn_readfirstlane(F.tid >> 6); }
#define WSP(T_, off) ((T_*)(F.ws + (off)))

__device__ __forceinline__ void p0_mod_partial(Frame& F) {
    LAS float* sv = (LAS float*)F.lds;
    for (int i = F.tid; i < 3 * D; i += NTHR) { const int v = i / D, k = i % D; const float c = v < 2 ? inp(F, I_C)[v * D + k] : inp(F, I_CCTX)[k]; sv[i] = siluf_(c); }
    __syncthreads();
    float* part = WSP(float, WS_MODP);
    const int total = 2 * 16 * 3072;
    for (int task = F.bid * NTHR + F.tid; task < total; task += F.G * NTHR) {
        const int q = task % 3072, ks = (task / 3072) % 16, l = task / (3072 * 16);
        const float* W = inp(F, I_WMOD) + ((size_t)l * D + ks * 128) * (6 * D) + q * 4;
        f32x4 a0 = {0, 0, 0, 0}, a1 = a0, a2 = a0;
#pragma unroll 8
        for (int k = 0; k < 128; ++k) { const f32x4 w = *(const f32x4*)(W + (size_t)k * (6 * D)); const float s0 = sv[ks * 128 + k], s1 = sv[D + ks * 128 + k], s2 = sv[2 * D + ks * 128 + k];
            a0 += w * s0; a1 += w * s1; a2 += w * s2; }
        float* o = part + ((size_t)(ks * 2 + l) * 3) * (6 * D) + q * 4;
        *(f32x4*)(o) = a0; *(f32x4*)(o + 6 * D) = a1; *(f32x4*)(o + 12 * D) = a2;
    }
    __syncthreads();
}
__device__ __forceinline__ void p0_tables(Frame& F) {
    const int gt = F.bid * NTHR + F.tid, NGT = F.G * NTHR;
    f32x2* ra = WSP(f32x2, WS_ROPEA); f32x2* rb = WSP(f32x2, WS_ROPEB);
    for (int i = gt; i < 256 * 16; i += NGT) { const int pos = i >> 4, f = i & 15; const float inv = powf(10000.0f, -(float)f / 16.0f); const float ang = (float)pos * inv; ra[i] = (f32x2){cosf(ang), sinf(ang)}; }
    for (int i = gt; i < 256 * 32; i += NGT) { const int pos = i >> 5, f = i & 31; const float inv = powf(10000.0f, -(float)f / 32.0f); const float ang = (float)pos * inv; rb[i] = (f32x2){cosf(ang), sinf(ang)}; }
    float* lb = WSP(float, WS_LB);
    for (int i = gt; i < 2 * 1024; i += NGT) { const float g0 = inp(F, I_GLB)[i], g1 = inp(F, I_GLB)[2048 + i]; const float m = fmaxf(g0, g1); const float e0 = expf(g0 - m), e1 = expf(g1 - m);
        lb[i] = 0.0f; lb[2048 + i] = e1 / (e0 + e1); }
    if (gt == 0) {
        float* sc = WSP(float, WS_SCAL);
        for (int l = 0; l < 2; ++l) {
            const float* al = inp(F, I_LAMBDA) + l * 256; float s1 = 0.f, s2 = 0.f;
            for (int i = 0; i < 64; ++i) { s1 += al[i] * al[64 + i]; s2 += al[128 + i] * al[192 + i]; }
            const float lam_init = 0.8f - 0.6f * expf(-0.3f * (float)l);
            sc[l] = expf(s1) - expf(s2) + lam_init;
            const float* g = inp(F, I_QKN) + l * 128; float mq = 0.f, mk = 0.f;
            for (int i = 0; i < 64; ++i) { mq = fmaxf(mq, fabsf(g[i])); mk = fmaxf(mk, fabsf(g[64 + i])); }
            sc[2 + l] = -(8.0f * mq * mk * 1.02f) * LOG2E;
        }
    }
}
__device__ __forceinline__ void convert_tile(Frame& F, const float* W, int N, int K, bf16_t* WT, int prow0, int k0, int base0, int base1, int ptype  ) {
    LAS float* t = (LAS float*)F.lds;
    { float wv[32];
#pragma unroll
      for (int i = 0; i < 32; ++i) { const int idx = i * NTHR + F.tid, kk = idx >> 8, c = idx & 255; const int col = c < 128 ? base0 + c : base1 + (c - 128);
          wv[i] = W[(size_t)(k0 + kk) * N + col]; }
#pragma unroll
      for (int i = 0; i < 32; ++i) { const int idx = i * NTHR + F.tid, kk = idx >> 8, c = idx & 255; t[kk * 257 + c] = wv[i]; } }
    __syncthreads();
#pragma unroll
    for (int i = 0; i < 4; ++i) { const int item = i * NTHR + F.tid, ch = item & 7, p = item >> 3; const int lc = ptype < 0 ? perm_col_up(p) : perm_col(ptype, p);
        const LAS float* s = t + (8 * ch) * 257 + lc;
        u32x4 o; o.x = cvtpk(s[0], s[257]); o.y = cvtpk(s[2 * 257], s[3 * 257]); o.z = cvtpk(s[4 * 257], s[5 * 257]); o.w = cvtpk(s[6 * 257], s[7 * 257]);
        *(u32x4*)(WT + (size_t)(prow0 + p) * K + k0 + 8 * ch) = o; }
    __syncthreads();
}
constexpr int CT_IN = 68 * 32, CT_BR = 3 * 8 * 16, CT_OUT = 8 * 32, CT_UP = 43 * 32, CT_DN = 8 * 86;
constexpr int CT0_BR = CT_IN, CT0_OUT = CT0_BR + CT_BR, CT0_UP = CT0_OUT + CT_OUT, CT0_DN = CT0_UP + CT_UP, CT_ALL = CT0_DN + CT_DN;
__device__ __forceinline__ void convert_weights(Frame& F, int l, int lo, int hi, int c0_) {
    bf16_t* wt = WSP(bf16_t, WS_WT);
    constexpr int T_IN = CT_IN, T_BR = CT_BR, T_OUT = CT_OUT, T_UP = CT_UP;
    const int c0 = (F.G == 256) ? c0_ : 0;
    if (F.bid < c0) return;
    for (int it = lo + F.bid - c0; it < hi; it += F.G - c0) {
        int r = it;
        if (r < T_IN) { const int pt = r / 32, kb = r % 32; const int lb = pt_logical_base(pt);
            convert_tile(F, inp(F, I_WIN) + (size_t)l * D * NIN, NIN, D, wt + WT_IN / 2, pt * 256, kb * 64, lb, lb + 128, pt_type(pt)); continue; } r -= T_IN;
        if (r < T_BR) { const int n = r / 128, pt = (r % 128) / 16, kb = r % 16;
            convert_tile(F, inp(F, I_WBR) + ((size_t)l * 3 + n) * 1024 * D, D, 1024, wt + WT_BR / 2 + (size_t)n * D * 1024, pt * 256, kb * 64, pt * 256, pt * 256 + 128, TY_PLAIN); continue; } r -= T_BR;
        if (r < T_OUT) { const int pt = r / 32, kb = r % 32;
            convert_tile(F, inp(F, I_WOUT) + (size_t)l * D * D, D, D, wt + WT_OUT / 2, pt * 256, kb * 64, pt * 256, pt * 256 + 128, TY_PLAIN); continue; } r -= T_OUT;
        if (r < T_UP) { const int pt = r / 32, kb = r % 32;
            convert_tile(F, inp(F, I_WUP) + (size_t)l * D * NUP, NUP, D, wt + WT_UP / 2, pt * 256, kb * 64, pt * 128, DFF + pt * 128, -1); continue; } r -= T_UP;
        { const int pt = r / 86, kb = r % 86;
            convert_tile(F, inp(F, I_WDOWN) + (size_t)l * DFF * D, D, DFF, wt + WT_DOWN / 2, pt * 256, kb * 64, pt * 256, pt * 256 + 128, TY_PLAIN); }
    }
}
__device__ __forceinline__ void p1_mod_final(Frame& F) {
    const float* part = WSP(float, WS_MODP); float* mv = WSP(float, WS_MODV);
    for (int i = F.bid * NTHR + F.tid; i < 2 * 3 * 6 * D; i += F.G * NTHR) { const int n = i % (6 * D), l = i / (3 * 6 * D);
        float s = inp(F, I_BMOD)[l * 6 * D + n];
#pragma unroll
        for (int ks = 0; ks < 16; ++ks) s += part[(size_t)ks * (2 * 3 * 6 * D) + i];
        mv[i] = s; }
}

__device__ __forceinline__ const float* xrow_src(Frame& F, int R, int use_inputs) {
    const int b = R / TT, t = R % TT;
    if (t < T) return (use_inputs ? inp(F, I_X) : (const float*)outp(F)) + ((size_t)b * T + t) * D;
    return (use_inputs ? inp(F, I_CTX) : (const float*)WSP(float, WS_XC)) + ((size_t)b * LC + (t - T)) * D;
}
__device__ __forceinline__ void norm_phase(Frame& F, int l, int which  ) {
    const int gw = F.bid * NWAVES + F.wave, NGW = F.G * NWAVES;
    bf16_t* h = WSP(bf16_t, WS_H); const float* mv = WSP(float, WS_MODV);
    const int use_inputs = (l == 0 && which == 0);
    f32x4 x[8], xn[8], sc1[8], sh[8]; int vcur = -1;
    if (gw < MR) { const f32x4* xr = (const f32x4*)xrow_src(F, gw, use_inputs) + F.lane;
#pragma unroll
        for (int j = 0; j < 8; ++j) x[j] = xr[64 * j]; }
    for (int R = gw; R < MR; R += NGW) {
        const int Rn = R + NGW;
        if (Rn < MR) { const f32x4* xr = (const f32x4*)xrow_src(F, Rn, use_inputs) + F.lane;
#pragma unroll
            for (int j = 0; j < 8; ++j) xn[j] = xr[64 * j]; }
        const int b = R / TT, t = R % TT, v = t < T ? b : 2;
        if (v != vcur) {
            const float* shift = mv + ((size_t)(l * 3 + v) * 6 + (which ? 3 : 0)) * D; const float* scale = shift + D;
#pragma unroll
            for (int j = 0; j < 8; ++j) { sc1[j] = *((const f32x4*)scale + F.lane + 64 * j) + 1.0f; sh[j] = *((const f32x4*)shift + F.lane + 64 * j); }
            vcur = v;
        }
        float ss = 0.f;
#pragma unroll
        for (int j = 0; j < 8; ++j) ss += (x[j].x * x[j].x + x[j].y * x[j].y) + (x[j].z * x[j].z + x[j].w * x[j].w);
        const float rstd = rsqrtf(wave_sum(ss) * (1.0f / D) + EPS);
        u32x2* o = (u32x2*)(h + (size_t)R * D) + F.lane;
#pragma unroll
        for (int j = 0; j < 8; ++j) { const f32x4 y = x[j] * rstd * sc1[j] + sh[j]; u32x2 w; w.x = cvtpk(y.x, y.y); w.y = cvtpk(y.z, y.w); o[64 * j] = w; }
#pragma unroll
        for (int j = 0; j < 8; ++j) x[j] = xn[j];
    }
}

typedef f32x4 acc_t[2][2][4][2];
__device__ __forceinline__ u32x4 pack8(const f32x4 a, const f32x4 b) { u32x4 w; w.x = cvtpk(a[0], a[1]); w.y = cvtpk(a[2], a[3]); w.z = cvtpk(b[0], b[1]); w.w = cvtpk(b[2], b[3]); return w; }

struct EpiIn {
    static constexpr bool PERM = false, AFTER_DRAIN = false;
    int pt0;
    bf16_t *rq, *r2, *r1;
    const float* qkn;
    const f32x2 *ropeA, *ropeB;
    __device__ __forceinline__ void operator()(const acc_t& acc, const pg8::Unit& u, int wr, int wc, int fr, int fq) const {
        const int pt = pt0 + u.pn, b = u.pm / PPB, tb = (u.pm % PPB) * 256 + wr * 64 + fr;
        if (pt < PT_DV) {
            const int isk = pt >= PT_DK, sh = 4 * (pt - (isk ? PT_DK : PT_DQ)) + wc, d0 = 32 * (fq >> 1) + 8 * (fq & 1);
            bf16_t* base = rq + (isk ? (size_t)MR * 1024 : (size_t)0) + ((size_t)(b * 16 + sh) * TT) * 64 + d0;
            const float* gp = qkn + isk * 64 + d0; const float osc = isk ? 1.0f : LOG2E * 0.125f;
            f32x4 g[2][2];
#pragma unroll
            for (int s = 0; s < 2; ++s)
#pragma unroll
                for (int n = 0; n < 2; ++n) g[s][n] = *(const f32x4*)(gp + 16 * s + 4 * n) * osc;
            const bool lat = (u.pm % PPB) != PPB - 1;
            f32x4 c0_[4], c1_[4], c2_[4];
#define R64_LD(buf, it) do { const int t = lat ? tb + ((it) >> 2) * 128 + ((it) & 3) * 16 : 0; const int pos = (fq < 2) ? (t >> 6) : (t & 63);                                              \
                const f32x4* rp = (const f32x4*)(ropeA + pos * 16 + 8 * (fq & 1)); _Pragma("unroll") for (int k = 0; k < 4; ++k) buf[k] = rp[k]; } while (0)
#define R64_DO(buf, it) do { constexpr int ai = (it) >> 2, m = (it) & 3; const int t = tb + ai * 128 + m * 16;                                                                                  \
                f32x4 x[2][2]; float ss = 0.f;                                                                                                                                                    \
                _Pragma("unroll") for (int s = 0; s < 2; ++s) _Pragma("unroll") for (int n = 0; n < 2; ++n) { x[s][n] = acc[ai][s][m][n];                                                         \
                    ss += (x[s][n][0] * x[s][n][0] + x[s][n][1] * x[s][n][1]) + (x[s][n][2] * x[s][n][2] + x[s][n][3] * x[s][n][3]); }                                                            \
                ss += __shfl_xor(ss, 16); ss += __shfl_xor(ss, 32);                                                                                                                               \
                const float rstd = rsqrtf(ss * (1.0f / 64.0f) + EPS);                                                                                                                             \
                _Pragma("unroll") for (int s = 0; s < 2; ++s) _Pragma("unroll") for (int n = 0; n < 2; ++n) x[s][n] = x[s][n] * rstd * g[s][n];                                                   \
                if (lat) { _Pragma("unroll") for (int n = 0; n < 2; ++n) { const f32x4 c01 = buf[2 * n], c23 = buf[2 * n + 1];               \
                    const f32x4 cs = {c01[0], c01[2], c23[0], c23[2]}, sn = {c01[1], c01[3], c23[1], c23[3]};                                                                                     \
                    const f32x4 u1 = x[0][n], u2 = x[1][n]; x[0][n] = u1 * cs - u2 * sn; x[1][n] = u1 * sn + u2 * cs; } }                                                                         \
                bf16_t* rowp = base + (size_t)t * 64;                                                                                                                                             \
                *(u32x4*)(rowp) = pack8(x[0][0], x[0][1]); *(u32x4*)(rowp + 16) = pack8(x[1][0], x[1][1]); } while (0)
            R64_LD(c0_, 0); R64_LD(c1_, 1); R64_LD(c2_, 2); R64_DO(c0_, 0); R64_LD(c0_, 3); R64_DO(c1_, 1); R64_LD(c1_, 4); R64_DO(c2_, 2); R64_LD(c2_, 5);
            R64_DO(c0_, 3); R64_LD(c0_, 6); R64_DO(c1_, 4); R64_LD(c1_, 7); R64_DO(c2_, 5); R64_DO(c0_, 6); R64_DO(c1_, 7);
#undef R64_LD
#undef R64_DO
        } else if (pt >= PT_RQ && pt < PT_RV) {
            const int isk = pt >= PT_RK, head = 2 * (pt - (isk ? PT_RK : PT_RQ)) + (wc >> 1), d0 = 64 * (wc & 1) + 8 * fq;
            bf16_t* base = r2 + (isk ? (size_t)MR * 512 : (size_t)0) + ((size_t)(b * 4 + head) * TT) * 128 + d0;
            const float osc = isk ? 0.08838834764831845f : 1.0f;
            const bool lat = (u.pm % PPB) != PPB - 1;
            f32x4 c0_[4], c1_[4], c2_[4];
#define R128_LD(buf, it) do { const int t = lat ? tb + ((it) >> 2) * 128 + ((it) & 3) * 16 : 0; const int pos = ((wc & 1) == 0) ? (t >> 6) : (t & 63);                                          \
                const f32x4* rp = (const f32x4*)(ropeB + pos * 32 + 8 * fq); _Pragma("unroll") for (int k = 0; k < 4; ++k) buf[k] = rp[k]; } while (0)
#define R128_DO(buf, it) do { constexpr int ai = (it) >> 2, m = (it) & 3; const int t = tb + ai * 128 + m * 16;                                                                                  \
                f32x4 x[2][2];                                                                                                                                                                    \
                _Pragma("unroll") for (int s = 0; s < 2; ++s) _Pragma("unroll") for (int n = 0; n < 2; ++n) x[s][n] = acc[ai][s][m][n] * osc;                                                     \
                if (lat) { _Pragma("unroll") for (int n = 0; n < 2; ++n) { const f32x4 c01 = buf[2 * n], c23 = buf[2 * n + 1];                                                                     \
                    const f32x4 cs = {c01[0], c01[2], c23[0], c23[2]}, sn = {c01[1], c01[3], c23[1], c23[3]};                                                                                     \
                    const f32x4 u1 = x[0][n], u2 = x[1][n]; x[0][n] = u1 * cs - u2 * sn; x[1][n] = u1 * sn + u2 * cs; } }                                                                         \
                bf16_t* rowp = base + (size_t)t * 128;                                                                                                                                            \
                *(u32x4*)(rowp) = pack8(x[0][0], x[0][1]); *(u32x4*)(rowp + 32) = pack8(x[1][0], x[1][1]); } while (0)
            R128_LD(c0_, 0); R128_LD(c1_, 1); R128_LD(c2_, 2); R128_DO(c0_, 0); R128_LD(c0_, 3); R128_DO(c1_, 1); R128_LD(c1_, 4); R128_DO(c2_, 2); R128_LD(c2_, 5);
            R128_DO(c0_, 3); R128_LD(c0_, 6); R128_DO(c1_, 4); R128_LD(c1_, 7); R128_DO(c2_, 5); R128_DO(c0_, 6); R128_DO(c1_, 7);
#undef R128_LD
#undef R128_DO
        } else {
            int pts, hd; bf16_t* sb;
            if (pt < PT_RQ) { sb = rq + (size_t)MR * 2048; pts = PT_DV; hd = 128; } else if (pt < PT_GQ) { sb = r2 + (size_t)MR * 1024; pts = PT_RV; hd = 256; }
            else { const int s4 = (pt - PT_GQ) >> 2; sb = r1 + (size_t)s4 * MR * 1024; pts = PT_GQ + 4 * s4; hd = 128; }
            const int c = 256 * (pt - pts) + 64 * wc + 8 * fq, head = c / hd, dim = c % hd, H = 1024 / hd;
            bf16_t* base = sb + ((size_t)(b * H + head) * TT) * hd + dim;
            const bool isq = (pt >= PT_GQ && pt < PT_GF);
#pragma unroll
            for (int ai = 0; ai < 2; ++ai)
#pragma unroll
                for (int m = 0; m < 4; ++m) {
                    const int t = tb + ai * 128 + m * 16; bf16_t* rowp = base + (size_t)t * hd;
#pragma unroll
                    for (int bj = 0; bj < 2; ++bj) { f32x4 a = acc[ai][bj][m][0], c2 = acc[ai][bj][m][1];
                        if (isq) {
#pragma unroll
                            for (int e = 0; e < 4; ++e) { a[e] = siluf_(a[e]) * 0.08838834764831845f; c2[e] = siluf_(c2[e]) * 0.08838834764831845f; } }
                        *(u32x4*)(rowp + 32 * bj) = pack8(a, c2); }
                }
        }
    }
};

struct EpiGates {
    static constexpr bool PERM = false, AFTER_DRAIN = false;
    bf16_t *oB, *oC, *G; const float* bias;
    __device__ __forceinline__ void operator()(const acc_t& acc, const pg8::Unit& u, int wr, int wc, int fr, int fq) const {
        const int R0 = u.pm * 256 + wr * 64 + fr;
        if (u.pn < 8) {
            bf16_t* o = (u.pn < 4 ? oB : oC) + 256 * (u.pn & 3) + 64 * wc + 8 * fq + (size_t)R0 * 1024;
            u32x4 wv[2][4][2];
#pragma unroll
            for (int ai = 0; ai < 2; ++ai)
#pragma unroll
                for (int m = 0; m < 4; ++m)
#pragma unroll
                    for (int bj = 0; bj < 2; ++bj) wv[ai][m][bj] = *(const u32x4*)(o + (size_t)(ai * 128 + m * 16) * 1024 + 32 * bj);
#pragma unroll
            for (int ai = 0; ai < 2; ++ai)
#pragma unroll
                for (int m = 0; m < 4; ++m) { bf16_t* rowp = o + (size_t)(ai * 128 + m * 16) * 1024;
#pragma unroll
                    for (int bj = 0; bj < 2; ++bj) { const u32x4 w = wv[ai][m][bj]; const f32x4 a = acc[ai][bj][m][0], c = acc[ai][bj][m][1];
                        const f32x4 r0 = {bflo(w.x) * siluf_(a[0]), bfhi(w.x) * siluf_(a[1]), bflo(w.y) * siluf_(a[2]), bfhi(w.y) * siluf_(a[3])};
                        const f32x4 r1 = {bflo(w.z) * siluf_(c[0]), bfhi(w.z) * siluf_(c[1]), bflo(w.w) * siluf_(c[2]), bfhi(w.w) * siluf_(c[3])};
                        *(u32x4*)(rowp + 32 * bj) = pack8(r0, r1); } }
        } else {
            const int t = u.pn - 8, n = t >> 3, c0 = 256 * (t & 7) + 64 * wc + 8 * fq;
            const float* bp = bias + n * D + c0; bf16_t* Gn = G + (size_t)n * MR * D + c0;
            f32x4 bv[2][2];
#pragma unroll
            for (int bj = 0; bj < 2; ++bj)
#pragma unroll
                for (int k = 0; k < 2; ++k) bv[bj][k] = *(const f32x4*)(bp + 32 * bj + 4 * k);
#pragma unroll
            for (int ai = 0; ai < 2; ++ai)
#pragma unroll
                for (int m = 0; m < 4; ++m) { bf16_t* rowp = Gn + (size_t)(R0 + ai * 128 + m * 16) * D;
#pragma unroll
                    for (int bj = 0; bj < 2; ++bj) { f32x4 a = acc[ai][bj][m][0] + bv[bj][0], c = acc[ai][bj][m][1] + bv[bj][1];
#pragma unroll
                        for (int e = 0; e < 4; ++e) { a[e] = fmaxf(sigmoidf_(a[e]), 7.888609052210118e-31f); c[e] = fmaxf(sigmoidf_(c[e]), 7.888609052210118e-31f); }
                        u32x4 w; w.x = cvtpk_c(a[0], a[1]); w.y = cvtpk_c(a[2], a[3]); w.z = cvtpk_c(c[0], c[1]); w.w = cvtpk_c(c[2], c[3]);
                        *(u32x4*)(rowp + 32 * bj) = w; } }
        }
    }
};
struct EpiProjAll {
    static constexpr bool PERM = false, AFTER_DRAIN = false, KEEPS_ACC = true;
    const bf16_t* G; bf16_t* y;
    __device__ __forceinline__ void operator()(acc_t& acc, const pg8::Unit& u, int wr, int wc, int fr, int fq) const {
        const int n = u.pm / NPAN, pm = u.pm - n * NPAN, pn = u.pn & 7;
        const int c0 = 256 * pn + 64 * wc + 8 * fq, R0 = pm * 256 + wr * 64 + fr;
        const bf16_t* Gn = G + (size_t)n * MR * D + (size_t)R0 * D + c0; const bf16_t* Gx = Gn + (size_t)MR * D;
        bf16_t* yp = y + (size_t)R0 * D + c0;
        u32x4 wa[4], xa[4], wb[4], xb[4];
#define PJ_LD(GW_, GX_, ai, bj) do { _Pragma("unroll") for (int m = 0; m < 4; ++m) { const size_t ro = (size_t)((ai) * 128 + m * 16) * D + 32 * (bj); GW_[m] = *(const u32x4*)(Gn + ro); GX_[m] = *(const u32x4*)(Gx + ro); } } while (0)
#define PJ_LD1(GW_, ai, bj) do { _Pragma("unroll") for (int m = 0; m < 4; ++m) { const size_t ro = (size_t)((ai) * 128 + m * 16) * D + 32 * (bj); GW_[m] = *(const u32x4*)(Gn + ro); } } while (0)
#define PJ_RATIO(GW_, GX_, ai, bj) do { _Pragma("unroll") for (int m = 0; m < 4; ++m) {                                                     \
            const float g[8] = {bflo(GW_[m].x), bfhi(GW_[m].x), bflo(GW_[m].y), bfhi(GW_[m].y), bflo(GW_[m].z), bfhi(GW_[m].z), bflo(GW_[m].w), bfhi(GW_[m].w)};            \
            const float d[8] = {bflo(GX_[m].x), bfhi(GX_[m].x), bflo(GX_[m].y), bfhi(GX_[m].y), bflo(GX_[m].z), bfhi(GX_[m].z), bflo(GX_[m].w), bfhi(GX_[m].w)};            \
            f32x4 r0 = acc[ai][bj][m][0], r1 = acc[ai][bj][m][1];                                                                                                         \
            _Pragma("unroll") for (int e = 0; e < 4; ++e) { r0[e] *= g[e] * __builtin_amdgcn_rcpf(d[e]); r1[e] *= g[4 + e] * __builtin_amdgcn_rcpf(d[4 + e]); }           \
            acc[ai][bj][m][0] = r0; acc[ai][bj][m][1] = r1; } } while (0)
#define PJ_FINAL(GW_, ai, bj) do { _Pragma("unroll") for (int m = 0; m < 4; ++m) {                                                           \
            const float g[8] = {bflo(GW_[m].x), bfhi(GW_[m].x), bflo(GW_[m].y), bfhi(GW_[m].y), bflo(GW_[m].z), bfhi(GW_[m].z), bflo(GW_[m].w), bfhi(GW_[m].w)};            \
            f32x4 r0 = acc[ai][bj][m][0], r1 = acc[ai][bj][m][1];                                                                                                         \
            _Pragma("unroll") for (int e = 0; e < 4; ++e) { r0[e] *= g[e]; r1[e] *= g[4 + e]; }                                                                           \
            *(u32x4*)(yp + (size_t)((ai) * 128 + m * 16) * D + 32 * (bj)) = pack8(r0, r1); } } while (0)
        if (n < 2) { PJ_LD(wa, xa, 0, 0); PJ_LD(wb, xb, 0, 1); PJ_RATIO(wa, xa, 0, 0); PJ_LD(wa, xa, 1, 0); PJ_RATIO(wb, xb, 0, 1); PJ_LD(wb, xb, 1, 1); PJ_RATIO(wa, xa, 1, 0); PJ_RATIO(wb, xb, 1, 1); }
        else { PJ_LD1(wa, 0, 0); PJ_LD1(wb, 0, 1); PJ_LD1(xa, 1, 0); PJ_LD1(xb, 1, 1); PJ_FINAL(wa, 0, 0); PJ_FINAL(wb, 0, 1); PJ_FINAL(xa, 1, 0); PJ_FINAL(xb, 1, 1); }
#undef PJ_LD
#undef PJ_LD1
#undef PJ_RATIO
#undef PJ_FINAL
    }
};
struct EpiRes {
    static constexpr bool PERM = false, AFTER_DRAIN = false;
    const float *srcx, *srcc; float *dstx, *dstc; const float* gate0;
    __device__ __forceinline__ void operator()(const acc_t& acc, const pg8::Unit& u, int wr, int wc, int fr, int fq) const {
        const int b = u.pm / PPB, lp = u.pm % PPB, c0 = 256 * u.pn + 64 * wc + 8 * fq, r0 = wr * 64 + fr;
        const bool isc = (lp == PPB - 1);
        const size_t rb = isc ? (size_t)(b * LC) : (size_t)(b * T + lp * 256);
        const float* s = (isc ? srcc : srcx) + (rb + r0) * D + c0; float* d = (isc ? dstc : dstx) + (rb + r0) * D + c0;
        const float* gp = gate0 + (size_t)(isc ? 2 : b) * 6 * D + c0;
        f32x4 gv[2][2];
#pragma unroll
        for (int bj = 0; bj < 2; ++bj)
#pragma unroll
            for (int n = 0; n < 2; ++n) gv[bj][n] = *(const f32x4*)(gp + 32 * bj + 4 * n);
        f32x4 sa[4][2], sb[4][2];
#define RES_LD(buf, ai, bj) do { _Pragma("unroll") for (int m = 0; m < 4; ++m) _Pragma("unroll") for (int n = 0; n < 2; ++n) buf[m][n] = *(const f32x4*)(s + (size_t)((ai) * 128 + m * 16) * D + 32 * (bj) + 4 * n); } while (0)
#define RES_ST(buf, ai, bj) do { _Pragma("unroll") for (int m = 0; m < 4; ++m) _Pragma("unroll") for (int n = 0; n < 2; ++n) *(f32x4*)(d + (size_t)((ai) * 128 + m * 16) * D + 32 * (bj) + 4 * n) = buf[m][n] + gv[bj][n] * acc[ai][bj][m][n]; } while (0)
        RES_LD(sa, 0, 0); RES_LD(sb, 0, 1); RES_ST(sa, 0, 0); RES_LD(sa, 1, 0); RES_ST(sb, 0, 1); RES_LD(sb, 1, 1); RES_ST(sa, 1, 0); RES_ST(sb, 1, 1);
#undef RES_LD
#undef RES_ST
    }
};
__device__ __forceinline__ float dpp_up1(float cur, float prev) {
    const int old = __builtin_amdgcn_mov_dpp(__float_as_int(prev), 0x121  , 0xf, 0xf, false);
    return __int_as_float(__builtin_amdgcn_update_dpp(old, __float_as_int(cur), 0x111  , 0xf, 0xf, false));
}
__device__ __forceinline__ float dpp_dn1(float cur, float next) {
    const int old = __builtin_amdgcn_mov_dpp(__float_as_int(next), 0x12F  , 0xf, 0xf, false);
    return __int_as_float(__builtin_amdgcn_update_dpp(old, __float_as_int(cur), 0x101  , 0xf, 0xf, false));
}
struct EpiConv {
    static constexpr bool PERM = false, AFTER_DRAIN = false;
    bf16_t* g; float* raw; const float* cw; const float* cb;
    __device__ __forceinline__ void operator()(const acc_t& acc, const pg8::Unit& u, int wr, int wc, int fr, int fq) const {
        const int jc = 128 * u.pn + 32 * wc + 8 * fq, R0 = u.pm * 256 + wr * 64 + fr;
        u32x2 keep[2][4];
        f32x4 cwv[2][8];
#pragma unroll
        for (int n = 0; n < 2; ++n) { const int j = jc + 4 * n;
            cwv[n][0] = *(const f32x4*)(cw + j); cwv[n][1] = *(const f32x4*)(cw + NUP + j); cwv[n][2] = *(const f32x4*)(cw + 2 * NUP + j); cwv[n][3] = *(const f32x4*)(cb + j);
            cwv[n][4] = *(const f32x4*)(cw + DFF + j); cwv[n][5] = *(const f32x4*)(cw + NUP + DFF + j); cwv[n][6] = *(const f32x4*)(cw + 2 * NUP + DFF + j); cwv[n][7] = *(const f32x4*)(cb + DFF + j); }
        const float m0 = (fr == 0) ? 1.0f : 0.0f, m15 = (fr == 15) ? 1.0f : 0.0f;
#define FMAC_DPP(y, x, w, CTRL) asm("v_fmac_f32_dpp %0, %1, %2 " CTRL " row_mask:0xf bank_mask:0xf bound_ctrl:1" : "+v"(y) : "v"(x), "v"(w))
#pragma unroll
        for (int n = 0; n < 2; ++n) {
            const int j = jc + 4 * n;
            const f32x4 wg0 = cwv[n][0], wg1 = cwv[n][1], wg2 = cwv[n][2], bg = cwv[n][3];
            const f32x4 wu0 = cwv[n][4], wu1 = cwv[n][5], wu2 = cwv[n][6], bu = cwv[n][7];
            const f32x4 wg0e = wg0 * m0, wg2e = wg2 * m15, wu0e = wu0 * m0, wu2e = wu2 * m15;
#pragma unroll
            for (int ai = 0; ai < 2; ++ai)
#pragma unroll
                for (int m = 0; m < 4; ++m) {
                    const f32x4 xg = acc[ai][0][m][n], xu = acc[ai][1][m][n];
                    const f32x4 pg = acc[ai][0][m > 0 ? m - 1 : 0][n], ng = acc[ai][0][m < 3 ? m + 1 : 3][n], pu = acc[ai][1][m > 0 ? m - 1 : 0][n], nu = acc[ai][1][m < 3 ? m + 1 : 3][n];
                    f32x4 yg, yu;
#pragma unroll
                    for (int e = 0; e < 4; ++e) {
                        float g_ = wg1[e] * xg[e] + bg[e], u_ = wu1[e] * xu[e] + bu[e];
                        { const float a0 = xg[e], a1 = pg[e], a2 = ng[e], c0 = wg0[e], c1 = wg0e[e], c2 = wg2[e], c3 = wg2e[e];
                          FMAC_DPP(g_, a0, c0, "row_shr:1"); FMAC_DPP(g_, a1, c1, "row_mirror"); FMAC_DPP(g_, a0, c2, "row_shl:1"); FMAC_DPP(g_, a2, c3, "row_mirror"); }
                        { const float a0 = xu[e], a1 = pu[e], a2 = nu[e], c0 = wu0[e], c1 = wu0e[e], c2 = wu2[e], c3 = wu2e[e];
                          FMAC_DPP(u_, a0, c0, "row_shr:1"); FMAC_DPP(u_, a1, c1, "row_mirror"); FMAC_DPP(u_, a0, c2, "row_shl:1"); FMAC_DPP(u_, a2, c3, "row_mirror"); }
                        yg[e] = g_; yu[e] = u_;
                    }
                    f32x4 r;
#pragma unroll
                    for (int e = 0; e < 4; ++e) r[e] = siluf_(yg[e]) * yu[e];
                    u32x2 pk; pk.x = cvtpk(r[0], r[1]); pk.y = cvtpk(r[2], r[3]);
                    if (n == 0) keep[ai][m] = pk;
                    else { u32x4 w; w.x = keep[ai][m].x; w.y = keep[ai][m].y; w.z = pk.x; w.w = pk.y; *(u32x4*)(g + (size_t)(R0 + ai * 128 + m * 16) * DFF + jc) = w; }
                    if ((m == 0 && fr < 2) || (m == 3 && fr >= 14)) {
                        const int slot = (m == 0) ? fr : fr - 12; float* rp = raw + ((size_t)(u.pm * 4 + ai * 2 + wr) * 4 + slot) * NUP + j;
                        *(f32x4*)(rp) = xg; *(f32x4*)(rp + DFF) = xu;
                    }
                }
        }
#undef FMAC_DPP
    }
};

namespace att {
constexpr int KVBLK = 64;
constexpr int SHM_V = 64 * 128 * 2, SHM_K = 64 * 64 * 2;
#define KSWZ64(row, colB) ((row) * 128 + ((colB) ^ ((((row) >> 1) & 7) << 4)))
#define SBAR() __builtin_amdgcn_sched_barrier(0)
__device__ __forceinline__ int crow(int r, int hi) { return (r & 3) + 8 * (r >> 2) + 4 * hi; }
template <int SK = 0> __device__ __forceinline__ void exp16(f32x16& p) {
    if (SK & 1) return;
#pragma unroll
    for (int r = 0; r < 16; ++r) p[r] = __builtin_amdgcn_exp2f(p[r]);
}
template <int BASE> __device__ __forceinline__ void exp8(f32x16& p) {
    float e[8];
#pragma unroll
    for (int r = 0; r < 8; ++r) e[r] = __builtin_amdgcn_exp2f(p[BASE + r]);
    asm volatile("" : "+v"(e[0]), "+v"(e[1]), "+v"(e[2]), "+v"(e[3]), "+v"(e[4]), "+v"(e[5]), "+v"(e[6]), "+v"(e[7]));
#pragma unroll
    for (int r = 0; r < 8; ++r) p[BASE + r] = e[r];
}
template <int SK = 0> __device__ __forceinline__ void finishSM(f32x16& p0, f32x16& p1, float& lsum, bf16x8& pa0, bf16x8& pa1, bf16x8& pa2, bf16x8& pa3) {
    if (SK & 8) { lsum += p0[0] + p1[0]; const unsigned c_ = cvtpk(p0[1], p1[1]); u32x4 w_ = {c_, c_, c_, c_}; pa0 = pa1 = pa2 = pa3 = *reinterpret_cast<bf16x8*>(&w_); return; }
    float ps = 0;
#pragma unroll
    for (int r = 0; r < 16; ++r) ps += p0[r];
#pragma unroll
    for (int r = 0; r < 16; ++r) ps += p1[r];
    lsum += ps;
#define PK4(P, BASE, OUT) do { unsigned a0 = cvtpk(P[BASE + 0], P[BASE + 1]), a1 = cvtpk(P[BASE + 2], P[BASE + 3]);   \
    unsigned b0 = cvtpk(P[BASE + 4], P[BASE + 5]), b1 = cvtpk(P[BASE + 6], P[BASE + 7]);                              \
    auto r0 = __builtin_amdgcn_permlane32_swap(a0, b0, false, false); auto r1 = __builtin_amdgcn_permlane32_swap(a1, b1, false, false); \
    u32x4 w = {r0[0], r1[0], r0[1], r1[1]}; OUT = *reinterpret_cast<bf16x8*>(&w); } while (0)
    PK4(p0, 0, pa0); PK4(p0, 8, pa1); PK4(p1, 0, pa2); PK4(p1, 8, pa3);
#undef PK4
}
template <int SK = 0> __device__ __forceinline__ void qkt(f32x16& p0, f32x16& p1, const LAS char* Ks, const bf16x8* qr, int r32, int hi, float negM) {
#pragma unroll
    for (int r = 0; r < 16; ++r) { p0[r] = 0.f; p1[r] = 0.f; }
    if (SK & 4) return;
#pragma unroll
    for (int d0 = 0; d0 < 4; ++d0) { const int cb = (d0 * 16 + hi * 8) * 2;
        const bf16x8 b0 = *(const LAS bf16x8*)(Ks + KSWZ64(r32, cb));
        const bf16x8 b1 = *(const LAS bf16x8*)(Ks + KSWZ64(32 + r32, cb));
        p0 = __builtin_amdgcn_mfma_f32_32x32x16_bf16(b0, qr[d0], p0, 0, 0, 0);
        p1 = __builtin_amdgcn_mfma_f32_32x32x16_bf16(b1, qr[d0], p1, 0, 0, 0); }
}
__device__ __forceinline__ int v_st(int k, int c) { const int kk = (k & ~0xC) | ((k & 4) << 1) | ((k & 8) >> 1); return ((kk >> 3) * 4 + (c >> 5)) * 512 + ((kk & 7) * 32 + (c & 31)) * 2; }
__device__ __forceinline__ int v_rd_base(int lane) { return ((lane & 3) << 3) | (((lane >> 2) & 3) << 6) | (((lane >> 4) & 1) << 5) | (((lane >> 5) & 1) << 8); }
constexpr int v_rd_off(int d0, int ks, int half) { return d0 * 512 + ks * 4096 + half * 2048; }
template <int OFF> __device__ __forceinline__ s16x4 tr_read(int vb) {
  s16x4 r; asm volatile("ds_read_b64_tr_b16 %0, %1 offset:%2" : "=&v"(r) : "v"(vb), "i"(OFF) : "memory"); return r;
}
template <int D0> __device__ __forceinline__ void pv_one(f32x16& od, int vb, bf16x8 pa0, bf16x8 pa1, bf16x8 pa2, bf16x8 pa3) {
  const s16x4 l0 = tr_read<v_rd_off(D0, 0, 0)>(vb), h0 = tr_read<v_rd_off(D0, 0, 1)>(vb), l1 = tr_read<v_rd_off(D0, 1, 0)>(vb), h1 = tr_read<v_rd_off(D0, 1, 1)>(vb);
  const s16x4 l2 = tr_read<v_rd_off(D0, 2, 0)>(vb), h2 = tr_read<v_rd_off(D0, 2, 1)>(vb), l3 = tr_read<v_rd_off(D0, 3, 0)>(vb), h3 = tr_read<v_rd_off(D0, 3, 1)>(vb);
  asm volatile("s_waitcnt lgkmcnt(0)" ::: "memory"); SBAR();
#define PK(L, H) (bf16x8){L[0], L[1], L[2], L[3], H[0], H[1], H[2], H[3]}
  od = __builtin_amdgcn_mfma_f32_32x32x16_bf16(pa0, PK(l0, h0), od, 0, 0, 0);
  od = __builtin_amdgcn_mfma_f32_32x32x16_bf16(pa1, PK(l1, h1), od, 0, 0, 0);
  od = __builtin_amdgcn_mfma_f32_32x32x16_bf16(pa2, PK(l2, h2), od, 0, 0, 0);
  od = __builtin_amdgcn_mfma_f32_32x32x16_bf16(pa3, PK(l3, h3), od, 0, 0, 0);
#undef PK
}
template <int SK = 0> __device__ __forceinline__ void pv_d0(f32x16* o, int vb, bf16x8 pa0, bf16x8 pa1, bf16x8 pa2, bf16x8 pa3) {
  if (SK & 2) { o[0][0] += __builtin_bit_cast(float, (int)pa0[0] << 16); return; }
  pv_one<0>(o[0], vb, pa0, pa1, pa2, pa3); pv_one<1>(o[1], vb, pa0, pa1, pa2, pa3); pv_one<2>(o[2], vb, pa0, pa1, pa2, pa3); pv_one<3>(o[3], vb, pa0, pa1, pa2, pa3);
}
#define ATT_WAITL(n) asm volatile("s_waitcnt lgkmcnt(" #n ")" ::: "memory")
template <int D0> __device__ __forceinline__ void readv(s16x4 (&v)[8], int vb) {
  v[0] = tr_read<v_rd_off(D0, 0, 0)>(vb); v[1] = tr_read<v_rd_off(D0, 0, 1)>(vb); v[2] = tr_read<v_rd_off(D0, 1, 0)>(vb); v[3] = tr_read<v_rd_off(D0, 1, 1)>(vb);
  v[4] = tr_read<v_rd_off(D0, 2, 0)>(vb); v[5] = tr_read<v_rd_off(D0, 2, 1)>(vb); v[6] = tr_read<v_rd_off(D0, 3, 0)>(vb); v[7] = tr_read<v_rd_off(D0, 3, 1)>(vb);
}
__device__ __forceinline__ void pvm(f32x16& od, const s16x4 (&v)[8], bf16x8 pa0, bf16x8 pa1, bf16x8 pa2, bf16x8 pa3) {
#define PK(L, H) (bf16x8){L[0], L[1], L[2], L[3], H[0], H[1], H[2], H[3]}
  od = __builtin_amdgcn_mfma_f32_32x32x16_bf16(pa0, PK(v[0], v[1]), od, 0, 0, 0);
  od = __builtin_amdgcn_mfma_f32_32x32x16_bf16(pa1, PK(v[2], v[3]), od, 0, 0, 0);
  od = __builtin_amdgcn_mfma_f32_32x32x16_bf16(pa2, PK(v[4], v[5]), od, 0, 0, 0);
  od = __builtin_amdgcn_mfma_f32_32x32x16_bf16(pa3, PK(v[6], v[7]), od, 0, 0, 0);
#undef PK
}
template <int SK, bool HASNEXT> __device__ __forceinline__ void tile_step(f32x16& pN0, f32x16& pN1, f32x16 (&o)[4], const bf16x8 (&qr)[4], float& lsum,
                                                                         const LAS char* ksn, int vbc, float negM, int r32, int hi) {
  bf16x8 kf0[4], kf1[4], pa0, pa1, pa2, pa3; s16x4 va[8], vc[8], vd[8];
  if (HASNEXT && !(SK & 4)) {
#pragma unroll
    for (int d0 = 0; d0 < 4; ++d0) { const int cb = (d0 * 16 + hi * 8) * 2; kf0[d0] = *(const LAS bf16x8*)(ksn + KSWZ64(r32, cb)); kf1[d0] = *(const LAS bf16x8*)(ksn + KSWZ64(32 + r32, cb)); }
  }
  SBAR();
  finishSM<SK>(pN0, pN1, lsum, pa0, pa1, pa2, pa3);
  SBAR();
  if (SK & 2) { o[0][0] += __builtin_bit_cast(float, (int)pa0[0] << 16); }
  else { readv<0>(va, vbc); readv<1>(vc, vbc); }
  SBAR();
  if (HASNEXT) {
#pragma unroll
    for (int r = 0; r < 16; ++r) { pN0[r] = 0.f; pN1[r] = 0.f; }
    if (!(SK & 4)) {
      if (SK & 2) ATT_WAITL(0); else ATT_WAITL(15);
      SBAR();
#pragma unroll
      for (int d0 = 0; d0 < 4; ++d0) { pN0 = __builtin_amdgcn_mfma_f32_32x32x16_bf16(kf0[d0], qr[d0], pN0, 0, 0, 0); pN1 = __builtin_amdgcn_mfma_f32_32x32x16_bf16(kf1[d0], qr[d0], pN1, 0, 0, 0); }
    }
  }
  SBAR();
  if (!(SK & 2)) {
    readv<2>(vd, vbc); SBAR(); ATT_WAITL(15); SBAR(); pvm(o[0], va, pa0, pa1, pa2, pa3); if (HASNEXT && !(SK & 1)) exp8<0>(pN0); SBAR();
    readv<3>(va, vbc); SBAR(); ATT_WAITL(15); SBAR(); pvm(o[1], vc, pa0, pa1, pa2, pa3); if (HASNEXT && !(SK & 1)) exp8<8>(pN0); SBAR();
    ATT_WAITL(8); SBAR(); pvm(o[2], vd, pa0, pa1, pa2, pa3); if (HASNEXT && !(SK & 1)) exp8<0>(pN1); SBAR();
    ATT_WAITL(0); SBAR(); pvm(o[3], va, pa0, pa1, pa2, pa3); if (HASNEXT && !(SK & 1)) exp8<8>(pN1); SBAR();
  } else if (HASNEXT && !(SK & 1)) { exp8<0>(pN0); exp8<8>(pN0); exp8<0>(pN1); exp8<8>(pN1); }
}
constexpr int SLOT = SHM_K + SHM_V, NSLOT = 4;
#define ATT_WAITV(n) asm volatile("s_waitcnt vmcnt(" #n ")" ::: "memory")
template <int SK = 0> __device__ __forceinline__ void attn_unit(const bf16_t* __restrict__ Qb, const bf16_t* __restrict__ Kh, const bf16_t* __restrict__ Vh, bf16_t* Ob, bf16_t* oAb, int second, float lam, float post,
                                                                const float* __restrict__ subln, int nkeys, float negM, LAS char* lds) {
  int tid_ = threadIdx.x; asm volatile("" : "+v"(tid_));
  const int tid = tid_, wid = __builtin_amdgcn_readfirstlane(tid >> 6), lane = tid & 63, r32 = lane & 31, hi = lane >> 5;
  LAS float* li_l = (LAS float*)(lds + NSLOT * SLOT) + wid * 64;
  float lsum = 0; f32x16 o[4];
#pragma unroll
  for (int d = 0; d < 4; ++d)
#pragma unroll
    for (int r = 0; r < 16; ++r) o[d][r] = 0.f;
  bf16x8 qr[4];
  const bf16_t* Qw = Qb + (long)(wid * 32 + r32) * 64 + hi * 8;
#pragma unroll
  for (int d0 = 0; d0 < 4; ++d0) qr[d0] = *reinterpret_cast<const bf16x8*>(Qw + d0 * 16);
  unsigned offK, offV[2];
  { const int row = 8 * wid + (lane >> 3), ch = (lane & 7) ^ ((row >> 1) & 7); offK = (unsigned)(row * 64 + ch * 8); }
#pragma unroll
  for (int i = 0; i < 2; ++i) { const int piece = wid + 8 * i, sub = piece * 2 + (lane >> 5), kk = (sub >> 2) * 8 + ((lane & 31) >> 2), k = (kk & ~0xC) | ((kk & 4) << 1) | ((kk & 8) >> 1), c = (sub & 3) * 32 + 8 * (lane & 3);
      offV[i] = (unsigned)(k * 128 + c); }
  const int vbase = (int)(uintptr_t)lds + SHM_K + v_rd_base(lane);
#define ISSUE(t) do { const int s_ = (t) & (NSLOT - 1); const long k0_ = (long)(t) * KVBLK; \
    __builtin_amdgcn_global_load_lds((const unsigned*)(Kh + k0_ * 64 + offK), (LAS unsigned*)(lds + s_ * SLOT + wid * 1024), 16, 0, 0); \
    __builtin_amdgcn_global_load_lds((const unsigned*)(Vh + k0_ * 128 + offV[0]), (LAS unsigned*)(lds + s_ * SLOT + SHM_K + wid * 1024), 16, 0, 0); \
    __builtin_amdgcn_global_load_lds((const unsigned*)(Vh + k0_ * 128 + offV[1]), (LAS unsigned*)(lds + s_ * SLOT + SHM_K + 8192 + wid * 1024), 16, 0, 0); } while (0)
#define KS(t) (lds + ((t) & (NSLOT - 1)) * SLOT)
#define VB(t) (vbase + ((t) & (NSLOT - 1)) * SLOT)
  f32x16 pA0, pA1; const int NT = nkeys / KVBLK;
  if (wid >= 4) __builtin_amdgcn_s_setprio(1);
  ATT_WAITV(0);
  ISSUE(0); ISSUE(1); ISSUE(2);
  ATT_WAITV(6); __builtin_amdgcn_s_barrier(); asm volatile("" ::: "memory");
  qkt<SK>(pA0, pA1, KS(0), qr, r32, hi, negM); exp16<SK>(pA0); exp16<SK>(pA1);
  for (int j = 0; j + 2 < NT; ++j) {
    if (j + 2 < NT) ATT_WAITV(3); else ATT_WAITV(0);
    __builtin_amdgcn_s_barrier(); asm volatile("" ::: "memory");
    if (!(SK & 16) && j + 3 < NT) ISSUE(j + 3);
    tile_step<SK, true>(pA0, pA1, o, qr, lsum, KS(j + 1), VB(j), negM, r32, hi);
  }
  ATT_WAITV(0); __builtin_amdgcn_s_barrier(); asm volatile("" ::: "memory");
  tile_step<SK, true>(pA0, pA1, o, qr, lsum, KS(NT - 1), VB(NT - 2), negM, r32, hi);
  tile_step<SK, false>(pA0, pA1, o, qr, lsum, KS(NT - 1), VB(NT - 1), negM, r32, hi);
  { auto rr = __builtin_amdgcn_permlane32_swap(__float_as_uint(lsum), __float_as_uint(lsum), false, false); lsum = __uint_as_float(rr[0]) + __uint_as_float(rr[1]); }
  if (hi == 0) li_l[r32] = lsum; asm volatile("s_waitcnt lgkmcnt(0)" ::: "memory");
  float rli[16];
#pragma unroll
  for (int r = 0; r < 16; ++r) rli[r] = __builtin_amdgcn_rcpf(li_l[crow(r, hi)]);
  bf16_t* Ow = Ob + (long)(wid * 32) * 1024;
  if (!second) {
#pragma unroll
    for (int r = 0; r < 16; ++r) { const int orow = crow(r, hi);
#pragma unroll
      for (int d0 = 0; d0 < 4; ++d0) Ow[(long)orow * 1024 + d0 * 32 + r32] = (bf16_t)(cvtpk(o[d0][r] * rli[r], 0.f) & 0xffffu); }
  } else {
    float sl[4];
#pragma unroll
    for (int d0 = 0; d0 < 4; ++d0) sl[d0] = subln[d0 * 32 + r32];
    bf16_t* Aw = oAb + (long)(wid * 32) * 1024;
#pragma unroll
    for (int rg = 0; rg < 4; ++rg) {
      unsigned short o1[4][4];
#pragma unroll
      for (int j = 0; j < 4; ++j)
#pragma unroll
        for (int d0 = 0; d0 < 4; ++d0) o1[j][d0] = *(const unsigned short*)(Ow + (long)crow(4 * rg + j, hi) * 1024 + d0 * 32 + r32);
#pragma unroll
      for (int j = 0; j < 4; ++j) { const int r = 4 * rg + j; float dd[4], ss = 0.f;
#pragma unroll
        for (int d0 = 0; d0 < 4; ++d0) { dd[d0] = __uint_as_float((unsigned)o1[j][d0] << 16) - lam * (o[d0][r] * rli[r]); ss += dd[d0] * dd[d0]; }
        ss += __shfl_xor(ss, 1); ss += __shfl_xor(ss, 2); ss += __shfl_xor(ss, 4); ss += __shfl_xor(ss, 8); ss += __shfl_xor(ss, 16);
        const float rs = rsqrtf(ss * (1.0f / 128.0f) + EPS) * post; bf16_t* rowp = Aw + (long)crow(r, hi) * 1024;
#pragma unroll
        for (int d0 = 0; d0 < 4; ++d0) { const float y = dd[d0] * rs; rowp[d0 * 32 + r32] = (bf16_t)(cvtpk(y * sl[d0], 0.f) & 0xffffu); } }
    }
  }
  __builtin_amdgcn_s_setprio(0);
  __builtin_amdgcn_s_barrier(); asm volatile("" ::: "memory");
#undef ISSUE
#undef KS
#undef VB
#undef ITER
}
}

template <int SK = 0> __device__ __forceinline__ void attn_phase(Frame& F, int l) {
    const bf16_t* Q = WSP(bf16_t, DY_QKV); const bf16_t* K = Q + (size_t)MR * 1024; const bf16_t* V = K + (size_t)MR * 1024;
    bf16_t* O = WSP(bf16_t, DY_O1); bf16_t* oA = WSP(bf16_t, DY_OA); const float negM = 0.f;
    const float lam = WSP(float, WS_SCAL)[l]; const float post = 1.0f - (0.8f - 0.6f * expf(-0.3f * (float)l)); const float* subln = inp(F, I_SUBLN) + l * 128;
    const int NL = NB * 8 * 64, NU = NL + (l == 0 ? NB * 8 : 0);
    for (int i = 0; i * F.G < NU; ++i) {
        int u = i * F.G + F.bid;
        if (F.G == 256 && i < 4) { const int hh = i * 8 + (F.bid & 7); u = (hh >> 1) * 64 + (hh & 1) * 32 + (F.bid >> 3); }
        if (u >= NU) break;
        int p, q0, k0, nk;
        if (u < NL) { p = u / 64; q0 = (u % 64) * 256; k0 = 0; nk = TT; }
        else { p = u - NL; q0 = T; k0 = T; nk = LC; }
        const int b = p >> 3, h = p & 7;
        for (int sm = 0; sm < 2; ++sm) {
            const size_t hb = (size_t)(b * 16 + 2 * h + sm) * TT;
            att::attn_unit<SK>(Q + (hb + q0) * 64, K + (hb + k0) * 64, V + ((size_t)(b * 8 + h) * TT + k0) * 128, O + ((size_t)b * TT + q0) * 1024 + h * 128, oA + ((size_t)b * TT + q0) * 1024 + h * 128,
                               sm, lam, post, subln, nk, negM, (LAS char*)F.lds);
        }
    }
}
__device__ __forceinline__ void ffn_fixup(Frame& F, int l) {
    const float* raw = WSP(float, DY_RAW); bf16_t* g = WSP(bf16_t, DY_G);
    const float* cw = inp(F, I_CONVW) + (size_t)l * 3 * NUP; const float* cb = inp(F, I_CONVB) + (size_t)l * NUP;
    const int NBLK = MR / 64, per = DFF / 4;
    const size_t total = (size_t)NBLK * 2 * per;
    for (size_t it = (size_t)F.bid * NTHR + F.tid; it < total; it += (size_t)F.G * NTHR) {
        const int cq = (int)(it % per), rb = (int)(it / per), blk = rb >> 1, last = rb & 1, j = cq * 4;
        const int bl = blk % (TT / 64);
        const bool seq_first = (bl == 0 || bl == T / 64), seq_last = (bl == T / 64 - 1 || bl == TT / 64 - 1);
        const float* rc = raw + ((size_t)blk * 4 + (last ? 3 : 0)) * NUP;
        const float* rp = last ? raw + ((size_t)blk * 4 + 2) * NUP : raw + ((size_t)(blk - 1) * 4 + 3) * NUP;
        const float* rn = last ? raw + ((size_t)(blk + 1) * 4 + 0) * NUP : raw + ((size_t)blk * 4 + 1) * NUP;
        const bool zp = (!last && seq_first), zn = (last && seq_last);
        const f32x4 z4 = {0.f, 0.f, 0.f, 0.f};
        f32x4 v[14];
        { const float* rpp = zp ? rc : rp; const float* rnn = zn ? rc : rn;
          v[0] = *(const f32x4*)(rpp + j); v[1] = *(const f32x4*)(rpp + DFF + j); v[2] = *(const f32x4*)(rnn + j); v[3] = *(const f32x4*)(rnn + DFF + j);
          v[4] = *(const f32x4*)(rc + j); v[5] = *(const f32x4*)(rc + DFF + j);
          v[6] = *(const f32x4*)(cw + j); v[7] = *(const f32x4*)(cw + NUP + j); v[8] = *(const f32x4*)(cw + 2 * NUP + j); v[9] = *(const f32x4*)(cb + j);
          v[10] = *(const f32x4*)(cw + DFF + j); v[11] = *(const f32x4*)(cw + NUP + DFF + j); v[12] = *(const f32x4*)(cw + 2 * NUP + DFF + j); v[13] = *(const f32x4*)(cb + DFF + j); }
#pragma unroll
        for (int k = 0; k < 14; ++k) asm volatile("" : "+v"(v[k]));
        const f32x4 pg = zp ? z4 : v[0], pu = zp ? z4 : v[1], ng = zn ? z4 : v[2], nu = zn ? z4 : v[3], xg = v[4], xu = v[5];
        const f32x4 yg = v[6] * pg + v[7] * xg + v[8] * ng + v[9];
        const f32x4 yu = v[10] * pu + v[11] * xu + v[12] * nu + v[13];
        u32x2 w; w.x = cvtpk(siluf_(yg[0]) * yu[0], siluf_(yg[1]) * yu[1]); w.y = cvtpk(siluf_(yg[2]) * yu[2], siluf_(yg[3]) * yu[3]);
        *(u32x2*)(g + (size_t)(blk * 64 + (last ? 63 : 0)) * DFF + j) = w;
    }
}

namespace scn {
using att::crow; using att::v_st; using att::v_rd_base; using att::v_rd_off; using att::tr_read;
__device__ __forceinline__ int cp_of(int c, int dir) { return c == PPB - 1 ? 0 : (dir ? (PPB - 1) - c : c + 1); }
#define KSWZ256(row, colB) ((row) * 256 + ((colB) ^ (((row) & 7) << 4)))
#define PKF(L, H) (bf16x8){L[0], L[1], L[2], L[3], H[0], H[1], H[2], H[3]}
__device__ __forceinline__ u32x4 scale8(const u32x4 w, float s) { u32x4 o; o.x = cvtpk(bflo(w.x) * s, bfhi(w.x) * s); o.y = cvtpk(bflo(w.y) * s, bfhi(w.y) * s); o.z = cvtpk(bflo(w.z) * s, bfhi(w.z) * s); o.w = cvtpk(bflo(w.w) * s, bfhi(w.w) * s); return o; }
__device__ __forceinline__ float ret_lg2(int h, int dir) { const int hh = dir ? 3 - h : h; return log1pf(-exp2f(-5.0f - (float)hh)) * LOG2E; }
constexpr size_t RET_US_ELEMS = (size_t)128 * 256, HG_US_ELEMS = (size_t)128 * 128;
constexpr size_t US_RET_OFF = DY_US, US_HG_OFF = DY_US + 65 * MiB;
constexpr size_t HG_A_OFF = WS_MODP;

__device__ __forceinline__ void store_state_tile(bf16_t* us, const f32x16& a, int rb, int d0, int nd0, int c32, int hi) {
#pragma unroll
    for (int g = 0; g < 4; ++g) { const int ks = 2 * rb + (g >> 1), ln = c32 + 32 * (g & 1);
        u32x2 w; w.x = cvtpk_c(a[4 * g], a[4 * g + 1]); w.y = cvtpk_c(a[4 * g + 2], a[4 * g + 3]);
        *(u32x2*)(us + ((size_t)(ks * nd0 + d0) * 64 + ln) * 8 + 4 * hi) = w; }
}

template <int TILE, int KST> __device__ __forceinline__ void ra_step(f32x16 (&acc)[4][2], int vbK, const int (&vbV)[2]) {
    bf16x8 A[4], Bv[2];
    { const s16x4 lo = tr_read<TILE * 16384 + v_rd_off(0, KST, 0)>(vbK), h4 = tr_read<TILE * 16384 + v_rd_off(0, KST, 1)>(vbK); A[0] = PKF(lo, h4); }
    { const s16x4 lo = tr_read<TILE * 16384 + v_rd_off(1, KST, 0)>(vbK), h4 = tr_read<TILE * 16384 + v_rd_off(1, KST, 1)>(vbK); A[1] = PKF(lo, h4); }
    { const s16x4 lo = tr_read<TILE * 16384 + v_rd_off(2, KST, 0)>(vbK), h4 = tr_read<TILE * 16384 + v_rd_off(2, KST, 1)>(vbK); A[2] = PKF(lo, h4); }
    { const s16x4 lo = tr_read<TILE * 16384 + v_rd_off(3, KST, 0)>(vbK), h4 = tr_read<TILE * 16384 + v_rd_off(3, KST, 1)>(vbK); A[3] = PKF(lo, h4); }
    { const s16x4 lo = tr_read<TILE * 32768 + v_rd_off(0, KST, 0)>(vbV[0]), h4 = tr_read<TILE * 32768 + v_rd_off(0, KST, 1)>(vbV[0]); Bv[0] = PKF(lo, h4); }
    { const s16x4 lo = tr_read<TILE * 32768 + v_rd_off(0, KST, 0)>(vbV[1]), h4 = tr_read<TILE * 32768 + v_rd_off(0, KST, 1)>(vbV[1]); Bv[1] = PKF(lo, h4); }
    asm volatile("s_waitcnt lgkmcnt(0)" ::: "memory"); __builtin_amdgcn_sched_barrier(0);
#pragma unroll
    for (int rb = 0; rb < 4; ++rb)
#pragma unroll
        for (int cb = 0; cb < 2; ++cb) acc[rb][cb] = __builtin_amdgcn_mfma_f32_32x32x16_bf16(A[rb], Bv[cb], acc[rb][cb], 0, 0, 0);
}
__device__ __forceinline__ void ret_local_unit(Frame& F, int b, int h, int c) {
    const bf16_t* RK = WSP(bf16_t, DY_PB) + (size_t)MR * 512; const bf16_t* RV = RK + (size_t)MR * 512;
    const size_t hb = (size_t)(b * 4 + h) * TT + (size_t)c * 256;
    const float lgf = ret_lg2(h, 0), lgb = ret_lg2(h, 1);
    const int w = F.wave, lane = F.lane, c32 = lane & 31, hi = lane >> 5, dir = w >> 2, dvq = w & 3;
    LAS char* lds = (LAS char*)F.lds;
    f32x16 acc[4][2];
#pragma unroll
    for (int rb = 0; rb < 4; ++rb)
#pragma unroll
        for (int cb = 0; cb < 2; ++cb)
#pragma unroll
            for (int r = 0; r < 16; ++r) acc[rb][cb][r] = 0.f;
    const int vbK = (int)(uintptr_t)lds + dir * 32768 + v_rd_base(lane);
    int vbV[2];
#pragma unroll
    for (int cb = 0; cb < 2; ++cb) { const int colblk = 2 * dvq + cb; vbV[cb] = (int)(uintptr_t)lds + 65536 + (colblk >> 2) * 16384 + (colblk & 3) * 512 + v_rd_base(lane); }
    for (int hh = 0; hh < 2; ++hh) {
        __syncthreads();
        u32x4 kq[4];
#pragma unroll
        for (int i = 0; i < 4; ++i) { const int idx = i * NTHR + F.tid, row = idx >> 4, ch = idx & 15, p = 128 * hh + row; kq[i] = *(const u32x4*)(RK + (hb + p) * 128 + ch * 8); }
#pragma unroll
        for (int i = 0; i < 4; ++i) asm volatile("" : "+v"(kq[i]));
#pragma unroll
        for (int i = 0; i < 4; ++i) { const int idx = i * NTHR + F.tid, row = idx >> 4, ch = idx & 15, p = 128 * hh + row;
            const u32x4 kv = kq[i];
            const float ff = __builtin_amdgcn_exp2f(lgf * (float)(255 - p)), fb = __builtin_amdgcn_exp2f(lgb * (float)p);
            const int off = (row >> 6) * 16384 + v_st(row & 63, ch * 8);
            *(LAS u32x4*)(lds + off) = scale8(kv, ff); *(LAS u32x4*)(lds + 32768 + off) = scale8(kv, fb); }
        { u32x4 vq[8];
#pragma unroll
          for (int i = 0; i < 8; ++i) { const int idx = i * NTHR + F.tid, row = idx >> 5, col = (idx & 31) * 8, p = 128 * hh + row; vq[i] = *(const u32x4*)(RV + (hb + p) * 256 + col); }
#pragma unroll
          for (int i = 0; i < 8; ++i) asm volatile("" : "+v"(vq[i]));
#pragma unroll
          for (int i = 0; i < 8; ++i) { const int idx = i * NTHR + F.tid, row = idx >> 5, col = (idx & 31) * 8;
            *(LAS u32x4*)(lds + 65536 + ((row >> 6) * 2 + (col >> 7)) * 16384 + v_st(row & 63, col & 127)) = vq[i]; } }
        __syncthreads();
        ra_step<0, 0>(acc, vbK, vbV); ra_step<0, 1>(acc, vbK, vbV); ra_step<0, 2>(acc, vbK, vbV); ra_step<0, 3>(acc, vbK, vbV);
        ra_step<1, 0>(acc, vbK, vbV); ra_step<1, 1>(acc, vbK, vbV); ra_step<1, 2>(acc, vbK, vbV); ra_step<1, 3>(acc, vbK, vbV);
    }
    bf16_t* us = (bf16_t*)(F.ws + US_RET_OFF) + ((size_t)((b * 4 + h) * 2 + dir) * PPB + cp_of(c, dir)) * RET_US_ELEMS;
#pragma unroll
    for (int rb = 0; rb < 4; ++rb)
#pragma unroll
        for (int cb = 0; cb < 2; ++cb) store_state_tile(us, acc[rb][cb], rb, 2 * dvq + cb, 8, c32, hi);
}

__device__ __forceinline__ void scan_states(Frame& F, bool do_ret, bool do_hg) {
  for (int gt = F.bid * NTHR + F.tid; gt < 131072; gt += F.G * NTHR) {
    if (gt < 65536) {
        if (!do_ret) continue;
        const int seq = gt >> 12, vec = gt & 4095, dir = seq & 1, h = (seq >> 1) & 3;
        const float g = exp2f(ret_lg2(h, dir) * 256.0f);
        u32x4* p = (u32x4*)(F.ws + US_RET_OFF) + (size_t)seq * PPB * 4096 + vec;
        float S[8];
#pragma unroll
        for (int e = 0; e < 8; ++e) S[e] = 0.f;
        for (int cp0 = 0; cp0 < PPB; cp0 += 13) {
            u32x4 ub[13];
#pragma unroll
            for (int k = 0; k < 13; ++k) ub[k] = p[(size_t)(cp0 + k) * 4096];
#pragma unroll
            for (int k = 0; k < 13; ++k) { const u32x4 u = ub[k];
                u32x4 o; o.x = cvtpk(S[0], S[1]); o.y = cvtpk(S[2], S[3]); o.z = cvtpk(S[4], S[5]); o.w = cvtpk(S[6], S[7]); p[(size_t)(cp0 + k) * 4096] = o;
                S[0] = g * S[0] + bflo(u.x); S[1] = g * S[1] + bfhi(u.x); S[2] = g * S[2] + bflo(u.y); S[3] = g * S[3] + bfhi(u.y);
                S[4] = g * S[4] + bflo(u.z); S[5] = g * S[5] + bfhi(u.z); S[6] = g * S[6] + bflo(u.w); S[7] = g * S[7] + bfhi(u.w); } }
    } else {
        if (!do_hg) continue;
        const int gv = gt - 65536, seq = gv >> 11, vec = gv & 2047;
        const int ks = vec >> 8, hi = (vec >> 5) & 1, dk0 = 16 * ks + 8 * hi;
        u32x4* p = (u32x4*)(F.ws + US_HG_OFF) + (size_t)seq * PPB * 2048 + vec;
        const f32x4* ap = (const f32x4*)((const float*)(F.ws + HG_A_OFF) + (size_t)seq * PPB * 128 + dk0);
        float S[8];
#pragma unroll
        for (int e = 0; e < 8; ++e) S[e] = 0.f;
        for (int cp0 = 0; cp0 < PPB; cp0 += 5) {
            u32x4 ub[5]; f32x4 a0b[5], a1b[5];
#pragma unroll
            for (int k = 0; k < 5; ++k) { ub[k] = p[(size_t)(cp0 + k) * 2048]; a0b[k] = ap[(cp0 + k) * 32]; a1b[k] = ap[(cp0 + k) * 32 + 1]; }
#pragma unroll
            for (int k = 0; k < 5; ++k) { const u32x4 u = ub[k]; const f32x4 a0 = a0b[k], a1 = a1b[k];
                u32x4 o; o.x = cvtpk(S[0], S[1]); o.y = cvtpk(S[2], S[3]); o.z = cvtpk(S[4], S[5]); o.w = cvtpk(S[6], S[7]); p[(size_t)(cp0 + k) * 2048] = o;
                S[0] = a0[0] * S[0] + bflo(u.x); S[1] = a0[1] * S[1] + bfhi(u.x); S[2] = a0[2] * S[2] + bflo(u.y); S[3] = a0[3] * S[3] + bfhi(u.y);
                S[4] = a1[0] * S[4] + bflo(u.z); S[5] = a1[1] * S[5] + bfhi(u.z); S[6] = a1[2] * S[6] + bflo(u.w); S[7] = a1[3] * S[7] + bfhi(u.w); } }
    }
  }
}

__device__ __forceinline__ void ret_out_unit(Frame& F, int l, int b, int h, int c) {
    const bf16_t* RQ = WSP(bf16_t, DY_PB); const bf16_t* RK = RQ + (size_t)MR * 512; const bf16_t* RV = RK + (size_t)MR * 512;
    const size_t hb = (size_t)(b * 4 + h) * TT + (size_t)c * 256;
    const float lgf = ret_lg2(h, 0), lgb = ret_lg2(h, 1);
    const int w = F.wave, lane = F.lane, r32 = lane & 31, hi = lane >> 5, irow = 32 * w + r32;
    LAS char* lds = (LAS char*)F.lds;
    bf16x8 qr[8];
#pragma unroll
    for (int d0 = 0; d0 < 8; ++d0) qr[d0] = *(const bf16x8*)(RQ + (hb + irow) * 128 + d0 * 16 + hi * 8);
    const int vb = (int)(uintptr_t)lds + 16384 + v_rd_base(lane);
    unsigned okk[2], ovv[2];
#pragma unroll
    for (int i = 0; i < 2; ++i) { const int P = w + 8 * i, row = 4 * P + (lane >> 4), ch = (lane & 15) ^ (row & 7); okk[i] = (unsigned)(row * 128 + ch * 8);
        const int sub = P * 2 + (lane >> 5), kk = (sub >> 2) * 8 + ((lane & 31) >> 2), k = (kk & ~0xC) | ((kk & 4) << 1) | ((kk & 8) >> 1), c = (sub & 3) * 32 + 8 * (lane & 3); ovv[i] = (unsigned)(k * 256 + c); }
    float ssq[16]; LAS unsigned* keep = (LAS unsigned*)(lds + 65536 + w * 8192) + lane;
#pragma unroll
    for (int r = 0; r < 16; ++r) ssq[r] = 0.f;
    f32x16 o[4];
#pragma unroll 1
    for (int half = 0; half < 2; ++half) {
#pragma unroll
        for (int d = 0; d < 4; ++d)
#pragma unroll
            for (int r = 0; r < 16; ++r) o[d][r] = 0.f;
#define RSC_ISSUE(J_, buf_) do { const size_t kb_ = (hb + 64 * (J_)) * 128, vbs_ = (hb + 64 * (J_)) * 256 + half * 128; \
            __builtin_amdgcn_global_load_lds((const unsigned*)(RK + kb_ + okk[0]), (LAS unsigned*)(lds + (buf_) * 32768 + w * 1024), 16, 0, 0); \
            __builtin_amdgcn_global_load_lds((const unsigned*)(RK + kb_ + okk[1]), (LAS unsigned*)(lds + (buf_) * 32768 + (w + 8) * 1024), 16, 0, 0); \
            __builtin_amdgcn_global_load_lds((const unsigned*)(RV + vbs_ + ovv[0]), (LAS unsigned*)(lds + (buf_) * 32768 + 16384 + w * 1024), 16, 0, 0); \
            __builtin_amdgcn_global_load_lds((const unsigned*)(RV + vbs_ + ovv[1]), (LAS unsigned*)(lds + (buf_) * 32768 + 16384 + (w + 8) * 1024), 16, 0, 0); } while (0)
        asm volatile("s_waitcnt vmcnt(0)" ::: "memory");
        RSC_ISSUE(0, 0);
#pragma unroll 1
        for (int J = 0; J < 4; ++J) {
            const int buf = J & 1;
            asm volatile("s_waitcnt lgkmcnt(0)" ::: "memory"); __builtin_amdgcn_s_barrier(); asm volatile("" ::: "memory");
            if (J < 3) { RSC_ISSUE(J + 1, buf ^ 1); asm volatile("s_waitcnt vmcnt(4)" ::: "memory"); } else asm volatile("s_waitcnt vmcnt(0)" ::: "memory");
            __builtin_amdgcn_s_barrier(); asm volatile("" ::: "memory");
            LAS char* kb = lds + buf * 32768; const int vbj = vb + buf * 32768;
            f32x16 p0, p1;
#pragma unroll
            for (int r = 0; r < 16; ++r) { p0[r] = 0.f; p1[r] = 0.f; }
#pragma unroll
            for (int d0 = 0; d0 < 8; ++d0) { const int cb = (d0 * 16 + hi * 8) * 2;
                const bf16x8 b0 = *(const LAS bf16x8*)(kb + KSWZ256(r32, cb)), b1 = *(const LAS bf16x8*)(kb + KSWZ256(32 + r32, cb));
                p0 = __builtin_amdgcn_mfma_f32_32x32x16_bf16(b0, qr[d0], p0, 0, 0, 0); p1 = __builtin_amdgcn_mfma_f32_32x32x16_bf16(b1, qr[d0], p1, 0, 0, 0); }
#pragma unroll
            for (int r = 0; r < 16; ++r) { const int d0i = irow - (64 * J + crow(r, hi)), d1i = d0i - 32;
                const float e0 = d0i >= 0 ? lgf * (float)d0i : -lgb * (float)d0i, e1 = d1i >= 0 ? lgf * (float)d1i : -lgb * (float)d1i;
                float m0 = __builtin_amdgcn_exp2f(e0), m1 = __builtin_amdgcn_exp2f(e1); if (d0i == 0) m0 = 2.0f; if (d1i == 0) m1 = 2.0f;
                p0[r] *= m0; p1[r] *= m1; }
            bf16x8 pa0, pa1, pa2, pa3;
#define PK4(P, BASE, OUT) do { unsigned a0 = cvtpk(P[BASE + 0], P[BASE + 1]), a1 = cvtpk(P[BASE + 2], P[BASE + 3]);   \
    unsigned b0_ = cvtpk(P[BASE + 4], P[BASE + 5]), b1_ = cvtpk(P[BASE + 6], P[BASE + 7]);                              \
    auto r0 = __builtin_amdgcn_permlane32_swap(a0, b0_, false, false); auto r1 = __builtin_amdgcn_permlane32_swap(a1, b1_, false, false); \
    u32x4 w_ = {r0[0], r1[0], r0[1], r1[1]}; OUT = *reinterpret_cast<bf16x8*>(&w_); } while (0)
            PK4(p0, 0, pa0); PK4(p0, 8, pa1); PK4(p1, 0, pa2); PK4(p1, 8, pa3);
            att::pv_d0(o, vbj, pa0, pa1, pa2, pa3);
        }
#undef RSC_ISSUE
#pragma unroll 1
        for (int dir = 0; dir < 2; ++dir) {
            const float sc = dir ? __builtin_amdgcn_exp2f(lgb * (float)(256 - irow)) : __builtin_amdgcn_exp2f(lgf * (float)(irow + 1));
            const bf16_t* us = (const bf16_t*)(F.ws + US_RET_OFF) + ((size_t)((b * 4 + h) * 2 + dir) * PPB + cp_of(c, dir)) * RET_US_ELEMS;
            __syncthreads();
#pragma unroll
            for (int i = 0; i < 4; ++i) { const int idx = i * NTHR + F.tid, fr_ = idx >> 6, ln = idx & 63, ks = fr_ >> 2, d0 = fr_ & 3;
                *(LAS u32x4*)(lds + 32768 + idx * 16) = *(const u32x4*)(us + ((size_t)(ks * 8 + half * 4 + d0) * 64 + ln) * 8); }
            __syncthreads();
#pragma unroll
            for (int ks = 0; ks < 8; ++ks) { const u32x4 qs = scale8(*reinterpret_cast<const u32x4*>(&qr[ks]), sc); const bf16x8 qa = *reinterpret_cast<const bf16x8*>(&qs);
#pragma unroll
                for (int d0 = 0; d0 < 4; ++d0) { const bf16x8 sf = *(const LAS bf16x8*)(lds + 32768 + ((ks * 4 + d0) * 64 + lane) * 16);
                    o[d0] = __builtin_amdgcn_mfma_f32_32x32x16_bf16(qa, sf, o[d0], 0, 0, 0); } }
        }
#pragma unroll
        for (int d0 = 0; d0 < 4; ++d0)
#pragma unroll
            for (int r = 0; r < 16; ++r) ssq[r] += o[d0][r] * o[d0][r];
        if (half == 0) {
#pragma unroll
            for (int d0 = 0; d0 < 4; ++d0)
#pragma unroll
                for (int r = 0; r < 8; ++r) keep[(d0 * 8 + r) * 64] = cvtpk_c(o[d0][2 * r], o[d0][2 * r + 1]);
        }
    }
    const float* rn = inp(F, I_RNORM) + l * 256;
    bf16_t* ob = WSP(bf16_t, DY_OB) + ((size_t)b * TT + (size_t)c * 256 + 32 * w) * 1024 + h * 256 + r32;
    float wn[8];
#pragma unroll
    for (int j = 0; j < 8; ++j) wn[j] = rn[32 * j + r32];
#pragma unroll
    for (int r = 0; r < 16; ++r) { float s = ssq[r];
        s += __shfl_xor(s, 1); s += __shfl_xor(s, 2); s += __shfl_xor(s, 4); s += __shfl_xor(s, 8); s += __shfl_xor(s, 16);
        const float rs = rsqrtf(s * (1.0f / 256.0f) + EPS); bf16_t* rowp = ob + (size_t)crow(r, hi) * 1024;
#pragma unroll
        for (int d0 = 0; d0 < 4; ++d0) { const unsigned pw = keep[(d0 * 8 + (r >> 1)) * 64]; const float v0 = (r & 1) ? bfhi(pw) : bflo(pw);
            rowp[32 * d0] = (bf16_t)(cvtpk(v0 * rs * wn[d0], 0.f) & 0xffffu);
            rowp[128 + 32 * d0] = (bf16_t)(cvtpk(o[d0][r] * rs * wn[4 + d0], 0.f) & 0xffffu); } }
    __syncthreads();
#undef PK4
}
}


namespace hgm {
using att::crow; using att::v_st; using att::v_rd_base; using att::v_rd_off; using att::tr_read;
constexpr int TTAB_OFF = RING_BYTES + 1024;
__device__ __forceinline__ float dpp_shr0(float v, int) { return v; }
template <int CTRL> __device__ __forceinline__ float dppz(float v) { return __int_as_float(__builtin_amdgcn_update_dpp(0, __float_as_int(v), CTRL, 0xf, 0xf, true)); }
template <bool REV> __device__ __forceinline__ void scan32x8(float (&v)[8], int lane, float (&tot)[8]) {
#pragma unroll
    for (int e = 0; e < 8; ++e) v[e] += REV ? dppz<0x101>(v[e]) : dppz<0x111>(v[e]);
#pragma unroll
    for (int e = 0; e < 8; ++e) v[e] += REV ? dppz<0x102>(v[e]) : dppz<0x112>(v[e]);
#pragma unroll
    for (int e = 0; e < 8; ++e) v[e] += REV ? dppz<0x104>(v[e]) : dppz<0x114>(v[e]);
#pragma unroll
    for (int e = 0; e < 8; ++e) v[e] += REV ? dppz<0x108>(v[e]) : dppz<0x118>(v[e]);
    const bool up = (lane & 32) != 0, addrow = REV ? ((lane & 16) == 0) : ((lane & 16) != 0);
    float cr[8];
#pragma unroll
    for (int e = 0; e < 8; ++e) { const float t0 = __int_as_float(__builtin_amdgcn_readlane(__float_as_int(v[e]), REV ? 16 : 15)), t1 = __int_as_float(__builtin_amdgcn_readlane(__float_as_int(v[e]), REV ? 48 : 47)); cr[e] = up ? t1 : t0; }
#pragma unroll
    for (int e = 0; e < 8; ++e) v[e] += addrow ? cr[e] : 0.f;
#pragma unroll
    for (int e = 0; e < 8; ++e) { const float t0 = __int_as_float(__builtin_amdgcn_readlane(__float_as_int(v[e]), REV ? 0 : 31)), t1 = __int_as_float(__builtin_amdgcn_readlane(__float_as_int(v[e]), REV ? 32 : 63)); tot[e] = up ? t1 : t0; }
}
constexpr int LBT_OFF = TTAB_OFF + 4096 + 4608;
template <bool REV, int LAYOUT> __device__ __forceinline__ void prep(const bf16_t* zrow, const LAS float* lbl, int lane, LAS float* ttab_w, float (&E)[64], LAS char* lds, int row) {
    const int hi = lane >> 5;
    u32x4 zw[8];
#pragma unroll
    for (int d0 = 0; d0 < 8; ++d0) zw[d0] = *(const u32x4*)(zrow + 16 * d0);
#pragma unroll
    for (int d0 = 0; d0 < 8; ++d0) {
        const f32x4 l0 = *(const LAS f32x4*)(lbl + 16 * d0), l1 = *(const LAS f32x4*)(lbl + 16 * d0 + 4);
        const float z[8] = {bflo(zw[d0].x), bfhi(zw[d0].x), bflo(zw[d0].y), bfhi(zw[d0].y), bflo(zw[d0].z), bfhi(zw[d0].z), bflo(zw[d0].w), bfhi(zw[d0].w)};
        const float lb[8] = {l0[0], l0[1], l0[2], l0[3], l1[0], l1[1], l1[2], l1[3]};
        float kk[8], Bv[8], tot[8];
#pragma unroll
        for (int e = 0; e < 8; ++e) { const float sg = sigmoidf_(z[e]); const float f = fmaxf(lb[e] + (1.0f - lb[e]) * sg, 1e-20f); Bv[e] = __builtin_amdgcn_logf(f); kk[e] = (1.0f - lb[e]) * (1.0f - sg); }
        scan32x8<REV>(Bv, lane, tot);
        float kv[8];
#pragma unroll
        for (int e = 0; e < 8; ++e) { const float ee = Bv[e] - tot[e]; E[d0 * 8 + e] = ee; kv[e] = kk[e] * __builtin_amdgcn_exp2f(-ee); }
        if ((lane & 31) == 0) { *(LAS f32x4*)(ttab_w + 16 * d0 + 8 * hi) = (f32x4){tot[0], tot[1], tot[2], tot[3]}; *(LAS f32x4*)(ttab_w + 16 * d0 + 8 * hi + 4) = (f32x4){tot[4], tot[5], tot[6], tot[7]}; }
        u32x4 kh; kh.x = cvtpk(kv[0], kv[1]); kh.y = cvtpk(kv[2], kv[3]); kh.z = cvtpk(kv[4], kv[5]); kh.w = cvtpk(kv[6], kv[7]);
        if (LAYOUT == 0) *(LAS u32x4*)(lds + KSWZ256(row, (16 * d0 + 8 * hi) * 2)) = kh;
        else *(LAS u32x4*)(lds + (row >> 6) * 16384 + v_st(row & 63, 16 * d0 + 8 * hi)) = kh;
        __builtin_amdgcn_sched_barrier(0);
    }
}
__device__ __forceinline__ u32x4 qscale(const u32x4 q, const float* Ek) {
    u32x4 o; o.x = cvtpk(bflo(q.x) * __builtin_amdgcn_exp2f(Ek[0]), bfhi(q.x) * __builtin_amdgcn_exp2f(Ek[1])); o.y = cvtpk(bflo(q.y) * __builtin_amdgcn_exp2f(Ek[2]), bfhi(q.y) * __builtin_amdgcn_exp2f(Ek[3]));
    o.z = cvtpk(bflo(q.z) * __builtin_amdgcn_exp2f(Ek[4]), bfhi(q.z) * __builtin_amdgcn_exp2f(Ek[5])); o.w = cvtpk(bflo(q.w) * __builtin_amdgcn_exp2f(Ek[6]), bfhi(q.w) * __builtin_amdgcn_exp2f(Ek[7])); return o;
}
#define HG_PK4(P, BASE, OUT) do { unsigned a0 = cvtpk_c(P[BASE + 0], P[BASE + 1]), a1 = cvtpk_c(P[BASE + 2], P[BASE + 3]);     \
    unsigned b0_ = cvtpk_c(P[BASE + 4], P[BASE + 5]), b1_ = cvtpk_c(P[BASE + 6], P[BASE + 7]);                              \
    auto r0 = __builtin_amdgcn_permlane32_swap(a0, b0_, false, false); auto r1 = __builtin_amdgcn_permlane32_swap(a1, b1_, false, false); \
    u32x4 w_ = {r0[0], r1[0], r0[1], r1[1]}; OUT = *reinterpret_cast<bf16x8*>(&w_); } while (0)
template <int D0> __device__ __forceinline__ void pv32(f32x16& od, int vb, bf16x8 pa0, bf16x8 pa1) {
    const s16x4 l0 = tr_read<v_rd_off(D0, 0, 0)>(vb), h0 = tr_read<v_rd_off(D0, 0, 1)>(vb), l1 = tr_read<v_rd_off(D0, 1, 0)>(vb), h1 = tr_read<v_rd_off(D0, 1, 1)>(vb);
    asm volatile("s_waitcnt lgkmcnt(0)" ::: "memory"); __builtin_amdgcn_sched_barrier(0);
    od = __builtin_amdgcn_mfma_f32_32x32x16_bf16(pa0, (bf16x8){l0[0], l0[1], l0[2], l0[3], h0[0], h0[1], h0[2], h0[3]}, od, 0, 0, 0);
    od = __builtin_amdgcn_mfma_f32_32x32x16_bf16(pa1, (bf16x8){l1[0], l1[1], l1[2], l1[3], h1[0], h1[1], h1[2], h1[3]}, od, 0, 0, 0);
}

constexpr int PTAB_OFF = TTAB_OFF + 4096;
__device__ __forceinline__ u32x4 qfac(u32x4 Q, const LAS float* ca, const LAS float* cb, bool sub) {
    asm volatile("" : "+v"(Q.x), "+v"(Q.y), "+v"(Q.z), "+v"(Q.w));
    f32x4 a0 = *(const LAS f32x4*)(ca), a1 = *(const LAS f32x4*)(ca + 4);
    if (sub) { a0 -= *(const LAS f32x4*)(cb); a1 -= *(const LAS f32x4*)(cb + 4); }
    u32x4 o; o.x = cvtpk(bflo(Q.x) * __builtin_amdgcn_exp2f(a0[0]), bfhi(Q.x) * __builtin_amdgcn_exp2f(a0[1])); o.y = cvtpk(bflo(Q.y) * __builtin_amdgcn_exp2f(a0[2]), bfhi(Q.y) * __builtin_amdgcn_exp2f(a0[3]));
    o.z = cvtpk(bflo(Q.z) * __builtin_amdgcn_exp2f(a1[0]), bfhi(Q.z) * __builtin_amdgcn_exp2f(a1[1])); o.w = cvtpk(bflo(Q.w) * __builtin_amdgcn_exp2f(a1[2]), bfhi(Q.w) * __builtin_amdgcn_exp2f(a1[3])); return o;
}
constexpr int FTAB_OFF = LBT_OFF + 1024;
__device__ __forceinline__ u32x4 qmul(u32x4 Q, const LAS float* f) {
    asm volatile("" : "+v"(Q.x), "+v"(Q.y), "+v"(Q.z), "+v"(Q.w));
    const f32x4 a0 = *(const LAS f32x4*)(f), a1 = *(const LAS f32x4*)(f + 4);
    u32x4 o; o.x = cvtpk(bflo(Q.x) * a0[0], bfhi(Q.x) * a0[1]); o.y = cvtpk(bflo(Q.y) * a0[2], bfhi(Q.y) * a0[3]);
    o.z = cvtpk(bflo(Q.z) * a1[0], bfhi(Q.z) * a1[1]); o.w = cvtpk(bflo(Q.w) * a1[2], bfhi(Q.w) * a1[3]); return o;
}
template <bool REV, int SK = 0> __device__ __forceinline__ void out_dir(Frame& F, int l, int b, int h, int c, f32x16 (&o)[4]) {
    const int w = F.wave, lane = F.lane, r32 = lane & 31, hi = lane >> 5, dir = REV ? 1 : 0;
    LAS char* lds = (LAS char*)F.lds; LAS float* ttab = (LAS float*)(lds + TTAB_OFF); LAS float* ptab = (LAS float*)(lds + PTAB_OFF);
    const size_t rowoff = ((size_t)(b * 8 + h) * TT + (size_t)c * 256 + 32 * w + r32) * 128 + 8 * hi;
    const bf16_t* Z = WSP(bf16_t, DY_PC) + (size_t)(1 + dir) * MR * 1024 + rowoff; const bf16_t* GQ = WSP(bf16_t, DY_PC) + rowoff;
    LAS float* lbt = (LAS float*)(lds + LBT_OFF) + dir * 128;
    __syncthreads();
    u32x4 Qp[8];
    { float E[64];
      prep<REV, 0>(Z, lbt + 8 * hi, lane, ttab + w * 128, E, lds, 32 * w + r32);
#pragma unroll
      for (int d0 = 0; d0 < 8; ++d0) Qp[d0] = *(const u32x4*)(GQ + 16 * d0);
#pragma unroll
      for (int d0 = 0; d0 < 8; ++d0) asm volatile("" : "+v"(Qp[d0]));
#pragma unroll
      for (int d0 = 0; d0 < 8; ++d0) Qp[d0] = qscale(Qp[d0], &E[d0 * 8]); }
    __syncthreads();
    if (F.tid < 128) { float s = 0.f;
#pragma unroll
        for (int pi = 0; pi < 8; ++pi) { ptab[pi * 128 + F.tid] = s; s += ttab[(REV ? 7 - pi : pi) * 128 + F.tid]; }
        ptab[8 * 128 + F.tid] = s; }
    __syncthreads();
    const int vbase = (int)(uintptr_t)lds + 65536 + v_rd_base(lane);
    const int piw = REV ? 7 - w : w; const LAS float* cw = ptab + (piw + 1) * 128 + 8 * hi; LAS float* ftab = (LAS float*)(lds + FTAB_OFF) + w * 128;
    for (int pi = (SK & 1) ? -1 : piw; pi >= 0; --pi) {
        const int J = REV ? 7 - pi : pi; const LAS float* cj = ptab + (pi + 1) * 128 + 8 * hi;
        { const LAS float* pw = ptab + (piw + 1) * 128, *pj = ptab + (pi + 1) * 128;
          ftab[lane] = __builtin_amdgcn_exp2f(pw[lane] - pj[lane]); ftab[lane + 64] = __builtin_amdgcn_exp2f(pw[lane + 64] - pj[lane + 64]); }
        asm volatile("s_waitcnt lgkmcnt(0)" ::: "memory");
        f32x16 p;
#pragma unroll
        for (int r = 0; r < 16; ++r) p[r] = 0.f;
#pragma unroll
        for (int d0 = 0; d0 < 8; ++d0) { const u32x4 qt = qmul(Qp[d0], ftab + 8 * hi + 16 * d0); const bf16x8 a = *(const LAS bf16x8*)(lds + KSWZ256(32 * J + r32, (16 * d0 + 8 * hi) * 2));
            p = __builtin_amdgcn_mfma_f32_32x32x16_bf16(a, *reinterpret_cast<const bf16x8*>(&qt), p, 0, 0, 0);
            if (d0 & 1) __builtin_amdgcn_sched_barrier(0); }
        if (pi == piw) {
#pragma unroll
            for (int r = 0; r < 16; ++r) { const int jj = crow(r, hi); const bool keep = REV ? (jj >= r32) : (jj <= r32); p[r] = keep ? p[r] : 0.f; } }
        bf16x8 pa0, pa1; HG_PK4(p, 0, pa0); HG_PK4(p, 8, pa1);
        const int vb = vbase + (J >> 1) * 16384 + (J & 1) * 8192;
        pv32<0>(o[0], vb, pa0, pa1); pv32<1>(o[1], vb, pa0, pa1); pv32<2>(o[2], vb, pa0, pa1); pv32<3>(o[3], vb, pa0, pa1);
    }
    const bf16_t* us = (const bf16_t*)(F.ws + scn::US_HG_OFF) + ((size_t)((b * 8 + h) * 2 + dir) * PPB + scn::cp_of(c, dir)) * scn::HG_US_ELEMS + (size_t)lane * 8;
    if (!(SK & 2)) {
        bf16x8 sfa[2][4], sfb[2][4];
#define HG_SLD(buf, kq) do { _Pragma("unroll") for (int k2 = 0; k2 < 2; ++k2) _Pragma("unroll") for (int d0 = 0; d0 < 4; ++d0) buf[k2][d0] = *(const bf16x8*)(us + (size_t)((2 * (kq) + k2) * 4 + d0) * 512); } while (0)
#define HG_SMM(buf, kq) do { _Pragma("unroll") for (int k2 = 0; k2 < 2; ++k2) { const u32x4 qe = qfac(Qp[2 * (kq) + k2], cw + 16 * (2 * (kq) + k2), cw, false);                                  \
            _Pragma("unroll") for (int d0 = 0; d0 < 4; ++d0) o[d0] = __builtin_amdgcn_mfma_f32_32x32x16_bf16(*reinterpret_cast<const bf16x8*>(&qe), buf[k2][d0], o[d0], 0, 0, 0); } } while (0)
        HG_SLD(sfa, 0); HG_SLD(sfb, 1); __builtin_amdgcn_sched_barrier(0);
        HG_SMM(sfa, 0); __builtin_amdgcn_sched_barrier(0); HG_SLD(sfa, 2); __builtin_amdgcn_sched_barrier(0);
        HG_SMM(sfb, 1); __builtin_amdgcn_sched_barrier(0); HG_SLD(sfb, 3); __builtin_amdgcn_sched_barrier(0);
        HG_SMM(sfa, 2); __builtin_amdgcn_sched_barrier(0); HG_SMM(sfb, 3); __builtin_amdgcn_sched_barrier(0);
#undef HG_SLD
#undef HG_SMM
    }
    __syncthreads();
}
template <int SK = 0> __device__ __forceinline__ void out_unit(Frame& F, int l, int b, int h, int c) {
    const int w = F.wave, lane = F.lane, r32 = lane & 31, hi = lane >> 5;
    LAS char* lds = (LAS char*)F.lds;
    const size_t rowoff = ((size_t)(b * 8 + h) * TT + (size_t)c * 256 + 32 * w + r32) * 128 + 8 * hi;
    const bf16_t* GI = WSP(bf16_t, DY_PC) + (size_t)3 * MR * 1024 + rowoff;
    { u32x4 gv[8];
#pragma unroll
      for (int d0 = 0; d0 < 8; ++d0) gv[d0] = *(const u32x4*)(GI + 16 * d0);
      float lbv = 0.f; if (F.tid < 256) lbv = WSP(float, WS_LB)[l * 2048 + (F.tid >> 7) * 1024 + h * 128 + (F.tid & 127)];
#pragma unroll
      for (int d0 = 0; d0 < 8; ++d0) asm volatile("" : "+v"(gv[d0]));
      if (F.tid < 256) ((LAS float*)(lds + LBT_OFF))[F.tid] = lbv;
#pragma unroll
      for (int d0 = 0; d0 < 8; ++d0) { const int row = 32 * w + r32; *(LAS u32x4*)(lds + 65536 + (row >> 6) * 16384 + v_st(row & 63, 16 * d0 + 8 * hi)) = gv[d0]; } }
    f32x16 o[4];
#pragma unroll
    for (int d = 0; d < 4; ++d)
#pragma unroll
        for (int r = 0; r < 16; ++r) o[d][r] = 0.f;
    out_dir<false, SK>(F, l, b, h, c, o);
    if (!(SK & 4)) out_dir<true, SK>(F, l, b, h, c, o);
    const float* gn = inp(F, I_GNORM) + l * 128;
    bf16_t* oc = WSP(bf16_t, DY_OC) + ((size_t)b * TT + (size_t)c * 256 + 32 * w) * 1024 + h * 128 + r32;
    float wn[4];
#pragma unroll
    for (int j = 0; j < 4; ++j) wn[j] = gn[32 * j + r32];
#pragma unroll
    for (int r = 0; r < 16; ++r) { float s = 0.f;
#pragma unroll
        for (int d0 = 0; d0 < 4; ++d0) s += o[d0][r] * o[d0][r];
        s += __shfl_xor(s, 1); s += __shfl_xor(s, 2); s += __shfl_xor(s, 4); s += __shfl_xor(s, 8); s += __shfl_xor(s, 16);
        const float rs = rsqrtf(s * (1.0f / 128.0f) + EPS); bf16_t* rowp = oc + (size_t)crow(r, hi) * 1024;
#pragma unroll
        for (int d0 = 0; d0 < 4; ++d0) rowp[32 * d0] = (bf16_t)(cvtpk(o[d0][r] * rs * wn[d0], 0.f) & 0xffffu); }
}

template <bool REV> __device__ __forceinline__ void local_dir(Frame& F, int l, int b, int h, int c) {
    const int w = F.wave, lane = F.lane, r32 = lane & 31, hi = lane >> 5, dir = REV ? 1 : 0, rb = w >> 1, cb0 = 2 * (w & 1);
    LAS char* lds = (LAS char*)F.lds; LAS float* ttab = (LAS float*)(lds + TTAB_OFF);
    const bf16_t* Z = WSP(bf16_t, DY_PC) + (size_t)(1 + dir) * MR * 1024 + ((size_t)(b * 8 + h) * TT + (size_t)c * 256 + 32 * w + r32) * 128 + 8 * hi;
    LAS float* lbt = (LAS float*)(lds + LBT_OFF) + dir * 128;
    __syncthreads();
    { float E[64]; prep<REV, 1>(Z, lbt + 8 * hi, lane, ttab + w * 128, E, lds, 32 * w + r32); }
    __syncthreads();
    f32x16 acc[2];
#pragma unroll
    for (int cb = 0; cb < 2; ++cb)
#pragma unroll
        for (int r = 0; r < 16; ++r) acc[cb][r] = 0.f;
    const int vbK0 = (int)(uintptr_t)lds + rb * 512 + v_rd_base(lane), vbV0 = (int)(uintptr_t)lds + 65536 + cb0 * 512 + v_rd_base(lane);
    for (int i = 0; i < 8; ++i) { const int blk = REV ? 7 - i : i;
        if (i > 0) { const LAS float* tb = ttab + blk * 128 + 32 * rb + 4 * hi;
#pragma unroll
            for (int g = 0; g < 4; ++g) { const f32x4 t = *(const LAS f32x4*)(tb + 8 * g);
#pragma unroll
                for (int j = 0; j < 4; ++j) { const float s = __builtin_amdgcn_exp2f(t[j]); acc[0][4 * g + j] *= s; acc[1][4 * g + j] *= s; } } }
        const int off = (blk >> 1) * 16384 + (blk & 1) * 8192; const int vk = vbK0 + off, vv = vbV0 + off;
#define HL_STEP(KS2) { const s16x4 al = tr_read<v_rd_off(0, KS2, 0)>(vk), ah = tr_read<v_rd_off(0, KS2, 1)>(vk), b0l = tr_read<v_rd_off(0, KS2, 0)>(vv), b0h = tr_read<v_rd_off(0, KS2, 1)>(vv), \
            b1l = tr_read<v_rd_off(1, KS2, 0)>(vv), b1h = tr_read<v_rd_off(1, KS2, 1)>(vv); \
            asm volatile("s_waitcnt lgkmcnt(0)" ::: "memory"); __builtin_amdgcn_sched_barrier(0); \
            const bf16x8 A_ = {al[0], al[1], al[2], al[3], ah[0], ah[1], ah[2], ah[3]}; \
            acc[0] = __builtin_amdgcn_mfma_f32_32x32x16_bf16(A_, (bf16x8){b0l[0], b0l[1], b0l[2], b0l[3], b0h[0], b0h[1], b0h[2], b0h[3]}, acc[0], 0, 0, 0); \
            acc[1] = __builtin_amdgcn_mfma_f32_32x32x16_bf16(A_, (bf16x8){b1l[0], b1l[1], b1l[2], b1l[3], b1h[0], b1h[1], b1h[2], b1h[3]}, acc[1], 0, 0, 0); }
        HL_STEP(0) HL_STEP(1)
#undef HL_STEP
    }
    const size_t slot = (size_t)((b * 8 + h) * 2 + dir) * PPB + scn::cp_of(c, dir);
    bf16_t* us = (bf16_t*)(F.ws + scn::US_HG_OFF) + slot * scn::HG_US_ELEMS;
    scn::store_state_tile(us, acc[0], rb, cb0, 4, r32, hi); scn::store_state_tile(us, acc[1], rb, cb0 + 1, 4, r32, hi);
    if (F.tid < 128) { float s = 0.f;
#pragma unroll
        for (int k = 0; k < 8; ++k) s += ttab[k * 128 + F.tid];
        ((float*)(F.ws + scn::HG_A_OFF))[slot * 128 + F.tid] = __builtin_amdgcn_exp2f(s); }
    __syncthreads();
}
__device__ __forceinline__ void local_unit(Frame& F, int l, int b, int h, int c) {
    const int w = F.wave, lane = F.lane, r32 = lane & 31, hi = lane >> 5;
    LAS char* lds = (LAS char*)F.lds;
    const bf16_t* GI = WSP(bf16_t, DY_PC) + (size_t)3 * MR * 1024 + ((size_t)(b * 8 + h) * TT + (size_t)c * 256 + 32 * w + r32) * 128 + 8 * hi;
    { u32x4 gv[8];
#pragma unroll
      for (int d0 = 0; d0 < 8; ++d0) gv[d0] = *(const u32x4*)(GI + 16 * d0);
      float lbv = 0.f; if (F.tid < 256) lbv = WSP(float, WS_LB)[l * 2048 + (F.tid >> 7) * 1024 + h * 128 + (F.tid & 127)];
#pragma unroll
      for (int d0 = 0; d0 < 8; ++d0) asm volatile("" : "+v"(gv[d0]));
      if (F.tid < 256) ((LAS float*)(lds + LBT_OFF))[F.tid] = lbv;
#pragma unroll
      for (int d0 = 0; d0 < 8; ++d0) { const int row = 32 * w + r32; *(LAS u32x4*)(lds + 65536 + (row >> 6) * 16384 + v_st(row & 63, 16 * d0 + 8 * hi)) = gv[d0]; } }
    local_dir<false>(F, l, b, h, c);
    local_dir<true>(F, l, b, h, c);
}
}

__device__ __forceinline__ void sa_phase(Frame& F, int l) {
    for (int u = F.bid; u < NB * 4 * PPB; u += F.G) { const int c = u % PPB, h = (u / PPB) & 3, b = u / (PPB * 4); scn::ret_local_unit(F, b, h, c); __syncthreads(); }
    frame_refresh(F);
    for (int u = F.G - 1 - F.bid; u < NB * 8 * PPB; u += F.G) { const int c = u % PPB, h = (u / PPB) & 7, b = u / (PPB * 8); hgm::local_unit(F, l, b, h, c); }
}
__device__ __forceinline__ void sc_phase(Frame& F, int l) {
    const int NC = (l == 1) ? PPB - 1 : PPB;
    for (int u = F.bid; u < NB * 4 * NC; u += F.G) { const int c = u % NC, h = (u / NC) & 3, b = u / (NC * 4); scn::ret_out_unit(F, l, b, h, c); }
    frame_refresh(F);
#ifndef HG_PROBE
#define HG_PROBE -1
#endif
    if (HG_PROBE >= 0) { for (int u = F.G - 1 - F.bid; u < NB * 8 * NC; u += F.G) { const int c = u % NC, h = (u / NC) & 7, b = u / (NC * 8); hgm::out_unit<(HG_PROBE < 0 ? 0 : HG_PROBE)>(F, l, b, h, c); } frame_refresh(F); }
    for (int u = F.G - 1 - F.bid; u < NB * 8 * NC; u += F.G) { const int c = u % NC, h = (u / NC) & 7, b = u / (NC * 8); hgm::out_unit<0>(F, l, b, h, c); }
}

#ifndef RET_MFMA
#define RET_MFMA 1
#endif
enum { PH_PRO = 0, PH_MODFIN, PH_N1, PH_GA, PH_ATT, PH_GB, PH_SA, PH_SB, PH_SC, PH_OG, PH_MG, PH_WO, PH_N2, PH_UP, PH_FIX, PH_DN, PH_COUNT };

template <int NN, int WG> struct PanelOrder : pg8::TileOrder<NN, WG> {
    int skip;
    __device__ __forceinline__ bool next(int i, pg8::Unit& u) const { const bool ok = pg8::TileOrder<NN, WG>::next(i, u); if (ok && skip) u.pm += (u.pm >= PPB - 1) ? 1 : 0; return ok; }
};
struct ProjOrder : PanelOrder<8, 4> {
    __device__ __forceinline__ bool next(int i, pg8::Unit& u) const { const int r = i / 3, n = i - 3 * r; const bool ok = PanelOrder<8, 4>::next(r, u); if (ok) { u.pm += n * NPAN; u.pn += 8 * n; } return ok; }
    __device__ __forceinline__ bool keep(int i) const { return (i % 3) != 2; }
};
template <int N, int WG, class Epi> __device__ __forceinline__ void run_gemm(Frame& F, const bf16_t* A, const bf16_t* Bt, int K, const Epi& E, bool skipctx = false) {
    pg8::Gemm g{A, Bt, MR, N, K}; PanelOrder<N / 256, WG> S; S.init(skipctx ? MR - 512 : MR, N, F.G, F.bid); S.skip = skipctx ? 1 : 0;
    pg8::gemm_phase<Epi, PanelOrder<N / 256, WG>, false>(F.lds, g, S, E, nullptr);
}
__device__ __forceinline__ EpiIn make_epi_in(Frame& F, int l, int pt0) {
    EpiIn E; E.pt0 = pt0;
    E.rq = WSP(bf16_t, DY_QKV); E.r2 = WSP(bf16_t, DY_PB); E.r1 = WSP(bf16_t, DY_PC);
    E.qkn = inp(F, I_QKN) + l * 128; E.ropeA = WSP(f32x2, WS_ROPEA); E.ropeB = WSP(f32x2, WS_ROPEB);
    return E;
}
__device__ __forceinline__ EpiRes make_epi_res(Frame& F, int l, int use_inputs, int gidx) {
    EpiRes E; E.srcx = use_inputs ? inp(F, I_X) : outp(F); E.srcc = use_inputs ? inp(F, I_CTX) : WSP(float, WS_XC); E.dstx = outp(F); E.dstc = WSP(float, WS_XC);
    E.gate0 = WSP(float, WS_MODV) + ((size_t)(l * 3) * 6 + gidx) * D; return E;
}

template <int PH> __device__ __forceinline__ void run_phase(Frame& F, int l) {
    frame_refresh(F);
    const bf16_t* h = WSP(bf16_t, WS_H); const bf16_t* wt = WSP(bf16_t, WS_WT);
    const bf16_t* wt_in = wt + WT_IN / 2;
    if constexpr (PH == PH_PRO) { p0_mod_partial(F); p0_tables(F); convert_weights(F, 0, 0, CT_IN, 0); }
    if constexpr (PH == PH_MODFIN) { p1_mod_final(F); }
    if constexpr (PH == PH_N1) { norm_phase(F, l, 0); }
    if constexpr (PH == PH_GA) { const EpiIn E = make_epi_in(F, l, PT_DQ); run_gemm<9216, 8>(F, h, wt_in, D, E);
        frame_refresh(F); if (l == 0) convert_weights(F, 0, CT0_UP, CT0_DN, 72); else convert_weights(F, 1, CT0_DN, CT_ALL, 72); }
#ifndef ATT_PROBE
#define ATT_PROBE -1
#endif
    if constexpr (PH == PH_ATT) { if (ATT_PROBE >= 0) { attn_phase<(ATT_PROBE < 0 ? 0 : ATT_PROBE)>(F, l); __syncthreads(); } attn_phase<0>(F, l); }
    if constexpr (PH == PH_GB) { }
    if constexpr (PH == PH_SA) { sa_phase(F, l); }
    if constexpr (PH == PH_SB) { scn::scan_states(F, true, true); }
    if constexpr (PH == PH_SC) { sc_phase(F, l); }
    if constexpr (PH == PH_OG) { EpiGates E; E.oB = WSP(bf16_t, DY_OB); E.oC = WSP(bf16_t, DY_OC); E.G = WSP(bf16_t, DY_MG); E.bias = inp(F, I_BGATE) + (size_t)l * 3 * D;
        run_gemm<8192, 4>(F, h, wt_in + (size_t)PT_RG * 256 * D, D, E, l == 1);
        if (l == 0) { frame_refresh(F); convert_weights(F, 0, CT0_BR, CT0_UP, 64); convert_weights(F, 0, CT0_DN, CT_ALL, 64); } }
    if constexpr (PH == PH_MG) {
        EpiProjAll E{WSP(bf16_t, DY_MG), WSP(bf16_t, DY_YO)};
        pg8::Gemm g{WSP(bf16_t, DY_OA), wt + WT_BR / 2, MR, 2048, 1024}; ProjOrder S; const bool sk = (l == 1); S.init(sk ? MR - 512 : MR, 2048, F.G, F.bid); S.skip = sk ? 1 : 0;
        pg8::gemm_phase<EpiProjAll, ProjOrder, false>(F.lds, g, S, E, nullptr);
    }
    if constexpr (PH == PH_WO) { const EpiRes E = make_epi_res(F, l, l == 0, 2); run_gemm<2048, 4>(F, WSP(bf16_t, DY_YO), wt + WT_OUT / 2, D, E, l == 1); }
    if constexpr (PH == PH_N2) { norm_phase(F, l, 1); }
    if constexpr (PH == PH_UP) { EpiConv E; E.g = WSP(bf16_t, DY_G); E.raw = WSP(float, DY_RAW); E.cw = inp(F, I_CONVW) + (size_t)l * 3 * NUP; E.cb = inp(F, I_CONVB) + (size_t)l * NUP;
        run_gemm<NUP, 8>(F, h, wt + WT_UP / 2, D, E, l == 1); }
    if constexpr (PH == PH_FIX) { ffn_fixup(F, l); }
    if constexpr (PH == PH_DN) { const EpiRes E = make_epi_res(F, l, 0, 5); run_gemm<2048, 4>(F, WSP(bf16_t, DY_G), wt + WT_DOWN / 2, DFF, E, l == 1);
        if (l == 0) { frame_refresh(F); convert_weights(F, 1, 0, CT0_DN, 16); } }
}

__device__ __forceinline__ void frame_init(Frame& F, const Args& a, unsigned char* lds) {
    F.lds = (LAS unsigned char*)lds; F.a = &a; F.G = gridDim.x; F.bid = blockIdx.x; frame_refresh(F);
}
template <int PH> __global__ void __launch_bounds__(NTHR, 2) k_phase(Args a) {
    extern __shared__ __attribute__((aligned(16))) unsigned char lds[];
    Frame F; frame_init(F, a, lds);
    run_phase<PH>(F, a.layer);
}
#ifndef MK_SINGLE
#define MK_SINGLE 1
#endif
__global__ void __launch_bounds__(NTHR, 2) k_all(Args a) {
    extern __shared__ __attribute__((aligned(16))) unsigned char lds[];
    Frame F; frame_init(F, a, lds);
    for (int u = F.tid; u < (LDS_BYTES - LDSCTL_OFF) / 4; u += NTHR) ((LAS unsigned*)(F.lds + LDSCTL_OFF))[u] = 0u;
    __syncthreads();
    (void)xcd_barrier_post((unsigned*)(a.ws + WS_CTL) + CW_BAR, (volatile LAS unsigned*)(F.lds + MISC_OFF + 32));
#define GRID_BAR() do { XcdBarrier b_; unsigned* bp_ = (unsigned*)(a.ws + WS_CTL) + CW_BAR; asm volatile("" : "+s"(bp_)); b_.bar = bp_; b_.x = xb_xcc_id(); \
        b_.st = (volatile LAS unsigned*)(F.lds + MISC_OFF + 32); xcd_barrier(b_); } while (0)
#ifndef PROBE_MASK
#define PROBE_MASK 0
#endif
#ifndef PROBE_T
#define PROBE_T 0
#endif
    unsigned long long pt0 = 0, pt1 = 0, pc0 = 0, pc1 = 0;
#define TSTART(ph, l_) do { if (PROBE_T && (ph) == PROBE_T - 1 && (l_) == 0) { pt0 = __builtin_amdgcn_s_memrealtime(); pc0 = (unsigned long long)clock64(); } } while (0)
#define TSTOP(ph, l_)  do { if (PROBE_T && (ph) == PROBE_T - 1 && (l_) == 0) { pt1 = __builtin_amdgcn_s_memrealtime(); pc1 = (unsigned long long)clock64(); } } while (0)
#define RUN(ph, l_, grp) do { TSTART(ph, l_); run_phase<ph>(F, l_); GRID_BAR(); TSTOP(ph, l_); if ((PROBE_MASK >> (grp)) & 1) { run_phase<ph>(F, l_); GRID_BAR(); } } while (0)
    RUN(PH_PRO, 0, 0); RUN(PH_MODFIN, 0, 0);
#pragma unroll 1
    for (int l = 0; l < 2; ++l) {
        RUN(PH_N1, l, 0);
        RUN(PH_GA, l, 1);
        RUN(PH_ATT, l, 2);
        RUN(PH_SA, l, 3);
        run_phase<PH_SB>(F, l); GRID_BAR();
        RUN(PH_SC, l, 4);
        run_phase<PH_OG>(F, l); GRID_BAR();
        RUN(PH_MG, l, 5);
        run_phase<PH_WO>(F, l); GRID_BAR();
        RUN(PH_N2, l, 0);
        RUN(PH_UP, l, 6);
        RUN(PH_FIX, l, 0);
        run_phase<PH_DN>(F, l); GRID_BAR();
    }
#undef RUN
    if (PROBE_T) {
        float* slot = (float*)(F.ws + WS_SCAL) + 64;
        if (F.bid == 0 && threadIdx.x == 0) { const float mhz = (float)(pc1 - pc0) / ((float)(pt1 - pt0) * 0.01f); *slot = floorf(mhz / 50.0f) * 50.0f; }
        GRID_BAR();
        const float v = *slot;
        for (size_t i = (size_t)F.bid * NTHR + threadIdx.x; i < (size_t)NB * T * D; i += (size_t)F.G * NTHR) a.out[i] = v;
    }
#undef GRID_BAR
}
__global__ void k_fill(float* out, size_t n, float v) { for (size_t i = (size_t)blockIdx.x * blockDim.x + threadIdx.x; i < n; i += (size_t)gridDim.x * blockDim.x) out[i] = v; }

template <int PH> static void launch_phase(const Args& a0, int layer, int grid, hipStream_t stream) {
    static bool attr = false;
    if (!attr) { if (hipFuncSetAttribute((const void*)k_phase<PH>, hipFuncAttributeMaxDynamicSharedMemorySize, LDS_BYTES) != hipSuccess) fprintf(stderr, "kernel_launch: hipFuncSetAttribute failed for phase %d\n", PH); attr = true; }
    Args a = a0; a.layer = layer;
    hipLaunchKernelGGL(k_phase<PH>, dim3(grid), dim3(NTHR), LDS_BYTES, stream, a);
    const hipError_t e = hipPeekAtLastError(); if (e != hipSuccess) fprintf(stderr, "kernel_launch: phase %d launch failed: %s\n", PH, hipGetErrorName(e));
}
extern "C" void kernel_launch(void* const* d_in, const int* in_sizes, int n_in, void* d_out, int out_size, void* d_ws, size_t ws_size, hipStream_t stream) {
    static int grid = 0;
    if (grid == 0) { int dev = 0, cus = 0; if (hipGetDevice(&dev) != hipSuccess || hipDeviceGetAttribute(&cus, hipDeviceAttributeMultiprocessorCount, dev) != hipSuccess || cus < 1) cus = 256; grid = cus; }
    if (n_in != N_INPUTS || out_size != NB * T * D || ws_size < WS_END) {
        fprintf(stderr, "kernel_launch: unexpected shapes: n_in %d out %d ws %zu (need %zu)\n", n_in, out_size, ws_size, (size_t)WS_END);
        hipLaunchKernelGGL(k_fill, dim3(1024), dim3(256), 0, stream, (float*)d_out, (size_t)out_size, (float)(ws_size >> 20));
        return;
    }
    Args a{};
    for (int i = 0; i < N_INPUTS; ++i) a.in[i] = (const float*)d_in[i];
    a.out = (float*)d_out; a.ws = (unsigned char*)d_ws; a.layer = 0; a.ph_lo = 0; a.ph_hi = 0; a.pad = 0;
#if MK_SINGLE
    {
        static bool attr = false;
        if (!attr) { if (hipFuncSetAttribute((const void*)k_all, hipFuncAttributeMaxDynamicSharedMemorySize, LDS_BYTES) != hipSuccess) fprintf(stderr, "kernel_launch: hipFuncSetAttribute failed\n");
            int per_cu = 0; if (hipOccupancyMaxActiveBlocksPerMultiprocessor(&per_cu, (const void*)k_all, NTHR, LDS_BYTES) != hipSuccess || per_cu < 1) fprintf(stderr, "kernel_launch: occupancy query says %d blocks per CU\n", per_cu);
            (void)hipGetLastError(); attr = true; }
        if (hipMemsetAsync((char*)d_ws + WS_CTL, 0, CTL_ZERO_BYTES, stream) != hipSuccess) { fprintf(stderr, "kernel_launch: memset failed\n"); return; }
        hipLaunchKernelGGL(k_all, dim3(grid), dim3(NTHR), LDS_BYTES, stream, a);
        const hipError_t e = hipPeekAtLastError(); if (e != hipSuccess) fprintf(stderr, "kernel_launch: launch failed: %s\n", hipGetErrorName(e));
        return;
    }
#endif
    launch_phase<PH_PRO>(a, 0, grid, stream);
    launch_phase<PH_MODFIN>(a, 0, grid, stream);
    for (int l = 0; l < 2; ++l) {
        launch_phase<PH_N1>(a, l, grid, stream); launch_phase<PH_GA>(a, l, grid, stream); launch_phase<PH_ATT>(a, l, grid, stream); launch_phase<PH_GB>(a, l, grid, stream);
        launch_phase<PH_SA>(a, l, grid, stream); launch_phase<PH_SB>(a, l, grid, stream); launch_phase<PH_SC>(a, l, grid, stream);
        launch_phase<PH_OG>(a, l, grid, stream); launch_phase<PH_MG>(a, l, grid, stream);
        launch_phase<PH_WO>(a, l, grid, stream); launch_phase<PH_N2>(a, l, grid, stream); launch_phase<PH_UP>(a, l, grid, stream); launch_phase<PH_FIX>(a, l, grid, stream);
        launch_phase<PH_DN>(a, l, grid, stream);
    }
}
```

```cpp
#include <hip/hip_runtime.h>
#include <cstdio>
#include <cstdint>
namespace pg8 {
#define PG8_LAS __attribute__((address_space(3)))
typedef unsigned short bf16_t;
typedef short bf16x8 __attribute__((ext_vector_type(8)));
typedef float f32x4 __attribute__((ext_vector_type(4)));
typedef unsigned u32x4 __attribute__((ext_vector_type(4)));
constexpr int BM = 256, BK = 64, HALF = 128, HTB = HALF * BK * 2  , STAGE_BYTES = 8 * HTB, NXCD = 8, WGM = 8;

__host__ __device__ __forceinline__ int lds_byte(int r, int c) { const int st = (r >> 4) * 2 + (c >> 5), rr = r & 15, cc = c & 31, ob = rr * 64 + cc * 2; return st * 1024 + (ob ^ (((ob >> 9) & 1) << 5)); }
__host__ __device__ __forceinline__ void stage_rc(int b, int& R, int& C) { const int st = b / 1024, sb = b % 1024, swz = sb ^ (((sb >> 9) & 1) << 5); R = (st >> 1) * 16 + swz / 64; C = (st & 1) * 32 + (swz % 64) / 2; }
__host__ __device__ __forceinline__ int perm32(int rho) { const int n = rho >> 4, i = rho & 15; return 8 * (i >> 2) + 4 * n + (i & 3); }

struct Unit { int pm, pn; };
struct Gemm { const bf16_t* A; const bf16_t* Bt; int M, N, K; };

struct StaticOrder {
    int nM, nN, nwg, G, c, wgm;
    __host__ __device__ void init(int M, int N, int G_, int c_) { nM = M / BM; nN = N / BM; nwg = nM * nN; G = G_; c = c_; wgm = WGM; }
    __host__ __device__ bool next(int i, Unit& u) const {
        const long L = (long)i * G + c; if (L >= nwg) return false;
        int wgid = (int)L; { const int q = nwg / NXCD, r = nwg % NXCD, xcd = wgid % NXCD, off = wgid / NXCD; wgid = (xcd < r ? xcd * (q + 1) : r * (q + 1) + (xcd - r) * q) + off; }
        const int nig = wgm * nN, gid = wgid / nig, fm = gid * wgm, gsz = (nM - fm) < wgm ? (nM - fm) : wgm;
        u.pm = fm + ((wgid % nig) % gsz); u.pn = (wgid % nig) / gsz; return true;
    }
    __device__ __forceinline__ void a_ready(const Unit&) const {}
    __device__ __forceinline__ void done(const Unit&) const {}
};
template <int NN, int WG> struct TileOrder {
    int nM, G;
    __host__ __device__ void init(int M, int, int G_, int) { nM = M / BM; G = G_; }
    __device__ __forceinline__ bool next(int i, Unit& u) const {
        const int nwg = nM * NN; const long L = (long)i * G + (int)blockIdx.x; if (L >= nwg) return false;
        constexpr int gsz = WG * NN; const int share = ((nwg / NXCD) / gsz) * gsz;
        int wgid = (int)L; if (wgid < NXCD * share) wgid = (wgid % NXCD) * share + wgid / NXCD;
        const int gid = wgid / gsz, fm = gid * WG, gh = (nM - fm) < WG ? (nM - fm) : WG, in = wgid - gid * gsz;
        u.pm = fm + in % gh; u.pn = in / gh; return true;
    }
    __device__ __forceinline__ void a_ready(const Unit&) const {}
    __device__ __forceinline__ void done(const Unit&) const {}
};
struct CountedOrder : StaticOrder {
    const unsigned* ready; unsigned need; unsigned* tmo;
    __device__ __forceinline__ void a_ready(const Unit& u) const {
        if (threadIdx.x < 64) {
            const unsigned long long t0 = __builtin_amdgcn_s_memrealtime(); unsigned polls = 0;
            while ((unsigned)__builtin_amdgcn_readfirstlane(__hip_atomic_load(ready + 64 * u.pm, __ATOMIC_RELAXED, __HIP_MEMORY_SCOPE_AGENT)) < need) {
                if ((++polls & 255u) == 0u && __builtin_amdgcn_readfirstlane(__hip_atomic_load(tmo, __ATOMIC_RELAXED, __HIP_MEMORY_SCOPE_AGENT)) != 0u) break;
                if (__builtin_amdgcn_s_memrealtime() - t0 > 2000000ull) {
                    if (threadIdx.x == 0) { unsigned expect = 0u; __hip_atomic_compare_exchange_strong(tmo + 1, &expect, 0x600u | (unsigned)(u.pm & 0xff), __ATOMIC_RELAXED, __ATOMIC_RELAXED, __HIP_MEMORY_SCOPE_AGENT); __hip_atomic_store(tmo, 1u, __ATOMIC_RELAXED, __HIP_MEMORY_SCOPE_AGENT); }
                    break; }
                __builtin_amdgcn_s_sleep(2); }
            __builtin_amdgcn_fence(__ATOMIC_ACQUIRE, "agent");
            asm volatile("s_waitcnt vmcnt(0)" ::: "memory");
        }
#if !defined(BROKEN_HOOK_NO_BARRIER)
        asm volatile("" ::: "memory"); __builtin_amdgcn_s_barrier(); asm volatile("" ::: "memory");
#endif
    }
};

template <class T, class = void> struct keeps_acc { static constexpr bool value = false; };
template <class T> struct keeps_acc<T, decltype((void)T::KEEPS_ACC)> { static constexpr bool value = true; };
template <class Epi, class Sched, bool STAMP = false>
__device__ __forceinline__ void gemm_phase(PG8_LAS unsigned char* lds, const Gemm g, const Sched& S, const Epi& E, unsigned long long* stamps) {
    int tid_ = threadIdx.x; asm volatile("" : "+v"(tid_));
    const int tid = tid_, wid = __builtin_amdgcn_readfirstlane(tid >> 6), lane = tid & 63, wr = wid >> 2, wc = wid & 3, fr = lane & 15, fq = lane >> 4;
    const int K = g.K, nt = K / BK;
    int ts_lo = 0, ts_hi = 0, nts = 0; const unsigned long long rt_entry = STAMP ? (unsigned long long)wall_clock64() : 0ull;
#define PG8_STAMP() do { if (STAMP && wid == 0 && nts < 64) { const unsigned long long _c = (unsigned long long)clock64(); \
        ts_lo = (lane == nts) ? (int)(unsigned)_c : ts_lo; ts_hi = (lane == nts) ? (int)(unsigned)(_c >> 32) : ts_hi; ++nts; } } while (0)
    PG8_STAMP();
    unsigned voffA[2], voffB[2];
#pragma unroll
    for (int i = 0; i < 2; ++i) { int R, C; stage_rc(tid * 16 + i * 8192, R, C); const int Rb = Epi::PERM ? ((R & ~31) + perm32(R & 31)) : R;
        voffA[i] = (unsigned)(R * K + C) * 2u; voffB[i] = (unsigned)(Rb * K + C) * 2u; }
    const size_t kstep = (size_t)(BK * 2);
    const size_t hstep = (size_t)HALF * K * 2;
    const size_t tstep = 2 * hstep;
    const unsigned ldsw = (unsigned)wid * 1024u;
    const int aoff = lds_byte(wr * 64 + fr, fq * 8), boff = lds_byte(wc * 32 + fr, fq * 8);
#define PG8_SA(b, h) (((b) * 2 + (h)) * HTB)
#define PG8_SB(b, h) ((4 + (b) * 2 + (h)) * HTB)
#define PG8_STAGE(bufoff, gbase, voff) do { const char* g_ = (const char*)(gbase); asm volatile("" : "+s"(g_));     \
        _Pragma("unroll") for (int _i = 0; _i < 2; ++_i) { asm volatile("" : "+v"((voff)[_i]));                         \
        __builtin_amdgcn_global_load_lds((const unsigned*)(g_ + (voff)[_i]), (PG8_LAS unsigned*)(lds + (bufoff) + ldsw + _i * 8192), 16, 0, 0); } } while (0)
#define PG8_LDA(dst, b, h) do { _Pragma("unroll") for (int m = 0; m < 4; ++m) _Pragma("unroll") for (int k = 0; k < 2; ++k) dst[m][k] = *(const PG8_LAS bf16x8*)(lds + PG8_SA(b, h) + aoff + m * 2048 + k * 1024); } while (0)
#define PG8_LDB(dst, b, h) do { _Pragma("unroll") for (int n = 0; n < 2; ++n) _Pragma("unroll") for (int k = 0; k < 2; ++k) dst[n][k] = *(const PG8_LAS bf16x8*)(lds + PG8_SB(b, h) + boff + n * 2048 + k * 1024); } while (0)
#define PG8_MMA(ai, bj, At, Bt) do { __builtin_amdgcn_s_setprio(1); _Pragma("unroll") for (int m = 0; m < 4; ++m) _Pragma("unroll") for (int n = 0; n < 2; ++n) _Pragma("unroll") for (int k = 0; k < 2; ++k) \
        acc[ai][bj][m][n] = __builtin_amdgcn_mfma_f32_16x16x32_bf16(Bt[n][k], At[m][k], acc[ai][bj][m][n], 0, 0, 0); __builtin_amdgcn_s_setprio(0); } while (0)
#define PG8_WAIT_V(n) asm volatile("s_waitcnt vmcnt(" #n ")" ::: "memory")
#define PG8_WAIT_L(n) asm volatile("s_waitcnt lgkmcnt(" #n ")" ::: "memory")
#define PG8_BAR __builtin_amdgcn_s_barrier()
#define PG8_SCHED __builtin_amdgcn_sched_barrier(0)
    Unit cur, nxt; int ui = 0;
    if (!S.next(0, cur)) return;
    f32x4 acc[2][2][4][2];
#pragma unroll
    for (int a = 0; a < 2; ++a)
#pragma unroll
        for (int b = 0; b < 2; ++b)
#pragma unroll
            for (int m = 0; m < 4; ++m)
#pragma unroll
                for (int n = 0; n < 2; ++n) acc[a][b][m][n] = (f32x4){0.f, 0.f, 0.f, 0.f};
    bf16x8 At[4][2], B0[2][2], B1[2][2];
    const char* cA = (const char*)g.A + (size_t)cur.pm * tstep; const char* cB = (const char*)g.Bt + (size_t)cur.pn * tstep;
    S.a_ready(cur);
    PG8_STAGE(PG8_SB(0, 0), cB, voffB); PG8_STAGE(PG8_SA(0, 0), cA, voffA); PG8_STAGE(PG8_SB(0, 1), cB + hstep, voffB); PG8_STAGE(PG8_SA(0, 1), cA + hstep, voffA);
    if (wr == 1) PG8_BAR;
    PG8_WAIT_V(4); PG8_BAR;
    PG8_STAGE(PG8_SB(1, 0), cB + kstep, voffB); PG8_STAGE(PG8_SA(1, 0), cA + kstep, voffA); PG8_STAGE(PG8_SB(1, 1), cB + hstep + kstep, voffB);
    PG8_WAIT_V(6); PG8_BAR;
    PG8_STAMP();
    for (;;) {
        const bool has_next = S.next(ui + 1, nxt);
        const char* nA = has_next ? (const char*)g.A + (size_t)nxt.pm * tstep : cA; const char* nB = has_next ? (const char*)g.Bt + (size_t)nxt.pn * tstep : cB;
        for (int t = 0; t < nt; t += 2) {
            const bool last = (t == nt - 2);
            const char* a1 = cA + (size_t)(t + 1) * kstep;
            const char* a2 = last ? nA : cA + (size_t)(t + 2) * kstep; const char* b2 = last ? nB : cB + (size_t)(t + 2) * kstep;
            const char* a3 = a2 + kstep; const char* b3 = b2 + kstep;
            if (last && has_next) S.a_ready(nxt);
            PG8_LDB(B0, 0, 0); PG8_SCHED; PG8_LDA(At, 0, 0); PG8_STAGE(PG8_SA(1, 1), a1 + hstep, voffA);
            PG8_WAIT_L(8); PG8_BAR; PG8_WAIT_L(0); PG8_MMA(0, 0, At, B0); PG8_BAR; PG8_SCHED;
            PG8_LDB(B1, 0, 1); PG8_STAGE(PG8_SB(0, 0), b2, voffB);
            PG8_BAR; PG8_WAIT_L(0); PG8_MMA(0, 1, At, B1); PG8_BAR;
            PG8_LDA(At, 0, 1); PG8_STAGE(PG8_SA(0, 0), a2, voffA);
            PG8_BAR; PG8_WAIT_L(0); PG8_MMA(1, 0, At, B0); PG8_BAR; PG8_SCHED;
            PG8_STAGE(PG8_SB(0, 1), b2 + hstep, voffB);
            PG8_WAIT_V(6); PG8_BAR; PG8_MMA(1, 1, At, B1); PG8_BAR;
            PG8_LDB(B0, 1, 0); PG8_SCHED; PG8_LDA(At, 1, 0); PG8_STAGE(PG8_SA(0, 1), a2 + hstep, voffA);
            PG8_WAIT_L(8); PG8_BAR; PG8_WAIT_L(0); PG8_MMA(0, 0, At, B0); PG8_BAR; PG8_SCHED;
            PG8_LDB(B1, 1, 1); PG8_STAGE(PG8_SB(1, 0), b3, voffB);
            PG8_BAR; PG8_WAIT_L(0); PG8_MMA(0, 1, At, B1); PG8_BAR;
            PG8_LDA(At, 1, 1); PG8_STAGE(PG8_SA(1, 0), a3, voffA);
            PG8_BAR; PG8_WAIT_L(0); PG8_MMA(1, 0, At, B0); PG8_BAR; PG8_SCHED;
            PG8_STAGE(PG8_SB(1, 1), b3 + hstep, voffB);
            PG8_WAIT_V(6); PG8_BAR; PG8_MMA(1, 1, At, B1); PG8_BAR;
        }
        PG8_STAMP();
        if constexpr (!Epi::AFTER_DRAIN) { E(acc, cur, wr, wc, fr, fq); S.done(cur); }
        PG8_STAMP();
        if (!has_next) break;
        bool keep_acc = false;
        if constexpr (keeps_acc<Epi>::value) keep_acc = S.keep(ui);
        if (!keep_acc) {
#pragma unroll
        for (int a = 0; a < 2; ++a)
#pragma unroll
            for (int b = 0; b < 2; ++b)
#pragma unroll
                for (int m = 0; m < 4; ++m)
#pragma unroll
                    for (int n = 0; n < 2; ++n) acc[a][b][m][n] = (f32x4){0.f, 0.f, 0.f, 0.f};
        }
        cur = nxt; cA = nA; cB = nB; ++ui;
    }
    PG8_WAIT_V(0);
    if (wr == 0) PG8_BAR;
    PG8_BAR;
    if constexpr (Epi::AFTER_DRAIN) { E.fused(acc, cur, wr, wc, fr, fq, lds, wid, lane); S.done(cur); }
    PG8_STAMP();
    if (STAMP && wid == 0) { stamps[lane] = lane < nts ? (((unsigned long long)(unsigned)ts_hi << 32) | (unsigned)ts_lo) : 0ull;
        if (lane == 62) stamps[62] = rt_entry; if (lane == 63) stamps[63] = (unsigned long long)wall_clock64(); }
#undef PG8_STAMP
#undef PG8_SA
#undef PG8_SB
#undef PG8_STAGE
#undef PG8_LDA
#undef PG8_LDB
#undef PG8_MMA
#undef PG8_WAIT_V
#undef PG8_WAIT_L
#undef PG8_BAR
#undef PG8_SCHED
}
}

#define GAS __attribute__((address_space(1)))
#define LAS __attribute__((address_space(3)))
typedef unsigned short bf16_t;
typedef short bf16x8 __attribute__((ext_vector_type(8)));
typedef short s16x4 __attribute__((ext_vector_type(4)));
typedef float f32x4 __attribute__((ext_vector_type(4)));
typedef float f32x2 __attribute__((ext_vector_type(2)));
typedef float f32x16 __attribute__((ext_vector_type(16)));
typedef unsigned u32x4 __attribute__((ext_vector_type(4)));
typedef unsigned u32x2 __attribute__((ext_vector_type(2)));

typedef __bf16 bf16x2_t __attribute__((ext_vector_type(2)));
__device__ __forceinline__ unsigned cvtpk_c(float lo, float hi) { const f32x2 v = {lo, hi}; return __builtin_bit_cast(unsigned, __builtin_convertvector(v, bf16x2_t)); }
__device__ __forceinline__ unsigned cvtpk(float lo, float hi) { unsigned r; asm volatile("v_cvt_pk_bf16_f32 %0, %1, %2" : "=v"(r) : "v"(lo), "v"(hi)); return r; }
__device__ __forceinline__ float bf2f(unsigned short b) { return __uint_as_float(((unsigned)b) << 16); }
__device__ __forceinline__ float bflo(unsigned w) { return __uint_as_float(w << 16); }
__device__ __forceinline__ float bfhi(unsigned w) { return __uint_as_float(w & 0xffff0000u); }
__device__ __forceinline__ float wave_sum(float v) {
#pragma unroll
    for (int o = 1; o < 64; o <<= 1) v += __shfl_xor(v, o);
    return v;
}
__device__ __forceinline__ float sigmoidf_(float x) { return __builtin_amdgcn_rcpf(1.0f + __builtin_amdgcn_exp2f(-1.4426950408889634f * x)); }
__device__ __forceinline__ float siluf_(float x) { return x * __builtin_amdgcn_rcpf(1.0f + __builtin_amdgcn_exp2f(-1.4426950408889634f * x)); }

#define XB_TMO      128
#define XB_XCNT(j)  (256  + 64 * (j))
#define XB_XSUB(j)  (1280 + 64 * (j))
#define XB_XGEN(j)  (2304 + 64 * (j))
#define XB_TOP      3328
#define XB_TOPGEN   3392
#define XCD_BAR_WORDS 3456
#define XB_SPIN_CAP (1u << 18)

__device__ __forceinline__ unsigned xb_ld(unsigned* p)              { return __hip_atomic_load(p, __ATOMIC_RELAXED, __HIP_MEMORY_SCOPE_AGENT); }
__device__ __forceinline__ unsigned xb_add(unsigned* p, unsigned v) { return __hip_atomic_fetch_add(p, v, __ATOMIC_RELAXED, __HIP_MEMORY_SCOPE_AGENT); }
__device__ __forceinline__ unsigned xb_xcc_id() { return (unsigned)__builtin_amdgcn_s_getreg((3 << 11) | 20) & 0xFu; }
#define XB_SPIN(cond, bar) do { unsigned _sp = 0; while (cond) { __builtin_amdgcn_s_sleep(1); \
    if ((++_sp & 255u) == 0u) { if (xb_ld(&(bar)[XB_TMO])) break; if (_sp > XB_SPIN_CAP) { atomicAdd(&(bar)[XB_TMO], 1u); break; } } } } while (0)

struct XcdBarrier {
    unsigned* bar; unsigned x;
    volatile LAS unsigned* st;
};
__device__ __forceinline__ XcdBarrier xcd_barrier_post(unsigned* bar, volatile LAS unsigned* st) {
    XcdBarrier b; b.bar = bar; b.x = xb_xcc_id(); b.st = st;
    if (threadIdx.x == 0) (void)xb_add(&bar[XB_XCNT(b.x)], 1u);
    return b;
}
__device__ __forceinline__ void xcd_barrier_complete(unsigned* bar, unsigned x, unsigned& nloc, unsigned& nx) {
    const unsigned G = gridDim.x * gridDim.y * gridDim.z;
    unsigned sum, cnt, mine, sp = 0u;
    for (;;) {
        sum = 0u; cnt = 0u; mine = 0u;
#pragma unroll
        for (unsigned j = 0; j < 16; ++j) { const unsigned c = xb_ld(&bar[XB_XCNT(j)]); sum += c; cnt += (c > 0u) ? 1u : 0u; mine = (j == x) ? c : mine; }
        if (sum == G) break;
        __builtin_amdgcn_s_sleep(1);
        if ((++sp & 255u) == 0u) { if (xb_ld(&bar[XB_TMO])) break; if (sp > XB_SPIN_CAP) { atomicAdd(&bar[XB_TMO], 1u); break; } }
    }
    nloc = mine > 0u ? mine : 1u; nx = cnt > 0u ? cnt : 1u;
}
__device__ __forceinline__ void xcd_barrier(const XcdBarrier& b) {
    asm volatile("s_waitcnt vmcnt(0)" ::: "memory");
    __syncthreads();
    if (threadIdx.x == 0) {
        unsigned* bar = b.bar;
        __builtin_amdgcn_s_waitcnt(0);
        unsigned nloc = b.st[0], nx = b.st[1];
        if (nloc == 0u) { xcd_barrier_complete(bar, b.x, nloc, nx); b.st[0] = nloc; b.st[1] = nx; }
        const unsigned old = xb_add(&bar[XB_XSUB(b.x)], 1u);
        const unsigned gen = old / nloc;
        if (old + 1u == (gen + 1u) * nloc) {
            __builtin_amdgcn_fence(__ATOMIC_RELEASE, "agent");
            asm volatile("s_waitcnt vmcnt(0)" ::: "memory");
            const unsigned og = xb_add(&bar[XB_TOP], 1u);
            const unsigned tg = og / nx;
            if (og + 1u == (tg + 1u) * nx) xb_add(&bar[XB_TOPGEN], 1u);
            else XB_SPIN(xb_ld(&bar[XB_TOPGEN]) == tg, bar);
            __builtin_amdgcn_fence(__ATOMIC_ACQUIRE, "agent");
            xb_add(&bar[XB_XGEN(b.x)], 1u);
            asm volatile("s_waitcnt vmcnt(0)" ::: "memory");
        } else {
            XB_SPIN(xb_ld(&bar[XB_XGEN(b.x)]) == gen, bar);
            __builtin_amdgcn_fence(__ATOMIC_ACQUIRE, "agent");
            asm volatile("s_waitcnt vmcnt(0)" ::: "memory");
        }
    }
    __syncthreads();
}

constexpr int D = 2048, NB = 2, T = 16384, LC = 256, TT = T + LC  , MR = NB * TT  ;
constexpr int NPAN = MR / 256  , PPB = TT / 256  ;
constexpr int NIN = 17408, DFF = 5504, NUP = 2 * DFF;
constexpr int NWAVES = 8, NTHR = 512;
constexpr float EPS = 1e-6f;
constexpr float LOG2E = 1.4426950408889634f;

enum { I_X = 0, I_C, I_CTX, I_CCTX, I_WMOD, I_BMOD, I_WIN, I_BGATE, I_QKN, I_LAMBDA, I_SUBLN, I_RNORM, I_GLB, I_GNORM, I_WBR, I_WOUT, I_WUP, I_CONVW, I_CONVB, I_WDOWN, N_INPUTS };

enum { TY_ROPE64 = 0, TY_ROPE128 = 1, TY_PLAIN = 2 };
enum { PT_DQ = 0, PT_DK = 4, PT_DV = 8, PT_RQ = 12, PT_RK = 14, PT_RV = 16, PT_GQ = 20, PT_GF = 24, PT_GB = 28, PT_GI = 32, PT_RG = 36, PT_GG = 40, PT_MA = 44, PT_MB = 52, PT_MC = 60, PT_END = 68 };
__host__ __device__ __forceinline__ int pt_logical_base(int pt) {
    if (pt < PT_RQ) return 256 * pt;
    if (pt < PT_RV) return 3072 + 256 * (pt - PT_RQ);
    if (pt < PT_GQ) return 4096 + 256 * (pt - PT_RV);
    if (pt < PT_RG) return 6144 + 256 * (pt - PT_GQ);
    if (pt < PT_GG) return 5120 + 256 * (pt - PT_RG);
    if (pt < PT_MA) return 10240 + 256 * (pt - PT_GG);
    return 11264 + 256 * (pt - PT_MA);
}
__host__ __device__ __forceinline__ int pt_type(int pt) { return pt < PT_DV ? TY_ROPE64 : (pt >= PT_RQ && pt < PT_RV) ? TY_ROPE128 : TY_PLAIN; }
__host__ __device__ __forceinline__ int perm_col(int type, int p) {
    const int bj = p >> 7, wc = (p >> 5) & 3, n = (p >> 4) & 1, fq = (p >> 2) & 3, e = p & 3;
    if (type == TY_ROPE64)  return 64 * wc + 32 * (fq >> 1) + 16 * bj + 8 * (fq & 1) + 4 * n + e;
    if (type == TY_ROPE128) return 128 * (wc >> 1) + 64 * (wc & 1) + 32 * bj + 8 * fq + 4 * n + e;
    return 64 * wc + 32 * bj + 8 * fq + 4 * n + e;
}
__host__ __device__ __forceinline__ int perm_col_up(int p) { const int bj = p >> 7, wc = (p >> 5) & 3, n = (p >> 4) & 1, fq = (p >> 2) & 3, e = p & 3; return 128 * bj + 32 * wc + 8 * fq + 4 * n + e; }

constexpr size_t MiB = 1u << 20;
constexpr size_t WS_CTL = 0, CTL_ZERO_BYTES = 1 * MiB;
constexpr size_t WS_MODP = 1 * MiB;
constexpr size_t WS_MODV = 6 * MiB;
constexpr size_t WS_ROPEA = 7 * MiB;
constexpr size_t WS_ROPEB = 7 * MiB + 64 * 1024;
constexpr size_t WS_LB = 7 * MiB + 256 * 1024;
constexpr size_t WS_SCAL = 7 * MiB + 512 * 1024;
constexpr size_t WS_XC = 9 * MiB;
constexpr size_t WS_WT = 13 * MiB;
constexpr size_t WT_IN = 0, WT_BR = 68 * MiB, WT_OUT = 80 * MiB, WT_UP = 88 * MiB, WT_DOWN = 131 * MiB;
constexpr size_t WS_H = 166 * MiB;
constexpr size_t WS_DYN = 296 * MiB;
constexpr size_t DY_OA = WS_DYN, DY_OB = WS_DYN + 65 * MiB, DY_OC = WS_DYN + 130 * MiB;
constexpr size_t DY_OSUB = WS_DYN + 195 * MiB;
constexpr size_t DY_US = DY_OSUB;
constexpr size_t DY_QKV = WS_DYN + 65 * MiB;
constexpr size_t DY_O1 = WS_DYN + 260 * MiB;
constexpr size_t DY_PC = WS_DYN + 325 * MiB;
constexpr size_t DY_PB = WS_DYN + 585 * MiB;
constexpr size_t DY_MG = WS_DYN + 325 * MiB;
constexpr size_t DY_Y = DY_OSUB, DY_YO = DY_OSUB;
constexpr size_t DY_G = WS_DYN, DY_RAW = WS_DYN + 350 * MiB;
constexpr size_t WS_END = WS_DYN + 715 * MiB;
constexpr size_t SZ_ROWS1K = (size_t)MR * 1024 * 2;

constexpr int CW_BAR = 4096;

constexpr int RING_BYTES = 131072, LDSCTL_OFF = RING_BYTES, MISC_OFF = LDSCTL_OFF + 320, LDS_BYTES = 147456;

struct Args { const float* in[N_INPUTS]; float* out; unsigned char* ws; int layer, ph_lo, ph_hi, pad; };

struct Frame {
    LAS unsigned char* lds;
    int tid, lane, wave, G, bid;
    const Args* a; unsigned char* ws;
};
__device__ __forceinline__ float* outp(const Frame& F) { GAS float* p = (GAS float*)F.a->out; asm volatile("" : "+s"(p)); return (float*)p; }
__device__ __forceinline__ const float* inp(const Frame& F, int i) { const GAS float* p = (const GAS float*)F.a->in[i]; asm volatile("" : "+s"(p)); return (const float*)p; }
__device__ __forceinline__ int opaque_tid() { int t = threadIdx.x; asm volatile("" : "+v"(t)); return t; }
__device__ __forceinline__ void frame_refresh(Frame& F) { GAS unsigned char* w_ = (GAS unsigned char*)F.a->ws; asm volatile("" : "+s"(w_)); F.ws = (unsigned char*)w_; F.tid = opaque_tid(); F.lane = F.tid & 63; F.wave = __builtin_amdgcn_readfirstlane(F.tid >> 6); }
#define WSP(T_, off) ((T_*)(F.ws + (off)))

__device__ __forceinline__ void p0_mod_partial(Frame& F) {
    LAS float* sv = (LAS float*)F.lds;
    for (int i = F.tid; i < 3 * D; i += NTHR) { const int v = i / D, k = i % D; const float c = v < 2 ? inp(F, I_C)[v * D + k] : inp(F, I_CCTX)[k]; sv[i] = siluf_(c); }
    __syncthreads();
    float* part = WSP(float, WS_MODP);
    const int total = 2 * 16 * 3072;
    for (int task = F.bid * NTHR + F.tid; task < total; task += F.G * NTHR) {
        const int q = task % 3072, ks = (task / 3072) % 16, l = task / (3072 * 16);
        const float* W = inp(F, I_WMOD) + ((size_t)l * D + ks * 128) * (6 * D) + q * 4;
        f32x4 a0 = {0, 0, 0, 0}, a1 = a0, a2 = a0;
#pragma unroll 8
        for (int k = 0; k < 128; ++k) { const f32x4 w = *(const f32x4*)(W + (size_t)k * (6 * D)); const float s0 = sv[ks * 128 + k], s1 = sv[D + ks * 128 + k], s2 = sv[2 * D + ks * 128 + k];
            a0 += w * s0; a1 += w * s1; a2 += w * s2; }
        float* o = part + ((size_t)(ks * 2 + l) * 3) * (6 * D) + q * 4;
        *(f32x4*)(o) = a0; *(f32x4*)(o + 6 * D) = a1; *(f32x4*)(o + 12 * D) = a2;
    }
    __syncthreads();
}
__device__ __forceinline__ void p0_tables(Frame& F) {
    const int gt = F.bid * NTHR + F.tid, NGT = F.G * NTHR;
    f32x2* ra = WSP(f32x2, WS_ROPEA); f32x2* rb = WSP(f32x2, WS_ROPEB);
    for (int i = gt; i < 256 * 16; i += NGT) { const int pos = i >> 4, f = i & 15; const float inv = powf(10000.0f, -(float)f / 16.0f); const float ang = (float)pos * inv; ra[i] = (f32x2){cosf(ang), sinf(ang)}; }
    for (int i = gt; i < 256 * 32; i += NGT) { const int pos = i >> 5, f = i & 31; const float inv = powf(10000.0f, -(float)f / 32.0f); const float ang = (float)pos * inv; rb[i] = (f32x2){cosf(ang), sinf(ang)}; }
    float* lb = WSP(float, WS_LB);
    for (int i = gt; i < 2 * 1024; i += NGT) { const float g0 = inp(F, I_GLB)[i], g1 = inp(F, I_GLB)[2048 + i]; const float m = fmaxf(g0, g1); const float e0 = expf(g0 - m), e1 = expf(g1 - m);
        lb[i] = 0.0f; lb[2048 + i] = e1 / (e0 + e1); }
    if (gt == 0) {
        float* sc = WSP(float, WS_SCAL);
        for (int l = 0; l < 2; ++l) {
            const float* al = inp(F, I_LAMBDA) + l * 256; float s1 = 0.f, s2 = 0.f;
            for (int i = 0; i < 64; ++i) { s1 += al[i] * al[64 + i]; s2 += al[128 + i] * al[192 + i]; }
            const float lam_init = 0.8f - 0.6f * expf(-0.3f * (float)l);
            sc[l] = expf(s1) - expf(s2) + lam_init;
            const float* g = inp(F, I_QKN) + l * 128; float mq = 0.f, mk = 0.f;
            for (int i = 0; i < 64; ++i) { mq = fmaxf(mq, fabsf(g[i])); mk = fmaxf(mk, fabsf(g[64 + i])); }
            sc[2 + l] = -(8.0f * mq * mk * 1.02f) * LOG2E;
        }
    }
}
__device__ __forceinline__ void convert_tile(Frame& F, const float* W, int N, int K, bf16_t* WT, int prow0, int k0, int base0, int base1, int ptype  ) {
    LAS float* t = (LAS float*)F.lds;
    { float wv[32];
#pragma unroll
      for (int i = 0; i < 32; ++i) { const int idx = i * NTHR + F.tid, kk = idx >> 8, c = idx & 255; const int col = c < 128 ? base0 + c : base1 + (c - 128);
          wv[i] = W[(size_t)(k0 + kk) * N + col]; }
#pragma unroll
      for (int i = 0; i < 32; ++i) { const int idx = i * NTHR + F.tid, kk = idx >> 8, c = idx & 255; t[kk * 257 + c] = wv[i]; } }
    __syncthreads();
#pragma unroll
    for (int i = 0; i < 4; ++i) { const int item = i * NTHR + F.tid, ch = item & 7, p = item >> 3; const int lc = ptype < 0 ? perm_col_up(p) : perm_col(ptype, p);
        const LAS float* s = t + (8 * ch) * 257 + lc;
        u32x4 o; o.x = cvtpk(s[0], s[257]); o.y = cvtpk(s[2 * 257], s[3 * 257]); o.z = cvtpk(s[4 * 257], s[5 * 257]); o.w = cvtpk(s[6 * 257], s[7 * 257]);
        *(u32x4*)(WT + (size_t)(prow0 + p) * K + k0 + 8 * ch) = o; }
    __syncthreads();
}
constexpr int CT_IN = 68 * 32, CT_BR = 3 * 8 * 16, CT_OUT = 8 * 32, CT_UP = 43 * 32, CT_DN = 8 * 86;
constexpr int CT0_BR = CT_IN, CT0_OUT = CT0_BR + CT_BR, CT0_UP = CT0_OUT + CT_OUT, CT0_DN = CT0_UP + CT_UP, CT_ALL = CT0_DN + CT_DN;
__device__ __forceinline__ void convert_weights(Frame& F, int l, int lo, int hi, int c0_) {
    bf16_t* wt = WSP(bf16_t, WS_WT);
    constexpr int T_IN = CT_IN, T_BR = CT_BR, T_OUT = CT_OUT, T_UP = CT_UP;
    const int c0 = (F.G == 256) ? c0_ : 0;
    if (F.bid < c0) return;
    for (int it = lo + F.bid - c0; it < hi; it += F.G - c0) {
        int r = it;
        if (r < T_IN) { const int pt = r / 32, kb = r % 32; const int lb = pt_logical_base(pt);
            convert_tile(F, inp(F, I_WIN) + (size_t)l * D * NIN, NIN, D, wt + WT_IN / 2, pt * 256, kb * 64, lb, lb + 128, pt_type(pt)); continue; } r -= T_IN;
        if (r < T_BR) { const int n = r / 128, pt = (r % 128) / 16, kb = r % 16;
            convert_tile(F, inp(F, I_WBR) + ((size_t)l * 3 + n) * 1024 * D, D, 1024, wt + WT_BR / 2 + (size_t)n * D * 1024, pt * 256, kb * 64, pt * 256, pt * 256 + 128, TY_PLAIN); continue; } r -= T_BR;
        if (r < T_OUT) { const int pt = r / 32, kb = r % 32;
            convert_tile(F, inp(F, I_WOUT) + (size_t)l * D * D, D, D, wt + WT_OUT / 2, pt * 256, kb * 64, pt * 256, pt * 256 + 128, TY_PLAIN); continue; } r -= T_OUT;
        if (r < T_UP) { const int pt = r / 32, kb = r % 32;
            convert_tile(F, inp(F, I_WUP) + (size_t)l * D * NUP, NUP, D, wt + WT_UP / 2, pt * 256, kb * 64, pt * 128, DFF + pt * 128, -1); continue; } r -= T_UP;
        { const int pt = r / 86, kb = r % 86;
            convert_tile(F, inp(F, I_WDOWN) + (size_t)l * DFF * D, D, DFF, wt + WT_DOWN / 2, pt * 256, kb * 64, pt * 256, pt * 256 + 128, TY_PLAIN); }
    }
}
__device__ __forceinline__ void p1_mod_final(Frame& F) {
    const float* part = WSP(float, WS_MODP); float* mv = WSP(float, WS_MODV);
    for (int i = F.bid * NTHR + F.tid; i < 2 * 3 * 6 * D; i += F.G * NTHR) { const int n = i % (6 * D), l = i / (3 * 6 * D);
        float s = inp(F, I_BMOD)[l * 6 * D + n];
#pragma unroll
        for (int ks = 0; ks < 16; ++ks) s += part[(size_t)ks * (2 * 3 * 6 * D) + i];
        mv[i] = s; }
}

__device__ __forceinline__ const float* xrow_src(Frame& F, int R, int use_inputs) {
    const int b = R / TT, t = R % TT;
    if (t < T) return (use_inputs ? inp(F, I_X) : (const float*)outp(F)) + ((size_t)b * T + t) * D;
    return (use_inputs ? inp(F, I_CTX) : (const float*)WSP(float, WS_XC)) + ((size_t)b * LC + (t - T)) * D;
}
__device__ __forceinline__ void norm_phase(Frame& F, int l, int which  ) {
    const int gw = F.bid * NWAVES + F.wave, NGW = F.G * NWAVES;
    bf16_t* h = WSP(bf16_t, WS_H); const float* mv = WSP(float, WS_MODV);
    const int use_inputs = (l == 0 && which == 0);
    f32x4 x[8], xn[8], sc1[8], sh[8]; int vcur = -1;
    if (gw < MR) { const f32x4* xr = (const f32x4*)xrow_src(F, gw, use_inputs) + F.lane;
#pragma unroll
        for (int j = 0; j < 8; ++j) x[j] = xr[64 * j]; }
    for (int R = gw; R < MR; R += NGW) {
        const int Rn = R + NGW;
        if (Rn < MR) { const f32x4* xr = (const f32x4*)xrow_src(F, Rn, use_inputs) + F.lane;
#pragma unroll
            for (int j = 0; j < 8; ++j) xn[j] = xr[64 * j]; }
        const int b = R / TT, t = R % TT, v = t < T ? b : 2;
        if (v != vcur) {
            const float* shift = mv + ((size_t)(l * 3 + v) * 6 + (which ? 3 : 0)) * D; const float* scale = shift + D;
#pragma unroll
            for (int j = 0; j < 8; ++j) { sc1[j] = *((const f32x4*)scale + F.lane + 64 * j) + 1.0f; sh[j] = *((const f32x4*)shift + F.lane + 64 * j); }
            vcur = v;
        }
        float ss = 0.f;
#pragma unroll
        for (int j = 0; j < 8; ++j) ss += (x[j].x * x[j].x + x[j].y * x[j].y) + (x[j].z * x[j].z + x[j].w * x[j].w);
        const float rstd = rsqrtf(wave_sum(ss) * (1.0f / D) + EPS);
        u32x2* o = (u32x2*)(h + (size_t)R * D) + F.lane;
#pragma unroll
        for (int j = 0; j < 8; ++j) { const f32x4 y = x[j] * rstd * sc1[j] + sh[j]; u32x2 w; w.x = cvtpk(y.x, y.y); w.y = cvtpk(y.z, y.w); o[64 * j] = w; }
#pragma unroll
        for (int j = 0; j < 8; ++j) x[j] = xn[j];
    }
}

typedef f32x4 acc_t[2][2][4][2];
__device__ __forceinline__ u32x4 pack8(const f32x4 a, const f32x4 b) { u32x4 w; w.x = cvtpk(a[0], a[1]); w.y = cvtpk(a[2], a[3]); w.z = cvtpk(b[0], b[1]); w.w = cvtpk(b[2], b[3]); return w; }

struct EpiIn {
    static constexpr bool PERM = false, AFTER_DRAIN = false;
    int pt0;
    bf16_t *rq, *r2, *r1;
    const float* qkn;
    const f32x2 *ropeA, *ropeB;
    __device__ __forceinline__ void operator()(const acc_t& acc, const pg8::Unit& u, int wr, int wc, int fr, int fq) const {
        const int pt = pt0 + u.pn, b = u.pm / PPB, tb = (u.pm % PPB) * 256 + wr * 64 + fr;
        if (pt < PT_DV) {
            const int isk = pt >= PT_DK, sh = 4 * (pt - (isk ? PT_DK : PT_DQ)) + wc, d0 = 32 * (fq >> 1) + 8 * (fq & 1);
            bf16_t* base = rq + (isk ? (size_t)MR * 1024 : (size_t)0) + ((size_t)(b * 16 + sh) * TT) * 64 + d0;
            const float* gp = qkn + isk * 64 + d0; const float osc = isk ? 1.0f : LOG2E * 0.125f;
            f32x4 g[2][2];
#pragma unroll
            for (int s = 0; s < 2; ++s)
#pragma unroll
                for (int n = 0; n < 2; ++n) g[s][n] = *(const f32x4*)(gp + 16 * s + 4 * n) * osc;
            const bool lat = (u.pm % PPB) != PPB - 1;
            f32x4 c0_[4], c1_[4], c2_[4];
#define R64_LD(buf, it) do { const int t = lat ? tb + ((it) >> 2) * 128 + ((it) & 3) * 16 : 0; const int pos = (fq < 2) ? (t >> 6) : (t & 63);                                              \
                const f32x4* rp = (const f32x4*)(ropeA + pos * 16 + 8 * (fq & 1)); _Pragma("unroll") for (int k = 0; k < 4; ++k) buf[k] = rp[k]; } while (0)
#define R64_DO(buf, it) do { constexpr int ai = (it) >> 2, m = (it) & 3; const int t = tb + ai * 128 + m * 16;                                                                                  \
                f32x4 x[2][2]; float ss = 0.f;                                                                                                                                                    \
                _Pragma("unroll") for (int s = 0; s < 2; ++s) _Pragma("unroll") for (int n = 0; n < 2; ++n) { x[s][n] = acc[ai][s][m][n];                                                         \
                    ss += (x[s][n][0] * x[s][n][0] + x[s][n][1] * x[s][n][1]) + (x[s][n][2] * x[s][n][2] + x[s][n][3] * x[s][n][3]); }                                                            \
                ss += __shfl_xor(ss, 16); ss += __shfl_xor(ss, 32);                                                                                                                               \
                const float rstd = rsqrtf(ss * (1.0f / 64.0f) + EPS);                                                                                                                             \
                _Pragma("unroll") for (int s = 0; s < 2; ++s) _Pragma("unroll") for (int n = 0; n < 2; ++n) x[s][n] = x[s][n] * rstd * g[s][n];                                                   \
                if (lat) { _Pragma("unroll") for (int n = 0; n < 2; ++n) { const f32x4 c01 = buf[2 * n], c23 = buf[2 * n + 1];               \
                    const f32x4 cs = {c01[0], c01[2], c23[0], c23[2]}, sn = {c01[1], c01[3], c23[1], c23[3]};                                                                                     \
                    const f32x4 u1 = x[0][n], u2 = x[1][n]; x[0][n] = u1 * cs - u2 * sn; x[1][n] = u1 * sn + u2 * cs; } }                                                                         \
                bf16_t* rowp = base + (size_t)t * 64;                                                                                                                                             \
                *(u32x4*)(rowp) = pack8(x[0][0], x[0][1]); *(u32x4*)(rowp + 16) = pack8(x[1][0], x[1][1]); } while (0)
            R64_LD(c0_, 0); R64_LD(c1_, 1); R64_LD(c2_, 2); R64_DO(c0_, 0); R64_LD(c0_, 3); R64_DO(c1_, 1); R64_LD(c1_, 4); R64_DO(c2_, 2); R64_LD(c2_, 5);
            R64_DO(c0_, 3); R64_LD(c0_, 6); R64_DO(c1_, 4); R64_LD(c1_, 7); R64_DO(c2_, 5); R64_DO(c0_, 6); R64_DO(c1_, 7);
#undef R64_LD
#undef R64_DO
        } else if (pt >= PT_RQ && pt < PT_RV) {
            const int isk = pt >= PT_RK, head = 2 * (pt - (isk ? PT_RK : PT_RQ)) + (wc >> 1), d0 = 64 * (wc & 1) + 8 * fq;
            bf16_t* base = r2 + (isk ? (size_t)MR * 512 : (size_t)0) + ((size_t)(b * 4 + head) * TT) * 128 + d0;
            const float osc = isk ? 0.08838834764831845f : 1.0f;
            const bool lat = (u.pm % PPB) != PPB - 1;
            f32x4 c0_[4], c1_[4], c2_[4];
#define R128_LD(buf, it) do { const int t = lat ? tb + ((it) >> 2) * 128 + ((it) & 3) * 16 : 0; const int pos = ((wc & 1) == 0) ? (t >> 6) : (t & 63);                                          \
                const f32x4* rp = (const f32x4*)(ropeB + pos * 32 + 8 * fq); _Pragma("unroll") for (int k = 0; k < 4; ++k) buf[k] = rp[k]; } while (0)
#define R128_DO(buf, it) do { constexpr int ai = (it) >> 2, m = (it) & 3; const int t = tb + ai * 128 + m * 16;                                                                                  \
                f32x4 x[2][2];                                                                                                                                                                    \
                _Pragma("unroll") for (int s = 0; s < 2; ++s) _Pragma("unroll") for (int n = 0; n < 2; ++n) x[s][n] = acc[ai][s][m][n] * osc;                                                     \
                if (lat) { _Pragma("unroll") for (int n = 0; n < 2; ++n) { const f32x4 c01 = buf[2 * n], c23 = buf[2 * n + 1];                                                                     \
                    const f32x4 cs = {c01[0], c01[2], c23[0], c23[2]}, sn = {c01[1], c01[3], c23[1], c23[3]};                                                                                     \
                    const f32x4 u1 = x[0][n], u2 = x[1][n]; x[0][n] = u1 * cs - u2 * sn; x[1][n] = u1 * sn + u2 * cs; } }                                                                         \
                bf16_t* rowp = base + (size_t)t * 128;                                                                                                                                            \
                *(u32x4*)(rowp) = pack8(x[0][0], x[0][1]); *(u32x4*)(rowp + 32) = pack8(x[1][0], x[1][1]); } while (0)
            R128_LD(c0_, 0); R128_LD(c1_, 1); R128_LD(c2_, 2); R128_DO(c0_, 0); R128_LD(c0_, 3); R128_DO(c1_, 1); R128_LD(c1_, 4); R128_DO(c2_, 2); R128_LD(c2_, 5);
            R128_DO(c0_, 3); R128_LD(c0_, 6); R128_DO(c1_, 4); R128_LD(c1_, 7); R128_DO(c2_, 5); R128_DO(c0_, 6); R128_DO(c1_, 7);
#undef R128_LD
#undef R128_DO
        } else {
            int pts, hd; bf16_t* sb;
            if (pt < PT_RQ) { sb = rq + (size_t)MR * 2048; pts = PT_DV; hd = 128; } else if (pt < PT_GQ) { sb = r2 + (size_t)MR * 1024; pts = PT_RV; hd = 256; }
            else { const int s4 = (pt - PT_GQ) >> 2; sb = r1 + (size_t)s4 * MR * 1024; pts = PT_GQ + 4 * s4; hd = 128; }
            const int c = 256 * (pt - pts) + 64 * wc + 8 * fq, head = c / hd, dim = c % hd, H = 1024 / hd;
            bf16_t* base = sb + ((size_t)(b * H + head) * TT) * hd + dim;
            const bool isq = (pt >= PT_GQ && pt < PT_GF);
#pragma unroll
            for (int ai = 0; ai < 2; ++ai)
#pragma unroll
                for (int m = 0; m < 4; ++m) {
                    const int t = tb + ai * 128 + m * 16; bf16_t* rowp = base + (size_t)t * hd;
#pragma unroll
                    for (int bj = 0; bj < 2; ++bj) { f32x4 a = acc[ai][bj][m][0], c2 = acc[ai][bj][m][1];
                        if (isq) {
#pragma unroll
                            for (int e = 0; e < 4; ++e) { a[e] = siluf_(a[e]) * 0.08838834764831845f; c2[e] = siluf_(c2[e]) * 0.08838834764831845f; } }
                        *(u32x4*)(rowp + 32 * bj) = pack8(a, c2); }
                }
        }
    }
};

struct EpiGates {
    static constexpr bool PERM = false, AFTER_DRAIN = false;
    bf16_t *oB, *oC, *G; const float* bias;
    __device__ __forceinline__ void operator()(const acc_t& acc, const pg8::Unit& u, int wr, int wc, int fr, int fq) const {
        const int R0 = u.pm * 256 + wr * 64 + fr;
        if (u.pn < 8) {
            bf16_t* o = (u.pn < 4 ? oB : oC) + 256 * (u.pn & 3) + 64 * wc + 8 * fq + (size_t)R0 * 1024;
            u32x4 wv[2][4][2];
#pragma unroll
            for (int ai = 0; ai < 2; ++ai)
#pragma unroll
                for (int m = 0; m < 4; ++m)
#pragma unroll
                    for (int bj = 0; bj < 2; ++bj) wv[ai][m][bj] = *(const u32x4*)(o + (size_t)(ai * 128 + m * 16) * 1024 + 32 * bj);
#pragma unroll
            for (int ai = 0; ai < 2; ++ai)
#pragma unroll
                for (int m = 0; m < 4; ++m) { bf16_t* rowp = o + (size_t)(ai * 128 + m * 16) * 1024;
#pragma unroll
                    for (int bj = 0; bj < 2; ++bj) { const u32x4 w = wv[ai][m][bj]; const f32x4 a = acc[ai][bj][m][0], c = acc[ai][bj][m][1];
                        const f32x4 r0 = {bflo(w.x) * siluf_(a[0]), bfhi(w.x) * siluf_(a[1]), bflo(w.y) * siluf_(a[2]), bfhi(w.y) * siluf_(a[3])};
                        const f32x4 r1 = {bflo(w.z) * siluf_(c[0]), bfhi(w.z) * siluf_(c[1]), bflo(w.w) * siluf_(c[2]), bfhi(w.w) * siluf_(c[3])};
                        *(u32x4*)(rowp + 32 * bj) = pack8(r0, r1); } }
        } else {
            const int t = u.pn - 8, n = t >> 3, c0 = 256 * (t & 7) + 64 * wc + 8 * fq;
            const float* bp = bias + n * D + c0; bf16_t* Gn = G + (size_t)n * MR * D + c0;
            f32x4 bv[2][2];
#pragma unroll
            for (int bj = 0; bj < 2; ++bj)
#pragma unroll
                for (int k = 0; k < 2; ++k) bv[bj][k] = *(const f32x4*)(bp + 32 * bj + 4 * k);
#pragma unroll
            for (int ai = 0; ai < 2; ++ai)
#pragma unroll
                for (int m = 0; m < 4; ++m) { bf16_t* rowp = Gn + (size_t)(R0 + ai * 128 + m * 16) * D;
#pragma unroll
                    for (int bj = 0; bj < 2; ++bj) { f32x4 a = acc[ai][bj][m][0] + bv[bj][0], c = acc[ai][bj][m][1] + bv[bj][1];
#pragma unroll
                        for (int e = 0; e < 4; ++e) { a[e] = fmaxf(sigmoidf_(a[e]), 7.888609052210118e-31f); c[e] = fmaxf(sigmoidf_(c[e]), 7.888609052210118e-31f); }
                        u32x4 w; w.x = cvtpk_c(a[0], a[1]); w.y = cvtpk_c(a[2], a[3]); w.z = cvtpk_c(c[0], c[1]); w.w = cvtpk_c(c[2], c[3]);
                        *(u32x4*)(rowp + 32 * bj) = w; } }
        }
    }
};
struct EpiProjAll {
    static constexpr bool PERM = false, AFTER_DRAIN = false, KEEPS_ACC = true;
    const bf16_t* G; bf16_t* y;
    __device__ __forceinline__ void operator()(acc_t& acc, const pg8::Unit& u, int wr, int wc, int fr, int fq) const {
        const int n = u.pm / NPAN, pm = u.pm - n * NPAN, pn = u.pn & 7;
        const int c0 = 256 * pn + 64 * wc + 8 * fq, R0 = pm * 256 + wr * 64 + fr;
        const bf16_t* Gn = G + (size_t)n * MR * D + (size_t)R0 * D + c0; const bf16_t* Gx = Gn + (size_t)MR * D;
        bf16_t* yp = y + (size_t)R0 * D + c0;
        u32x4 wa[4], xa[4], wb[4], xb[4];
#define PJ_LD(GW_, GX_, ai, bj) do { _Pragma("unroll") for (int m = 0; m < 4; ++m) { const size_t ro = (size_t)((ai) * 128 + m * 16) * D + 32 * (bj); GW_[m] = *(const u32x4*)(Gn + ro); GX_[m] = *(const u32x4*)(Gx + ro); } } while (0)
#define PJ_LD1(GW_, ai, bj) do { _Pragma("unroll") for (int m = 0; m < 4; ++m) { const size_t ro = (size_t)((ai) * 128 + m * 16) * D + 32 * (bj); GW_[m] = *(const u32x4*)(Gn + ro); } } while (0)
#define PJ_RATIO(GW_, GX_, ai, bj) do { _Pragma("unroll") for (int m = 0; m < 4; ++m) {                                                     \
            const float g[8] = {bflo(GW_[m].x), bfhi(GW_[m].x), bflo(GW_[m].y), bfhi(GW_[m].y), bflo(GW_[m].z), bfhi(GW_[m].z), bflo(GW_[m].w), bfhi(GW_[m].w)};            \
            const float d[8] = {bflo(GX_[m].x), bfhi(GX_[m].x), bflo(GX_[m].y), bfhi(GX_[m].y), bflo(GX_[m].z), bfhi(GX_[m].z), bflo(GX_[m].w), bfhi(GX_[m].w)};            \
            f32x4 r0 = acc[ai][bj][m][0], r1 = acc[ai][bj][m][1];                                                                                                         \
            _Pragma("unroll") for (int e = 0; e < 4; ++e) { r0[e] *= g[e] * __builtin_amdgcn_rcpf(d[e]); r1[e] *= g[4 + e] * __builtin_amdgcn_rcpf(d[4 + e]); }           \
            acc[ai][bj][m][0] = r0; acc[ai][bj][m][1] = r1; } } while (0)
#define PJ_FINAL(GW_, ai, bj) do { _Pragma("unroll") for (int m = 0; m < 4; ++m) {                                                           \
            const float g[8] = {bflo(GW_[m].x), bfhi(GW_[m].x), bflo(GW_[m].y), bfhi(GW_[m].y), bflo(GW_[m].z), bfhi(GW_[m].z), bflo(GW_[m].w), bfhi(GW_[m].w)};            \
            f32x4 r0 = acc[ai][bj][m][0], r1 = acc[ai][bj][m][1];                                                                                                         \
            _Pragma("unroll") for (int e = 0; e < 4; ++e) { r0[e] *= g[e]; r1[e] *= g[4 + e]; }                                                                           \
            *(u32x4*)(yp + (size_t)((ai) * 128 + m * 16) * D + 32 * (bj)) = pack8(r0, r1); } } while (0)
        if (n < 2) { PJ_LD(wa, xa, 0, 0); PJ_LD(wb, xb, 0, 1); PJ_RATIO(wa, xa, 0, 0); PJ_LD(wa, xa, 1, 0); PJ_RATIO(wb, xb, 0, 1); PJ_LD(wb, xb, 1, 1); PJ_RATIO(wa, xa, 1, 0); PJ_RATIO(wb, xb, 1, 1); }
        else { PJ_LD1(wa, 0, 0); PJ_LD1(wb, 0, 1); PJ_LD1(xa, 1, 0); PJ_LD1(xb, 1, 1); PJ_FINAL(wa, 0, 0); PJ_FINAL(wb, 0, 1); PJ_FINAL(xa, 1, 0); PJ_FINAL(xb, 1, 1); }
#undef PJ_LD
#undef PJ_LD1
#undef PJ_RATIO
#undef PJ_FINAL
    }
};
struct EpiRes {
    static constexpr bool PERM = false, AFTER_DRAIN = false;
    const float *srcx, *srcc; float *dstx, *dstc; const float* gate0;
    __device__ __forceinline__ void operator()(const acc_t& acc, const pg8::Unit& u, int wr, int wc, int fr, int fq) const {
        const int b = u.pm / PPB, lp = u.pm % PPB, c0 = 256 * u.pn + 64 * wc + 8 * fq, r0 = wr * 64 + fr;
        const bool isc = (lp == PPB - 1);
        const size_t rb = isc ? (size_t)(b * LC) : (size_t)(b * T + lp * 256);
        const float* s = (isc ? srcc : srcx) + (rb + r0) * D + c0; float* d = (isc ? dstc : dstx) + (rb + r0) * D + c0;
        const float* gp = gate0 + (size_t)(isc ? 2 : b) * 6 * D + c0;
        f32x4 gv[2][2];
#pragma unroll
        for (int bj = 0; bj < 2; ++bj)
#pragma unroll
            for (int n = 0; n < 2; ++n) gv[bj][n] = *(const f32x4*)(gp + 32 * bj + 4 * n);
        f32x4 sa[4][2], sb[4][2];
#define RES_LD(buf, ai, bj) do { _Pragma("unroll") for (int m = 0; m < 4; ++m) _Pragma("unroll") for (int n = 0; n < 2; ++n) buf[m][n] = *(const f32x4*)(s + (size_t)((ai) * 128 + m * 16) * D + 32 * (bj) + 4 * n); } while (0)
#define RES_ST(buf, ai, bj) do { _Pragma("unroll") for (int m = 0; m < 4; ++m) _Pragma("unroll") for (int n = 0; n < 2; ++n) *(f32x4*)(d + (size_t)((ai) * 128 + m * 16) * D + 32 * (bj) + 4 * n) = buf[m][n] + gv[bj][n] * acc[ai][bj][m][n]; } while (0)
        RES_LD(sa, 0, 0); RES_LD(sb, 0, 1); RES_ST(sa, 0, 0); RES_LD(sa, 1, 0); RES_ST(sb, 0, 1); RES_LD(sb, 1, 1); RES_ST(sa, 1, 0); RES_ST(sb, 1, 1);
#undef RES_LD
#undef RES_ST
    }
};
__device__ __forceinline__ float dpp_up1(float cur, float prev) {
    const int old = __builtin_amdgcn_mov_dpp(__float_as_int(prev), 0x121  , 0xf, 0xf, false);
    return __int_as_float(__builtin_amdgcn_update_dpp(old, __float_as_int(cur), 0x111  , 0xf, 0xf, false));
}
__device__ __forceinline__ float dpp_dn1(float cur, float next) {
    const int old = __builtin_amdgcn_mov_dpp(__float_as_int(next), 0x12F  , 0xf, 0xf, false);
    return __int_as_float(__builtin_amdgcn_update_dpp(old, __float_as_int(cur), 0x101  , 0xf, 0xf, false));
}
struct EpiConv {
    static constexpr bool PERM = false, AFTER_DRAIN = false;
    bf16_t* g; float* raw; const float* cw; const float* cb;
    __device__ __forceinline__ void operator()(const acc_t& acc, const pg8::Unit& u, int wr, int wc, int fr, int fq) const {
        const int jc = 128 * u.pn + 32 * wc + 8 * fq, R0 = u.pm * 256 + wr * 64 + fr;
        u32x2 keep[2][4];
        f32x4 cwv[2][8];
#pragma unroll
        for (int n = 0; n < 2; ++n) { const int j = jc + 4 * n;
            cwv[n][0] = *(const f32x4*)(cw + j); cwv[n][1] = *(const f32x4*)(cw + NUP + j); cwv[n][2] = *(const f32x4*)(cw + 2 * NUP + j); cwv[n][3] = *(const f32x4*)(cb + j);
            cwv[n][4] = *(const f32x4*)(cw + DFF + j); cwv[n][5] = *(const f32x4*)(cw + NUP + DFF + j); cwv[n][6] = *(const f32x4*)(cw + 2 * NUP + DFF + j); cwv[n][7] = *(const f32x4*)(cb + DFF + j); }
        const float m0 = (fr == 0) ? 1.0f : 0.0f, m15 = (fr == 15) ? 1.0f : 0.0f;
#define FMAC_DPP(y, x, w, CTRL) asm("v_fmac_f32_dpp %0, %1, %2 " CTRL " row_mask:0xf bank_mask:0xf bound_ctrl:1" : "+v"(y) : "v"(x), "v"(w))
#pragma unroll
        for (int n = 0; n < 2; ++n) {
            const int j = jc + 4 * n;
            const f32x4 wg0 = cwv[n][0], wg1 = cwv[n][1], wg2 = cwv[n][2], bg = cwv[n][3];
            const f32x4 wu0 = cwv[n][4], wu1 = cwv[n][5], wu2 = cwv[n][6], bu = cwv[n][7];
            const f32x4 wg0e = wg0 * m0, wg2e = wg2 * m15, wu0e = wu0 * m0, wu2e = wu2 * m15;
#pragma unroll
            for (int ai = 0; ai < 2; ++ai)
#pragma unroll
                for (int m = 0; m < 4; ++m) {
                    const f32x4 xg = acc[ai][0][m][n], xu = acc[ai][1][m][n];
                    const f32x4 pg = acc[ai][0][m > 0 ? m - 1 : 0][n], ng = acc[ai][0][m < 3 ? m + 1 : 3][n], pu = acc[ai][1][m > 0 ? m - 1 : 0][n], nu = acc[ai][1][m < 3 ? m + 1 : 3][n];
                    f32x4 yg, yu;
#pragma unroll
                    for (int e = 0; e < 4; ++e) {
                        float g_ = wg1[e] * xg[e] + bg[e], u_ = wu1[e] * xu[e] + bu[e];
                        { const float a0 = xg[e], a1 = pg[e], a2 = ng[e], c0 = wg0[e], c1 = wg0e[e], c2 = wg2[e], c3 = wg2e[e];
                          FMAC_DPP(g_, a0, c0, "row_shr:1"); FMAC_DPP(g_, a1, c1, "row_mirror"); FMAC_DPP(g_, a0, c2, "row_shl:1"); FMAC_DPP(g_, a2, c3, "row_mirror"); }
                        { const float a0 = xu[e], a1 = pu[e], a2 = nu[e], c0 = wu0[e], c1 = wu0e[e], c2 = wu2[e], c3 = wu2e[e];
                          FMAC_DPP(u_, a0, c0, "row_shr:1"); FMAC_DPP(u_, a1, c1, "row_mirror"); FMAC_DPP(u_, a0, c2, "row_shl:1"); FMAC_DPP(u_, a2, c3, "row_mirror"); }
                        yg[e] = g_; yu[e] = u_;
                    }
                    f32x4 r;
#pragma unroll
                    for (int e = 0; e < 4; ++e) r[e] = siluf_(yg[e]) * yu[e];
                    u32x2 pk; pk.x = cvtpk(r[0], r[1]); pk.y = cvtpk(r[2], r[3]);
                    if (n == 0) keep[ai][m] = pk;
                    else { u32x4 w; w.x = keep[ai][m].x; w.y = keep[ai][m].y; w.z = pk.x; w.w = pk.y; *(u32x4*)(g + (size_t)(R0 + ai * 128 + m * 16) * DFF + jc) = w; }
                    if ((m == 0 && fr < 2) || (m == 3 && fr >= 14)) {
                        const int slot = (m == 0) ? fr : fr - 12; float* rp = raw + ((size_t)(u.pm * 4 + ai * 2 + wr) * 4 + slot) * NUP + j;
                        *(f32x4*)(rp) = xg; *(f32x4*)(rp + DFF) = xu;
                    }
                }
        }
#undef FMAC_DPP
    }
};

namespace att {
constexpr int KVBLK = 64;
constexpr int SHM_V = 64 * 128 * 2, SHM_K = 64 * 64 * 2;
#define KSWZ64(row, colB) ((row) * 128 + ((colB) ^ ((((row) >> 1) & 7) << 4)))
#define SBAR() __builtin_amdgcn_sched_barrier(0)
__device__ __forceinline__ int crow(int r, int hi) { return (r & 3) + 8 * (r >> 2) + 4 * hi; }
template <int SK = 0> __device__ __forceinline__ void exp16(f32x16& p) {
    if (SK & 1) return;
#pragma unroll
    for (int r = 0; r < 16; ++r) p[r] = __builtin_amdgcn_exp2f(p[r]);
}
template <int BASE> __device__ __forceinline__ void exp8(f32x16& p) {
    float e[8];
#pragma unroll
    for (int r = 0; r < 8; ++r) e[r] = __builtin_amdgcn_exp2f(p[BASE + r]);
    asm volatile("" : "+v"(e[0]), "+v"(e[1]), "+v"(e[2]), "+v"(e[3]), "+v"(e[4]), "+v"(e[5]), "+v"(e[6]), "+v"(e[7]));
#pragma unroll
    for (int r = 0; r < 8; ++r) p[BASE + r] = e[r];
}
template <int SK = 0> __device__ __forceinline__ void finishSM(f32x16& p0, f32x16& p1, float& lsum, bf16x8& pa0, bf16x8& pa1, bf16x8& pa2, bf16x8& pa3) {
    if (SK & 8) { lsum += p0[0] + p1[0]; const unsigned c_ = cvtpk(p0[1], p1[1]); u32x4 w_ = {c_, c_, c_, c_}; pa0 = pa1 = pa2 = pa3 = *reinterpret_cast<bf16x8*>(&w_); return; }
    float ps = 0;
#pragma unroll
    for (int r = 0; r < 16; ++r) ps += p0[r];
#pragma unroll
    for (int r = 0; r < 16; ++r) ps += p1[r];
    lsum += ps;
#define PK4(P, BASE, OUT) do { unsigned a0 = cvtpk(P[BASE + 0], P[BASE + 1]), a1 = cvtpk(P[BASE + 2], P[BASE + 3]);   \
    unsigned b0 = cvtpk(P[BASE + 4], P[BASE + 5]), b1 = cvtpk(P[BASE + 6], P[BASE + 7]);                              \
    auto r0 = __builtin_amdgcn_permlane32_swap(a0, b0, false, false); auto r1 = __builtin_amdgcn_permlane32_swap(a1, b1, false, false); \
    u32x4 w = {r0[0], r1[0], r0[1], r1[1]}; OUT = *reinterpret_cast<bf16x8*>(&w); } while (0)
    PK4(p0, 0, pa0); PK4(p0, 8, pa1); PK4(p1, 0, pa2); PK4(p1, 8, pa3);
#undef PK4
}
template <int SK = 0> __device__ __forceinline__ void qkt(f32x16& p0, f32x16& p1, const LAS char* Ks, const bf16x8* qr, int r32, int hi, float negM) {
#pragma unroll
    for (int r = 0; r < 16; ++r) { p0[r] = 0.f; p1[r] = 0.f; }
    if (SK & 4) return;
#pragma unroll
    for (int d0 = 0; d0 < 4; ++d0) { const int cb = (d0 * 16 + hi * 8) * 2;
        const bf16x8 b0 = *(const LAS bf16x8*)(Ks + KSWZ64(r32, cb));
        const bf16x8 b1 = *(const LAS bf16x8*)(Ks + KSWZ64(32 + r32, cb));
        p0 = __builtin_amdgcn_mfma_f32_32x32x16_bf16(b0, qr[d0], p0, 0, 0, 0);
        p1 = __builtin_amdgcn_mfma_f32_32x32x16_bf16(b1, qr[d0], p1, 0, 0, 0); }
}
__device__ __forceinline__ int v_st(int k, int c) { const int kk = (k & ~0xC) | ((k & 4) << 1) | ((k & 8) >> 1); return ((kk >> 3) * 4 + (c >> 5)) * 512 + ((kk & 7) * 32 + (c & 31)) * 2; }
__device__ __forceinline__ int v_rd_base(int lane) { return ((lane & 3) << 3) | (((lane >> 2) & 3) << 6) | (((lane >> 4) & 1) << 5) | (((lane >> 5) & 1) << 8); }
constexpr int v_rd_off(int d0, int ks, int half) { return d0 * 512 + ks * 4096 + half * 2048; }
template <int OFF> __device__ __forceinline__ s16x4 tr_read(int vb) {
  s16x4 r; asm volatile("ds_read_b64_tr_b16 %0, %1 offset:%2" : "=&v"(r) : "v"(vb), "i"(OFF) : "memory"); return r;
}
template <int D0> __device__ __forceinline__ void pv_one(f32x16& od, int vb, bf16x8 pa0, bf16x8 pa1, bf16x8 pa2, bf16x8 pa3) {
  const s16x4 l0 = tr_read<v_rd_off(D0, 0, 0)>(vb), h0 = tr_read<v_rd_off(D0, 0, 1)>(vb), l1 = tr_read<v_rd_off(D0, 1, 0)>(vb), h1 = tr_read<v_rd_off(D0, 1, 1)>(vb);
  const s16x4 l2 = tr_read<v_rd_off(D0, 2, 0)>(vb), h2 = tr_read<v_rd_off(D0, 2, 1)>(vb), l3 = tr_read<v_rd_off(D0, 3, 0)>(vb), h3 = tr_read<v_rd_off(D0, 3, 1)>(vb);
  asm volatile("s_waitcnt lgkmcnt(0)" ::: "memory"); SBAR();
#define PK(L, H) (bf16x8){L[0], L[1], L[2], L[3], H[0], H[1], H[2], H[3]}
  od = __builtin_amdgcn_mfma_f32_32x32x16_bf16(pa0, PK(l0, h0), od, 0, 0, 0);
  od = __builtin_amdgcn_mfma_f32_32x32x16_bf16(pa1, PK(l1, h1), od, 0, 0, 0);
  od = __builtin_amdgcn_mfma_f32_32x32x16_bf16(pa2, PK(l2, h2), od, 0, 0, 0);
  od = __builtin_amdgcn_mfma_f32_32x32x16_bf16(pa3, PK(l3, h3), od, 0, 0, 0);
#undef PK
}
template <int SK = 0> __device__ __forceinline__ void pv_d0(f32x16* o, int vb, bf16x8 pa0, bf16x8 pa1, bf16x8 pa2, bf16x8 pa3) {
  if (SK & 2) { o[0][0] += __builtin_bit_cast(float, (int)pa0[0] << 16); return; }
  pv_one<0>(o[0], vb, pa0, pa1, pa2, pa3); pv_one<1>(o[1], vb, pa0, pa1, pa2, pa3); pv_one<2>(o[2], vb, pa0, pa1, pa2, pa3); pv_one<3>(o[3], vb, pa0, pa1, pa2, pa3);
}
#define ATT_WAITL(n) asm volatile("s_waitcnt lgkmcnt(" #n ")" ::: "memory")
template <int D0> __device__ __forceinline__ void readv(s16x4 (&v)[8], int vb) {
  v[0] = tr_read<v_rd_off(D0, 0, 0)>(vb); v[1] = tr_read<v_rd_off(D0, 0, 1)>(vb); v[2] = tr_read<v_rd_off(D0, 1, 0)>(vb); v[3] = tr_read<v_rd_off(D0, 1, 1)>(vb);
  v[4] = tr_read<v_rd_off(D0, 2, 0)>(vb); v[5] = tr_read<v_rd_off(D0, 2, 1)>(vb); v[6] = tr_read<v_rd_off(D0, 3, 0)>(vb); v[7] = tr_read<v_rd_off(D0, 3, 1)>(vb);
}
__device__ __forceinline__ void pvm(f32x16& od, const s16x4 (&v)[8], bf16x8 pa0, bf16x8 pa1, bf16x8 pa2, bf16x8 pa3) {
#define PK(L, H) (bf16x8){L[0], L[1], L[2], L[3], H[0], H[1], H[2], H[3]}
  od = __builtin_amdgcn_mfma_f32_32x32x16_bf16(pa0, PK(v[0], v[1]), od, 0, 0, 0);
  od = __builtin_amdgcn_mfma_f32_32x32x16_bf16(pa1, PK(v[2], v[3]), od, 0, 0, 0);
  od = __builtin_amdgcn_mfma_f32_32x32x16_bf16(pa2, PK(v[4], v[5]), od, 0, 0, 0);
  od = __builtin_amdgcn_mfma_f32_32x32x16_bf16(pa3, PK(v[6], v[7]), od, 0, 0, 0);
#undef PK
}
template <int SK, bool HASNEXT> __device__ __forceinline__ void tile_step(f32x16& pN0, f32x16& pN1, f32x16 (&o)[4], const bf16x8 (&qr)[4], float& lsum,
                                                                         const LAS char* ksn, int vbc, float negM, int r32, int hi) {
  bf16x8 kf0[4], kf1[4], pa0, pa1, pa2, pa3; s16x4 va[8], vc[8], vd[8];
  if (HASNEXT && !(SK & 4)) {
#pragma unroll
    for (int d0 = 0; d0 < 4; ++d0) { const int cb = (d0 * 16 + hi * 8) * 2; kf0[d0] = *(const LAS bf16x8*)(ksn + KSWZ64(r32, cb)); kf1[d0] = *(const LAS bf16x8*)(ksn + KSWZ64(32 + r32, cb)); }
  }
  SBAR();
  finishSM<SK>(pN0, pN1, lsum, pa0, pa1, pa2, pa3);
  SBAR();
  if (SK & 2) { o[0][0] += __builtin_bit_cast(float, (int)pa0[0] << 16); }
  else { readv<0>(va, vbc); readv<1>(vc, vbc); }
  SBAR();
  if (HASNEXT) {
#pragma unroll
    for (int r = 0; r < 16; ++r) { pN0[r] = 0.f; pN1[r] = 0.f; }
    if (!(SK & 4)) {
      if (SK & 2) ATT_WAITL(0); else ATT_WAITL(15);
      SBAR();
#pragma unroll
      for (int d0 = 0; d0 < 4; ++d0) { pN0 = __builtin_amdgcn_mfma_f32_32x32x16_bf16(kf0[d0], qr[d0], pN0, 0, 0, 0); pN1 = __builtin_amdgcn_mfma_f32_32x32x16_bf16(kf1[d0], qr[d0], pN1, 0, 0, 0); }
    }
  }
  SBAR();
  if (!(SK & 2)) {
    readv<2>(vd, vbc); SBAR(); ATT_WAITL(15); SBAR(); pvm(o[0], va, pa0, pa1, pa2, pa3); if (HASNEXT && !(SK & 1)) exp8<0>(pN0); SBAR();
    readv<3>(va, vbc); SBAR(); ATT_WAITL(15); SBAR(); pvm(o[1], vc, pa0, pa1, pa2, pa3); if (HASNEXT && !(SK & 1)) exp8<8>(pN0); SBAR();
    ATT_WAITL(8); SBAR(); pvm(o[2], vd, pa0, pa1, pa2, pa3); if (HASNEXT && !(SK & 1)) exp8<0>(pN1); SBAR();
    ATT_WAITL(0); SBAR(); pvm(o[3], va, pa0, pa1, pa2, pa3); if (HASNEXT && !(SK & 1)) exp8<8>(pN1); SBAR();
  } else if (HASNEXT && !(SK & 1)) { exp8<0>(pN0); exp8<8>(pN0); exp8<0>(pN1); exp8<8>(pN1); }
}
constexpr int SLOT = SHM_K + SHM_V, NSLOT = 4;
#define ATT_WAITV(n) asm volatile("s_waitcnt vmcnt(" #n ")" ::: "memory")
template <int SK = 0> __device__ __forceinline__ void attn_unit(const bf16_t* __restrict__ Qb, const bf16_t* __restrict__ Kh, const bf16_t* __restrict__ Vh, bf16_t* Ob, bf16_t* oAb, int second, float lam, float post,
                                                                const float* __restrict__ subln, int nkeys, float negM, LAS char* lds) {
  int tid_ = threadIdx.x; asm volatile("" : "+v"(tid_));
  const int tid = tid_, wid = __builtin_amdgcn_readfirstlane(tid >> 6), lane = tid & 63, r32 = lane & 31, hi = lane >> 5;
  LAS float* li_l = (LAS float*)(lds + NSLOT * SLOT) + wid * 64;
  float lsum = 0; f32x16 o[4];
#pragma unroll
  for (int d = 0; d < 4; ++d)
#pragma unroll
    for (int r = 0; r < 16; ++r) o[d][r] = 0.f;
  bf16x8 qr[4];
  const bf16_t* Qw = Qb + (long)(wid * 32 + r32) * 64 + hi * 8;
#pragma unroll
  for (int d0 = 0; d0 < 4; ++d0) qr[d0] = *reinterpret_cast<const bf16x8*>(Qw + d0 * 16);
  unsigned offK, offV[2];
  { const int row = 8 * wid + (lane >> 3), ch = (lane & 7) ^ ((row >> 1) & 7); offK = (unsigned)(row * 64 + ch * 8); }
#pragma unroll
  for (int i = 0; i < 2; ++i) { const int piece = wid + 8 * i, sub = piece * 2 + (lane >> 5), kk = (sub >> 2) * 8 + ((lane & 31) >> 2), k = (kk & ~0xC) | ((kk & 4) << 1) | ((kk & 8) >> 1), c = (sub & 3) * 32 + 8 * (lane & 3);
      offV[i] = (unsigned)(k * 128 + c); }
  const int vbase = (int)(uintptr_t)lds + SHM_K + v_rd_base(lane);
#define ISSUE(t) do { const int s_ = (t) & (NSLOT - 1); const long k0_ = (long)(t) * KVBLK; \
    __builtin_amdgcn_global_load_lds((const unsigned*)(Kh + k0_ * 64 + offK), (LAS unsigned*)(lds + s_ * SLOT + wid * 1024), 16, 0, 0); \
    __builtin_amdgcn_global_load_lds((const unsigned*)(Vh + k0_ * 128 + offV[0]), (LAS unsigned*)(lds + s_ * SLOT + SHM_K + wid * 1024), 16, 0, 0); \
    __builtin_amdgcn_global_load_lds((const unsigned*)(Vh + k0_ * 128 + offV[1]), (LAS unsigned*)(lds + s_ * SLOT + SHM_K + 8192 + wid * 1024), 16, 0, 0); } while (0)
#define KS(t) (lds + ((t) & (NSLOT - 1)) * SLOT)
#define VB(t) (vbase + ((t) & (NSLOT - 1)) * SLOT)
  f32x16 pA0, pA1; const int NT = nkeys / KVBLK;
  if (wid >= 4) __builtin_amdgcn_s_setprio(1);
  ATT_WAITV(0);
  ISSUE(0); ISSUE(1); ISSUE(2);
  ATT_WAITV(6); __builtin_amdgcn_s_barrier(); asm volatile("" ::: "memory");
  qkt<SK>(pA0, pA1, KS(0), qr, r32, hi, negM); exp16<SK>(pA0); exp16<SK>(pA1);
  for (int j = 0; j + 2 < NT; ++j) {
    if (j + 2 < NT) ATT_WAITV(3); else ATT_WAITV(0);
    __builtin_amdgcn_s_barrier(); asm volatile("" ::: "memory");
    if (!(SK & 16) && j + 3 < NT) ISSUE(j + 3);
    tile_step<SK, true>(pA0, pA1, o, qr, lsum, KS(j + 1), VB(j), negM, r32, hi);
  }
  ATT_WAITV(0); __builtin_amdgcn_s_barrier(); asm volatile("" ::: "memory");
  tile_step<SK, true>(pA0, pA1, o, qr, lsum, KS(NT - 1), VB(NT - 2), negM, r32, hi);
  tile_step<SK, false>(pA0, pA1, o, qr, lsum, KS(NT - 1), VB(NT - 1), negM, r32, hi);
  { auto rr = __builtin_amdgcn_permlane32_swap(__float_as_uint(lsum), __float_as_uint(lsum), false, false); lsum = __uint_as_float(rr[0]) + __uint_as_float(rr[1]); }
  if (hi == 0) li_l[r32] = lsum; asm volatile("s_waitcnt lgkmcnt(0)" ::: "memory");
  float rli[16];
#pragma unroll
  for (int r = 0; r < 16; ++r) rli[r] = __builtin_amdgcn_rcpf(li_l[crow(r, hi)]);
  bf16_t* Ow = Ob + (long)(wid * 32) * 1024;
  if (!second) {
#pragma unroll
    for (int r = 0; r < 16; ++r) { const int orow = crow(r, hi);
#pragma unroll
      for (int d0 = 0; d0 < 4; ++d0) Ow[(long)orow * 1024 + d0 * 32 + r32] = (bf16_t)(cvtpk(o[d0][r] * rli[r], 0.f) & 0xffffu); }
  } else {
    float sl[4];
#pragma unroll
    for (int d0 = 0; d0 < 4; ++d0) sl[d0] = subln[d0 * 32 + r32];
    bf16_t* Aw = oAb + (long)(wid * 32) * 1024;
#pragma unroll
    for (int rg = 0; rg < 4; ++rg) {
      unsigned short o1[4][4];
#pragma unroll
      for (int j = 0; j < 4; ++j)
#pragma unroll
        for (int d0 = 0; d0 < 4; ++d0) o1[j][d0] = *(const unsigned short*)(Ow + (long)crow(4 * rg + j, hi) * 1024 + d0 * 32 + r32);
#pragma unroll
      for (int j = 0; j < 4; ++j) { const int r = 4 * rg + j; float dd[4], ss = 0.f;
#pragma unroll
        for (int d0 = 0; d0 < 4; ++d0) { dd[d0] = __uint_as_float((unsigned)o1[j][d0] << 16) - lam * (o[d0][r] * rli[r]); ss += dd[d0] * dd[d0]; }
        ss += __shfl_xor(ss, 1); ss += __shfl_xor(ss, 2); ss += __shfl_xor(ss, 4); ss += __shfl_xor(ss, 8); ss += __shfl_xor(ss, 16);
        const float rs = rsqrtf(ss * (1.0f / 128.0f) + EPS) * post; bf16_t* rowp = Aw + (long)crow(r, hi) * 1024;
#pragma unroll
        for (int d0 = 0; d0 < 4; ++d0) { const float y = dd[d0] * rs; rowp[d0 * 32 + r32] = (bf16_t)(cvtpk(y * sl[d0], 0.f) & 0xffffu); } }
    }
  }
  __builtin_amdgcn_s_setprio(0);
  __builtin_amdgcn_s_barrier(); asm volatile("" ::: "memory");
#undef ISSUE
#undef KS
#undef VB
#undef ITER
}
}

template <int SK = 0> __device__ __forceinline__ void attn_phase(Frame& F, int l) {
    const bf16_t* Q = WSP(bf16_t, DY_QKV); const bf16_t* K = Q + (size_t)MR * 1024; const bf16_t* V = K + (size_t)MR * 1024;
    bf16_t* O = WSP(bf16_t, DY_O1); bf16_t* oA = WSP(bf16_t, DY_OA); const float negM = 0.f;
    const float lam = WSP(float, WS_SCAL)[l]; const float post = 1.0f - (0.8f - 0.6f * expf(-0.3f * (float)l)); const float* subln = inp(F, I_SUBLN) + l * 128;
    const int NL = NB * 8 * 64, NU = NL + (l == 0 ? NB * 8 : 0);
    for (int i = 0; i * F.G < NU; ++i) {
        int u = i * F.G + F.bid;
        if (F.G == 256 && i < 4) { const int hh = i * 8 + (F.bid & 7); u = (hh >> 1) * 64 + (hh & 1) * 32 + (F.bid >> 3); }
        if (u >= NU) break;
        int p, q0, k0, nk;
        if (u < NL) { p = u / 64; q0 = (u % 64) * 256; k0 = 0; nk = TT; }
        else { p = u - NL; q0 = T; k0 = T; nk = LC; }
        const int b = p >> 3, h = p & 7;
        for (int sm = 0; sm < 2; ++sm) {
            const size_t hb = (size_t)(b * 16 + 2 * h + sm) * TT;
            att::attn_unit<SK>(Q + (hb + q0) * 64, K + (hb + k0) * 64, V + ((size_t)(b * 8 + h) * TT + k0) * 128, O + ((size_t)b * TT + q0) * 1024 + h * 128, oA + ((size_t)b * TT + q0) * 1024 + h * 128,
                               sm, lam, post, subln, nk, negM, (LAS char*)F.lds);
        }
    }
}
__device__ __forceinline__ void ffn_fixup(Frame& F, int l) {
    const float* raw = WSP(float, DY_RAW); bf16_t* g = WSP(bf16_t, DY_G);
    const float* cw = inp(F, I_CONVW) + (size_t)l * 3 * NUP; const float* cb = inp(F, I_CONVB) + (size_t)l * NUP;
    const int NBLK = MR / 64, per = DFF / 4;
    const size_t total = (size_t)NBLK * 2 * per;
    for (size_t it = (size_t)F.bid * NTHR + F.tid; it < total; it += (size_t)F.G * NTHR) {
        const int cq = (int)(it % per), rb = (int)(it / per), blk = rb >> 1, last = rb & 1, j = cq * 4;
        const int bl = blk % (TT / 64);
        const bool seq_first = (bl == 0 || bl == T / 64), seq_last = (bl == T / 64 - 1 || bl == TT / 64 - 1);
        const float* rc = raw + ((size_t)blk * 4 + (last ? 3 : 0)) * NUP;
        const float* rp = last ? raw + ((size_t)blk * 4 + 2) * NUP : raw + ((size_t)(blk - 1) * 4 + 3) * NUP;
        const float* rn = last ? raw + ((size_t)(blk + 1) * 4 + 0) * NUP : raw + ((size_t)blk * 4 + 1) * NUP;
        const bool zp = (!last && seq_first), zn = (last && seq_last);
        const f32x4 z4 = {0.f, 0.f, 0.f, 0.f};
        f32x4 v[14];
        { const float* rpp = zp ? rc : rp; const float* rnn = zn ? rc : rn;
          v[0] = *(const f32x4*)(rpp + j); v[1] = *(const f32x4*)(rpp + DFF + j); v[2] = *(const f32x4*)(rnn + j); v[3] = *(const f32x4*)(rnn + DFF + j);
          v[4] = *(const f32x4*)(rc + j); v[5] = *(const f32x4*)(rc + DFF + j);
          v[6] = *(const f32x4*)(cw + j); v[7] = *(const f32x4*)(cw + NUP + j); v[8] = *(const f32x4*)(cw + 2 * NUP + j); v[9] = *(const f32x4*)(cb + j);
          v[10] = *(const f32x4*)(cw + DFF + j); v[11] = *(const f32x4*)(cw + NUP + DFF + j); v[12] = *(const f32x4*)(cw + 2 * NUP + DFF + j); v[13] = *(const f32x4*)(cb + DFF + j); }
#pragma unroll
        for (int k = 0; k < 14; ++k) asm volatile("" : "+v"(v[k]));
        const f32x4 pg = zp ? z4 : v[0], pu = zp ? z4 : v[1], ng = zn ? z4 : v[2], nu = zn ? z4 : v[3], xg = v[4], xu = v[5];
        const f32x4 yg = v[6] * pg + v[7] * xg + v[8] * ng + v[9];
        const f32x4 yu = v[10] * pu + v[11] * xu + v[12] * nu + v[13];
        u32x2 w; w.x = cvtpk(siluf_(yg[0]) * yu[0], siluf_(yg[1]) * yu[1]); w.y = cvtpk(siluf_(yg[2]) * yu[2], siluf_(yg[3]) * yu[3]);
        *(u32x2*)(g + (size_t)(blk * 64 + (last ? 63 : 0)) * DFF + j) = w;
    }
}

namespace scn {
using att::crow; using att::v_st; using att::v_rd_base; using att::v_rd_off; using att::tr_read;
__device__ __forceinline__ int cp_of(int c, int dir) { return c == PPB - 1 ? 0 : (dir ? (PPB - 1) - c : c + 1); }
#define KSWZ256(row, colB) ((row) * 256 + ((colB) ^ (((row) & 7) << 4)))
#define PKF(L, H) (bf16x8){L[0], L[1], L[2], L[3], H[0], H[1], H[2], H[3]}
__device__ __forceinline__ u32x4 scale8(const u32x4 w, float s) { u32x4 o; o.x = cvtpk(bflo(w.x) * s, bfhi(w.x) * s); o.y = cvtpk(bflo(w.y) * s, bfhi(w.y) * s); o.z = cvtpk(bflo(w.z) * s, bfhi(w.z) * s); o.w = cvtpk(bflo(w.w) * s, bfhi(w.w) * s); return o; }
__device__ __forceinline__ float ret_lg2(int h, int dir) { const int hh = dir ? 3 - h : h; return log1pf(-exp2f(-5.0f - (float)hh)) * LOG2E; }
constexpr size_t RET_US_ELEMS = (size_t)128 * 256, HG_US_ELEMS = (size_t)128 * 128;
constexpr size_t US_RET_OFF = DY_US, US_HG_OFF = DY_US + 65 * MiB;
constexpr size_t HG_A_OFF = WS_MODP;

__device__ __forceinline__ void store_state_tile(bf16_t* us, const f32x16& a, int rb, int d0, int nd0, int c32, int hi) {
#pragma unroll
    for (int g = 0; g < 4; ++g) { const int ks = 2 * rb + (g >> 1), ln = c32 + 32 * (g & 1);
        u32x2 w; w.x = cvtpk_c(a[4 * g], a[4 * g + 1]); w.y = cvtpk_c(a[4 * g + 2], a[4 * g + 3]);
        *(u32x2*)(us + ((size_t)(ks * nd0 + d0) * 64 + ln) * 8 + 4 * hi) = w; }
}

template <int TILE, int KST> __device__ __forceinline__ void ra_step(f32x16 (&acc)[4][2], int vbK, const int (&vbV)[2]) {
    bf16x8 A[4], Bv[2];
    { const s16x4 lo = tr_read<TILE * 16384 + v_rd_off(0, KST, 0)>(vbK), h4 = tr_read<TILE * 16384 + v_rd_off(0, KST, 1)>(vbK); A[0] = PKF(lo, h4); }
    { const s16x4 lo = tr_read<TILE * 16384 + v_rd_off(1, KST, 0)>(vbK), h4 = tr_read<TILE * 16384 + v_rd_off(1, KST, 1)>(vbK); A[1] = PKF(lo, h4); }
    { const s16x4 lo = tr_read<TILE * 16384 + v_rd_off(2, KST, 0)>(vbK), h4 = tr_read<TILE * 16384 + v_rd_off(2, KST, 1)>(vbK); A[2] = PKF(lo, h4); }
    { const s16x4 lo = tr_read<TILE * 16384 + v_rd_off(3, KST, 0)>(vbK), h4 = tr_read<TILE * 16384 + v_rd_off(3, KST, 1)>(vbK); A[3] = PKF(lo, h4); }
    { const s16x4 lo = tr_read<TILE * 32768 + v_rd_off(0, KST, 0)>(vbV[0]), h4 = tr_read<TILE * 32768 + v_rd_off(0, KST, 1)>(vbV[0]); Bv[0] = PKF(lo, h4); }
    { const s16x4 lo = tr_read<TILE * 32768 + v_rd_off(0, KST, 0)>(vbV[1]), h4 = tr_read<TILE * 32768 + v_rd_off(0, KST, 1)>(vbV[1]); Bv[1] = PKF(lo, h4); }
    asm volatile("s_waitcnt lgkmcnt(0)" ::: "memory"); __builtin_amdgcn_sched_barrier(0);
#pragma unroll
    for (int rb = 0; rb < 4; ++rb)
#pragma unroll
        for (int cb = 0; cb < 2; ++cb) acc[rb][cb] = __builtin_amdgcn_mfma_f32_32x32x16_bf16(A[rb], Bv[cb], acc[rb][cb], 0, 0, 0);
}
__device__ __forceinline__ void ret_local_unit(Frame& F, int b, int h, int c) {
    const bf16_t* RK = WSP(bf16_t, DY_PB) + (size_t)MR * 512; const bf16_t* RV = RK + (size_t)MR * 512;
    const size_t hb = (size_t)(b * 4 + h) * TT + (size_t)c * 256;
    const float lgf = ret_lg2(h, 0), lgb = ret_lg2(h, 1);
    const int w = F.wave, lane = F.lane, c32 = lane & 31, hi = lane >> 5, dir = w >> 2, dvq = w & 3;
    LAS char* lds = (LAS char*)F.lds;
    f32x16 acc[4][2];
#pragma unroll
    for (int rb = 0; rb < 4; ++rb)
#pragma unroll
        for (int cb = 0; cb < 2; ++cb)
#pragma unroll
            for (int r = 0; r < 16; ++r) acc[rb][cb][r] = 0.f;
    const int vbK = (int)(uintptr_t)lds + dir * 32768 + v_rd_base(lane);
    int vbV[2];
#pragma unroll
    for (int cb = 0; cb < 2; ++cb) { const int colblk = 2 * dvq + cb; vbV[cb] = (int)(uintptr_t)lds + 65536 + (colblk >> 2) * 16384 + (colblk & 3) * 512 + v_rd_base(lane); }
    for (int hh = 0; hh < 2; ++hh) {
        __syncthreads();
        u32x4 kq[4];
#pragma unroll
        for (int i = 0; i < 4; ++i) { const int idx = i * NTHR + F.tid, row = idx >> 4, ch = idx & 15, p = 128 * hh + row; kq[i] = *(const u32x4*)(RK + (hb + p) * 128 + ch * 8); }
#pragma unroll
        for (int i = 0; i < 4; ++i) asm volatile("" : "+v"(kq[i]));
#pragma unroll
        for (int i = 0; i < 4; ++i) { const int idx = i * NTHR + F.tid, row = idx >> 4, ch = idx & 15, p = 128 * hh + row;
            const u32x4 kv = kq[i];
            const float ff = __builtin_amdgcn_exp2f(lgf * (float)(255 - p)), fb = __builtin_amdgcn_exp2f(lgb * (float)p);
            const int off = (row >> 6) * 16384 + v_st(row & 63, ch * 8);
            *(LAS u32x4*)(lds + off) = scale8(kv, ff); *(LAS u32x4*)(lds + 32768 + off) = scale8(kv, fb); }
        { u32x4 vq[8];
#pragma unroll
          for (int i = 0; i < 8; ++i) { const int idx = i * NTHR + F.tid, row = idx >> 5, col = (idx & 31) * 8, p = 128 * hh + row; vq[i] = *(const u32x4*)(RV + (hb + p) * 256 + col); }
#pragma unroll
          for (int i = 0; i < 8; ++i) asm volatile("" : "+v"(vq[i]));
#pragma unroll
          for (int i = 0; i < 8; ++i) { const int idx = i * NTHR + F.tid, row = idx >> 5, col = (idx & 31) * 8;
            *(LAS u32x4*)(lds + 65536 + ((row >> 6) * 2 + (col >> 7)) * 16384 + v_st(row & 63, col & 127)) = vq[i]; } }
        __syncthreads();
        ra_step<0, 0>(acc, vbK, vbV); ra_step<0, 1>(acc, vbK, vbV); ra_step<0, 2>(acc, vbK, vbV); ra_step<0, 3>(acc, vbK, vbV);
        ra_step<1, 0>(acc, vbK, vbV); ra_step<1, 1>(acc, vbK, vbV); ra_step<1, 2>(acc, vbK, vbV); ra_step<1, 3>(acc, vbK, vbV);
    }
    bf16_t* us = (bf16_t*)(F.ws + US_RET_OFF) + ((size_t)((b * 4 + h) * 2 + dir) * PPB + cp_of(c, dir)) * RET_US_ELEMS;
#pragma unroll
    for (int rb = 0; rb < 4; ++rb)
#pragma unroll
        for (int cb = 0; cb < 2; ++cb) store_state_tile(us, acc[rb][cb], rb, 2 * dvq + cb, 8, c32, hi);
}

__device__ __forceinline__ void scan_states(Frame& F, bool do_ret, bool do_hg) {
  for (int gt = F.bid * NTHR + F.tid; gt < 131072; gt += F.G * NTHR) {
    if (gt < 65536) {
        if (!do_ret) continue;
        const int seq = gt >> 12, vec = gt & 4095, dir = seq & 1, h = (seq >> 1) & 3;
        const float g = exp2f(ret_lg2(h, dir) * 256.0f);
        u32x4* p = (u32x4*)(F.ws + US_RET_OFF) + (size_t)seq * PPB * 4096 + vec;
        float S[8];
#pragma unroll
        for (int e = 0; e < 8; ++e) S[e] = 0.f;
        for (int cp0 = 0; cp0 < PPB; cp0 += 13) {
            u32x4 ub[13];
#pragma unroll
            for (int k = 0; k < 13; ++k) ub[k] = p[(size_t)(cp0 + k) * 4096];
#pragma unroll
            for (int k = 0; k < 13; ++k) { const u32x4 u = ub[k];
                u32x4 o; o.x = cvtpk(S[0], S[1]); o.y = cvtpk(S[2], S[3]); o.z = cvtpk(S[4], S[5]); o.w = cvtpk(S[6], S[7]); p[(size_t)(cp0 + k) * 4096] = o;
                S[0] = g * S[0] + bflo(u.x); S[1] = g * S[1] + bfhi(u.x); S[2] = g * S[2] + bflo(u.y); S[3] = g * S[3] + bfhi(u.y);
                S[4] = g * S[4] + bflo(u.z); S[5] = g * S[5] + bfhi(u.z); S[6] = g * S[6] + bflo(u.w); S[7] = g * S[7] + bfhi(u.w); } }
    } else {
        if (!do_hg) continue;
        const int gv = gt - 65536, seq = gv >> 11, vec = gv & 2047;
        const int ks = vec >> 8, hi = (vec >> 5) & 1, dk0 = 16 * ks + 8 * hi;
        u32x4* p = (u32x4*)(F.ws + US_HG_OFF) + (size_t)seq * PPB * 2048 + vec;
        const f32x4* ap = (const f32x4*)((const float*)(F.ws + HG_A_OFF) + (size_t)seq * PPB * 128 + dk0);
        float S[8];
#pragma unroll
        for (int e = 0; e < 8; ++e) S[e] = 0.f;
        for (int cp0 = 0; cp0 < PPB; cp0 += 5) {
            u32x4 ub[5]; f32x4 a0b[5], a1b[5];
#pragma unroll
            for (int k = 0; k < 5; ++k) { ub[k] = p[(size_t)(cp0 + k) * 2048]; a0b[k] = ap[(cp0 + k) * 32]; a1b[k] = ap[(cp0 + k) * 32 + 1]; }
#pragma unroll
            for (int k = 0; k < 5; ++k) { const u32x4 u = ub[k]; const f32x4 a0 = a0b[k], a1 = a1b[k];
                u32x4 o; o.x = cvtpk(S[0], S[1]); o.y = cvtpk(S[2], S[3]); o.z = cvtpk(S[4], S[5]); o.w = cvtpk(S[6], S[7]); p[(size_t)(cp0 + k) * 2048] = o;
                S[0] = a0[0] * S[0] + bflo(u.x); S[1] = a0[1] * S[1] + bfhi(u.x); S[2] = a0[2] * S[2] + bflo(u.y); S[3] = a0[3] * S[3] + bfhi(u.y);
                S[4] = a1[0] * S[4] + bflo(u.z); S[5] = a1[1] * S[5] + bfhi(u.z); S[6] = a1[2] * S[6] + bflo(u.w); S[7] = a1[3] * S[7] + bfhi(u.w); } }
    }
  }
}

__device__ __forceinline__ void ret_out_unit(Frame& F, int l, int b, int h, int c) {
    const bf16_t* RQ = WSP(bf16_t, DY_PB); const bf16_t* RK = RQ + (size_t)MR * 512; const bf16_t* RV = RK + (size_t)MR * 512;
    const size_t hb = (size_t)(b * 4 + h) * TT + (size_t)c * 256;
    const float lgf = ret_lg2(h, 0), lgb = ret_lg2(h, 1);
    const int w = F.wave, lane = F.lane, r32 = lane & 31, hi = lane >> 5, irow = 32 * w + r32;
    LAS char* lds = (LAS char*)F.lds;
    bf16x8 qr[8];
#pragma unroll
    for (int d0 = 0; d0 < 8; ++d0) qr[d0] = *(const bf16x8*)(RQ + (hb + irow) * 128 + d0 * 16 + hi * 8);
    const int vb = (int)(uintptr_t)lds + 16384 + v_rd_base(lane);
    unsigned okk[2], ovv[2];
#pragma unroll
    for (int i = 0; i < 2; ++i) { const int P = w + 8 * i, row = 4 * P + (lane >> 4), ch = (lane & 15) ^ (row & 7); okk[i] = (unsigned)(row * 128 + ch * 8);
        const int sub = P * 2 + (lane >> 5), kk = (sub >> 2) * 8 + ((lane & 31) >> 2), k = (kk & ~0xC) | ((kk & 4) << 1) | ((kk & 8) >> 1), c = (sub & 3) * 32 + 8 * (lane & 3); ovv[i] = (unsigned)(k * 256 + c); }
    float ssq[16]; LAS unsigned* keep = (LAS unsigned*)(lds + 65536 + w * 8192) + lane;
#pragma unroll
    for (int r = 0; r < 16; ++r) ssq[r] = 0.f;
    f32x16 o[4];
#pragma unroll 1
    for (int half = 0; half < 2; ++half) {
#pragma unroll
        for (int d = 0; d < 4; ++d)
#pragma unroll
            for (int r = 0; r < 16; ++r) o[d][r] = 0.f;
#define RSC_ISSUE(J_, buf_) do { const size_t kb_ = (hb + 64 * (J_)) * 128, vbs_ = (hb + 64 * (J_)) * 256 + half * 128; \
            __builtin_amdgcn_global_load_lds((const unsigned*)(RK + kb_ + okk[0]), (LAS unsigned*)(lds + (buf_) * 32768 + w * 1024), 16, 0, 0); \
            __builtin_amdgcn_global_load_lds((const unsigned*)(RK + kb_ + okk[1]), (LAS unsigned*)(lds + (buf_) * 32768 + (w + 8) * 1024), 16, 0, 0); \
            __builtin_amdgcn_global_load_lds((const unsigned*)(RV + vbs_ + ovv[0]), (LAS unsigned*)(lds + (buf_) * 32768 + 16384 + w * 1024), 16, 0, 0); \
            __builtin_amdgcn_global_load_lds((const unsigned*)(RV + vbs_ + ovv[1]), (LAS unsigned*)(lds + (buf_) * 32768 + 16384 + (w + 8) * 1024), 16, 0, 0); } while (0)
        asm volatile("s_waitcnt vmcnt(0)" ::: "memory");
        RSC_ISSUE(0, 0);
#pragma unroll 1
        for (int J = 0; J < 4; ++J) {
            const int buf = J & 1;
            asm volatile("s_waitcnt lgkmcnt(0)" ::: "memory"); __builtin_amdgcn_s_barrier(); asm volatile("" ::: "memory");
            if (J < 3) { RSC_ISSUE(J + 1, buf ^ 1); asm volatile("s_waitcnt vmcnt(4)" ::: "memory"); } else asm volatile("s_waitcnt vmcnt(0)" ::: "memory");
            __builtin_amdgcn_s_barrier(); asm volatile("" ::: "memory");
            LAS char* kb = lds + buf * 32768; const int vbj = vb + buf * 32768;
            f32x16 p0, p1;
#pragma unroll
            for (int r = 0; r < 16; ++r) { p0[r] = 0.f; p1[r] = 0.f; }
#pragma unroll
            for (int d0 = 0; d0 < 8; ++d0) { const int cb = (d0 * 16 + hi * 8) * 2;
                const bf16x8 b0 = *(const LAS bf16x8*)(kb + KSWZ256(r32, cb)), b1 = *(const LAS bf16x8*)(kb + KSWZ256(32 + r32, cb));
                p0 = __builtin_amdgcn_mfma_f32_32x32x16_bf16(b0, qr[d0], p0, 0, 0, 0); p1 = __builtin_amdgcn_mfma_f32_32x32x16_bf16(b1, qr[d0], p1, 0, 0, 0); }
#pragma unroll
            for (int r = 0; r < 16; ++r) { const int d0i = irow - (64 * J + crow(r, hi)), d1i = d0i - 32;
                const float e0 = d0i >= 0 ? lgf * (float)d0i : -lgb * (float)d0i, e1 = d1i >= 0 ? lgf * (float)d1i : -lgb * (float)d1i;
                float m0 = __builtin_amdgcn_exp2f(e0), m1 = __builtin_amdgcn_exp2f(e1); if (d0i == 0) m0 = 2.0f; if (d1i == 0) m1 = 2.0f;
                p0[r] *= m0; p1[r] *= m1; }
            bf16x8 pa0, pa1, pa2, pa3;
#define PK4(P, BASE, OUT) do { unsigned a0 = cvtpk(P[BASE + 0], P[BASE + 1]), a1 = cvtpk(P[BASE + 2], P[BASE + 3]);   \
    unsigned b0_ = cvtpk(P[BASE + 4], P[BASE + 5]), b1_ = cvtpk(P[BASE + 6], P[BASE + 7]);                              \
    auto r0 = __builtin_amdgcn_permlane32_swap(a0, b0_, false, false); auto r1 = __builtin_amdgcn_permlane32_swap(a1, b1_, false, false); \
    u32x4 w_ = {r0[0], r1[0], r0[1], r1[1]}; OUT = *reinterpret_cast<bf16x8*>(&w_); } while (0)
            PK4(p0, 0, pa0); PK4(p0, 8, pa1); PK4(p1, 0, pa2); PK4(p1, 8, pa3);
            att::pv_d0(o, vbj, pa0, pa1, pa2, pa3);
        }
#undef RSC_ISSUE
#pragma unroll 1
        for (int dir = 0; dir < 2; ++dir) {
            const float sc = dir ? __builtin_amdgcn_exp2f(lgb * (float)(256 - irow)) : __builtin_amdgcn_exp2f(lgf * (float)(irow + 1));
            const bf16_t* us = (const bf16_t*)(F.ws + US_RET_OFF) + ((size_t)((b * 4 + h) * 2 + dir) * PPB + cp_of(c, dir)) * RET_US_ELEMS;
            __syncthreads();
#pragma unroll
            for (int i = 0; i < 4; ++i) { const int idx = i * NTHR + F.tid, fr_ = idx >> 6, ln = idx & 63, ks = fr_ >> 2, d0 = fr_ & 3;
                *(LAS u32x4*)(lds + 32768 + idx * 16) = *(const u32x4*)(us + ((size_t)(ks * 8 + half * 4 + d0) * 64 + ln) * 8); }
            __syncthreads();
#pragma unroll
            for (int ks = 0; ks < 8; ++ks) { const u32x4 qs = scale8(*reinterpret_cast<const u32x4*>(&qr[ks]), sc); const bf16x8 qa = *reinterpret_cast<const bf16x8*>(&qs);
#pragma unroll
                for (int d0 = 0; d0 < 4; ++d0) { const bf16x8 sf = *(const LAS bf16x8*)(lds + 32768 + ((ks * 4 + d0) * 64 + lane) * 16);
                    o[d0] = __builtin_amdgcn_mfma_f32_32x32x16_bf16(qa, sf, o[d0], 0, 0, 0); } }
        }
#pragma unroll
        for (int d0 = 0; d0 < 4; ++d0)
#pragma unroll
            for (int r = 0; r < 16; ++r) ssq[r] += o[d0][r] * o[d0][r];
        if (half == 0) {
#pragma unroll
            for (int d0 = 0; d0 < 4; ++d0)
#pragma unroll
                for (int r = 0; r < 8; ++r) keep[(d0 * 8 + r) * 64] = cvtpk_c(o[d0][2 * r], o[d0][2 * r + 1]);
        }
    }
    const float* rn = inp(F, I_RNORM) + l * 256;
    bf16_t* ob = WSP(bf16_t, DY_OB) + ((size_t)b * TT + (size_t)c * 256 + 32 * w) * 1024 + h * 256 + r32;
    float wn[8];
#pragma unroll
    for (int j = 0; j < 8; ++j) wn[j] = rn[32 * j + r32];
#pragma unroll
    for (int r = 0; r < 16; ++r) { float s = ssq[r];
        s += __shfl_xor(s, 1); s += __shfl_xor(s, 2); s += __shfl_xor(s, 4); s += __shfl_xor(s, 8); s += __shfl_xor(s, 16);
        const float rs = rsqrtf(s * (1.0f / 256.0f) + EPS); bf16_t* rowp = ob + (size_t)crow(r, hi) * 1024;
#pragma unroll
        for (int d0 = 0; d0 < 4; ++d0) { const unsigned pw = keep[(d0 * 8 + (r >> 1)) * 64]; const float v0 = (r & 1) ? bfhi(pw) : bflo(pw);
            rowp[32 * d0] = (bf16_t)(cvtpk(v0 * rs * wn[d0], 0.f) & 0xffffu);
            rowp[128 + 32 * d0] = (bf16_t)(cvtpk(o[d0][r] * rs * wn[4 + d0], 0.f) & 0xffffu); } }
    __syncthreads();
#undef PK4
}
}


namespace hgm {
using att::crow; using att::v_st; using att::v_rd_base; using att::v_rd_off; using att::tr_read;
constexpr int TTAB_OFF = RING_BYTES + 1024;
__device__ __forceinline__ float dpp_shr0(float v, int) { return v; }
template <int CTRL> __device__ __forceinline__ float dppz(float v) { return __int_as_float(__builtin_amdgcn_update_dpp(0, __float_as_int(v), CTRL, 0xf, 0xf, true)); }
template <bool REV> __device__ __forceinline__ void scan32x8(float (&v)[8], int lane, float (&tot)[8]) {
#pragma unroll
    for (int e = 0; e < 8; ++e) v[e] += REV ? dppz<0x101>(v[e]) : dppz<0x111>(v[e]);
#pragma unroll
    for (int e = 0; e < 8; ++e) v[e] += REV ? dppz<0x102>(v[e]) : dppz<0x112>(v[e]);
#pragma unroll
    for (int e = 0; e < 8; ++e) v[e] += REV ? dppz<0x104>(v[e]) : dppz<0x114>(v[e]);
#pragma unroll
    for (int e = 0; e < 8; ++e) v[e] += REV ? dppz<0x108>(v[e]) : dppz<0x118>(v[e]);
    const bool up = (lane & 32) != 0, addrow = REV ? ((lane & 16) == 0) : ((lane & 16) != 0);
    float cr[8];
#pragma unroll
    for (int e = 0; e < 8; ++e) { const float t0 = __int_as_float(__builtin_amdgcn_readlane(__float_as_int(v[e]), REV ? 16 : 15)), t1 = __int_as_float(__builtin_amdgcn_readlane(__float_as_int(v[e]), REV ? 48 : 47)); cr[e] = up ? t1 : t0; }
#pragma unroll
    for (int e = 0; e < 8; ++e) v[e] += addrow ? cr[e] : 0.f;
#pragma unroll
    for (int e = 0; e < 8; ++e) { const float t0 = __int_as_float(__builtin_amdgcn_readlane(__float_as_int(v[e]), REV ? 0 : 31)), t1 = __int_as_float(__builtin_amdgcn_readlane(__float_as_int(v[e]), REV ? 32 : 63)); tot[e] = up ? t1 : t0; }
}
constexpr int LBT_OFF = TTAB_OFF + 4096 + 4608;
template <bool REV, int LAYOUT> __device__ __forceinline__ void prep(const bf16_t* zrow, const LAS float* lbl, int lane, LAS float* ttab_w, float (&E)[64], LAS char* lds, int row) {
    const int hi = lane >> 5;
    u32x4 zw[8];
#pragma unroll
    for (int d0 = 0; d0 < 8; ++d0) zw[d0] = *(const u32x4*)(zrow + 16 * d0);
#pragma unroll
    for (int d0 = 0; d0 < 8; ++d0) {
        const f32x4 l0 = *(const LAS f32x4*)(lbl + 16 * d0), l1 = *(const LAS f32x4*)(lbl + 16 * d0 + 4);
        const float z[8] = {bflo(zw[d0].x), bfhi(zw[d0].x), bflo(zw[d0].y), bfhi(zw[d0].y), bflo(zw[d0].z), bfhi(zw[d0].z), bflo(zw[d0].w), bfhi(zw[d0].w)};
        const float lb[8] = {l0[0], l0[1], l0[2], l0[3], l1[0], l1[1], l1[2], l1[3]};
        float kk[8], Bv[8], tot[8];
#pragma unroll
        for (int e = 0; e < 8; ++e) { const float sg = sigmoidf_(z[e]); const float f = fmaxf(lb[e] + (1.0f - lb[e]) * sg, 1e-20f); Bv[e] = __builtin_amdgcn_logf(f); kk[e] = (1.0f - lb[e]) * (1.0f - sg); }
        scan32x8<REV>(Bv, lane, tot);
        float kv[8];
#pragma unroll
        for (int e = 0; e < 8; ++e) { const float ee = Bv[e] - tot[e]; E[d0 * 8 + e] = ee; kv[e] = kk[e] * __builtin_amdgcn_exp2f(-ee); }
        if ((lane & 31) == 0) { *(LAS f32x4*)(ttab_w + 16 * d0 + 8 * hi) = (f32x4){tot[0], tot[1], tot[2], tot[3]}; *(LAS f32x4*)(ttab_w + 16 * d0 + 8 * hi + 4) = (f32x4){tot[4], tot[5], tot[6], tot[7]}; }
        u32x4 kh; kh.x = cvtpk(kv[0], kv[1]); kh.y = cvtpk(kv[2], kv[3]); kh.z = cvtpk(kv[4], kv[5]); kh.w = cvtpk(kv[6], kv[7]);
        if (LAYOUT == 0) *(LAS u32x4*)(lds + KSWZ256(row, (16 * d0 + 8 * hi) * 2)) = kh;
        else *(LAS u32x4*)(lds + (row >> 6) * 16384 + v_st(row & 63, 16 * d0 + 8 * hi)) = kh;
        __builtin_amdgcn_sched_barrier(0);
    }
}
__device__ __forceinline__ u32x4 qscale(const u32x4 q, const float* Ek) {
    u32x4 o; o.x = cvtpk(bflo(q.x) * __builtin_amdgcn_exp2f(Ek[0]), bfhi(q.x) * __builtin_amdgcn_exp2f(Ek[1])); o.y = cvtpk(bflo(q.y) * __builtin_amdgcn_exp2f(Ek[2]), bfhi(q.y) * __builtin_amdgcn_exp2f(Ek[3]));
    o.z = cvtpk(bflo(q.z) * __builtin_amdgcn_exp2f(Ek[4]), bfhi(q.z) * __builtin_amdgcn_exp2f(Ek[5])); o.w = cvtpk(bflo(q.w) * __builtin_amdgcn_exp2f(Ek[6]), bfhi(q.w) * __builtin_amdgcn_exp2f(Ek[7])); return o;
}
#define HG_PK4(P, BASE, OUT) do { unsigned a0 = cvtpk_c(P[BASE + 0], P[BASE + 1]), a1 = cvtpk_c(P[BASE + 2], P[BASE + 3]);     \
    unsigned b0_ = cvtpk_c(P[BASE + 4], P[BASE + 5]), b1_ = cvtpk_c(P[BASE + 6], P[BASE + 7]);                              \
    auto r0 = __builtin_amdgcn_permlane32_swap(a0, b0_, false, false); auto r1 = __builtin_amdgcn_permlane32_swap(a1, b1_, false, false); \
    u32x4 w_ = {r0[0], r1[0], r0[1], r1[1]}; OUT = *reinterpret_cast<bf16x8*>(&w_); } while (0)
template <int D0> __device__ __forceinline__ void pv32(f32x16& od, int vb, bf16x8 pa0, bf16x8 pa1) {
    const s16x4 l0 = tr_read<v_rd_off(D0, 0, 0)>(vb), h0 = tr_read<v_rd_off(D0, 0, 1)>(vb), l1 = tr_read<v_rd_off(D0, 1, 0)>(vb), h1 = tr_read<v_rd_off(D0, 1, 1)>(vb);
    asm volatile("s_waitcnt lgkmcnt(0)" ::: "memory"); __builtin_amdgcn_sched_barrier(0);
    od = __builtin_amdgcn_mfma_f32_32x32x16_bf16(pa0, (bf16x8){l0[0], l0[1], l0[2], l0[3], h0[0], h0[1], h0[2], h0[3]}, od, 0, 0, 0);
    od = __builtin_amdgcn_mfma_f32_32x32x16_bf16(pa1, (bf16x8){l1[0], l1[1], l1[2], l1[3], h1[0], h1[1], h1[2], h1[3]}, od, 0, 0, 0);
}

constexpr int PTAB_OFF = TTAB_OFF + 4096;
__device__ __forceinline__ u32x4 qfac(u32x4 Q, const LAS float* ca, const LAS float* cb, bool sub) {
    asm volatile("" : "+v"(Q.x), "+v"(Q.y), "+v"(Q.z), "+v"(Q.w));
    f32x4 a0 = *(const LAS f32x4*)(ca), a1 = *(const LAS f32x4*)(ca + 4);
    if (sub) { a0 -= *(const LAS f32x4*)(cb); a1 -= *(const LAS f32x4*)(cb + 4); }
    u32x4 o; o.x = cvtpk(bflo(Q.x) * __builtin_amdgcn_exp2f(a0[0]), bfhi(Q.x) * __builtin_amdgcn_exp2f(a0[1])); o.y = cvtpk(bflo(Q.y) * __builtin_amdgcn_exp2f(a0[2]), bfhi(Q.y) * __builtin_amdgcn_exp2f(a0[3]));
    o.z = cvtpk(bflo(Q.z) * __builtin_amdgcn_exp2f(a1[0]), bfhi(Q.z) * __builtin_amdgcn_exp2f(a1[1])); o.w = cvtpk(bflo(Q.w) * __builtin_amdgcn_exp2f(a1[2]), bfhi(Q.w) * __builtin_amdgcn_exp2f(a1[3])); return o;
}
constexpr int FTAB_OFF = LBT_OFF + 1024;
__device__ __forceinline__ u32x4 qmul(u32x4 Q, const LAS float* f) {
    asm volatile("" : "+v"(Q.x), "+v"(Q.y), "+v"(Q.z), "+v"(Q.w));
    const f32x4 a0 = *(const LAS f32x4*)(f), a1 = *(const LAS f32x4*)(f + 4);
    u32x4 o; o.x = cvtpk(bflo(Q.x) * a0[0], bfhi(Q.x) * a0[1]); o.y = cvtpk(bflo(Q.y) * a0[2], bfhi(Q.y) * a0[3]);
    o.z = cvtpk(bflo(Q.z) * a1[0], bfhi(Q.z) * a1[1]); o.w = cvtpk(bflo(Q.w) * a1[2], bfhi(Q.w) * a1[3]); return o;
}
template <bool REV, int SK = 0> __device__ __forceinline__ void out_dir(Frame& F, int l, int b, int h, int c, f32x16 (&o)[4]) {
    const int w = F.wave, lane = F.lane, r32 = lane & 31, hi = lane >> 5, dir = REV ? 1 : 0;
    LAS char* lds = (LAS char*)F.lds; LAS float* ttab = (LAS float*)(lds + TTAB_OFF); LAS float* ptab = (LAS float*)(lds + PTAB_OFF);
    const size_t rowoff = ((size_t)(b * 8 + h) * TT + (size_t)c * 256 + 32 * w + r32) * 128 + 8 * hi;
    const bf16_t* Z = WSP(bf16_t, DY_PC) + (size_t)(1 + dir) * MR * 1024 + rowoff; const bf16_t* GQ = WSP(bf16_t, DY_PC) + rowoff;
    LAS float* lbt = (LAS float*)(lds + LBT_OFF) + dir * 128;
    __syncthreads();
    u32x4 Qp[8];
    { float E[64];
      prep<REV, 0>(Z, lbt + 8 * hi, lane, ttab + w * 128, E, lds, 32 * w + r32);
#pragma unroll
      for (int d0 = 0; d0 < 8; ++d0) Qp[d0] = *(const u32x4*)(GQ + 16 * d0);
#pragma unroll
      for (int d0 = 0; d0 < 8; ++d0) asm volatile("" : "+v"(Qp[d0]));
#pragma unroll
      for (int d0 = 0; d0 < 8; ++d0) Qp[d0] = qscale(Qp[d0], &E[d0 * 8]); }
    __syncthreads();
    if (F.tid < 128) { float s = 0.f;
#pragma unroll
        for (int pi = 0; pi < 8; ++pi) { ptab[pi * 128 + F.tid] = s; s += ttab[(REV ? 7 - pi : pi) * 128 + F.tid]; }
        ptab[8 * 128 + F.tid] = s; }
    __syncthreads();
    const int vbase = (int)(uintptr_t)lds + 65536 + v_rd_base(lane);
    const int piw = REV ? 7 - w : w; const LAS float* cw = ptab + (piw + 1) * 128 + 8 * hi; LAS float* ftab = (LAS float*)(lds + FTAB_OFF) + w * 128;
    for (int pi = (SK & 1) ? -1 : piw; pi >= 0; --pi) {
        const int J = REV ? 7 - pi : pi; const LAS float* cj = ptab + (pi + 1) * 128 + 8 * hi;
        { const LAS float* pw = ptab + (piw + 1) * 128, *pj = ptab + (pi + 1) * 128;
          ftab[lane] = __builtin_amdgcn_exp2f(pw[lane] - pj[lane]); ftab[lane + 64] = __builtin_amdgcn_exp2f(pw[lane + 64] - pj[lane + 64]); }
        asm volatile("s_waitcnt lgkmcnt(0)" ::: "memory");
        f32x16 p;
#pragma unroll
        for (int r = 0; r < 16; ++r) p[r] = 0.f;
#pragma unroll
        for (int d0 = 0; d0 < 8; ++d0) { const u32x4 qt = qmul(Qp[d0], ftab + 8 * hi + 16 * d0); const bf16x8 a = *(const LAS bf16x8*)(lds + KSWZ256(32 * J + r32, (16 * d0 + 8 * hi) * 2));
            p = __builtin_amdgcn_mfma_f32_32x32x16_bf16(a, *reinterpret_cast<const bf16x8*>(&qt), p, 0, 0, 0);
            if (d0 & 1) __builtin_amdgcn_sched_barrier(0); }
        if (pi == piw) {
#pragma unroll
            for (int r = 0; r < 16; ++r) { const int jj = crow(r, hi); const bool keep = REV ? (jj >= r32) : (jj <= r32); p[r] = keep ? p[r] : 0.f; } }
        bf16x8 pa0, pa1; HG_PK4(p, 0, pa0); HG_PK4(p, 8, pa1);
        const int vb = vbase + (J >> 1) * 16384 + (J & 1) * 8192;
        pv32<0>(o[0], vb, pa0, pa1); pv32<1>(o[1], vb, pa0, pa1); pv32<2>(o[2], vb, pa0, pa1); pv32<3>(o[3], vb, pa0, pa1);
    }
    const bf16_t* us = (const bf16_t*)(F.ws + scn::US_HG_OFF) + ((size_t)((b * 8 + h) * 2 + dir) * PPB + scn::cp_of(c, dir)) * scn::HG_US_ELEMS + (size_t)lane * 8;
    if (!(SK & 2)) {
        bf16x8 sfa[2][4], sfb[2][4];
#define HG_SLD(buf, kq) do { _Pragma("unroll") for (int k2 = 0; k2 < 2; ++k2) _Pragma("unroll") for (int d0 = 0; d0 < 4; ++d0) buf[k2][d0] = *(const bf16x8*)(us + (size_t)((2 * (kq) + k2) * 4 + d0) * 512); } while (0)
#define HG_SMM(buf, kq) do { _Pragma("unroll") for (int k2 = 0; k2 < 2; ++k2) { const u32x4 qe = qfac(Qp[2 * (kq) + k2], cw + 16 * (2 * (kq) + k2), cw, false);                                  \
            _Pragma("unroll") for (int d0 = 0; d0 < 4; ++d0) o[d0] = __builtin_amdgcn_mfma_f32_32x32x16_bf16(*reinterpret_cast<const bf16x8*>(&qe), buf[k2][d0], o[d0], 0, 0, 0); } } while (0)
        HG_SLD(sfa, 0); HG_SLD(sfb, 1); __builtin_amdgcn_sched_barrier(0);
        HG_SMM(sfa, 0); __builtin_amdgcn_sched_barrier(0); HG_SLD(sfa, 2); __builtin_amdgcn_sched_barrier(0);
        HG_SMM(sfb, 1); __builtin_amdgcn_sched_barrier(0); HG_SLD(sfb, 3); __builtin_amdgcn_sched_barrier(0);
        HG_SMM(sfa, 2); __builtin_amdgcn_sched_barrier(0); HG_SMM(sfb, 3); __builtin_amdgcn_sched_barrier(0);
#undef HG_SLD
#undef HG_SMM
    }
    __syncthreads();
}
template <int SK = 0> __device__ __forceinline__ void out_unit(Frame& F, int l, int b, int h, int c) {
    const int w = F.wave, lane = F.lane, r32 = lane & 31, hi = lane >> 5;
    LAS char* lds = (LAS char*)F.lds;
    const size_t rowoff = ((size_t)(b * 8 + h) * TT + (size_t)c * 256 + 32 * w + r32) * 128 + 8 * hi;
    const bf16_t* GI = WSP(bf16_t, DY_PC) + (size_t)3 * MR * 1024 + rowoff;
    { u32x4 gv[8];
#pragma unroll
      for (int d0 = 0; d0 < 8; ++d0) gv[d0] = *(const u32x4*)(GI + 16 * d0);
      float lbv = 0.f; if (F.tid < 256) lbv = WSP(float, WS_LB)[l * 2048 + (F.tid >> 7) * 1024 + h * 128 + (F.tid & 127)];
#pragma unroll
      for (int d0 = 0; d0 < 8; ++d0) asm volatile("" : "+v"(gv[d0]));
      if (F.tid < 256) ((LAS float*)(lds + LBT_OFF))[F.tid] = lbv;
#pragma unroll
      for (int d0 = 0; d0 < 8; ++d0) { const int row = 32 * w + r32; *(LAS u32x4*)(lds + 65536 + (row >> 6) * 16384 + v_st(row & 63, 16 * d0 + 8 * hi)) = gv[d0]; } }
    f32x16 o[4];
#pragma unroll
    for (int d = 0; d < 4; ++d)
#pragma unroll
        for (int r = 0; r < 16; ++r) o[d][r] = 0.f;
    out_dir<false, SK>(F, l, b, h, c, o);
    if (!(SK & 4)) out_dir<true, SK>(F, l, b, h, c, o);
    const float* gn = inp(F, I_GNORM) + l * 128;
    bf16_t* oc = WSP(bf16_t, DY_OC) + ((size_t)b * TT + (size_t)c * 256 + 32 * w) * 1024 + h * 128 + r32;
    float wn[4];
#pragma unroll
    for (int j = 0; j < 4; ++j) wn[j] = gn[32 * j + r32];
#pragma unroll
    for (int r = 0; r < 16; ++r) { float s = 0.f;
#pragma unroll
        for (int d0 = 0; d0 < 4; ++d0) s += o[d0][r] * o[d0][r];
        s += __shfl_xor(s, 1); s += __shfl_xor(s, 2); s += __shfl_xor(s, 4); s += __shfl_xor(s, 8); s += __shfl_xor(s, 16);
        const float rs = rsqrtf(s * (1.0f / 128.0f) + EPS); bf16_t* rowp = oc + (size_t)crow(r, hi) * 1024;
#pragma unroll
        for (int d0 = 0; d0 < 4; ++d0) rowp[32 * d0] = (bf16_t)(cvtpk(o[d0][r] * rs * wn[d0], 0.f) & 0xffffu); }
}

template <bool REV> __device__ __forceinline__ void local_dir(Frame& F, int l, int b, int h, int c) {
    const int w = F.wave, lane = F.lane, r32 = lane & 31, hi = lane >> 5, dir = REV ? 1 : 0, rb = w >> 1, cb0 = 2 * (w & 1);
    LAS char* lds = (LAS char*)F.lds; LAS float* ttab = (LAS float*)(lds + TTAB_OFF);
    const bf16_t* Z = WSP(bf16_t, DY_PC) + (size_t)(1 + dir) * MR * 1024 + ((size_t)(b * 8 + h) * TT + (size_t)c * 256 + 32 * w + r32) * 128 + 8 * hi;
    LAS float* lbt = (LAS float*)(lds + LBT_OFF) + dir * 128;
    __syncthreads();
    { float E[64]; prep<REV, 1>(Z, lbt + 8 * hi, lane, ttab + w * 128, E, lds, 32 * w + r32); }
    __syncthreads();
    f32x16 acc[2];
#pragma unroll
    for (int cb = 0; cb < 2; ++cb)
#pragma unroll
        for (int r = 0; r < 16; ++r) acc[cb][r] = 0.f;
    const int vbK0 = (int)(uintptr_t)lds + rb * 512 + v_rd_base(lane), vbV0 = (int)(uintptr_t)lds + 65536 + cb0 * 512 + v_rd_base(lane);
    for (int i = 0; i < 8; ++i) { const int blk = REV ? 7 - i : i;
        if (i > 0) { const LAS float* tb = ttab + blk * 128 + 32 * rb + 4 * hi;
#pragma unroll
            for (int g = 0; g < 4; ++g) { const f32x4 t = *(const LAS f32x4*)(tb + 8 * g);
#pragma unroll
                for (int j = 0; j < 4; ++j) { const float s = __builtin_amdgcn_exp2f(t[j]); acc[0][4 * g + j] *= s; acc[1][4 * g + j] *= s; } } }
        const int off = (blk >> 1) * 16384 + (blk & 1) * 8192; const int vk = vbK0 + off, vv = vbV0 + off;
#define HL_STEP(KS2) { const s16x4 al = tr_read<v_rd_off(0, KS2, 0)>(vk), ah = tr_read<v_rd_off(0, KS2, 1)>(vk), b0l = tr_read<v_rd_off(0, KS2, 0)>(vv), b0h = tr_read<v_rd_off(0, KS2, 1)>(vv), \
            b1l = tr_read<v_rd_off(1, KS2, 0)>(vv), b1h = tr_read<v_rd_off(1, KS2, 1)>(vv); \
            asm volatile("s_waitcnt lgkmcnt(0)" ::: "memory"); __builtin_amdgcn_sched_barrier(0); \
            const bf16x8 A_ = {al[0], al[1], al[2], al[3], ah[0], ah[1], ah[2], ah[3]}; \
            acc[0] = __builtin_amdgcn_mfma_f32_32x32x16_bf16(A_, (bf16x8){b0l[0], b0l[1], b0l[2], b0l[3], b0h[0], b0h[1], b0h[2], b0h[3]}, acc[0], 0, 0, 0); \
            acc[1] = __builtin_amdgcn_mfma_f32_32x32x16_bf16(A_, (bf16x8){b1l[0], b1l[1], b1l[2], b1l[3], b1h[0], b1h[1], b1h[2], b1h[3]}, acc[1], 0, 0, 0); }
        HL_STEP(0) HL_STEP(1)
#undef HL_STEP
    }
    const size_t slot = (size_t)((b * 8 + h) * 2 + dir) * PPB + scn::cp_of(c, dir);
    bf16_t* us = (bf16_t*)(F.ws + scn::US_HG_OFF) + slot * scn::HG_US_ELEMS;
    scn::store_state_tile(us, acc[0], rb, cb0, 4, r32, hi); scn::store_state_tile(us, acc[1], rb, cb0 + 1, 4, r32, hi);
    if (F.tid < 128) { float s = 0.f;
#pragma unroll
        for (int k = 0; k < 8; ++k) s += ttab[k * 128 + F.tid];
        ((float*)(F.ws + scn::HG_A_OFF))[slot * 128 + F.tid] = __builtin_amdgcn_exp2f(s); }
    __syncthreads();
}
__device__ __forceinline__ void local_unit(Frame& F, int l, int b, int h, int c) {
    const int w = F.wave, lane = F.lane, r32 = lane & 31, hi = lane >> 5;
    LAS char* lds = (LAS char*)F.lds;
    const bf16_t* GI = WSP(bf16_t, DY_PC) + (size_t)3 * MR * 1024 + ((size_t)(b * 8 + h) * TT + (size_t)c * 256 + 32 * w + r32) * 128 + 8 * hi;
    { u32x4 gv[8];
#pragma unroll
      for (int d0 = 0; d0 < 8; ++d0) gv[d0] = *(const u32x4*)(GI + 16 * d0);
      float lbv = 0.f; if (F.tid < 256) lbv = WSP(float, WS_LB)[l * 2048 + (F.tid >> 7) * 1024 + h * 128 + (F.tid & 127)];
#pragma unroll
      for (int d0 = 0; d0 < 8; ++d0) asm volatile("" : "+v"(gv[d0]));
      if (F.tid < 256) ((LAS float*)(lds + LBT_OFF))[F.tid] = lbv;
#pragma unroll
      for (int d0 = 0; d0 < 8; ++d0) { const int row = 32 * w + r32; *(LAS u32x4*)(lds + 65536 + (row >> 6) * 16384 + v_st(row & 63, 16 * d0 + 8 * hi)) = gv[d0]; } }
    local_dir<false>(F, l, b, h, c);
    local_dir<true>(F, l, b, h, c);
}
}

__device__ __forceinline__ void sa_phase(Frame& F, int l) {
    for (int u = F.bid; u < NB * 4 * PPB; u += F.G) { const int c = u % PPB, h = (u / PPB) & 3, b = u / (PPB * 4); scn::ret_local_unit(F, b, h, c); __syncthreads(); }
    frame_refresh(F);
    for (int u = F.G - 1 - F.bid; u < NB * 8 * PPB; u += F.G) { const int c = u % PPB, h = (u / PPB) & 7, b = u / (PPB * 8); hgm::local_unit(F, l, b, h, c); }
}
__device__ __forceinline__ void sc_phase(Frame& F, int l) {
    const int NC = (l == 1) ? PPB - 1 : PPB;
    for (int u = F.bid; u < NB * 4 * NC; u += F.G) { const int c = u % NC, h = (u / NC) & 3, b = u / (NC * 4); scn::ret_out_unit(F, l, b, h, c); }
    frame_refresh(F);
#ifndef HG_PROBE
#define HG_PROBE -1
#endif
    if (HG_PROBE >= 0) { for (int u = F.G - 1 - F.bid; u < NB * 8 * NC; u += F.G) { const int c = u % NC, h = (u / NC) & 7, b = u / (NC * 8); hgm::out_unit<(HG_PROBE < 0 ? 0 : HG_PROBE)>(F, l, b, h, c); } frame_refresh(F); }
    for (int u = F.G - 1 - F.bid; u < NB * 8 * NC; u += F.G) { const int c = u % NC, h = (u / NC) & 7, b = u / (NC * 8); hgm::out_unit<0>(F, l, b, h, c); }
}

#ifndef RET_MFMA
#define RET_MFMA 1
#endif
enum { PH_PRO = 0, PH_MODFIN, PH_N1, PH_GA, PH_ATT, PH_GB, PH_SA, PH_SB, PH_SC, PH_OG, PH_MG, PH_WO, PH_N2, PH_UP, PH_FIX, PH_DN, PH_COUNT };

template <int NN, int WG> struct PanelOrder : pg8::TileOrder<NN, WG> {
    int skip;
    __device__ __forceinline__ bool next(int i, pg8::Unit& u) const { const bool ok = pg8::TileOrder<NN, WG>::next(i, u); if (ok && skip) u.pm += (u.pm >= PPB - 1) ? 1 : 0; return ok; }
};
struct ProjOrder : PanelOrder<8, 4> {
    __device__ __forceinline__ bool next(int i, pg8::Unit& u) const { const int r = i / 3, n = i - 3 * r; const bool ok = PanelOrder<8, 4>::next(r, u); if (ok) { u.pm += n * NPAN; u.pn += 8 * n; } return ok; }
    __device__ __forceinline__ bool keep(int i) const { return (i % 3) != 2; }
};
template <int N, int WG, class Epi> __device__ __forceinline__ void run_gemm(Frame& F, const bf16_t* A, const bf16_t* Bt, int K, const Epi& E, bool skipctx = false) {
    pg8::Gemm g{A, Bt, MR, N, K}; PanelOrder<N / 256, WG> S; S.init(skipctx ? MR - 512 : MR, N, F.G, F.bid); S.skip = skipctx ? 1 : 0;
    pg8::gemm_phase<Epi, PanelOrder<N / 256, WG>, false>(F.lds, g, S, E, nullptr);
}
__device__ __forceinline__ EpiIn make_epi_in(Frame& F, int l, int pt0) {
    EpiIn E; E.pt0 = pt0;
    E.rq = WSP(bf16_t, DY_QKV); E.r2 = WSP(bf16_t, DY_PB); E.r1 = WSP(bf16_t, DY_PC);
    E.qkn = inp(F, I_QKN) + l * 128; E.ropeA = WSP(f32x2, WS_ROPEA); E.ropeB = WSP(f32x2, WS_ROPEB);
    return E;
}
__device__ __forceinline__ EpiRes make_epi_res(Frame& F, int l, int use_inputs, int gidx) {
    EpiRes E; E.srcx = use_inputs ? inp(F, I_X) : outp(F); E.srcc = use_inputs ? inp(F, I_CTX) : WSP(float, WS_XC); E.dstx = outp(F); E.dstc = WSP(float, WS_XC);
    E.gate0 = WSP(float, WS_MODV) + ((size_t)(l * 3) * 6 + gidx) * D; return E;
}

template <int PH> __device__ __forceinline__ void run_phase(Frame& F, int l) {
    frame_refresh(F);
    const bf16_t* h = WSP(bf16_t, WS_H); const bf16_t* wt = WSP(bf16_t, WS_WT);
    const bf16_t* wt_in = wt + WT_IN / 2;
    if constexpr (PH == PH_PRO) { p0_mod_partial(F); p0_tables(F); convert_weights(F, 0, 0, 36 * 32, 0); }
    if constexpr (PH == PH_MODFIN) { p1_mod_final(F); }
    if constexpr (PH == PH_N1) { norm_phase(F, l, 0); }
    if constexpr (PH == PH_GA) { const EpiIn E = make_epi_in(F, l, PT_DQ); run_gemm<9216, 8>(F, h, wt_in, D, E);
        frame_refresh(F); if (l == 0) convert_weights(F, 0, 36 * 32, CT_IN, 72); else convert_weights(F, 1, CT0_DN, CT_ALL, 72); }
#ifndef ATT_PROBE
#define ATT_PROBE -1
#endif
    if constexpr (PH == PH_ATT) { if (ATT_PROBE >= 0) { attn_phase<(ATT_PROBE < 0 ? 0 : ATT_PROBE)>(F, l); __syncthreads(); } attn_phase<0>(F, l); }
    if constexpr (PH == PH_GB) { }
    if constexpr (PH == PH_SA) { sa_phase(F, l); }
    if constexpr (PH == PH_SB) { scn::scan_states(F, true, true); }
    if constexpr (PH == PH_SC) { sc_phase(F, l); }
    if constexpr (PH == PH_OG) { EpiGates E; E.oB = WSP(bf16_t, DY_OB); E.oC = WSP(bf16_t, DY_OC); E.G = WSP(bf16_t, DY_MG); E.bias = inp(F, I_BGATE) + (size_t)l * 3 * D;
        run_gemm<8192, 4>(F, h, wt_in + (size_t)PT_RG * 256 * D, D, E, l == 1);
        if (l == 0) { frame_refresh(F); convert_weights(F, 0, CT0_BR, CT0_UP, 64); } }
    if constexpr (PH == PH_MG) {
        EpiProjAll E{WSP(bf16_t, DY_MG), WSP(bf16_t, DY_YO)};
        pg8::Gemm g{WSP(bf16_t, DY_OA), wt + WT_BR / 2, MR, 2048, 1024}; ProjOrder S; const bool sk = (l == 1); S.init(sk ? MR - 512 : MR, 2048, F.G, F.bid); S.skip = sk ? 1 : 0;
        pg8::gemm_phase<EpiProjAll, ProjOrder, false>(F.lds, g, S, E, nullptr);
        if (l == 0) { frame_refresh(F); convert_weights(F, 0, CT0_UP, CT0_DN, 16); }
    }
    if constexpr (PH == PH_WO) { const EpiRes E = make_epi_res(F, l, l == 0, 2); run_gemm<2048, 4>(F, WSP(bf16_t, DY_YO), wt + WT_OUT / 2, D, E, l == 1);
        if (l == 0) { frame_refresh(F); convert_weights(F, 0, CT0_DN, CT_ALL, 16); } }
    if constexpr (PH == PH_N2) { norm_phase(F, l, 1); }
    if constexpr (PH == PH_UP) { EpiConv E; E.g = WSP(bf16_t, DY_G); E.raw = WSP(float, DY_RAW); E.cw = inp(F, I_CONVW) + (size_t)l * 3 * NUP; E.cb = inp(F, I_CONVB) + (size_t)l * NUP;
        run_gemm<NUP, 8>(F, h, wt + WT_UP / 2, D, E, l == 1); }
    if constexpr (PH == PH_FIX) { ffn_fixup(F, l); }
    if constexpr (PH == PH_DN) { const EpiRes E = make_epi_res(F, l, 0, 5); run_gemm<2048, 4>(F, WSP(bf16_t, DY_G), wt + WT_DOWN / 2, DFF, E, l == 1);
        if (l == 0) { frame_refresh(F); convert_weights(F, 1, 0, CT0_DN, 16); } }
}

__device__ __forceinline__ void frame_init(Frame& F, const Args& a, unsigned char* lds) {
    F.lds = (LAS unsigned char*)lds; F.a = &a; F.G = gridDim.x; F.bid = blockIdx.x; frame_refresh(F);
}
template <int PH> __global__ void __launch_bounds__(NTHR, 2) k_phase(Args a) {
    extern __shared__ __attribute__((aligned(16))) unsigned char lds[];
    Frame F; frame_init(F, a, lds);
    run_phase<PH>(F, a.layer);
}
#ifndef MK_SINGLE
#define MK_SINGLE 1
#endif
__global__ void __launch_bounds__(NTHR, 2) k_all(Args a) {
    extern __shared__ __attribute__((aligned(16))) unsigned char lds[];
    Frame F; frame_init(F, a, lds);
    for (int u = F.tid; u < (LDS_BYTES - LDSCTL_OFF) / 4; u += NTHR) ((LAS unsigned*)(F.lds + LDSCTL_OFF))[u] = 0u;
    __syncthreads();
    (void)xcd_barrier_post((unsigned*)(a.ws + WS_CTL) + CW_BAR, (volatile LAS unsigned*)(F.lds + MISC_OFF + 32));
#define GRID_BAR() do { XcdBarrier b_; unsigned* bp_ = (unsigned*)(a.ws + WS_CTL) + CW_BAR; asm volatile("" : "+s"(bp_)); b_.bar = bp_; b_.x = xb_xcc_id(); \
        b_.st = (volatile LAS unsigned*)(F.lds + MISC_OFF + 32); xcd_barrier(b_); } while (0)
#ifndef PROBE_MASK
#define PROBE_MASK 0
#endif
#ifndef PROBE_T
#define PROBE_T 0
#endif
    unsigned long long pt0 = 0, pt1 = 0, pc0 = 0, pc1 = 0;
#define TSTART(ph, l_) do { if (PROBE_T && (ph) == PROBE_T - 1 && (l_) == 0) { pt0 = __builtin_amdgcn_s_memrealtime(); pc0 = (unsigned long long)clock64(); } } while (0)
#define TSTOP(ph, l_)  do { if (PROBE_T && (ph) == PROBE_T - 1 && (l_) == 0) { pt1 = __builtin_amdgcn_s_memrealtime(); pc1 = (unsigned long long)clock64(); } } while (0)
#define RUN(ph, l_, grp) do { TSTART(ph, l_); run_phase<ph>(F, l_); GRID_BAR(); TSTOP(ph, l_); if ((PROBE_MASK >> (grp)) & 1) { run_phase<ph>(F, l_); GRID_BAR(); } } while (0)
    RUN(PH_PRO, 0, 0); RUN(PH_MODFIN, 0, 0);
#pragma unroll 1
    for (int l = 0; l < 2; ++l) {
        RUN(PH_N1, l, 0);
        RUN(PH_GA, l, 1);
        RUN(PH_ATT, l, 2);
        RUN(PH_SA, l, 3);
        run_phase<PH_SB>(F, l); GRID_BAR();
        RUN(PH_SC, l, 4);
        run_phase<PH_OG>(F, l); GRID_BAR();
        RUN(PH_MG, l, 5);
        run_phase<PH_WO>(F, l); GRID_BAR();
        RUN(PH_N2, l, 0);
        RUN(PH_UP, l, 6);
        RUN(PH_FIX, l, 0);
        run_phase<PH_DN>(F, l); GRID_BAR();
    }
#undef RUN
    if (PROBE_T) {
        float* slot = (float*)(F.ws + WS_SCAL) + 64;
        if (F.bid == 0 && threadIdx.x == 0) { const float mhz = (float)(pc1 - pc0) / ((float)(pt1 - pt0) * 0.01f); *slot = floorf(mhz / 50.0f) * 50.0f; }
        GRID_BAR();
        const float v = *slot;
        for (size_t i = (size_t)F.bid * NTHR + threadIdx.x; i < (size_t)NB * T * D; i += (size_t)F.G * NTHR) a.out[i] = v;
    }
#undef GRID_BAR
}
__global__ void k_fill(float* out, size_t n, float v) { for (size_t i = (size_t)blockIdx.x * blockDim.x + threadIdx.x; i < n; i += (size_t)gridDim.x * blockDim.x) out[i] = v; }

template <int PH> static void launch_phase(const Args& a0, int layer, int grid, hipStream_t stream) {
    static bool attr = false;
    if (!attr) { if (hipFuncSetAttribute((const void*)k_phase<PH>, hipFuncAttributeMaxDynamicSharedMemorySize, LDS_BYTES) != hipSuccess) fprintf(stderr, "kernel_launch: hipFuncSetAttribute failed for phase %d\n", PH); attr = true; }
    Args a = a0; a.layer = layer;
    hipLaunchKernelGGL(k_phase<PH>, dim3(grid), dim3(NTHR), LDS_BYTES, stream, a);
    const hipError_t e = hipPeekAtLastError(); if (e != hipSuccess) fprintf(stderr, "kernel_launch: phase %d launch failed: %s\n", PH, hipGetErrorName(e));
}
extern "C" void kernel_launch(void* const* d_in, const int* in_sizes, int n_in, void* d_out, int out_size, void* d_ws, size_t ws_size, hipStream_t stream) {
    static int grid = 0;
    if (grid == 0) { int dev = 0, cus = 0; if (hipGetDevice(&dev) != hipSuccess || hipDeviceGetAttribute(&cus, hipDeviceAttributeMultiprocessorCount, dev) != hipSuccess || cus < 1) cus = 256; grid = cus; }
    if (n_in != N_INPUTS || out_size != NB * T * D || ws_size < WS_END) {
        fprintf(stderr, "kernel_launch: unexpected shapes: n_in %d out %d ws %zu (need %zu)\n", n_in, out_size, ws_size, (size_t)WS_END);
        hipLaunchKernelGGL(k_fill, dim3(1024), dim3(256), 0, stream, (float*)d_out, (size_t)out_size, (float)(ws_size >> 20));
        return;
    }
    Args a{};
    for (int i = 0; i < N_INPUTS; ++i) a.in[i] = (const float*)d_in[i];
    a.out = (float*)d_out; a.ws = (unsigned char*)d_ws; a.layer = 0; a.ph_lo = 0; a.ph_hi = 0; a.pad = 0;
#if MK_SINGLE
    {
        static bool attr = false;
        if (!attr) { if (hipFuncSetAttribute((const void*)k_all, hipFuncAttributeMaxDynamicSharedMemorySize, LDS_BYTES) != hipSuccess) fprintf(stderr, "kernel_launch: hipFuncSetAttribute failed\n");
            int per_cu = 0; if (hipOccupancyMaxActiveBlocksPerMultiprocessor(&per_cu, (const void*)k_all, NTHR, LDS_BYTES) != hipSuccess || per_cu < 1) fprintf(stderr, "kernel_launch: occupancy query says %d blocks per CU\n", per_cu);
            (void)hipGetLastError(); attr = true; }
        if (hipMemsetAsync((char*)d_ws + WS_CTL, 0, CTL_ZERO_BYTES, stream) != hipSuccess) { fprintf(stderr, "kernel_launch: memset failed\n"); return; }
        hipLaunchKernelGGL(k_all, dim3(grid), dim3(NTHR), LDS_BYTES, stream, a);
        const hipError_t e = hipPeekAtLastError(); if (e != hipSuccess) fprintf(stderr, "kernel_launch: launch failed: %s\n", hipGetErrorName(e));
        return;
    }
#endif
    launch_phase<PH_PRO>(a, 0, grid, stream);
    launch_phase<PH_MODFIN>(a, 0, grid, stream);
    for (int l = 0; l < 2; ++l) {
        launch_phase<PH_N1>(a, l, grid, stream); launch_phase<PH_GA>(a, l, grid, stream); launch_phase<PH_ATT>(a, l, grid, stream); launch_phase<PH_GB>(a, l, grid, stream);
        launch_phase<PH_SA>(a, l, grid, stream); launch_phase<PH_SB>(a, l, grid, stream); launch_phase<PH_SC>(a, l, grid, stream);
        launch_phase<PH_OG>(a, l, grid, stream); launch_phase<PH_MG>(a, l, grid, stream);
        launch_phase<PH_WO>(a, l, grid, stream); launch_phase<PH_N2>(a, l, grid, stream); launch_phase<PH_UP>(a, l, grid, stream); launch_phase<PH_FIX>(a, l, grid, stream);
        launch_phase<PH_DN>(a, l, grid, stream);
    }
}
```
